# Optimizing an MI355X kernel written in HIP

```python
import math
import jax, jax.numpy as jnp
from jax import lax
import numpy as np

D_MODEL = 1024
BATCH = 32
SEQ = 2048
DEPTH = 4

N_META = 16
GLA_H = 4
GLA_DK = D_MODEL // 2 // GLA_H
GLA_DV = D_MODEL // GLA_H
GLA_LR = 16
GLA_TAU = 16.0
GLA_CHUNK = 64
DSA_H = 16
DSA_DH = D_MODEL // DSA_H
DSA_Q_LORA = D_MODEL // 4
DSA_KV_LAT = D_MODEL // 8
IDX_H = 8
IDX_D = 64
TOPK_MAX = 256
QBLK = 128
ML_H = 4
ML_DK = D_MODEL // 2 // ML_H
ML_DV = D_MODEL // ML_H
ML_CONV = 4
ML_CHUNK = 64
T5_BUCKETS = 32
T5_MAX_DIST = 128
D_FF = 4 * D_MODEL
EPS = 1e-6
NEG = -1e30

COL_SPLITS = (
    GLA_H * GLA_DK, GLA_H * GLA_DK, GLA_H * GLA_DV, GLA_H * GLA_DV, GLA_LR,
    DSA_Q_LORA, DSA_KV_LAT, IDX_D, IDX_H,
    ML_H * ML_DK, ML_H * ML_DK, ML_H * ML_DV, ML_H * ML_DV, ML_H, ML_H,
    D_MODEL, D_MODEL, D_MODEL,
)
N_COLS = sum(COL_SPLITS)

kernel_name = "hybrid_gla_dsa_mlstm_trunk"


def rms_norm(x, g):
    x32 = x.astype(jnp.float32)
    y = x32 * lax.rsqrt(jnp.mean(x32 * x32, axis=-1, keepdims=True) + EPS)
    return (y * g.astype(jnp.float32)).astype(x.dtype)


def layer_norm(x, g, b):
    x32 = x.astype(jnp.float32)
    mu = jnp.mean(x32, axis=-1, keepdims=True)
    var = jnp.mean(jnp.square(x32 - mu), axis=-1, keepdims=True)
    y = (x32 - mu) * lax.rsqrt(var + EPS) * g.astype(jnp.float32) + b.astype(jnp.float32)
    return y.astype(x.dtype)


def to_chunks(a, chunk):
    front = (-a.shape[1]) % chunk
    a = jnp.pad(a, [(0, 0), (front, 0)] + [(0, 0)] * (a.ndim - 2))
    b, tp = a.shape[:2]
    a = a.reshape(b, tp // chunk, chunk, *a.shape[2:])
    perm = (1, 0, 3, 2) + tuple(range(4, a.ndim))
    return a.transpose(perm), front


def from_chunks(a, front):
    a = a.transpose(1, 0, 3, 2, 4)
    b, nc, c, h, d = a.shape
    return a.reshape(b, nc * c, h, d)[:, front:]


def causal_dwconv(x, w):
    return lax.conv_general_dilated(
        x, w[:, None, :].astype(x.dtype), window_strides=(1,), padding=[(ML_CONV - 1, 0)],
        dimension_numbers=("NWC", "WIO", "NWC"), feature_group_count=x.shape[-1])


def t5_bucket(rel):
    n = jnp.maximum(rel, 0)
    max_exact = T5_BUCKETS // 2
    nf = jnp.maximum(n, 1).astype(jnp.float32)
    large = max_exact + (jnp.log(nf / max_exact) / math.log(T5_MAX_DIST / max_exact)
                         * (T5_BUCKETS - max_exact)).astype(jnp.int32)
    large = jnp.minimum(large, T5_BUCKETS - 1)
    return jnp.where(n < max_exact, n, large)


def gla_chunk_step(S, xs):
    q, k, v, g = xs
    C = q.shape[2]
    G = jnp.cumsum(g, axis=2)
    causal = jnp.tril(jnp.ones((C, C), bool))
    diff = G[:, :, :, None, :] - G[:, :, None, :, :]
    decay = jnp.exp(jnp.where(causal[None, None, :, :, None], diff, -jnp.inf))
    A = jnp.einsum("bhtk,bhtsk,bhsk->bhts", q, decay, k)
    o = jnp.einsum("bhtk,bhkv->bhtv", q * jnp.exp(G), S) + jnp.einsum("bhts,bhsv->bhtv", A, v)
    G_last = G[:, :, -1:, :]
    S_new = jnp.exp(G_last[:, :, 0, :])[..., None] * S + jnp.einsum(
        "bhsk,bhsv->bhkv", k * jnp.exp(G_last - G), v)
    return S_new, o


def gla_branch(q, k, v, r, a_lr, p):
    B, T = q.shape[:2]
    q = q.reshape(B, T, GLA_H, GLA_DK) * GLA_DK ** -0.5
    k = k.reshape(B, T, GLA_H, GLA_DK)
    v = v.reshape(B, T, GLA_H, GLA_DV)
    g = jax.nn.log_sigmoid((a_lr @ p["w_gla_a2"] + p["b_gla_a"]).astype(jnp.float32)) / GLA_TAU
    g = g.reshape(B, T, GLA_H, GLA_DK)
    qc, front = to_chunks(q, GLA_CHUNK)
    kc, _ = to_chunks(k, GLA_CHUNK)
    vc, _ = to_chunks(v, GLA_CHUNK)
    gc, _ = to_chunks(g, GLA_CHUNK)
    s0 = jnp.zeros((B, GLA_H, GLA_DK, GLA_DV), jnp.float32)
    _, oc = lax.scan(gla_chunk_step, s0, (qc, kc, vc, gc))
    o = from_chunks(oc, front)
    o = rms_norm(o, p["g_gla_head"]) * jax.nn.silu(r.reshape(B, T, GLA_H, GLA_DV))
    return o.reshape(B, T, GLA_H * GLA_DV).astype(v.dtype)


def dsa_branch(c_q, c_kv, k_idx, w_idx, p, t5_table):
    B, T = c_q.shape[:2]
    topk = min(TOPK_MAX, (T - N_META) // 4)
    cq = rms_norm(c_q, p["g_dsa_q"])
    q = (cq @ p["w_dsa_uq"]).reshape(B, T, DSA_H, DSA_KV_LAT) * DSA_KV_LAT ** -0.5
    qi = (cq @ p["w_idx_q"]).reshape(B, T, IDX_H, IDX_D) * IDX_D ** -0.5
    wi = w_idx * IDX_H ** -0.5
    kv = rms_norm(c_kv, p["g_dsa_kv"])
    ki = layer_norm(k_idx, p["idx_ln_g"], p["idx_ln_b"])

    front = (-T) % QBLK
    nblk = (T + front) // QBLK

    def blk(a):
        a = jnp.pad(a, [(0, 0), (front, 0)] + [(0, 0)] * (a.ndim - 2))
        return a.reshape(B, nblk, QBLK, *a.shape[2:]).swapaxes(0, 1)

    qpos = (jnp.arange(T + front, dtype=jnp.int32) - front).reshape(nblk, QBLK)
    kpos = jnp.arange(T, dtype=jnp.int32)

    def attend_block(args):
        qb, qib, wb, pb = args
        score = jnp.einsum("bqh,bqhs->bqs", wb,
                           jax.nn.relu(jnp.einsum("bqhd,bsd->bqhs", qib, ki))).astype(jnp.float32)
        score = jnp.where(kpos[None, None, :] <= pb[None, :, None], score, NEG)
        _, idx = lax.top_k(score, topk)
        kv_sel = jax.vmap(lambda kv_b, i_b: kv_b[i_b])(kv, idx)
        bias = t5_table[t5_bucket(pb[None, :, None] - idx)]
        logits = (jnp.einsum("bqhc,bqkc->bhqk", qb, kv_sel).astype(jnp.float32)
                  + bias.transpose(0, 3, 1, 2).astype(jnp.float32))
        logits = jnp.where((idx <= pb[None, :, None])[:, None], logits, NEG)
        prob = jax.nn.softmax(logits, axis=-1).astype(kv_sel.dtype)
        return jnp.einsum("bhqk,bqkc->bqhc", prob, kv_sel)

    o_lat = lax.map(attend_block, (blk(q), blk(qi), blk(wi), qpos))
    o_lat = o_lat.swapaxes(0, 1).reshape(B, nblk * QBLK, DSA_H, DSA_KV_LAT)[:, front:]
    o = jnp.einsum("bthc,hcd->bthd", o_lat, p["w_dsa_uv"])
    return o.reshape(B, T, DSA_H * DSA_DH)


def mlstm_chunk_step(carry, xs):
    Cs, ns, ms = carry
    q, k, v, li, lf = xs
    C = q.shape[2]
    causal = jnp.tril(jnp.ones((C, C), bool))
    b = jnp.cumsum(lf, axis=-1)
    D = jnp.where(causal, b[..., :, None] - b[..., None, :] + li[..., None, :], -jnp.inf)
    m_inter = b + ms[..., None]
    m = jnp.maximum(m_inter, jnp.max(D, axis=-1))
    w_inter = jnp.exp(m_inter - m)
    P = jnp.exp(D - m[..., None]) * jnp.einsum("bhtk,bhsk->bhts", q, k)
    num = w_inter[..., None] * jnp.einsum("bhtk,bhkv->bhtv", q, Cs) + jnp.einsum("bhts,bhsv->bhtv", P, v)
    den = w_inter * jnp.einsum("bhtk,bhk->bht", q, ns) + jnp.sum(P, axis=-1)
    h = num / jnp.maximum(jnp.abs(den), jnp.exp(-m))[..., None]
    b_last = b[..., -1]
    dec = b_last[..., None] - b + li
    m_new = jnp.maximum(b_last + ms, jnp.max(dec, axis=-1))
    w_old = jnp.exp(b_last + ms - m_new)
    w_new = jnp.exp(dec - m_new[..., None])
    Cs_new = w_old[..., None, None] * Cs + jnp.einsum("bhs,bhsk,bhsv->bhkv", w_new, k, v)
    ns_new = w_old[..., None] * ns + jnp.einsum("bhs,bhsk->bhk", w_new, k)
    return (Cs_new, ns_new, m_new), h


def mlstm_branch(q, k, v, o_pre, i_pre, f_pre, p):
    B, T = q.shape[:2]
    qk = jax.nn.silu(causal_dwconv(jnp.concatenate([q, k], axis=-1), p["ml_conv"]))
    q, k = jnp.split(qk, 2, axis=-1)
    q = q.reshape(B, T, ML_H, ML_DK) * ML_DK ** -0.5
    k = k.reshape(B, T, ML_H, ML_DK)
    v = v.reshape(B, T, ML_H, ML_DV)
    li = i_pre.astype(jnp.float32)
    lf = jax.nn.log_sigmoid(f_pre.astype(jnp.float32) + p["ml_f_bias"].astype(jnp.float32))
    qc, front = to_chunks(q, ML_CHUNK)
    kc, _ = to_chunks(k, ML_CHUNK)
    vc, _ = to_chunks(v, ML_CHUNK)
    lic, _ = to_chunks(li, ML_CHUNK)
    lfc, _ = to_chunks(lf, ML_CHUNK)
    init = (jnp.zeros((B, ML_H, ML_DK, ML_DV), jnp.float32),
            jnp.zeros((B, ML_H, ML_DK), jnp.float32),
            jnp.zeros((B, ML_H), jnp.float32))
    _, hc = lax.scan(mlstm_chunk_step, init, (qc, kc, vc, lic, lfc))
    h = from_chunks(hc, front)
    h = rms_norm(h, p["g_ml_head"]) * jax.nn.sigmoid(o_pre).reshape(B, T, ML_H, ML_DV)
    return h.reshape(B, T, ML_H * ML_DV).astype(v.dtype)


def hybrid_layer(h, p, t5_table):
    xn = rms_norm(h, p["g_pre_mix"])
    z = xn @ p["w_in"] + p["b_in"]
    (gla_q, gla_k, gla_v, gla_r, gla_a, dsa_cq, dsa_ckv, idx_k, idx_w,
     ml_q, ml_k, ml_v, ml_o, ml_i, ml_f, gate_a, gate_b, gate_c) = jnp.split(
        z, np.cumsum(COL_SPLITS)[:-1].tolist(), axis=-1)
    y_a = gla_branch(gla_q, gla_k, gla_v, gla_r, gla_a, p) @ p["w_br_gla"]
    y_b = dsa_branch(dsa_cq, dsa_ckv, idx_k, idx_w, p, t5_table) @ p["w_br_dsa"]
    y_c = mlstm_branch(ml_q, ml_k, ml_v, ml_o, ml_i, ml_f, p) @ p["w_br_ml"]
    mix = jax.nn.sigmoid(gate_a) * y_a + jax.nn.sigmoid(gate_b) * y_b + jax.nn.sigmoid(gate_c) * y_c
    h = h + rms_norm(mix @ p["w_out"], p["g_post_mix"])
    xn = rms_norm(h, p["g_pre_mlp"])
    u = jnp.square(jax.nn.relu(xn @ p["w_up"]))
    return h + rms_norm(u @ p["w_down"], p["g_post_mlp"])


def setup_inputs(seed: int = 0) -> dict:
    key = jax.random.key(seed)
    ks = jax.random.split(key, 32)
    f32 = jnp.float32
    L = DEPTH

    def nrm(k, shape, scale):
        return scale * jax.random.normal(k, shape, f32)

    def gain(k, shape):
        return 1.0 + 0.05 * jax.random.normal(k, shape, f32)

    return {
        "x": nrm(ks[0], (BATCH, SEQ, D_MODEL), 1.0),
        "meta_tokens": nrm(ks[1], (N_META, D_MODEL), 1.0),
        "t5_bias": nrm(ks[2], (T5_BUCKETS, DSA_H), 0.5),
        "g_pre_mix": gain(ks[3], (L, D_MODEL)),
        "w_in": nrm(ks[4], (L, D_MODEL, N_COLS), D_MODEL ** -0.5),
        "b_in": nrm(ks[5], (L, N_COLS), 0.01),
        "w_gla_a2": nrm(ks[6], (L, GLA_LR, GLA_H * GLA_DK), GLA_LR ** -0.5),
        "b_gla_a": nrm(ks[7], (L, GLA_H * GLA_DK), 0.1),
        "g_gla_head": gain(ks[8], (L, GLA_DV)),
        "w_br_gla": nrm(ks[9], (L, GLA_H * GLA_DV, D_MODEL), (GLA_H * GLA_DV) ** -0.5),
        "g_dsa_q": gain(ks[10], (L, DSA_Q_LORA)),
        "w_dsa_uq": nrm(ks[11], (L, DSA_Q_LORA, DSA_H * DSA_KV_LAT), DSA_Q_LORA ** -0.5),
        "w_idx_q": nrm(ks[12], (L, DSA_Q_LORA, IDX_H * IDX_D), DSA_Q_LORA ** -0.5),
        "g_dsa_kv": gain(ks[13], (L, DSA_KV_LAT)),
        "w_dsa_uv": nrm(ks[14], (L, DSA_H, DSA_KV_LAT, DSA_DH), DSA_KV_LAT ** -0.5),
        "idx_ln_g": gain(ks[15], (L, IDX_D)),
        "idx_ln_b": nrm(ks[16], (L, IDX_D), 0.01),
        "w_br_dsa": nrm(ks[17], (L, DSA_H * DSA_DH, D_MODEL), (DSA_H * DSA_DH) ** -0.5),
        "ml_conv": nrm(ks[18], (L, ML_CONV, 2 * ML_H * ML_DK), ML_CONV ** -0.5),
        "ml_f_bias": jnp.linspace(3.0, 6.0, ML_H, dtype=f32)[None, :] + nrm(ks[19], (L, ML_H), 0.1),
        "g_ml_head": gain(ks[20], (L, ML_DV)),
        "w_br_ml": nrm(ks[21], (L, ML_H * ML_DV, D_MODEL), (ML_H * ML_DV) ** -0.5),
        "w_out": nrm(ks[22], (L, D_MODEL, D_MODEL), D_MODEL ** -0.5),
        "g_post_mix": gain(ks[23], (L, D_MODEL)),
        "g_pre_mlp": gain(ks[24], (L, D_MODEL)),
        "w_up": nrm(ks[25], (L, D_MODEL, D_FF), D_MODEL ** -0.5),
        "w_down": nrm(ks[26], (L, D_FF, D_MODEL), D_FF ** -0.5),
        "g_post_mlp": gain(ks[27], (L, D_MODEL)),
    }


def reference(x, meta_tokens, t5_bias, g_pre_mix, w_in, b_in, w_gla_a2, b_gla_a, g_gla_head,
              w_br_gla, g_dsa_q, w_dsa_uq, w_idx_q, g_dsa_kv, w_dsa_uv, idx_ln_g, idx_ln_b,
              w_br_dsa, ml_conv, ml_f_bias, g_ml_head, w_br_ml, w_out, g_post_mix, g_pre_mlp,
              w_up, w_down, g_post_mlp):
    B = x.shape[0]
    meta = jnp.broadcast_to(meta_tokens.astype(x.dtype)[None], (B, N_META, x.shape[-1]))
    h = jnp.concatenate([meta, x], axis=1)
    for l in range(DEPTH):
        p = {
            "g_pre_mix": g_pre_mix[l], "w_in": w_in[l], "b_in": b_in[l],
            "w_gla_a2": w_gla_a2[l], "b_gla_a": b_gla_a[l], "g_gla_head": g_gla_head[l],
            "w_br_gla": w_br_gla[l],
            "g_dsa_q": g_dsa_q[l], "w_dsa_uq": w_dsa_uq[l], "w_idx_q": w_idx_q[l],
            "g_dsa_kv": g_dsa_kv[l], "w_dsa_uv": w_dsa_uv[l], "idx_ln_g": idx_ln_g[l],
            "idx_ln_b": idx_ln_b[l], "w_br_dsa": w_br_dsa[l],
            "ml_conv": ml_conv[l], "ml_f_bias": ml_f_bias[l], "g_ml_head": g_ml_head[l],
            "w_br_ml": w_br_ml[l],
            "w_out": w_out[l], "g_post_mix": g_post_mix[l], "g_pre_mlp": g_pre_mlp[l],
            "w_up": w_up[l], "w_down": w_down[l], "g_post_mlp": g_post_mlp[l],
        }
        h = hybrid_layer(h, p, t5_bias)
    return h[:, N_META:]
```

```cpp
#include <hip/hip_runtime.h>
#include <cstdio>
#include <cstdint>
namespace pg8 {
#define PG8_LAS __attribute__((address_space(3)))
typedef unsigned short bf16_t;
typedef short bf16x8 __attribute__((ext_vector_type(8)));
typedef float f32x4 __attribute__((ext_vector_type(4)));
typedef unsigned u32x4 __attribute__((ext_vector_type(4)));
constexpr int BM = 256, BK = 64, HALF = 128, HTB = HALF * BK * 2  , STAGE_BYTES = 8 * HTB, NXCD = 8, WGM = 8;

__host__ __device__ __forceinline__ int lds_byte(int r, int c) { const int st = (r >> 4) * 2 + (c >> 5), rr = r & 15, cc = c & 31, ob = rr * 64 + cc * 2; return st * 1024 + (ob ^ (((ob >> 9) & 1) << 5)); }
__host__ __device__ __forceinline__ void stage_rc(int b, int& R, int& C) { const int st = b / 1024, sb = b % 1024, swz = sb ^ (((sb >> 9) & 1) << 5); R = (st >> 1) * 16 + swz / 64; C = (st & 1) * 32 + (swz % 64) / 2; }
__host__ __device__ __forceinline__ int perm32(int rho) { const int n = rho >> 4, i = rho & 15; return 8 * (i >> 2) + 4 * n + (i & 3); }

struct Unit { int pm, pn; };
struct Gemm { const bf16_t* A; const bf16_t* Bt; int M, N, K; };

struct StaticOrder {
    int nM, nN, nwg, G, c;
    __host__ __device__ void init(int M, int N, int G_, int c_) { nM = M / BM; nN = N / BM; nwg = nM * nN; G = G_; c = c_; }
    __host__ __device__ bool next(int i, Unit& u) const {
        const long L = (long)i * G + c; if (L >= nwg) return false;
        int wgid = (int)L; { const int q = nwg / NXCD, r = nwg % NXCD, xcd = wgid % NXCD, off = wgid / NXCD; wgid = (xcd < r ? xcd * (q + 1) : r * (q + 1) + (xcd - r) * q) + off; }
        const int nig = WGM * nN, gid = wgid / nig, fm = gid * WGM, gsz = (nM - fm) < WGM ? (nM - fm) : WGM;
        u.pm = fm + ((wgid % nig) % gsz); u.pn = (wgid % nig) / gsz; return true;
    }
    __device__ __forceinline__ void a_ready(const Unit&) const {}
    __device__ __forceinline__ void done(const Unit&) const {}
};

__device__ __forceinline__ unsigned cvt_pk_bf16(float lo, float hi) { unsigned r; asm volatile("v_cvt_pk_bf16_f32 %0, %1, %2" : "=v"(r) : "v"(lo), "v"(hi)); return r; }
template <class Epi, class Sched, bool ALIGN_EPI = false, bool SP2 = false>
__device__ __forceinline__ void gemm_phase(PG8_LAS unsigned char* lds, const Gemm g, const Sched& S, const Epi& E) {
    int tid_ = threadIdx.x; asm volatile("" : "+v"(tid_));
    const int tid = tid_, wid = __builtin_amdgcn_readfirstlane(tid >> 6), lane = tid & 63, wr = wid >> 2, wc = wid & 3, fr = lane & 15, fq = lane >> 4;
    const int K = g.K, nt = K / BK;
    unsigned voffA[2], voffB[2];
#pragma unroll
    for (int i = 0; i < 2; ++i) { int R, C; stage_rc(tid * 16 + i * 8192, R, C); const int Rb = Epi::PERM ? ((R & ~31) + perm32(R & 31)) : R;
        voffA[i] = (unsigned)(R * K + C) * 2u; voffB[i] = (unsigned)(Rb * K + C) * 2u; }
    const size_t kstep = (size_t)(BK * 2);
    const size_t hstep = (size_t)HALF * K * 2;
    const size_t tstep = 2 * hstep;
    const unsigned ldsw = (unsigned)wid * 1024u;
    const int aoff = lds_byte(wr * 64 + fr, fq * 8), boff = lds_byte(wc * 32 + fr, fq * 8);
#define PG8_SA(b, h) (((b) * 2 + (h)) * HTB)
#define PG8_SB(b, h) ((4 + (b) * 2 + (h)) * HTB)
#define PG8_STAGE(bufoff, gbase, voff) do { _Pragma("unroll") for (int _i = 0; _i < 2; ++_i) \
        __builtin_amdgcn_global_load_lds((const unsigned*)((const char*)(gbase) + (voff)[_i]), (PG8_LAS unsigned*)(lds + (bufoff) + ldsw + _i * 8192), 16, 0, 0); } while (0)
#define PG8_LDA(dst, b, h) do { _Pragma("unroll") for (int m = 0; m < 4; ++m) _Pragma("unroll") for (int k = 0; k < 2; ++k) dst[m][k] = *(const PG8_LAS bf16x8*)(lds + PG8_SA(b, h) + aoff + m * 2048 + k * 1024); } while (0)
#define PG8_LDB(dst, b, h) do { _Pragma("unroll") for (int n = 0; n < 2; ++n) _Pragma("unroll") for (int k = 0; k < 2; ++k) dst[n][k] = *(const PG8_LAS bf16x8*)(lds + PG8_SB(b, h) + boff + n * 2048 + k * 1024); } while (0)
#define PG8_MMA(ai, bj, At, Bt) do { __builtin_amdgcn_s_setprio(1); _Pragma("unroll") for (int m = 0; m < 4; ++m) _Pragma("unroll") for (int n = 0; n < 2; ++n) _Pragma("unroll") for (int k = 0; k < 2; ++k) \
        acc[ai][bj][m][n] = __builtin_amdgcn_mfma_f32_16x16x32_bf16(Bt[n][k], At[m][k], acc[ai][bj][m][n], 0, 0, 0); __builtin_amdgcn_s_setprio(0); } while (0)
#define PG8_WAIT_V(n) asm volatile("s_waitcnt vmcnt(" #n ")" ::: "memory")
#define PG8_WAIT_L(n) asm volatile("s_waitcnt lgkmcnt(" #n ")" ::: "memory")
#define PG8_BAR __builtin_amdgcn_s_barrier()
#define PG8_SCHED __builtin_amdgcn_sched_barrier(0)
    Unit cur, nxt; int ui = 0;
    if (!S.next(0, cur)) return;
    f32x4 acc[2][2][4][2];
#pragma unroll
    for (int a = 0; a < 2; ++a)
#pragma unroll
        for (int b = 0; b < 2; ++b)
#pragma unroll
            for (int m = 0; m < 4; ++m)
#pragma unroll
                for (int n = 0; n < 2; ++n) acc[a][b][m][n] = (f32x4){0.f, 0.f, 0.f, 0.f};
    bf16x8 At[4][2], B0[2][2], B1[2][2];
    const char* cA = (const char*)g.A + (size_t)cur.pm * tstep; const char* cB = (const char*)g.Bt + (size_t)cur.pn * tstep;
    S.a_ready(cur);
    if constexpr (SP2) {
        PG8_STAGE(PG8_SB(0, 0), cB, voffB); PG8_STAGE(PG8_SB(0, 1), cB + hstep, voffB); PG8_STAGE(PG8_SA(0, 0), cA, voffA); PG8_STAGE(PG8_SA(0, 1), cA + hstep, voffA);
        if (wr == 1) PG8_BAR;
        PG8_WAIT_V(2); PG8_BAR;
        PG8_STAGE(PG8_SB(1, 0), cB + kstep, voffB); PG8_STAGE(PG8_SA(1, 0), cA + kstep, voffA); PG8_STAGE(PG8_SB(1, 1), cB + hstep + kstep, voffB);
        PG8_WAIT_V(6); PG8_BAR;
    } else {
        PG8_STAGE(PG8_SB(0, 0), cB, voffB); PG8_STAGE(PG8_SA(0, 0), cA, voffA); PG8_STAGE(PG8_SB(0, 1), cB + hstep, voffB); PG8_STAGE(PG8_SA(0, 1), cA + hstep, voffA);
        if (wr == 1) PG8_BAR;
        PG8_WAIT_V(4); PG8_BAR;
        PG8_STAGE(PG8_SB(1, 0), cB + kstep, voffB); PG8_STAGE(PG8_SA(1, 0), cA + kstep, voffA); PG8_STAGE(PG8_SB(1, 1), cB + hstep + kstep, voffB);
        PG8_WAIT_V(6); PG8_BAR;
    }
    for (;;) {
        const bool has_next = S.next(ui + 1, nxt);
        const char* nA = has_next ? (const char*)g.A + (size_t)nxt.pm * tstep : cA; const char* nB = has_next ? (const char*)g.Bt + (size_t)nxt.pn * tstep : cB;
        for (int t = 0; t < nt; t += 2) {
            const bool last = (t == nt - 2);
            const char* a1 = cA + (size_t)(t + 1) * kstep;
            const char* a2 = last ? nA : cA + (size_t)(t + 2) * kstep; const char* b2 = last ? nB : cB + (size_t)(t + 2) * kstep;
            const char* a3 = a2 + kstep; const char* b3 = b2 + kstep;
            if (last && has_next) S.a_ready(nxt);
            if constexpr (SP2) {
            PG8_LDB(B0, 0, 0); PG8_LDB(B1, 0, 1); PG8_SCHED; PG8_LDA(At, 0, 0); PG8_STAGE(PG8_SA(1, 1), a1 + hstep, voffA);
            PG8_WAIT_V(8); PG8_WAIT_L(0); PG8_BAR; PG8_MMA(0, 0, At, B0); PG8_MMA(0, 1, At, B1); PG8_BAR; PG8_SCHED;
            PG8_LDA(At, 0, 1); PG8_STAGE(PG8_SB(0, 0), b2, voffB); PG8_STAGE(PG8_SB(0, 1), b2 + hstep, voffB); PG8_STAGE(PG8_SA(0, 0), a2, voffA);
            PG8_WAIT_V(8); PG8_WAIT_L(0); PG8_BAR; PG8_MMA(1, 0, At, B0); PG8_MMA(1, 1, At, B1); PG8_BAR; PG8_SCHED;
            PG8_LDB(B0, 1, 0); PG8_LDB(B1, 1, 1); PG8_SCHED; PG8_LDA(At, 1, 0); PG8_STAGE(PG8_SA(0, 1), a2 + hstep, voffA);
            PG8_WAIT_V(8); PG8_WAIT_L(0); PG8_BAR; PG8_MMA(0, 0, At, B0); PG8_MMA(0, 1, At, B1); PG8_BAR; PG8_SCHED;
            PG8_LDA(At, 1, 1); PG8_STAGE(PG8_SB(1, 0), b3, voffB); PG8_STAGE(PG8_SB(1, 1), b3 + hstep, voffB); PG8_STAGE(PG8_SA(1, 0), a3, voffA);
            PG8_WAIT_V(8); PG8_WAIT_L(0); PG8_BAR; PG8_MMA(1, 0, At, B0); PG8_MMA(1, 1, At, B1); PG8_BAR; PG8_SCHED;
            } else {
            PG8_LDB(B0, 0, 0); PG8_SCHED; PG8_LDA(At, 0, 0); PG8_STAGE(PG8_SA(1, 1), a1 + hstep, voffA);
            PG8_WAIT_L(8); PG8_BAR; PG8_WAIT_L(0); PG8_MMA(0, 0, At, B0); PG8_BAR; PG8_SCHED;
            PG8_LDB(B1, 0, 1); PG8_STAGE(PG8_SB(0, 0), b2, voffB);
            PG8_BAR; PG8_WAIT_L(0); PG8_MMA(0, 1, At, B1); PG8_BAR;
            PG8_LDA(At, 0, 1); PG8_STAGE(PG8_SA(0, 0), a2, voffA);
            PG8_BAR; PG8_WAIT_L(0); PG8_MMA(1, 0, At, B0); PG8_BAR; PG8_SCHED;
            PG8_STAGE(PG8_SB(0, 1), b2 + hstep, voffB);
            PG8_WAIT_V(6); PG8_BAR; PG8_MMA(1, 1, At, B1); PG8_BAR;
            PG8_LDB(B0, 1, 0); PG8_SCHED; PG8_LDA(At, 1, 0); PG8_STAGE(PG8_SA(0, 1), a2 + hstep, voffA);
            PG8_WAIT_L(8); PG8_BAR; PG8_WAIT_L(0); PG8_MMA(0, 0, At, B0); PG8_BAR; PG8_SCHED;
            PG8_LDB(B1, 1, 1); PG8_STAGE(PG8_SB(1, 0), b3, voffB);
            PG8_BAR; PG8_WAIT_L(0); PG8_MMA(0, 1, At, B1); PG8_BAR;
            PG8_LDA(At, 1, 1); PG8_STAGE(PG8_SA(1, 0), a3, voffA);
            PG8_BAR; PG8_WAIT_L(0); PG8_MMA(1, 0, At, B0); PG8_BAR; PG8_SCHED;
            PG8_STAGE(PG8_SB(1, 1), b3 + hstep, voffB);
            PG8_WAIT_V(6); PG8_BAR; PG8_MMA(1, 1, At, B1); PG8_BAR;
            }
        }
        if constexpr (ALIGN_EPI) { if (wr == 0) PG8_BAR; }
        if constexpr (!Epi::AFTER_DRAIN) { E(acc, cur, wr, wc, fr, fq); S.done(cur); }
        if (!has_next) break;
#pragma unroll
        for (int a = 0; a < 2; ++a)
#pragma unroll
            for (int b = 0; b < 2; ++b)
#pragma unroll
                for (int m = 0; m < 4; ++m)
#pragma unroll
                    for (int n = 0; n < 2; ++n) acc[a][b][m][n] = (f32x4){0.f, 0.f, 0.f, 0.f};
        cur = nxt; cA = nA; cB = nB; ++ui;
        if constexpr (ALIGN_EPI) { if (wr == 1) PG8_BAR; }
    }
    PG8_WAIT_V(0);
    if constexpr (!ALIGN_EPI) { if (wr == 0) PG8_BAR; }
    PG8_BAR;
    if constexpr (Epi::AFTER_DRAIN) { E.fused(acc, cur, wr, wc, fr, fq, lds, wid, lane); S.done(cur); }
#undef PG8_SA
#undef PG8_SB
#undef PG8_STAGE
#undef PG8_LDA
#undef PG8_LDB
#undef PG8_MMA
#undef PG8_WAIT_V
#undef PG8_WAIT_L
#undef PG8_BAR
#undef PG8_SCHED
}
}

constexpr int NB = 32, SEQ = 2048, NMETA = 16, TT = SEQ + NMETA, D = 1024, NL = 4, DFF = 4096;
constexpr int NG = 4, GB = NB / NG, MR = GB * SEQ  , MT = MR + NMETA  ;
constexpr int NCOLS = 9696, NZ = 9728, ZB = 9216, ZFW = 512;
constexpr float EPS = 1e-6f;
constexpr int ZC_GQ = 0, ZC_GK = 512, ZC_GV = 1024, ZC_GR = 2048, ZC_MQ = 3072, ZC_MK = 3584, ZC_MV = 4096, ZC_MO = 5120, ZC_GATE = 6144;
constexpr int ZF_CQ = 0, ZF_CKV = 256, ZF_IK = 384, ZF_A = 448, ZF_IW = 464, ZF_MI = 472, ZF_MF = 476;
constexpr int NQQ = 2560;

constexpr size_t MiB = 1u << 20;
constexpr size_t WS_CTL = 0, CTL_ZERO_BYTES = 1 * MiB;
constexpr size_t WS_BIN = 1 * MiB;
constexpr size_t WS_WIN = 2 * MiB;
constexpr size_t WS_WQQ = 78 * MiB;
constexpr size_t WS_WBG = 83 * MiB;
constexpr size_t WS_WBM = 91 * MiB;
constexpr size_t WS_WBD = 99 * MiB;
constexpr size_t WS_WOUT = 115 * MiB;
constexpr size_t WS_WUP = 123 * MiB;
constexpr size_t WS_WDN = 155 * MiB;
constexpr size_t WS_HM = 187 * MiB;
constexpr size_t WS_XN = 188 * MiB;
constexpr size_t WS_ZF = 221 * MiB;
constexpr size_t WS_CQN = 254 * MiB;
constexpr size_t WS_KV = 263 * MiB;
constexpr size_t WS_KI = 268 * MiB;
constexpr size_t WS_WI = 271 * MiB;
constexpr size_t WS_LIF = 272 * MiB;
constexpr size_t WS_G = 273 * MiB;
constexpr size_t WS_QKC = 306 * MiB;
constexpr size_t WS_QQ = 339 * MiB;
constexpr size_t WS_OG = 420 * MiB;
constexpr size_t WS_OM = 453 * MiB;
constexpr size_t WS_OD = 486 * MiB;
constexpr size_t WS_MIX = 551 * MiB;
constexpr size_t WS_Y = 584 * MiB;
constexpr size_t WS_Z = 649 * MiB;
constexpr size_t WS_END = 938 * MiB;
static_assert(WS_Z + (size_t)MT * ZB * 2 <= WS_END, "ws map");

constexpr int CW_BAR = 4096;

constexpr int RING_BYTES = 131072;
constexpr int MISC_OFF = RING_BYTES + 320;
constexpr int LDS_BYTES = 147456;
constexpr int NWAVES = 8;

#define LAS __attribute__((address_space(3)))
typedef unsigned short bf16;
typedef float f32x4 __attribute__((ext_vector_type(4)));
typedef float f32x2 __attribute__((ext_vector_type(2)));
typedef unsigned u32x4 __attribute__((ext_vector_type(4)));
typedef unsigned u32x2 __attribute__((ext_vector_type(2)));
typedef short bf16x8 __attribute__((ext_vector_type(8)));
#define LDS_WAIT() asm volatile("s_waitcnt lgkmcnt(0)" ::: "memory")
#define VM_WAIT() asm volatile("s_waitcnt vmcnt(0)" ::: "memory")

__device__ __forceinline__ unsigned f2bf(float f) { unsigned u = __builtin_bit_cast(unsigned, f); return (u + 0x7fffu + ((u >> 16) & 1u)) >> 16; }
__device__ __forceinline__ unsigned pk2(float lo, float hi) { return f2bf(lo) | (f2bf(hi) << 16); }
__device__ __forceinline__ float bf2f(unsigned b) { return __builtin_bit_cast(float, b << 16); }
__device__ __forceinline__ float bflo(unsigned w) { return __builtin_bit_cast(float, w << 16); }
__device__ __forceinline__ float bfhi(unsigned w) { return __builtin_bit_cast(float, w & 0xffff0000u); }
__device__ __forceinline__ float wave_sum(float v) {
#pragma unroll
    for (int o = 1; o < 64; o <<= 1) v += __shfl_xor(v, o);
    return v;
}
__device__ __forceinline__ float wave_max(float v) {
#pragma unroll
    for (int o = 1; o < 64; o <<= 1) v = fmaxf(v, __shfl_xor(v, o));
    return v;
}
__device__ __forceinline__ float sigmoid_f(float x) { return 1.f / (1.f + __expf(-x)); }
__device__ __forceinline__ float silu_f(float x) { return x * sigmoid_f(x); }
__device__ __forceinline__ float logsigmoid_f(float x) { return fminf(x, 0.f) - log1pf(__expf(-fabsf(x))); }

#define XB_TMO      128
#define XB_XCNT(j)  (256  + 64 * (j))
#define XB_XSUB(j)  (1280 + 64 * (j))
#define XB_XGEN(j)  (2304 + 64 * (j))
#define XB_TOP      3328
#define XB_TOPGEN   3392
#define XCD_BAR_WORDS 3456
#define XB_SPIN_CAP (1u << 22)

__device__ __forceinline__ unsigned xb_ld(unsigned* p)              { return __hip_atomic_load(p, __ATOMIC_RELAXED, __HIP_MEMORY_SCOPE_AGENT); }
__device__ __forceinline__ unsigned xb_add(unsigned* p, unsigned v) { return __hip_atomic_fetch_add(p, v, __ATOMIC_RELAXED, __HIP_MEMORY_SCOPE_AGENT); }
__device__ __forceinline__ unsigned xb_xcc_id() { return (unsigned)__builtin_amdgcn_s_getreg((3 << 11) | 20) & 0xFu; }
#define XB_SPIN(cond, bar) do { unsigned _sp = 0; while (cond) { __builtin_amdgcn_s_sleep(1); \
    if ((++_sp & 255u) == 0u) { if (xb_ld(&(bar)[XB_TMO])) break; if (_sp > XB_SPIN_CAP) { atomicAdd(&(bar)[XB_TMO], 1u); break; } } } } while (0)

struct XcdBarrier {
    unsigned* bar; unsigned x;
    volatile LAS unsigned* st;
};

__device__ __forceinline__ XcdBarrier xcd_barrier_post(unsigned* bar, volatile LAS unsigned* st) {
    XcdBarrier b; b.bar = bar; b.x = xb_xcc_id(); b.st = st;
    if (threadIdx.x == 0) (void)xb_add(&bar[XB_XCNT(b.x)], 1u);
    return b;
}
__device__ __forceinline__ void xcd_barrier_complete(unsigned* bar, unsigned x, unsigned& nloc, unsigned& nx) {
    const unsigned G = gridDim.x * gridDim.y * gridDim.z;
    unsigned sum, cnt, mine, sp = 0u;
    for (;;) {
        sum = 0u; cnt = 0u; mine = 0u;
#pragma unroll
        for (unsigned j = 0; j < 16; ++j) { const unsigned c = xb_ld(&bar[XB_XCNT(j)]); sum += c; cnt += (c > 0u) ? 1u : 0u; mine = (j == x) ? c : mine; }
        if (sum == G) break;
        __builtin_amdgcn_s_sleep(1);
        if ((++sp & 255u) == 0u) { if (xb_ld(&bar[XB_TMO])) break; if (sp > XB_SPIN_CAP) { atomicAdd(&bar[XB_TMO], 1u); break; } }
    }
    nloc = mine > 0u ? mine : 1u; nx = cnt > 0u ? cnt : 1u;
}

__device__ __forceinline__ void xcd_barrier(const XcdBarrier& b) {
    asm volatile("s_waitcnt vmcnt(0)" ::: "memory");
    __syncthreads();
    if (threadIdx.x == 0) {
        unsigned* bar = b.bar;
        __builtin_amdgcn_s_waitcnt(0);
        unsigned nloc = b.st[0], nx = b.st[1];
        if (nloc == 0u) { xcd_barrier_complete(bar, b.x, nloc, nx); b.st[0] = nloc; b.st[1] = nx; }
        const unsigned old = xb_add(&bar[XB_XSUB(b.x)], 1u);
        const unsigned gen = old / nloc;
        if (old + 1u == (gen + 1u) * nloc) {
            __builtin_amdgcn_fence(__ATOMIC_RELEASE, "agent");
            asm volatile("s_waitcnt vmcnt(0)" ::: "memory");
            const unsigned og = xb_add(&bar[XB_TOP], 1u);
            const unsigned tg = og / nx;
            if (og + 1u == (tg + 1u) * nx) xb_add(&bar[XB_TOPGEN], 1u);
            else XB_SPIN(xb_ld(&bar[XB_TOPGEN]) == tg, bar);
            __builtin_amdgcn_fence(__ATOMIC_ACQUIRE, "agent");
            xb_add(&bar[XB_XGEN(b.x)], 1u);
            asm volatile("s_waitcnt vmcnt(0)" ::: "memory");
        } else {
            XB_SPIN(xb_ld(&bar[XB_XGEN(b.x)]) == gen, bar);
            __builtin_amdgcn_fence(__ATOMIC_ACQUIRE, "agent");
            asm volatile("s_waitcnt vmcnt(0)" ::: "memory");
        }
    }
    __syncthreads();
}


struct Args { const float* in[28]; float* out; unsigned char* ws; int g_lo, g_hi, l_lo, l_hi, ph_lo, ph_hi, prep, use_bar; };
typedef const __attribute__((address_space(4))) Args* ArgsP;
enum { I_X = 0, I_META, I_T5, I_GPREMIX, I_WIN, I_BIN, I_WA2, I_BA, I_GGLA, I_WBRG, I_GDQ, I_WUQ, I_WIQ, I_GDKV, I_WUV, I_LNG, I_LNB, I_WBRD,
       I_CONV, I_FB, I_GML, I_WBRM, I_WOUT, I_GPOSTMIX, I_GPREMLP, I_WUP, I_WDN, I_GPOSTMLP };

__device__ __forceinline__ int win_src(int n) {
    if (n < 3072) return n;
    if (n < 6144) return n - 3072 + 3544;
    if (n < 9216) return n - 6144 + 6624;
    if (n < 9472) return n - 9216 + 3088;
    if (n < 9600) return n - 9472 + 3344;
    if (n < 9664) return n - 9600 + 3472;
    if (n < 9680) return n - 9664 + 3072;
    if (n < 9688) return n - 9680 + 3536;
    if (n < 9692) return n - 9688 + 6616;
    if (n < 9696) return n - 9692 + 6620;
    return -1;
}
struct CmIdent { __device__ __forceinline__ int operator()(int n) const { return n; } };
struct CmWin { __device__ __forceinline__ int operator()(int n) const { return win_src(n); } };

template <class CM>
__device__ __forceinline__ void tr_item(const float* __restrict__ W, int ldw, bf16* __restrict__ WT, int Kd, LAS float* scr, int k0, int ns0, int nd0, int lane, CM cm) {
    const int sc = cm(ns0 + (lane & 31));
#pragma unroll 8
    for (int i = 0; i < 32; ++i) { const int kk = 2 * i + (lane >> 5); scr[kk * 33 + (lane & 31)] = sc >= 0 ? W[(size_t)(k0 + kk) * ldw + sc] : 0.f; }
    LDS_WAIT();
    const int c = lane & 7;
#pragma unroll
    for (int j = 0; j < 4; ++j) { const int n = (lane >> 3) + 8 * j; const LAS float* s = scr + (8 * c) * 33 + n;
        u32x4 o; o.x = pk2(s[0 * 33], s[1 * 33]); o.y = pk2(s[2 * 33], s[3 * 33]); o.z = pk2(s[4 * 33], s[5 * 33]); o.w = pk2(s[6 * 33], s[7 * 33]);
        *(u32x4*)(WT + (size_t)(nd0 + n) * Kd + k0 + 8 * c) = o; }
    LDS_WAIT();
}

__device__ __forceinline__ void prep_weights(ArgsP a, LAS unsigned char* lds, int gw, int ngw, int wave, int lane) {
    LAS float* scr = (LAS float*)(lds + wave * 16384);
    unsigned char* ws = a->ws;
    constexpr int I_WIN_N = 16 * 304, I_UQ = 4 * 64, I_IQ = 4 * 16, I_SQ = 16 * 32, I_UP = 16 * 128, I_DN = 64 * 32, I_WBD = 512, I_B = NZ / 64;
    constexpr int PER_L = I_WIN_N + I_UQ + I_IQ + 3 * I_SQ + I_UP + I_DN + I_WBD + I_B;
    for (int it = gw; it < NL * PER_L; it += ngw) {
        const int l = it / PER_L; int r = it % PER_L;
        if (r < I_WIN_N) { const int kb = r / 304, nb = r % 304;
            tr_item(a->in[I_WIN] + (size_t)l * D * NCOLS, NCOLS, (bf16*)(ws + WS_WIN) + (size_t)l * NZ * D, D, scr, kb * 64, nb * 32, nb * 32, lane, CmWin()); continue; }
        r -= I_WIN_N;
        if (r < I_UQ) { const int kb = r / 64, nb = r % 64;
            tr_item(a->in[I_WUQ] + (size_t)l * 256 * 2048, 2048, (bf16*)(ws + WS_WQQ) + (size_t)l * NQQ * 256, 256, scr, kb * 64, nb * 32, nb * 32, lane, CmIdent()); continue; }
        r -= I_UQ;
        if (r < I_IQ) { const int kb = r / 16, nb = r % 16;
            tr_item(a->in[I_WIQ] + (size_t)l * 256 * 512, 512, (bf16*)(ws + WS_WQQ) + (size_t)l * NQQ * 256, 256, scr, kb * 64, nb * 32, 2048 + nb * 32, lane, CmIdent()); continue; }
        r -= I_IQ;
        if (r < I_SQ) { const int kb = r / 32, nb = r % 32;
            tr_item(a->in[I_WBRG] + (size_t)l * D * D, D, (bf16*)(ws + WS_WBG) + (size_t)l * D * D, D, scr, kb * 64, nb * 32, nb * 32, lane, CmIdent()); continue; }
        r -= I_SQ;
        if (r < I_SQ) { const int kb = r / 32, nb = r % 32;
            tr_item(a->in[I_WBRM] + (size_t)l * D * D, D, (bf16*)(ws + WS_WBM) + (size_t)l * D * D, D, scr, kb * 64, nb * 32, nb * 32, lane, CmIdent()); continue; }
        r -= I_SQ;
        if (r < I_SQ) { const int kb = r / 32, nb = r % 32;
            tr_item(a->in[I_WOUT] + (size_t)l * D * D, D, (bf16*)(ws + WS_WOUT) + (size_t)l * D * D, D, scr, kb * 64, nb * 32, nb * 32, lane, CmIdent()); continue; }
        r -= I_SQ;
        if (r < I_UP) { const int kb = r / 128, nb = r % 128;
            tr_item(a->in[I_WUP] + (size_t)l * D * DFF, DFF, (bf16*)(ws + WS_WUP) + (size_t)l * DFF * D, D, scr, kb * 64, nb * 32, nb * 32, lane, CmIdent()); continue; }
        r -= I_UP;
        if (r < I_DN) { const int kb = r / 32, nb = r % 32;
            tr_item(a->in[I_WDN] + (size_t)l * DFF * D, D, (bf16*)(ws + WS_WDN) + (size_t)l * D * DFF, DFF, scr, kb * 64, nb * 32, nb * 32, lane, CmIdent()); continue; }
        r -= I_DN;
        if (r < I_WBD) {
            const int h = r >> 5, ch = (r >> 4) & 1, nb = r & 15, c = ch * 64 + lane;
            const float* uv = a->in[I_WUV] + ((size_t)(l * 16 + h) * 128 + c) * 64;
            const float* wb = a->in[I_WBRD] + ((size_t)l * D + h * 64) * D + nb * 64;
            bf16* o = (bf16*)(ws + WS_WBD) + (size_t)l * D * 2048 + (size_t)(nb * 64) * 2048 + h * 128 + c;
            f32x4 w[16];
#pragma unroll
            for (int i = 0; i < 16; ++i) w[i] = *(const f32x4*)(uv + 4 * i);
            for (int nn = 0; nn < 64; ++nn) {
                float acc = 0.f;
#pragma unroll
                for (int i = 0; i < 16; ++i) { acc += w[i].x * wb[(size_t)(4 * i + 0) * D + nn] + w[i].y * wb[(size_t)(4 * i + 1) * D + nn] + w[i].z * wb[(size_t)(4 * i + 2) * D + nn] + w[i].w * wb[(size_t)(4 * i + 3) * D + nn]; }
                o[(size_t)nn * 2048] = (bf16)f2bf(acc);
            }
            continue; }
        r -= I_WBD;
        { const int n = r * 64 + lane; const int sc = win_src(n);
          ((float*)(ws + WS_BIN))[l * NZ + n] = sc >= 0 ? a->in[I_BIN][l * NCOLS + sc] : 0.f; }
    }
}

__device__ __forceinline__ float* hrow(ArgsP a, int g, int r) {
    return r < MR ? a->out + ((size_t)g * MR + r) * D : (float*)(a->ws + WS_HM) + (size_t)(r - MR) * D;
}
__device__ __forceinline__ void rms_row_bf16(const f32x4 (&v)[4], const float* __restrict__ gain, bf16* __restrict__ orow, int lane) {
    float s = 0.f;
#pragma unroll
    for (int j = 0; j < 4; ++j) s += (v[j].x * v[j].x + v[j].y * v[j].y) + (v[j].z * v[j].z + v[j].w * v[j].w);
    const float r = rsqrtf(wave_sum(s) * (1.f / D) + EPS);
#pragma unroll
    for (int j = 0; j < 4; ++j) { const f32x4 gg = *(const f32x4*)(gain + 4 * lane + 256 * j); const f32x4 o = v[j] * r * gg;
        u32x2 w; w.x = pk2(o.x, o.y); w.y = pk2(o.z, o.w); *(u32x2*)(orow + 4 * lane + 256 * j) = w; }
}
__device__ __forceinline__ void p0_init(ArgsP a, int g, int gw, int ngw, int lane) {
    bf16* XN = (bf16*)(a->ws + WS_XN);
    for (int r = gw; r < MT; r += ngw) {
        const float* src = r < MR ? a->in[I_X] + ((size_t)g * MR + r) * D : a->in[I_META] + (size_t)(r - MR) * D;
        float* hd = hrow(a, g, r);
        f32x4 v[4];
#pragma unroll
        for (int j = 0; j < 4; ++j) { v[j] = *(const f32x4*)(src + 4 * lane + 256 * j); *(f32x4*)(hd + 4 * lane + 256 * j) = v[j]; }
        rms_row_bf16(v, a->in[I_GPREMIX], XN + (size_t)r * D, lane);
    }
}
__device__ __forceinline__ void p_norm_res(ArgsP a, int g, const float* gpost, const float* gpre, int gw, int ngw, int lane) {
    bf16* XN = (bf16*)(a->ws + WS_XN); const float* Y = (const float*)(a->ws + WS_Y);
    for (int r = gw; r < MT; r += ngw) {
        float* hd = hrow(a, g, r);
        f32x4 y[4], v[4]; float s = 0.f;
#pragma unroll
        for (int j = 0; j < 4; ++j) { y[j] = *(const f32x4*)(Y + (size_t)r * D + 4 * lane + 256 * j); v[j] = *(const f32x4*)(hd + 4 * lane + 256 * j);
            s += (y[j].x * y[j].x + y[j].y * y[j].y) + (y[j].z * y[j].z + y[j].w * y[j].w); }
        const float rr = rsqrtf(wave_sum(s) * (1.f / D) + EPS);
#pragma unroll
        for (int j = 0; j < 4; ++j) { const f32x4 gg = *(const f32x4*)(gpost + 4 * lane + 256 * j); v[j] = v[j] + y[j] * rr * gg; *(f32x4*)(hd + 4 * lane + 256 * j) = v[j]; }
        if (gpre) rms_row_bf16(v, gpre, XN + (size_t)r * D, lane);
    }
}

template <class F> struct EpiT {
    static constexpr bool PERM = true, AFTER_DRAIN = false;
    F f;
    __device__ __forceinline__ void operator()(const f32x4 (&acc)[2][2][4][2], const pg8::Unit& u, int wr, int wc, int fr, int fq) const {
        const int row0 = u.pm * 256 + wr * 64 + fr, col0 = u.pn * 256 + wc * 32 + 8 * fq;
#pragma unroll
        for (int ai = 0; ai < 2; ++ai)
#pragma unroll
            for (int m = 0; m < 4; ++m)
#pragma unroll
                for (int bj = 0; bj < 2; ++bj) { f.apply(row0 + ai * 128 + m * 16, col0 + bj * 128, acc[ai][bj][m][0], acc[ai][bj][m][1]); asm volatile("" ::: "memory"); }
    }
};
__device__ __forceinline__ void st_bf16x8(bf16* p, f32x4 v0, f32x4 v1) { u32x4 w; w.x = pk2(v0.x, v0.y); w.y = pk2(v0.z, v0.w); w.z = pk2(v1.x, v1.y); w.w = pk2(v1.z, v1.w); *(u32x4*)p = w; }
__device__ __forceinline__ void ld_bf16x8(const bf16* p, f32x4& v0, f32x4& v1) { const u32x4 w = *(const u32x4*)p;
    v0 = (f32x4){bflo(w.x), bfhi(w.x), bflo(w.y), bfhi(w.y)}; v1 = (f32x4){bflo(w.z), bfhi(w.z), bflo(w.w), bfhi(w.w)}; }

struct FIn {
    bf16* Z; float* ZF; const float* bias;
    __device__ __forceinline__ void apply(int row, int col, f32x4 v0, f32x4 v1) const {
        v0 += *(const f32x4*)(bias + col); v1 += *(const f32x4*)(bias + col + 4);
        const int t = col >> 8;
        if (t >= 36) { float* p = ZF + (size_t)row * ZFW + (col - ZB); *(f32x4*)p = v0; *(f32x4*)(p + 4) = v1; return; }
        if (t < 2) { v0 *= 0.08838834764831845f; v1 *= 0.08838834764831845f; }
        else if (t >= 8 && t < 12) {
#pragma unroll
            for (int i = 0; i < 4; ++i) { v0[i] = silu_f(v0[i]); v1[i] = silu_f(v1[i]); } }
        else if (t >= 20) {
#pragma unroll
            for (int i = 0; i < 4; ++i) { v0[i] = sigmoid_f(v0[i]); v1[i] = sigmoid_f(v1[i]); } }
        st_bf16x8(Z + (size_t)row * ZB + col, v0, v1);
    }
};
struct FQQ {
    bf16* QQ;
    __device__ __forceinline__ void apply(int row, int col, f32x4 v0, f32x4 v1) const {
        const float s = col < 2048 ? 0.08838834764831845f : 0.125f;
        st_bf16x8(QQ + (size_t)row * NQQ + col, v0 * s, v1 * s);
    }
};
template <int IDX> struct FBr {
    const bf16* Z; float* Y; bf16* MIX;
    __device__ __forceinline__ void apply(int row, int col, f32x4 v0, f32x4 v1) const {
        f32x4 g0, g1; ld_bf16x8(Z + (size_t)row * ZB + ZC_GATE + IDX * 1024 + col, g0, g1);
        float* y = Y + (size_t)row * D + col;
        f32x4 a0 = v0 * g0, a1 = v1 * g1;
        if (IDX > 0) { a0 += *(const f32x4*)y; a1 += *(const f32x4*)(y + 4); }
        if (IDX < 2) { *(f32x4*)y = a0; *(f32x4*)(y + 4) = a1; }
        else st_bf16x8(MIX + (size_t)row * D + col, a0, a1);
    }
};
struct FY {
    float* Y;
    __device__ __forceinline__ void apply(int row, int col, f32x4 v0, f32x4 v1) const { float* y = Y + (size_t)row * D + col; *(f32x4*)y = v0; *(f32x4*)(y + 4) = v1; }
};
struct FUp {
    bf16* U;
    __device__ __forceinline__ void apply(int row, int col, f32x4 v0, f32x4 v1) const {
#pragma unroll
        for (int i = 0; i < 4; ++i) { const float p = fmaxf(v0[i], 0.f), q = fmaxf(v1[i], 0.f); v0[i] = p * p; v1[i] = q * q; }
        st_bf16x8(U + (size_t)row * DFF + col, v0, v1);
    }
};

template <class F>
__device__ __forceinline__ void mini_gemm(const bf16* __restrict__ A, const bf16* __restrict__ Bt, int N, int K, const F& f, int gw, int ngw, int lane) {
    const int fr = lane & 15, fq = lane >> 4;
    for (int wt = gw; wt < N / 32; wt += ngw) {
        const int n0 = wt * 32;
        f32x4 acc0 = {0.f, 0.f, 0.f, 0.f}, acc1 = {0.f, 0.f, 0.f, 0.f};
        const bf16* ap = A + (size_t)(MR + fr) * K + fq * 8;
        const bf16* b0 = Bt + (size_t)(n0 + pg8::perm32(fr)) * K + fq * 8;
        const bf16* b1 = Bt + (size_t)(n0 + pg8::perm32(16 + fr)) * K + fq * 8;
        for (int k = 0; k < K; k += 32) {
            const bf16x8 av = *(const bf16x8*)(ap + k), w0 = *(const bf16x8*)(b0 + k), w1 = *(const bf16x8*)(b1 + k);
            acc0 = __builtin_amdgcn_mfma_f32_16x16x32_bf16(w0, av, acc0, 0, 0, 0);
            acc1 = __builtin_amdgcn_mfma_f32_16x16x32_bf16(w1, av, acc1, 0, 0, 0);
        }
        f.apply(MR + fr, n0 + 8 * fq, acc0, acc1);
    }
}
template <class F>
__device__ __forceinline__ void run_gemm(LAS unsigned char* lds, const bf16* A, const bf16* Bt, int N, int K, const F& f, int gw, int ngw, int lane) {
    asm volatile("" : "+s"(K)); asm volatile("" : "+s"(N));
    pg8::Gemm g{A, Bt, MR, N, K}; pg8::StaticOrder S; S.init(MR, N, (int)gridDim.x, (int)blockIdx.x);
    EpiT<F> E{f};
    pg8::gemm_phase<EpiT<F>, pg8::StaticOrder, true, true>((PG8_LAS unsigned char*)lds, g, S, E);
    mini_gemm(A, Bt, N, K, f, gw, ngw, lane);
}

__device__ __forceinline__ int prow(int r, int j) {
    if (r < MR) { const int s = r & (SEQ - 1); return (s - j >= 0) ? r - j : MR + (NMETA + s - j); }
    const int t = r - MR; return (t - j >= 0) ? r - j : -1;
}
__device__ __forceinline__ void p2_prep(ArgsP a, int l, int gw, int ngw, int lane) {
    unsigned char* ws = a->ws;
    const bf16* Z = (const bf16*)(ws + WS_Z);
    for (int r = gw; r < MT; r += ngw) {
        const float* zf = (const float*)(ws + WS_ZF) + (size_t)r * ZFW;
        {
            f32x4 v = *(const f32x4*)(zf + ZF_CQ + 4 * lane);
            const float rr = rsqrtf(wave_sum((v.x * v.x + v.y * v.y) + (v.z * v.z + v.w * v.w)) * (1.f / 256.f) + EPS);
            const f32x4 gg = *(const f32x4*)(a->in[I_GDQ] + l * 256 + 4 * lane); v = v * rr * gg;
            u32x2 w; w.x = pk2(v.x, v.y); w.y = pk2(v.z, v.w); *(u32x2*)((bf16*)(ws + WS_CQN) + (size_t)r * 256 + 4 * lane) = w;
        }
        {
            f32x2 v = *(const f32x2*)(zf + ZF_CKV + 2 * lane);
            const float rr = rsqrtf(wave_sum(v.x * v.x + v.y * v.y) * (1.f / 128.f) + EPS);
            const f32x2 gg = *(const f32x2*)(a->in[I_GDKV] + l * 128 + 2 * lane);
            *(unsigned*)((bf16*)(ws + WS_KV) + (size_t)r * 128 + 2 * lane) = pk2(v.x * rr * gg.x, v.y * rr * gg.y);
        }
        {
            const float v = zf[ZF_IK + lane]; const float mu = wave_sum(v) * (1.f / 64.f); const float d = v - mu;
            const float var = wave_sum(d * d) * (1.f / 64.f);
            const float y = d * rsqrtf(var + EPS) * a->in[I_LNG][l * 64 + lane] + a->in[I_LNB][l * 64 + lane];
            ((bf16*)(ws + WS_KI))[(size_t)r * 64 + lane] = (bf16)f2bf(y);
        }
        if (lane < 8) ((float*)(ws + WS_WI))[(size_t)r * 8 + lane] = zf[ZF_IW + lane] * 0.35355339059327373f;
        if (lane < 4) ((float*)(ws + WS_LIF))[(size_t)r * 8 + lane] = zf[ZF_MI + lane];
        else if (lane < 8) ((float*)(ws + WS_LIF))[(size_t)r * 8 + lane] = logsigmoid_f(zf[ZF_MF + lane - 4] + a->in[I_FB][l * 4 + lane - 4]);
        {
            f32x4 av[4];
#pragma unroll
            for (int i = 0; i < 4; ++i) av[i] = *(const f32x4*)(zf + ZF_A + 4 * i);
            const int c = 8 * lane;
            f32x4 s0 = *(const f32x4*)(a->in[I_BA] + l * 512 + c), s1 = *(const f32x4*)(a->in[I_BA] + l * 512 + c + 4);
#pragma unroll
            for (int j = 0; j < 16; ++j) { const float aj = av[j >> 2][j & 3]; const float* wp = a->in[I_WA2] + (size_t)(l * 16 + j) * 512 + c;
                s0 += aj * *(const f32x4*)wp; s1 += aj * *(const f32x4*)(wp + 4); }
#pragma unroll
            for (int i = 0; i < 4; ++i) { s0[i] = logsigmoid_f(s0[i]) * 0.0625f; s1[i] = logsigmoid_f(s1[i]) * 0.0625f; }
            float* gp = (float*)(ws + WS_G) + (size_t)r * 512 + c; *(f32x4*)gp = s0; *(f32x4*)(gp + 4) = s1;
        }
        {
            const int c = 16 * lane;
            f32x4 acc[4];
#pragma unroll
            for (int i = 0; i < 4; ++i) acc[i] = (f32x4){0.f, 0.f, 0.f, 0.f};
#pragma unroll
            for (int tap = 0; tap < 4; ++tap) {
                const int rt = tap == 3 ? r : prow(r, 3 - tap);
                if (rt >= 0) {
                    f32x4 x0, x1, x2, x3; ld_bf16x8(Z + (size_t)rt * ZB + ZC_MQ + c, x0, x1); ld_bf16x8(Z + (size_t)rt * ZB + ZC_MQ + c + 8, x2, x3);
                    const float* wp = a->in[I_CONV] + (size_t)(l * 4 + tap) * 1024 + c;
                    acc[0] += x0 * *(const f32x4*)wp; acc[1] += x1 * *(const f32x4*)(wp + 4); acc[2] += x2 * *(const f32x4*)(wp + 8); acc[3] += x3 * *(const f32x4*)(wp + 12);
                }
            }
            const float sc = c < 512 ? 0.08838834764831845f : 1.f;
#pragma unroll
            for (int i = 0; i < 4; ++i)
#pragma unroll
                for (int e = 0; e < 4; ++e) acc[i][e] = silu_f(acc[i][e]) * sc;
            bf16* qp = (bf16*)(ws + WS_QKC) + (size_t)r * 1024 + c; st_bf16x8(qp, acc[0], acc[1]); st_bf16x8(qp + 8, acc[2], acc[3]);
        }
    }
}

template <bool ML>
__device__ __forceinline__ void scan_unit(ArgsP a, LAS unsigned char* lds, int b, int h, int vs, int tid) {
    unsigned char* ws = a->ws;
    const bf16* Z = (const bf16*)(ws + WS_Z); const bf16* QKC = (const bf16*)(ws + WS_QKC);
    const float* G = (const float*)(ws + WS_G); const float* LIF = (const float*)(ws + WS_LIF);
    bf16* O = (bf16*)(ws + (ML ? WS_OM : WS_OG));
    LAS float* qs = (LAS float*)lds; LAS float* ks = qs + 2048; LAS float* ds = ks + 2048; LAS float* vsm = ds + 2048; LAS float* fi = vsm + 1024;
    const int kg = tid & 7, v = tid >> 3;
    const int stt = tid >> 5, sc4 = (tid & 31) * 4, sv2 = (tid & 31) * 2;
    float S[16], nn[16];
#pragma unroll
    for (int j = 0; j < 16; ++j) { S[j] = 0.f; nn[j] = 0.f; }
    for (int blk = 0; blk < TT / 16; ++blk) {
        const int row0 = blk == 0 ? MR : b * SEQ + (blk - 1) * 16;
        __syncthreads();
        {
            const int row = row0 + stt;
            u32x2 qw, kw;
            if (ML) { qw = *(const u32x2*)(QKC + (size_t)row * 1024 + h * 128 + sc4); kw = *(const u32x2*)(QKC + (size_t)row * 1024 + 512 + h * 128 + sc4); }
            else { qw = *(const u32x2*)(Z + (size_t)row * ZB + ZC_GQ + h * 128 + sc4); kw = *(const u32x2*)(Z + (size_t)row * ZB + ZC_GK + h * 128 + sc4); }
            *(LAS f32x4*)(qs + stt * 128 + sc4) = (f32x4){bflo(qw.x), bfhi(qw.x), bflo(qw.y), bfhi(qw.y)};
            *(LAS f32x4*)(ks + stt * 128 + sc4) = (f32x4){bflo(kw.x), bfhi(kw.x), bflo(kw.y), bfhi(kw.y)};
            if (!ML) { f32x4 gv = *(const f32x4*)(G + (size_t)row * 512 + h * 128 + sc4);
                *(LAS f32x4*)(ds + stt * 128 + sc4) = (f32x4){__expf(gv.x), __expf(gv.y), __expf(gv.z), __expf(gv.w)}; }
            const unsigned vw = *(const unsigned*)(Z + (size_t)row * ZB + (ML ? ZC_MV : ZC_GV) + h * 256 + vs * 64 + sv2);
            *(LAS f32x2*)(vsm + stt * 64 + sv2) = (f32x2){bflo(vw), bfhi(vw)};
            if (ML && tid < 16) { const int rw = row0 + tid; fi[2 * tid] = __expf(LIF[(size_t)rw * 8 + 4 + h]); fi[2 * tid + 1] = __expf(LIF[(size_t)rw * 8 + h]); }
        }
        __syncthreads();
        for (int tt = 0; tt < 16; ++tt) {
            float q[16], k[16], d[16];
#pragma unroll
            for (int i = 0; i < 4; ++i) { const f32x4 t4 = *(const LAS f32x4*)(qs + tt * 128 + 16 * kg + 4 * i); q[4 * i] = t4.x; q[4 * i + 1] = t4.y; q[4 * i + 2] = t4.z; q[4 * i + 3] = t4.w; }
#pragma unroll
            for (int i = 0; i < 4; ++i) { const f32x4 t4 = *(const LAS f32x4*)(ks + tt * 128 + 16 * kg + 4 * i); k[4 * i] = t4.x; k[4 * i + 1] = t4.y; k[4 * i + 2] = t4.z; k[4 * i + 3] = t4.w; }
            const float vv = vsm[tt * 64 + v];
            float num = 0.f, den = 0.f;
            if (ML) {
                const float f = fi[2 * tt], ii = fi[2 * tt + 1];
#pragma unroll
                for (int j = 0; j < 16; ++j) { const float ik = ii * k[j]; S[j] = f * S[j] + ik * vv; nn[j] = f * nn[j] + ik; num += q[j] * S[j]; den += q[j] * nn[j]; }
            } else {
#pragma unroll
                for (int i = 0; i < 4; ++i) { const f32x4 t4 = *(const LAS f32x4*)(ds + tt * 128 + 16 * kg + 4 * i); d[4 * i] = t4.x; d[4 * i + 1] = t4.y; d[4 * i + 2] = t4.z; d[4 * i + 3] = t4.w; }
#pragma unroll
                for (int j = 0; j < 16; ++j) { S[j] = d[j] * S[j] + k[j] * vv; num += q[j] * S[j]; }
            }
            num += __shfl_xor(num, 1); num += __shfl_xor(num, 2); num += __shfl_xor(num, 4);
            if (ML) { den += __shfl_xor(den, 1); den += __shfl_xor(den, 2); den += __shfl_xor(den, 4); num = num / fmaxf(fabsf(den), 1.f); }
            if (kg == 0) O[(size_t)(row0 + tt) * 1024 + h * 256 + vs * 64 + v] = (bf16)f2bf(num);
        }
    }
}

__device__ __forceinline__ void p6_headnorm(ArgsP a, int l, int gw, int ngw, int lane) {
    unsigned char* ws = a->ws; const bf16* Z = (const bf16*)(ws + WS_Z);
    for (int it = gw; it < MT * 8; it += ngw) {
        const int r = it >> 3, mx = (it >> 2) & 1, h = it & 3;
        bf16* op = (bf16*)(ws + (mx ? WS_OM : WS_OG)) + (size_t)r * 1024 + h * 256 + 4 * lane;
        const u32x2 w = *(const u32x2*)op; f32x4 v = {bflo(w.x), bfhi(w.x), bflo(w.y), bfhi(w.y)};
        const float rr = rsqrtf(wave_sum((v.x * v.x + v.y * v.y) + (v.z * v.z + v.w * v.w)) * (1.f / 256.f) + EPS);
        const f32x4 gg = *(const f32x4*)(a->in[mx ? I_GML : I_GGLA] + l * 256 + 4 * lane);
        const u32x2 gw2 = *(const u32x2*)(Z + (size_t)r * ZB + (mx ? ZC_MO : ZC_GR) + h * 256 + 4 * lane);
        const f32x4 gt = {bflo(gw2.x), bfhi(gw2.x), bflo(gw2.y), bfhi(gw2.y)};
        v = v * rr * gg * gt;
        u32x2 o; o.x = pk2(v.x, v.y); o.y = pk2(v.z, v.w); *(u32x2*)op = o;
    }
}

__device__ __forceinline__ int krow(int b, int s) { return s < NMETA ? MR + s : b * SEQ + (s - NMETA); }
__device__ __forceinline__ int wave_sum_i(int v) {
#pragma unroll
    for (int o = 1; o < 64; o <<= 1) v += __shfl_xor(v, o);
    return v;
}
__device__ __forceinline__ int t5_bucket(int n) {
    if (n < 16) return n < 0 ? 0 : n;
    const int lg = 16 + (int)(__logf((float)n * (1.f / 16.f)) / 2.0794415416798357f * 16.f);
    return lg < 31 ? lg : 31;
}
constexpr int DW_STRIDE = 15360, DW_SC = 0, DW_Q = 8448, DW_QI = 12544, DW_SEL = 14592, DSA_T5 = 8 * DW_STRIDE;

__device__ __forceinline__ void dsa_query(ArgsP a, LAS unsigned char* wl, const LAS float* t5L, int qrow, int b, int p, int lane_in) {
    int lane = lane_in; asm volatile("" : "+v"(lane));
    unsigned char* ws = a->ws;
    const bf16* QQ = (const bf16*)(ws + WS_QQ) + (size_t)qrow * NQQ;
    const bf16* KI = (const bf16*)(ws + WS_KI); const bf16* KV = (const bf16*)(ws + WS_KV);
    LAS float* scL = (LAS float*)(wl + DW_SC); LAS bf16* PL = (LAS bf16*)(wl + DW_SC);
    LAS bf16* qL = (LAS bf16*)(wl + DW_Q); LAS float* qiL = (LAS float*)(wl + DW_QI); LAS unsigned short* selL = (LAS unsigned short*)(wl + DW_SEL);
#pragma unroll
    for (int i = 0; i < 4; ++i) *(LAS u32x4*)(qL + (i * 64 + lane) * 8) = *(const u32x4*)(QQ + (i * 64 + lane) * 8);
    { f32x4 v0, v1; ld_bf16x8(QQ + 2048 + lane * 8, v0, v1); *(LAS f32x4*)(qiL + lane * 8) = v0; *(LAS f32x4*)(qiL + lane * 8 + 4) = v1; }
    float wi[8];
    { const f32x4 w0 = *(const f32x4*)((const float*)(ws + WS_WI) + (size_t)qrow * 8), w1 = *(const f32x4*)((const float*)(ws + WS_WI) + (size_t)qrow * 8 + 4);
      wi[0] = w0.x; wi[1] = w0.y; wi[2] = w0.z; wi[3] = w0.w; wi[4] = w1.x; wi[5] = w1.y; wi[6] = w1.z; wi[7] = w1.w; }
    LDS_WAIT();
    const int nk = p + 1;
    int nsel;
    if (nk > 256) {
        const int nsteps = (nk + 63) >> 6;
        for (int i = 0; i < nsteps; ++i) {
            const int s = lane + 64 * i; float sc = -INFINITY;
            if (s < nk) {
                const u32x4* kp = (const u32x4*)(KI + (size_t)krow(b, s) * 64);
                u32x4 kk[8];
#pragma unroll
                for (int d8 = 0; d8 < 8; ++d8) kk[d8] = kp[d8];
                float acc[8];
#pragma unroll
                for (int h = 0; h < 8; ++h) acc[h] = 0.f;
#pragma unroll
                for (int d8 = 0; d8 < 8; ++d8) {
                    const float k0 = bflo(kk[d8].x), k1 = bfhi(kk[d8].x), k2 = bflo(kk[d8].y), k3 = bfhi(kk[d8].y), k4 = bflo(kk[d8].z), k5 = bfhi(kk[d8].z), k6 = bflo(kk[d8].w), k7 = bfhi(kk[d8].w);
#pragma unroll
                    for (int h = 0; h < 8; ++h) { const f32x4 q0 = *(const LAS f32x4*)(qiL + h * 64 + d8 * 8), q1 = *(const LAS f32x4*)(qiL + h * 64 + d8 * 8 + 4);
                        acc[h] += (q0.x * k0 + q0.y * k1) + (q0.z * k2 + q0.w * k3) + (q1.x * k4 + q1.y * k5) + (q1.z * k6 + q1.w * k7); }
                    asm volatile("" ::: "memory");
                }
                sc = 0.f;
#pragma unroll
                for (int h = 0; h < 8; ++h) sc += wi[h] * fmaxf(acc[h], 0.f);
            }
            scL[s] = sc;
        }
        LDS_WAIT();
        unsigned u[33];
#pragma unroll
        for (int i = 0; i < 33; ++i) { const int s = lane + 64 * i; unsigned key = 0u;
            if (s < nk) { const unsigned bits = __builtin_bit_cast(unsigned, scL[s]); key = bits ^ ((bits >> 31) ? 0xffffffffu : 0x80000000u); }
            u[i] = key; }
        unsigned prefix = 0u; int rem = 256;
        for (int bit = 31; bit >= 0; --bit) {
            const unsigned cand = prefix | (1u << bit), msk = ~((1u << bit) - 1u);
            int cnt = 0;
#pragma unroll
            for (int i = 0; i < 33; ++i) cnt += ((u[i] & msk) == cand) ? 1 : 0;
            cnt = wave_sum_i(cnt);
            if (cnt >= rem) prefix = cand; else rem -= cnt;
        }
        const unsigned long long lt = (1ull << lane) - 1ull;
        int base = 0, eqseen = 0;
#pragma unroll
        for (int i = 0; i < 33; ++i) {
            const bool gt = u[i] > prefix, eq = u[i] == prefix;
            const unsigned long long meq = __ballot(eq);
            const bool take = gt || (eq && (eqseen + __popcll(meq & lt)) < rem);
            const unsigned long long mt = __ballot(take);
            if (take) selL[base + __popcll(mt & lt)] = (unsigned short)(lane + 64 * i);
            base += __popcll(mt); eqseen += __popcll(meq);
        }
        nsel = 256;
    } else {
#pragma unroll
        for (int m = 0; m < 4; ++m) selL[lane + 64 * m] = (unsigned short)(lane + 64 * m);
        nsel = nk;
    }
    LDS_WAIT();
    asm volatile("" : "+v"(lane));
    int idx[4];
#pragma unroll
    for (int m = 0; m < 4; ++m) { const int j = lane + 64 * m; idx[m] = j < nsel ? (int)selL[j] : 0; }
    const u32x4* kp0 = (const u32x4*)(KV + (size_t)krow(b, idx[0]) * 128); const u32x4* kp1 = (const u32x4*)(KV + (size_t)krow(b, idx[1]) * 128);
    const u32x4* kp2 = (const u32x4*)(KV + (size_t)krow(b, idx[2]) * 128); const u32x4* kp3 = (const u32x4*)(KV + (size_t)krow(b, idx[3]) * 128);
    int bk[4];
#pragma unroll
    for (int m = 0; m < 4; ++m) bk[m] = t5_bucket(p - idx[m]) * 16;
    for (int hh = 0; hh < 2; ++hh) {
        float lg[8][4];
#pragma unroll
        for (int h = 0; h < 8; ++h)
#pragma unroll
            for (int m = 0; m < 4; ++m) lg[h][m] = 0.f;
        for (int d8 = 0; d8 < 16; ++d8) {
            u32x4 kw[4]; kw[0] = kp0[d8]; kw[1] = kp1[d8]; kw[2] = kp2[d8]; kw[3] = kp3[d8];
#pragma unroll
            for (int m = 0; m < 4; ++m) {
                const float k0 = bflo(kw[m].x), k1 = bfhi(kw[m].x), k2 = bflo(kw[m].y), k3 = bfhi(kw[m].y), k4 = bflo(kw[m].z), k5 = bfhi(kw[m].z), k6 = bflo(kw[m].w), k7 = bfhi(kw[m].w);
#pragma unroll
                for (int h = 0; h < 8; ++h) {
                    const u32x4 qw = *(const LAS u32x4*)(qL + (hh * 8 + h) * 128 + d8 * 8);
                    lg[h][m] += (bflo(qw.x) * k0 + bfhi(qw.x) * k1) + (bflo(qw.y) * k2 + bfhi(qw.y) * k3) + (bflo(qw.z) * k4 + bfhi(qw.z) * k5) + (bflo(qw.w) * k6 + bfhi(qw.w) * k7);
                    if ((h & 3) == 3) asm volatile("" ::: "memory");
                }
            }
        }
#pragma unroll
        for (int h = 0; h < 8; ++h) {
            float mx = -INFINITY;
#pragma unroll
            for (int m = 0; m < 4; ++m) { const bool ok = (lane + 64 * m) < nsel; lg[h][m] = ok ? lg[h][m] + t5L[bk[m] + hh * 8 + h] : -INFINITY; mx = fmaxf(mx, lg[h][m]); }
            mx = wave_max(mx);
            float sm = 0.f;
#pragma unroll
            for (int m = 0; m < 4; ++m) { lg[h][m] = __expf(lg[h][m] - mx); sm += lg[h][m]; }
            sm = 1.f / wave_sum(sm);
#pragma unroll
            for (int m = 0; m < 4; ++m) lg[h][m] *= sm;
        }
#pragma unroll
        for (int m = 0; m < 4; ++m) {
            u32x4 w0;
            w0.x = pk2(lg[0][m], lg[1][m]); w0.y = pk2(lg[2][m], lg[3][m]); w0.z = pk2(lg[4][m], lg[5][m]); w0.w = pk2(lg[6][m], lg[7][m]);
            *(LAS u32x4*)(PL + (lane + 64 * m) * 16 + hh * 8) = w0;
        }
    }
    LDS_WAIT();
    asm volatile("" : "+v"(lane));
    float o0[16], o1[16];
#pragma unroll
    for (int h = 0; h < 16; ++h) { o0[h] = 0.f; o1[h] = 0.f; }
    for (int j0 = 0; j0 < nsel; j0 += 4) {
        unsigned kvw[4]; u32x4 pa[4], pb[4];
#pragma unroll
        for (int e = 0; e < 4; ++e) { const int j = j0 + e; const bool ok = j < nsel; const int id = ok ? (int)selL[j] : 0;
            kvw[e] = ok ? *(const unsigned*)(KV + (size_t)krow(b, id) * 128 + 2 * lane) : 0u;
            pa[e] = *(const LAS u32x4*)(PL + (ok ? j : 0) * 16); pb[e] = *(const LAS u32x4*)(PL + (ok ? j : 0) * 16 + 8); }
#pragma unroll
        for (int e = 0; e < 4; ++e) {
            const float lo = bflo(kvw[e]), hi = bfhi(kvw[e]);
            const unsigned pw[8] = {pa[e].x, pa[e].y, pa[e].z, pa[e].w, pb[e].x, pb[e].y, pb[e].z, pb[e].w};
#pragma unroll
            for (int hh = 0; hh < 8; ++hh) { const float p0 = bflo(pw[hh]), p1 = bfhi(pw[hh]);
                o0[2 * hh] += p0 * lo; o1[2 * hh] += p0 * hi; o0[2 * hh + 1] += p1 * lo; o1[2 * hh + 1] += p1 * hi; }
        }
    }
    bf16* od = (bf16*)(ws + WS_OD) + (size_t)qrow * 2048 + 2 * lane;
#pragma unroll
    for (int h = 0; h < 16; ++h) *(unsigned*)(od + h * 128) = pk2(o0[h], o1[h]);
    LDS_WAIT();
}
__device__ __forceinline__ void p5_dsa(ArgsP a, LAS unsigned char* lds, int tid, int wave, int lane) {
    LAS float* t5L = (LAS float*)(lds + DSA_T5);
    __syncthreads();
    t5L[tid] = a->in[I_T5][tid];
    __syncthreads();
    LAS unsigned char* wl = lds + wave * DW_STRIDE;
    for (int u = blockIdx.x; u < MT / 8; u += gridDim.x) {
        const int q = u * 8 + wave;
        int b, p;
        if (q < MR) { b = q >> 11; p = NMETA + (q & (SEQ - 1)); } else { b = 0; p = q - MR; }
        dsa_query(a, wl, t5L, q, b, p, lane);
    }
}

__global__ void __launch_bounds__(NWAVES * 64, 2) fwd(Args a_) {
    extern __shared__ __attribute__((aligned(16))) unsigned char lds_raw[];
    LAS unsigned char* lds = (LAS unsigned char*)lds_raw;
    volatile LAS unsigned* MISC = (volatile LAS unsigned*)(lds + MISC_OFF);
    if (threadIdx.x < 32) MISC[threadIdx.x] = 0u;
    __syncthreads();
    const int g_lo = a_.g_lo, g_hi = a_.g_hi, l_lo = a_.l_lo, l_hi = a_.l_hi, ph_lo = a_.ph_lo, ph_hi = a_.ph_hi, use_bar = a_.use_bar;
    XcdBarrier bar; bar.bar = (unsigned*)(a_.ws + WS_CTL) + CW_BAR; bar.x = 0; bar.st = nullptr;
    if (use_bar) bar = xcd_barrier_post((unsigned*)(a_.ws + WS_CTL) + CW_BAR, MISC + 8);
#define GRID_BAR() do { if (use_bar) xcd_barrier(bar); } while (0)
#ifndef PHMASK
#define PHMASK 0xFFFF
#endif
#define PH(k) (((PHMASK >> (k)) & 1) && ph_lo <= (k) && (k) < ph_hi)
#define PBEGIN ArgsP a = (ArgsP)__builtin_amdgcn_kernarg_segment_ptr(); asm volatile("" : "+s"(a)); unsigned char* ws = a->ws; \
    int tid_ = threadIdx.x; asm volatile("" : "+v"(tid_)); const int tid = tid_, lane = tid & 63, wave = __builtin_amdgcn_readfirstlane(tid >> 6); const int gw = blockIdx.x * NWAVES + wave, ngw = gridDim.x * NWAVES; (void)ws; (void)gw; (void)ngw; (void)lane;

    if (((PHMASK >> 13) & 1) && a_.prep) { PBEGIN prep_weights(a, lds, gw, ngw, wave, lane); GRID_BAR(); }

    for (int g = g_lo; g < g_hi; ++g) {
        for (int l = l_lo; l < l_hi; ++l) {
            if (PH(0) && l == 0) { PBEGIN p0_init(a, g, gw, ngw, lane); GRID_BAR(); }
            if (PH(1)) { PBEGIN
                FIn f{(bf16*)(ws + WS_Z), (float*)(ws + WS_ZF), (const float*)(ws + WS_BIN) + l * NZ};
                run_gemm(lds, (const bf16*)(ws + WS_XN), (const bf16*)(ws + WS_WIN) + (size_t)l * NZ * D, NZ, D, f, gw, ngw, lane);
                GRID_BAR();
            }
            if (PH(2)) { PBEGIN p2_prep(a, l, gw, ngw, lane); GRID_BAR(); }
            if (PH(3)) { PBEGIN
                FQQ f{(bf16*)(ws + WS_QQ)};
                run_gemm(lds, (const bf16*)(ws + WS_CQN), (const bf16*)(ws + WS_WQQ) + (size_t)l * NQQ * 256, NQQ, 256, f, gw, ngw, lane);
            }
            if (PH(4)) { PBEGIN
                for (int u = blockIdx.x; u < 256; u += gridDim.x) {
                    const int b = (u >> 4) & 7, h = (u >> 2) & 3, vs = u & 3;
                    if (u >> 7) scan_unit<true>(a, lds, b, h, vs, tid); else scan_unit<false>(a, lds, b, h, vs, tid);
                }
                GRID_BAR();
            }
            if (PH(5)) { PBEGIN p5_dsa(a, lds, tid, wave, lane); }
            if (PH(6)) { PBEGIN p6_headnorm(a, l, gw, ngw, lane); GRID_BAR(); }
            if (PH(7)) {
                __syncthreads();
                { PBEGIN FBr<0> f0{(const bf16*)(ws + WS_Z), (float*)(ws + WS_Y), (bf16*)(ws + WS_MIX)};
                  run_gemm(lds, (const bf16*)(ws + WS_OG), (const bf16*)(ws + WS_WBG) + (size_t)l * D * D, D, D, f0, gw, ngw, lane); }
                { PBEGIN FBr<1> f1{(const bf16*)(ws + WS_Z), (float*)(ws + WS_Y), (bf16*)(ws + WS_MIX)};
                  run_gemm(lds, (const bf16*)(ws + WS_OD), (const bf16*)(ws + WS_WBD) + (size_t)l * D * 2048, D, 2048, f1, gw, ngw, lane); }
                { PBEGIN FBr<2> f2{(const bf16*)(ws + WS_Z), (float*)(ws + WS_Y), (bf16*)(ws + WS_MIX)};
                  run_gemm(lds, (const bf16*)(ws + WS_OM), (const bf16*)(ws + WS_WBM) + (size_t)l * D * D, D, D, f2, gw, ngw, lane); }
                GRID_BAR();
            }
            if (PH(8)) { PBEGIN
                FY f{(float*)(ws + WS_Y)};
                run_gemm(lds, (const bf16*)(ws + WS_MIX), (const bf16*)(ws + WS_WOUT) + (size_t)l * D * D, D, D, f, gw, ngw, lane);
                GRID_BAR();
            }
            if (PH(9)) { PBEGIN p_norm_res(a, g, a->in[I_GPOSTMIX] + l * D, a->in[I_GPREMLP] + l * D, gw, ngw, lane); GRID_BAR(); }
            if (PH(10)) { PBEGIN
                FUp f{(bf16*)(ws + WS_Z)};
                run_gemm(lds, (const bf16*)(ws + WS_XN), (const bf16*)(ws + WS_WUP) + (size_t)l * DFF * D, DFF, D, f, gw, ngw, lane);
                GRID_BAR();
            }
            if (PH(11)) { PBEGIN
                FY f{(float*)(ws + WS_Y)};
                run_gemm(lds, (const bf16*)(ws + WS_Z), (const bf16*)(ws + WS_WDN) + (size_t)l * D * DFF, D, DFF, f, gw, ngw, lane);
                GRID_BAR();
            }
            if (PH(12)) { PBEGIN p_norm_res(a, g, a->in[I_GPOSTMLP] + l * D, l + 1 < NL ? a->in[I_GPREMIX] + (l + 1) * D : nullptr, gw, ngw, lane); GRID_BAR(); }
        }
    }
#undef PH
#undef GRID_BAR
#undef PBEGIN
}

#ifndef MK_ONE_LAUNCH
#define MK_ONE_LAUNCH 0
#endif
extern "C" void kernel_launch(void* const* d_in, const int* in_sizes, int n_in, void* d_out, int out_size, void* d_ws, size_t ws_size, hipStream_t stream) {
    static int grid = 0;
    if (grid == 0) {
        if (n_in != 28 || out_size != NB * SEQ * D || ws_size < WS_END) { fprintf(stderr, "kernel_launch: unexpected shapes (n_in %d out %d ws %zu need %zu)\n", n_in, out_size, ws_size, (size_t)WS_END); grid = -1; return; }
        int dev = 0, cus = 0, per_cu = 0;
        if (hipGetDevice(&dev) != hipSuccess || hipDeviceGetAttribute(&cus, hipDeviceAttributeMultiprocessorCount, dev) != hipSuccess) { grid = -1; return; }
        if (hipFuncSetAttribute((const void*)fwd, hipFuncAttributeMaxDynamicSharedMemorySize, LDS_BYTES) != hipSuccess) { fprintf(stderr, "kernel_launch: hipFuncSetAttribute failed\n"); grid = -1; return; }
        if (hipOccupancyMaxActiveBlocksPerMultiprocessor(&per_cu, (const void*)fwd, NWAVES * 64, LDS_BYTES) != hipSuccess || per_cu < 1) { fprintf(stderr, "kernel_launch: occupancy query says %d\n", per_cu); }
        (void)hipGetLastError();
        grid = cus;
    }
    if (grid < 0) return;
    (void)hipMemsetAsync((char*)d_ws + WS_CTL, 0, CTL_ZERO_BYTES, stream);
    Args a{};
    for (int i = 0; i < 28; ++i) a.in[i] = (const float*)d_in[i];
    a.out = (float*)d_out; a.ws = (unsigned char*)d_ws;
#if MK_ONE_LAUNCH
    a.g_lo = 0; a.g_hi = NG; a.l_lo = 0; a.l_hi = NL; a.ph_lo = 0; a.ph_hi = 13; a.prep = 1; a.use_bar = 1;
    hipLaunchKernelGGL(fwd, dim3(grid), dim3(NWAVES * 64), LDS_BYTES, stream, a);
#else
    a.use_bar = 0;
    a.prep = 1; a.g_lo = 0; a.g_hi = 0; a.l_lo = 0; a.l_hi = 0; a.ph_lo = 0; a.ph_hi = 0;
    hipLaunchKernelGGL(fwd, dim3(grid), dim3(NWAVES * 64), LDS_BYTES, stream, a);
    a.prep = 0;
    static const int cuts[] = {0, 1, 2, 3, 5, 7, 8, 9, 10, 11, 12, 13};
    for (int g = 0; g < NG; ++g) for (int l = 0; l < NL; ++l) for (int c = 0; c < 11; ++c) {
        if (c == 0 && l != 0) continue;
        a.g_lo = g; a.g_hi = g + 1; a.l_lo = l; a.l_hi = l + 1; a.ph_lo = cuts[c]; a.ph_hi = cuts[c + 1];
        hipLaunchKernelGGL(fwd, dim3(grid), dim3(NWAVES * 64), LDS_BYTES, stream, a);
    }
#endif
    const hipError_t le = hipPeekAtLastError();
    if (le != hipSuccess) fprintf(stderr, "kernel_launch: launch failed: %s\n", hipGetErrorName(le));
}
```

```cpp
#include <hip/hip_runtime.h>
#include <cstdio>
#include <cstdint>
namespace pg8 {
#define PG8_LAS __attribute__((address_space(3)))
typedef unsigned short bf16_t;
typedef short bf16x8 __attribute__((ext_vector_type(8)));
typedef float f32x4 __attribute__((ext_vector_type(4)));
typedef unsigned u32x4 __attribute__((ext_vector_type(4)));
constexpr int BM = 256, BK = 64, HALF = 128, HTB = HALF * BK * 2  , STAGE_BYTES = 8 * HTB, NXCD = 8, WGM = 8;

__host__ __device__ __forceinline__ int lds_byte(int r, int c) { const int st = (r >> 4) * 2 + (c >> 5), rr = r & 15, cc = c & 31, ob = rr * 64 + cc * 2; return st * 1024 + (ob ^ (((ob >> 9) & 1) << 5)); }
__host__ __device__ __forceinline__ void stage_rc(int b, int& R, int& C) { const int st = b / 1024, sb = b % 1024, swz = sb ^ (((sb >> 9) & 1) << 5); R = (st >> 1) * 16 + swz / 64; C = (st & 1) * 32 + (swz % 64) / 2; }
__host__ __device__ __forceinline__ int perm32(int rho) { const int n = rho >> 4, i = rho & 15; return 8 * (i >> 2) + 4 * n + (i & 3); }

struct Unit { int pm, pn; };
struct Gemm { const bf16_t* A; const bf16_t* Bt; int M, N, K; };

struct StaticOrder {
    int nM, nN, nwg, G, c;
    __host__ __device__ void init(int M, int N, int G_, int c_) { nM = M / BM; nN = N / BM; nwg = nM * nN; G = G_; c = c_; }
    __host__ __device__ bool next(int i, Unit& u) const {
        const long L = (long)i * G + c; if (L >= nwg) return false;
        int wgid = (int)L; { const int q = nwg / NXCD, r = nwg % NXCD, xcd = wgid % NXCD, off = wgid / NXCD; wgid = (xcd < r ? xcd * (q + 1) : r * (q + 1) + (xcd - r) * q) + off; }
        const int nig = WGM * nN, gid = wgid / nig, fm = gid * WGM, gsz = (nM - fm) < WGM ? (nM - fm) : WGM;
        u.pm = fm + ((wgid % nig) % gsz); u.pn = (wgid % nig) / gsz; return true;
    }
    __device__ __forceinline__ void a_ready(const Unit&) const {}
    __device__ __forceinline__ void done(const Unit&) const {}
};

__device__ __forceinline__ unsigned cvt_pk_bf16(float lo, float hi) { unsigned r; asm volatile("v_cvt_pk_bf16_f32 %0, %1, %2" : "=v"(r) : "v"(lo), "v"(hi)); return r; }
template <class Epi, class Sched, bool ALIGN_EPI = false, bool SP2 = false>
__device__ __forceinline__ void gemm_phase(PG8_LAS unsigned char* lds, const Gemm g, const Sched& S, const Epi& E) {
    int tid_ = threadIdx.x; asm volatile("" : "+v"(tid_));
    const int tid = tid_, wid = __builtin_amdgcn_readfirstlane(tid >> 6), lane = tid & 63, wr = wid >> 2, wc = wid & 3, fr = lane & 15, fq = lane >> 4;
    const int K = g.K, nt = K / BK;
    unsigned voffA[2], voffB[2];
#pragma unroll
    for (int i = 0; i < 2; ++i) { int R, C; stage_rc(tid * 16 + i * 8192, R, C); const int Rb = Epi::PERM ? ((R & ~31) + perm32(R & 31)) : R;
        voffA[i] = (unsigned)(R * K + C) * 2u; voffB[i] = (unsigned)(Rb * K + C) * 2u; }
    const size_t kstep = (size_t)(BK * 2);
    const size_t hstep = (size_t)HALF * K * 2;
    const size_t tstep = 2 * hstep;
    const unsigned ldsw = (unsigned)wid * 1024u;
    const int aoff = lds_byte(wr * 64 + fr, fq * 8), boff = lds_byte(wc * 32 + fr, fq * 8);
#define PG8_SA(b, h) (((b) * 2 + (h)) * HTB)
#define PG8_SB(b, h) ((4 + (b) * 2 + (h)) * HTB)
#define PG8_STAGE(bufoff, gbase, voff) do { _Pragma("unroll") for (int _i = 0; _i < 2; ++_i) \
        __builtin_amdgcn_global_load_lds((const unsigned*)((const char*)(gbase) + (voff)[_i]), (PG8_LAS unsigned*)(lds + (bufoff) + ldsw + _i * 8192), 16, 0, 0); } while (0)
#define PG8_LDA(dst, b, h) do { _Pragma("unroll") for (int m = 0; m < 4; ++m) _Pragma("unroll") for (int k = 0; k < 2; ++k) dst[m][k] = *(const PG8_LAS bf16x8*)(lds + PG8_SA(b, h) + aoff + m * 2048 + k * 1024); } while (0)
#define PG8_LDB(dst, b, h) do { _Pragma("unroll") for (int n = 0; n < 2; ++n) _Pragma("unroll") for (int k = 0; k < 2; ++k) dst[n][k] = *(const PG8_LAS bf16x8*)(lds + PG8_SB(b, h) + boff + n * 2048 + k * 1024); } while (0)
#define PG8_MMA(ai, bj, At, Bt) do { __builtin_amdgcn_s_setprio(1); _Pragma("unroll") for (int m = 0; m < 4; ++m) _Pragma("unroll") for (int n = 0; n < 2; ++n) _Pragma("unroll") for (int k = 0; k < 2; ++k) \
        acc[ai][bj][m][n] = __builtin_amdgcn_mfma_f32_16x16x32_bf16(Bt[n][k], At[m][k], acc[ai][bj][m][n], 0, 0, 0); __builtin_amdgcn_s_setprio(0); } while (0)
#define PG8_WAIT_V(n) asm volatile("s_waitcnt vmcnt(" #n ")" ::: "memory")
#define PG8_WAIT_L(n) asm volatile("s_waitcnt lgkmcnt(" #n ")" ::: "memory")
#define PG8_BAR __builtin_amdgcn_s_barrier()
#define PG8_SCHED __builtin_amdgcn_sched_barrier(0)
    Unit cur, nxt; int ui = 0;
    if (!S.next(0, cur)) return;
    f32x4 acc[2][2][4][2];
#pragma unroll
    for (int a = 0; a < 2; ++a)
#pragma unroll
        for (int b = 0; b < 2; ++b)
#pragma unroll
            for (int m = 0; m < 4; ++m)
#pragma unroll
                for (int n = 0; n < 2; ++n) acc[a][b][m][n] = (f32x4){0.f, 0.f, 0.f, 0.f};
    bf16x8 At[4][2], B0[2][2], B1[2][2];
    const char* cA = (const char*)g.A + (size_t)cur.pm * tstep; const char* cB = (const char*)g.Bt + (size_t)cur.pn * tstep;
    S.a_ready(cur);
    if constexpr (SP2) {
        PG8_STAGE(PG8_SB(0, 0), cB, voffB); PG8_STAGE(PG8_SB(0, 1), cB + hstep, voffB); PG8_STAGE(PG8_SA(0, 0), cA, voffA); PG8_STAGE(PG8_SA(0, 1), cA + hstep, voffA);
        if (wr == 1) PG8_BAR;
        PG8_WAIT_V(2); PG8_BAR;
        PG8_STAGE(PG8_SB(1, 0), cB + kstep, voffB); PG8_STAGE(PG8_SA(1, 0), cA + kstep, voffA); PG8_STAGE(PG8_SB(1, 1), cB + hstep + kstep, voffB);
        PG8_WAIT_V(6); PG8_BAR;
    } else {
        PG8_STAGE(PG8_SB(0, 0), cB, voffB); PG8_STAGE(PG8_SA(0, 0), cA, voffA); PG8_STAGE(PG8_SB(0, 1), cB + hstep, voffB); PG8_STAGE(PG8_SA(0, 1), cA + hstep, voffA);
        if (wr == 1) PG8_BAR;
        PG8_WAIT_V(4); PG8_BAR;
        PG8_STAGE(PG8_SB(1, 0), cB + kstep, voffB); PG8_STAGE(PG8_SA(1, 0), cA + kstep, voffA); PG8_STAGE(PG8_SB(1, 1), cB + hstep + kstep, voffB);
        PG8_WAIT_V(6); PG8_BAR;
    }
    for (;;) {
        const bool has_next = S.next(ui + 1, nxt);
        const char* nA = has_next ? (const char*)g.A + (size_t)nxt.pm * tstep : cA; const char* nB = has_next ? (const char*)g.Bt + (size_t)nxt.pn * tstep : cB;
        for (int t = 0; t < nt; t += 2) {
            const bool last = (t == nt - 2);
            const char* a1 = cA + (size_t)(t + 1) * kstep;
            const char* a2 = last ? nA : cA + (size_t)(t + 2) * kstep; const char* b2 = last ? nB : cB + (size_t)(t + 2) * kstep;
            const char* a3 = a2 + kstep; const char* b3 = b2 + kstep;
            if (last && has_next) S.a_ready(nxt);
            if constexpr (SP2) {
            PG8_LDB(B0, 0, 0); PG8_LDB(B1, 0, 1); PG8_SCHED; PG8_LDA(At, 0, 0); PG8_STAGE(PG8_SA(1, 1), a1 + hstep, voffA);
            PG8_WAIT_V(8); PG8_WAIT_L(0); PG8_BAR; PG8_MMA(0, 0, At, B0); PG8_MMA(0, 1, At, B1); PG8_BAR; PG8_SCHED;
            PG8_LDA(At, 0, 1); PG8_STAGE(PG8_SB(0, 0), b2, voffB); PG8_STAGE(PG8_SB(0, 1), b2 + hstep, voffB); PG8_STAGE(PG8_SA(0, 0), a2, voffA);
            PG8_WAIT_V(8); PG8_WAIT_L(0); PG8_BAR; PG8_MMA(1, 0, At, B0); PG8_MMA(1, 1, At, B1); PG8_BAR; PG8_SCHED;
            PG8_LDB(B0, 1, 0); PG8_LDB(B1, 1, 1); PG8_SCHED; PG8_LDA(At, 1, 0); PG8_STAGE(PG8_SA(0, 1), a2 + hstep, voffA);
            PG8_WAIT_V(8); PG8_WAIT_L(0); PG8_BAR; PG8_MMA(0, 0, At, B0); PG8_MMA(0, 1, At, B1); PG8_BAR; PG8_SCHED;
            PG8_LDA(At, 1, 1); PG8_STAGE(PG8_SB(1, 0), b3, voffB); PG8_STAGE(PG8_SB(1, 1), b3 + hstep, voffB); PG8_STAGE(PG8_SA(1, 0), a3, voffA);
            PG8_WAIT_V(8); PG8_WAIT_L(0); PG8_BAR; PG8_MMA(1, 0, At, B0); PG8_MMA(1, 1, At, B1); PG8_BAR; PG8_SCHED;
            } else {
            PG8_LDB(B0, 0, 0); PG8_SCHED; PG8_LDA(At, 0, 0); PG8_STAGE(PG8_SA(1, 1), a1 + hstep, voffA);
            PG8_WAIT_L(8); PG8_BAR; PG8_WAIT_L(0); PG8_MMA(0, 0, At, B0); PG8_BAR; PG8_SCHED;
            PG8_LDB(B1, 0, 1); PG8_STAGE(PG8_SB(0, 0), b2, voffB);
            PG8_BAR; PG8_WAIT_L(0); PG8_MMA(0, 1, At, B1); PG8_BAR;
            PG8_LDA(At, 0, 1); PG8_STAGE(PG8_SA(0, 0), a2, voffA);
            PG8_BAR; PG8_WAIT_L(0); PG8_MMA(1, 0, At, B0); PG8_BAR; PG8_SCHED;
            PG8_STAGE(PG8_SB(0, 1), b2 + hstep, voffB);
            PG8_WAIT_V(6); PG8_BAR; PG8_MMA(1, 1, At, B1); PG8_BAR;
            PG8_LDB(B0, 1, 0); PG8_SCHED; PG8_LDA(At, 1, 0); PG8_STAGE(PG8_SA(0, 1), a2 + hstep, voffA);
            PG8_WAIT_L(8); PG8_BAR; PG8_WAIT_L(0); PG8_MMA(0, 0, At, B0); PG8_BAR; PG8_SCHED;
            PG8_LDB(B1, 1, 1); PG8_STAGE(PG8_SB(1, 0), b3, voffB);
            PG8_BAR; PG8_WAIT_L(0); PG8_MMA(0, 1, At, B1); PG8_BAR;
            PG8_LDA(At, 1, 1); PG8_STAGE(PG8_SA(1, 0), a3, voffA);
            PG8_BAR; PG8_WAIT_L(0); PG8_MMA(1, 0, At, B0); PG8_BAR; PG8_SCHED;
            PG8_STAGE(PG8_SB(1, 1), b3 + hstep, voffB);
            PG8_WAIT_V(6); PG8_BAR; PG8_MMA(1, 1, At, B1); PG8_BAR;
            }
        }
        if constexpr (ALIGN_EPI) { if (wr == 0) PG8_BAR; }
        if constexpr (!Epi::AFTER_DRAIN) { E(acc, cur, wr, wc, fr, fq); S.done(cur); }
        if (!has_next) break;
#pragma unroll
        for (int a = 0; a < 2; ++a)
#pragma unroll
            for (int b = 0; b < 2; ++b)
#pragma unroll
                for (int m = 0; m < 4; ++m)
#pragma unroll
                    for (int n = 0; n < 2; ++n) acc[a][b][m][n] = (f32x4){0.f, 0.f, 0.f, 0.f};
        cur = nxt; cA = nA; cB = nB; ++ui;
        if constexpr (ALIGN_EPI) { if (wr == 1) PG8_BAR; }
    }
    PG8_WAIT_V(0);
    if constexpr (!ALIGN_EPI) { if (wr == 0) PG8_BAR; }
    PG8_BAR;
    if constexpr (Epi::AFTER_DRAIN) { E.fused(acc, cur, wr, wc, fr, fq, lds, wid, lane); S.done(cur); }
#undef PG8_SA
#undef PG8_SB
#undef PG8_STAGE
#undef PG8_LDA
#undef PG8_LDB
#undef PG8_MMA
#undef PG8_WAIT_V
#undef PG8_WAIT_L
#undef PG8_BAR
#undef PG8_SCHED
}
}

constexpr int NB = 32, SEQ = 2048, NMETA = 16, TT = SEQ + NMETA, D = 1024, NL = 4, DFF = 4096;
constexpr int NG = 4, GB = NB / NG, MR = GB * SEQ  , MT = MR + NMETA  ;
constexpr int NCOLS = 9696, NZ = 9728, ZB = 9216, ZFW = 512;
constexpr float EPS = 1e-6f;
constexpr int ZC_GQ = 0, ZC_GK = 512, ZC_GV = 1024, ZC_GR = 2048, ZC_MQ = 3072, ZC_MK = 3584, ZC_MV = 4096, ZC_MO = 5120, ZC_GATE = 6144;
constexpr int ZF_CQ = 0, ZF_CKV = 256, ZF_IK = 384, ZF_A = 448, ZF_IW = 464, ZF_MI = 472, ZF_MF = 476;
constexpr int NQQ = 2560;

constexpr size_t MiB = 1u << 20;
constexpr size_t WS_CTL = 0, CTL_ZERO_BYTES = 1 * MiB;
constexpr size_t WS_BIN = 1 * MiB;
constexpr size_t WS_WIN = 2 * MiB;
constexpr size_t WS_WQQ = 78 * MiB;
constexpr size_t WS_WBG = 83 * MiB;
constexpr size_t WS_WBM = 91 * MiB;
constexpr size_t WS_WBD = 99 * MiB;
constexpr size_t WS_WOUT = 115 * MiB;
constexpr size_t WS_WUP = 123 * MiB;
constexpr size_t WS_WDN = 155 * MiB;
constexpr size_t WS_HM = 187 * MiB;
constexpr size_t WS_XN = 188 * MiB;
constexpr size_t WS_ZF = 221 * MiB;
constexpr size_t WS_CQN = 254 * MiB;
constexpr size_t WS_KV = 263 * MiB;
constexpr size_t WS_KI = 268 * MiB;
constexpr size_t WS_WI = 271 * MiB;
constexpr size_t WS_LIF = 272 * MiB;
constexpr size_t WS_G = 273 * MiB;
constexpr size_t WS_QKC = 306 * MiB;
constexpr size_t WS_QQ = 339 * MiB;
constexpr size_t WS_OG = 420 * MiB;
constexpr size_t WS_OM = 453 * MiB;
constexpr size_t WS_OD = 486 * MiB;
constexpr size_t WS_MIX = 551 * MiB;
constexpr size_t WS_Y = 584 * MiB;
constexpr size_t WS_Z = 649 * MiB;
constexpr size_t WS_END = 938 * MiB;
static_assert(WS_Z + (size_t)MT * ZB * 2 <= WS_END, "ws map");

constexpr int CW_BAR = 4096;

constexpr int RING_BYTES = 131072;
constexpr int MISC_OFF = RING_BYTES + 320;
constexpr int LDS_BYTES = 147456;
constexpr int NWAVES = 8;

#define LAS __attribute__((address_space(3)))
typedef unsigned short bf16;
typedef float f32x4 __attribute__((ext_vector_type(4)));
typedef float f32x2 __attribute__((ext_vector_type(2)));
typedef unsigned u32x4 __attribute__((ext_vector_type(4)));
typedef unsigned u32x2 __attribute__((ext_vector_type(2)));
typedef short bf16x8 __attribute__((ext_vector_type(8)));
#define LDS_WAIT() asm volatile("s_waitcnt lgkmcnt(0)" ::: "memory")
#define VM_WAIT() asm volatile("s_waitcnt vmcnt(0)" ::: "memory")

__device__ __forceinline__ unsigned f2bf(float f) { unsigned u = __builtin_bit_cast(unsigned, f); return (u + 0x7fffu + ((u >> 16) & 1u)) >> 16; }
__device__ __forceinline__ unsigned pk2(float lo, float hi) { return f2bf(lo) | (f2bf(hi) << 16); }
__device__ __forceinline__ float bf2f(unsigned b) { return __builtin_bit_cast(float, b << 16); }
__device__ __forceinline__ float bflo(unsigned w) { return __builtin_bit_cast(float, w << 16); }
__device__ __forceinline__ float bfhi(unsigned w) { return __builtin_bit_cast(float, w & 0xffff0000u); }
__device__ __forceinline__ float wave_sum(float v) {
#pragma unroll
    for (int o = 1; o < 64; o <<= 1) v += __shfl_xor(v, o);
    return v;
}
__device__ __forceinline__ float wave_max(float v) {
#pragma unroll
    for (int o = 1; o < 64; o <<= 1) v = fmaxf(v, __shfl_xor(v, o));
    return v;
}
__device__ __forceinline__ float sigmoid_f(float x) { return 1.f / (1.f + __expf(-x)); }
__device__ __forceinline__ float silu_f(float x) { return x * sigmoid_f(x); }
__device__ __forceinline__ float logsigmoid_f(float x) { return fminf(x, 0.f) - log1pf(__expf(-fabsf(x))); }

#define XB_TMO      128
#define XB_XCNT(j)  (256  + 64 * (j))
#define XB_XSUB(j)  (1280 + 64 * (j))
#define XB_XGEN(j)  (2304 + 64 * (j))
#define XB_TOP      3328
#define XB_TOPGEN   3392
#define XCD_BAR_WORDS 3456
#define XB_SPIN_CAP (1u << 22)

__device__ __forceinline__ unsigned xb_ld(unsigned* p)              { return __hip_atomic_load(p, __ATOMIC_RELAXED, __HIP_MEMORY_SCOPE_AGENT); }
__device__ __forceinline__ unsigned xb_add(unsigned* p, unsigned v) { return __hip_atomic_fetch_add(p, v, __ATOMIC_RELAXED, __HIP_MEMORY_SCOPE_AGENT); }
__device__ __forceinline__ unsigned xb_xcc_id() { return (unsigned)__builtin_amdgcn_s_getreg((3 << 11) | 20) & 0xFu; }
#define XB_SPIN(cond, bar) do { unsigned _sp = 0; while (cond) { __builtin_amdgcn_s_sleep(1); \
    if ((++_sp & 255u) == 0u) { if (xb_ld(&(bar)[XB_TMO])) break; if (_sp > XB_SPIN_CAP) { atomicAdd(&(bar)[XB_TMO], 1u); break; } } } } while (0)

struct XcdBarrier {
    unsigned* bar; unsigned x;
    volatile LAS unsigned* st;
};

__device__ __forceinline__ XcdBarrier xcd_barrier_post(unsigned* bar, volatile LAS unsigned* st) {
    XcdBarrier b; b.bar = bar; b.x = xb_xcc_id(); b.st = st;
    if (threadIdx.x == 0) (void)xb_add(&bar[XB_XCNT(b.x)], 1u);
    return b;
}
__device__ __forceinline__ void xcd_barrier_complete(unsigned* bar, unsigned x, unsigned& nloc, unsigned& nx) {
    const unsigned G = gridDim.x * gridDim.y * gridDim.z;
    unsigned sum, cnt, mine, sp = 0u;
    for (;;) {
        sum = 0u; cnt = 0u; mine = 0u;
#pragma unroll
        for (unsigned j = 0; j < 16; ++j) { const unsigned c = xb_ld(&bar[XB_XCNT(j)]); sum += c; cnt += (c > 0u) ? 1u : 0u; mine = (j == x) ? c : mine; }
        if (sum == G) break;
        __builtin_amdgcn_s_sleep(1);
        if ((++sp & 255u) == 0u) { if (xb_ld(&bar[XB_TMO])) break; if (sp > XB_SPIN_CAP) { atomicAdd(&bar[XB_TMO], 1u); break; } }
    }
    nloc = mine > 0u ? mine : 1u; nx = cnt > 0u ? cnt : 1u;
}

__device__ __forceinline__ void xcd_barrier(const XcdBarrier& b) {
    asm volatile("s_waitcnt vmcnt(0)" ::: "memory");
    __syncthreads();
    if (threadIdx.x == 0) {
        unsigned* bar = b.bar;
        __builtin_amdgcn_s_waitcnt(0);
        unsigned nloc = b.st[0], nx = b.st[1];
        if (nloc == 0u) { xcd_barrier_complete(bar, b.x, nloc, nx); b.st[0] = nloc; b.st[1] = nx; }
        const unsigned old = xb_add(&bar[XB_XSUB(b.x)], 1u);
        const unsigned gen = old / nloc;
        if (old + 1u == (gen + 1u) * nloc) {
            __builtin_amdgcn_fence(__ATOMIC_RELEASE, "agent");
            asm volatile("s_waitcnt vmcnt(0)" ::: "memory");
            const unsigned og = xb_add(&bar[XB_TOP], 1u);
            const unsigned tg = og / nx;
            if (og + 1u == (tg + 1u) * nx) xb_add(&bar[XB_TOPGEN], 1u);
            else XB_SPIN(xb_ld(&bar[XB_TOPGEN]) == tg, bar);
            __builtin_amdgcn_fence(__ATOMIC_ACQUIRE, "agent");
            xb_add(&bar[XB_XGEN(b.x)], 1u);
            asm volatile("s_waitcnt vmcnt(0)" ::: "memory");
        } else {
            XB_SPIN(xb_ld(&bar[XB_XGEN(b.x)]) == gen, bar);
            __builtin_amdgcn_fence(__ATOMIC_ACQUIRE, "agent");
            asm volatile("s_waitcnt vmcnt(0)" ::: "memory");
        }
    }
    __syncthreads();
}


struct Args { const float* in[28]; float* out; unsigned char* ws; int g_lo, g_hi, l_lo, l_hi, ph_lo, ph_hi, prep, use_bar; };
typedef const __attribute__((address_space(4))) Args* ArgsP;
enum { I_X = 0, I_META, I_T5, I_GPREMIX, I_WIN, I_BIN, I_WA2, I_BA, I_GGLA, I_WBRG, I_GDQ, I_WUQ, I_WIQ, I_GDKV, I_WUV, I_LNG, I_LNB, I_WBRD,
       I_CONV, I_FB, I_GML, I_WBRM, I_WOUT, I_GPOSTMIX, I_GPREMLP, I_WUP, I_WDN, I_GPOSTMLP };

__device__ __forceinline__ int win_src(int n) {
    if (n < 3072) return n;
    if (n < 6144) return n - 3072 + 3544;
    if (n < 9216) return n - 6144 + 6624;
    if (n < 9472) return n - 9216 + 3088;
    if (n < 9600) return n - 9472 + 3344;
    if (n < 9664) return n - 9600 + 3472;
    if (n < 9680) return n - 9664 + 3072;
    if (n < 9688) return n - 9680 + 3536;
    if (n < 9692) return n - 9688 + 6616;
    if (n < 9696) return n - 9692 + 6620;
    return -1;
}
struct CmIdent { __device__ __forceinline__ int operator()(int n) const { return n; } };
struct CmWin { __device__ __forceinline__ int operator()(int n) const { return win_src(n); } };

template <class CM>
__device__ __forceinline__ void tr_item(const float* __restrict__ W, int ldw, bf16* __restrict__ WT, int Kd, LAS float* scr, int k0, int ns0, int nd0, int lane, CM cm) {
    const int sc = cm(ns0 + (lane & 31));
#pragma unroll 8
    for (int i = 0; i < 32; ++i) { const int kk = 2 * i + (lane >> 5); scr[kk * 33 + (lane & 31)] = sc >= 0 ? W[(size_t)(k0 + kk) * ldw + sc] : 0.f; }
    LDS_WAIT();
    const int c = lane & 7;
#pragma unroll
    for (int j = 0; j < 4; ++j) { const int n = (lane >> 3) + 8 * j; const LAS float* s = scr + (8 * c) * 33 + n;
        u32x4 o; o.x = pk2(s[0 * 33], s[1 * 33]); o.y = pk2(s[2 * 33], s[3 * 33]); o.z = pk2(s[4 * 33], s[5 * 33]); o.w = pk2(s[6 * 33], s[7 * 33]);
        *(u32x4*)(WT + (size_t)(nd0 + n) * Kd + k0 + 8 * c) = o; }
    LDS_WAIT();
}

__device__ __forceinline__ void prep_weights(ArgsP a, LAS unsigned char* lds, int gw, int ngw, int wave, int lane) {
    LAS float* scr = (LAS float*)(lds + wave * 16384);
    unsigned char* ws = a->ws;
    constexpr int I_WIN_N = 16 * 304, I_UQ = 4 * 64, I_IQ = 4 * 16, I_SQ = 16 * 32, I_UP = 16 * 128, I_DN = 64 * 32, I_WBD = 512, I_B = NZ / 64;
    constexpr int PER_L = I_WIN_N + I_UQ + I_IQ + 3 * I_SQ + I_UP + I_DN + I_WBD + I_B;
    for (int it = gw; it < NL * PER_L; it += ngw) {
        const int l = it / PER_L; int r = it % PER_L;
        if (r < I_WIN_N) { const int kb = r / 304, nb = r % 304;
            tr_item(a->in[I_WIN] + (size_t)l * D * NCOLS, NCOLS, (bf16*)(ws + WS_WIN) + (size_t)l * NZ * D, D, scr, kb * 64, nb * 32, nb * 32, lane, CmWin()); continue; }
        r -= I_WIN_N;
        if (r < I_UQ) { const int kb = r / 64, nb = r % 64;
            tr_item(a->in[I_WUQ] + (size_t)l * 256 * 2048, 2048, (bf16*)(ws + WS_WQQ) + (size_t)l * NQQ * 256, 256, scr, kb * 64, nb * 32, nb * 32, lane, CmIdent()); continue; }
        r -= I_UQ;
        if (r < I_IQ) { const int kb = r / 16, nb = r % 16;
            tr_item(a->in[I_WIQ] + (size_t)l * 256 * 512, 512, (bf16*)(ws + WS_WQQ) + (size_t)l * NQQ * 256, 256, scr, kb * 64, nb * 32, 2048 + nb * 32, lane, CmIdent()); continue; }
        r -= I_IQ;
        if (r < I_SQ) { const int kb = r / 32, nb = r % 32;
            tr_item(a->in[I_WBRG] + (size_t)l * D * D, D, (bf16*)(ws + WS_WBG) + (size_t)l * D * D, D, scr, kb * 64, nb * 32, nb * 32, lane, CmIdent()); continue; }
        r -= I_SQ;
        if (r < I_SQ) { const int kb = r / 32, nb = r % 32;
            tr_item(a->in[I_WBRM] + (size_t)l * D * D, D, (bf16*)(ws + WS_WBM) + (size_t)l * D * D, D, scr, kb * 64, nb * 32, nb * 32, lane, CmIdent()); continue; }
        r -= I_SQ;
        if (r < I_SQ) { const int kb = r / 32, nb = r % 32;
            tr_item(a->in[I_WOUT] + (size_t)l * D * D, D, (bf16*)(ws + WS_WOUT) + (size_t)l * D * D, D, scr, kb * 64, nb * 32, nb * 32, lane, CmIdent()); continue; }
        r -= I_SQ;
        if (r < I_UP) { const int kb = r / 128, nb = r % 128;
            tr_item(a->in[I_WUP] + (size_t)l * D * DFF, DFF, (bf16*)(ws + WS_WUP) + (size_t)l * DFF * D, D, scr, kb * 64, nb * 32, nb * 32, lane, CmIdent()); continue; }
        r -= I_UP;
        if (r < I_DN) { const int kb = r / 32, nb = r % 32;
            tr_item(a->in[I_WDN] + (size_t)l * DFF * D, D, (bf16*)(ws + WS_WDN) + (size_t)l * D * DFF, DFF, scr, kb * 64, nb * 32, nb * 32, lane, CmIdent()); continue; }
        r -= I_DN;
        if (r < I_WBD) {
            const int h = r >> 5, ch = (r >> 4) & 1, nb = r & 15, c = ch * 64 + lane;
            const float* uv = a->in[I_WUV] + ((size_t)(l * 16 + h) * 128 + c) * 64;
            const float* wb = a->in[I_WBRD] + ((size_t)l * D + h * 64) * D + nb * 64;
            bf16* o = (bf16*)(ws + WS_WBD) + (size_t)l * D * 2048 + (size_t)(nb * 64) * 2048 + h * 128 + c;
            f32x4 w[16];
#pragma unroll
            for (int i = 0; i < 16; ++i) w[i] = *(const f32x4*)(uv + 4 * i);
            for (int nn = 0; nn < 64; ++nn) {
                float acc = 0.f;
#pragma unroll
                for (int i = 0; i < 16; ++i) { acc += w[i].x * wb[(size_t)(4 * i + 0) * D + nn] + w[i].y * wb[(size_t)(4 * i + 1) * D + nn] + w[i].z * wb[(size_t)(4 * i + 2) * D + nn] + w[i].w * wb[(size_t)(4 * i + 3) * D + nn]; }
                o[(size_t)nn * 2048] = (bf16)f2bf(acc);
            }
            continue; }
        r -= I_WBD;
        { const int n = r * 64 + lane; const int sc = win_src(n);
          ((float*)(ws + WS_BIN))[l * NZ + n] = sc >= 0 ? a->in[I_BIN][l * NCOLS + sc] : 0.f; }
    }
}

__device__ __forceinline__ float* hrow(ArgsP a, int g, int r) {
    return r < MR ? a->out + ((size_t)g * MR + r) * D : (float*)(a->ws + WS_HM) + (size_t)(r - MR) * D;
}
__device__ __forceinline__ void rms_row_bf16(const f32x4 (&v)[4], const float* __restrict__ gain, bf16* __restrict__ orow, int lane) {
    float s = 0.f;
#pragma unroll
    for (int j = 0; j < 4; ++j) s += (v[j].x * v[j].x + v[j].y * v[j].y) + (v[j].z * v[j].z + v[j].w * v[j].w);
    const float r = rsqrtf(wave_sum(s) * (1.f / D) + EPS);
#pragma unroll
    for (int j = 0; j < 4; ++j) { const f32x4 gg = *(const f32x4*)(gain + 4 * lane + 256 * j); const f32x4 o = v[j] * r * gg;
        u32x2 w; w.x = pk2(o.x, o.y); w.y = pk2(o.z, o.w); *(u32x2*)(orow + 4 * lane + 256 * j) = w; }
}
__device__ __forceinline__ void p0_init(ArgsP a, int g, int gw, int ngw, int lane) {
    bf16* XN = (bf16*)(a->ws + WS_XN);
    for (int r = gw; r < MT; r += ngw) {
        const float* src = r < MR ? a->in[I_X] + ((size_t)g * MR + r) * D : a->in[I_META] + (size_t)(r - MR) * D;
        float* hd = hrow(a, g, r);
        f32x4 v[4];
#pragma unroll
        for (int j = 0; j < 4; ++j) { v[j] = *(const f32x4*)(src + 4 * lane + 256 * j); *(f32x4*)(hd + 4 * lane + 256 * j) = v[j]; }
        rms_row_bf16(v, a->in[I_GPREMIX], XN + (size_t)r * D, lane);
    }
}
__device__ __forceinline__ void p_norm_res(ArgsP a, int g, const float* gpost, const float* gpre, int gw, int ngw, int lane) {
    bf16* XN = (bf16*)(a->ws + WS_XN); const float* Y = (const float*)(a->ws + WS_Y);
    for (int r = gw; r < MT; r += ngw) {
        float* hd = hrow(a, g, r);
        f32x4 y[4], v[4]; float s = 0.f;
#pragma unroll
        for (int j = 0; j < 4; ++j) { y[j] = *(const f32x4*)(Y + (size_t)r * D + 4 * lane + 256 * j); v[j] = *(const f32x4*)(hd + 4 * lane + 256 * j);
            s += (y[j].x * y[j].x + y[j].y * y[j].y) + (y[j].z * y[j].z + y[j].w * y[j].w); }
        const float rr = rsqrtf(wave_sum(s) * (1.f / D) + EPS);
#pragma unroll
        for (int j = 0; j < 4; ++j) { const f32x4 gg = *(const f32x4*)(gpost + 4 * lane + 256 * j); v[j] = v[j] + y[j] * rr * gg; *(f32x4*)(hd + 4 * lane + 256 * j) = v[j]; }
        if (gpre) rms_row_bf16(v, gpre, XN + (size_t)r * D, lane);
    }
}

template <class F> struct EpiT {
    static constexpr bool PERM = true, AFTER_DRAIN = false;
    F f;
    __device__ __forceinline__ void operator()(const f32x4 (&acc)[2][2][4][2], const pg8::Unit& u, int wr, int wc, int fr, int fq) const {
        const int row0 = u.pm * 256 + wr * 64 + fr, col0 = u.pn * 256 + wc * 32 + 8 * fq;
#pragma unroll
        for (int ai = 0; ai < 2; ++ai)
#pragma unroll
            for (int m = 0; m < 4; ++m)
#pragma unroll
                for (int bj = 0; bj < 2; ++bj) { f.apply(row0 + ai * 128 + m * 16, col0 + bj * 128, acc[ai][bj][m][0], acc[ai][bj][m][1]); asm volatile("" ::: "memory"); }
    }
};
__device__ __forceinline__ void st_bf16x8(bf16* p, f32x4 v0, f32x4 v1) { u32x4 w; w.x = pk2(v0.x, v0.y); w.y = pk2(v0.z, v0.w); w.z = pk2(v1.x, v1.y); w.w = pk2(v1.z, v1.w); *(u32x4*)p = w; }
__device__ __forceinline__ void ld_bf16x8(const bf16* p, f32x4& v0, f32x4& v1) { const u32x4 w = *(const u32x4*)p;
    v0 = (f32x4){bflo(w.x), bfhi(w.x), bflo(w.y), bfhi(w.y)}; v1 = (f32x4){bflo(w.z), bfhi(w.z), bflo(w.w), bfhi(w.w)}; }

struct FIn {
    bf16* Z; float* ZF; const float* bias;
    __device__ __forceinline__ void apply(int row, int col, f32x4 v0, f32x4 v1) const {
        v0 += *(const f32x4*)(bias + col); v1 += *(const f32x4*)(bias + col + 4);
        const int t = col >> 8;
        if (t >= 36) { float* p = ZF + (size_t)row * ZFW + (col - ZB); *(f32x4*)p = v0; *(f32x4*)(p + 4) = v1; return; }
        if (t < 2) { v0 *= 0.08838834764831845f; v1 *= 0.08838834764831845f; }
        else if (t >= 8 && t < 12) {
#pragma unroll
            for (int i = 0; i < 4; ++i) { v0[i] = silu_f(v0[i]); v1[i] = silu_f(v1[i]); } }
        else if (t >= 20) {
#pragma unroll
            for (int i = 0; i < 4; ++i) { v0[i] = sigmoid_f(v0[i]); v1[i] = sigmoid_f(v1[i]); } }
        st_bf16x8(Z + (size_t)row * ZB + col, v0, v1);
    }
};
struct FQQ {
    bf16* QQ;
    __device__ __forceinline__ void apply(int row, int col, f32x4 v0, f32x4 v1) const {
        const float s = col < 2048 ? 0.08838834764831845f : 0.125f;
        st_bf16x8(QQ + (size_t)row * NQQ + col, v0 * s, v1 * s);
    }
};
template <int IDX> struct FBr {
    const bf16* Z; float* Y; bf16* MIX;
    __device__ __forceinline__ void apply(int row, int col, f32x4 v0, f32x4 v1) const {
        f32x4 g0, g1; ld_bf16x8(Z + (size_t)row * ZB + ZC_GATE + IDX * 1024 + col, g0, g1);
        float* y = Y + (size_t)row * D + col;
        f32x4 a0 = v0 * g0, a1 = v1 * g1;
        if (IDX > 0) { a0 += *(const f32x4*)y; a1 += *(const f32x4*)(y + 4); }
        if (IDX < 2) { *(f32x4*)y = a0; *(f32x4*)(y + 4) = a1; }
        else st_bf16x8(MIX + (size_t)row * D + col, a0, a1);
    }
};
struct FY {
    float* Y;
    __device__ __forceinline__ void apply(int row, int col, f32x4 v0, f32x4 v1) const { float* y = Y + (size_t)row * D + col; *(f32x4*)y = v0; *(f32x4*)(y + 4) = v1; }
};
struct FUp {
    bf16* U;
    __device__ __forceinline__ void apply(int row, int col, f32x4 v0, f32x4 v1) const {
#pragma unroll
        for (int i = 0; i < 4; ++i) { const float p = fmaxf(v0[i], 0.f), q = fmaxf(v1[i], 0.f); v0[i] = p * p; v1[i] = q * q; }
        st_bf16x8(U + (size_t)row * DFF + col, v0, v1);
    }
};

template <class F>
__device__ __forceinline__ void mini_gemm(const bf16* __restrict__ A, const bf16* __restrict__ Bt, int N, int K, const F& f, int gw, int ngw, int lane) {
    const int fr = lane & 15, fq = lane >> 4;
    for (int wt = gw; wt < N / 32; wt += ngw) {
        const int n0 = wt * 32;
        f32x4 acc0 = {0.f, 0.f, 0.f, 0.f}, acc1 = {0.f, 0.f, 0.f, 0.f};
        const bf16* ap = A + (size_t)(MR + fr) * K + fq * 8;
        const bf16* b0 = Bt + (size_t)(n0 + pg8::perm32(fr)) * K + fq * 8;
        const bf16* b1 = Bt + (size_t)(n0 + pg8::perm32(16 + fr)) * K + fq * 8;
        for (int k = 0; k < K; k += 32) {
            const bf16x8 av = *(const bf16x8*)(ap + k), w0 = *(const bf16x8*)(b0 + k), w1 = *(const bf16x8*)(b1 + k);
            acc0 = __builtin_amdgcn_mfma_f32_16x16x32_bf16(w0, av, acc0, 0, 0, 0);
            acc1 = __builtin_amdgcn_mfma_f32_16x16x32_bf16(w1, av, acc1, 0, 0, 0);
        }
        f.apply(MR + fr, n0 + 8 * fq, acc0, acc1);
    }
}
template <class F>
__device__ __forceinline__ void run_gemm(LAS unsigned char* lds, const bf16* A, const bf16* Bt, int N, int K, const F& f, int gw, int ngw, int lane) {
    asm volatile("" : "+s"(K)); asm volatile("" : "+s"(N));
    pg8::Gemm g{A, Bt, MR, N, K}; pg8::StaticOrder S; S.init(MR, N, (int)gridDim.x, (int)blockIdx.x);
    EpiT<F> E{f};
    pg8::gemm_phase<EpiT<F>, pg8::StaticOrder, true, true>((PG8_LAS unsigned char*)lds, g, S, E);
    mini_gemm(A, Bt, N, K, f, gw, ngw, lane);
}

__device__ __forceinline__ int prow(int r, int j) {
    if (r < MR) { const int s = r & (SEQ - 1); return (s - j >= 0) ? r - j : MR + (NMETA + s - j); }
    const int t = r - MR; return (t - j >= 0) ? r - j : -1;
}
__device__ __forceinline__ void p2_prep(ArgsP a, int l, int gw, int ngw, int lane) {
    unsigned char* ws = a->ws;
    const bf16* Z = (const bf16*)(ws + WS_Z);
    for (int r = gw; r < MT; r += ngw) {
        const float* zf = (const float*)(ws + WS_ZF) + (size_t)r * ZFW;
        {
            f32x4 v = *(const f32x4*)(zf + ZF_CQ + 4 * lane);
            const float rr = rsqrtf(wave_sum((v.x * v.x + v.y * v.y) + (v.z * v.z + v.w * v.w)) * (1.f / 256.f) + EPS);
            const f32x4 gg = *(const f32x4*)(a->in[I_GDQ] + l * 256 + 4 * lane); v = v * rr * gg;
            u32x2 w; w.x = pk2(v.x, v.y); w.y = pk2(v.z, v.w); *(u32x2*)((bf16*)(ws + WS_CQN) + (size_t)r * 256 + 4 * lane) = w;
        }
        {
            f32x2 v = *(const f32x2*)(zf + ZF_CKV + 2 * lane);
            const float rr = rsqrtf(wave_sum(v.x * v.x + v.y * v.y) * (1.f / 128.f) + EPS);
            const f32x2 gg = *(const f32x2*)(a->in[I_GDKV] + l * 128 + 2 * lane);
            *(unsigned*)((bf16*)(ws + WS_KV) + (size_t)r * 128 + 2 * lane) = pk2(v.x * rr * gg.x, v.y * rr * gg.y);
        }
        {
            const float v = zf[ZF_IK + lane]; const float mu = wave_sum(v) * (1.f / 64.f); const float d = v - mu;
            const float var = wave_sum(d * d) * (1.f / 64.f);
            const float y = d * rsqrtf(var + EPS) * a->in[I_LNG][l * 64 + lane] + a->in[I_LNB][l * 64 + lane];
            ((bf16*)(ws + WS_KI))[(size_t)r * 64 + lane] = (bf16)f2bf(y);
        }
        if (lane < 8) ((float*)(ws + WS_WI))[(size_t)r * 8 + lane] = zf[ZF_IW + lane] * 0.35355339059327373f;
        if (lane < 4) ((float*)(ws + WS_LIF))[(size_t)r * 8 + lane] = zf[ZF_MI + lane];
        else if (lane < 8) ((float*)(ws + WS_LIF))[(size_t)r * 8 + lane] = logsigmoid_f(zf[ZF_MF + lane - 4] + a->in[I_FB][l * 4 + lane - 4]);
        {
            f32x4 av[4];
#pragma unroll
            for (int i = 0; i < 4; ++i) av[i] = *(const f32x4*)(zf + ZF_A + 4 * i);
            const int c = 8 * lane;
            f32x4 s0 = *(const f32x4*)(a->in[I_BA] + l * 512 + c), s1 = *(const f32x4*)(a->in[I_BA] + l * 512 + c + 4);
#pragma unroll
            for (int j = 0; j < 16; ++j) { const float aj = av[j >> 2][j & 3]; const float* wp = a->in[I_WA2] + (size_t)(l * 16 + j) * 512 + c;
                s0 += aj * *(const f32x4*)wp; s1 += aj * *(const f32x4*)(wp + 4); }
#pragma unroll
            for (int i = 0; i < 4; ++i) { s0[i] = logsigmoid_f(s0[i]) * 0.0625f; s1[i] = logsigmoid_f(s1[i]) * 0.0625f; }
            float* gp = (float*)(ws + WS_G) + (size_t)r * 512 + c; *(f32x4*)gp = s0; *(f32x4*)(gp + 4) = s1;
        }
        {
            const int c = 16 * lane;
            f32x4 acc[4];
#pragma unroll
            for (int i = 0; i < 4; ++i) acc[i] = (f32x4){0.f, 0.f, 0.f, 0.f};
#pragma unroll
            for (int tap = 0; tap < 4; ++tap) {
                const int rt = tap == 3 ? r : prow(r, 3 - tap);
                if (rt >= 0) {
                    f32x4 x0, x1, x2, x3; ld_bf16x8(Z + (size_t)rt * ZB + ZC_MQ + c, x0, x1); ld_bf16x8(Z + (size_t)rt * ZB + ZC_MQ + c + 8, x2, x3);
                    const float* wp = a->in[I_CONV] + (size_t)(l * 4 + tap) * 1024 + c;
                    acc[0] += x0 * *(const f32x4*)wp; acc[1] += x1 * *(const f32x4*)(wp + 4); acc[2] += x2 * *(const f32x4*)(wp + 8); acc[3] += x3 * *(const f32x4*)(wp + 12);
                }
            }
            const float sc = c < 512 ? 0.08838834764831845f : 1.f;
#pragma unroll
            for (int i = 0; i < 4; ++i)
#pragma unroll
                for (int e = 0; e < 4; ++e) acc[i][e] = silu_f(acc[i][e]) * sc;
            bf16* qp = (bf16*)(ws + WS_QKC) + (size_t)r * 1024 + c; st_bf16x8(qp, acc[0], acc[1]); st_bf16x8(qp + 8, acc[2], acc[3]);
        }
    }
}

template <bool ML>
__device__ __forceinline__ void scan_unit(ArgsP a, LAS unsigned char* lds, int b, int h, int vs, int tid) {
    unsigned char* ws = a->ws;
    const bf16* Z = (const bf16*)(ws + WS_Z); const bf16* QKC = (const bf16*)(ws + WS_QKC);
    const float* G = (const float*)(ws + WS_G); const float* LIF = (const float*)(ws + WS_LIF);
    bf16* O = (bf16*)(ws + (ML ? WS_OM : WS_OG));
    LAS float* qs = (LAS float*)lds; LAS float* ks = qs + 2048; LAS float* ds = ks + 2048; LAS float* vsm = ds + 2048; LAS float* fi = vsm + 1024;
    const int kg = tid & 7, v = tid >> 3;
    const int stt = tid >> 5, sc4 = (tid & 31) * 4, sv2 = (tid & 31) * 2;
    float S[16], nn[16];
#pragma unroll
    for (int j = 0; j < 16; ++j) { S[j] = 0.f; nn[j] = 0.f; }
    for (int blk = 0; blk < TT / 16; ++blk) {
        const int row0 = blk == 0 ? MR : b * SEQ + (blk - 1) * 16;
        __syncthreads();
        {
            const int row = row0 + stt;
            u32x2 qw, kw;
            if (ML) { qw = *(const u32x2*)(QKC + (size_t)row * 1024 + h * 128 + sc4); kw = *(const u32x2*)(QKC + (size_t)row * 1024 + 512 + h * 128 + sc4); }
            else { qw = *(const u32x2*)(Z + (size_t)row * ZB + ZC_GQ + h * 128 + sc4); kw = *(const u32x2*)(Z + (size_t)row * ZB + ZC_GK + h * 128 + sc4); }
            *(LAS f32x4*)(qs + stt * 128 + sc4) = (f32x4){bflo(qw.x), bfhi(qw.x), bflo(qw.y), bfhi(qw.y)};
            *(LAS f32x4*)(ks + stt * 128 + sc4) = (f32x4){bflo(kw.x), bfhi(kw.x), bflo(kw.y), bfhi(kw.y)};
            if (!ML) { f32x4 gv = *(const f32x4*)(G + (size_t)row * 512 + h * 128 + sc4);
                *(LAS f32x4*)(ds + stt * 128 + sc4) = (f32x4){__expf(gv.x), __expf(gv.y), __expf(gv.z), __expf(gv.w)}; }
            const unsigned vw = *(const unsigned*)(Z + (size_t)row * ZB + (ML ? ZC_MV : ZC_GV) + h * 256 + vs * 64 + sv2);
            *(LAS f32x2*)(vsm + stt * 64 + sv2) = (f32x2){bflo(vw), bfhi(vw)};
            if (ML && tid < 16) { const int rw = row0 + tid; fi[2 * tid] = __expf(LIF[(size_t)rw * 8 + 4 + h]); fi[2 * tid + 1] = __expf(LIF[(size_t)rw * 8 + h]); }
        }
        __syncthreads();
        for (int tt = 0; tt < 16; ++tt) {
            float q[16], k[16], d[16];
#pragma unroll
            for (int i = 0; i < 4; ++i) { const f32x4 t4 = *(const LAS f32x4*)(qs + tt * 128 + 16 * kg + 4 * i); q[4 * i] = t4.x; q[4 * i + 1] = t4.y; q[4 * i + 2] = t4.z; q[4 * i + 3] = t4.w; }
#pragma unroll
            for (int i = 0; i < 4; ++i) { const f32x4 t4 = *(const LAS f32x4*)(ks + tt * 128 + 16 * kg + 4 * i); k[4 * i] = t4.x; k[4 * i + 1] = t4.y; k[4 * i + 2] = t4.z; k[4 * i + 3] = t4.w; }
            const float vv = vsm[tt * 64 + v];
            float num = 0.f, den = 0.f;
            if (ML) {
                const float f = fi[2 * tt], ii = fi[2 * tt + 1];
#pragma unroll
                for (int j = 0; j < 16; ++j) { const float ik = ii * k[j]; S[j] = f * S[j] + ik * vv; nn[j] = f * nn[j] + ik; num += q[j] * S[j]; den += q[j] * nn[j]; }
            } else {
#pragma unroll
                for (int i = 0; i < 4; ++i) { const f32x4 t4 = *(const LAS f32x4*)(ds + tt * 128 + 16 * kg + 4 * i); d[4 * i] = t4.x; d[4 * i + 1] = t4.y; d[4 * i + 2] = t4.z; d[4 * i + 3] = t4.w; }
#pragma unroll
                for (int j = 0; j < 16; ++j) { S[j] = d[j] * S[j] + k[j] * vv; num += q[j] * S[j]; }
            }
            num += __shfl_xor(num, 1); num += __shfl_xor(num, 2); num += __shfl_xor(num, 4);
            if (ML) { den += __shfl_xor(den, 1); den += __shfl_xor(den, 2); den += __shfl_xor(den, 4); num = num / fmaxf(fabsf(den), 1.f); }
            if (kg == 0) O[(size_t)(row0 + tt) * 1024 + h * 256 + vs * 64 + v] = (bf16)f2bf(num);
        }
    }
}

__device__ __forceinline__ void p6_headnorm(ArgsP a, int l, int gw, int ngw, int lane) {
    unsigned char* ws = a->ws; const bf16* Z = (const bf16*)(ws + WS_Z);
    for (int it = gw; it < MT * 8; it += ngw) {
        const int r = it >> 3, mx = (it >> 2) & 1, h = it & 3;
        bf16* op = (bf16*)(ws + (mx ? WS_OM : WS_OG)) + (size_t)r * 1024 + h * 256 + 4 * lane;
        const u32x2 w = *(const u32x2*)op; f32x4 v = {bflo(w.x), bfhi(w.x), bflo(w.y), bfhi(w.y)};
        const float rr = rsqrtf(wave_sum((v.x * v.x + v.y * v.y) + (v.z * v.z + v.w * v.w)) * (1.f / 256.f) + EPS);
        const f32x4 gg = *(const f32x4*)(a->in[mx ? I_GML : I_GGLA] + l * 256 + 4 * lane);
        const u32x2 gw2 = *(const u32x2*)(Z + (size_t)r * ZB + (mx ? ZC_MO : ZC_GR) + h * 256 + 4 * lane);
        const f32x4 gt = {bflo(gw2.x), bfhi(gw2.x), bflo(gw2.y), bfhi(gw2.y)};
        v = v * rr * gg * gt;
        u32x2 o; o.x = pk2(v.x, v.y); o.y = pk2(v.z, v.w); *(u32x2*)op = o;
    }
}

__device__ __forceinline__ int krow(int b, int s) { return s < NMETA ? MR + s : b * SEQ + (s - NMETA); }
__device__ __forceinline__ int wave_sum_i(int v) {
#pragma unroll
    for (int o = 1; o < 64; o <<= 1) v += __shfl_xor(v, o);
    return v;
}
__device__ __forceinline__ int t5_bucket(int n) {
    if (n < 16) return n < 0 ? 0 : n;
    const int lg = 16 + (int)(__logf((float)n * (1.f / 16.f)) / 2.0794415416798357f * 16.f);
    return lg < 31 ? lg : 31;
}
constexpr int DW_STRIDE = 15360, DW_SC = 0, DW_Q = 8448, DW_QI = 12544, DW_SEL = 14592, DSA_T5 = 8 * DW_STRIDE;

__device__ __forceinline__ void dsa_query(ArgsP a, LAS unsigned char* wl, const LAS float* t5L, int qrow, int b, int p, int lane_in) {
    int lane = lane_in; asm volatile("" : "+v"(lane));
    unsigned char* ws = a->ws;
    const bf16* QQ = (const bf16*)(ws + WS_QQ) + (size_t)qrow * NQQ;
    const bf16* KI = (const bf16*)(ws + WS_KI); const bf16* KV = (const bf16*)(ws + WS_KV);
    LAS float* scL = (LAS float*)(wl + DW_SC); LAS bf16* PL = (LAS bf16*)(wl + DW_SC);
    LAS bf16* qL = (LAS bf16*)(wl + DW_Q); LAS float* qiL = (LAS float*)(wl + DW_QI); LAS unsigned short* selL = (LAS unsigned short*)(wl + DW_SEL);
#pragma unroll
    for (int i = 0; i < 4; ++i) *(LAS u32x4*)(qL + (i * 64 + lane) * 8) = *(const u32x4*)(QQ + (i * 64 + lane) * 8);
    { f32x4 v0, v1; ld_bf16x8(QQ + 2048 + lane * 8, v0, v1); *(LAS f32x4*)(qiL + lane * 8) = v0; *(LAS f32x4*)(qiL + lane * 8 + 4) = v1; }
    float wi[8];
    { const f32x4 w0 = *(const f32x4*)((const float*)(ws + WS_WI) + (size_t)qrow * 8), w1 = *(const f32x4*)((const float*)(ws + WS_WI) + (size_t)qrow * 8 + 4);
      wi[0] = w0.x; wi[1] = w0.y; wi[2] = w0.z; wi[3] = w0.w; wi[4] = w1.x; wi[5] = w1.y; wi[6] = w1.z; wi[7] = w1.w; }
    LDS_WAIT();
    const int nk = p + 1;
    int nsel;
    if (nk > 256) {
        const int nsteps = (nk + 63) >> 6;
        for (int i = 0; i < nsteps; ++i) {
            const int s = lane + 64 * i; float sc = -INFINITY;
            if (s < nk) {
                const u32x4* kp = (const u32x4*)(KI + (size_t)krow(b, s) * 64);
                u32x4 kk[8];
#pragma unroll
                for (int d8 = 0; d8 < 8; ++d8) kk[d8] = kp[d8];
                float acc[8];
#pragma unroll
                for (int h = 0; h < 8; ++h) acc[h] = 0.f;
#pragma unroll
                for (int d8 = 0; d8 < 8; ++d8) {
                    const float k0 = bflo(kk[d8].x), k1 = bfhi(kk[d8].x), k2 = bflo(kk[d8].y), k3 = bfhi(kk[d8].y), k4 = bflo(kk[d8].z), k5 = bfhi(kk[d8].z), k6 = bflo(kk[d8].w), k7 = bfhi(kk[d8].w);
#pragma unroll
                    for (int h = 0; h < 8; ++h) { const f32x4 q0 = *(const LAS f32x4*)(qiL + h * 64 + d8 * 8), q1 = *(const LAS f32x4*)(qiL + h * 64 + d8 * 8 + 4);
                        acc[h] += (q0.x * k0 + q0.y * k1) + (q0.z * k2 + q0.w * k3) + (q1.x * k4 + q1.y * k5) + (q1.z * k6 + q1.w * k7); }
                    asm volatile("" ::: "memory");
                }
                sc = 0.f;
#pragma unroll
                for (int h = 0; h < 8; ++h) sc += wi[h] * fmaxf(acc[h], 0.f);
            }
            scL[s] = sc;
        }
        LDS_WAIT();
        unsigned u[33];
#pragma unroll
        for (int i = 0; i < 33; ++i) { const int s = lane + 64 * i; unsigned key = 0u;
            if (s < nk) { const unsigned bits = __builtin_bit_cast(unsigned, scL[s]); key = bits ^ ((bits >> 31) ? 0xffffffffu : 0x80000000u); }
            u[i] = key; }
        unsigned prefix = 0u; int rem = 256;
        for (int bit = 31; bit >= 0; --bit) {
            const unsigned cand = prefix | (1u << bit), msk = ~((1u << bit) - 1u);
            int cnt = 0;
#pragma unroll
            for (int i = 0; i < 33; ++i) cnt += ((u[i] & msk) == cand) ? 1 : 0;
            cnt = wave_sum_i(cnt);
            if (cnt >= rem) prefix = cand; else rem -= cnt;
        }
        const unsigned long long lt = (1ull << lane) - 1ull;
        int base = 0, eqseen = 0;
#pragma unroll
        for (int i = 0; i < 33; ++i) {
            const bool gt = u[i] > prefix, eq = u[i] == prefix;
            const unsigned long long meq = __ballot(eq);
            const bool take = gt || (eq && (eqseen + __popcll(meq & lt)) < rem);
            const unsigned long long mt = __ballot(take);
            if (take) selL[base + __popcll(mt & lt)] = (unsigned short)(lane + 64 * i);
            base += __popcll(mt); eqseen += __popcll(meq);
        }
        nsel = 256;
    } else {
#pragma unroll
        for (int m = 0; m < 4; ++m) selL[lane + 64 * m] = (unsigned short)(lane + 64 * m);
        nsel = nk;
    }
    LDS_WAIT();
    asm volatile("" : "+v"(lane));
    int idx[4];
#pragma unroll
    for (int m = 0; m < 4; ++m) { const int j = lane + 64 * m; idx[m] = j < nsel ? (int)selL[j] : 0; }
    const u32x4* kp0 = (const u32x4*)(KV + (size_t)krow(b, idx[0]) * 128); const u32x4* kp1 = (const u32x4*)(KV + (size_t)krow(b, idx[1]) * 128);
    const u32x4* kp2 = (const u32x4*)(KV + (size_t)krow(b, idx[2]) * 128); const u32x4* kp3 = (const u32x4*)(KV + (size_t)krow(b, idx[3]) * 128);
    int bk[4];
#pragma unroll
    for (int m = 0; m < 4; ++m) bk[m] = t5_bucket(p - idx[m]) * 16;
    for (int hh = 0; hh < 2; ++hh) {
        float lg[8][4];
#pragma unroll
        for (int h = 0; h < 8; ++h)
#pragma unroll
            for (int m = 0; m < 4; ++m) lg[h][m] = 0.f;
        for (int d8 = 0; d8 < 16; ++d8) {
            u32x4 kw[4]; kw[0] = kp0[d8]; kw[1] = kp1[d8]; kw[2] = kp2[d8]; kw[3] = kp3[d8];
#pragma unroll
            for (int m = 0; m < 4; ++m) {
                const float k0 = bflo(kw[m].x), k1 = bfhi(kw[m].x), k2 = bflo(kw[m].y), k3 = bfhi(kw[m].y), k4 = bflo(kw[m].z), k5 = bfhi(kw[m].z), k6 = bflo(kw[m].w), k7 = bfhi(kw[m].w);
#pragma unroll
                for (int h = 0; h < 8; ++h) {
                    const u32x4 qw = *(const LAS u32x4*)(qL + (hh * 8 + h) * 128 + d8 * 8);
                    lg[h][m] += (bflo(qw.x) * k0 + bfhi(qw.x) * k1) + (bflo(qw.y) * k2 + bfhi(qw.y) * k3) + (bflo(qw.z) * k4 + bfhi(qw.z) * k5) + (bflo(qw.w) * k6 + bfhi(qw.w) * k7);
                    if ((h & 3) == 3) asm volatile("" ::: "memory");
                }
            }
        }
#pragma unroll
        for (int h = 0; h < 8; ++h) {
            float mx = -INFINITY;
#pragma unroll
            for (int m = 0; m < 4; ++m) { const bool ok = (lane + 64 * m) < nsel; lg[h][m] = ok ? lg[h][m] + t5L[bk[m] + hh * 8 + h] : -INFINITY; mx = fmaxf(mx, lg[h][m]); }
            mx = wave_max(mx);
            float sm = 0.f;
#pragma unroll
            for (int m = 0; m < 4; ++m) { lg[h][m] = __expf(lg[h][m] - mx); sm += lg[h][m]; }
            sm = 1.f / wave_sum(sm);
#pragma unroll
            for (int m = 0; m < 4; ++m) lg[h][m] *= sm;
        }
#pragma unroll
        for (int m = 0; m < 4; ++m) {
            u32x4 w0;
            w0.x = pk2(lg[0][m], lg[1][m]); w0.y = pk2(lg[2][m], lg[3][m]); w0.z = pk2(lg[4][m], lg[5][m]); w0.w = pk2(lg[6][m], lg[7][m]);
            *(LAS u32x4*)(PL + (lane + 64 * m) * 16 + hh * 8) = w0;
        }
    }
    LDS_WAIT();
    asm volatile("" : "+v"(lane));
    float o0[16], o1[16];
#pragma unroll
    for (int h = 0; h < 16; ++h) { o0[h] = 0.f; o1[h] = 0.f; }
    for (int j0 = 0; j0 < nsel; j0 += 4) {
        unsigned kvw[4]; u32x4 pa[4], pb[4];
#pragma unroll
        for (int e = 0; e < 4; ++e) { const int j = j0 + e; const bool ok = j < nsel; const int id = ok ? (int)selL[j] : 0;
            kvw[e] = ok ? *(const unsigned*)(KV + (size_t)krow(b, id) * 128 + 2 * lane) : 0u;
            pa[e] = *(const LAS u32x4*)(PL + (ok ? j : 0) * 16); pb[e] = *(const LAS u32x4*)(PL + (ok ? j : 0) * 16 + 8); }
#pragma unroll
        for (int e = 0; e < 4; ++e) {
            const float lo = bflo(kvw[e]), hi = bfhi(kvw[e]);
            const unsigned pw[8] = {pa[e].x, pa[e].y, pa[e].z, pa[e].w, pb[e].x, pb[e].y, pb[e].z, pb[e].w};
#pragma unroll
            for (int hh = 0; hh < 8; ++hh) { const float p0 = bflo(pw[hh]), p1 = bfhi(pw[hh]);
                o0[2 * hh] += p0 * lo; o1[2 * hh] += p0 * hi; o0[2 * hh + 1] += p1 * lo; o1[2 * hh + 1] += p1 * hi; }
        }
    }
    bf16* od = (bf16*)(ws + WS_OD) + (size_t)qrow * 2048 + 2 * lane;
#pragma unroll
    for (int h = 0; h < 16; ++h) *(unsigned*)(od + h * 128) = pk2(o0[h], o1[h]);
    LDS_WAIT();
}
__device__ __forceinline__ void p5_dsa(ArgsP a, LAS unsigned char* lds, int tid, int wave, int lane) {
    LAS float* t5L = (LAS float*)(lds + DSA_T5);
    __syncthreads();
    t5L[tid] = a->in[I_T5][tid];
    __syncthreads();
    LAS unsigned char* wl = lds + wave * DW_STRIDE;
    for (int u = blockIdx.x; u < MT / 8; u += gridDim.x) {
        const int q = u * 8 + wave;
        int b, p;
        if (q < MR) { b = q >> 11; p = NMETA + (q & (SEQ - 1)); } else { b = 0; p = q - MR; }
        dsa_query(a, wl, t5L, q, b, p, lane);
    }
}

__global__ void __launch_bounds__(NWAVES * 64, 2) fwd(Args a_) {
    extern __shared__ __attribute__((aligned(16))) unsigned char lds_raw[];
    LAS unsigned char* lds = (LAS unsigned char*)lds_raw;
    volatile LAS unsigned* MISC = (volatile LAS unsigned*)(lds + MISC_OFF);
    if (threadIdx.x < 32) MISC[threadIdx.x] = 0u;
    __syncthreads();
    const int g_lo = a_.g_lo, g_hi = a_.g_hi, l_lo = a_.l_lo, l_hi = a_.l_hi, ph_lo = a_.ph_lo, ph_hi = a_.ph_hi, use_bar = a_.use_bar;
    XcdBarrier bar; bar.bar = (unsigned*)(a_.ws + WS_CTL) + CW_BAR; bar.x = 0; bar.st = nullptr;
    if (use_bar) bar = xcd_barrier_post((unsigned*)(a_.ws + WS_CTL) + CW_BAR, MISC + 8);
#define GRID_BAR() do { if (use_bar) xcd_barrier(bar); } while (0)
#ifndef PHMASK
#define PHMASK 0xFFFF
#endif
#define PH(k) (((PHMASK >> (k)) & 1) && ph_lo <= (k) && (k) < ph_hi)
#define PBEGIN ArgsP a = (ArgsP)__builtin_amdgcn_kernarg_segment_ptr(); asm volatile("" : "+s"(a)); unsigned char* ws = a->ws; \
    int tid_ = threadIdx.x; asm volatile("" : "+v"(tid_)); const int tid = tid_, lane = tid & 63, wave = __builtin_amdgcn_readfirstlane(tid >> 6); const int gw = blockIdx.x * NWAVES + wave, ngw = gridDim.x * NWAVES; (void)ws; (void)gw; (void)ngw; (void)lane;

    if (((PHMASK >> 13) & 1) && a_.prep) { PBEGIN prep_weights(a, lds, gw, ngw, wave, lane); GRID_BAR(); }

    for (int g = g_lo; g < g_hi; ++g) {
        for (int l = l_lo; l < l_hi; ++l) {
            if (PH(0) && l == 0) { PBEGIN p0_init(a, g, gw, ngw, lane); GRID_BAR(); }
            if (PH(1)) { PBEGIN
                FIn f{(bf16*)(ws + WS_Z), (float*)(ws + WS_ZF), (const float*)(ws + WS_BIN) + l * NZ};
                run_gemm(lds, (const bf16*)(ws + WS_XN), (const bf16*)(ws + WS_WIN) + (size_t)l * NZ * D, NZ, D, f, gw, ngw, lane);
                GRID_BAR();
            }
            if (PH(2)) { PBEGIN p2_prep(a, l, gw, ngw, lane); GRID_BAR(); }
            if (PH(3)) { PBEGIN
                FQQ f{(bf16*)(ws + WS_QQ)};
                run_gemm(lds, (const bf16*)(ws + WS_CQN), (const bf16*)(ws + WS_WQQ) + (size_t)l * NQQ * 256, NQQ, 256, f, gw, ngw, lane);
            }
            if (PH(4)) { PBEGIN
                for (int u = blockIdx.x; u < 256; u += gridDim.x) {
                    const int b = (u >> 4) & 7, h = (u >> 2) & 3, vs = u & 3;
                    if (u >> 7) scan_unit<true>(a, lds, b, h, vs, tid); else scan_unit<false>(a, lds, b, h, vs, tid);
                }
                GRID_BAR();
            }
            if (PH(5)) { PBEGIN p5_dsa(a, lds, tid, wave, lane); }
            if (PH(6)) { PBEGIN p6_headnorm(a, l, gw, ngw, lane); GRID_BAR(); }
            if (PH(7)) {
                __syncthreads();
                { PBEGIN FBr<0> f0{(const bf16*)(ws + WS_Z), (float*)(ws + WS_Y), (bf16*)(ws + WS_MIX)};
                  run_gemm(lds, (const bf16*)(ws + WS_OG), (const bf16*)(ws + WS_WBG) + (size_t)l * D * D, D, D, f0, gw, ngw, lane); }
                { PBEGIN FBr<1> f1{(const bf16*)(ws + WS_Z), (float*)(ws + WS_Y), (bf16*)(ws + WS_MIX)};
                  run_gemm(lds, (const bf16*)(ws + WS_OD), (const bf16*)(ws + WS_WBD) + (size_t)l * D * 2048, D, 2048, f1, gw, ngw, lane); }
                { PBEGIN FBr<2> f2{(const bf16*)(ws + WS_Z), (float*)(ws + WS_Y), (bf16*)(ws + WS_MIX)};
                  run_gemm(lds, (const bf16*)(ws + WS_OM), (const bf16*)(ws + WS_WBM) + (size_t)l * D * D, D, D, f2, gw, ngw, lane); }
                GRID_BAR();
            }
            if (PH(8)) { PBEGIN
                FY f{(float*)(ws + WS_Y)};
                run_gemm(lds, (const bf16*)(ws + WS_MIX), (const bf16*)(ws + WS_WOUT) + (size_t)l * D * D, D, D, f, gw, ngw, lane);
                GRID_BAR();
            }
            if (PH(9)) { PBEGIN p_norm_res(a, g, a->in[I_GPOSTMIX] + l * D, a->in[I_GPREMLP] + l * D, gw, ngw, lane); GRID_BAR(); }
            if (PH(10)) { PBEGIN
                FUp f{(bf16*)(ws + WS_Z)};
                run_gemm(lds, (const bf16*)(ws + WS_XN), (const bf16*)(ws + WS_WUP) + (size_t)l * DFF * D, DFF, D, f, gw, ngw, lane);
                GRID_BAR();
            }
            if (PH(11)) { PBEGIN
                FY f{(float*)(ws + WS_Y)};
                run_gemm(lds, (const bf16*)(ws + WS_Z), (const bf16*)(ws + WS_WDN) + (size_t)l * D * DFF, D, DFF, f, gw, ngw, lane);
                GRID_BAR();
            }
            if (PH(12)) { PBEGIN p_norm_res(a, g, a->in[I_GPOSTMLP] + l * D, l + 1 < NL ? a->in[I_GPREMIX] + (l + 1) * D : nullptr, gw, ngw, lane); GRID_BAR(); }
        }
    }
#undef PH
#undef GRID_BAR
#undef PBEGIN
}

#ifndef MK_ONE_LAUNCH
#define MK_ONE_LAUNCH 1
#endif
extern "C" void kernel_launch(void* const* d_in, const int* in_sizes, int n_in, void* d_out, int out_size, void* d_ws, size_t ws_size, hipStream_t stream) {
    static int grid = 0;
    if (grid == 0) {
        if (n_in != 28 || out_size != NB * SEQ * D || ws_size < WS_END) { fprintf(stderr, "kernel_launch: unexpected shapes (n_in %d out %d ws %zu need %zu)\n", n_in, out_size, ws_size, (size_t)WS_END); grid = -1; return; }
        int dev = 0, cus = 0, per_cu = 0;
        if (hipGetDevice(&dev) != hipSuccess || hipDeviceGetAttribute(&cus, hipDeviceAttributeMultiprocessorCount, dev) != hipSuccess) { grid = -1; return; }
        if (hipFuncSetAttribute((const void*)fwd, hipFuncAttributeMaxDynamicSharedMemorySize, LDS_BYTES) != hipSuccess) { fprintf(stderr, "kernel_launch: hipFuncSetAttribute failed\n"); grid = -1; return; }
        if (hipOccupancyMaxActiveBlocksPerMultiprocessor(&per_cu, (const void*)fwd, NWAVES * 64, LDS_BYTES) != hipSuccess || per_cu < 1) { fprintf(stderr, "kernel_launch: occupancy query says %d\n", per_cu); }
        (void)hipGetLastError();
        grid = cus;
    }
    if (grid < 0) return;
    (void)hipMemsetAsync((char*)d_ws + WS_CTL, 0, CTL_ZERO_BYTES, stream);
    Args a{};
    for (int i = 0; i < 28; ++i) a.in[i] = (const float*)d_in[i];
    a.out = (float*)d_out; a.ws = (unsigned char*)d_ws;
#if MK_ONE_LAUNCH
    a.g_lo = 0; a.g_hi = NG; a.l_lo = 0; a.l_hi = NL; a.ph_lo = 0; a.ph_hi = 13; a.prep = 1; a.use_bar = 1;
    hipLaunchKernelGGL(fwd, dim3(grid), dim3(NWAVES * 64), LDS_BYTES, stream, a);
#else
    a.use_bar = 0;
    a.prep = 1; a.g_lo = 0; a.g_hi = 0; a.l_lo = 0; a.l_hi = 0; a.ph_lo = 0; a.ph_hi = 0;
    hipLaunchKernelGGL(fwd, dim3(grid), dim3(NWAVES * 64), LDS_BYTES, stream, a);
    a.prep = 0;
    static const int cuts[] = {0, 1, 2, 3, 5, 7, 8, 9, 10, 11, 12, 13};
    for (int g = 0; g < NG; ++g) for (int l = 0; l < NL; ++l) for (int c = 0; c < 11; ++c) {
        if (c == 0 && l != 0) continue;
        a.g_lo = g; a.g_hi = g + 1; a.l_lo = l; a.l_hi = l + 1; a.ph_lo = cuts[c]; a.ph_hi = cuts[c + 1];
        hipLaunchKernelGGL(fwd, dim3(grid), dim3(NWAVES * 64), LDS_BYTES, stream, a);
    }
#endif
    const hipError_t le = hipPeekAtLastError();
    if (le != hipSuccess) fprintf(stderr, "kernel_launch: launch failed: %s\n", hipGetErrorName(le));
}
```

```cpp
#include <hip/hip_runtime.h>
#include <cstdio>
#include <cstdint>
namespace pg8 {
#define PG8_LAS __attribute__((address_space(3)))
typedef unsigned short bf16_t;
typedef short bf16x8 __attribute__((ext_vector_type(8)));
typedef float f32x4 __attribute__((ext_vector_type(4)));
typedef unsigned u32x4 __attribute__((ext_vector_type(4)));
constexpr int BM = 256, BK = 64, HALF = 128, HTB = HALF * BK * 2  , STAGE_BYTES = 8 * HTB, NXCD = 8, WGM = 8;

__host__ __device__ __forceinline__ int lds_byte(int r, int c) { const int st = (r >> 4) * 2 + (c >> 5), rr = r & 15, cc = c & 31, ob = rr * 64 + cc * 2; return st * 1024 + (ob ^ (((ob >> 9) & 1) << 5)); }
__host__ __device__ __forceinline__ void stage_rc(int b, int& R, int& C) { const int st = b / 1024, sb = b % 1024, swz = sb ^ (((sb >> 9) & 1) << 5); R = (st >> 1) * 16 + swz / 64; C = (st & 1) * 32 + (swz % 64) / 2; }
__host__ __device__ __forceinline__ int perm32(int rho) { const int n = rho >> 4, i = rho & 15; return 8 * (i >> 2) + 4 * n + (i & 3); }

struct Unit { int pm, pn; };
struct Gemm { const bf16_t* A; const bf16_t* Bt; int M, N, K; };

struct StaticOrder {
    int nM, nN, nwg, G, c;
    __host__ __device__ void init(int M, int N, int G_, int c_) { nM = M / BM; nN = N / BM; nwg = nM * nN; G = G_; c = c_; }
    __host__ __device__ bool next(int i, Unit& u) const {
        const long L = (long)i * G + c; if (L >= nwg) return false;
        int wgid = (int)L; { const int q = nwg / NXCD, r = nwg % NXCD, xcd = wgid % NXCD, off = wgid / NXCD; wgid = (xcd < r ? xcd * (q + 1) : r * (q + 1) + (xcd - r) * q) + off; }
        const int nig = WGM * nN, gid = wgid / nig, fm = gid * WGM, gsz = (nM - fm) < WGM ? (nM - fm) : WGM;
        u.pm = fm + ((wgid % nig) % gsz); u.pn = (wgid % nig) / gsz; return true;
    }
    __device__ __forceinline__ void a_ready(const Unit&) const {}
    __device__ __forceinline__ void done(const Unit&) const {}
};

__device__ __forceinline__ unsigned cvt_pk_bf16(float lo, float hi) { unsigned r; asm volatile("v_cvt_pk_bf16_f32 %0, %1, %2" : "=v"(r) : "v"(lo), "v"(hi)); return r; }
template <class Epi, class Sched, bool ALIGN_EPI = false, bool SP2 = false>
__device__ __forceinline__ void gemm_phase(PG8_LAS unsigned char* lds, const Gemm g, const Sched& S, const Epi& E) {
    int tid_ = threadIdx.x; asm volatile("" : "+v"(tid_));
    const int tid = tid_, wid = __builtin_amdgcn_readfirstlane(tid >> 6), lane = tid & 63, wr = wid >> 2, wc = wid & 3, fr = lane & 15, fq = lane >> 4;
    const int K = g.K, nt = K / BK;
    unsigned voffA[2], voffB[2];
#pragma unroll
    for (int i = 0; i < 2; ++i) { int R, C; stage_rc(tid * 16 + i * 8192, R, C); const int Rb = Epi::PERM ? ((R & ~31) + perm32(R & 31)) : R;
        voffA[i] = (unsigned)(R * K + C) * 2u; voffB[i] = (unsigned)(Rb * K + C) * 2u; }
    const size_t kstep = (size_t)(BK * 2);
    const size_t hstep = (size_t)HALF * K * 2;
    const size_t tstep = 2 * hstep;
    const unsigned ldsw = (unsigned)wid * 1024u;
    const int aoff = lds_byte(wr * 64 + fr, fq * 8), boff = lds_byte(wc * 32 + fr, fq * 8);
#define PG8_SA(b, h) (((b) * 2 + (h)) * HTB)
#define PG8_SB(b, h) ((4 + (b) * 2 + (h)) * HTB)
#define PG8_STAGE(bufoff, gbase, voff) do { _Pragma("unroll") for (int _i = 0; _i < 2; ++_i) \
        __builtin_amdgcn_global_load_lds((const unsigned*)((const char*)(gbase) + (voff)[_i]), (PG8_LAS unsigned*)(lds + (bufoff) + ldsw + _i * 8192), 16, 0, 0); } while (0)
#define PG8_LDA(dst, b, h) do { _Pragma("unroll") for (int m = 0; m < 4; ++m) _Pragma("unroll") for (int k = 0; k < 2; ++k) dst[m][k] = *(const PG8_LAS bf16x8*)(lds + PG8_SA(b, h) + aoff + m * 2048 + k * 1024); } while (0)
#define PG8_LDB(dst, b, h) do { _Pragma("unroll") for (int n = 0; n < 2; ++n) _Pragma("unroll") for (int k = 0; k < 2; ++k) dst[n][k] = *(const PG8_LAS bf16x8*)(lds + PG8_SB(b, h) + boff + n * 2048 + k * 1024); } while (0)
#define PG8_MMA(ai, bj, At, Bt) do { __builtin_amdgcn_s_setprio(1); _Pragma("unroll") for (int m = 0; m < 4; ++m) _Pragma("unroll") for (int n = 0; n < 2; ++n) _Pragma("unroll") for (int k = 0; k < 2; ++k) \
        acc[ai][bj][m][n] = __builtin_amdgcn_mfma_f32_16x16x32_bf16(Bt[n][k], At[m][k], acc[ai][bj][m][n], 0, 0, 0); __builtin_amdgcn_s_setprio(0); } while (0)
#define PG8_WAIT_V(n) asm volatile("s_waitcnt vmcnt(" #n ")" ::: "memory")
#define PG8_WAIT_L(n) asm volatile("s_waitcnt lgkmcnt(" #n ")" ::: "memory")
#define PG8_BAR __builtin_amdgcn_s_barrier()
#define PG8_SCHED __builtin_amdgcn_sched_barrier(0)
    Unit cur, nxt; int ui = 0;
    if (!S.next(0, cur)) return;
    f32x4 acc[2][2][4][2];
#pragma unroll
    for (int a = 0; a < 2; ++a)
#pragma unroll
        for (int b = 0; b < 2; ++b)
#pragma unroll
            for (int m = 0; m < 4; ++m)
#pragma unroll
                for (int n = 0; n < 2; ++n) acc[a][b][m][n] = (f32x4){0.f, 0.f, 0.f, 0.f};
    bf16x8 At[4][2], B0[2][2], B1[2][2];
    const char* cA = (const char*)g.A + (size_t)cur.pm * tstep; const char* cB = (const char*)g.Bt + (size_t)cur.pn * tstep;
    S.a_ready(cur);
    if constexpr (SP2) {
        PG8_STAGE(PG8_SB(0, 0), cB, voffB); PG8_STAGE(PG8_SB(0, 1), cB + hstep, voffB); PG8_STAGE(PG8_SA(0, 0), cA, voffA); PG8_STAGE(PG8_SA(0, 1), cA + hstep, voffA);
        if (wr == 1) PG8_BAR;
        PG8_WAIT_V(2); PG8_BAR;
        PG8_STAGE(PG8_SB(1, 0), cB + kstep, voffB); PG8_STAGE(PG8_SA(1, 0), cA + kstep, voffA); PG8_STAGE(PG8_SB(1, 1), cB + hstep + kstep, voffB);
        PG8_WAIT_V(6); PG8_BAR;
    } else {
        PG8_STAGE(PG8_SB(0, 0), cB, voffB); PG8_STAGE(PG8_SA(0, 0), cA, voffA); PG8_STAGE(PG8_SB(0, 1), cB + hstep, voffB); PG8_STAGE(PG8_SA(0, 1), cA + hstep, voffA);
        if (wr == 1) PG8_BAR;
        PG8_WAIT_V(4); PG8_BAR;
        PG8_STAGE(PG8_SB(1, 0), cB + kstep, voffB); PG8_STAGE(PG8_SA(1, 0), cA + kstep, voffA); PG8_STAGE(PG8_SB(1, 1), cB + hstep + kstep, voffB);
        PG8_WAIT_V(6); PG8_BAR;
    }
    for (;;) {
        const bool has_next = S.next(ui + 1, nxt);
        const char* nA = has_next ? (const char*)g.A + (size_t)nxt.pm * tstep : cA; const char* nB = has_next ? (const char*)g.Bt + (size_t)nxt.pn * tstep : cB;
        for (int t = 0; t < nt; t += 2) {
            const bool last = (t == nt - 2);
            const char* a1 = cA + (size_t)(t + 1) * kstep;
            const char* a2 = last ? nA : cA + (size_t)(t + 2) * kstep; const char* b2 = last ? nB : cB + (size_t)(t + 2) * kstep;
            const char* a3 = a2 + kstep; const char* b3 = b2 + kstep;
            if (last && has_next) S.a_ready(nxt);
            if constexpr (SP2) {
            PG8_LDB(B0, 0, 0); PG8_LDB(B1, 0, 1); PG8_SCHED; PG8_LDA(At, 0, 0); PG8_STAGE(PG8_SA(1, 1), a1 + hstep, voffA);
            PG8_WAIT_V(8); PG8_WAIT_L(0); PG8_BAR; PG8_MMA(0, 0, At, B0); PG8_MMA(0, 1, At, B1); PG8_BAR; PG8_SCHED;
            PG8_LDA(At, 0, 1); PG8_STAGE(PG8_SB(0, 0), b2, voffB); PG8_STAGE(PG8_SB(0, 1), b2 + hstep, voffB); PG8_STAGE(PG8_SA(0, 0), a2, voffA);
            PG8_WAIT_V(8); PG8_WAIT_L(0); PG8_BAR; PG8_MMA(1, 0, At, B0); PG8_MMA(1, 1, At, B1); PG8_BAR; PG8_SCHED;
            PG8_LDB(B0, 1, 0); PG8_LDB(B1, 1, 1); PG8_SCHED; PG8_LDA(At, 1, 0); PG8_STAGE(PG8_SA(0, 1), a2 + hstep, voffA);
            PG8_WAIT_V(8); PG8_WAIT_L(0); PG8_BAR; PG8_MMA(0, 0, At, B0); PG8_MMA(0, 1, At, B1); PG8_BAR; PG8_SCHED;
            PG8_LDA(At, 1, 1); PG8_STAGE(PG8_SB(1, 0), b3, voffB); PG8_STAGE(PG8_SB(1, 1), b3 + hstep, voffB); PG8_STAGE(PG8_SA(1, 0), a3, voffA);
            PG8_WAIT_V(8); PG8_WAIT_L(0); PG8_BAR; PG8_MMA(1, 0, At, B0); PG8_MMA(1, 1, At, B1); PG8_BAR; PG8_SCHED;
            } else {
            PG8_LDB(B0, 0, 0); PG8_SCHED; PG8_LDA(At, 0, 0); PG8_STAGE(PG8_SA(1, 1), a1 + hstep, voffA);
            PG8_WAIT_L(8); PG8_BAR; PG8_WAIT_L(0); PG8_MMA(0, 0, At, B0); PG8_BAR; PG8_SCHED;
            PG8_LDB(B1, 0, 1); PG8_STAGE(PG8_SB(0, 0), b2, voffB);
            PG8_BAR; PG8_WAIT_L(0); PG8_MMA(0, 1, At, B1); PG8_BAR;
            PG8_LDA(At, 0, 1); PG8_STAGE(PG8_SA(0, 0), a2, voffA);
            PG8_BAR; PG8_WAIT_L(0); PG8_MMA(1, 0, At, B0); PG8_BAR; PG8_SCHED;
            PG8_STAGE(PG8_SB(0, 1), b2 + hstep, voffB);
            PG8_WAIT_V(6); PG8_BAR; PG8_MMA(1, 1, At, B1); PG8_BAR;
            PG8_LDB(B0, 1, 0); PG8_SCHED; PG8_LDA(At, 1, 0); PG8_STAGE(PG8_SA(0, 1), a2 + hstep, voffA);
            PG8_WAIT_L(8); PG8_BAR; PG8_WAIT_L(0); PG8_MMA(0, 0, At, B0); PG8_BAR; PG8_SCHED;
            PG8_LDB(B1, 1, 1); PG8_STAGE(PG8_SB(1, 0), b3, voffB);
            PG8_BAR; PG8_WAIT_L(0); PG8_MMA(0, 1, At, B1); PG8_BAR;
            PG8_LDA(At, 1, 1); PG8_STAGE(PG8_SA(1, 0), a3, voffA);
            PG8_BAR; PG8_WAIT_L(0); PG8_MMA(1, 0, At, B0); PG8_BAR; PG8_SCHED;
            PG8_STAGE(PG8_SB(1, 1), b3 + hstep, voffB);
            PG8_WAIT_V(6); PG8_BAR; PG8_MMA(1, 1, At, B1); PG8_BAR;
            }
        }
        if constexpr (ALIGN_EPI) { if (wr == 0) PG8_BAR; }
        if constexpr (!Epi::AFTER_DRAIN) { E(acc, cur, wr, wc, fr, fq); S.done(cur); }
        if (!has_next) break;
#pragma unroll
        for (int a = 0; a < 2; ++a)
#pragma unroll
            for (int b = 0; b < 2; ++b)
#pragma unroll
                for (int m = 0; m < 4; ++m)
#pragma unroll
                    for (int n = 0; n < 2; ++n) acc[a][b][m][n] = (f32x4){0.f, 0.f, 0.f, 0.f};
        cur = nxt; cA = nA; cB = nB; ++ui;
        if constexpr (ALIGN_EPI) { if (wr == 1) PG8_BAR; }
    }
    PG8_WAIT_V(0);
    if constexpr (!ALIGN_EPI) { if (wr == 0) PG8_BAR; }
    PG8_BAR;
    if constexpr (Epi::AFTER_DRAIN) { E.fused(acc, cur, wr, wc, fr, fq, lds, wid, lane); S.done(cur); }
#undef PG8_SA
#undef PG8_SB
#undef PG8_STAGE
#undef PG8_LDA
#undef PG8_LDB
#undef PG8_MMA
#undef PG8_WAIT_V
#undef PG8_WAIT_L
#undef PG8_BAR
#undef PG8_SCHED
}
}

constexpr int NB = 32, SEQ = 2048, NMETA = 16, TT = SEQ + NMETA, D = 1024, NL = 4, DFF = 4096;
constexpr int NG = 4, GB = NB / NG, MR = GB * SEQ  , MT = MR + NMETA  ;
constexpr int NCOLS = 9696, NZ = 9728, ZB = 9216, ZFW = 512;
constexpr float EPS = 1e-6f;
constexpr int ZC_GQ = 0, ZC_GK = 512, ZC_GV = 1024, ZC_GR = 2048, ZC_MQ = 3072, ZC_MK = 3584, ZC_MV = 4096, ZC_MO = 5120, ZC_GATE = 6144;
constexpr int ZF_CQ = 0, ZF_CKV = 256, ZF_IK = 384, ZF_A = 448, ZF_IW = 464, ZF_MI = 472, ZF_MF = 476;
constexpr int NQQ = 2560;

constexpr size_t MiB = 1u << 20;
constexpr size_t WS_CTL = 0, CTL_ZERO_BYTES = 1 * MiB;
constexpr size_t WS_BIN = 1 * MiB;
constexpr size_t WS_WIN = 2 * MiB;
constexpr size_t WS_WQQ = 78 * MiB;
constexpr size_t WS_WBG = 83 * MiB;
constexpr size_t WS_WBM = 91 * MiB;
constexpr size_t WS_WBD = 99 * MiB;
constexpr size_t WS_WOUT = 115 * MiB;
constexpr size_t WS_WUP = 123 * MiB;
constexpr size_t WS_WDN = 155 * MiB;
constexpr size_t WS_HM = 187 * MiB;
constexpr size_t WS_XN = 188 * MiB;
constexpr size_t WS_ZF = 221 * MiB;
constexpr size_t WS_CQN = 254 * MiB;
constexpr size_t WS_KV = 263 * MiB;
constexpr size_t WS_KI = 268 * MiB;
constexpr size_t WS_WI = 271 * MiB;
constexpr size_t WS_LIF = 272 * MiB;
constexpr size_t WS_G = 273 * MiB;
constexpr size_t WS_QKC = 306 * MiB;
constexpr size_t WS_QQ = 339 * MiB;
constexpr size_t WS_OG = 420 * MiB;
constexpr size_t WS_OM = 453 * MiB;
constexpr size_t WS_OD = 486 * MiB;
constexpr size_t WS_Z = 551 * MiB;
constexpr size_t WS_MIX = 840 * MiB;
constexpr size_t WS_Y = 873 * MiB;
constexpr size_t WS_SC = 840 * MiB;
constexpr size_t WS_END = 1024 * MiB;
constexpr int SC_PITCH = 2080;
static_assert(WS_Z + (size_t)MT * ZB * 2 <= WS_MIX && WS_Y + (size_t)MT * D * 4 <= WS_END && WS_SC + (size_t)256 * 64 * SC_PITCH * 4 <= WS_END, "ws map");

constexpr int CW_BAR = 4096;

constexpr int RING_BYTES = 131072;
constexpr int MISC_OFF = RING_BYTES + 320;
constexpr int LDS_BYTES = 147456;
constexpr int NWAVES = 8;

#define LAS __attribute__((address_space(3)))
typedef unsigned short bf16;
typedef float f32x4 __attribute__((ext_vector_type(4)));
typedef float f32x2 __attribute__((ext_vector_type(2)));
typedef unsigned u32x4 __attribute__((ext_vector_type(4)));
typedef unsigned u32x2 __attribute__((ext_vector_type(2)));
typedef short bf16x8 __attribute__((ext_vector_type(8)));
#define LDS_WAIT() asm volatile("s_waitcnt lgkmcnt(0)" ::: "memory")
#define VM_WAIT() asm volatile("s_waitcnt vmcnt(0)" ::: "memory")

__device__ __forceinline__ unsigned f2bf(float f) { unsigned u = __builtin_bit_cast(unsigned, f); return (u + 0x7fffu + ((u >> 16) & 1u)) >> 16; }
__device__ __forceinline__ unsigned pk2(float lo, float hi) { return f2bf(lo) | (f2bf(hi) << 16); }
__device__ __forceinline__ float bf2f(unsigned b) { return __builtin_bit_cast(float, b << 16); }
__device__ __forceinline__ float bflo(unsigned w) { return __builtin_bit_cast(float, w << 16); }
__device__ __forceinline__ float bfhi(unsigned w) { return __builtin_bit_cast(float, w & 0xffff0000u); }
__device__ __forceinline__ float wave_sum(float v) {
#pragma unroll
    for (int o = 1; o < 64; o <<= 1) v += __shfl_xor(v, o);
    return v;
}
__device__ __forceinline__ float wave_max(float v) {
#pragma unroll
    for (int o = 1; o < 64; o <<= 1) v = fmaxf(v, __shfl_xor(v, o));
    return v;
}
__device__ __forceinline__ float sigmoid_f(float x) { return 1.f / (1.f + __expf(-x)); }
__device__ __forceinline__ float silu_f(float x) { return x * sigmoid_f(x); }
__device__ __forceinline__ float logsigmoid_f(float x) { return fminf(x, 0.f) - log1pf(__expf(-fabsf(x))); }

#define XB_TMO      128
#define XB_XCNT(j)  (256  + 64 * (j))
#define XB_XSUB(j)  (1280 + 64 * (j))
#define XB_XGEN(j)  (2304 + 64 * (j))
#define XB_TOP      3328
#define XB_TOPGEN   3392
#define XCD_BAR_WORDS 3456
#define XB_SPIN_CAP (1u << 22)

__device__ __forceinline__ unsigned xb_ld(unsigned* p)              { return __hip_atomic_load(p, __ATOMIC_RELAXED, __HIP_MEMORY_SCOPE_AGENT); }
__device__ __forceinline__ unsigned xb_add(unsigned* p, unsigned v) { return __hip_atomic_fetch_add(p, v, __ATOMIC_RELAXED, __HIP_MEMORY_SCOPE_AGENT); }
__device__ __forceinline__ unsigned xb_xcc_id() { return (unsigned)__builtin_amdgcn_s_getreg((3 << 11) | 20) & 0xFu; }
#define XB_SPIN(cond, bar) do { unsigned _sp = 0; while (cond) { __builtin_amdgcn_s_sleep(1); \
    if ((++_sp & 255u) == 0u) { if (xb_ld(&(bar)[XB_TMO])) break; if (_sp > XB_SPIN_CAP) { atomicAdd(&(bar)[XB_TMO], 1u); break; } } } } while (0)

struct XcdBarrier {
    unsigned* bar; unsigned x;
    volatile LAS unsigned* st;
};

__device__ __forceinline__ XcdBarrier xcd_barrier_post(unsigned* bar, volatile LAS unsigned* st) {
    XcdBarrier b; b.bar = bar; b.x = xb_xcc_id(); b.st = st;
    if (threadIdx.x == 0) (void)xb_add(&bar[XB_XCNT(b.x)], 1u);
    return b;
}
__device__ __forceinline__ void xcd_barrier_complete(unsigned* bar, unsigned x, unsigned& nloc, unsigned& nx) {
    const unsigned G = gridDim.x * gridDim.y * gridDim.z;
    unsigned sum, cnt, mine, sp = 0u;
    for (;;) {
        sum = 0u; cnt = 0u; mine = 0u;
#pragma unroll
        for (unsigned j = 0; j < 16; ++j) { const unsigned c = xb_ld(&bar[XB_XCNT(j)]); sum += c; cnt += (c > 0u) ? 1u : 0u; mine = (j == x) ? c : mine; }
        if (sum == G) break;
        __builtin_amdgcn_s_sleep(1);
        if ((++sp & 255u) == 0u) { if (xb_ld(&bar[XB_TMO])) break; if (sp > XB_SPIN_CAP) { atomicAdd(&bar[XB_TMO], 1u); break; } }
    }
    nloc = mine > 0u ? mine : 1u; nx = cnt > 0u ? cnt : 1u;
}

__device__ __forceinline__ void xcd_barrier(const XcdBarrier& b) {
    asm volatile("s_waitcnt vmcnt(0)" ::: "memory");
    __syncthreads();
    if (threadIdx.x == 0) {
        unsigned* bar = b.bar;
        __builtin_amdgcn_s_waitcnt(0);
        unsigned nloc = b.st[0], nx = b.st[1];
        if (nloc == 0u) { xcd_barrier_complete(bar, b.x, nloc, nx); b.st[0] = nloc; b.st[1] = nx; }
        const unsigned old = xb_add(&bar[XB_XSUB(b.x)], 1u);
        const unsigned gen = old / nloc;
        if (old + 1u == (gen + 1u) * nloc) {
            __builtin_amdgcn_fence(__ATOMIC_RELEASE, "agent");
            asm volatile("s_waitcnt vmcnt(0)" ::: "memory");
            const unsigned og = xb_add(&bar[XB_TOP], 1u);
            const unsigned tg = og / nx;
            if (og + 1u == (tg + 1u) * nx) xb_add(&bar[XB_TOPGEN], 1u);
            else XB_SPIN(xb_ld(&bar[XB_TOPGEN]) == tg, bar);
            __builtin_amdgcn_fence(__ATOMIC_ACQUIRE, "agent");
            xb_add(&bar[XB_XGEN(b.x)], 1u);
            asm volatile("s_waitcnt vmcnt(0)" ::: "memory");
        } else {
            XB_SPIN(xb_ld(&bar[XB_XGEN(b.x)]) == gen, bar);
            __builtin_amdgcn_fence(__ATOMIC_ACQUIRE, "agent");
            asm volatile("s_waitcnt vmcnt(0)" ::: "memory");
        }
    }
    __syncthreads();
}


struct Args { const float* in[28]; float* out; unsigned char* ws; int g_lo, g_hi, l_lo, l_hi, ph_lo, ph_hi, prep, use_bar; };
typedef const __attribute__((address_space(4))) Args* ArgsP;
enum { I_X = 0, I_META, I_T5, I_GPREMIX, I_WIN, I_BIN, I_WA2, I_BA, I_GGLA, I_WBRG, I_GDQ, I_WUQ, I_WIQ, I_GDKV, I_WUV, I_LNG, I_LNB, I_WBRD,
       I_CONV, I_FB, I_GML, I_WBRM, I_WOUT, I_GPOSTMIX, I_GPREMLP, I_WUP, I_WDN, I_GPOSTMLP };

__device__ __forceinline__ int win_src(int n) {
    if (n < 3072) return n;
    if (n < 6144) return n - 3072 + 3544;
    if (n < 9216) return n - 6144 + 6624;
    if (n < 9472) return n - 9216 + 3088;
    if (n < 9600) return n - 9472 + 3344;
    if (n < 9664) return n - 9600 + 3472;
    if (n < 9680) return n - 9664 + 3072;
    if (n < 9688) return n - 9680 + 3536;
    if (n < 9692) return n - 9688 + 6616;
    if (n < 9696) return n - 9692 + 6620;
    return -1;
}
struct CmIdent { __device__ __forceinline__ int operator()(int n) const { return n; } };
struct CmWin { __device__ __forceinline__ int operator()(int n) const { return win_src(n); } };

template <class CM>
__device__ __forceinline__ void tr_item(const float* __restrict__ W, int ldw, bf16* __restrict__ WT, int Kd, LAS float* scr, int k0, int ns0, int nd0, int lane, CM cm) {
    const int sc = cm(ns0 + (lane & 31));
#pragma unroll 8
    for (int i = 0; i < 32; ++i) { const int kk = 2 * i + (lane >> 5); scr[kk * 33 + (lane & 31)] = sc >= 0 ? W[(size_t)(k0 + kk) * ldw + sc] : 0.f; }
    LDS_WAIT();
    const int c = lane & 7;
#pragma unroll
    for (int j = 0; j < 4; ++j) { const int n = (lane >> 3) + 8 * j; const LAS float* s = scr + (8 * c) * 33 + n;
        u32x4 o; o.x = pk2(s[0 * 33], s[1 * 33]); o.y = pk2(s[2 * 33], s[3 * 33]); o.z = pk2(s[4 * 33], s[5 * 33]); o.w = pk2(s[6 * 33], s[7 * 33]);
        *(u32x4*)(WT + (size_t)(nd0 + n) * Kd + k0 + 8 * c) = o; }
    LDS_WAIT();
}

__device__ __forceinline__ void prep_weights(ArgsP a, LAS unsigned char* lds, int gw, int ngw, int wave, int lane) {
    LAS float* scr = (LAS float*)(lds + wave * 16384);
    unsigned char* ws = a->ws;
    constexpr int I_WIN_N = 16 * 304, I_UQ = 4 * 64, I_IQ = 4 * 16, I_SQ = 16 * 32, I_UP = 16 * 128, I_DN = 64 * 32, I_WBD = 512, I_B = NZ / 64;
    constexpr int PER_L = I_WIN_N + I_UQ + I_IQ + 3 * I_SQ + I_UP + I_DN + I_WBD + I_B;
    for (int it = gw; it < NL * PER_L; it += ngw) {
        const int l = it / PER_L; int r = it % PER_L;
        if (r < I_WIN_N) { const int kb = r / 304, nb = r % 304;
            tr_item(a->in[I_WIN] + (size_t)l * D * NCOLS, NCOLS, (bf16*)(ws + WS_WIN) + (size_t)l * NZ * D, D, scr, kb * 64, nb * 32, nb * 32, lane, CmWin()); continue; }
        r -= I_WIN_N;
        if (r < I_UQ) { const int kb = r / 64, nb = r % 64;
            tr_item(a->in[I_WUQ] + (size_t)l * 256 * 2048, 2048, (bf16*)(ws + WS_WQQ) + (size_t)l * NQQ * 256, 256, scr, kb * 64, nb * 32, nb * 32, lane, CmIdent()); continue; }
        r -= I_UQ;
        if (r < I_IQ) { const int kb = r / 16, nb = r % 16;
            tr_item(a->in[I_WIQ] + (size_t)l * 256 * 512, 512, (bf16*)(ws + WS_WQQ) + (size_t)l * NQQ * 256, 256, scr, kb * 64, nb * 32, 2048 + nb * 32, lane, CmIdent()); continue; }
        r -= I_IQ;
        if (r < I_SQ) { const int kb = r / 32, nb = r % 32;
            tr_item(a->in[I_WBRG] + (size_t)l * D * D, D, (bf16*)(ws + WS_WBG) + (size_t)l * D * D, D, scr, kb * 64, nb * 32, nb * 32, lane, CmIdent()); continue; }
        r -= I_SQ;
        if (r < I_SQ) { const int kb = r / 32, nb = r % 32;
            tr_item(a->in[I_WBRM] + (size_t)l * D * D, D, (bf16*)(ws + WS_WBM) + (size_t)l * D * D, D, scr, kb * 64, nb * 32, nb * 32, lane, CmIdent()); continue; }
        r -= I_SQ;
        if (r < I_SQ) { const int kb = r / 32, nb = r % 32;
            tr_item(a->in[I_WOUT] + (size_t)l * D * D, D, (bf16*)(ws + WS_WOUT) + (size_t)l * D * D, D, scr, kb * 64, nb * 32, nb * 32, lane, CmIdent()); continue; }
        r -= I_SQ;
        if (r < I_UP) { const int kb = r / 128, nb = r % 128;
            tr_item(a->in[I_WUP] + (size_t)l * D * DFF, DFF, (bf16*)(ws + WS_WUP) + (size_t)l * DFF * D, D, scr, kb * 64, nb * 32, nb * 32, lane, CmIdent()); continue; }
        r -= I_UP;
        if (r < I_DN) { const int kb = r / 32, nb = r % 32;
            tr_item(a->in[I_WDN] + (size_t)l * DFF * D, D, (bf16*)(ws + WS_WDN) + (size_t)l * D * DFF, DFF, scr, kb * 64, nb * 32, nb * 32, lane, CmIdent()); continue; }
        r -= I_DN;
        if (r < I_WBD) {
            const int h = r >> 5, ch = (r >> 4) & 1, nb = r & 15, c = ch * 64 + lane;
            const float* uv = a->in[I_WUV] + ((size_t)(l * 16 + h) * 128 + c) * 64;
            const float* wb = a->in[I_WBRD] + ((size_t)l * D + h * 64) * D + nb * 64;
            bf16* o = (bf16*)(ws + WS_WBD) + (size_t)l * D * 2048 + (size_t)(nb * 64) * 2048 + h * 128 + c;
            f32x4 w[16];
#pragma unroll
            for (int i = 0; i < 16; ++i) w[i] = *(const f32x4*)(uv + 4 * i);
            for (int nn = 0; nn < 64; ++nn) {
                float acc = 0.f;
#pragma unroll
                for (int i = 0; i < 16; ++i) { acc += w[i].x * wb[(size_t)(4 * i + 0) * D + nn] + w[i].y * wb[(size_t)(4 * i + 1) * D + nn] + w[i].z * wb[(size_t)(4 * i + 2) * D + nn] + w[i].w * wb[(size_t)(4 * i + 3) * D + nn]; }
                o[(size_t)nn * 2048] = (bf16)f2bf(acc);
            }
            continue; }
        r -= I_WBD;
        { const int n = r * 64 + lane; const int sc = win_src(n);
          ((float*)(ws + WS_BIN))[l * NZ + n] = sc >= 0 ? a->in[I_BIN][l * NCOLS + sc] : 0.f; }
    }
}

__device__ __forceinline__ float* hrow(ArgsP a, int g, int r) {
    return r < MR ? a->out + ((size_t)g * MR + r) * D : (float*)(a->ws + WS_HM) + (size_t)(r - MR) * D;
}
__device__ __forceinline__ void rms_row_bf16(const f32x4 (&v)[4], const float* __restrict__ gain, bf16* __restrict__ orow, int lane) {
    float s = 0.f;
#pragma unroll
    for (int j = 0; j < 4; ++j) s += (v[j].x * v[j].x + v[j].y * v[j].y) + (v[j].z * v[j].z + v[j].w * v[j].w);
    const float r = rsqrtf(wave_sum(s) * (1.f / D) + EPS);
#pragma unroll
    for (int j = 0; j < 4; ++j) { const f32x4 gg = *(const f32x4*)(gain + 4 * lane + 256 * j); const f32x4 o = v[j] * r * gg;
        u32x2 w; w.x = pk2(o.x, o.y); w.y = pk2(o.z, o.w); *(u32x2*)(orow + 4 * lane + 256 * j) = w; }
}
__device__ __forceinline__ void p0_init(ArgsP a, int g, int gw, int ngw, int lane) {
    bf16* XN = (bf16*)(a->ws + WS_XN);
    for (int r = gw; r < MT; r += ngw) {
        const float* src = r < MR ? a->in[I_X] + ((size_t)g * MR + r) * D : a->in[I_META] + (size_t)(r - MR) * D;
        float* hd = hrow(a, g, r);
        f32x4 v[4];
#pragma unroll
        for (int j = 0; j < 4; ++j) { v[j] = *(const f32x4*)(src + 4 * lane + 256 * j); *(f32x4*)(hd + 4 * lane + 256 * j) = v[j]; }
        rms_row_bf16(v, a->in[I_GPREMIX], XN + (size_t)r * D, lane);
    }
}
__device__ __forceinline__ void p_norm_res(ArgsP a, int g, const float* gpost, const float* gpre, int gw, int ngw, int lane) {
    bf16* XN = (bf16*)(a->ws + WS_XN); const float* Y = (const float*)(a->ws + WS_Y);
    for (int r = gw; r < MT; r += ngw) {
        float* hd = hrow(a, g, r);
        f32x4 y[4], v[4]; float s = 0.f;
#pragma unroll
        for (int j = 0; j < 4; ++j) { y[j] = *(const f32x4*)(Y + (size_t)r * D + 4 * lane + 256 * j); v[j] = *(const f32x4*)(hd + 4 * lane + 256 * j);
            s += (y[j].x * y[j].x + y[j].y * y[j].y) + (y[j].z * y[j].z + y[j].w * y[j].w); }
        const float rr = rsqrtf(wave_sum(s) * (1.f / D) + EPS);
#pragma unroll
        for (int j = 0; j < 4; ++j) { const f32x4 gg = *(const f32x4*)(gpost + 4 * lane + 256 * j); v[j] = v[j] + y[j] * rr * gg; *(f32x4*)(hd + 4 * lane + 256 * j) = v[j]; }
        if (gpre) rms_row_bf16(v, gpre, XN + (size_t)r * D, lane);
    }
}

template <class F> struct EpiT {
    static constexpr bool PERM = true, AFTER_DRAIN = false;
    F f;
    __device__ __forceinline__ void operator()(const f32x4 (&acc)[2][2][4][2], const pg8::Unit& u, int wr, int wc, int fr, int fq) const {
        const int row0 = u.pm * 256 + wr * 64 + fr, col0 = u.pn * 256 + wc * 32 + 8 * fq;
#pragma unroll
        for (int ai = 0; ai < 2; ++ai)
#pragma unroll
            for (int m = 0; m < 4; ++m)
#pragma unroll
                for (int bj = 0; bj < 2; ++bj) { f.apply(row0 + ai * 128 + m * 16, col0 + bj * 128, acc[ai][bj][m][0], acc[ai][bj][m][1]); asm volatile("" ::: "memory"); }
    }
};
__device__ __forceinline__ void st_bf16x8(bf16* p, f32x4 v0, f32x4 v1) { u32x4 w; w.x = pk2(v0.x, v0.y); w.y = pk2(v0.z, v0.w); w.z = pk2(v1.x, v1.y); w.w = pk2(v1.z, v1.w); *(u32x4*)p = w; }
__device__ __forceinline__ void ld_bf16x8(const bf16* p, f32x4& v0, f32x4& v1) { const u32x4 w = *(const u32x4*)p;
    v0 = (f32x4){bflo(w.x), bfhi(w.x), bflo(w.y), bfhi(w.y)}; v1 = (f32x4){bflo(w.z), bfhi(w.z), bflo(w.w), bfhi(w.w)}; }

struct FIn {
    bf16* Z; float* ZF; const float* bias;
    __device__ __forceinline__ void apply(int row, int col, f32x4 v0, f32x4 v1) const {
        v0 += *(const f32x4*)(bias + col); v1 += *(const f32x4*)(bias + col + 4);
        const int t = col >> 8;
        if (t >= 36) { float* p = ZF + (size_t)row * ZFW + (col - ZB); *(f32x4*)p = v0; *(f32x4*)(p + 4) = v1; return; }
        if (t < 2) { v0 *= 0.08838834764831845f; v1 *= 0.08838834764831845f; }
        else if (t >= 8 && t < 12) {
#pragma unroll
            for (int i = 0; i < 4; ++i) { v0[i] = silu_f(v0[i]); v1[i] = silu_f(v1[i]); } }
        else if (t >= 20) {
#pragma unroll
            for (int i = 0; i < 4; ++i) { v0[i] = sigmoid_f(v0[i]); v1[i] = sigmoid_f(v1[i]); } }
        st_bf16x8(Z + (size_t)row * ZB + col, v0, v1);
    }
};
struct FQQ {
    bf16* QQ;
    __device__ __forceinline__ void apply(int row, int col, f32x4 v0, f32x4 v1) const {
        const float s = col < 2048 ? 0.08838834764831845f : 0.125f;
        st_bf16x8(QQ + (size_t)row * NQQ + col, v0 * s, v1 * s);
    }
};
template <int IDX> struct FBr {
    const bf16* Z; float* Y; bf16* MIX;
    __device__ __forceinline__ void apply(int row, int col, f32x4 v0, f32x4 v1) const {
        f32x4 g0, g1; ld_bf16x8(Z + (size_t)row * ZB + ZC_GATE + IDX * 1024 + col, g0, g1);
        float* y = Y + (size_t)row * D + col;
        f32x4 a0 = v0 * g0, a1 = v1 * g1;
        if (IDX > 0) { a0 += *(const f32x4*)y; a1 += *(const f32x4*)(y + 4); }
        if (IDX < 2) { *(f32x4*)y = a0; *(f32x4*)(y + 4) = a1; }
        else st_bf16x8(MIX + (size_t)row * D + col, a0, a1);
    }
};
struct FY {
    float* Y;
    __device__ __forceinline__ void apply(int row, int col, f32x4 v0, f32x4 v1) const { float* y = Y + (size_t)row * D + col; *(f32x4*)y = v0; *(f32x4*)(y + 4) = v1; }
};
struct FUp {
    bf16* U;
    __device__ __forceinline__ void apply(int row, int col, f32x4 v0, f32x4 v1) const {
#pragma unroll
        for (int i = 0; i < 4; ++i) { const float p = fmaxf(v0[i], 0.f), q = fmaxf(v1[i], 0.f); v0[i] = p * p; v1[i] = q * q; }
        st_bf16x8(U + (size_t)row * DFF + col, v0, v1);
    }
};

template <class F>
__device__ __forceinline__ void mini_gemm(const bf16* __restrict__ A, const bf16* __restrict__ Bt, int N, int K, const F& f, int gw, int ngw, int lane) {
    const int fr = lane & 15, fq = lane >> 4;
    for (int wt = gw; wt < N / 32; wt += ngw) {
        const int n0 = wt * 32;
        f32x4 acc0 = {0.f, 0.f, 0.f, 0.f}, acc1 = {0.f, 0.f, 0.f, 0.f};
        const bf16* ap = A + (size_t)(MR + fr) * K + fq * 8;
        const bf16* b0 = Bt + (size_t)(n0 + pg8::perm32(fr)) * K + fq * 8;
        const bf16* b1 = Bt + (size_t)(n0 + pg8::perm32(16 + fr)) * K + fq * 8;
        for (int k = 0; k < K; k += 32) {
            const bf16x8 av = *(const bf16x8*)(ap + k), w0 = *(const bf16x8*)(b0 + k), w1 = *(const bf16x8*)(b1 + k);
            acc0 = __builtin_amdgcn_mfma_f32_16x16x32_bf16(w0, av, acc0, 0, 0, 0);
            acc1 = __builtin_amdgcn_mfma_f32_16x16x32_bf16(w1, av, acc1, 0, 0, 0);
        }
        f.apply(MR + fr, n0 + 8 * fq, acc0, acc1);
    }
}
template <class F>
__device__ __forceinline__ void run_gemm(LAS unsigned char* lds, const bf16* A, const bf16* Bt, int N, int K, const F& f, int gw, int ngw, int lane) {
    asm volatile("" : "+s"(K)); asm volatile("" : "+s"(N));
    pg8::Gemm g{A, Bt, MR, N, K}; pg8::StaticOrder S; S.init(MR, N, (int)gridDim.x, (int)blockIdx.x);
    EpiT<F> E{f};
    pg8::gemm_phase<EpiT<F>, pg8::StaticOrder, true, true>((PG8_LAS unsigned char*)lds, g, S, E);
    mini_gemm(A, Bt, N, K, f, gw, ngw, lane);
}

__device__ __forceinline__ int prow(int r, int j) {
    if (r < MR) { const int s = r & (SEQ - 1); return (s - j >= 0) ? r - j : MR + (NMETA + s - j); }
    const int t = r - MR; return (t - j >= 0) ? r - j : -1;
}
__device__ __forceinline__ void p2_prep(ArgsP a, int l, int gw, int ngw, int lane) {
    unsigned char* ws = a->ws;
    const bf16* Z = (const bf16*)(ws + WS_Z);
    for (int r = gw; r < MT; r += ngw) {
        const float* zf = (const float*)(ws + WS_ZF) + (size_t)r * ZFW;
        {
            f32x4 v = *(const f32x4*)(zf + ZF_CQ + 4 * lane);
            const float rr = rsqrtf(wave_sum((v.x * v.x + v.y * v.y) + (v.z * v.z + v.w * v.w)) * (1.f / 256.f) + EPS);
            const f32x4 gg = *(const f32x4*)(a->in[I_GDQ] + l * 256 + 4 * lane); v = v * rr * gg;
            u32x2 w; w.x = pk2(v.x, v.y); w.y = pk2(v.z, v.w); *(u32x2*)((bf16*)(ws + WS_CQN) + (size_t)r * 256 + 4 * lane) = w;
        }
        {
            f32x2 v = *(const f32x2*)(zf + ZF_CKV + 2 * lane);
            const float rr = rsqrtf(wave_sum(v.x * v.x + v.y * v.y) * (1.f / 128.f) + EPS);
            const f32x2 gg = *(const f32x2*)(a->in[I_GDKV] + l * 128 + 2 * lane);
            *(unsigned*)((bf16*)(ws + WS_KV) + (size_t)r * 128 + 2 * lane) = pk2(v.x * rr * gg.x, v.y * rr * gg.y);
        }
        {
            const float v = zf[ZF_IK + lane]; const float mu = wave_sum(v) * (1.f / 64.f); const float d = v - mu;
            const float var = wave_sum(d * d) * (1.f / 64.f);
            const float y = d * rsqrtf(var + EPS) * a->in[I_LNG][l * 64 + lane] + a->in[I_LNB][l * 64 + lane];
            ((bf16*)(ws + WS_KI))[(size_t)r * 64 + lane] = (bf16)f2bf(y);
        }
        if (lane < 8) ((float*)(ws + WS_WI))[(size_t)r * 8 + lane] = zf[ZF_IW + lane] * 0.35355339059327373f;
        if (lane < 4) ((float*)(ws + WS_LIF))[(size_t)r * 8 + lane] = zf[ZF_MI + lane];
        else if (lane < 8) ((float*)(ws + WS_LIF))[(size_t)r * 8 + lane] = logsigmoid_f(zf[ZF_MF + lane - 4] + a->in[I_FB][l * 4 + lane - 4]);
        {
            f32x4 av[4];
#pragma unroll
            for (int i = 0; i < 4; ++i) av[i] = *(const f32x4*)(zf + ZF_A + 4 * i);
            const int c = 8 * lane;
            f32x4 s0 = *(const f32x4*)(a->in[I_BA] + l * 512 + c), s1 = *(const f32x4*)(a->in[I_BA] + l * 512 + c + 4);
#pragma unroll
            for (int j = 0; j < 16; ++j) { const float aj = av[j >> 2][j & 3]; const float* wp = a->in[I_WA2] + (size_t)(l * 16 + j) * 512 + c;
                s0 += aj * *(const f32x4*)wp; s1 += aj * *(const f32x4*)(wp + 4); }
#pragma unroll
            for (int i = 0; i < 4; ++i) { s0[i] = logsigmoid_f(s0[i]) * 0.0625f; s1[i] = logsigmoid_f(s1[i]) * 0.0625f; }
            float* gp = (float*)(ws + WS_G) + (size_t)r * 512 + c; *(f32x4*)gp = s0; *(f32x4*)(gp + 4) = s1;
        }
        {
            const int c = 16 * lane;
            f32x4 acc[4];
#pragma unroll
            for (int i = 0; i < 4; ++i) acc[i] = (f32x4){0.f, 0.f, 0.f, 0.f};
#pragma unroll
            for (int tap = 0; tap < 4; ++tap) {
                const int rt = tap == 3 ? r : prow(r, 3 - tap);
                if (rt >= 0) {
                    f32x4 x0, x1, x2, x3; ld_bf16x8(Z + (size_t)rt * ZB + ZC_MQ + c, x0, x1); ld_bf16x8(Z + (size_t)rt * ZB + ZC_MQ + c + 8, x2, x3);
                    const float* wp = a->in[I_CONV] + (size_t)(l * 4 + tap) * 1024 + c;
                    acc[0] += x0 * *(const f32x4*)wp; acc[1] += x1 * *(const f32x4*)(wp + 4); acc[2] += x2 * *(const f32x4*)(wp + 8); acc[3] += x3 * *(const f32x4*)(wp + 12);
                }
            }
            const float sc = c < 512 ? 0.08838834764831845f : 1.f;
#pragma unroll
            for (int i = 0; i < 4; ++i)
#pragma unroll
                for (int e = 0; e < 4; ++e) acc[i][e] = silu_f(acc[i][e]) * sc;
            bf16* qp = (bf16*)(ws + WS_QKC) + (size_t)r * 1024 + c; st_bf16x8(qp, acc[0], acc[1]); st_bf16x8(qp + 8, acc[2], acc[3]);
        }
    }
}

template <bool ML>
__device__ __forceinline__ void scan_unit(ArgsP a, LAS unsigned char* lds, int b, int h, int vs, int tid) {
    unsigned char* ws = a->ws;
    const bf16* Z = (const bf16*)(ws + WS_Z); const bf16* QKC = (const bf16*)(ws + WS_QKC);
    const float* G = (const float*)(ws + WS_G); const float* LIF = (const float*)(ws + WS_LIF);
    bf16* O = (bf16*)(ws + (ML ? WS_OM : WS_OG));
    LAS float* qs = (LAS float*)lds; LAS float* ks = qs + 2048; LAS float* ds = ks + 2048; LAS float* vsm = ds + 2048; LAS float* fi = vsm + 1024;
    const int kg = tid & 7, v = tid >> 3;
    const int stt = tid >> 5, sc4 = (tid & 31) * 4, sv2 = (tid & 31) * 2;
    float S[16], nn[16];
#pragma unroll
    for (int j = 0; j < 16; ++j) { S[j] = 0.f; nn[j] = 0.f; }
    for (int blk = 0; blk < TT / 16; ++blk) {
        const int row0 = blk == 0 ? MR : b * SEQ + (blk - 1) * 16;
        __syncthreads();
        {
            const int row = row0 + stt;
            u32x2 qw, kw;
            if (ML) { qw = *(const u32x2*)(QKC + (size_t)row * 1024 + h * 128 + sc4); kw = *(const u32x2*)(QKC + (size_t)row * 1024 + 512 + h * 128 + sc4); }
            else { qw = *(const u32x2*)(Z + (size_t)row * ZB + ZC_GQ + h * 128 + sc4); kw = *(const u32x2*)(Z + (size_t)row * ZB + ZC_GK + h * 128 + sc4); }
            *(LAS f32x4*)(qs + stt * 128 + sc4) = (f32x4){bflo(qw.x), bfhi(qw.x), bflo(qw.y), bfhi(qw.y)};
            *(LAS f32x4*)(ks + stt * 128 + sc4) = (f32x4){bflo(kw.x), bfhi(kw.x), bflo(kw.y), bfhi(kw.y)};
            if (!ML) { f32x4 gv = *(const f32x4*)(G + (size_t)row * 512 + h * 128 + sc4);
                *(LAS f32x4*)(ds + stt * 128 + sc4) = (f32x4){__expf(gv.x), __expf(gv.y), __expf(gv.z), __expf(gv.w)}; }
            const unsigned vw = *(const unsigned*)(Z + (size_t)row * ZB + (ML ? ZC_MV : ZC_GV) + h * 256 + vs * 64 + sv2);
            *(LAS f32x2*)(vsm + stt * 64 + sv2) = (f32x2){bflo(vw), bfhi(vw)};
            if (ML && tid < 16) { const int rw = row0 + tid; fi[2 * tid] = __expf(LIF[(size_t)rw * 8 + 4 + h]); fi[2 * tid + 1] = __expf(LIF[(size_t)rw * 8 + h]); }
        }
        __syncthreads();
        for (int tt = 0; tt < 16; ++tt) {
            float q[16], k[16], d[16];
#pragma unroll
            for (int i = 0; i < 4; ++i) { const f32x4 t4 = *(const LAS f32x4*)(qs + tt * 128 + 16 * kg + 4 * i); q[4 * i] = t4.x; q[4 * i + 1] = t4.y; q[4 * i + 2] = t4.z; q[4 * i + 3] = t4.w; }
#pragma unroll
            for (int i = 0; i < 4; ++i) { const f32x4 t4 = *(const LAS f32x4*)(ks + tt * 128 + 16 * kg + 4 * i); k[4 * i] = t4.x; k[4 * i + 1] = t4.y; k[4 * i + 2] = t4.z; k[4 * i + 3] = t4.w; }
            const float vv = vsm[tt * 64 + v];
            float num = 0.f, den = 0.f;
            if (ML) {
                const float f = fi[2 * tt], ii = fi[2 * tt + 1];
#pragma unroll
                for (int j = 0; j < 16; ++j) { const float ik = ii * k[j]; S[j] = f * S[j] + ik * vv; nn[j] = f * nn[j] + ik; num += q[j] * S[j]; den += q[j] * nn[j]; }
            } else {
#pragma unroll
                for (int i = 0; i < 4; ++i) { const f32x4 t4 = *(const LAS f32x4*)(ds + tt * 128 + 16 * kg + 4 * i); d[4 * i] = t4.x; d[4 * i + 1] = t4.y; d[4 * i + 2] = t4.z; d[4 * i + 3] = t4.w; }
#pragma unroll
                for (int j = 0; j < 16; ++j) { S[j] = d[j] * S[j] + k[j] * vv; num += q[j] * S[j]; }
            }
            num += __shfl_xor(num, 1); num += __shfl_xor(num, 2); num += __shfl_xor(num, 4);
            if (ML) { den += __shfl_xor(den, 1); den += __shfl_xor(den, 2); den += __shfl_xor(den, 4); num = num / fmaxf(fabsf(den), 1.f); }
            if (kg == 0) O[(size_t)(row0 + tt) * 1024 + h * 256 + vs * 64 + v] = (bf16)f2bf(num);
        }
    }
}

__device__ __forceinline__ void p6_headnorm(ArgsP a, int l, int gw, int ngw, int lane) {
    unsigned char* ws = a->ws; const bf16* Z = (const bf16*)(ws + WS_Z);
    for (int it = gw; it < MT * 8; it += ngw) {
        const int r = it >> 3, mx = (it >> 2) & 1, h = it & 3;
        bf16* op = (bf16*)(ws + (mx ? WS_OM : WS_OG)) + (size_t)r * 1024 + h * 256 + 4 * lane;
        const u32x2 w = *(const u32x2*)op; f32x4 v = {bflo(w.x), bfhi(w.x), bflo(w.y), bfhi(w.y)};
        const float rr = rsqrtf(wave_sum((v.x * v.x + v.y * v.y) + (v.z * v.z + v.w * v.w)) * (1.f / 256.f) + EPS);
        const f32x4 gg = *(const f32x4*)(a->in[mx ? I_GML : I_GGLA] + l * 256 + 4 * lane);
        const u32x2 gw2 = *(const u32x2*)(Z + (size_t)r * ZB + (mx ? ZC_MO : ZC_GR) + h * 256 + 4 * lane);
        const f32x4 gt = {bflo(gw2.x), bfhi(gw2.x), bflo(gw2.y), bfhi(gw2.y)};
        v = v * rr * gg * gt;
        u32x2 o; o.x = pk2(v.x, v.y); o.y = pk2(v.z, v.w); *(u32x2*)op = o;
    }
}

__device__ __forceinline__ int krow(int b, int s) { return s < NMETA ? MR + s : b * SEQ + (s - NMETA); }
__device__ __forceinline__ int t5_bucket(int n) {
    if (n < 16) return n < 0 ? 0 : n;
    const int lg = 16 + (int)(__logf((float)n * (1.f / 16.f)) / 2.0794415416798357f * 16.f);
    return lg < 31 ? lg : 31;
}
typedef short s16x4 __attribute__((ext_vector_type(4)));
__device__ __forceinline__ unsigned off_b(unsigned row, unsigned ch) { return 256u * row + 16u * (ch ^ (((row & 3) << 2) | ((row >> 2) & 3))); }
__device__ __forceinline__ s16x4 tr_rd(LAS unsigned char* p) { return __builtin_amdgcn_ds_read_tr16_b64_v4i16((LAS s16x4*)p); }

constexpr int DW2_STRIDE = 9216, DW2_TILE = 0, DW2_SEL = 8192, DW2_BK = 8704, DSA2_T5 = 8 * DW2_STRIDE;

template <bool DENSE_ONLY>
__device__ __forceinline__ void dsa_unit(ArgsP a, LAS unsigned char* lds, int b, int c, int nq, int wave, int lane_in) {
    int lane = lane_in; asm volatile("" : "+v"(lane));
    unsigned char* ws = a->ws;
    const bf16* QQ = (const bf16*)(ws + WS_QQ); const bf16* KI = (const bf16*)(ws + WS_KI); const bf16* KV = (const bf16*)(ws + WS_KV);
    unsigned* SC = (unsigned*)(ws + WS_SC) + (size_t)blockIdx.x * 64 * SC_PITCH;
    const int r0 = DENSE_ONLY ? MR : b * SEQ + 64 * c, p0 = DENSE_ONLY ? 0 : NMETA + 64 * c;
    const int fr = lane & 15, fq = lane >> 4;
    if (!DENSE_ONLY) {
        const int qt = wave & 3, kh = wave >> 2;
        if (p0 + 16 * qt + 15 >= 256) {
            const int qrow = r0 + 16 * qt + fr, pq = p0 + 16 * qt + fr;
            bf16x8 qf[8][2];
#pragma unroll
            for (int h = 0; h < 8; ++h)
#pragma unroll
                for (int ks = 0; ks < 2; ++ks) qf[h][ks] = *(const bf16x8*)(QQ + (size_t)qrow * NQQ + 2048 + h * 64 + ks * 32 + 8 * fq);
            float wi[8];
            { const f32x4 w0 = *(const f32x4*)((const float*)(ws + WS_WI) + (size_t)qrow * 8), w1 = *(const f32x4*)((const float*)(ws + WS_WI) + (size_t)qrow * 8 + 4);
              wi[0] = w0.x; wi[1] = w0.y; wi[2] = w0.z; wi[3] = w0.w; wi[4] = w1.x; wi[5] = w1.y; wi[6] = w1.z; wi[7] = w1.w; }
            const int nkt = 2 + 4 * c + qt;
            unsigned* scq = SC + (size_t)(16 * qt + fr) * SC_PITCH + 4 * fq;
            for (int kt = kh; kt < nkt; kt += 2) {
                const bf16* kp = KI + (size_t)krow(b, 16 * kt + fr) * 64 + 8 * fq;
                const bf16x8 a0 = *(const bf16x8*)kp, a1 = *(const bf16x8*)(kp + 32);
                float s0 = 0.f, s1 = 0.f, s2 = 0.f, s3 = 0.f;
#pragma unroll
                for (int h = 0; h < 8; ++h) {
                    f32x4 acc = {0.f, 0.f, 0.f, 0.f};
                    acc = __builtin_amdgcn_mfma_f32_16x16x32_bf16(a0, qf[h][0], acc, 0, 0, 0);
                    acc = __builtin_amdgcn_mfma_f32_16x16x32_bf16(a1, qf[h][1], acc, 0, 0, 0);
                    s0 += wi[h] * fmaxf(acc.x, 0.f); s1 += wi[h] * fmaxf(acc.y, 0.f); s2 += wi[h] * fmaxf(acc.z, 0.f); s3 += wi[h] * fmaxf(acc.w, 0.f);
                }
                const int kb = 16 * kt + 4 * fq;
                u32x4 o;
                { const unsigned bits = __builtin_bit_cast(unsigned, s0); o.x = (kb + 0) <= pq ? (bits ^ ((bits >> 31) ? 0xffffffffu : 0x80000000u)) : 0u; }
                { const unsigned bits = __builtin_bit_cast(unsigned, s1); o.y = (kb + 1) <= pq ? (bits ^ ((bits >> 31) ? 0xffffffffu : 0x80000000u)) : 0u; }
                { const unsigned bits = __builtin_bit_cast(unsigned, s2); o.z = (kb + 2) <= pq ? (bits ^ ((bits >> 31) ? 0xffffffffu : 0x80000000u)) : 0u; }
                { const unsigned bits = __builtin_bit_cast(unsigned, s3); o.w = (kb + 3) <= pq ? (bits ^ ((bits >> 31) ? 0xffffffffu : 0x80000000u)) : 0u; }
                *(u32x4*)(scq + 16 * kt) = o;
            }
        }
        VM_WAIT();
        __syncthreads();
    }
    LAS unsigned char* wl = lds + wave * DW2_STRIDE;
    LAS unsigned char* tile = wl + DW2_TILE;
    LAS unsigned short* selL = (LAS unsigned short*)(wl + DW2_SEL);
    LAS unsigned short* bkL = (LAS unsigned short*)(wl + DW2_BK);
    const LAS float* t5L = (const LAS float*)(lds + DSA2_T5);
    const int nqw = DENSE_ONLY ? 2 : 8;
    for (int qi_ = 0; qi_ < nqw; ++qi_) {
        asm volatile("" : "+v"(lane));
        const int iq = wave * nqw + qi_;
        if (iq >= nq) break;
        const int p = p0 + iq, nk = p + 1, qrow = r0 + iq;
        int nsel;
        if (!DENSE_ONLY && nk > 256) {
            const unsigned* scr = SC + (size_t)iq * SC_PITCH;
            unsigned u[33];
#pragma unroll
            for (int i = 0; i < 33; ++i) { const int s = lane + 64 * i; u[i] = s < nk ? __hip_atomic_load(scr + s, __ATOMIC_RELAXED, __HIP_MEMORY_SCOPE_AGENT) : 0u; }
            unsigned tau = 0u;
            for (int bit = 31; bit >= 0; --bit) {
                const unsigned cand = tau | (1u << bit);
                int cnt = 0;
#pragma unroll
                for (int i = 0; i < 33; ++i) cnt += __popcll(__ballot(u[i] >= cand));
                if (cnt >= 256) tau = cand;
            }
            int cgt = 0;
#pragma unroll
            for (int i = 0; i < 33; ++i) cgt += __popcll(__ballot(u[i] > tau));
            const int rem = 256 - cgt;
            const unsigned long long lt = (1ull << lane) - 1ull;
            int base = 0, eqseen = 0;
#pragma unroll
            for (int i = 0; i < 33; ++i) {
                const bool gt = u[i] > tau, eq = u[i] == tau;
                const unsigned long long meq = __ballot(eq);
                const bool take = gt || (eq && (eqseen + __popcll(meq & lt)) < rem);
                const unsigned long long mt = __ballot(take);
                if (take) { const int pos = base + __popcll(mt & lt), s = lane + 64 * i; selL[pos] = (unsigned short)s; bkL[pos] = (unsigned short)(t5_bucket(p - s) * 16); }
                base += __popcll(mt); eqseen += __popcll(meq);
            }
            nsel = 256;
        } else {
#pragma unroll
            for (int m = 0; m < 4; ++m) { const int s = lane + 64 * m; selL[s] = (unsigned short)(s < nk ? s : 0); bkL[s] = (unsigned short)(t5_bucket(p - s) * 16); }
            nsel = nk;
        }
        asm volatile("" : "+v"(lane));
        bf16x8 qB[4];
#pragma unroll
        for (int ks = 0; ks < 4; ++ks) qB[ks] = *(const bf16x8*)(QQ + (size_t)qrow * NQQ + fr * 128 + ks * 32 + 8 * fq);
        LDS_WAIT();
        f32x4 O[8];
#pragma unroll
        for (int nt = 0; nt < 8; ++nt) O[nt] = (f32x4){0.f, 0.f, 0.f, 0.f};
        float mrun = -INFINITY, lrun = 0.f;
        const int nblk = (nsel + 31) >> 5;
        for (int blk = 0; blk < nblk; ++blk) {
            u32x4 gv[8];
#pragma unroll
            for (int e = 0; e < 8; ++e) { const int pid = lane + 64 * e, ri = pid >> 4, ch = pid & 15, j = 32 * blk + ri;
                const int key = j < nsel ? (int)selL[j] : 0;
                gv[e] = *(const u32x4*)(KV + (size_t)krow(b, key) * 128 + ch * 8); }
#pragma unroll
            for (int e = 0; e < 8; ++e) { const int pid = lane + 64 * e, ri = pid >> 4, ch = pid & 15; *(LAS u32x4*)(tile + off_b(ri, ch)) = gv[e]; }
            LDS_WAIT();
            f32x4 s0 = {0.f, 0.f, 0.f, 0.f}, s1 = {0.f, 0.f, 0.f, 0.f};
#pragma unroll
            for (int ks = 0; ks < 4; ++ks) {
                const bf16x8 k0 = *(const LAS bf16x8*)(tile + off_b(fr, 4 * ks + fq)), k1 = *(const LAS bf16x8*)(tile + off_b(16 + fr, 4 * ks + fq));
                s0 = __builtin_amdgcn_mfma_f32_16x16x32_bf16(k0, qB[ks], s0, 0, 0, 0);
                s1 = __builtin_amdgcn_mfma_f32_16x16x32_bf16(k1, qB[ks], s1, 0, 0, 0);
            }
            const int j0 = 32 * blk + 4 * fq;
            const u32x2 b0 = *(const LAS u32x2*)(bkL + j0), b1 = *(const LAS u32x2*)(bkL + j0 + 16);
            const int bo0[4] = {(int)(b0.x & 0xffffu), (int)(b0.x >> 16), (int)(b0.y & 0xffffu), (int)(b0.y >> 16)};
            const int bo1[4] = {(int)(b1.x & 0xffffu), (int)(b1.x >> 16), (int)(b1.y & 0xffffu), (int)(b1.y >> 16)};
            float bm = -INFINITY;
#pragma unroll
            for (int r = 0; r < 4; ++r) {
                s0[r] = (j0 + r) < nsel ? s0[r] + t5L[bo0[r] + fr] : -INFINITY;
                s1[r] = (j0 + 16 + r) < nsel ? s1[r] + t5L[bo1[r] + fr] : -INFINITY;
                bm = fmaxf(bm, fmaxf(s0[r], s1[r]));
            }
            bm = fmaxf(bm, __shfl_xor(bm, 16)); bm = fmaxf(bm, __shfl_xor(bm, 32));
            const float mnew = fmaxf(mrun, bm);
            const float scl = __expf(mrun - mnew);
            mrun = mnew;
            float ps = 0.f;
#pragma unroll
            for (int r = 0; r < 4; ++r) { s0[r] = __expf(s0[r] - mnew); s1[r] = __expf(s1[r] - mnew); ps += s0[r] + s1[r]; }
            lrun = lrun * scl + ps;
            float sr[4];
#pragma unroll
            for (int r = 0; r < 4; ++r) sr[r] = __shfl(scl, 4 * fq + r);
#pragma unroll
            for (int nt = 0; nt < 8; ++nt)
#pragma unroll
                for (int r = 0; r < 4; ++r) O[nt][r] *= sr[r];
            u32x4 pw; pw.x = pk2(s0[0], s0[1]); pw.y = pk2(s0[2], s0[3]); pw.z = pk2(s1[0], s1[1]); pw.w = pk2(s1[2], s1[3]);
            const bf16x8 pa = __builtin_bit_cast(bf16x8, pw);
            const unsigned q4 = (unsigned)(fr >> 2), p4 = (unsigned)(lane & 3);
#pragma unroll
            for (int nt = 0; nt < 8; ++nt) {
                const s16x4 vlo = tr_rd(tile + off_b(4 * fq + q4, 2 * nt + (p4 >> 1)) + 8 * (p4 & 1));
                const s16x4 vhi = tr_rd(tile + off_b(16 + 4 * fq + q4, 2 * nt + (p4 >> 1)) + 8 * (p4 & 1));
                const bf16x8 vb = __builtin_shufflevector(vlo, vhi, 0, 1, 2, 3, 4, 5, 6, 7);
                O[nt] = __builtin_amdgcn_mfma_f32_16x16x32_bf16(pa, vb, O[nt], 0, 0, 0);
            }
        }
        float lt2 = lrun + __shfl_xor(lrun, 16); lt2 += __shfl_xor(lt2, 32);
        const float inv = 1.f / lt2;
        float ir[4];
#pragma unroll
        for (int r = 0; r < 4; ++r) ir[r] = __shfl(inv, 4 * fq + r);
        bf16* od = (bf16*)(ws + WS_OD) + (size_t)qrow * 2048 + fr;
#pragma unroll
        for (int nt = 0; nt < 8; ++nt)
#pragma unroll
            for (int r = 0; r < 4; ++r) od[(4 * fq + r) * 128 + 16 * nt] = (bf16)f2bf(O[nt][r] * ir[r]);
        LDS_WAIT();
    }
}
__device__ __forceinline__ void p5_dsa(ArgsP a, LAS unsigned char* lds, int tid, int wave, int lane) {
    LAS float* t5L = (LAS float*)(lds + DSA2_T5);
    __syncthreads();
    t5L[tid] = a->in[I_T5][tid];
    __syncthreads();
    for (int u = blockIdx.x; u < 256; u += gridDim.x) {
        dsa_unit<false>(a, lds, u >> 5, u & 31, 64, wave, lane);
        __syncthreads();
    }
    if (blockIdx.x == 0) dsa_unit<true>(a, lds, 0, 0, 16, wave, lane);
}

__global__ void __launch_bounds__(NWAVES * 64, 2) fwd(Args a_) {
    extern __shared__ __attribute__((aligned(16))) unsigned char lds_raw[];
    LAS unsigned char* lds = (LAS unsigned char*)lds_raw;
    volatile LAS unsigned* MISC = (volatile LAS unsigned*)(lds + MISC_OFF);
    if (threadIdx.x < 32) MISC[threadIdx.x] = 0u;
    __syncthreads();
    const int g_lo = a_.g_lo, g_hi = a_.g_hi, l_lo = a_.l_lo, l_hi = a_.l_hi, ph_lo = a_.ph_lo, ph_hi = a_.ph_hi, use_bar = a_.use_bar;
    XcdBarrier bar; bar.bar = (unsigned*)(a_.ws + WS_CTL) + CW_BAR; bar.x = 0; bar.st = nullptr;
    if (use_bar) bar = xcd_barrier_post((unsigned*)(a_.ws + WS_CTL) + CW_BAR, MISC + 8);
#define GRID_BAR() do { if (use_bar) xcd_barrier(bar); } while (0)
#ifndef PHMASK
#define PHMASK 0xFFFF
#endif
#ifndef PROBE_PH
#define PROBE_PH -1
#endif
#define PH(k) (((PHMASK >> (k)) & 1) && ph_lo <= (k) && (k) < ph_hi)
#define PBEGIN ArgsP a = (ArgsP)__builtin_amdgcn_kernarg_segment_ptr(); asm volatile("" : "+s"(a)); unsigned char* ws = a->ws; \
    int tid_ = threadIdx.x; asm volatile("" : "+v"(tid_)); const int tid = tid_, lane = tid & 63, wave = __builtin_amdgcn_readfirstlane(tid >> 6); const int gw = blockIdx.x * NWAVES + wave, ngw = gridDim.x * NWAVES; (void)ws; (void)gw; (void)ngw; (void)lane;

    if (((PHMASK >> 13) & 1) && a_.prep) { PBEGIN prep_weights(a, lds, gw, ngw, wave, lane); GRID_BAR(); }

    for (int g = g_lo; g < g_hi; ++g) {
        for (int l = l_lo; l < l_hi; ++l) {
            if (PH(0) && l == 0) { PBEGIN p0_init(a, g, gw, ngw, lane); GRID_BAR(); }
            if (PH(1)) { PBEGIN
                FIn f{(bf16*)(ws + WS_Z), (float*)(ws + WS_ZF), (const float*)(ws + WS_BIN) + l * NZ};
                run_gemm(lds, (const bf16*)(ws + WS_XN), (const bf16*)(ws + WS_WIN) + (size_t)l * NZ * D, NZ, D, f, gw, ngw, lane);
                GRID_BAR();
            }
            if (PH(2)) { PBEGIN p2_prep(a, l, gw, ngw, lane); GRID_BAR(); }
            if (PH(3)) { PBEGIN
                FQQ f{(bf16*)(ws + WS_QQ)};
                run_gemm(lds, (const bf16*)(ws + WS_CQN), (const bf16*)(ws + WS_WQQ) + (size_t)l * NQQ * 256, NQQ, 256, f, gw, ngw, lane);
            }
            if (PH(4)) { PBEGIN
                for (int u = blockIdx.x; u < 256; u += gridDim.x) {
                    const int b = (u >> 4) & 7, h = (u >> 2) & 3, vs = u & 3;
                    if (u >> 7) scan_unit<true>(a, lds, b, h, vs, tid); else scan_unit<false>(a, lds, b, h, vs, tid);
                }
#if PROBE_PH == 4
                for (int u = blockIdx.x; u < 256; u += gridDim.x) {
                    const int b = (u >> 4) & 7, h = (u >> 2) & 3, vs = u & 3;
                    if (u >> 7) scan_unit<true>(a, lds, b, h, vs, tid); else scan_unit<false>(a, lds, b, h, vs, tid);
                }
#endif
                GRID_BAR();
            }
            if (PH(5)) { PBEGIN p5_dsa(a, lds, tid, wave, lane); }
#if PROBE_PH == 5
            if (PH(5)) { PBEGIN p5_dsa(a, lds, tid, wave, lane); }
#endif
            if (PH(6)) { PBEGIN p6_headnorm(a, l, gw, ngw, lane); GRID_BAR(); }
            if (PH(7)) {
                __syncthreads();
                { PBEGIN FBr<0> f0{(const bf16*)(ws + WS_Z), (float*)(ws + WS_Y), (bf16*)(ws + WS_MIX)};
                  run_gemm(lds, (const bf16*)(ws + WS_OG), (const bf16*)(ws + WS_WBG) + (size_t)l * D * D, D, D, f0, gw, ngw, lane); }
                { PBEGIN FBr<1> f1{(const bf16*)(ws + WS_Z), (float*)(ws + WS_Y), (bf16*)(ws + WS_MIX)};
                  run_gemm(lds, (const bf16*)(ws + WS_OD), (const bf16*)(ws + WS_WBD) + (size_t)l * D * 2048, D, 2048, f1, gw, ngw, lane); }
                { PBEGIN FBr<2> f2{(const bf16*)(ws + WS_Z), (float*)(ws + WS_Y), (bf16*)(ws + WS_MIX)};
                  run_gemm(lds, (const bf16*)(ws + WS_OM), (const bf16*)(ws + WS_WBM) + (size_t)l * D * D, D, D, f2, gw, ngw, lane); }
                GRID_BAR();
            }
            if (PH(8)) { PBEGIN
                FY f{(float*)(ws + WS_Y)};
                run_gemm(lds, (const bf16*)(ws + WS_MIX), (const bf16*)(ws + WS_WOUT) + (size_t)l * D * D, D, D, f, gw, ngw, lane);
                GRID_BAR();
            }
            if (PH(9)) { PBEGIN p_norm_res(a, g, a->in[I_GPOSTMIX] + l * D, a->in[I_GPREMLP] + l * D, gw, ngw, lane); GRID_BAR(); }
            if (PH(10)) { PBEGIN
                FUp f{(bf16*)(ws + WS_Z)};
                run_gemm(lds, (const bf16*)(ws + WS_XN), (const bf16*)(ws + WS_WUP) + (size_t)l * DFF * D, DFF, D, f, gw, ngw, lane);
                GRID_BAR();
            }
            if (PH(11)) { PBEGIN
                FY f{(float*)(ws + WS_Y)};
                run_gemm(lds, (const bf16*)(ws + WS_Z), (const bf16*)(ws + WS_WDN) + (size_t)l * D * DFF, D, DFF, f, gw, ngw, lane);
                GRID_BAR();
            }
            if (PH(12)) { PBEGIN p_norm_res(a, g, a->in[I_GPOSTMLP] + l * D, l + 1 < NL ? a->in[I_GPREMIX] + (l + 1) * D : nullptr, gw, ngw, lane); GRID_BAR(); }
        }
    }
#undef PH
#undef GRID_BAR
#undef PBEGIN
}

#ifndef MK_ONE_LAUNCH
#define MK_ONE_LAUNCH 1
#endif
extern "C" void kernel_launch(void* const* d_in, const int* in_sizes, int n_in, void* d_out, int out_size, void* d_ws, size_t ws_size, hipStream_t stream) {
    static int grid = 0;
    if (grid == 0) {
        if (n_in != 28 || out_size != NB * SEQ * D || ws_size < WS_END) { fprintf(stderr, "kernel_launch: unexpected shapes (n_in %d out %d ws %zu need %zu)\n", n_in, out_size, ws_size, (size_t)WS_END); grid = -1; return; }
        int dev = 0, cus = 0, per_cu = 0;
        if (hipGetDevice(&dev) != hipSuccess || hipDeviceGetAttribute(&cus, hipDeviceAttributeMultiprocessorCount, dev) != hipSuccess) { grid = -1; return; }
        if (hipFuncSetAttribute((const void*)fwd, hipFuncAttributeMaxDynamicSharedMemorySize, LDS_BYTES) != hipSuccess) { fprintf(stderr, "kernel_launch: hipFuncSetAttribute failed\n"); grid = -1; return; }
        if (hipOccupancyMaxActiveBlocksPerMultiprocessor(&per_cu, (const void*)fwd, NWAVES * 64, LDS_BYTES) != hipSuccess || per_cu < 1) { fprintf(stderr, "kernel_launch: occupancy query says %d\n", per_cu); }
        (void)hipGetLastError();
        grid = cus;
    }
    if (grid < 0) return;
    (void)hipMemsetAsync((char*)d_ws + WS_CTL, 0, CTL_ZERO_BYTES, stream);
    Args a{};
    for (int i = 0; i < 28; ++i) a.in[i] = (const float*)d_in[i];
    a.out = (float*)d_out; a.ws = (unsigned char*)d_ws;
#if MK_ONE_LAUNCH
    a.g_lo = 0; a.g_hi = NG; a.l_lo = 0; a.l_hi = NL; a.ph_lo = 0; a.ph_hi = 13; a.prep = 1; a.use_bar = 1;
    hipLaunchKernelGGL(fwd, dim3(grid), dim3(NWAVES * 64), LDS_BYTES, stream, a);
#else
    a.use_bar = 0;
    a.prep = 1; a.g_lo = 0; a.g_hi = 0; a.l_lo = 0; a.l_hi = 0; a.ph_lo = 0; a.ph_hi = 0;
    hipLaunchKernelGGL(fwd, dim3(grid), dim3(NWAVES * 64), LDS_BYTES, stream, a);
    a.prep = 0;
    static const int cuts[] = {0, 1, 2, 3, 5, 7, 8, 9, 10, 11, 12, 13};
    for (int g = 0; g < NG; ++g) for (int l = 0; l < NL; ++l) for (int c = 0; c < 11; ++c) {
        if (c == 0 && l != 0) continue;
        a.g_lo = g; a.g_hi = g + 1; a.l_lo = l; a.l_hi = l + 1; a.ph_lo = cuts[c]; a.ph_hi = cuts[c + 1];
        hipLaunchKernelGGL(fwd, dim3(grid), dim3(NWAVES * 64), LDS_BYTES, stream, a);
    }
#endif
    const hipError_t le = hipPeekAtLastError();
    if (le != hipSuccess) fprintf(stderr, "kernel_launch: launch failed: %s\n", hipGetErrorName(le));
}
```

```cpp
#include <hip/hip_runtime.h>
#include <cstdio>
#include <cstdint>
namespace pg8 {
#define PG8_LAS __attribute__((address_space(3)))
typedef unsigned short bf16_t;
typedef short bf16x8 __attribute__((ext_vector_type(8)));
typedef float f32x4 __attribute__((ext_vector_type(4)));
typedef unsigned u32x4 __attribute__((ext_vector_type(4)));
constexpr int BM = 256, BK = 64, HALF = 128, HTB = HALF * BK * 2  , STAGE_BYTES = 8 * HTB, NXCD = 8, WGM = 8;

__host__ __device__ __forceinline__ int lds_byte(int r, int c) { const int st = (r >> 4) * 2 + (c >> 5), rr = r & 15, cc = c & 31, ob = rr * 64 + cc * 2; return st * 1024 + (ob ^ (((ob >> 9) & 1) << 5)); }
__host__ __device__ __forceinline__ void stage_rc(int b, int& R, int& C) { const int st = b / 1024, sb = b % 1024, swz = sb ^ (((sb >> 9) & 1) << 5); R = (st >> 1) * 16 + swz / 64; C = (st & 1) * 32 + (swz % 64) / 2; }
__host__ __device__ __forceinline__ int perm32(int rho) { const int n = rho >> 4, i = rho & 15; return 8 * (i >> 2) + 4 * n + (i & 3); }

struct Unit { int pm, pn; };
struct Gemm { const bf16_t* A; const bf16_t* Bt; int M, N, K; };

struct StaticOrder {
    int nM, nN, nwg, G, c;
    __host__ __device__ void init(int M, int N, int G_, int c_) { nM = M / BM; nN = N / BM; nwg = nM * nN; G = G_; c = c_; }
    __host__ __device__ bool next(int i, Unit& u) const {
        const long L = (long)i * G + c; if (L >= nwg) return false;
        int wgid = (int)L; { const int q = nwg / NXCD, r = nwg % NXCD, xcd = wgid % NXCD, off = wgid / NXCD; wgid = (xcd < r ? xcd * (q + 1) : r * (q + 1) + (xcd - r) * q) + off; }
        const int nig = WGM * nN, gid = wgid / nig, fm = gid * WGM, gsz = (nM - fm) < WGM ? (nM - fm) : WGM;
        u.pm = fm + ((wgid % nig) % gsz); u.pn = (wgid % nig) / gsz; return true;
    }
    __device__ __forceinline__ void a_ready(const Unit&) const {}
    __device__ __forceinline__ void done(const Unit&) const {}
};

__device__ __forceinline__ unsigned cvt_pk_bf16(float lo, float hi) { unsigned r; asm volatile("v_cvt_pk_bf16_f32 %0, %1, %2" : "=v"(r) : "v"(lo), "v"(hi)); return r; }
template <class Epi, class Sched, bool ALIGN_EPI = false, bool SP2 = false>
__device__ __forceinline__ void gemm_phase(PG8_LAS unsigned char* lds, const Gemm g, const Sched& S, const Epi& E) {
    int tid_ = threadIdx.x; asm volatile("" : "+v"(tid_));
    const int tid = tid_, wid = __builtin_amdgcn_readfirstlane(tid >> 6), lane = tid & 63, wr = wid >> 2, wc = wid & 3, fr = lane & 15, fq = lane >> 4;
    const int K = g.K, nt = K / BK;
    unsigned voffA[2], voffB[2];
#pragma unroll
    for (int i = 0; i < 2; ++i) { int R, C; stage_rc(tid * 16 + i * 8192, R, C); const int Rb = Epi::PERM ? ((R & ~31) + perm32(R & 31)) : R;
        voffA[i] = (unsigned)(R * K + C) * 2u; voffB[i] = (unsigned)(Rb * K + C) * 2u; }
    const size_t kstep = (size_t)(BK * 2);
    const size_t hstep = (size_t)HALF * K * 2;
    const size_t tstep = 2 * hstep;
    const unsigned ldsw = (unsigned)wid * 1024u;
    const int aoff = lds_byte(wr * 64 + fr, fq * 8), boff = lds_byte(wc * 32 + fr, fq * 8);
#define PG8_SA(b, h) (((b) * 2 + (h)) * HTB)
#define PG8_SB(b, h) ((4 + (b) * 2 + (h)) * HTB)
#define PG8_STAGE(bufoff, gbase, voff) do { _Pragma("unroll") for (int _i = 0; _i < 2; ++_i) \
        __builtin_amdgcn_global_load_lds((const unsigned*)((const char*)(gbase) + (voff)[_i]), (PG8_LAS unsigned*)(lds + (bufoff) + ldsw + _i * 8192), 16, 0, 0); } while (0)
#define PG8_LDA(dst, b, h) do { _Pragma("unroll") for (int m = 0; m < 4; ++m) _Pragma("unroll") for (int k = 0; k < 2; ++k) dst[m][k] = *(const PG8_LAS bf16x8*)(lds + PG8_SA(b, h) + aoff + m * 2048 + k * 1024); } while (0)
#define PG8_LDB(dst, b, h) do { _Pragma("unroll") for (int n = 0; n < 2; ++n) _Pragma("unroll") for (int k = 0; k < 2; ++k) dst[n][k] = *(const PG8_LAS bf16x8*)(lds + PG8_SB(b, h) + boff + n * 2048 + k * 1024); } while (0)
#define PG8_MMA(ai, bj, At, Bt) do { __builtin_amdgcn_s_setprio(1); _Pragma("unroll") for (int m = 0; m < 4; ++m) _Pragma("unroll") for (int n = 0; n < 2; ++n) _Pragma("unroll") for (int k = 0; k < 2; ++k) \
        acc[ai][bj][m][n] = __builtin_amdgcn_mfma_f32_16x16x32_bf16(Bt[n][k], At[m][k], acc[ai][bj][m][n], 0, 0, 0); __builtin_amdgcn_s_setprio(0); } while (0)
#define PG8_WAIT_V(n) asm volatile("s_waitcnt vmcnt(" #n ")" ::: "memory")
#define PG8_WAIT_L(n) asm volatile("s_waitcnt lgkmcnt(" #n ")" ::: "memory")
#define PG8_BAR __builtin_amdgcn_s_barrier()
#define PG8_SCHED __builtin_amdgcn_sched_barrier(0)
    Unit cur, nxt; int ui = 0;
    if (!S.next(0, cur)) return;
    f32x4 acc[2][2][4][2];
#pragma unroll
    for (int a = 0; a < 2; ++a)
#pragma unroll
        for (int b = 0; b < 2; ++b)
#pragma unroll
            for (int m = 0; m < 4; ++m)
#pragma unroll
                for (int n = 0; n < 2; ++n) acc[a][b][m][n] = (f32x4){0.f, 0.f, 0.f, 0.f};
    bf16x8 At[4][2], B0[2][2], B1[2][2];
    const char* cA = (const char*)g.A + (size_t)cur.pm * tstep; const char* cB = (const char*)g.Bt + (size_t)cur.pn * tstep;
    S.a_ready(cur);
    if constexpr (SP2) {
        PG8_STAGE(PG8_SB(0, 0), cB, voffB); PG8_STAGE(PG8_SB(0, 1), cB + hstep, voffB); PG8_STAGE(PG8_SA(0, 0), cA, voffA); PG8_STAGE(PG8_SA(0, 1), cA + hstep, voffA);
        if (wr == 1) PG8_BAR;
        PG8_WAIT_V(2); PG8_BAR;
        PG8_STAGE(PG8_SB(1, 0), cB + kstep, voffB); PG8_STAGE(PG8_SA(1, 0), cA + kstep, voffA); PG8_STAGE(PG8_SB(1, 1), cB + hstep + kstep, voffB);
        PG8_WAIT_V(6); PG8_BAR;
    } else {
        PG8_STAGE(PG8_SB(0, 0), cB, voffB); PG8_STAGE(PG8_SA(0, 0), cA, voffA); PG8_STAGE(PG8_SB(0, 1), cB + hstep, voffB); PG8_STAGE(PG8_SA(0, 1), cA + hstep, voffA);
        if (wr == 1) PG8_BAR;
        PG8_WAIT_V(4); PG8_BAR;
        PG8_STAGE(PG8_SB(1, 0), cB + kstep, voffB); PG8_STAGE(PG8_SA(1, 0), cA + kstep, voffA); PG8_STAGE(PG8_SB(1, 1), cB + hstep + kstep, voffB);
        PG8_WAIT_V(6); PG8_BAR;
    }
    for (;;) {
        const bool has_next = S.next(ui + 1, nxt);
        const char* nA = has_next ? (const char*)g.A + (size_t)nxt.pm * tstep : cA; const char* nB = has_next ? (const char*)g.Bt + (size_t)nxt.pn * tstep : cB;
        for (int t = 0; t < nt; t += 2) {
            const bool last = (t == nt - 2);
            const char* a1 = cA + (size_t)(t + 1) * kstep;
            const char* a2 = last ? nA : cA + (size_t)(t + 2) * kstep; const char* b2 = last ? nB : cB + (size_t)(t + 2) * kstep;
            const char* a3 = a2 + kstep; const char* b3 = b2 + kstep;
            if (last && has_next) S.a_ready(nxt);
            if constexpr (SP2) {
            PG8_LDB(B0, 0, 0); PG8_LDB(B1, 0, 1); PG8_SCHED; PG8_LDA(At, 0, 0); PG8_STAGE(PG8_SA(1, 1), a1 + hstep, voffA);
            PG8_WAIT_V(8); PG8_WAIT_L(0); PG8_BAR; PG8_MMA(0, 0, At, B0); PG8_MMA(0, 1, At, B1); PG8_BAR; PG8_SCHED;
            PG8_LDA(At, 0, 1); PG8_STAGE(PG8_SB(0, 0), b2, voffB); PG8_STAGE(PG8_SB(0, 1), b2 + hstep, voffB); PG8_STAGE(PG8_SA(0, 0), a2, voffA);
            PG8_WAIT_V(8); PG8_WAIT_L(0); PG8_BAR; PG8_MMA(1, 0, At, B0); PG8_MMA(1, 1, At, B1); PG8_BAR; PG8_SCHED;
            PG8_LDB(B0, 1, 0); PG8_LDB(B1, 1, 1); PG8_SCHED; PG8_LDA(At, 1, 0); PG8_STAGE(PG8_SA(0, 1), a2 + hstep, voffA);
            PG8_WAIT_V(8); PG8_WAIT_L(0); PG8_BAR; PG8_MMA(0, 0, At, B0); PG8_MMA(0, 1, At, B1); PG8_BAR; PG8_SCHED;
            PG8_LDA(At, 1, 1); PG8_STAGE(PG8_SB(1, 0), b3, voffB); PG8_STAGE(PG8_SB(1, 1), b3 + hstep, voffB); PG8_STAGE(PG8_SA(1, 0), a3, voffA);
            PG8_WAIT_V(8); PG8_WAIT_L(0); PG8_BAR; PG8_MMA(1, 0, At, B0); PG8_MMA(1, 1, At, B1); PG8_BAR; PG8_SCHED;
            } else {
            PG8_LDB(B0, 0, 0); PG8_SCHED; PG8_LDA(At, 0, 0); PG8_STAGE(PG8_SA(1, 1), a1 + hstep, voffA);
            PG8_WAIT_L(8); PG8_BAR; PG8_WAIT_L(0); PG8_MMA(0, 0, At, B0); PG8_BAR; PG8_SCHED;
            PG8_LDB(B1, 0, 1); PG8_STAGE(PG8_SB(0, 0), b2, voffB);
            PG8_BAR; PG8_WAIT_L(0); PG8_MMA(0, 1, At, B1); PG8_BAR;
            PG8_LDA(At, 0, 1); PG8_STAGE(PG8_SA(0, 0), a2, voffA);
            PG8_BAR; PG8_WAIT_L(0); PG8_MMA(1, 0, At, B0); PG8_BAR; PG8_SCHED;
            PG8_STAGE(PG8_SB(0, 1), b2 + hstep, voffB);
            PG8_WAIT_V(6); PG8_BAR; PG8_MMA(1, 1, At, B1); PG8_BAR;
            PG8_LDB(B0, 1, 0); PG8_SCHED; PG8_LDA(At, 1, 0); PG8_STAGE(PG8_SA(0, 1), a2 + hstep, voffA);
            PG8_WAIT_L(8); PG8_BAR; PG8_WAIT_L(0); PG8_MMA(0, 0, At, B0); PG8_BAR; PG8_SCHED;
            PG8_LDB(B1, 1, 1); PG8_STAGE(PG8_SB(1, 0), b3, voffB);
            PG8_BAR; PG8_WAIT_L(0); PG8_MMA(0, 1, At, B1); PG8_BAR;
            PG8_LDA(At, 1, 1); PG8_STAGE(PG8_SA(1, 0), a3, voffA);
            PG8_BAR; PG8_WAIT_L(0); PG8_MMA(1, 0, At, B0); PG8_BAR; PG8_SCHED;
            PG8_STAGE(PG8_SB(1, 1), b3 + hstep, voffB);
            PG8_WAIT_V(6); PG8_BAR; PG8_MMA(1, 1, At, B1); PG8_BAR;
            }
        }
        if constexpr (ALIGN_EPI) { if (wr == 0) PG8_BAR; }
        if constexpr (!Epi::AFTER_DRAIN) { E(acc, cur, wr, wc, fr, fq); S.done(cur); }
        if (!has_next) break;
#pragma unroll
        for (int a = 0; a < 2; ++a)
#pragma unroll
            for (int b = 0; b < 2; ++b)
#pragma unroll
                for (int m = 0; m < 4; ++m)
#pragma unroll
                    for (int n = 0; n < 2; ++n) acc[a][b][m][n] = (f32x4){0.f, 0.f, 0.f, 0.f};
        cur = nxt; cA = nA; cB = nB; ++ui;
        if constexpr (ALIGN_EPI) { if (wr == 1) PG8_BAR; }
    }
    PG8_WAIT_V(0);
    if constexpr (!ALIGN_EPI) { if (wr == 0) PG8_BAR; }
    PG8_BAR;
    if constexpr (Epi::AFTER_DRAIN) { E.fused(acc, cur, wr, wc, fr, fq, lds, wid, lane); S.done(cur); }
#undef PG8_SA
#undef PG8_SB
#undef PG8_STAGE
#undef PG8_LDA
#undef PG8_LDB
#undef PG8_MMA
#undef PG8_WAIT_V
#undef PG8_WAIT_L
#undef PG8_BAR
#undef PG8_SCHED
}
}

constexpr int NB = 32, SEQ = 2048, NMETA = 16, TT = SEQ + NMETA, D = 1024, NL = 4, DFF = 4096;
constexpr int NG = 4, GB = NB / NG, MR = GB * SEQ  , MT = MR + NMETA  ;
constexpr int NCOLS = 9696, NZ = 9728, ZB = 9216, ZFW = 512;
constexpr float EPS = 1e-6f;
constexpr int ZC_GQ = 0, ZC_GK = 512, ZC_GV = 1024, ZC_GR = 2048, ZC_MQ = 3072, ZC_MK = 3584, ZC_MV = 4096, ZC_MO = 5120, ZC_GATE = 6144;
constexpr int ZF_CQ = 0, ZF_CKV = 256, ZF_IK = 384, ZF_A = 448, ZF_IW = 464, ZF_MI = 472, ZF_MF = 476;
constexpr int NQQ = 2560;

constexpr size_t MiB = 1u << 20;
constexpr size_t WS_CTL = 0, CTL_ZERO_BYTES = 1 * MiB;
constexpr size_t WS_BIN = 1 * MiB;
constexpr size_t WS_WIN = 2 * MiB;
constexpr size_t WS_WQQ = 78 * MiB;
constexpr size_t WS_WBG = 83 * MiB;
constexpr size_t WS_WBM = 91 * MiB;
constexpr size_t WS_WBD = 99 * MiB;
constexpr size_t WS_WOUT = 115 * MiB;
constexpr size_t WS_WUP = 123 * MiB;
constexpr size_t WS_WDN = 155 * MiB;
constexpr size_t WS_HM = 187 * MiB;
constexpr size_t WS_XN = 188 * MiB;
constexpr size_t WS_ZF = 221 * MiB;
constexpr size_t WS_CQN = 254 * MiB;
constexpr size_t WS_KV = 263 * MiB;
constexpr size_t WS_KI = 268 * MiB;
constexpr size_t WS_WI = 271 * MiB;
constexpr size_t WS_LIF = 272 * MiB;
constexpr size_t WS_G = 273 * MiB;
constexpr size_t WS_QKC = 306 * MiB;
constexpr size_t WS_QQ = 339 * MiB;
constexpr size_t WS_OG = 420 * MiB;
constexpr size_t WS_OM = 453 * MiB;
constexpr size_t WS_OD = 486 * MiB;
constexpr size_t WS_Z = 551 * MiB;
constexpr size_t WS_MIX = 840 * MiB;
constexpr size_t WS_Y = 873 * MiB;
constexpr size_t WS_SC = 840 * MiB;
constexpr size_t WS_DD = 1020 * MiB;
constexpr size_t WS_END = 1024 * MiB;
constexpr int SC_PITCH = 2080;
static_assert(WS_Z + (size_t)MT * ZB * 2 <= WS_MIX && WS_Y + (size_t)MT * D * 4 <= WS_END && WS_SC + (size_t)256 * 64 * SC_PITCH * 4 <= WS_END, "ws map");

constexpr int CW_BAR = 4096;

constexpr int RING_BYTES = 131072;
constexpr int MISC_OFF = RING_BYTES + 320;
constexpr int LDS_BYTES = 147456;
constexpr int NWAVES = 8;

#define LAS __attribute__((address_space(3)))
typedef unsigned short bf16;
typedef float f32x4 __attribute__((ext_vector_type(4)));
typedef float f32x2 __attribute__((ext_vector_type(2)));
typedef unsigned u32x4 __attribute__((ext_vector_type(4)));
typedef unsigned u32x2 __attribute__((ext_vector_type(2)));
typedef short bf16x8 __attribute__((ext_vector_type(8)));
typedef short s16x4 __attribute__((ext_vector_type(4)));
#define LDS_WAIT() asm volatile("s_waitcnt lgkmcnt(0)" ::: "memory")
#define VM_WAIT() asm volatile("s_waitcnt vmcnt(0)" ::: "memory")

__device__ __forceinline__ unsigned f2bf(float f) { unsigned u = __builtin_bit_cast(unsigned, f); return (u + 0x7fffu + ((u >> 16) & 1u)) >> 16; }
__device__ __forceinline__ unsigned pk2(float lo, float hi) { return f2bf(lo) | (f2bf(hi) << 16); }
__device__ __forceinline__ float bf2f(unsigned b) { return __builtin_bit_cast(float, b << 16); }
__device__ __forceinline__ float bflo(unsigned w) { return __builtin_bit_cast(float, w << 16); }
__device__ __forceinline__ float bfhi(unsigned w) { return __builtin_bit_cast(float, w & 0xffff0000u); }
__device__ __forceinline__ float wave_sum(float v) {
#pragma unroll
    for (int o = 1; o < 64; o <<= 1) v += __shfl_xor(v, o);
    return v;
}
__device__ __forceinline__ float wave_max(float v) {
#pragma unroll
    for (int o = 1; o < 64; o <<= 1) v = fmaxf(v, __shfl_xor(v, o));
    return v;
}
__device__ __forceinline__ float sigmoid_f(float x) { return 1.f / (1.f + __expf(-x)); }
__device__ __forceinline__ float silu_f(float x) { return x * sigmoid_f(x); }
__device__ __forceinline__ float logsigmoid_f(float x) { return fminf(x, 0.f) - log1pf(__expf(-fabsf(x))); }

#define XB_TMO      128
#define XB_XCNT(j)  (256  + 64 * (j))
#define XB_XSUB(j)  (1280 + 64 * (j))
#define XB_XGEN(j)  (2304 + 64 * (j))
#define XB_TOP      3328
#define XB_TOPGEN   3392
#define XCD_BAR_WORDS 3456
#define XB_SPIN_CAP (1u << 22)

__device__ __forceinline__ unsigned xb_ld(unsigned* p)              { return __hip_atomic_load(p, __ATOMIC_RELAXED, __HIP_MEMORY_SCOPE_AGENT); }
__device__ __forceinline__ unsigned xb_add(unsigned* p, unsigned v) { return __hip_atomic_fetch_add(p, v, __ATOMIC_RELAXED, __HIP_MEMORY_SCOPE_AGENT); }
__device__ __forceinline__ unsigned xb_xcc_id() { return (unsigned)__builtin_amdgcn_s_getreg((3 << 11) | 20) & 0xFu; }
#define XB_SPIN(cond, bar) do { unsigned _sp = 0; while (cond) { __builtin_amdgcn_s_sleep(1); \
    if ((++_sp & 255u) == 0u) { if (xb_ld(&(bar)[XB_TMO])) break; if (_sp > XB_SPIN_CAP) { atomicAdd(&(bar)[XB_TMO], 1u); break; } } } } while (0)

struct XcdBarrier {
    unsigned* bar; unsigned x;
    volatile LAS unsigned* st;
};

__device__ __forceinline__ XcdBarrier xcd_barrier_post(unsigned* bar, volatile LAS unsigned* st) {
    XcdBarrier b; b.bar = bar; b.x = xb_xcc_id(); b.st = st;
    if (threadIdx.x == 0) (void)xb_add(&bar[XB_XCNT(b.x)], 1u);
    return b;
}
__device__ __forceinline__ void xcd_barrier_complete(unsigned* bar, unsigned x, unsigned& nloc, unsigned& nx) {
    const unsigned G = gridDim.x * gridDim.y * gridDim.z;
    unsigned sum, cnt, mine, sp = 0u;
    for (;;) {
        sum = 0u; cnt = 0u; mine = 0u;
#pragma unroll
        for (unsigned j = 0; j < 16; ++j) { const unsigned c = xb_ld(&bar[XB_XCNT(j)]); sum += c; cnt += (c > 0u) ? 1u : 0u; mine = (j == x) ? c : mine; }
        if (sum == G) break;
        __builtin_amdgcn_s_sleep(1);
        if ((++sp & 255u) == 0u) { if (xb_ld(&bar[XB_TMO])) break; if (sp > XB_SPIN_CAP) { atomicAdd(&bar[XB_TMO], 1u); break; } }
    }
    nloc = mine > 0u ? mine : 1u; nx = cnt > 0u ? cnt : 1u;
}

__device__ __forceinline__ void xcd_barrier(const XcdBarrier& b) {
    asm volatile("s_waitcnt vmcnt(0)" ::: "memory");
    __syncthreads();
    if (threadIdx.x == 0) {
        unsigned* bar = b.bar;
        __builtin_amdgcn_s_waitcnt(0);
        unsigned nloc = b.st[0], nx = b.st[1];
        if (nloc == 0u) { xcd_barrier_complete(bar, b.x, nloc, nx); b.st[0] = nloc; b.st[1] = nx; }
        const unsigned old = xb_add(&bar[XB_XSUB(b.x)], 1u);
        const unsigned gen = old / nloc;
        if (old + 1u == (gen + 1u) * nloc) {
            __builtin_amdgcn_fence(__ATOMIC_RELEASE, "agent");
            asm volatile("s_waitcnt vmcnt(0)" ::: "memory");
            const unsigned og = xb_add(&bar[XB_TOP], 1u);
            const unsigned tg = og / nx;
            if (og + 1u == (tg + 1u) * nx) xb_add(&bar[XB_TOPGEN], 1u);
            else XB_SPIN(xb_ld(&bar[XB_TOPGEN]) == tg, bar);
            __builtin_amdgcn_fence(__ATOMIC_ACQUIRE, "agent");
            xb_add(&bar[XB_XGEN(b.x)], 1u);
            asm volatile("s_waitcnt vmcnt(0)" ::: "memory");
        } else {
            XB_SPIN(xb_ld(&bar[XB_XGEN(b.x)]) == gen, bar);
            __builtin_amdgcn_fence(__ATOMIC_ACQUIRE, "agent");
            asm volatile("s_waitcnt vmcnt(0)" ::: "memory");
        }
    }
    __syncthreads();
}


struct Args { const float* in[28]; float* out; unsigned char* ws; int g_lo, g_hi, l_lo, l_hi, ph_lo, ph_hi, prep, use_bar; };
typedef const __attribute__((address_space(4))) Args* ArgsP;
enum { I_X = 0, I_META, I_T5, I_GPREMIX, I_WIN, I_BIN, I_WA2, I_BA, I_GGLA, I_WBRG, I_GDQ, I_WUQ, I_WIQ, I_GDKV, I_WUV, I_LNG, I_LNB, I_WBRD,
       I_CONV, I_FB, I_GML, I_WBRM, I_WOUT, I_GPOSTMIX, I_GPREMLP, I_WUP, I_WDN, I_GPOSTMLP };

__device__ __forceinline__ int win_src(int n) {
    if (n < 3072) return n;
    if (n < 6144) return n - 3072 + 3544;
    if (n < 9216) return n - 6144 + 6624;
    if (n < 9472) return n - 9216 + 3088;
    if (n < 9600) return n - 9472 + 3344;
    if (n < 9664) return n - 9600 + 3472;
    if (n < 9680) return n - 9664 + 3072;
    if (n < 9688) return n - 9680 + 3536;
    if (n < 9692) return n - 9688 + 6616;
    if (n < 9696) return n - 9692 + 6620;
    return -1;
}
struct CmIdent { __device__ __forceinline__ int operator()(int n) const { return n; } };
struct CmWin { __device__ __forceinline__ int operator()(int n) const { return win_src(n); } };

template <class CM>
__device__ __forceinline__ void tr_item(const float* __restrict__ W, int ldw, bf16* __restrict__ WT, int Kd, LAS float* scr, int k0, int ns0, int nd0, int lane, CM cm) {
    const int sc = cm(ns0 + (lane & 31));
#pragma unroll 8
    for (int i = 0; i < 32; ++i) { const int kk = 2 * i + (lane >> 5); scr[kk * 33 + (lane & 31)] = sc >= 0 ? W[(size_t)(k0 + kk) * ldw + sc] : 0.f; }
    LDS_WAIT();
    const int c = lane & 7;
#pragma unroll
    for (int j = 0; j < 4; ++j) { const int n = (lane >> 3) + 8 * j; const LAS float* s = scr + (8 * c) * 33 + n;
        u32x4 o; o.x = pk2(s[0 * 33], s[1 * 33]); o.y = pk2(s[2 * 33], s[3 * 33]); o.z = pk2(s[4 * 33], s[5 * 33]); o.w = pk2(s[6 * 33], s[7 * 33]);
        *(u32x4*)(WT + (size_t)(nd0 + n) * Kd + k0 + 8 * c) = o; }
    LDS_WAIT();
}

__device__ __forceinline__ void prep_weights(ArgsP a, LAS unsigned char* lds, int gw, int ngw, int wave, int lane) {
    LAS float* scr = (LAS float*)(lds + wave * 16384);
    unsigned char* ws = a->ws;
    constexpr int I_WIN_N = 16 * 304, I_UQ = 4 * 64, I_IQ = 4 * 16, I_SQ = 16 * 32, I_UP = 16 * 128, I_DN = 64 * 32, I_WBD = 512, I_B = NZ / 64;
    constexpr int PER_L = I_WIN_N + I_UQ + I_IQ + 3 * I_SQ + I_UP + I_DN + I_WBD + I_B;
    for (int it = gw; it < NL * PER_L; it += ngw) {
        const int l = it / PER_L; int r = it % PER_L;
        if (r < I_WIN_N) { const int kb = r / 304, nb = r % 304;
            tr_item(a->in[I_WIN] + (size_t)l * D * NCOLS, NCOLS, (bf16*)(ws + WS_WIN) + (size_t)l * NZ * D, D, scr, kb * 64, nb * 32, nb * 32, lane, CmWin()); continue; }
        r -= I_WIN_N;
        if (r < I_UQ) { const int kb = r / 64, nb = r % 64;
            tr_item(a->in[I_WUQ] + (size_t)l * 256 * 2048, 2048, (bf16*)(ws + WS_WQQ) + (size_t)l * NQQ * 256, 256, scr, kb * 64, nb * 32, nb * 32, lane, CmIdent()); continue; }
        r -= I_UQ;
        if (r < I_IQ) { const int kb = r / 16, nb = r % 16;
            tr_item(a->in[I_WIQ] + (size_t)l * 256 * 512, 512, (bf16*)(ws + WS_WQQ) + (size_t)l * NQQ * 256, 256, scr, kb * 64, nb * 32, 2048 + nb * 32, lane, CmIdent()); continue; }
        r -= I_IQ;
        if (r < I_SQ) { const int kb = r / 32, nb = r % 32;
            tr_item(a->in[I_WBRG] + (size_t)l * D * D, D, (bf16*)(ws + WS_WBG) + (size_t)l * D * D, D, scr, kb * 64, nb * 32, nb * 32, lane, CmIdent()); continue; }
        r -= I_SQ;
        if (r < I_SQ) { const int kb = r / 32, nb = r % 32;
            tr_item(a->in[I_WBRM] + (size_t)l * D * D, D, (bf16*)(ws + WS_WBM) + (size_t)l * D * D, D, scr, kb * 64, nb * 32, nb * 32, lane, CmIdent()); continue; }
        r -= I_SQ;
        if (r < I_SQ) { const int kb = r / 32, nb = r % 32;
            tr_item(a->in[I_WOUT] + (size_t)l * D * D, D, (bf16*)(ws + WS_WOUT) + (size_t)l * D * D, D, scr, kb * 64, nb * 32, nb * 32, lane, CmIdent()); continue; }
        r -= I_SQ;
        if (r < I_UP) { const int kb = r / 128, nb = r % 128;
            tr_item(a->in[I_WUP] + (size_t)l * D * DFF, DFF, (bf16*)(ws + WS_WUP) + (size_t)l * DFF * D, D, scr, kb * 64, nb * 32, nb * 32, lane, CmIdent()); continue; }
        r -= I_UP;
        if (r < I_DN) { const int kb = r / 32, nb = r % 32;
            tr_item(a->in[I_WDN] + (size_t)l * DFF * D, D, (bf16*)(ws + WS_WDN) + (size_t)l * D * DFF, DFF, scr, kb * 64, nb * 32, nb * 32, lane, CmIdent()); continue; }
        r -= I_DN;
        if (r < I_WBD) {
            const int h = r >> 5, ch = (r >> 4) & 1, nb = r & 15, c = ch * 64 + lane;
            const float* uv = a->in[I_WUV] + ((size_t)(l * 16 + h) * 128 + c) * 64;
            const float* wb = a->in[I_WBRD] + ((size_t)l * D + h * 64) * D + nb * 64;
            bf16* o = (bf16*)(ws + WS_WBD) + (size_t)l * D * 2048 + (size_t)(nb * 64) * 2048 + h * 128 + c;
            f32x4 w[16];
#pragma unroll
            for (int i = 0; i < 16; ++i) w[i] = *(const f32x4*)(uv + 4 * i);
            for (int nn = 0; nn < 64; ++nn) {
                float acc = 0.f;
#pragma unroll
                for (int i = 0; i < 16; ++i) { acc += w[i].x * wb[(size_t)(4 * i + 0) * D + nn] + w[i].y * wb[(size_t)(4 * i + 1) * D + nn] + w[i].z * wb[(size_t)(4 * i + 2) * D + nn] + w[i].w * wb[(size_t)(4 * i + 3) * D + nn]; }
                o[(size_t)nn * 2048] = (bf16)f2bf(acc);
            }
            continue; }
        r -= I_WBD;
        { const int n = r * 64 + lane; const int sc = win_src(n);
          ((float*)(ws + WS_BIN))[l * NZ + n] = sc >= 0 ? a->in[I_BIN][l * NCOLS + sc] : 0.f; }
    }
}

__device__ __forceinline__ float* hrow(ArgsP a, int g, int r) {
    return r < MR ? a->out + ((size_t)g * MR + r) * D : (float*)(a->ws + WS_HM) + (size_t)(r - MR) * D;
}
__device__ __forceinline__ void rms_row_bf16(const f32x4 (&v)[4], const float* __restrict__ gain, bf16* __restrict__ orow, int lane) {
    float s = 0.f;
#pragma unroll
    for (int j = 0; j < 4; ++j) s += (v[j].x * v[j].x + v[j].y * v[j].y) + (v[j].z * v[j].z + v[j].w * v[j].w);
    const float r = rsqrtf(wave_sum(s) * (1.f / D) + EPS);
#pragma unroll
    for (int j = 0; j < 4; ++j) { const f32x4 gg = *(const f32x4*)(gain + 4 * lane + 256 * j); const f32x4 o = v[j] * r * gg;
        u32x2 w; w.x = pk2(o.x, o.y); w.y = pk2(o.z, o.w); *(u32x2*)(orow + 4 * lane + 256 * j) = w; }
}
__device__ __forceinline__ void p0_init(ArgsP a, int g, int gw, int ngw, int lane) {
    bf16* XN = (bf16*)(a->ws + WS_XN);
    for (int r = gw; r < MT; r += ngw) {
        const float* src = r < MR ? a->in[I_X] + ((size_t)g * MR + r) * D : a->in[I_META] + (size_t)(r - MR) * D;
        float* hd = hrow(a, g, r);
        f32x4 v[4];
#pragma unroll
        for (int j = 0; j < 4; ++j) { v[j] = *(const f32x4*)(src + 4 * lane + 256 * j); *(f32x4*)(hd + 4 * lane + 256 * j) = v[j]; }
        rms_row_bf16(v, a->in[I_GPREMIX], XN + (size_t)r * D, lane);
    }
}
__device__ __forceinline__ void p_norm_res(ArgsP a, int g, const float* gpost, const float* gpre, int gw, int ngw, int lane) {
    bf16* XN = (bf16*)(a->ws + WS_XN); const float* Y = (const float*)(a->ws + WS_Y);
    for (int r = gw; r < MT; r += ngw) {
        float* hd = hrow(a, g, r);
        f32x4 y[4], v[4]; float s = 0.f;
#pragma unroll
        for (int j = 0; j < 4; ++j) { y[j] = *(const f32x4*)(Y + (size_t)r * D + 4 * lane + 256 * j); v[j] = *(const f32x4*)(hd + 4 * lane + 256 * j);
            s += (y[j].x * y[j].x + y[j].y * y[j].y) + (y[j].z * y[j].z + y[j].w * y[j].w); }
        const float rr = rsqrtf(wave_sum(s) * (1.f / D) + EPS);
#pragma unroll
        for (int j = 0; j < 4; ++j) { const f32x4 gg = *(const f32x4*)(gpost + 4 * lane + 256 * j); v[j] = v[j] + y[j] * rr * gg; *(f32x4*)(hd + 4 * lane + 256 * j) = v[j]; }
        if (gpre) rms_row_bf16(v, gpre, XN + (size_t)r * D, lane);
    }
}

template <class F> struct EpiT {
    static constexpr bool PERM = true, AFTER_DRAIN = false;
    F f;
    __device__ __forceinline__ void operator()(const f32x4 (&acc)[2][2][4][2], const pg8::Unit& u, int wr, int wc, int fr, int fq) const {
        const int row0 = u.pm * 256 + wr * 64 + fr, col0 = u.pn * 256 + wc * 32 + 8 * fq;
#pragma unroll
        for (int ai = 0; ai < 2; ++ai)
#pragma unroll
            for (int m = 0; m < 4; ++m)
#pragma unroll
                for (int bj = 0; bj < 2; ++bj) { f.apply(row0 + ai * 128 + m * 16, col0 + bj * 128, acc[ai][bj][m][0], acc[ai][bj][m][1]); asm volatile("" ::: "memory"); }
    }
};
__device__ __forceinline__ void st_bf16x8(bf16* p, f32x4 v0, f32x4 v1) { u32x4 w; w.x = pk2(v0.x, v0.y); w.y = pk2(v0.z, v0.w); w.z = pk2(v1.x, v1.y); w.w = pk2(v1.z, v1.w); *(u32x4*)p = w; }
__device__ __forceinline__ void ld_bf16x8(const bf16* p, f32x4& v0, f32x4& v1) { const u32x4 w = *(const u32x4*)p;
    v0 = (f32x4){bflo(w.x), bfhi(w.x), bflo(w.y), bfhi(w.y)}; v1 = (f32x4){bflo(w.z), bfhi(w.z), bflo(w.w), bfhi(w.w)}; }

struct FIn {
    bf16* Z; float* ZF; const float* bias;
    __device__ __forceinline__ void apply(int row, int col, f32x4 v0, f32x4 v1) const {
        v0 += *(const f32x4*)(bias + col); v1 += *(const f32x4*)(bias + col + 4);
        const int t = col >> 8;
        if (t >= 36) { float* p = ZF + (size_t)row * ZFW + (col - ZB); *(f32x4*)p = v0; *(f32x4*)(p + 4) = v1; return; }
        if (t < 2) { v0 *= 0.08838834764831845f; v1 *= 0.08838834764831845f; }
        else if (t >= 8 && t < 12) {
#pragma unroll
            for (int i = 0; i < 4; ++i) { v0[i] = silu_f(v0[i]); v1[i] = silu_f(v1[i]); } }
        else if (t >= 20) {
#pragma unroll
            for (int i = 0; i < 4; ++i) { v0[i] = sigmoid_f(v0[i]); v1[i] = sigmoid_f(v1[i]); } }
        st_bf16x8(Z + (size_t)row * ZB + col, v0, v1);
    }
};
struct FQQ {
    bf16* QQ;
    __device__ __forceinline__ void apply(int row, int col, f32x4 v0, f32x4 v1) const {
        const float s = col < 2048 ? 0.08838834764831845f : 0.125f;
        st_bf16x8(QQ + (size_t)row * NQQ + col, v0 * s, v1 * s);
    }
};
template <int IDX> struct FBr {
    const bf16* Z; float* Y; bf16* MIX;
    __device__ __forceinline__ void apply(int row, int col, f32x4 v0, f32x4 v1) const {
        f32x4 g0, g1; ld_bf16x8(Z + (size_t)row * ZB + ZC_GATE + IDX * 1024 + col, g0, g1);
        float* y = Y + (size_t)row * D + col;
        f32x4 a0 = v0 * g0, a1 = v1 * g1;
        if (IDX > 0) { a0 += *(const f32x4*)y; a1 += *(const f32x4*)(y + 4); }
        if (IDX < 2) { *(f32x4*)y = a0; *(f32x4*)(y + 4) = a1; }
        else st_bf16x8(MIX + (size_t)row * D + col, a0, a1);
    }
};
struct FY {
    float* Y;
    __device__ __forceinline__ void apply(int row, int col, f32x4 v0, f32x4 v1) const { float* y = Y + (size_t)row * D + col; *(f32x4*)y = v0; *(f32x4*)(y + 4) = v1; }
};
struct FUp {
    bf16* U;
    __device__ __forceinline__ void apply(int row, int col, f32x4 v0, f32x4 v1) const {
#pragma unroll
        for (int i = 0; i < 4; ++i) { const float p = fmaxf(v0[i], 0.f), q = fmaxf(v1[i], 0.f); v0[i] = p * p; v1[i] = q * q; }
        st_bf16x8(U + (size_t)row * DFF + col, v0, v1);
    }
};

template <class F>
__device__ __forceinline__ void mini_gemm(const bf16* __restrict__ A, const bf16* __restrict__ Bt, int N, int K, const F& f, int gw, int ngw, int lane) {
    const int fr = lane & 15, fq = lane >> 4;
    for (int wt = gw; wt < N / 32; wt += ngw) {
        const int n0 = wt * 32;
        f32x4 acc0 = {0.f, 0.f, 0.f, 0.f}, acc1 = {0.f, 0.f, 0.f, 0.f};
        const bf16* ap = A + (size_t)(MR + fr) * K + fq * 8;
        const bf16* b0 = Bt + (size_t)(n0 + pg8::perm32(fr)) * K + fq * 8;
        const bf16* b1 = Bt + (size_t)(n0 + pg8::perm32(16 + fr)) * K + fq * 8;
        for (int k = 0; k < K; k += 32) {
            const bf16x8 av = *(const bf16x8*)(ap + k), w0 = *(const bf16x8*)(b0 + k), w1 = *(const bf16x8*)(b1 + k);
            acc0 = __builtin_amdgcn_mfma_f32_16x16x32_bf16(w0, av, acc0, 0, 0, 0);
            acc1 = __builtin_amdgcn_mfma_f32_16x16x32_bf16(w1, av, acc1, 0, 0, 0);
        }
        f.apply(MR + fr, n0 + 8 * fq, acc0, acc1);
    }
}
template <class F>
__device__ __forceinline__ void run_gemm(LAS unsigned char* lds, const bf16* A, const bf16* Bt, int N, int K, const F& f, int gw, int ngw, int lane) {
    asm volatile("" : "+s"(K)); asm volatile("" : "+s"(N));
    pg8::Gemm g{A, Bt, MR, N, K}; pg8::StaticOrder S; S.init(MR, N, (int)gridDim.x, (int)blockIdx.x);
    EpiT<F> E{f};
    pg8::gemm_phase<EpiT<F>, pg8::StaticOrder, true, true>((PG8_LAS unsigned char*)lds, g, S, E);
    mini_gemm(A, Bt, N, K, f, gw, ngw, lane);
}

__device__ __forceinline__ int prow(int r, int j) {
    if (r < MR) { const int s = r & (SEQ - 1); return (s - j >= 0) ? r - j : MR + (NMETA + s - j); }
    const int t = r - MR; return (t - j >= 0) ? r - j : -1;
}
__device__ __forceinline__ void p2_prep(ArgsP a, int l, int gw, int ngw, int lane) {
    unsigned char* ws = a->ws;
    const bf16* Z = (const bf16*)(ws + WS_Z);
    for (int r = gw; r < MT; r += ngw) {
        const float* zf = (const float*)(ws + WS_ZF) + (size_t)r * ZFW;
        {
            f32x4 v = *(const f32x4*)(zf + ZF_CQ + 4 * lane);
            const float rr = rsqrtf(wave_sum((v.x * v.x + v.y * v.y) + (v.z * v.z + v.w * v.w)) * (1.f / 256.f) + EPS);
            const f32x4 gg = *(const f32x4*)(a->in[I_GDQ] + l * 256 + 4 * lane); v = v * rr * gg;
            u32x2 w; w.x = pk2(v.x, v.y); w.y = pk2(v.z, v.w); *(u32x2*)((bf16*)(ws + WS_CQN) + (size_t)r * 256 + 4 * lane) = w;
        }
        {
            f32x2 v = *(const f32x2*)(zf + ZF_CKV + 2 * lane);
            const float rr = rsqrtf(wave_sum(v.x * v.x + v.y * v.y) * (1.f / 128.f) + EPS);
            const f32x2 gg = *(const f32x2*)(a->in[I_GDKV] + l * 128 + 2 * lane);
            *(unsigned*)((bf16*)(ws + WS_KV) + (size_t)r * 128 + 2 * lane) = pk2(v.x * rr * gg.x, v.y * rr * gg.y);
        }
        {
            const float v = zf[ZF_IK + lane]; const float mu = wave_sum(v) * (1.f / 64.f); const float d = v - mu;
            const float var = wave_sum(d * d) * (1.f / 64.f);
            const float y = d * rsqrtf(var + EPS) * a->in[I_LNG][l * 64 + lane] + a->in[I_LNB][l * 64 + lane];
            ((bf16*)(ws + WS_KI))[(size_t)r * 64 + lane] = (bf16)f2bf(y);
        }
        if (lane < 8) ((float*)(ws + WS_WI))[(size_t)r * 8 + lane] = zf[ZF_IW + lane] * 0.35355339059327373f;
    }
    float* DDp = (float*)(ws + WS_DD);
    for (int it = gw; it < 257 * 8; it += ngw) {
        const int cid = it >> 3, mx = (it >> 2) & 1, h = it & 3;
        const int nrows = cid == 256 ? NMETA : 64, rbase = cid == 256 ? MR : cid * 64;
        const int k0 = 2 * lane;
        if (!mx) {
            float w0[16], w1[16];
#pragma unroll
            for (int j = 0; j < 16; ++j) { const f32x2 w = *(const f32x2*)(a->in[I_WA2] + (size_t)(l * 16 + j) * 512 + h * 128 + k0); w0[j] = w.x; w1[j] = w.y; }
            const f32x2 bb = *(const f32x2*)(a->in[I_BA] + l * 512 + h * 128 + k0);
            bf16* QG = (bf16*)(ws + WS_G);
            float G0 = 0.f, G1 = 0.f;
            for (int t = 0; t < nrows; ++t) {
                const int r = rbase + t;
                const float* zf = (const float*)(ws + WS_ZF) + (size_t)r * ZFW + ZF_A;
                const f32x4 a0 = *(const f32x4*)zf, a1 = *(const f32x4*)(zf + 4), a2 = *(const f32x4*)(zf + 8), a3 = *(const f32x4*)(zf + 12);
                const float av[16] = {a0.x, a0.y, a0.z, a0.w, a1.x, a1.y, a1.z, a1.w, a2.x, a2.y, a2.z, a2.w, a3.x, a3.y, a3.z, a3.w};
                float s0 = bb.x, s1 = bb.y;
#pragma unroll
                for (int j = 0; j < 16; ++j) { s0 += av[j] * w0[j]; s1 += av[j] * w1[j]; }
                G0 += logsigmoid_f(s0) * 0.0625f; G1 += logsigmoid_f(s1) * 0.0625f;
                const unsigned qw = *(const unsigned*)(Z + (size_t)r * ZB + ZC_GQ + h * 128 + k0), kw = *(const unsigned*)(Z + (size_t)r * ZB + ZC_GK + h * 128 + k0);
                const float e0 = __expf(G0), e1 = __expf(G1), i0 = __expf(-G0), i1 = __expf(-G1);
                *(unsigned*)(QG + (size_t)r * 1024 + h * 128 + k0) = pk2(bflo(qw) * e0, bfhi(qw) * e1);
                *(unsigned*)(QG + (size_t)r * 1024 + 512 + h * 128 + k0) = pk2(bflo(kw) * i0, bfhi(kw) * i1);
            }
            *(f32x2*)(DDp + ((size_t)cid * 4 + h) * 128 + k0) = (f32x2){__expf(G0), __expf(G1)};
        } else {
            float cq[4][2], ck[4][2];
#pragma unroll
            for (int tap = 0; tap < 4; ++tap) { const f32x2 wq = *(const f32x2*)(a->in[I_CONV] + (size_t)(l * 4 + tap) * 1024 + h * 128 + k0), wk = *(const f32x2*)(a->in[I_CONV] + (size_t)(l * 4 + tap) * 1024 + 512 + h * 128 + k0);
                cq[tap][0] = wq.x; cq[tap][1] = wq.y; ck[tap][0] = wk.x; ck[tap][1] = wk.y; }
            const float fb = a->in[I_FB][l * 4 + h];
            bf16* QM = (bf16*)(ws + WS_QKC);
            float xq[3][2], xk[3][2];
#pragma unroll
            for (int j = 0; j < 3; ++j) {
                const int rp = prow(rbase, j + 1);
                unsigned qw = 0u, kw = 0u;
                if (rp >= 0) { qw = *(const unsigned*)(Z + (size_t)rp * ZB + ZC_MQ + h * 128 + k0); kw = *(const unsigned*)(Z + (size_t)rp * ZB + ZC_MK + h * 128 + k0); }
                xq[j][0] = bflo(qw); xq[j][1] = bfhi(qw); xk[j][0] = bflo(kw); xk[j][1] = bfhi(kw);
            }
            float bsum = 0.f;
            for (int t = 0; t < nrows; ++t) {
                const int r = rbase + t;
                const float* zf = (const float*)(ws + WS_ZF) + (size_t)r * ZFW;
                const float li = zf[ZF_MI + h], lf = logsigmoid_f(zf[ZF_MF + h] + fb);
                bsum += lf;
                const unsigned qw = *(const unsigned*)(Z + (size_t)r * ZB + ZC_MQ + h * 128 + k0), kw = *(const unsigned*)(Z + (size_t)r * ZB + ZC_MK + h * 128 + k0);
                const float q0 = bflo(qw), q1 = bfhi(qw), kk0 = bflo(kw), kk1 = bfhi(kw);
                float yq0 = cq[3][0] * q0 + cq[2][0] * xq[0][0] + cq[1][0] * xq[1][0] + cq[0][0] * xq[2][0];
                float yq1 = cq[3][1] * q1 + cq[2][1] * xq[0][1] + cq[1][1] * xq[1][1] + cq[0][1] * xq[2][1];
                float yk0 = ck[3][0] * kk0 + ck[2][0] * xk[0][0] + ck[1][0] * xk[1][0] + ck[0][0] * xk[2][0];
                float yk1 = ck[3][1] * kk1 + ck[2][1] * xk[0][1] + ck[1][1] * xk[1][1] + ck[0][1] * xk[2][1];
                xq[2][0] = xq[1][0]; xq[2][1] = xq[1][1]; xq[1][0] = xq[0][0]; xq[1][1] = xq[0][1]; xq[0][0] = q0; xq[0][1] = q1;
                xk[2][0] = xk[1][0]; xk[2][1] = xk[1][1]; xk[1][0] = xk[0][0]; xk[1][1] = xk[0][1]; xk[0][0] = kk0; xk[0][1] = kk1;
                const float eq = __expf(bsum) * 0.08838834764831845f, ek = __expf(li - bsum);
                *(unsigned*)(QM + (size_t)r * 1024 + h * 128 + k0) = pk2(silu_f(yq0) * eq, silu_f(yq1) * eq);
                *(unsigned*)(QM + (size_t)r * 1024 + 512 + h * 128 + k0) = pk2(silu_f(yk0) * ek, silu_f(yk1) * ek);
            }
            const float dd = __expf(bsum);
            *(f32x2*)(DDp + ((size_t)(257 + cid) * 4 + h) * 128 + k0) = (f32x2){dd, dd};
        }
    }
}

constexpr int SC_QS = 272, SC_VS = 144;
constexpr int SC_QT = 0, SC_KT = 2 * 17408, SC_VT = 4 * 17408, SC_AT = SC_VT + 2 * 9216, SC_SB = SC_AT + 9216, SC_DD = SC_SB + 18432, SC_NB = SC_DD + 1024, SC_END = SC_NB + 256;
static_assert(SC_END <= RING_BYTES, "scan LDS");
__device__ __forceinline__ bf16x8 tr8(LAS unsigned char* base, int stride, int row0, int col0, int lane) {
    const int fq = lane >> 4, q4 = (lane & 15) >> 2, p4 = lane & 3;
    LAS unsigned char* p = base + (row0 + 8 * fq + q4) * stride + (col0 + 4 * p4) * 2;
    const s16x4 lo = __builtin_amdgcn_ds_read_tr16_b64_v4i16((LAS s16x4*)p);
    const s16x4 hi = __builtin_amdgcn_ds_read_tr16_b64_v4i16((LAS s16x4*)(p + 4 * stride));
    return __builtin_shufflevector(lo, hi, 0, 1, 2, 3, 4, 5, 6, 7);
}
template <bool ML>
__device__ __forceinline__ void scan_unit(ArgsP a, LAS unsigned char* lds, int b, int h, int vs, int tid_in) {
    int tid = tid_in; asm volatile("" : "+v"(tid));
    unsigned char* ws = a->ws;
    const bf16* Z = (const bf16*)(ws + WS_Z);
    const bf16* QK = (const bf16*)(ws + (ML ? WS_QKC : WS_G));
    const float* DDp = (const float*)(ws + WS_DD) + (ML ? (size_t)257 * 512 : 0);
    bf16* O = (bf16*)(ws + (ML ? WS_OM : WS_OG));
    const int lane = tid & 63, wave = __builtin_amdgcn_readfirstlane(tid >> 6), fr = lane & 15, fq = lane >> 4;
    const int vt = wave & 3, hh = wave >> 2;
    for (int i = tid; i < (18432 + 1024 + 256) / 4; i += 512) ((LAS unsigned*)(lds + SC_SB))[i] = 0u;
    f32x4 S[4], nacc[4];
#pragma unroll
    for (int i = 0; i < 4; ++i) { S[i] = (f32x4){0.f, 0.f, 0.f, 0.f}; nacc[i] = (f32x4){0.f, 0.f, 0.f, 0.f}; }
    const bf16x8 ones = {(short)0x3F80, (short)0x3F80, (short)0x3F80, (short)0x3F80, (short)0x3F80, (short)0x3F80, (short)0x3F80, (short)0x3F80};
    u32x4 gq[2], gk[2], gv; float gd = 0.f;
    const int vcol = (ML ? ZC_MV : ZC_GV) + h * 256 + vs * 64;
#define SCAN_LOAD(c) do { const int c_ = (c); \
        _Pragma("unroll") for (int e = 0; e < 2; ++e) { const int pid = tid + 512 * e, t = pid >> 4, ch = pid & 15; \
            const bool ok = c_ > 0 || t >= 48; const int row = c_ == 0 ? MR + t - 48 : b * SEQ + (c_ - 1) * 64 + t; \
            gq[e] = ok ? *(const u32x4*)(QK + (size_t)row * 1024 + h * 128 + ch * 8) : (u32x4){0u, 0u, 0u, 0u}; \
            gk[e] = ok ? *(const u32x4*)(QK + (size_t)row * 1024 + 512 + h * 128 + ch * 8) : (u32x4){0u, 0u, 0u, 0u}; } \
        { const int t = tid >> 3, ch = tid & 7; const bool ok = c_ > 0 || t >= 48; const int row = c_ == 0 ? MR + t - 48 : b * SEQ + (c_ - 1) * 64 + t; \
          gv = ok ? *(const u32x4*)(Z + (size_t)row * ZB + vcol + ch * 8) : (u32x4){0u, 0u, 0u, 0u}; } \
        if (tid < 128) { const int cid = c_ == 0 ? 256 : b * 32 + (c_ - 1); gd = DDp[((size_t)cid * 4 + h) * 128 + tid]; } } while (0)
#define SCAN_STORE(buf) do { const int bo_ = (buf); \
        _Pragma("unroll") for (int e = 0; e < 2; ++e) { const int pid = tid + 512 * e, t = pid >> 4, ch = pid & 15; \
            *(LAS u32x4*)(lds + SC_QT + bo_ * 17408 + t * SC_QS + ch * 16) = gq[e]; *(LAS u32x4*)(lds + SC_KT + bo_ * 17408 + t * SC_QS + ch * 16) = gk[e]; } \
        { const int t = tid >> 3, ch = tid & 7; *(LAS u32x4*)(lds + SC_VT + bo_ * 9216 + t * SC_VS + ch * 16) = gv; } \
        if (tid < 128) ((LAS float*)(lds + SC_DD))[bo_ * 128 + tid] = gd; } while (0)
    SCAN_LOAD(0);
    __syncthreads();
    SCAN_STORE(0);
    __syncthreads();
    for (int c = 0; c < 33; ++c) {
        const int buf = c & 1;
        LAS unsigned char* QT = lds + SC_QT + buf * 17408; LAS unsigned char* KT = lds + SC_KT + buf * 17408; LAS unsigned char* VT = lds + SC_VT + buf * 9216;
        LAS unsigned char* AT = lds + SC_AT; LAS unsigned char* SB = lds + SC_SB;
        const LAS float* ddL = (const LAS float*)(lds + SC_DD) + buf * 128;
        if (c + 1 < 33) SCAN_LOAD(c + 1);
        {
            const int ti = wave >> 1;
#pragma unroll
            for (int sj = 0; sj < 2; ++sj) {
                const int si = 2 * (wave & 1) + sj;
                f32x4 acc = {0.f, 0.f, 0.f, 0.f};
#pragma unroll
                for (int ks = 0; ks < 4; ++ks) {
                    const bf16x8 qa = *(const LAS bf16x8*)(QT + (16 * ti + fr) * SC_QS + (32 * ks + 8 * fq) * 2);
                    const bf16x8 kb = *(const LAS bf16x8*)(KT + (16 * si + fr) * SC_QS + (32 * ks + 8 * fq) * 2);
                    acc = __builtin_amdgcn_mfma_f32_16x16x32_bf16(qa, kb, acc, 0, 0, 0);
                }
                const int sg = 16 * si + fr, tg = 16 * ti + 4 * fq;
                LAS bf16* ap = (LAS bf16*)(AT + tg * SC_VS) + sg;
                ap[0 * (SC_VS / 2)] = (bf16)(sg <= tg + 0 ? f2bf(acc.x) : 0u);
                ap[1 * (SC_VS / 2)] = (bf16)(sg <= tg + 1 ? f2bf(acc.y) : 0u);
                ap[2 * (SC_VS / 2)] = (bf16)(sg <= tg + 2 ? f2bf(acc.z) : 0u);
                ap[3 * (SC_VS / 2)] = (bf16)(sg <= tg + 3 ? f2bf(acc.w) : 0u);
            }
        }
        {
            const bf16x8 vb0 = tr8(VT, SC_VS, 0, 16 * vt, lane), vb1 = tr8(VT, SC_VS, 32, 16 * vt, lane);
#pragma unroll
            for (int i = 0; i < 4; ++i) {
                const int kt = 4 * hh + i;
                const bf16x8 ka0 = tr8(KT, SC_QS, 0, 16 * kt, lane), ka1 = tr8(KT, SC_QS, 32, 16 * kt, lane);
                f32x4 acc = S[i];
                acc = __builtin_amdgcn_mfma_f32_16x16x32_bf16(ka0, vb0, acc, 0, 0, 0);
                acc = __builtin_amdgcn_mfma_f32_16x16x32_bf16(ka1, vb1, acc, 0, 0, 0);
                const f32x4 dv = *(const LAS f32x4*)(ddL + 16 * kt + 4 * fq);
                S[i] = acc * dv;
                if (ML) {
                    f32x4 na = nacc[i];
                    na = __builtin_amdgcn_mfma_f32_16x16x32_bf16(ka0, ones, na, 0, 0, 0);
                    na = __builtin_amdgcn_mfma_f32_16x16x32_bf16(ka1, ones, na, 0, 0, 0);
                    nacc[i] = na * dv;
                }
            }
        }
        LDS_WAIT();
        __syncthreads();
        {
            const bf16x8 vb0 = tr8(VT, SC_VS, 0, 16 * vt, lane), vb1 = tr8(VT, SC_VS, 32, 16 * vt, lane);
            bf16x8 sb[4];
#pragma unroll
            for (int ks = 0; ks < 4; ++ks) sb[ks] = tr8(SB, SC_VS, 32 * ks, 16 * vt, lane);
            bf16x8 nb[4];
            if (ML) {
#pragma unroll
                for (int ks = 0; ks < 4; ++ks) nb[ks] = *(const LAS bf16x8*)(lds + SC_NB + (32 * ks + 8 * fq) * 2);
            }
#pragma unroll
            for (int tj = 0; tj < 2; ++tj) {
                const int ti = 2 * hh + tj;
                f32x4 acc = {0.f, 0.f, 0.f, 0.f}, den = {0.f, 0.f, 0.f, 0.f};
#pragma unroll
                for (int ks = 0; ks < 4; ++ks) {
                    const bf16x8 qa = *(const LAS bf16x8*)(QT + (16 * ti + fr) * SC_QS + (32 * ks + 8 * fq) * 2);
                    acc = __builtin_amdgcn_mfma_f32_16x16x32_bf16(qa, sb[ks], acc, 0, 0, 0);
                    if (ML) den = __builtin_amdgcn_mfma_f32_16x16x32_bf16(qa, nb[ks], den, 0, 0, 0);
                }
                const bf16x8 aa0 = *(const LAS bf16x8*)(AT + (16 * ti + fr) * SC_VS + (8 * fq) * 2), aa1 = *(const LAS bf16x8*)(AT + (16 * ti + fr) * SC_VS + (32 + 8 * fq) * 2);
                acc = __builtin_amdgcn_mfma_f32_16x16x32_bf16(aa0, vb0, acc, 0, 0, 0);
                acc = __builtin_amdgcn_mfma_f32_16x16x32_bf16(aa1, vb1, acc, 0, 0, 0);
                if (ML) {
                    den = __builtin_amdgcn_mfma_f32_16x16x32_bf16(aa0, ones, den, 0, 0, 0);
                    den = __builtin_amdgcn_mfma_f32_16x16x32_bf16(aa1, ones, den, 0, 0, 0);
                    acc.x = acc.x / fmaxf(fabsf(den.x), 1.f); acc.y = acc.y / fmaxf(fabsf(den.y), 1.f); acc.z = acc.z / fmaxf(fabsf(den.z), 1.f); acc.w = acc.w / fmaxf(fabsf(den.w), 1.f);
                }
                const int t0 = 16 * ti + 4 * fq;
                const int rowb = c == 0 ? MR + t0 - 48 : b * SEQ + (c - 1) * 64 + t0;
                bf16* op = O + (size_t)rowb * 1024 + h * 256 + vs * 64 + 16 * vt + fr;
                if (c > 0 || t0 >= 48) { op[0] = (bf16)f2bf(acc.x); op[1024] = (bf16)f2bf(acc.y); op[2048] = (bf16)f2bf(acc.z); op[3072] = (bf16)f2bf(acc.w); }
            }
        }
        LDS_WAIT();
        __syncthreads();
        {
#pragma unroll
            for (int i = 0; i < 4; ++i) {
                const int k0 = 16 * (4 * hh + i) + 4 * fq;
                LAS bf16* sp = (LAS bf16*)(SB + k0 * SC_VS) + 16 * vt + fr;
                sp[0 * (SC_VS / 2)] = (bf16)f2bf(S[i].x); sp[1 * (SC_VS / 2)] = (bf16)f2bf(S[i].y); sp[2 * (SC_VS / 2)] = (bf16)f2bf(S[i].z); sp[3 * (SC_VS / 2)] = (bf16)f2bf(S[i].w);
                if (ML && vt == 0 && fr == 0) { LAS bf16* np = (LAS bf16*)(lds + SC_NB) + k0; np[0] = (bf16)f2bf(nacc[i].x); np[1] = (bf16)f2bf(nacc[i].y); np[2] = (bf16)f2bf(nacc[i].z); np[3] = (bf16)f2bf(nacc[i].w); }
            }
            if (c + 1 < 33) SCAN_STORE(buf ^ 1);
        }
        LDS_WAIT();
        __syncthreads();
    }
#undef SCAN_LOAD
#undef SCAN_STORE
}

__device__ __forceinline__ void p6_headnorm(ArgsP a, int l, int gw, int ngw, int lane) {
    unsigned char* ws = a->ws; const bf16* Z = (const bf16*)(ws + WS_Z);
    for (int it = gw; it < MT * 8; it += ngw) {
        const int r = it >> 3, mx = (it >> 2) & 1, h = it & 3;
        bf16* op = (bf16*)(ws + (mx ? WS_OM : WS_OG)) + (size_t)r * 1024 + h * 256 + 4 * lane;
        const u32x2 w = *(const u32x2*)op; f32x4 v = {bflo(w.x), bfhi(w.x), bflo(w.y), bfhi(w.y)};
        const float rr = rsqrtf(wave_sum((v.x * v.x + v.y * v.y) + (v.z * v.z + v.w * v.w)) * (1.f / 256.f) + EPS);
        const f32x4 gg = *(const f32x4*)(a->in[mx ? I_GML : I_GGLA] + l * 256 + 4 * lane);
        const u32x2 gw2 = *(const u32x2*)(Z + (size_t)r * ZB + (mx ? ZC_MO : ZC_GR) + h * 256 + 4 * lane);
        const f32x4 gt = {bflo(gw2.x), bfhi(gw2.x), bflo(gw2.y), bfhi(gw2.y)};
        v = v * rr * gg * gt;
        u32x2 o; o.x = pk2(v.x, v.y); o.y = pk2(v.z, v.w); *(u32x2*)op = o;
    }
}

__device__ __forceinline__ int krow(int b, int s) { return s < NMETA ? MR + s : b * SEQ + (s - NMETA); }
__device__ __forceinline__ int t5_bucket(int n) {
    if (n < 16) return n < 0 ? 0 : n;
    const int lg = 16 + (int)(__logf((float)n * (1.f / 16.f)) / 2.0794415416798357f * 16.f);
    return lg < 31 ? lg : 31;
}
__device__ __forceinline__ unsigned off_b(unsigned row, unsigned ch) { return 256u * row + 16u * (ch ^ (((row & 3) << 2) | ((row >> 2) & 3))); }
__device__ __forceinline__ s16x4 tr_rd(LAS unsigned char* p) { return __builtin_amdgcn_ds_read_tr16_b64_v4i16((LAS s16x4*)p); }

constexpr int DW2_STRIDE = 9216, DW2_TILE = 0, DW2_SEL = 8192, DW2_BK = 8704, DSA2_T5 = 8 * DW2_STRIDE;

template <bool DENSE_ONLY>
__device__ __forceinline__ void dsa_unit(ArgsP a, LAS unsigned char* lds, int b, int c, int nq, int wave, int lane_in) {
    int lane = lane_in; asm volatile("" : "+v"(lane));
    unsigned char* ws = a->ws;
    const bf16* QQ = (const bf16*)(ws + WS_QQ); const bf16* KI = (const bf16*)(ws + WS_KI); const bf16* KV = (const bf16*)(ws + WS_KV);
    unsigned* SC = (unsigned*)(ws + WS_SC) + (size_t)blockIdx.x * 64 * SC_PITCH;
    const int r0 = DENSE_ONLY ? MR : b * SEQ + 64 * c, p0 = DENSE_ONLY ? 0 : NMETA + 64 * c;
    const int fr = lane & 15, fq = lane >> 4;
    if (!DENSE_ONLY) {
        const int qt = wave & 3, kh = wave >> 2;
        if (p0 + 16 * qt + 15 >= 256) {
            const int qrow = r0 + 16 * qt + fr, pq = p0 + 16 * qt + fr;
            bf16x8 qf[8][2];
#pragma unroll
            for (int h = 0; h < 8; ++h)
#pragma unroll
                for (int ks = 0; ks < 2; ++ks) qf[h][ks] = *(const bf16x8*)(QQ + (size_t)qrow * NQQ + 2048 + h * 64 + ks * 32 + 8 * fq);
            float wi[8];
            { const f32x4 w0 = *(const f32x4*)((const float*)(ws + WS_WI) + (size_t)qrow * 8), w1 = *(const f32x4*)((const float*)(ws + WS_WI) + (size_t)qrow * 8 + 4);
              wi[0] = w0.x; wi[1] = w0.y; wi[2] = w0.z; wi[3] = w0.w; wi[4] = w1.x; wi[5] = w1.y; wi[6] = w1.z; wi[7] = w1.w; }
            const int nkt = 2 + 4 * c + qt;
            unsigned* scq = SC + (size_t)(16 * qt + fr) * SC_PITCH + 4 * fq;
            for (int kt = kh; kt < nkt; kt += 2) {
                const bf16* kp = KI + (size_t)krow(b, 16 * kt + fr) * 64 + 8 * fq;
                const bf16x8 a0 = *(const bf16x8*)kp, a1 = *(const bf16x8*)(kp + 32);
                float s0 = 0.f, s1 = 0.f, s2 = 0.f, s3 = 0.f;
#pragma unroll
                for (int h = 0; h < 8; ++h) {
                    f32x4 acc = {0.f, 0.f, 0.f, 0.f};
                    acc = __builtin_amdgcn_mfma_f32_16x16x32_bf16(a0, qf[h][0], acc, 0, 0, 0);
                    acc = __builtin_amdgcn_mfma_f32_16x16x32_bf16(a1, qf[h][1], acc, 0, 0, 0);
                    s0 += wi[h] * fmaxf(acc.x, 0.f); s1 += wi[h] * fmaxf(acc.y, 0.f); s2 += wi[h] * fmaxf(acc.z, 0.f); s3 += wi[h] * fmaxf(acc.w, 0.f);
                }
                const int kb = 16 * kt + 4 * fq;
                u32x4 o;
                { const unsigned bits = __builtin_bit_cast(unsigned, s0); o.x = (kb + 0) <= pq ? (bits ^ ((bits >> 31) ? 0xffffffffu : 0x80000000u)) : 0u; }
                { const unsigned bits = __builtin_bit_cast(unsigned, s1); o.y = (kb + 1) <= pq ? (bits ^ ((bits >> 31) ? 0xffffffffu : 0x80000000u)) : 0u; }
                { const unsigned bits = __builtin_bit_cast(unsigned, s2); o.z = (kb + 2) <= pq ? (bits ^ ((bits >> 31) ? 0xffffffffu : 0x80000000u)) : 0u; }
                { const unsigned bits = __builtin_bit_cast(unsigned, s3); o.w = (kb + 3) <= pq ? (bits ^ ((bits >> 31) ? 0xffffffffu : 0x80000000u)) : 0u; }
                *(u32x4*)(scq + 16 * kt) = o;
            }
        }
        VM_WAIT();
        __syncthreads();
    }
    LAS unsigned char* wl = lds + wave * DW2_STRIDE;
    LAS unsigned char* tile = wl + DW2_TILE;
    LAS unsigned short* selL = (LAS unsigned short*)(wl + DW2_SEL);
    LAS unsigned short* bkL = (LAS unsigned short*)(wl + DW2_BK);
    const LAS float* t5L = (const LAS float*)(lds + DSA2_T5);
    const int nqw = DENSE_ONLY ? 2 : 8;
    for (int qi_ = 0; qi_ < nqw; ++qi_) {
        asm volatile("" : "+v"(lane));
        const int iq = wave * nqw + qi_;
        if (iq >= nq) break;
        const int p = p0 + iq, nk = p + 1, qrow = r0 + iq;
        int nsel;
        if (!DENSE_ONLY && nk > 256) {
            const unsigned* scr = SC + (size_t)iq * SC_PITCH;
            unsigned u[33];
#pragma unroll
            for (int i = 0; i < 33; ++i) { const int s = lane + 64 * i; u[i] = s < nk ? __hip_atomic_load(scr + s, __ATOMIC_RELAXED, __HIP_MEMORY_SCOPE_AGENT) : 0u; }
            unsigned tau = 0u;
            for (int bit = 31; bit >= 0; --bit) {
                const unsigned cand = tau | (1u << bit);
                int cnt = 0;
#pragma unroll
                for (int i = 0; i < 33; ++i) cnt += __popcll(__ballot(u[i] >= cand));
                if (cnt >= 256) tau = cand;
            }
            int cgt = 0;
#pragma unroll
            for (int i = 0; i < 33; ++i) cgt += __popcll(__ballot(u[i] > tau));
            const int rem = 256 - cgt;
            const unsigned long long lt = (1ull << lane) - 1ull;
            int base = 0, eqseen = 0;
#pragma unroll
            for (int i = 0; i < 33; ++i) {
                const bool gt = u[i] > tau, eq = u[i] == tau;
                const unsigned long long meq = __ballot(eq);
                const bool take = gt || (eq && (eqseen + __popcll(meq & lt)) < rem);
                const unsigned long long mt = __ballot(take);
                if (take) { const int pos = base + __popcll(mt & lt), s = lane + 64 * i; selL[pos] = (unsigned short)s; bkL[pos] = (unsigned short)(t5_bucket(p - s) * 16); }
                base += __popcll(mt); eqseen += __popcll(meq);
            }
            nsel = 256;
        } else {
#pragma unroll
            for (int m = 0; m < 4; ++m) { const int s = lane + 64 * m; selL[s] = (unsigned short)(s < nk ? s : 0); bkL[s] = (unsigned short)(t5_bucket(p - s) * 16); }
            nsel = nk;
        }
        asm volatile("" : "+v"(lane));
        bf16x8 qB[4];
#pragma unroll
        for (int ks = 0; ks < 4; ++ks) qB[ks] = *(const bf16x8*)(QQ + (size_t)qrow * NQQ + fr * 128 + ks * 32 + 8 * fq);
        LDS_WAIT();
        f32x4 O[8];
#pragma unroll
        for (int nt = 0; nt < 8; ++nt) O[nt] = (f32x4){0.f, 0.f, 0.f, 0.f};
        float mrun = -INFINITY, lrun = 0.f;
        const int nblk = (nsel + 31) >> 5;
        for (int blk = 0; blk < nblk; ++blk) {
            u32x4 gv[8];
#pragma unroll
            for (int e = 0; e < 8; ++e) { const int pid = lane + 64 * e, ri = pid >> 4, ch = pid & 15, j = 32 * blk + ri;
                const int key = j < nsel ? (int)selL[j] : 0;
                gv[e] = *(const u32x4*)(KV + (size_t)krow(b, key) * 128 + ch * 8); }
#pragma unroll
            for (int e = 0; e < 8; ++e) { const int pid = lane + 64 * e, ri = pid >> 4, ch = pid & 15; *(LAS u32x4*)(tile + off_b(ri, ch)) = gv[e]; }
            LDS_WAIT();
            f32x4 s0 = {0.f, 0.f, 0.f, 0.f}, s1 = {0.f, 0.f, 0.f, 0.f};
#pragma unroll
            for (int ks = 0; ks < 4; ++ks) {
                const bf16x8 k0 = *(const LAS bf16x8*)(tile + off_b(fr, 4 * ks + fq)), k1 = *(const LAS bf16x8*)(tile + off_b(16 + fr, 4 * ks + fq));
                s0 = __builtin_amdgcn_mfma_f32_16x16x32_bf16(k0, qB[ks], s0, 0, 0, 0);
                s1 = __builtin_amdgcn_mfma_f32_16x16x32_bf16(k1, qB[ks], s1, 0, 0, 0);
            }
            const int j0 = 32 * blk + 4 * fq;
            const u32x2 b0 = *(const LAS u32x2*)(bkL + j0), b1 = *(const LAS u32x2*)(bkL + j0 + 16);
            const int bo0[4] = {(int)(b0.x & 0xffffu), (int)(b0.x >> 16), (int)(b0.y & 0xffffu), (int)(b0.y >> 16)};
            const int bo1[4] = {(int)(b1.x & 0xffffu), (int)(b1.x >> 16), (int)(b1.y & 0xffffu), (int)(b1.y >> 16)};
            float bm = -INFINITY;
#pragma unroll
            for (int r = 0; r < 4; ++r) {
                s0[r] = (j0 + r) < nsel ? s0[r] + t5L[bo0[r] + fr] : -INFINITY;
                s1[r] = (j0 + 16 + r) < nsel ? s1[r] + t5L[bo1[r] + fr] : -INFINITY;
                bm = fmaxf(bm, fmaxf(s0[r], s1[r]));
            }
            bm = fmaxf(bm, __shfl_xor(bm, 16)); bm = fmaxf(bm, __shfl_xor(bm, 32));
            const float mnew = fmaxf(mrun, bm);
            const float scl = __expf(mrun - mnew);
            mrun = mnew;
            float ps = 0.f;
#pragma unroll
            for (int r = 0; r < 4; ++r) { s0[r] = __expf(s0[r] - mnew); s1[r] = __expf(s1[r] - mnew); ps += s0[r] + s1[r]; }
            lrun = lrun * scl + ps;
            float sr[4];
#pragma unroll
            for (int r = 0; r < 4; ++r) sr[r] = __shfl(scl, 4 * fq + r);
#pragma unroll
            for (int nt = 0; nt < 8; ++nt)
#pragma unroll
                for (int r = 0; r < 4; ++r) O[nt][r] *= sr[r];
            u32x4 pw; pw.x = pk2(s0[0], s0[1]); pw.y = pk2(s0[2], s0[3]); pw.z = pk2(s1[0], s1[1]); pw.w = pk2(s1[2], s1[3]);
            const bf16x8 pa = __builtin_bit_cast(bf16x8, pw);
            const unsigned q4 = (unsigned)(fr >> 2), p4 = (unsigned)(lane & 3);
#pragma unroll
            for (int nt = 0; nt < 8; ++nt) {
                const s16x4 vlo = tr_rd(tile + off_b(4 * fq + q4, 2 * nt + (p4 >> 1)) + 8 * (p4 & 1));
                const s16x4 vhi = tr_rd(tile + off_b(16 + 4 * fq + q4, 2 * nt + (p4 >> 1)) + 8 * (p4 & 1));
                const bf16x8 vb = __builtin_shufflevector(vlo, vhi, 0, 1, 2, 3, 4, 5, 6, 7);
                O[nt] = __builtin_amdgcn_mfma_f32_16x16x32_bf16(pa, vb, O[nt], 0, 0, 0);
            }
        }
        float lt2 = lrun + __shfl_xor(lrun, 16); lt2 += __shfl_xor(lt2, 32);
        const float inv = 1.f / lt2;
        float ir[4];
#pragma unroll
        for (int r = 0; r < 4; ++r) ir[r] = __shfl(inv, 4 * fq + r);
        bf16* od = (bf16*)(ws + WS_OD) + (size_t)qrow * 2048 + fr;
#pragma unroll
        for (int nt = 0; nt < 8; ++nt)
#pragma unroll
            for (int r = 0; r < 4; ++r) od[(4 * fq + r) * 128 + 16 * nt] = (bf16)f2bf(O[nt][r] * ir[r]);
        LDS_WAIT();
    }
}
__device__ __forceinline__ void p5_dsa(ArgsP a, LAS unsigned char* lds, int tid, int wave, int lane) {
    LAS float* t5L = (LAS float*)(lds + DSA2_T5);
    __syncthreads();
    t5L[tid] = a->in[I_T5][tid];
    __syncthreads();
    for (int u = blockIdx.x; u < 256; u += gridDim.x) {
        dsa_unit<false>(a, lds, u >> 5, u & 31, 64, wave, lane);
        __syncthreads();
    }
    if (blockIdx.x == 0) dsa_unit<true>(a, lds, 0, 0, 16, wave, lane);
}

__global__ void __launch_bounds__(NWAVES * 64, 2) fwd(Args a_) {
    extern __shared__ __attribute__((aligned(16))) unsigned char lds_raw[];
    LAS unsigned char* lds = (LAS unsigned char*)lds_raw;
    volatile LAS unsigned* MISC = (volatile LAS unsigned*)(lds + MISC_OFF);
    if (threadIdx.x < 32) MISC[threadIdx.x] = 0u;
    __syncthreads();
    const int g_lo = a_.g_lo, g_hi = a_.g_hi, l_lo = a_.l_lo, l_hi = a_.l_hi, ph_lo = a_.ph_lo, ph_hi = a_.ph_hi, use_bar = a_.use_bar;
    XcdBarrier bar; bar.bar = (unsigned*)(a_.ws + WS_CTL) + CW_BAR; bar.x = 0; bar.st = nullptr;
    if (use_bar) bar = xcd_barrier_post((unsigned*)(a_.ws + WS_CTL) + CW_BAR, MISC + 8);
#define GRID_BAR() do { if (use_bar) xcd_barrier(bar); } while (0)
#ifndef PHMASK
#define PHMASK 0xFFFF
#endif
#ifndef PROBE_PH
#define PROBE_PH -1
#endif
#define PH(k) (((PHMASK >> (k)) & 1) && ph_lo <= (k) && (k) < ph_hi)
#define PBEGIN ArgsP a = (ArgsP)__builtin_amdgcn_kernarg_segment_ptr(); asm volatile("" : "+s"(a)); unsigned char* ws = a->ws; \
    int tid_ = threadIdx.x; asm volatile("" : "+v"(tid_)); const int tid = tid_, lane = tid & 63, wave = __builtin_amdgcn_readfirstlane(tid >> 6); const int gw = blockIdx.x * NWAVES + wave, ngw = gridDim.x * NWAVES; (void)ws; (void)gw; (void)ngw; (void)lane;

    if (((PHMASK >> 13) & 1) && a_.prep) { PBEGIN prep_weights(a, lds, gw, ngw, wave, lane); GRID_BAR(); }

    for (int g = g_lo; g < g_hi; ++g) {
        for (int l = l_lo; l < l_hi; ++l) {
            if (PH(0) && l == 0) { PBEGIN p0_init(a, g, gw, ngw, lane); GRID_BAR(); }
            if (PH(1)) { PBEGIN
                FIn f{(bf16*)(ws + WS_Z), (float*)(ws + WS_ZF), (const float*)(ws + WS_BIN) + l * NZ};
                run_gemm(lds, (const bf16*)(ws + WS_XN), (const bf16*)(ws + WS_WIN) + (size_t)l * NZ * D, NZ, D, f, gw, ngw, lane);
                GRID_BAR();
            }
            if (PH(2)) { PBEGIN p2_prep(a, l, gw, ngw, lane); GRID_BAR(); }
            if (PH(3)) { PBEGIN
                FQQ f{(bf16*)(ws + WS_QQ)};
                run_gemm(lds, (const bf16*)(ws + WS_CQN), (const bf16*)(ws + WS_WQQ) + (size_t)l * NQQ * 256, NQQ, 256, f, gw, ngw, lane);
            }
            if (PH(4)) { PBEGIN
                for (int u = blockIdx.x; u < 256; u += gridDim.x) {
                    const int b = (u >> 4) & 7, h = (u >> 2) & 3, vs = u & 3;
                    if (u >> 7) scan_unit<true>(a, lds, b, h, vs, tid); else scan_unit<false>(a, lds, b, h, vs, tid);
                }
#if PROBE_PH == 4
                for (int u = blockIdx.x; u < 256; u += gridDim.x) {
                    const int b = (u >> 4) & 7, h = (u >> 2) & 3, vs = u & 3;
                    if (u >> 7) scan_unit<true>(a, lds, b, h, vs, tid); else scan_unit<false>(a, lds, b, h, vs, tid);
                }
#endif
                GRID_BAR();
            }
            if (PH(5)) { PBEGIN p5_dsa(a, lds, tid, wave, lane); }
#if PROBE_PH == 5
            if (PH(5)) { PBEGIN p5_dsa(a, lds, tid, wave, lane); }
#endif
            if (PH(6)) { PBEGIN p6_headnorm(a, l, gw, ngw, lane); GRID_BAR(); }
            if (PH(7)) {
                __syncthreads();
                { PBEGIN FBr<0> f0{(const bf16*)(ws + WS_Z), (float*)(ws + WS_Y), (bf16*)(ws + WS_MIX)};
                  run_gemm(lds, (const bf16*)(ws + WS_OG), (const bf16*)(ws + WS_WBG) + (size_t)l * D * D, D, D, f0, gw, ngw, lane); }
                { PBEGIN FBr<1> f1{(const bf16*)(ws + WS_Z), (float*)(ws + WS_Y), (bf16*)(ws + WS_MIX)};
                  run_gemm(lds, (const bf16*)(ws + WS_OD), (const bf16*)(ws + WS_WBD) + (size_t)l * D * 2048, D, 2048, f1, gw, ngw, lane); }
                { PBEGIN FBr<2> f2{(const bf16*)(ws + WS_Z), (float*)(ws + WS_Y), (bf16*)(ws + WS_MIX)};
                  run_gemm(lds, (const bf16*)(ws + WS_OM), (const bf16*)(ws + WS_WBM) + (size_t)l * D * D, D, D, f2, gw, ngw, lane); }
                GRID_BAR();
            }
            if (PH(8)) { PBEGIN
                FY f{(float*)(ws + WS_Y)};
                run_gemm(lds, (const bf16*)(ws + WS_MIX), (const bf16*)(ws + WS_WOUT) + (size_t)l * D * D, D, D, f, gw, ngw, lane);
                GRID_BAR();
            }
            if (PH(9)) { PBEGIN p_norm_res(a, g, a->in[I_GPOSTMIX] + l * D, a->in[I_GPREMLP] + l * D, gw, ngw, lane); GRID_BAR(); }
            if (PH(10)) { PBEGIN
                FUp f{(bf16*)(ws + WS_Z)};
                run_gemm(lds, (const bf16*)(ws + WS_XN), (const bf16*)(ws + WS_WUP) + (size_t)l * DFF * D, DFF, D, f, gw, ngw, lane);
                GRID_BAR();
            }
            if (PH(11)) { PBEGIN
                FY f{(float*)(ws + WS_Y)};
                run_gemm(lds, (const bf16*)(ws + WS_Z), (const bf16*)(ws + WS_WDN) + (size_t)l * D * DFF, D, DFF, f, gw, ngw, lane);
                GRID_BAR();
            }
            if (PH(12)) { PBEGIN p_norm_res(a, g, a->in[I_GPOSTMLP] + l * D, l + 1 < NL ? a->in[I_GPREMIX] + (l + 1) * D : nullptr, gw, ngw, lane); GRID_BAR(); }
        }
    }
#undef PH
#undef GRID_BAR
#undef PBEGIN
}

#ifndef MK_ONE_LAUNCH
#define MK_ONE_LAUNCH 1
#endif
extern "C" void kernel_launch(void* const* d_in, const int* in_sizes, int n_in, void* d_out, int out_size, void* d_ws, size_t ws_size, hipStream_t stream) {
    static int grid = 0;
    if (grid == 0) {
        if (n_in != 28 || out_size != NB * SEQ * D || ws_size < WS_END) { fprintf(stderr, "kernel_launch: unexpected shapes (n_in %d out %d ws %zu need %zu)\n", n_in, out_size, ws_size, (size_t)WS_END); grid = -1; return; }
        int dev = 0, cus = 0, per_cu = 0;
        if (hipGetDevice(&dev) != hipSuccess || hipDeviceGetAttribute(&cus, hipDeviceAttributeMultiprocessorCount, dev) != hipSuccess) { grid = -1; return; }
        if (hipFuncSetAttribute((const void*)fwd, hipFuncAttributeMaxDynamicSharedMemorySize, LDS_BYTES) != hipSuccess) { fprintf(stderr, "kernel_launch: hipFuncSetAttribute failed\n"); grid = -1; return; }
        if (hipOccupancyMaxActiveBlocksPerMultiprocessor(&per_cu, (const void*)fwd, NWAVES * 64, LDS_BYTES) != hipSuccess || per_cu < 1) { fprintf(stderr, "kernel_launch: occupancy query says %d\n", per_cu); }
        (void)hipGetLastError();
        grid = cus;
    }
    if (grid < 0) return;
    (void)hipMemsetAsync((char*)d_ws + WS_CTL, 0, CTL_ZERO_BYTES, stream);
    Args a{};
    for (int i = 0; i < 28; ++i) a.in[i] = (const float*)d_in[i];
    a.out = (float*)d_out; a.ws = (unsigned char*)d_ws;
#if MK_ONE_LAUNCH
    a.g_lo = 0; a.g_hi = NG; a.l_lo = 0; a.l_hi = NL; a.ph_lo = 0; a.ph_hi = 13; a.prep = 1; a.use_bar = 1;
    hipLaunchKernelGGL(fwd, dim3(grid), dim3(NWAVES * 64), LDS_BYTES, stream, a);
#else
    a.use_bar = 0;
    a.prep = 1; a.g_lo = 0; a.g_hi = 0; a.l_lo = 0; a.l_hi = 0; a.ph_lo = 0; a.ph_hi = 0;
    hipLaunchKernelGGL(fwd, dim3(grid), dim3(NWAVES * 64), LDS_BYTES, stream, a);
    a.prep = 0;
    static const int cuts[] = {0, 1, 2, 3, 5, 7, 8, 9, 10, 11, 12, 13};
    for (int g = 0; g < NG; ++g) for (int l = 0; l < NL; ++l) for (int c = 0; c < 11; ++c) {
        if (c == 0 && l != 0) continue;
        a.g_lo = g; a.g_hi = g + 1; a.l_lo = l; a.l_hi = l + 1; a.ph_lo = cuts[c]; a.ph_hi = cuts[c + 1];
        hipLaunchKernelGGL(fwd, dim3(grid), dim3(NWAVES * 64), LDS_BYTES, stream, a);
    }
#endif
    const hipError_t le = hipPeekAtLastError();
    if (le != hipSuccess) fprintf(stderr, "kernel_launch: launch failed: %s\n", hipGetErrorName(le));
}
```

```cpp
#include <hip/hip_runtime.h>
#include <cstdio>
#include <cstdint>
namespace pg8 {
#define PG8_LAS __attribute__((address_space(3)))
typedef unsigned short bf16_t;
typedef short bf16x8 __attribute__((ext_vector_type(8)));
typedef float f32x4 __attribute__((ext_vector_type(4)));
typedef unsigned u32x4 __attribute__((ext_vector_type(4)));
constexpr int BM = 256, BK = 64, HALF = 128, HTB = HALF * BK * 2  , STAGE_BYTES = 8 * HTB, NXCD = 8, WGM = 8;

__host__ __device__ __forceinline__ int lds_byte(int r, int c) { const int st = (r >> 4) * 2 + (c >> 5), rr = r & 15, cc = c & 31, ob = rr * 64 + cc * 2; return st * 1024 + (ob ^ (((ob >> 9) & 1) << 5)); }
__host__ __device__ __forceinline__ void stage_rc(int b, int& R, int& C) { const int st = b / 1024, sb = b % 1024, swz = sb ^ (((sb >> 9) & 1) << 5); R = (st >> 1) * 16 + swz / 64; C = (st & 1) * 32 + (swz % 64) / 2; }
__host__ __device__ __forceinline__ int perm32(int rho) { const int n = rho >> 4, i = rho & 15; return 8 * (i >> 2) + 4 * n + (i & 3); }

struct Unit { int pm, pn, sub; };
struct Gemm { const bf16_t* A; const bf16_t* Bt; int M, N, K; const bf16_t *A1, *A2, *A3, *B1, *B2, *B3; };

struct StaticOrder {
    int nM, nN, nwg, G, c;
    __host__ __device__ void init(int M, int N, int G_, int c_) { nM = M / BM; nN = N / BM; nwg = nM * nN; G = G_; c = c_; }
    __host__ __device__ bool next(int i, Unit& u) const {
        const long L = (long)i * G + c; if (L >= nwg) return false;
        int wgid = (int)L; { const int q = nwg / NXCD, r = nwg % NXCD, xcd = wgid % NXCD, off = wgid / NXCD; wgid = (xcd < r ? xcd * (q + 1) : r * (q + 1) + (xcd - r) * q) + off; }
        const int nig = WGM * nN, gid = wgid / nig, fm = gid * WGM, gsz = (nM - fm) < WGM ? (nM - fm) : WGM;
        u.pm = fm + ((wgid % nig) % gsz); u.pn = (wgid % nig) / gsz; u.sub = 0; return true;
    }
    __device__ __forceinline__ void a_ready(const Unit&) const {}
    __device__ __forceinline__ void done(const Unit&) const {}
};

__device__ __forceinline__ unsigned cvt_pk_bf16(float lo, float hi) { unsigned r; asm volatile("v_cvt_pk_bf16_f32 %0, %1, %2" : "=v"(r) : "v"(lo), "v"(hi)); return r; }
template <class Epi, class Sched, bool ALIGN_EPI = false, bool SP2 = false, bool CHAIN = false>
__device__ __forceinline__ void gemm_phase(PG8_LAS unsigned char* lds, const Gemm g, const Sched& S, const Epi& E) {
    int tid_ = threadIdx.x; asm volatile("" : "+v"(tid_));
    const int tid = tid_, wid = __builtin_amdgcn_readfirstlane(tid >> 6), lane = tid & 63, wr = wid >> 2, wc = wid & 3, fr = lane & 15, fq = lane >> 4;
    const int K = g.K, nt = K / BK;
    unsigned voffA[2], voffB[2];
#pragma unroll
    for (int i = 0; i < 2; ++i) { int R, C; stage_rc(tid * 16 + i * 8192, R, C); const int Rb = Epi::PERM ? ((R & ~31) + perm32(R & 31)) : R;
        voffA[i] = (unsigned)(R * K + C) * 2u; voffB[i] = (unsigned)(Rb * K + C) * 2u; }
    const size_t kstep = (size_t)(BK * 2);
    const size_t hstep = (size_t)HALF * K * 2;
    const size_t tstep = 2 * hstep;
    const unsigned ldsw = (unsigned)wid * 1024u;
    const int aoff = lds_byte(wr * 64 + fr, fq * 8), boff = lds_byte(wc * 32 + fr, fq * 8);
#define PG8_SA(b, h) (((b) * 2 + (h)) * HTB)
#define PG8_SB(b, h) ((4 + (b) * 2 + (h)) * HTB)
#define PG8_STAGE(bufoff, gbase, voff) do { _Pragma("unroll") for (int _i = 0; _i < 2; ++_i) \
        __builtin_amdgcn_global_load_lds((const unsigned*)((const char*)(gbase) + (voff)[_i]), (PG8_LAS unsigned*)(lds + (bufoff) + ldsw + _i * 8192), 16, 0, 0); } while (0)
#define PG8_LDA(dst, b, h) do { _Pragma("unroll") for (int m = 0; m < 4; ++m) _Pragma("unroll") for (int k = 0; k < 2; ++k) dst[m][k] = *(const PG8_LAS bf16x8*)(lds + PG8_SA(b, h) + aoff + m * 2048 + k * 1024); } while (0)
#define PG8_LDB(dst, b, h) do { _Pragma("unroll") for (int n = 0; n < 2; ++n) _Pragma("unroll") for (int k = 0; k < 2; ++k) dst[n][k] = *(const PG8_LAS bf16x8*)(lds + PG8_SB(b, h) + boff + n * 2048 + k * 1024); } while (0)
#define PG8_MMA(ai, bj, At, Bt) do { __builtin_amdgcn_s_setprio(1); _Pragma("unroll") for (int m = 0; m < 4; ++m) _Pragma("unroll") for (int n = 0; n < 2; ++n) _Pragma("unroll") for (int k = 0; k < 2; ++k) \
        acc[ai][bj][m][n] = __builtin_amdgcn_mfma_f32_16x16x32_bf16(Bt[n][k], At[m][k], acc[ai][bj][m][n], 0, 0, 0); __builtin_amdgcn_s_setprio(0); } while (0)
#define PG8_WAIT_V(n) asm volatile("s_waitcnt vmcnt(" #n ")" ::: "memory")
#define PG8_WAIT_L(n) asm volatile("s_waitcnt lgkmcnt(" #n ")" ::: "memory")
#define PG8_BAR __builtin_amdgcn_s_barrier()
#define PG8_SCHED __builtin_amdgcn_sched_barrier(0)
    Unit cur, nxt; int ui = 0;
    if (!S.next(0, cur)) return;
    f32x4 acc[2][2][4][2];
#pragma unroll
    for (int a = 0; a < 2; ++a)
#pragma unroll
        for (int b = 0; b < 2; ++b)
#pragma unroll
            for (int m = 0; m < 4; ++m)
#pragma unroll
                for (int n = 0; n < 2; ++n) acc[a][b][m][n] = (f32x4){0.f, 0.f, 0.f, 0.f};
    bf16x8 At[4][2], B0[2][2], B1[2][2];
#define PG8_ABASE(u) ((const char*)(!CHAIN || (u).sub == 0 ? g.A : (u).sub == 1 ? g.A1 : (u).sub == 2 ? g.A2 : g.A3) + (size_t)(u).pm * tstep)
#define PG8_BBASE(u) ((const char*)(!CHAIN || (u).sub == 0 ? g.Bt : (u).sub == 1 ? g.B1 : (u).sub == 2 ? g.B2 : g.B3) + (size_t)(u).pn * tstep)
    const char* cA = PG8_ABASE(cur); const char* cB = PG8_BBASE(cur);
    S.a_ready(cur);
    if constexpr (SP2) {
        PG8_STAGE(PG8_SB(0, 0), cB, voffB); PG8_STAGE(PG8_SB(0, 1), cB + hstep, voffB); PG8_STAGE(PG8_SA(0, 0), cA, voffA); PG8_STAGE(PG8_SA(0, 1), cA + hstep, voffA);
        if (wr == 1) PG8_BAR;
        PG8_WAIT_V(2); PG8_BAR;
        PG8_STAGE(PG8_SB(1, 0), cB + kstep, voffB); PG8_STAGE(PG8_SA(1, 0), cA + kstep, voffA); PG8_STAGE(PG8_SB(1, 1), cB + hstep + kstep, voffB);
        PG8_WAIT_V(6); PG8_BAR;
    } else {
        PG8_STAGE(PG8_SB(0, 0), cB, voffB); PG8_STAGE(PG8_SA(0, 0), cA, voffA); PG8_STAGE(PG8_SB(0, 1), cB + hstep, voffB); PG8_STAGE(PG8_SA(0, 1), cA + hstep, voffA);
        if (wr == 1) PG8_BAR;
        PG8_WAIT_V(4); PG8_BAR;
        PG8_STAGE(PG8_SB(1, 0), cB + kstep, voffB); PG8_STAGE(PG8_SA(1, 0), cA + kstep, voffA); PG8_STAGE(PG8_SB(1, 1), cB + hstep + kstep, voffB);
        PG8_WAIT_V(6); PG8_BAR;
    }
    for (;;) {
        const bool has_next = S.next(ui + 1, nxt);
        const char* nA = has_next ? PG8_ABASE(nxt) : cA; const char* nB = has_next ? PG8_BBASE(nxt) : cB;
        for (int t = 0; t < nt; t += 2) {
            const bool last = (t == nt - 2);
            const char* a1 = cA + (size_t)(t + 1) * kstep;
            const char* a2 = last ? nA : cA + (size_t)(t + 2) * kstep; const char* b2 = last ? nB : cB + (size_t)(t + 2) * kstep;
            const char* a3 = a2 + kstep; const char* b3 = b2 + kstep;
            if (last && has_next) S.a_ready(nxt);
            if constexpr (SP2) {
            PG8_LDB(B0, 0, 0); PG8_LDB(B1, 0, 1); PG8_SCHED; PG8_LDA(At, 0, 0); PG8_STAGE(PG8_SA(1, 1), a1 + hstep, voffA);
            PG8_WAIT_V(8); PG8_WAIT_L(0); PG8_BAR; PG8_MMA(0, 0, At, B0); PG8_MMA(0, 1, At, B1); PG8_BAR; PG8_SCHED;
            PG8_LDA(At, 0, 1); PG8_STAGE(PG8_SB(0, 0), b2, voffB); PG8_STAGE(PG8_SB(0, 1), b2 + hstep, voffB); PG8_STAGE(PG8_SA(0, 0), a2, voffA);
            PG8_WAIT_V(8); PG8_WAIT_L(0); PG8_BAR; PG8_MMA(1, 0, At, B0); PG8_MMA(1, 1, At, B1); PG8_BAR; PG8_SCHED;
            PG8_LDB(B0, 1, 0); PG8_LDB(B1, 1, 1); PG8_SCHED; PG8_LDA(At, 1, 0); PG8_STAGE(PG8_SA(0, 1), a2 + hstep, voffA);
            PG8_WAIT_V(8); PG8_WAIT_L(0); PG8_BAR; PG8_MMA(0, 0, At, B0); PG8_MMA(0, 1, At, B1); PG8_BAR; PG8_SCHED;
            PG8_LDA(At, 1, 1); PG8_STAGE(PG8_SB(1, 0), b3, voffB); PG8_STAGE(PG8_SB(1, 1), b3 + hstep, voffB); PG8_STAGE(PG8_SA(1, 0), a3, voffA);
            PG8_WAIT_V(8); PG8_WAIT_L(0); PG8_BAR; PG8_MMA(1, 0, At, B0); PG8_MMA(1, 1, At, B1); PG8_BAR; PG8_SCHED;
            } else {
            PG8_LDB(B0, 0, 0); PG8_SCHED; PG8_LDA(At, 0, 0); PG8_STAGE(PG8_SA(1, 1), a1 + hstep, voffA);
            PG8_WAIT_L(8); PG8_BAR; PG8_WAIT_L(0); PG8_MMA(0, 0, At, B0); PG8_BAR; PG8_SCHED;
            PG8_LDB(B1, 0, 1); PG8_STAGE(PG8_SB(0, 0), b2, voffB);
            PG8_BAR; PG8_WAIT_L(0); PG8_MMA(0, 1, At, B1); PG8_BAR;
            PG8_LDA(At, 0, 1); PG8_STAGE(PG8_SA(0, 0), a2, voffA);
            PG8_BAR; PG8_WAIT_L(0); PG8_MMA(1, 0, At, B0); PG8_BAR; PG8_SCHED;
            PG8_STAGE(PG8_SB(0, 1), b2 + hstep, voffB);
            PG8_WAIT_V(6); PG8_BAR; PG8_MMA(1, 1, At, B1); PG8_BAR;
            PG8_LDB(B0, 1, 0); PG8_SCHED; PG8_LDA(At, 1, 0); PG8_STAGE(PG8_SA(0, 1), a2 + hstep, voffA);
            PG8_WAIT_L(8); PG8_BAR; PG8_WAIT_L(0); PG8_MMA(0, 0, At, B0); PG8_BAR; PG8_SCHED;
            PG8_LDB(B1, 1, 1); PG8_STAGE(PG8_SB(1, 0), b3, voffB);
            PG8_BAR; PG8_WAIT_L(0); PG8_MMA(0, 1, At, B1); PG8_BAR;
            PG8_LDA(At, 1, 1); PG8_STAGE(PG8_SA(1, 0), a3, voffA);
            PG8_BAR; PG8_WAIT_L(0); PG8_MMA(1, 0, At, B0); PG8_BAR; PG8_SCHED;
            PG8_STAGE(PG8_SB(1, 1), b3 + hstep, voffB);
            PG8_WAIT_V(6); PG8_BAR; PG8_MMA(1, 1, At, B1); PG8_BAR;
            }
        }
        if constexpr (ALIGN_EPI) { if (wr == 0) PG8_BAR; }
        if constexpr (CHAIN) { if (cur.sub < 3) E.mid(acc, cur, wr, wc, fr, fq); else E(acc, cur, wr, wc, fr, fq); S.done(cur); }
        else if constexpr (!Epi::AFTER_DRAIN) { E(acc, cur, wr, wc, fr, fq); S.done(cur); }
        if (!has_next) break;
        if (!CHAIN || cur.sub == 3)
#pragma unroll
        for (int a = 0; a < 2; ++a)
#pragma unroll
            for (int b = 0; b < 2; ++b)
#pragma unroll
                for (int m = 0; m < 4; ++m)
#pragma unroll
                    for (int n = 0; n < 2; ++n) acc[a][b][m][n] = (f32x4){0.f, 0.f, 0.f, 0.f};
        cur = nxt; cA = nA; cB = nB; ++ui;
        if constexpr (ALIGN_EPI) { if (wr == 1) PG8_BAR; }
    }
    PG8_WAIT_V(0);
    if constexpr (!ALIGN_EPI) { if (wr == 0) PG8_BAR; }
    PG8_BAR;
    if constexpr (Epi::AFTER_DRAIN) { E.fused(acc, cur, wr, wc, fr, fq, lds, wid, lane); S.done(cur); }
#undef PG8_ABASE
#undef PG8_BBASE
#undef PG8_SA
#undef PG8_SB
#undef PG8_STAGE
#undef PG8_LDA
#undef PG8_LDB
#undef PG8_MMA
#undef PG8_WAIT_V
#undef PG8_WAIT_L
#undef PG8_BAR
#undef PG8_SCHED
}
}

constexpr int NB = 32, SEQ = 2048, NMETA = 16, TT = SEQ + NMETA, D = 1024, NL = 4, DFF = 4096;
constexpr int NG = 4, GB = NB / NG, MR = GB * SEQ  , MT = MR + NMETA  ;
constexpr int NCOLS = 9696, NZ = 9728, ZB = 9216, ZFW = 512;
constexpr float EPS = 1e-6f;
constexpr int ZC_GQ = 0, ZC_GK = 512, ZC_GV = 1024, ZC_GR = 2048, ZC_MQ = 3072, ZC_MK = 3584, ZC_MV = 4096, ZC_MO = 5120, ZC_GATE = 6144;
constexpr int ZF_CQ = 0, ZF_CKV = 256, ZF_IK = 384, ZF_A = 448, ZF_IW = 464, ZF_MI = 472, ZF_MF = 476;
constexpr int NQQ = 2560;

constexpr size_t MiB = 1u << 20;
constexpr size_t WS_CTL = 0, CTL_ZERO_BYTES = 1 * MiB;
constexpr size_t WS_BIN = 1 * MiB;
constexpr size_t WS_WIN = 2 * MiB;
constexpr size_t WS_WQQ = 78 * MiB;
constexpr size_t WS_WBG = 83 * MiB;
constexpr size_t WS_WBM = 91 * MiB;
constexpr size_t WS_WBD = 99 * MiB;
constexpr size_t WS_WOUT = 115 * MiB;
constexpr size_t WS_WUP = 123 * MiB;
constexpr size_t WS_WDN = 155 * MiB;
constexpr size_t WS_HM = 187 * MiB;
constexpr size_t WS_XN = 188 * MiB;
constexpr size_t WS_ZF = 221 * MiB;
constexpr size_t WS_CQN = 254 * MiB;
constexpr size_t WS_KV = 263 * MiB;
constexpr size_t WS_KI = 268 * MiB;
constexpr size_t WS_WI = 271 * MiB;
constexpr size_t WS_LIF = 272 * MiB;
constexpr size_t WS_G = 273 * MiB;
constexpr size_t WS_QKC = 306 * MiB;
constexpr size_t WS_QQ = 339 * MiB;
constexpr size_t WS_OG = 420 * MiB;
constexpr size_t WS_OM = 453 * MiB;
constexpr size_t WS_OD = 486 * MiB;
constexpr size_t WS_Z = 551 * MiB;
constexpr size_t WS_MIX = 840 * MiB;
constexpr size_t WS_Y = 873 * MiB;
constexpr size_t WS_SC = 840 * MiB;
constexpr size_t WS_DD = 1020 * MiB;
constexpr size_t WS_END = 1024 * MiB;
constexpr int SC_PITCH = 2080;
static_assert(WS_Z + (size_t)MT * ZB * 2 <= WS_MIX && WS_Y + (size_t)MT * D * 4 <= WS_END && WS_SC + (size_t)256 * 64 * SC_PITCH * 4 <= WS_END, "ws map");

constexpr int CW_BAR = 4096;

constexpr int RING_BYTES = 131072;
constexpr int MISC_OFF = RING_BYTES + 320;
constexpr int LDS_BYTES = 147456;
constexpr int NWAVES = 8;

#define LAS __attribute__((address_space(3)))
typedef unsigned short bf16;
typedef float f32x4 __attribute__((ext_vector_type(4)));
typedef float f32x2 __attribute__((ext_vector_type(2)));
typedef unsigned u32x4 __attribute__((ext_vector_type(4)));
typedef unsigned u32x2 __attribute__((ext_vector_type(2)));
typedef short bf16x8 __attribute__((ext_vector_type(8)));
typedef short s16x4 __attribute__((ext_vector_type(4)));
#define LDS_WAIT() asm volatile("s_waitcnt lgkmcnt(0)" ::: "memory")
#define VM_WAIT() asm volatile("s_waitcnt vmcnt(0)" ::: "memory")

__device__ __forceinline__ unsigned f2bf(float f) { unsigned u = __builtin_bit_cast(unsigned, f); return (u + 0x7fffu + ((u >> 16) & 1u)) >> 16; }
__device__ __forceinline__ unsigned pk2(float lo, float hi) { return f2bf(lo) | (f2bf(hi) << 16); }
__device__ __forceinline__ float bf2f(unsigned b) { return __builtin_bit_cast(float, b << 16); }
__device__ __forceinline__ float bflo(unsigned w) { return __builtin_bit_cast(float, w << 16); }
__device__ __forceinline__ float bfhi(unsigned w) { return __builtin_bit_cast(float, w & 0xffff0000u); }
__device__ __forceinline__ float wave_sum(float v) {
#pragma unroll
    for (int o = 1; o < 64; o <<= 1) v += __shfl_xor(v, o);
    return v;
}
__device__ __forceinline__ float wave_max(float v) {
#pragma unroll
    for (int o = 1; o < 64; o <<= 1) v = fmaxf(v, __shfl_xor(v, o));
    return v;
}
__device__ __forceinline__ float sigmoid_f(float x) { return 1.f / (1.f + __expf(-x)); }
__device__ __forceinline__ float silu_f(float x) { return x * sigmoid_f(x); }
__device__ __forceinline__ float logsigmoid_f(float x) { return fminf(x, 0.f) - log1pf(__expf(-fabsf(x))); }

#define XB_TMO      128
#define XB_XCNT(j)  (256  + 64 * (j))
#define XB_XSUB(j)  (1280 + 64 * (j))
#define XB_XGEN(j)  (2304 + 64 * (j))
#define XB_TOP      3328
#define XB_TOPGEN   3392
#define XCD_BAR_WORDS 3456
#define XB_SPIN_CAP (1u << 22)

__device__ __forceinline__ unsigned xb_ld(unsigned* p)              { return __hip_atomic_load(p, __ATOMIC_RELAXED, __HIP_MEMORY_SCOPE_AGENT); }
__device__ __forceinline__ unsigned xb_add(unsigned* p, unsigned v) { return __hip_atomic_fetch_add(p, v, __ATOMIC_RELAXED, __HIP_MEMORY_SCOPE_AGENT); }
__device__ __forceinline__ unsigned xb_xcc_id() { return (unsigned)__builtin_amdgcn_s_getreg((3 << 11) | 20) & 0xFu; }
#define XB_SPIN(cond, bar) do { unsigned _sp = 0; while (cond) { __builtin_amdgcn_s_sleep(1); \
    if ((++_sp & 255u) == 0u) { if (xb_ld(&(bar)[XB_TMO])) break; if (_sp > XB_SPIN_CAP) { atomicAdd(&(bar)[XB_TMO], 1u); break; } } } } while (0)

struct XcdBarrier {
    unsigned* bar; unsigned x;
    volatile LAS unsigned* st;
};

__device__ __forceinline__ XcdBarrier xcd_barrier_post(unsigned* bar, volatile LAS unsigned* st) {
    XcdBarrier b; b.bar = bar; b.x = xb_xcc_id(); b.st = st;
    if (threadIdx.x == 0) (void)xb_add(&bar[XB_XCNT(b.x)], 1u);
    return b;
}
__device__ __forceinline__ void xcd_barrier_complete(unsigned* bar, unsigned x, unsigned& nloc, unsigned& nx) {
    const unsigned G = gridDim.x * gridDim.y * gridDim.z;
    unsigned sum, cnt, mine, sp = 0u;
    for (;;) {
        sum = 0u; cnt = 0u; mine = 0u;
#pragma unroll
        for (unsigned j = 0; j < 16; ++j) { const unsigned c = xb_ld(&bar[XB_XCNT(j)]); sum += c; cnt += (c > 0u) ? 1u : 0u; mine = (j == x) ? c : mine; }
        if (sum == G) break;
        __builtin_amdgcn_s_sleep(1);
        if ((++sp & 255u) == 0u) { if (xb_ld(&bar[XB_TMO])) break; if (sp > XB_SPIN_CAP) { atomicAdd(&bar[XB_TMO], 1u); break; } }
    }
    nloc = mine > 0u ? mine : 1u; nx = cnt > 0u ? cnt : 1u;
}

__device__ __forceinline__ void xcd_barrier(const XcdBarrier& b) {
    asm volatile("s_waitcnt vmcnt(0)" ::: "memory");
    __syncthreads();
    if (threadIdx.x == 0) {
        unsigned* bar = b.bar;
        __builtin_amdgcn_s_waitcnt(0);
        unsigned nloc = b.st[0], nx = b.st[1];
        if (nloc == 0u) { xcd_barrier_complete(bar, b.x, nloc, nx); b.st[0] = nloc; b.st[1] = nx; }
        const unsigned old = xb_add(&bar[XB_XSUB(b.x)], 1u);
        const unsigned gen = old / nloc;
        if (old + 1u == (gen + 1u) * nloc) {
            __builtin_amdgcn_fence(__ATOMIC_RELEASE, "agent");
            asm volatile("s_waitcnt vmcnt(0)" ::: "memory");
            const unsigned og = xb_add(&bar[XB_TOP], 1u);
            const unsigned tg = og / nx;
            if (og + 1u == (tg + 1u) * nx) xb_add(&bar[XB_TOPGEN], 1u);
            else XB_SPIN(xb_ld(&bar[XB_TOPGEN]) == tg, bar);
            __builtin_amdgcn_fence(__ATOMIC_ACQUIRE, "agent");
            xb_add(&bar[XB_XGEN(b.x)], 1u);
            asm volatile("s_waitcnt vmcnt(0)" ::: "memory");
        } else {
            XB_SPIN(xb_ld(&bar[XB_XGEN(b.x)]) == gen, bar);
            __builtin_amdgcn_fence(__ATOMIC_ACQUIRE, "agent");
            asm volatile("s_waitcnt vmcnt(0)" ::: "memory");
        }
    }
    __syncthreads();
}


struct Args { const float* in[28]; float* out; unsigned char* ws; int g_lo, g_hi, l_lo, l_hi, ph_lo, ph_hi, prep, use_bar; };
typedef const __attribute__((address_space(4))) Args* ArgsP;
enum { I_X = 0, I_META, I_T5, I_GPREMIX, I_WIN, I_BIN, I_WA2, I_BA, I_GGLA, I_WBRG, I_GDQ, I_WUQ, I_WIQ, I_GDKV, I_WUV, I_LNG, I_LNB, I_WBRD,
       I_CONV, I_FB, I_GML, I_WBRM, I_WOUT, I_GPOSTMIX, I_GPREMLP, I_WUP, I_WDN, I_GPOSTMLP };

__device__ __forceinline__ int win_src(int n) {
    if (n < 3072) return n;
    if (n < 6144) return n - 3072 + 3544;
    if (n < 9216) return n - 6144 + 6624;
    if (n < 9472) return n - 9216 + 3088;
    if (n < 9600) return n - 9472 + 3344;
    if (n < 9664) return n - 9600 + 3472;
    if (n < 9680) return n - 9664 + 3072;
    if (n < 9688) return n - 9680 + 3536;
    if (n < 9692) return n - 9688 + 6616;
    if (n < 9696) return n - 9692 + 6620;
    return -1;
}
struct CmIdent { __device__ __forceinline__ int operator()(int n) const { return n; } };
struct CmWin { __device__ __forceinline__ int operator()(int n) const { return win_src(n); } };

template <class CM>
__device__ __forceinline__ void tr_item(const float* __restrict__ W, int ldw, bf16* __restrict__ WT, int Kd, LAS float* scr, int k0, int ns0, int nd0, int lane, CM cm) {
    const int sc = cm(ns0 + (lane & 31));
#pragma unroll 8
    for (int i = 0; i < 32; ++i) { const int kk = 2 * i + (lane >> 5); scr[kk * 33 + (lane & 31)] = sc >= 0 ? W[(size_t)(k0 + kk) * ldw + sc] : 0.f; }
    LDS_WAIT();
    const int c = lane & 7;
#pragma unroll
    for (int j = 0; j < 4; ++j) { const int n = (lane >> 3) + 8 * j; const LAS float* s = scr + (8 * c) * 33 + n;
        u32x4 o; o.x = pk2(s[0 * 33], s[1 * 33]); o.y = pk2(s[2 * 33], s[3 * 33]); o.z = pk2(s[4 * 33], s[5 * 33]); o.w = pk2(s[6 * 33], s[7 * 33]);
        *(u32x4*)(WT + (size_t)(nd0 + n) * Kd + k0 + 8 * c) = o; }
    LDS_WAIT();
}

__device__ __forceinline__ void prep_weights(ArgsP a, LAS unsigned char* lds, int gw, int ngw, int wave, int lane) {
    LAS float* scr = (LAS float*)(lds + wave * 16384);
    unsigned char* ws = a->ws;
    constexpr int I_WIN_N = 16 * 304, I_UQ = 4 * 64, I_IQ = 4 * 16, I_SQ = 16 * 32, I_UP = 16 * 128, I_DN = 64 * 32, I_WBD = 512, I_B = NZ / 64;
    constexpr int PER_L = I_WIN_N + I_UQ + I_IQ + 3 * I_SQ + I_UP + I_DN + I_WBD + I_B;
    for (int it = gw; it < NL * PER_L; it += ngw) {
        const int l = it / PER_L; int r = it % PER_L;
        if (r < I_WIN_N) { const int kb = r / 304, nb = r % 304;
            tr_item(a->in[I_WIN] + (size_t)l * D * NCOLS, NCOLS, (bf16*)(ws + WS_WIN) + (size_t)l * NZ * D, D, scr, kb * 64, nb * 32, nb * 32, lane, CmWin()); continue; }
        r -= I_WIN_N;
        if (r < I_UQ) { const int kb = r / 64, nb = r % 64;
            tr_item(a->in[I_WUQ] + (size_t)l * 256 * 2048, 2048, (bf16*)(ws + WS_WQQ) + (size_t)l * NQQ * 256, 256, scr, kb * 64, nb * 32, nb * 32, lane, CmIdent()); continue; }
        r -= I_UQ;
        if (r < I_IQ) { const int kb = r / 16, nb = r % 16;
            tr_item(a->in[I_WIQ] + (size_t)l * 256 * 512, 512, (bf16*)(ws + WS_WQQ) + (size_t)l * NQQ * 256, 256, scr, kb * 64, nb * 32, 2048 + nb * 32, lane, CmIdent()); continue; }
        r -= I_IQ;
        if (r < I_SQ) { const int kb = r / 32, nb = r % 32;
            tr_item(a->in[I_WBRG] + (size_t)l * D * D, D, (bf16*)(ws + WS_WBG) + (size_t)l * D * D, D, scr, kb * 64, nb * 32, nb * 32, lane, CmIdent()); continue; }
        r -= I_SQ;
        if (r < I_SQ) { const int kb = r / 32, nb = r % 32;
            tr_item(a->in[I_WBRM] + (size_t)l * D * D, D, (bf16*)(ws + WS_WBM) + (size_t)l * D * D, D, scr, kb * 64, nb * 32, nb * 32, lane, CmIdent()); continue; }
        r -= I_SQ;
        if (r < I_SQ) { const int kb = r / 32, nb = r % 32;
            tr_item(a->in[I_WOUT] + (size_t)l * D * D, D, (bf16*)(ws + WS_WOUT) + (size_t)l * D * D, D, scr, kb * 64, nb * 32, nb * 32, lane, CmIdent()); continue; }
        r -= I_SQ;
        if (r < I_UP) { const int kb = r / 128, nb = r % 128;
            tr_item(a->in[I_WUP] + (size_t)l * D * DFF, DFF, (bf16*)(ws + WS_WUP) + (size_t)l * DFF * D, D, scr, kb * 64, nb * 32, nb * 32, lane, CmIdent()); continue; }
        r -= I_UP;
        if (r < I_DN) { const int kb = r / 32, nb = r % 32;
            tr_item(a->in[I_WDN] + (size_t)l * DFF * D, D, (bf16*)(ws + WS_WDN) + (size_t)l * D * DFF, DFF, scr, kb * 64, nb * 32, nb * 32, lane, CmIdent()); continue; }
        r -= I_DN;
        if (r < I_WBD) {
            const int h = r >> 5, ch = (r >> 4) & 1, nb = r & 15, c = ch * 64 + lane;
            const float* uv = a->in[I_WUV] + ((size_t)(l * 16 + h) * 128 + c) * 64;
            const float* wb = a->in[I_WBRD] + ((size_t)l * D + h * 64) * D + nb * 64;
            bf16* o = (bf16*)(ws + WS_WBD) + (size_t)l * D * 2048 + (size_t)(h >> 3) * D * D + (size_t)(nb * 64) * D + (h & 7) * 128 + c;
            f32x4 w[16];
#pragma unroll
            for (int i = 0; i < 16; ++i) w[i] = *(const f32x4*)(uv + 4 * i);
            for (int nn = 0; nn < 64; ++nn) {
                float acc = 0.f;
#pragma unroll
                for (int i = 0; i < 16; ++i) { acc += w[i].x * wb[(size_t)(4 * i + 0) * D + nn] + w[i].y * wb[(size_t)(4 * i + 1) * D + nn] + w[i].z * wb[(size_t)(4 * i + 2) * D + nn] + w[i].w * wb[(size_t)(4 * i + 3) * D + nn]; }
                o[(size_t)nn * D] = (bf16)f2bf(acc);
            }
            continue; }
        r -= I_WBD;
        { const int n = r * 64 + lane; const int sc = win_src(n);
          ((float*)(ws + WS_BIN))[l * NZ + n] = sc >= 0 ? a->in[I_BIN][l * NCOLS + sc] : 0.f; }
    }
}

__device__ __forceinline__ float* hrow(ArgsP a, int g, int r) {
    return r < MR ? a->out + ((size_t)g * MR + r) * D : (float*)(a->ws + WS_HM) + (size_t)(r - MR) * D;
}
__device__ __forceinline__ void rms_row_bf16(const f32x4 (&v)[4], const float* __restrict__ gain, bf16* __restrict__ orow, int lane) {
    float s = 0.f;
#pragma unroll
    for (int j = 0; j < 4; ++j) s += (v[j].x * v[j].x + v[j].y * v[j].y) + (v[j].z * v[j].z + v[j].w * v[j].w);
    const float r = rsqrtf(wave_sum(s) * (1.f / D) + EPS);
#pragma unroll
    for (int j = 0; j < 4; ++j) { const f32x4 gg = *(const f32x4*)(gain + 4 * lane + 256 * j); const f32x4 o = v[j] * r * gg;
        u32x2 w; w.x = pk2(o.x, o.y); w.y = pk2(o.z, o.w); *(u32x2*)(orow + 4 * lane + 256 * j) = w; }
}
__device__ __forceinline__ void p0_init(ArgsP a, int g, int gw, int ngw, int lane) {
    bf16* XN = (bf16*)(a->ws + WS_XN);
    for (int r = gw; r < MT; r += ngw) {
        const float* src = r < MR ? a->in[I_X] + ((size_t)g * MR + r) * D : a->in[I_META] + (size_t)(r - MR) * D;
        float* hd = hrow(a, g, r);
        f32x4 v[4];
#pragma unroll
        for (int j = 0; j < 4; ++j) { v[j] = *(const f32x4*)(src + 4 * lane + 256 * j); *(f32x4*)(hd + 4 * lane + 256 * j) = v[j]; }
        rms_row_bf16(v, a->in[I_GPREMIX], XN + (size_t)r * D, lane);
    }
}
__device__ __forceinline__ void p_norm_res(ArgsP a, int g, const float* gpost, const float* gpre, int gw, int ngw, int lane) {
    bf16* XN = (bf16*)(a->ws + WS_XN); const float* Y = (const float*)(a->ws + WS_Y);
    for (int r = gw; r < MT; r += ngw) {
        float* hd = hrow(a, g, r);
        f32x4 y[4], v[4]; float s = 0.f;
#pragma unroll
        for (int j = 0; j < 4; ++j) { y[j] = *(const f32x4*)(Y + (size_t)r * D + 4 * lane + 256 * j); v[j] = *(const f32x4*)(hd + 4 * lane + 256 * j);
            s += (y[j].x * y[j].x + y[j].y * y[j].y) + (y[j].z * y[j].z + y[j].w * y[j].w); }
        const float rr = rsqrtf(wave_sum(s) * (1.f / D) + EPS);
#pragma unroll
        for (int j = 0; j < 4; ++j) { const f32x4 gg = *(const f32x4*)(gpost + 4 * lane + 256 * j); v[j] = v[j] + y[j] * rr * gg; *(f32x4*)(hd + 4 * lane + 256 * j) = v[j]; }
        if (gpre) rms_row_bf16(v, gpre, XN + (size_t)r * D, lane);
    }
}

template <class F> struct EpiT {
    static constexpr bool PERM = true, AFTER_DRAIN = false;
    F f;
    __device__ __forceinline__ void operator()(const f32x4 (&acc)[2][2][4][2], const pg8::Unit& u, int wr, int wc, int fr, int fq) const {
        const int row0 = u.pm * 256 + wr * 64 + fr, col0 = u.pn * 256 + wc * 32 + 8 * fq;
#pragma unroll
        for (int ai = 0; ai < 2; ++ai)
#pragma unroll
            for (int m = 0; m < 4; ++m)
#pragma unroll
                for (int bj = 0; bj < 2; ++bj) { f.apply(row0 + ai * 128 + m * 16, col0 + bj * 128, acc[ai][bj][m][0], acc[ai][bj][m][1]); asm volatile("" ::: "memory"); }
    }
};
__device__ __forceinline__ void st_bf16x8(bf16* p, f32x4 v0, f32x4 v1) { u32x4 w; w.x = pk2(v0.x, v0.y); w.y = pk2(v0.z, v0.w); w.z = pk2(v1.x, v1.y); w.w = pk2(v1.z, v1.w); *(u32x4*)p = w; }
__device__ __forceinline__ void ld_bf16x8(const bf16* p, f32x4& v0, f32x4& v1) { const u32x4 w = *(const u32x4*)p;
    v0 = (f32x4){bflo(w.x), bfhi(w.x), bflo(w.y), bfhi(w.y)}; v1 = (f32x4){bflo(w.z), bfhi(w.z), bflo(w.w), bfhi(w.w)}; }

struct FIn {
    bf16* Z; float* ZF; const float* bias;
    __device__ __forceinline__ void apply(int row, int col, f32x4 v0, f32x4 v1) const {
        v0 += *(const f32x4*)(bias + col); v1 += *(const f32x4*)(bias + col + 4);
        const int t = col >> 8;
        if (t >= 36) { float* p = ZF + (size_t)row * ZFW + (col - ZB); *(f32x4*)p = v0; *(f32x4*)(p + 4) = v1; return; }
        if (t < 2) { v0 *= 0.08838834764831845f; v1 *= 0.08838834764831845f; }
        else if (t >= 8 && t < 12) {
#pragma unroll
            for (int i = 0; i < 4; ++i) { v0[i] = silu_f(v0[i]); v1[i] = silu_f(v1[i]); } }
        else if (t >= 20) {
#pragma unroll
            for (int i = 0; i < 4; ++i) { v0[i] = sigmoid_f(v0[i]); v1[i] = sigmoid_f(v1[i]); } }
        st_bf16x8(Z + (size_t)row * ZB + col, v0, v1);
    }
};
struct FQQ {
    bf16* QQ;
    __device__ __forceinline__ void apply(int row, int col, f32x4 v0, f32x4 v1) const {
        const float s = col < 2048 ? 0.08838834764831845f : 0.125f;
        st_bf16x8(QQ + (size_t)row * NQQ + col, v0 * s, v1 * s);
    }
};
template <int IDX> struct FBr {
    const bf16* Z; float* Y; bf16* MIX;
    __device__ __forceinline__ void apply(int row, int col, f32x4 v0, f32x4 v1) const {
        f32x4 g0, g1; ld_bf16x8(Z + (size_t)row * ZB + ZC_GATE + IDX * 1024 + col, g0, g1);
        float* y = Y + (size_t)row * D + col;
        f32x4 a0 = v0 * g0, a1 = v1 * g1;
        if (IDX > 0) { a0 += *(const f32x4*)y; a1 += *(const f32x4*)(y + 4); }
        if (IDX < 2) { *(f32x4*)y = a0; *(f32x4*)(y + 4) = a1; }
        else st_bf16x8(MIX + (size_t)row * D + col, a0, a1);
    }
};
struct FY {
    float* Y;
    __device__ __forceinline__ void apply(int row, int col, f32x4 v0, f32x4 v1) const { float* y = Y + (size_t)row * D + col; *(f32x4*)y = v0; *(f32x4*)(y + 4) = v1; }
};
struct FUp {
    bf16* U;
    __device__ __forceinline__ void apply(int row, int col, f32x4 v0, f32x4 v1) const {
#pragma unroll
        for (int i = 0; i < 4; ++i) { const float p = fmaxf(v0[i], 0.f), q = fmaxf(v1[i], 0.f); v0[i] = p * p; v1[i] = q * q; }
        st_bf16x8(U + (size_t)row * DFF + col, v0, v1);
    }
};

template <class F>
__device__ __forceinline__ void mini_gemm(const bf16* __restrict__ A, const bf16* __restrict__ Bt, int N, int K, const F& f, int gw, int ngw, int lane) {
    const int fr = lane & 15, fq = lane >> 4;
    for (int wt = gw; wt < N / 32; wt += ngw) {
        const int n0 = wt * 32;
        f32x4 acc0 = {0.f, 0.f, 0.f, 0.f}, acc1 = {0.f, 0.f, 0.f, 0.f};
        const bf16* ap = A + (size_t)(MR + fr) * K + fq * 8;
        const bf16* b0 = Bt + (size_t)(n0 + pg8::perm32(fr)) * K + fq * 8;
        const bf16* b1 = Bt + (size_t)(n0 + pg8::perm32(16 + fr)) * K + fq * 8;
        for (int k = 0; k < K; k += 256) {
            bf16x8 av[8], w0[8], w1[8];
#pragma unroll
            for (int u = 0; u < 8; ++u) { av[u] = *(const bf16x8*)(ap + k + 32 * u); w0[u] = *(const bf16x8*)(b0 + k + 32 * u); w1[u] = *(const bf16x8*)(b1 + k + 32 * u); }
#pragma unroll
            for (int u = 0; u < 8; ++u) {
                acc0 = __builtin_amdgcn_mfma_f32_16x16x32_bf16(w0[u], av[u], acc0, 0, 0, 0);
                acc1 = __builtin_amdgcn_mfma_f32_16x16x32_bf16(w1[u], av[u], acc1, 0, 0, 0);
            }
        }
        f.apply(MR + fr, n0 + 8 * fq, acc0, acc1);
    }
}
template <class F>
__device__ __forceinline__ void run_gemm(LAS unsigned char* lds, const bf16* A, const bf16* Bt, int N, int K, const F& f, int gw, int ngw, int lane) {
    asm volatile("" : "+s"(K)); asm volatile("" : "+s"(N));
    pg8::Gemm g{A, Bt, MR, N, K}; pg8::StaticOrder S; S.init(MR, N, (int)gridDim.x, (int)blockIdx.x);
    EpiT<F> E{f};
    pg8::gemm_phase<EpiT<F>, pg8::StaticOrder, true, true>((PG8_LAS unsigned char*)lds, g, S, E);
    mini_gemm(A, Bt, N, K, f, gw, ngw, lane);
}

struct ChainOrder {
    pg8::StaticOrder S;
    __device__ __forceinline__ bool next(int i, pg8::Unit& u) const { if (!S.next(i >> 2, u)) return false; u.sub = i & 3; return true; }
    __device__ __forceinline__ void a_ready(const pg8::Unit&) const {}
    __device__ __forceinline__ void done(const pg8::Unit&) const {}
};
struct EpiMix {
    static constexpr bool PERM = true, AFTER_DRAIN = false;
    const bf16* Z; bf16* MIX;
    __device__ __forceinline__ void mid(f32x4 (&acc)[2][2][4][2], const pg8::Unit& u, int wr, int wc, int fr, int fq) const {
        if (u.sub == 1) return;
        const int gi = u.sub == 0 ? 0 : 1;
        const int row0 = u.pm * 256 + wr * 64 + fr, col0 = u.pn * 256 + wc * 32 + 8 * fq;
#pragma unroll
        for (int ai = 0; ai < 2; ++ai)
#pragma unroll
            for (int m = 0; m < 4; ++m)
#pragma unroll
                for (int bj = 0; bj < 2; ++bj) {
                    const bf16* gp = Z + (size_t)(row0 + ai * 128 + m * 16) * ZB + ZC_GATE + gi * 1024 + col0 + bj * 128;
                    f32x4 a0, a1, b0, b1; ld_bf16x8(gp, a0, a1); ld_bf16x8(gp + 1024, b0, b1);
                    f32x4 r0, r1;
                    r0.x = a0.x * __builtin_amdgcn_rcpf(b0.x); r0.y = a0.y * __builtin_amdgcn_rcpf(b0.y); r0.z = a0.z * __builtin_amdgcn_rcpf(b0.z); r0.w = a0.w * __builtin_amdgcn_rcpf(b0.w);
                    r1.x = a1.x * __builtin_amdgcn_rcpf(b1.x); r1.y = a1.y * __builtin_amdgcn_rcpf(b1.y); r1.z = a1.z * __builtin_amdgcn_rcpf(b1.z); r1.w = a1.w * __builtin_amdgcn_rcpf(b1.w);
                    acc[ai][bj][m][0] *= r0; acc[ai][bj][m][1] *= r1;
                    asm volatile("" ::: "memory");
                }
    }
    __device__ __forceinline__ void operator()(const f32x4 (&acc)[2][2][4][2], const pg8::Unit& u, int wr, int wc, int fr, int fq) const {
        const int row0 = u.pm * 256 + wr * 64 + fr, col0 = u.pn * 256 + wc * 32 + 8 * fq;
#pragma unroll
        for (int ai = 0; ai < 2; ++ai)
#pragma unroll
            for (int m = 0; m < 4; ++m)
#pragma unroll
                for (int bj = 0; bj < 2; ++bj) {
                    const int row = row0 + ai * 128 + m * 16, col = col0 + bj * 128;
                    f32x4 g0, g1; ld_bf16x8(Z + (size_t)row * ZB + ZC_GATE + 2 * 1024 + col, g0, g1);
                    st_bf16x8(MIX + (size_t)row * D + col, acc[ai][bj][m][0] * g0, acc[ai][bj][m][1] * g1);
                    asm volatile("" ::: "memory");
                }
    }
};

__device__ __forceinline__ int prow(int r, int j) {
    if (r < MR) { const int s = r & (SEQ - 1); return (s - j >= 0) ? r - j : MR + (NMETA + s - j); }
    const int t = r - MR; return (t - j >= 0) ? r - j : -1;
}
__device__ __forceinline__ void p2_prep(ArgsP a, int l, int gw, int ngw, int lane) {
    unsigned char* ws = a->ws;
    const bf16* Z = (const bf16*)(ws + WS_Z);
    for (int r = gw; r < MT; r += ngw) {
        const float* zf = (const float*)(ws + WS_ZF) + (size_t)r * ZFW;
        {
            f32x4 v = *(const f32x4*)(zf + ZF_CQ + 4 * lane);
            const float rr = rsqrtf(wave_sum((v.x * v.x + v.y * v.y) + (v.z * v.z + v.w * v.w)) * (1.f / 256.f) + EPS);
            const f32x4 gg = *(const f32x4*)(a->in[I_GDQ] + l * 256 + 4 * lane); v = v * rr * gg;
            u32x2 w; w.x = pk2(v.x, v.y); w.y = pk2(v.z, v.w); *(u32x2*)((bf16*)(ws + WS_CQN) + (size_t)r * 256 + 4 * lane) = w;
        }
        {
            f32x2 v = *(const f32x2*)(zf + ZF_CKV + 2 * lane);
            const float rr = rsqrtf(wave_sum(v.x * v.x + v.y * v.y) * (1.f / 128.f) + EPS);
            const f32x2 gg = *(const f32x2*)(a->in[I_GDKV] + l * 128 + 2 * lane);
            *(unsigned*)((bf16*)(ws + WS_KV) + (size_t)r * 128 + 2 * lane) = pk2(v.x * rr * gg.x, v.y * rr * gg.y);
        }
        {
            const float v = zf[ZF_IK + lane]; const float mu = wave_sum(v) * (1.f / 64.f); const float d = v - mu;
            const float var = wave_sum(d * d) * (1.f / 64.f);
            const float y = d * rsqrtf(var + EPS) * a->in[I_LNG][l * 64 + lane] + a->in[I_LNB][l * 64 + lane];
            ((bf16*)(ws + WS_KI))[(size_t)r * 64 + lane] = (bf16)f2bf(y);
        }
        if (lane < 8) ((float*)(ws + WS_WI))[(size_t)r * 8 + lane] = zf[ZF_IW + lane] * 0.35355339059327373f;
    }
    float* DDp = (float*)(ws + WS_DD);
    for (int it = gw; it < 257 * 8; it += ngw) {
        const int cid = it >> 3, mx = (it >> 2) & 1, h = it & 3;
        const int nrows = cid == 256 ? NMETA : 64, rbase = cid == 256 ? MR : cid * 64;
        const int k0 = 2 * lane;
        if (!mx) {
            float w0[16], w1[16];
#pragma unroll
            for (int j = 0; j < 16; ++j) { const f32x2 w = *(const f32x2*)(a->in[I_WA2] + (size_t)(l * 16 + j) * 512 + h * 128 + k0); w0[j] = w.x; w1[j] = w.y; }
            const f32x2 bb = *(const f32x2*)(a->in[I_BA] + l * 512 + h * 128 + k0);
            bf16* QG = (bf16*)(ws + WS_G);
            float G0 = 0.f, G1 = 0.f;
            for (int t = 0; t < nrows; ++t) {
                const int r = rbase + t;
                const float* zf = (const float*)(ws + WS_ZF) + (size_t)r * ZFW + ZF_A;
                const f32x4 a0 = *(const f32x4*)zf, a1 = *(const f32x4*)(zf + 4), a2 = *(const f32x4*)(zf + 8), a3 = *(const f32x4*)(zf + 12);
                const float av[16] = {a0.x, a0.y, a0.z, a0.w, a1.x, a1.y, a1.z, a1.w, a2.x, a2.y, a2.z, a2.w, a3.x, a3.y, a3.z, a3.w};
                float s0 = bb.x, s1 = bb.y;
#pragma unroll
                for (int j = 0; j < 16; ++j) { s0 += av[j] * w0[j]; s1 += av[j] * w1[j]; }
                G0 += logsigmoid_f(s0) * 0.0625f; G1 += logsigmoid_f(s1) * 0.0625f;
                const unsigned qw = *(const unsigned*)(Z + (size_t)r * ZB + ZC_GQ + h * 128 + k0), kw = *(const unsigned*)(Z + (size_t)r * ZB + ZC_GK + h * 128 + k0);
                const float e0 = __expf(G0), e1 = __expf(G1), i0 = __expf(-G0), i1 = __expf(-G1);
                *(unsigned*)(QG + (size_t)r * 1024 + h * 128 + k0) = pk2(bflo(qw) * e0, bfhi(qw) * e1);
                *(unsigned*)(QG + (size_t)r * 1024 + 512 + h * 128 + k0) = pk2(bflo(kw) * i0, bfhi(kw) * i1);
            }
            *(f32x2*)(DDp + ((size_t)cid * 4 + h) * 128 + k0) = (f32x2){__expf(G0), __expf(G1)};
        } else {
            float cq[4][2], ck[4][2];
#pragma unroll
            for (int tap = 0; tap < 4; ++tap) { const f32x2 wq = *(const f32x2*)(a->in[I_CONV] + (size_t)(l * 4 + tap) * 1024 + h * 128 + k0), wk = *(const f32x2*)(a->in[I_CONV] + (size_t)(l * 4 + tap) * 1024 + 512 + h * 128 + k0);
                cq[tap][0] = wq.x; cq[tap][1] = wq.y; ck[tap][0] = wk.x; ck[tap][1] = wk.y; }
            const float fb = a->in[I_FB][l * 4 + h];
            bf16* QM = (bf16*)(ws + WS_QKC);
            float xq[3][2], xk[3][2];
#pragma unroll
            for (int j = 0; j < 3; ++j) {
                const int rp = prow(rbase, j + 1);
                unsigned qw = 0u, kw = 0u;
                if (rp >= 0) { qw = *(const unsigned*)(Z + (size_t)rp * ZB + ZC_MQ + h * 128 + k0); kw = *(const unsigned*)(Z + (size_t)rp * ZB + ZC_MK + h * 128 + k0); }
                xq[j][0] = bflo(qw); xq[j][1] = bfhi(qw); xk[j][0] = bflo(kw); xk[j][1] = bfhi(kw);
            }
            float bsum = 0.f;
            for (int t = 0; t < nrows; ++t) {
                const int r = rbase + t;
                const float* zf = (const float*)(ws + WS_ZF) + (size_t)r * ZFW;
                const float li = zf[ZF_MI + h], lf = logsigmoid_f(zf[ZF_MF + h] + fb);
                bsum += lf;
                const unsigned qw = *(const unsigned*)(Z + (size_t)r * ZB + ZC_MQ + h * 128 + k0), kw = *(const unsigned*)(Z + (size_t)r * ZB + ZC_MK + h * 128 + k0);
                const float q0 = bflo(qw), q1 = bfhi(qw), kk0 = bflo(kw), kk1 = bfhi(kw);
                float yq0 = cq[3][0] * q0 + cq[2][0] * xq[0][0] + cq[1][0] * xq[1][0] + cq[0][0] * xq[2][0];
                float yq1 = cq[3][1] * q1 + cq[2][1] * xq[0][1] + cq[1][1] * xq[1][1] + cq[0][1] * xq[2][1];
                float yk0 = ck[3][0] * kk0 + ck[2][0] * xk[0][0] + ck[1][0] * xk[1][0] + ck[0][0] * xk[2][0];
                float yk1 = ck[3][1] * kk1 + ck[2][1] * xk[0][1] + ck[1][1] * xk[1][1] + ck[0][1] * xk[2][1];
                xq[2][0] = xq[1][0]; xq[2][1] = xq[1][1]; xq[1][0] = xq[0][0]; xq[1][1] = xq[0][1]; xq[0][0] = q0; xq[0][1] = q1;
                xk[2][0] = xk[1][0]; xk[2][1] = xk[1][1]; xk[1][0] = xk[0][0]; xk[1][1] = xk[0][1]; xk[0][0] = kk0; xk[0][1] = kk1;
                const float eq = __expf(bsum) * 0.08838834764831845f, ek = __expf(li - bsum);
                *(unsigned*)(QM + (size_t)r * 1024 + h * 128 + k0) = pk2(silu_f(yq0) * eq, silu_f(yq1) * eq);
                *(unsigned*)(QM + (size_t)r * 1024 + 512 + h * 128 + k0) = pk2(silu_f(yk0) * ek, silu_f(yk1) * ek);
            }
            const float dd = __expf(bsum);
            *(f32x2*)(DDp + ((size_t)(257 + cid) * 4 + h) * 128 + k0) = (f32x2){dd, dd};
        }
    }
}

constexpr int SC_QS = 272, SC_VS = 144;
constexpr int SC_QT = 0, SC_KT = 2 * 17408, SC_VT = 4 * 17408, SC_AT = SC_VT + 2 * 9216, SC_SB = SC_AT + 9216, SC_DD = SC_SB + 18432, SC_NB = SC_DD + 1024, SC_END = SC_NB + 256;
static_assert(SC_END <= RING_BYTES, "scan LDS");
__device__ __forceinline__ bf16x8 tr8(LAS unsigned char* base, int stride, int row0, int col0, int lane) {
    const int fq = lane >> 4, q4 = (lane & 15) >> 2, p4 = lane & 3;
    LAS unsigned char* p = base + (row0 + 8 * fq + q4) * stride + (col0 + 4 * p4) * 2;
    const s16x4 lo = __builtin_amdgcn_ds_read_tr16_b64_v4i16((LAS s16x4*)p);
    const s16x4 hi = __builtin_amdgcn_ds_read_tr16_b64_v4i16((LAS s16x4*)(p + 4 * stride));
    return __builtin_shufflevector(lo, hi, 0, 1, 2, 3, 4, 5, 6, 7);
}
template <bool ML>
__device__ __forceinline__ void scan_unit(ArgsP a, LAS unsigned char* lds, int b, int h, int vs, int tid_in) {
    int tid = tid_in; asm volatile("" : "+v"(tid));
    unsigned char* ws = a->ws;
    const bf16* Z = (const bf16*)(ws + WS_Z);
    const bf16* QK = (const bf16*)(ws + (ML ? WS_QKC : WS_G));
    const float* DDp = (const float*)(ws + WS_DD) + (ML ? (size_t)257 * 512 : 0);
    bf16* O = (bf16*)(ws + (ML ? WS_OM : WS_OG));
    const int lane = tid & 63, wave = __builtin_amdgcn_readfirstlane(tid >> 6), fr = lane & 15, fq = lane >> 4;
    const int vt = wave & 3, hh = wave >> 2;
    for (int i = tid; i < (18432 + 1024 + 256) / 4; i += 512) ((LAS unsigned*)(lds + SC_SB))[i] = 0u;
    f32x4 S[4], nacc[4];
#pragma unroll
    for (int i = 0; i < 4; ++i) { S[i] = (f32x4){0.f, 0.f, 0.f, 0.f}; nacc[i] = (f32x4){0.f, 0.f, 0.f, 0.f}; }
    const bf16x8 ones = {(short)0x3F80, (short)0x3F80, (short)0x3F80, (short)0x3F80, (short)0x3F80, (short)0x3F80, (short)0x3F80, (short)0x3F80};
    u32x4 gq[2], gk[2], gv; float gd = 0.f;
    const int vcol = (ML ? ZC_MV : ZC_GV) + h * 256 + vs * 64;
#define SCAN_LOAD(c) do { const int c_ = (c); \
        _Pragma("unroll") for (int e = 0; e < 2; ++e) { const int pid = tid + 512 * e, t = pid >> 4, ch = pid & 15; \
            const bool ok = c_ > 0 || t >= 48; const int row = c_ == 0 ? MR + t - 48 : b * SEQ + (c_ - 1) * 64 + t; \
            gq[e] = ok ? *(const u32x4*)(QK + (size_t)row * 1024 + h * 128 + ch * 8) : (u32x4){0u, 0u, 0u, 0u}; \
            gk[e] = ok ? *(const u32x4*)(QK + (size_t)row * 1024 + 512 + h * 128 + ch * 8) : (u32x4){0u, 0u, 0u, 0u}; } \
        { const int t = tid >> 3, ch = tid & 7; const bool ok = c_ > 0 || t >= 48; const int row = c_ == 0 ? MR + t - 48 : b * SEQ + (c_ - 1) * 64 + t; \
          gv = ok ? *(const u32x4*)(Z + (size_t)row * ZB + vcol + ch * 8) : (u32x4){0u, 0u, 0u, 0u}; } \
        if (tid < 128) { const int cid = c_ == 0 ? 256 : b * 32 + (c_ - 1); gd = DDp[((size_t)cid * 4 + h) * 128 + tid]; } } while (0)
#define SCAN_STORE(buf) do { const int bo_ = (buf); \
        _Pragma("unroll") for (int e = 0; e < 2; ++e) { const int pid = tid + 512 * e, t = pid >> 4, ch = pid & 15; \
            *(LAS u32x4*)(lds + SC_QT + bo_ * 17408 + t * SC_QS + ch * 16) = gq[e]; *(LAS u32x4*)(lds + SC_KT + bo_ * 17408 + t * SC_QS + ch * 16) = gk[e]; } \
        { const int t = tid >> 3, ch = tid & 7; *(LAS u32x4*)(lds + SC_VT + bo_ * 9216 + t * SC_VS + ch * 16) = gv; } \
        if (tid < 128) ((LAS float*)(lds + SC_DD))[bo_ * 128 + tid] = gd; } while (0)
    SCAN_LOAD(0);
    __syncthreads();
    SCAN_STORE(0);
    __syncthreads();
    for (int c = 0; c < 33; ++c) {
        const int buf = c & 1;
        LAS unsigned char* QT = lds + SC_QT + buf * 17408; LAS unsigned char* KT = lds + SC_KT + buf * 17408; LAS unsigned char* VT = lds + SC_VT + buf * 9216;
        LAS unsigned char* AT = lds + SC_AT; LAS unsigned char* SB = lds + SC_SB;
        const LAS float* ddL = (const LAS float*)(lds + SC_DD) + buf * 128;
        if (c + 1 < 33) SCAN_LOAD(c + 1);
        {
            const int ti = wave >> 1;
#pragma unroll
            for (int sj = 0; sj < 2; ++sj) {
                const int si = 2 * (wave & 1) + sj;
                f32x4 acc = {0.f, 0.f, 0.f, 0.f};
#pragma unroll
                for (int ks = 0; ks < 4; ++ks) {
                    const bf16x8 qa = *(const LAS bf16x8*)(QT + (16 * ti + fr) * SC_QS + (32 * ks + 8 * fq) * 2);
                    const bf16x8 kb = *(const LAS bf16x8*)(KT + (16 * si + fr) * SC_QS + (32 * ks + 8 * fq) * 2);
                    acc = __builtin_amdgcn_mfma_f32_16x16x32_bf16(qa, kb, acc, 0, 0, 0);
                }
                const int sg = 16 * si + fr, tg = 16 * ti + 4 * fq;
                LAS bf16* ap = (LAS bf16*)(AT + tg * SC_VS) + sg;
                ap[0 * (SC_VS / 2)] = (bf16)(sg <= tg + 0 ? f2bf(acc.x) : 0u);
                ap[1 * (SC_VS / 2)] = (bf16)(sg <= tg + 1 ? f2bf(acc.y) : 0u);
                ap[2 * (SC_VS / 2)] = (bf16)(sg <= tg + 2 ? f2bf(acc.z) : 0u);
                ap[3 * (SC_VS / 2)] = (bf16)(sg <= tg + 3 ? f2bf(acc.w) : 0u);
            }
        }
        {
            const bf16x8 vb0 = tr8(VT, SC_VS, 0, 16 * vt, lane), vb1 = tr8(VT, SC_VS, 32, 16 * vt, lane);
#pragma unroll
            for (int i = 0; i < 4; ++i) {
                const int kt = 4 * hh + i;
                const bf16x8 ka0 = tr8(KT, SC_QS, 0, 16 * kt, lane), ka1 = tr8(KT, SC_QS, 32, 16 * kt, lane);
                f32x4 acc = S[i];
                acc = __builtin_amdgcn_mfma_f32_16x16x32_bf16(ka0, vb0, acc, 0, 0, 0);
                acc = __builtin_amdgcn_mfma_f32_16x16x32_bf16(ka1, vb1, acc, 0, 0, 0);
                const f32x4 dv = *(const LAS f32x4*)(ddL + 16 * kt + 4 * fq);
                S[i] = acc * dv;
                if (ML) {
                    f32x4 na = nacc[i];
                    na = __builtin_amdgcn_mfma_f32_16x16x32_bf16(ka0, ones, na, 0, 0, 0);
                    na = __builtin_amdgcn_mfma_f32_16x16x32_bf16(ka1, ones, na, 0, 0, 0);
                    nacc[i] = na * dv;
                }
            }
        }
        LDS_WAIT();
        __syncthreads();
        {
            const bf16x8 vb0 = tr8(VT, SC_VS, 0, 16 * vt, lane), vb1 = tr8(VT, SC_VS, 32, 16 * vt, lane);
            bf16x8 sb[4];
#pragma unroll
            for (int ks = 0; ks < 4; ++ks) sb[ks] = tr8(SB, SC_VS, 32 * ks, 16 * vt, lane);
            bf16x8 nb[4];
            if (ML) {
#pragma unroll
                for (int ks = 0; ks < 4; ++ks) nb[ks] = *(const LAS bf16x8*)(lds + SC_NB + (32 * ks + 8 * fq) * 2);
            }
#pragma unroll
            for (int tj = 0; tj < 2; ++tj) {
                const int ti = 2 * hh + tj;
                f32x4 acc = {0.f, 0.f, 0.f, 0.f}, den = {0.f, 0.f, 0.f, 0.f};
#pragma unroll
                for (int ks = 0; ks < 4; ++ks) {
                    const bf16x8 qa = *(const LAS bf16x8*)(QT + (16 * ti + fr) * SC_QS + (32 * ks + 8 * fq) * 2);
                    acc = __builtin_amdgcn_mfma_f32_16x16x32_bf16(qa, sb[ks], acc, 0, 0, 0);
                    if (ML) den = __builtin_amdgcn_mfma_f32_16x16x32_bf16(qa, nb[ks], den, 0, 0, 0);
                }
                const bf16x8 aa0 = *(const LAS bf16x8*)(AT + (16 * ti + fr) * SC_VS + (8 * fq) * 2), aa1 = *(const LAS bf16x8*)(AT + (16 * ti + fr) * SC_VS + (32 + 8 * fq) * 2);
                acc = __builtin_amdgcn_mfma_f32_16x16x32_bf16(aa0, vb0, acc, 0, 0, 0);
                acc = __builtin_amdgcn_mfma_f32_16x16x32_bf16(aa1, vb1, acc, 0, 0, 0);
                if (ML) {
                    den = __builtin_amdgcn_mfma_f32_16x16x32_bf16(aa0, ones, den, 0, 0, 0);
                    den = __builtin_amdgcn_mfma_f32_16x16x32_bf16(aa1, ones, den, 0, 0, 0);
                    acc.x = acc.x / fmaxf(fabsf(den.x), 1.f); acc.y = acc.y / fmaxf(fabsf(den.y), 1.f); acc.z = acc.z / fmaxf(fabsf(den.z), 1.f); acc.w = acc.w / fmaxf(fabsf(den.w), 1.f);
                }
                const int t0 = 16 * ti + 4 * fq;
                const int rowb = c == 0 ? MR + t0 - 48 : b * SEQ + (c - 1) * 64 + t0;
                bf16* op = O + (size_t)rowb * 1024 + h * 256 + vs * 64 + 16 * vt + fr;
                if (c > 0 || t0 >= 48) { op[0] = (bf16)f2bf(acc.x); op[1024] = (bf16)f2bf(acc.y); op[2048] = (bf16)f2bf(acc.z); op[3072] = (bf16)f2bf(acc.w); }
            }
        }
        LDS_WAIT();
        __syncthreads();
        {
#pragma unroll
            for (int i = 0; i < 4; ++i) {
                const int k0 = 16 * (4 * hh + i) + 4 * fq;
                LAS bf16* sp = (LAS bf16*)(SB + k0 * SC_VS) + 16 * vt + fr;
                sp[0 * (SC_VS / 2)] = (bf16)f2bf(S[i].x); sp[1 * (SC_VS / 2)] = (bf16)f2bf(S[i].y); sp[2 * (SC_VS / 2)] = (bf16)f2bf(S[i].z); sp[3 * (SC_VS / 2)] = (bf16)f2bf(S[i].w);
                if (ML && vt == 0 && fr == 0) { LAS bf16* np = (LAS bf16*)(lds + SC_NB) + k0; np[0] = (bf16)f2bf(nacc[i].x); np[1] = (bf16)f2bf(nacc[i].y); np[2] = (bf16)f2bf(nacc[i].z); np[3] = (bf16)f2bf(nacc[i].w); }
            }
            if (c + 1 < 33) SCAN_STORE(buf ^ 1);
        }
        LDS_WAIT();
        __syncthreads();
    }
#undef SCAN_LOAD
#undef SCAN_STORE
}

__device__ __forceinline__ void p6_headnorm(ArgsP a, int l, int gw, int ngw, int lane) {
    unsigned char* ws = a->ws; const bf16* Z = (const bf16*)(ws + WS_Z);
    for (int it = gw; it < MT * 8; it += ngw) {
        const int r = it >> 3, mx = (it >> 2) & 1, h = it & 3;
        bf16* op = (bf16*)(ws + (mx ? WS_OM : WS_OG)) + (size_t)r * 1024 + h * 256 + 4 * lane;
        const u32x2 w = *(const u32x2*)op; f32x4 v = {bflo(w.x), bfhi(w.x), bflo(w.y), bfhi(w.y)};
        const float rr = rsqrtf(wave_sum((v.x * v.x + v.y * v.y) + (v.z * v.z + v.w * v.w)) * (1.f / 256.f) + EPS);
        const f32x4 gg = *(const f32x4*)(a->in[mx ? I_GML : I_GGLA] + l * 256 + 4 * lane);
        const u32x2 gw2 = *(const u32x2*)(Z + (size_t)r * ZB + (mx ? ZC_MO : ZC_GR) + h * 256 + 4 * lane);
        const f32x4 gt = {bflo(gw2.x), bfhi(gw2.x), bflo(gw2.y), bfhi(gw2.y)};
        v = v * rr * gg * gt;
        u32x2 o; o.x = pk2(v.x, v.y); o.y = pk2(v.z, v.w); *(u32x2*)op = o;
    }
}

__device__ __forceinline__ int krow(int b, int s) { return s < NMETA ? MR + s : b * SEQ + (s - NMETA); }
__device__ __forceinline__ int t5_bucket(int n) {
    if (n < 16) return n < 0 ? 0 : n;
    const int lg = 16 + (int)(__logf((float)n * (1.f / 16.f)) / 2.0794415416798357f * 16.f);
    return lg < 31 ? lg : 31;
}
__device__ __forceinline__ unsigned off_b(unsigned row, unsigned ch) { return 256u * row + 16u * (ch ^ (((row & 3) << 2) | ((row >> 2) & 3))); }
__device__ __forceinline__ s16x4 tr_rd(LAS unsigned char* p) { return __builtin_amdgcn_ds_read_tr16_b64_v4i16((LAS s16x4*)p); }

constexpr int DW2_STRIDE = 9216, DW2_TILE = 0, DW2_SEL = 8192, DW2_BK = 8704, DSA2_T5 = 8 * DW2_STRIDE, DSA2_BT = DSA2_T5 + 2048 + 64;

template <bool DENSE_ONLY>
__device__ __forceinline__ void dsa_unit(ArgsP a, LAS unsigned char* lds, int b, int c, int nq, int wave, int lane_in) {
    int lane = lane_in; asm volatile("" : "+v"(lane));
    unsigned char* ws = a->ws;
    const bf16* QQ = (const bf16*)(ws + WS_QQ); const bf16* KI = (const bf16*)(ws + WS_KI); const bf16* KV = (const bf16*)(ws + WS_KV);
    unsigned* SC = (unsigned*)(ws + WS_SC) + (size_t)blockIdx.x * 64 * SC_PITCH;
    const int r0 = DENSE_ONLY ? MR : b * SEQ + 64 * c, p0 = DENSE_ONLY ? 0 : NMETA + 64 * c;
    const int fr = lane & 15, fq = lane >> 4;
    if (!DENSE_ONLY) {
        const int qt = wave & 3, kh = wave >> 2;
        if (p0 + 16 * qt + 15 >= 256) {
            const int qrow = r0 + 16 * qt + fr, pq = p0 + 16 * qt + fr;
            bf16x8 qf[8][2];
#pragma unroll
            for (int h = 0; h < 8; ++h)
#pragma unroll
                for (int ks = 0; ks < 2; ++ks) qf[h][ks] = *(const bf16x8*)(QQ + (size_t)qrow * NQQ + 2048 + h * 64 + ks * 32 + 8 * fq);
            float wi[8];
            { const f32x4 w0 = *(const f32x4*)((const float*)(ws + WS_WI) + (size_t)qrow * 8), w1 = *(const f32x4*)((const float*)(ws + WS_WI) + (size_t)qrow * 8 + 4);
              wi[0] = w0.x; wi[1] = w0.y; wi[2] = w0.z; wi[3] = w0.w; wi[4] = w1.x; wi[5] = w1.y; wi[6] = w1.z; wi[7] = w1.w; }
            const int nkt = 2 + 4 * c + qt;
            unsigned* scq = SC + (size_t)(16 * qt + fr) * SC_PITCH + 4 * fq;
            for (int kt0 = kh; kt0 < nkt; kt0 += 8) {
                bf16x8 a0[4], a1[4];
#pragma unroll
                for (int j = 0; j < 4; ++j) { const int kt = kt0 + 2 * j < nkt ? kt0 + 2 * j : nkt - 1;
                    const bf16* kp = KI + (size_t)krow(b, 16 * kt + fr) * 64 + 8 * fq;
                    a0[j] = *(const bf16x8*)kp; a1[j] = *(const bf16x8*)(kp + 32); }
#pragma unroll
                for (int j = 0; j < 4; ++j) {
                    const int kt = kt0 + 2 * j;
                    float s0 = 0.f, s1 = 0.f, s2 = 0.f, s3 = 0.f;
#pragma unroll
                    for (int h = 0; h < 8; ++h) {
                        f32x4 acc = {0.f, 0.f, 0.f, 0.f};
                        acc = __builtin_amdgcn_mfma_f32_16x16x32_bf16(a0[j], qf[h][0], acc, 0, 0, 0);
                        acc = __builtin_amdgcn_mfma_f32_16x16x32_bf16(a1[j], qf[h][1], acc, 0, 0, 0);
                        s0 += wi[h] * fmaxf(acc.x, 0.f); s1 += wi[h] * fmaxf(acc.y, 0.f); s2 += wi[h] * fmaxf(acc.z, 0.f); s3 += wi[h] * fmaxf(acc.w, 0.f);
                    }
                    const int kb = 16 * kt + 4 * fq;
                    u32x4 o;
                    { const unsigned bits = __builtin_bit_cast(unsigned, s0); o.x = (kb + 0) <= pq ? (bits ^ ((bits >> 31) ? 0xffffffffu : 0x80000000u)) : 0u; }
                    { const unsigned bits = __builtin_bit_cast(unsigned, s1); o.y = (kb + 1) <= pq ? (bits ^ ((bits >> 31) ? 0xffffffffu : 0x80000000u)) : 0u; }
                    { const unsigned bits = __builtin_bit_cast(unsigned, s2); o.z = (kb + 2) <= pq ? (bits ^ ((bits >> 31) ? 0xffffffffu : 0x80000000u)) : 0u; }
                    { const unsigned bits = __builtin_bit_cast(unsigned, s3); o.w = (kb + 3) <= pq ? (bits ^ ((bits >> 31) ? 0xffffffffu : 0x80000000u)) : 0u; }
                    if (kt < nkt) *(u32x4*)(scq + 16 * kt) = o;
                }
            }
        }
        VM_WAIT();
        __syncthreads();
    }
    LAS unsigned char* wl = lds + wave * DW2_STRIDE;
    LAS unsigned char* tile = wl + DW2_TILE;
    LAS unsigned short* selL = (LAS unsigned short*)(wl + DW2_SEL);
    LAS unsigned short* bkL = (LAS unsigned short*)(wl + DW2_BK);
    const LAS float* t5L = (const LAS float*)(lds + DSA2_T5);
    const LAS unsigned short* bkT = (const LAS unsigned short*)(lds + DSA2_BT);
    const int nqw = DENSE_ONLY ? 2 : 8;
    for (int qi_ = 0; qi_ < nqw; ++qi_) {
        asm volatile("" : "+v"(lane));
        const int iq = wave * nqw + qi_;
        if (iq >= nq) break;
        const int p = p0 + iq, nk = p + 1, qrow = r0 + iq;
        int nsel;
        if (!DENSE_ONLY && nk > 256) {
            const unsigned* scr = SC + (size_t)iq * SC_PITCH;
            unsigned u[33];
#pragma unroll
            for (int i = 0; i < 33; ++i) { const int s = lane + 64 * i; u[i] = s < nk ? __hip_atomic_load(scr + s, __ATOMIC_RELAXED, __HIP_MEMORY_SCOPE_AGENT) : 0u; }
            unsigned tau = 0u;
            for (int bit = 31; bit >= 16; --bit) {
                const unsigned cand = tau | (1u << bit);
                int cnt = 0;
#pragma unroll
                for (int i = 0; i < 33; ++i) cnt += __popcll(__ballot(u[i] >= cand));
                if (cnt >= 256) tau = cand;
            }
            {
                const unsigned hi = tau >> 16;
                int cab = 0, ncand = 0;
                LAS unsigned short* candL = (LAS unsigned short*)tile;
                const unsigned long long ltm = (1ull << lane) - 1ull;
#pragma unroll
                for (int i = 0; i < 33; ++i) {
                    const unsigned uh = u[i] >> 16;
                    cab += __popcll(__ballot(uh > hi));
                    const unsigned long long mc = __ballot(uh == hi);
                    if (mc != 0ull) { if (uh == hi) candL[ncand + __popcll(mc & ltm)] = (unsigned short)(u[i] & 0xffffu); ncand += __popcll(mc); }
                }
                LDS_WAIT();
                const int need = 256 - cab;
                unsigned lo = 0u;
                if (ncand <= 64) {
                    const unsigned v = lane < ncand ? (unsigned)candL[lane] + 1u : 0u;
                    for (int bit = 15; bit >= 0; --bit) { const unsigned cand = lo | (1u << bit); if (__popcll(__ballot(v >= cand + 1u)) >= need) lo = cand; }
                } else {
                    for (int bit = 15; bit >= 0; --bit) {
                        const unsigned cand = lo | (1u << bit); int cnt = 0;
                        for (int j = lane; j < ((ncand + 63) & ~63); j += 64) { const unsigned v = j < ncand ? (unsigned)candL[j] + 1u : 0u; cnt += __popcll(__ballot(v >= cand + 1u)); }
                        if (cnt >= need) lo = cand;
                    }
                }
                tau |= lo;
                LDS_WAIT();
            }
            int cgt = 0;
#pragma unroll
            for (int i = 0; i < 33; ++i) cgt += __popcll(__ballot(u[i] > tau));
            const int rem = 256 - cgt;
            const unsigned long long lt = (1ull << lane) - 1ull;
            int base = 0, eqseen = 0;
#pragma unroll
            for (int i = 0; i < 33; ++i) {
                const bool gt = u[i] > tau, eq = u[i] == tau;
                const unsigned long long meq = __ballot(eq);
                const bool take = gt || (eq && (eqseen + __popcll(meq & lt)) < rem);
                const unsigned long long mt = __ballot(take);
                if (take) { const int pos = base + __popcll(mt & lt), s = lane + 64 * i; selL[pos] = (unsigned short)s; bkL[pos] = bkT[p - s]; }
                base += __popcll(mt); eqseen += __popcll(meq);
            }
            nsel = 256;
        } else {
#pragma unroll
            for (int m = 0; m < 4; ++m) { const int s = lane + 64 * m; selL[s] = (unsigned short)(s < nk ? s : 0); bkL[s] = bkT[s < nk ? p - s : 0]; }
            nsel = nk;
        }
        asm volatile("" : "+v"(lane));
        bf16x8 qB[4];
#pragma unroll
        for (int ks = 0; ks < 4; ++ks) qB[ks] = *(const bf16x8*)(QQ + (size_t)qrow * NQQ + fr * 128 + ks * 32 + 8 * fq);
        LDS_WAIT();
        f32x4 O[8];
#pragma unroll
        for (int nt = 0; nt < 8; ++nt) O[nt] = (f32x4){0.f, 0.f, 0.f, 0.f};
        float qss = 0.f;
#pragma unroll
        for (int ks = 0; ks < 4; ++ks) { const u32x4 w = __builtin_bit_cast(u32x4, qB[ks]);
            qss += (bflo(w.x) * bflo(w.x) + bfhi(w.x) * bfhi(w.x)) + (bflo(w.y) * bflo(w.y) + bfhi(w.y) * bfhi(w.y)) + (bflo(w.z) * bflo(w.z) + bfhi(w.z) * bfhi(w.z)) + (bflo(w.w) * bflo(w.w) + bfhi(w.w) * bfhi(w.w)); }
        qss += __shfl_xor(qss, 16); qss += __shfl_xor(qss, 32);
        const float mb = sqrtf(qss) * t5L[512] + t5L[513];
        float lrun = 0.f;
        const int nblk = (nsel + 31) >> 5;
        u32x4 gv[8];
#pragma unroll
        for (int e = 0; e < 8; ++e) { const int pid = lane + 64 * e, ri = pid >> 4, ch = pid & 15;
            const int key = ri < nsel ? (int)selL[ri] : 0;
            gv[e] = *(const u32x4*)(KV + (size_t)krow(b, key) * 128 + ch * 8); }
        for (int blk = 0; blk < nblk; ++blk) {
#pragma unroll
            for (int e = 0; e < 8; ++e) { const int pid = lane + 64 * e, ri = pid >> 4, ch = pid & 15; *(LAS u32x4*)(tile + off_b(ri, ch)) = gv[e]; }
            if (blk + 1 < nblk) {
#pragma unroll
                for (int e = 0; e < 8; ++e) { const int pid = lane + 64 * e, ri = pid >> 4, ch = pid & 15, j = 32 * (blk + 1) + ri;
                    const int key = j < nsel ? (int)selL[j] : 0;
                    gv[e] = *(const u32x4*)(KV + (size_t)krow(b, key) * 128 + ch * 8); }
            }
            LDS_WAIT();
            f32x4 s0 = {0.f, 0.f, 0.f, 0.f}, s1 = {0.f, 0.f, 0.f, 0.f};
#pragma unroll
            for (int ks = 0; ks < 4; ++ks) {
                const bf16x8 k0 = *(const LAS bf16x8*)(tile + off_b(fr, 4 * ks + fq)), k1 = *(const LAS bf16x8*)(tile + off_b(16 + fr, 4 * ks + fq));
                s0 = __builtin_amdgcn_mfma_f32_16x16x32_bf16(k0, qB[ks], s0, 0, 0, 0);
                s1 = __builtin_amdgcn_mfma_f32_16x16x32_bf16(k1, qB[ks], s1, 0, 0, 0);
            }
            const int j0 = 32 * blk + 4 * fq;
            const u32x2 b0 = *(const LAS u32x2*)(bkL + j0), b1 = *(const LAS u32x2*)(bkL + j0 + 16);
            const float p00 = (j0 + 0) < nsel ? __expf(s0.x + t5L[(b0.x & 0xffffu) + fr] - mb) : 0.f, p01 = (j0 + 1) < nsel ? __expf(s0.y + t5L[(b0.x >> 16) + fr] - mb) : 0.f;
            const float p02 = (j0 + 2) < nsel ? __expf(s0.z + t5L[(b0.y & 0xffffu) + fr] - mb) : 0.f, p03 = (j0 + 3) < nsel ? __expf(s0.w + t5L[(b0.y >> 16) + fr] - mb) : 0.f;
            const float p10 = (j0 + 16) < nsel ? __expf(s1.x + t5L[(b1.x & 0xffffu) + fr] - mb) : 0.f, p11 = (j0 + 17) < nsel ? __expf(s1.y + t5L[(b1.x >> 16) + fr] - mb) : 0.f;
            const float p12 = (j0 + 18) < nsel ? __expf(s1.z + t5L[(b1.y & 0xffffu) + fr] - mb) : 0.f, p13 = (j0 + 19) < nsel ? __expf(s1.w + t5L[(b1.y >> 16) + fr] - mb) : 0.f;
            lrun += ((p00 + p01) + (p02 + p03)) + ((p10 + p11) + (p12 + p13));
            u32x4 pw; pw.x = pk2(p00, p01); pw.y = pk2(p02, p03); pw.z = pk2(p10, p11); pw.w = pk2(p12, p13);
            const bf16x8 pa = __builtin_bit_cast(bf16x8, pw);
            const unsigned q4 = (unsigned)(fr >> 2), p4 = (unsigned)(lane & 3);
#pragma unroll
            for (int nt = 0; nt < 8; ++nt) {
                const s16x4 vlo = tr_rd(tile + off_b(4 * fq + q4, 2 * nt + (p4 >> 1)) + 8 * (p4 & 1));
                const s16x4 vhi = tr_rd(tile + off_b(16 + 4 * fq + q4, 2 * nt + (p4 >> 1)) + 8 * (p4 & 1));
                const bf16x8 vb = __builtin_shufflevector(vlo, vhi, 0, 1, 2, 3, 4, 5, 6, 7);
                O[nt] = __builtin_amdgcn_mfma_f32_16x16x32_bf16(pa, vb, O[nt], 0, 0, 0);
            }
        }
        float lt2 = lrun + __shfl_xor(lrun, 16); lt2 += __shfl_xor(lt2, 32);
        const float inv = 1.f / lt2;
        float ir[4];
#pragma unroll
        for (int r = 0; r < 4; ++r) ir[r] = __shfl(inv, 4 * fq + r);
        bf16* od = (bf16*)(ws + WS_OD) + (size_t)qrow * 1024 + fr;
#pragma unroll
        for (int nt = 0; nt < 8; ++nt)
#pragma unroll
            for (int r = 0; r < 4; ++r) { const int hd = 4 * fq + r; od[(size_t)(hd >> 3) * MT * 1024 + (hd & 7) * 128 + 16 * nt] = (bf16)f2bf(O[nt][r] * ir[r]); }
        LDS_WAIT();
    }
}
__device__ __forceinline__ void p5_dsa(ArgsP a, LAS unsigned char* lds, int l, int tid, int wave, int lane) {
    LAS float* t5L = (LAS float*)(lds + DSA2_T5);
    __syncthreads();
    t5L[tid] = a->in[I_T5][tid];
    for (int n = tid; n < TT; n += 512) ((LAS unsigned short*)(lds + DSA2_BT))[n] = (unsigned short)(t5_bucket(n) * 16);
    if (tid < 64) {
        const float g0 = fabsf(a->in[I_GDKV][l * 128 + tid]), g1 = fabsf(a->in[I_GDKV][l * 128 + 64 + tid]);
        const float gm = wave_max(fmaxf(g0, g1));
        float tm = 0.f;
#pragma unroll
        for (int i = 0; i < 8; ++i) tm = fmaxf(tm, fabsf(a->in[I_T5][tid + 64 * i]));
        tm = wave_max(tm);
        if (tid == 0) { t5L[512] = 11.313708498984761f * gm; t5L[513] = tm; }
    }
    __syncthreads();
    for (int u = blockIdx.x; u < 256; u += gridDim.x) {
        dsa_unit<false>(a, lds, u >> 5, u & 31, 64, wave, lane);
        __syncthreads();
    }
    if (blockIdx.x == 0) dsa_unit<true>(a, lds, 0, 0, 16, wave, lane);
}

__global__ void __launch_bounds__(NWAVES * 64, 2) fwd(Args a_) {
    extern __shared__ __attribute__((aligned(16))) unsigned char lds_raw[];
    LAS unsigned char* lds = (LAS unsigned char*)lds_raw;
    volatile LAS unsigned* MISC = (volatile LAS unsigned*)(lds + MISC_OFF);
    if (threadIdx.x < 32) MISC[threadIdx.x] = 0u;
    __syncthreads();
    const int g_lo = a_.g_lo, g_hi = a_.g_hi, l_lo = a_.l_lo, l_hi = a_.l_hi, ph_lo = a_.ph_lo, ph_hi = a_.ph_hi, use_bar = a_.use_bar;
    XcdBarrier bar; bar.bar = (unsigned*)(a_.ws + WS_CTL) + CW_BAR; bar.x = 0; bar.st = nullptr;
    if (use_bar) bar = xcd_barrier_post((unsigned*)(a_.ws + WS_CTL) + CW_BAR, MISC + 8);
#define GRID_BAR() do { if (use_bar) xcd_barrier(bar); } while (0)
#ifndef PHMASK
#define PHMASK 0xFFFF
#endif
#ifndef PROBE_PH
#define PROBE_PH -1
#endif
#ifndef PROBE_MASK
#define PROBE_MASK 0
#endif
#define PROBED(k) ((PROBE_MASK >> (k)) & 1)
#define PH(k) (((PHMASK >> (k)) & 1) && ph_lo <= (k) && (k) < ph_hi)
#define PBEGIN ArgsP a = (ArgsP)__builtin_amdgcn_kernarg_segment_ptr(); asm volatile("" : "+s"(a)); unsigned char* ws = a->ws; \
    int tid_ = threadIdx.x; asm volatile("" : "+v"(tid_)); const int tid = tid_, lane = tid & 63, wave = __builtin_amdgcn_readfirstlane(tid >> 6); const int gw = blockIdx.x * NWAVES + wave, ngw = gridDim.x * NWAVES; (void)ws; (void)gw; (void)ngw; (void)lane;

    if (((PHMASK >> 13) & 1) && a_.prep) { PBEGIN prep_weights(a, lds, gw, ngw, wave, lane); GRID_BAR(); }

    for (int g = g_lo; g < g_hi; ++g) {
        for (int l = l_lo; l < l_hi; ++l) {
            if (PH(0) && l == 0) { PBEGIN p0_init(a, g, gw, ngw, lane); GRID_BAR(); }
            if (PH(1)) { PBEGIN
                FIn f{(bf16*)(ws + WS_Z), (float*)(ws + WS_ZF), (const float*)(ws + WS_BIN) + l * NZ};
                run_gemm(lds, (const bf16*)(ws + WS_XN), (const bf16*)(ws + WS_WIN) + (size_t)l * NZ * D, NZ, D, f, gw, ngw, lane);
                if (PROBED(1)) { run_gemm(lds, (const bf16*)(ws + WS_XN), (const bf16*)(ws + WS_WIN) + (size_t)l * NZ * D, NZ, D, f, gw, ngw, lane); }
                GRID_BAR();
            }
            if (PH(2)) { PBEGIN p2_prep(a, l, gw, ngw, lane); if (PROBED(2)) { p2_prep(a, l, gw, ngw, lane); } GRID_BAR(); }
            if (PH(3)) { PBEGIN
                FQQ f{(bf16*)(ws + WS_QQ)};
                run_gemm(lds, (const bf16*)(ws + WS_CQN), (const bf16*)(ws + WS_WQQ) + (size_t)l * NQQ * 256, NQQ, 256, f, gw, ngw, lane);
                if (PROBED(3)) { run_gemm(lds, (const bf16*)(ws + WS_CQN), (const bf16*)(ws + WS_WQQ) + (size_t)l * NQQ * 256, NQQ, 256, f, gw, ngw, lane); }
            }
            if (PH(4)) { PBEGIN
                for (int u = blockIdx.x; u < 256; u += gridDim.x) {
                    const int b = (u >> 4) & 7, h = (u >> 2) & 3, vs = u & 3;
                    if (u >> 7) scan_unit<true>(a, lds, b, h, vs, tid); else scan_unit<false>(a, lds, b, h, vs, tid);
                }
#if PROBE_PH == 4
                for (int u = blockIdx.x; u < 256; u += gridDim.x) {
                    const int b = (u >> 4) & 7, h = (u >> 2) & 3, vs = u & 3;
                    if (u >> 7) scan_unit<true>(a, lds, b, h, vs, tid); else scan_unit<false>(a, lds, b, h, vs, tid);
                }
#endif
                GRID_BAR();
            }
            if (PH(5)) { PBEGIN p5_dsa(a, lds, l, tid, wave, lane); }
#if PROBE_PH == 5
            if (PH(5)) { PBEGIN p5_dsa(a, lds, l, tid, wave, lane); }
#endif
            if (PH(6)) { PBEGIN p6_headnorm(a, l, gw, ngw, lane); GRID_BAR(); }
            if (PH(7)) {
                __syncthreads();
                { PBEGIN
                  const bf16* OD0 = (const bf16*)(ws + WS_OD); const bf16* OD1 = OD0 + (size_t)MT * 1024;
                  const bf16* WB0 = (const bf16*)(ws + WS_WBD) + (size_t)l * D * 2048; const bf16* WB1 = WB0 + (size_t)D * D;
                  int Kc = D, Nc = D; asm volatile("" : "+s"(Kc)); asm volatile("" : "+s"(Nc));
                  pg8::Gemm g{(const bf16*)(ws + WS_OG), (const bf16*)(ws + WS_WBG) + (size_t)l * D * D, MR, Nc, Kc, OD0, OD1, (const bf16*)(ws + WS_OM), WB0, WB1, (const bf16*)(ws + WS_WBM) + (size_t)l * D * D};
                  ChainOrder S; S.S.init(MR, Nc, (int)gridDim.x, (int)blockIdx.x);
                  EpiMix E{(const bf16*)(ws + WS_Z), (bf16*)(ws + WS_MIX)};
                  pg8::gemm_phase<EpiMix, ChainOrder, true, true, true>((PG8_LAS unsigned char*)lds, g, S, E);
                  FBr<0> f0{(const bf16*)(ws + WS_Z), (float*)(ws + WS_Y), (bf16*)(ws + WS_MIX)};
                  mini_gemm((const bf16*)(ws + WS_OG), (const bf16*)(ws + WS_WBG) + (size_t)l * D * D, Nc, Kc, f0, gw, ngw, lane);
                  FBr<1> f1{(const bf16*)(ws + WS_Z), (float*)(ws + WS_Y), (bf16*)(ws + WS_MIX)};
                  mini_gemm(OD0, WB0, Nc, Kc, f1, gw, ngw, lane);
                  mini_gemm(OD1, WB1, Nc, Kc, f1, gw, ngw, lane);
                  FBr<2> f2{(const bf16*)(ws + WS_Z), (float*)(ws + WS_Y), (bf16*)(ws + WS_MIX)};
                  mini_gemm((const bf16*)(ws + WS_OM), (const bf16*)(ws + WS_WBM) + (size_t)l * D * D, Nc, Kc, f2, gw, ngw, lane);
                }
#if PROBED(7)
                { PBEGIN
                  const bf16* OD0 = (const bf16*)(ws + WS_OD); const bf16* OD1 = OD0 + (size_t)MT * 1024;
                  const bf16* WB0 = (const bf16*)(ws + WS_WBD) + (size_t)l * D * 2048; const bf16* WB1 = WB0 + (size_t)D * D;
                  int Kc = D, Nc = D; asm volatile("" : "+s"(Kc)); asm volatile("" : "+s"(Nc));
                  pg8::Gemm g{(const bf16*)(ws + WS_OG), (const bf16*)(ws + WS_WBG) + (size_t)l * D * D, MR, Nc, Kc, OD0, OD1, (const bf16*)(ws + WS_OM), WB0, WB1, (const bf16*)(ws + WS_WBM) + (size_t)l * D * D};
                  ChainOrder S; S.S.init(MR, Nc, (int)gridDim.x, (int)blockIdx.x);
                  EpiMix E{(const bf16*)(ws + WS_Z), (bf16*)(ws + WS_MIX)};
                  pg8::gemm_phase<EpiMix, ChainOrder, true, true, true>((PG8_LAS unsigned char*)lds, g, S, E);
                  FBr<0> f0{(const bf16*)(ws + WS_Z), (float*)(ws + WS_Y), (bf16*)(ws + WS_MIX)};
                  mini_gemm((const bf16*)(ws + WS_OG), (const bf16*)(ws + WS_WBG) + (size_t)l * D * D, Nc, Kc, f0, gw, ngw, lane);
                  FBr<1> f1{(const bf16*)(ws + WS_Z), (float*)(ws + WS_Y), (bf16*)(ws + WS_MIX)};
                  mini_gemm(OD0, WB0, Nc, Kc, f1, gw, ngw, lane);
                  mini_gemm(OD1, WB1, Nc, Kc, f1, gw, ngw, lane);
                  FBr<2> f2{(const bf16*)(ws + WS_Z), (float*)(ws + WS_Y), (bf16*)(ws + WS_MIX)};
                  mini_gemm((const bf16*)(ws + WS_OM), (const bf16*)(ws + WS_WBM) + (size_t)l * D * D, Nc, Kc, f2, gw, ngw, lane);
                }
#endif
                GRID_BAR();
            }
            if (PH(8)) { PBEGIN
                FY f{(float*)(ws + WS_Y)};
                run_gemm(lds, (const bf16*)(ws + WS_MIX), (const bf16*)(ws + WS_WOUT) + (size_t)l * D * D, D, D, f, gw, ngw, lane);
                if (PROBED(8)) { run_gemm(lds, (const bf16*)(ws + WS_MIX), (const bf16*)(ws + WS_WOUT) + (size_t)l * D * D, D, D, f, gw, ngw, lane); }
                GRID_BAR();
            }
            if (PH(9)) { PBEGIN p_norm_res(a, g, a->in[I_GPOSTMIX] + l * D, a->in[I_GPREMLP] + l * D, gw, ngw, lane); GRID_BAR(); }
            if (PH(10)) { PBEGIN
                FUp f{(bf16*)(ws + WS_Z)};
                run_gemm(lds, (const bf16*)(ws + WS_XN), (const bf16*)(ws + WS_WUP) + (size_t)l * DFF * D, DFF, D, f, gw, ngw, lane);
                if (PROBED(10)) { run_gemm(lds, (const bf16*)(ws + WS_XN), (const bf16*)(ws + WS_WUP) + (size_t)l * DFF * D, DFF, D, f, gw, ngw, lane); }
                GRID_BAR();
            }
            if (PH(11)) { PBEGIN
                FY f{(float*)(ws + WS_Y)};
                run_gemm(lds, (const bf16*)(ws + WS_Z), (const bf16*)(ws + WS_WDN) + (size_t)l * D * DFF, D, DFF, f, gw, ngw, lane);
                if (PROBED(11)) { run_gemm(lds, (const bf16*)(ws + WS_Z), (const bf16*)(ws + WS_WDN) + (size_t)l * D * DFF, D, DFF, f, gw, ngw, lane); }
                GRID_BAR();
            }
            if (PH(12)) { PBEGIN p_norm_res(a, g, a->in[I_GPOSTMLP] + l * D, l + 1 < NL ? a->in[I_GPREMIX] + (l + 1) * D : nullptr, gw, ngw, lane); GRID_BAR(); }
        }
    }
#undef PH
#undef GRID_BAR
#undef PBEGIN
}

#ifndef MK_ONE_LAUNCH
#define MK_ONE_LAUNCH 1
#endif
extern "C" void kernel_launch(void* const* d_in, const int* in_sizes, int n_in, void* d_out, int out_size, void* d_ws, size_t ws_size, hipStream_t stream) {
    static int grid = 0;
    if (grid == 0) {
        if (n_in != 28 || out_size != NB * SEQ * D || ws_size < WS_END) { fprintf(stderr, "kernel_launch: unexpected shapes (n_in %d out %d ws %zu need %zu)\n", n_in, out_size, ws_size, (size_t)WS_END); grid = -1; return; }
        int dev = 0, cus = 0, per_cu = 0;
        if (hipGetDevice(&dev) != hipSuccess || hipDeviceGetAttribute(&cus, hipDeviceAttributeMultiprocessorCount, dev) != hipSuccess) { grid = -1; return; }
        if (hipFuncSetAttribute((const void*)fwd, hipFuncAttributeMaxDynamicSharedMemorySize, LDS_BYTES) != hipSuccess) { fprintf(stderr, "kernel_launch: hipFuncSetAttribute failed\n"); grid = -1; return; }
        if (hipOccupancyMaxActiveBlocksPerMultiprocessor(&per_cu, (const void*)fwd, NWAVES * 64, LDS_BYTES) != hipSuccess || per_cu < 1) { fprintf(stderr, "kernel_launch: occupancy query says %d\n", per_cu); }
        (void)hipGetLastError();
        grid = cus;
    }
    if (grid < 0) return;
    (void)hipMemsetAsync((char*)d_ws + WS_CTL, 0, CTL_ZERO_BYTES, stream);
    Args a{};
    for (int i = 0; i < 28; ++i) a.in[i] = (const float*)d_in[i];
    a.out = (float*)d_out; a.ws = (unsigned char*)d_ws;
#if MK_ONE_LAUNCH
    a.g_lo = 0; a.g_hi = NG; a.l_lo = 0; a.l_hi = NL; a.ph_lo = 0; a.ph_hi = 13; a.prep = 1; a.use_bar = 1;
    hipLaunchKernelGGL(fwd, dim3(grid), dim3(NWAVES * 64), LDS_BYTES, stream, a);
#else
    a.use_bar = 0;
    a.prep = 1; a.g_lo = 0; a.g_hi = 0; a.l_lo = 0; a.l_hi = 0; a.ph_lo = 0; a.ph_hi = 0;
    hipLaunchKernelGGL(fwd, dim3(grid), dim3(NWAVES * 64), LDS_BYTES, stream, a);
    a.prep = 0;
    static const int cuts[] = {0, 1, 2, 3, 5, 7, 8, 9, 10, 11, 12, 13};
    for (int g = 0; g < NG; ++g) for (int l = 0; l < NL; ++l) for (int c = 0; c < 11; ++c) {
        if (c == 0 && l != 0) continue;
        a.g_lo = g; a.g_hi = g + 1; a.l_lo = l; a.l_hi = l + 1; a.ph_lo = cuts[c]; a.ph_hi = cuts[c + 1];
        hipLaunchKernelGGL(fwd, dim3(grid), dim3(NWAVES * 64), LDS_BYTES, stream, a);
    }
#endif
    const hipError_t le = hipPeekAtLastError();
    if (le != hipSuccess) fprintf(stderr, "kernel_launch: launch failed: %s\n", hipGetErrorName(le));
}
```

```cpp
#include <hip/hip_runtime.h>
#include <cstdio>
#include <cstdint>
namespace pg8 {
#define PG8_LAS __attribute__((address_space(3)))
typedef unsigned short bf16_t;
typedef short bf16x8 __attribute__((ext_vector_type(8)));
typedef float f32x4 __attribute__((ext_vector_type(4)));
typedef unsigned u32x4 __attribute__((ext_vector_type(4)));
constexpr int BM = 256, BK = 64, HALF = 128, HTB = HALF * BK * 2  , STAGE_BYTES = 8 * HTB, NXCD = 8, WGM = 8;

__host__ __device__ __forceinline__ int lds_byte(int r, int c) { const int st = (r >> 4) * 2 + (c >> 5), rr = r & 15, cc = c & 31, ob = rr * 64 + cc * 2; return st * 1024 + (ob ^ (((ob >> 9) & 1) << 5)); }
__host__ __device__ __forceinline__ void stage_rc(int b, int& R, int& C) { const int st = b / 1024, sb = b % 1024, swz = sb ^ (((sb >> 9) & 1) << 5); R = (st >> 1) * 16 + swz / 64; C = (st & 1) * 32 + (swz % 64) / 2; }
__host__ __device__ __forceinline__ int perm32(int rho) { const int n = rho >> 4, i = rho & 15; return 8 * (i >> 2) + 4 * n + (i & 3); }

struct Unit { int pm, pn, sub; };
struct Gemm { const bf16_t* A; const bf16_t* Bt; int M, N, K; const bf16_t *A1, *A2, *A3, *B1, *B2, *B3; };

struct StaticOrder {
    int nM, nN, nwg, G, c;
    __host__ __device__ void init(int M, int N, int G_, int c_) { nM = M / BM; nN = N / BM; nwg = nM * nN; G = G_; c = c_; }
    __host__ __device__ bool next(int i, Unit& u) const {
        const long L = (long)i * G + c; if (L >= nwg) return false;
        int wgid = (int)L; { const int q = nwg / NXCD, r = nwg % NXCD, xcd = wgid % NXCD, off = wgid / NXCD; wgid = (xcd < r ? xcd * (q + 1) : r * (q + 1) + (xcd - r) * q) + off; }
        const int nig = WGM * nN, gid = wgid / nig, fm = gid * WGM, gsz = (nM - fm) < WGM ? (nM - fm) : WGM;
        u.pm = fm + ((wgid % nig) % gsz); u.pn = (wgid % nig) / gsz; u.sub = 0; return true;
    }
    __device__ __forceinline__ void a_ready(const Unit&) const {}
    __device__ __forceinline__ void done(const Unit&) const {}
};

__device__ __forceinline__ unsigned cvt_pk_bf16(float lo, float hi) { unsigned r; asm volatile("v_cvt_pk_bf16_f32 %0, %1, %2" : "=v"(r) : "v"(lo), "v"(hi)); return r; }
template <class Epi, class Sched, bool ALIGN_EPI = false, bool SP2 = false, bool CHAIN = false>
__device__ __forceinline__ void gemm_phase(PG8_LAS unsigned char* lds, const Gemm g, const Sched& S, const Epi& E) {
    int tid_ = threadIdx.x; asm volatile("" : "+v"(tid_));
    const int tid = tid_, wid = __builtin_amdgcn_readfirstlane(tid >> 6), lane = tid & 63, wr = wid >> 2, wc = wid & 3, fr = lane & 15, fq = lane >> 4;
    const int K = g.K, nt = K / BK;
    unsigned voffA[2], voffB[2];
#pragma unroll
    for (int i = 0; i < 2; ++i) { int R, C; stage_rc(tid * 16 + i * 8192, R, C); const int Rb = Epi::PERM ? ((R & ~31) + perm32(R & 31)) : R;
        voffA[i] = (unsigned)(R * K + C) * 2u; voffB[i] = (unsigned)(Rb * K + C) * 2u; }
    const size_t kstep = (size_t)(BK * 2);
    const size_t hstep = (size_t)HALF * K * 2;
    const size_t tstep = 2 * hstep;
    const unsigned ldsw = (unsigned)wid * 1024u;
    const int aoff = lds_byte(wr * 64 + fr, fq * 8), boff = lds_byte(wc * 32 + fr, fq * 8);
#define PG8_SA(b, h) (((b) * 2 + (h)) * HTB)
#define PG8_SB(b, h) ((4 + (b) * 2 + (h)) * HTB)
#define PG8_STAGE(bufoff, gbase, voff) do { _Pragma("unroll") for (int _i = 0; _i < 2; ++_i) \
        __builtin_amdgcn_global_load_lds((const unsigned*)((const char*)(gbase) + (voff)[_i]), (PG8_LAS unsigned*)(lds + (bufoff) + ldsw + _i * 8192), 16, 0, 0); } while (0)
#define PG8_LDA(dst, b, h) do { _Pragma("unroll") for (int m = 0; m < 4; ++m) _Pragma("unroll") for (int k = 0; k < 2; ++k) dst[m][k] = *(const PG8_LAS bf16x8*)(lds + PG8_SA(b, h) + aoff + m * 2048 + k * 1024); } while (0)
#define PG8_LDB(dst, b, h) do { _Pragma("unroll") for (int n = 0; n < 2; ++n) _Pragma("unroll") for (int k = 0; k < 2; ++k) dst[n][k] = *(const PG8_LAS bf16x8*)(lds + PG8_SB(b, h) + boff + n * 2048 + k * 1024); } while (0)
#define PG8_MMA(ai, bj, At, Bt) do { __builtin_amdgcn_s_setprio(1); _Pragma("unroll") for (int m = 0; m < 4; ++m) _Pragma("unroll") for (int n = 0; n < 2; ++n) _Pragma("unroll") for (int k = 0; k < 2; ++k) \
        acc[ai][bj][m][n] = __builtin_amdgcn_mfma_f32_16x16x32_bf16(Bt[n][k], At[m][k], acc[ai][bj][m][n], 0, 0, 0); __builtin_amdgcn_s_setprio(0); } while (0)
#define PG8_WAIT_V(n) asm volatile("s_waitcnt vmcnt(" #n ")" ::: "memory")
#define PG8_WAIT_L(n) asm volatile("s_waitcnt lgkmcnt(" #n ")" ::: "memory")
#define PG8_BAR __builtin_amdgcn_s_barrier()
#define PG8_SCHED __builtin_amdgcn_sched_barrier(0)
    Unit cur, nxt; int ui = 0;
    if (!S.next(0, cur)) return;
    f32x4 acc[2][2][4][2];
#pragma unroll
    for (int a = 0; a < 2; ++a)
#pragma unroll
        for (int b = 0; b < 2; ++b)
#pragma unroll
            for (int m = 0; m < 4; ++m)
#pragma unroll
                for (int n = 0; n < 2; ++n) acc[a][b][m][n] = (f32x4){0.f, 0.f, 0.f, 0.f};
    bf16x8 At[4][2], B0[2][2], B1[2][2];
#define PG8_ABASE(u) ((const char*)(!CHAIN || (u).sub == 0 ? g.A : (u).sub == 1 ? g.A1 : (u).sub == 2 ? g.A2 : g.A3) + (size_t)(u).pm * tstep)
#define PG8_BBASE(u) ((const char*)(!CHAIN || (u).sub == 0 ? g.Bt : (u).sub == 1 ? g.B1 : (u).sub == 2 ? g.B2 : g.B3) + (size_t)(u).pn * tstep)
    const char* cA = PG8_ABASE(cur); const char* cB = PG8_BBASE(cur);
    S.a_ready(cur);
    if constexpr (SP2) {
        PG8_STAGE(PG8_SB(0, 0), cB, voffB); PG8_STAGE(PG8_SB(0, 1), cB + hstep, voffB); PG8_STAGE(PG8_SA(0, 0), cA, voffA); PG8_STAGE(PG8_SA(0, 1), cA + hstep, voffA);
        if (wr == 1) PG8_BAR;
        PG8_WAIT_V(2); PG8_BAR;
        PG8_STAGE(PG8_SB(1, 0), cB + kstep, voffB); PG8_STAGE(PG8_SA(1, 0), cA + kstep, voffA); PG8_STAGE(PG8_SB(1, 1), cB + hstep + kstep, voffB);
        PG8_WAIT_V(6); PG8_BAR;
    } else {
        PG8_STAGE(PG8_SB(0, 0), cB, voffB); PG8_STAGE(PG8_SA(0, 0), cA, voffA); PG8_STAGE(PG8_SB(0, 1), cB + hstep, voffB); PG8_STAGE(PG8_SA(0, 1), cA + hstep, voffA);
        if (wr == 1) PG8_BAR;
        PG8_WAIT_V(4); PG8_BAR;
        PG8_STAGE(PG8_SB(1, 0), cB + kstep, voffB); PG8_STAGE(PG8_SA(1, 0), cA + kstep, voffA); PG8_STAGE(PG8_SB(1, 1), cB + hstep + kstep, voffB);
        PG8_WAIT_V(6); PG8_BAR;
    }
    for (;;) {
        const bool has_next = S.next(ui + 1, nxt);
        const char* nA = has_next ? PG8_ABASE(nxt) : cA; const char* nB = has_next ? PG8_BBASE(nxt) : cB;
        for (int t = 0; t < nt; t += 2) {
            const bool last = (t == nt - 2);
            const char* a1 = cA + (size_t)(t + 1) * kstep;
            const char* a2 = last ? nA : cA + (size_t)(t + 2) * kstep; const char* b2 = last ? nB : cB + (size_t)(t + 2) * kstep;
            const char* a3 = a2 + kstep; const char* b3 = b2 + kstep;
            if (last && has_next) S.a_ready(nxt);
            if constexpr (SP2) {
            PG8_LDB(B0, 0, 0); PG8_LDB(B1, 0, 1); PG8_SCHED; PG8_LDA(At, 0, 0); PG8_STAGE(PG8_SA(1, 1), a1 + hstep, voffA);
            PG8_WAIT_V(8); PG8_WAIT_L(0); PG8_BAR; PG8_MMA(0, 0, At, B0); PG8_MMA(0, 1, At, B1); PG8_BAR; PG8_SCHED;
            PG8_LDA(At, 0, 1); PG8_STAGE(PG8_SB(0, 0), b2, voffB); PG8_STAGE(PG8_SB(0, 1), b2 + hstep, voffB); PG8_STAGE(PG8_SA(0, 0), a2, voffA);
            PG8_WAIT_V(8); PG8_WAIT_L(0); PG8_BAR; PG8_MMA(1, 0, At, B0); PG8_MMA(1, 1, At, B1); PG8_BAR; PG8_SCHED;
            PG8_LDB(B0, 1, 0); PG8_LDB(B1, 1, 1); PG8_SCHED; PG8_LDA(At, 1, 0); PG8_STAGE(PG8_SA(0, 1), a2 + hstep, voffA);
            PG8_WAIT_V(8); PG8_WAIT_L(0); PG8_BAR; PG8_MMA(0, 0, At, B0); PG8_MMA(0, 1, At, B1); PG8_BAR; PG8_SCHED;
            PG8_LDA(At, 1, 1); PG8_STAGE(PG8_SB(1, 0), b3, voffB); PG8_STAGE(PG8_SB(1, 1), b3 + hstep, voffB); PG8_STAGE(PG8_SA(1, 0), a3, voffA);
            PG8_WAIT_V(8); PG8_WAIT_L(0); PG8_BAR; PG8_MMA(1, 0, At, B0); PG8_MMA(1, 1, At, B1); PG8_BAR; PG8_SCHED;
            } else {
            PG8_LDB(B0, 0, 0); PG8_SCHED; PG8_LDA(At, 0, 0); PG8_STAGE(PG8_SA(1, 1), a1 + hstep, voffA);
            PG8_WAIT_L(8); PG8_BAR; PG8_WAIT_L(0); PG8_MMA(0, 0, At, B0); PG8_BAR; PG8_SCHED;
            PG8_LDB(B1, 0, 1); PG8_STAGE(PG8_SB(0, 0), b2, voffB);
            PG8_BAR; PG8_WAIT_L(0); PG8_MMA(0, 1, At, B1); PG8_BAR;
            PG8_LDA(At, 0, 1); PG8_STAGE(PG8_SA(0, 0), a2, voffA);
            PG8_BAR; PG8_WAIT_L(0); PG8_MMA(1, 0, At, B0); PG8_BAR; PG8_SCHED;
            PG8_STAGE(PG8_SB(0, 1), b2 + hstep, voffB);
            PG8_WAIT_V(6); PG8_BAR; PG8_MMA(1, 1, At, B1); PG8_BAR;
            PG8_LDB(B0, 1, 0); PG8_SCHED; PG8_LDA(At, 1, 0); PG8_STAGE(PG8_SA(0, 1), a2 + hstep, voffA);
            PG8_WAIT_L(8); PG8_BAR; PG8_WAIT_L(0); PG8_MMA(0, 0, At, B0); PG8_BAR; PG8_SCHED;
            PG8_LDB(B1, 1, 1); PG8_STAGE(PG8_SB(1, 0), b3, voffB);
            PG8_BAR; PG8_WAIT_L(0); PG8_MMA(0, 1, At, B1); PG8_BAR;
            PG8_LDA(At, 1, 1); PG8_STAGE(PG8_SA(1, 0), a3, voffA);
            PG8_BAR; PG8_WAIT_L(0); PG8_MMA(1, 0, At, B0); PG8_BAR; PG8_SCHED;
            PG8_STAGE(PG8_SB(1, 1), b3 + hstep, voffB);
            PG8_WAIT_V(6); PG8_BAR; PG8_MMA(1, 1, At, B1); PG8_BAR;
            }
        }
        if constexpr (ALIGN_EPI) { if (wr == 0) PG8_BAR; }
        if constexpr (CHAIN) { if (cur.sub < 3) E.mid(acc, cur, wr, wc, fr, fq); else E(acc, cur, wr, wc, fr, fq); S.done(cur); }
        else if constexpr (!Epi::AFTER_DRAIN) { E(acc, cur, wr, wc, fr, fq); S.done(cur); }
        if (!has_next) break;
        if (!CHAIN || cur.sub == 3)
#pragma unroll
        for (int a = 0; a < 2; ++a)
#pragma unroll
            for (int b = 0; b < 2; ++b)
#pragma unroll
                for (int m = 0; m < 4; ++m)
#pragma unroll
                    for (int n = 0; n < 2; ++n) acc[a][b][m][n] = (f32x4){0.f, 0.f, 0.f, 0.f};
        cur = nxt; cA = nA; cB = nB; ++ui;
        if constexpr (ALIGN_EPI) { if (wr == 1) PG8_BAR; }
    }
    PG8_WAIT_V(0);
    if constexpr (!ALIGN_EPI) { if (wr == 0) PG8_BAR; }
    PG8_BAR;
    if constexpr (Epi::AFTER_DRAIN) { E.fused(acc, cur, wr, wc, fr, fq, lds, wid, lane); S.done(cur); }
#undef PG8_ABASE
#undef PG8_BBASE
#undef PG8_SA
#undef PG8_SB
#undef PG8_STAGE
#undef PG8_LDA
#undef PG8_LDB
#undef PG8_MMA
#undef PG8_WAIT_V
#undef PG8_WAIT_L
#undef PG8_BAR
#undef PG8_SCHED
}
}

constexpr int NB = 32, SEQ = 2048, NMETA = 16, TT = SEQ + NMETA, D = 1024, NL = 4, DFF = 4096;
constexpr int NG = 4, GB = NB / NG, MR = GB * SEQ  , MT = MR + NMETA  ;
constexpr int NCOLS = 9696, NZ = 9728, ZB = 9216, ZFW = 512;
constexpr float EPS = 1e-6f;
constexpr int ZC_GQ = 0, ZC_GK = 512, ZC_GV = 1024, ZC_GR = 2048, ZC_MQ = 3072, ZC_MK = 3584, ZC_MV = 4096, ZC_MO = 5120, ZC_GATE = 6144;
constexpr int ZF_CQ = 0, ZF_CKV = 256, ZF_IK = 384, ZF_A = 448, ZF_IW = 464, ZF_MI = 472, ZF_MF = 476;
constexpr int NQQ = 2560;

constexpr size_t MiB = 1u << 20;
constexpr size_t WS_CTL = 0, CTL_ZERO_BYTES = 1 * MiB;
constexpr size_t WS_BIN = 1 * MiB;
constexpr size_t WS_WIN = 2 * MiB;
constexpr size_t WS_WQQ = 78 * MiB;
constexpr size_t WS_WBG = 83 * MiB;
constexpr size_t WS_WBM = 91 * MiB;
constexpr size_t WS_WBD = 99 * MiB;
constexpr size_t WS_WOUT = 115 * MiB;
constexpr size_t WS_WUP = 123 * MiB;
constexpr size_t WS_WDN = 155 * MiB;
constexpr size_t WS_HM = 187 * MiB;
constexpr size_t WS_XN = 188 * MiB;
constexpr size_t WS_ZF = 221 * MiB;
constexpr size_t WS_CQN = 254 * MiB;
constexpr size_t WS_KV = 263 * MiB;
constexpr size_t WS_KI = 268 * MiB;
constexpr size_t WS_WI = 271 * MiB;
constexpr size_t WS_LIF = 272 * MiB;
constexpr size_t WS_G = 273 * MiB;
constexpr size_t WS_QKC = 306 * MiB;
constexpr size_t WS_QQ = 339 * MiB;
constexpr size_t WS_OG = 420 * MiB;
constexpr size_t WS_OM = 453 * MiB;
constexpr size_t WS_OD = 486 * MiB;
constexpr size_t WS_Z = 551 * MiB;
constexpr size_t WS_MIX = 840 * MiB;
constexpr size_t WS_Y = 873 * MiB;
constexpr size_t WS_SC = 840 * MiB;
constexpr size_t WS_DD = 1020 * MiB;
constexpr size_t WS_END = 1024 * MiB;
constexpr int SC_PITCH = 2080;
static_assert(WS_Z + (size_t)MT * ZB * 2 <= WS_MIX && WS_Y + (size_t)MT * D * 4 <= WS_END && WS_SC + (size_t)256 * 64 * SC_PITCH * 4 <= WS_END, "ws map");

constexpr int CW_BAR = 4096;

constexpr int RING_BYTES = 131072;
constexpr int MISC_OFF = RING_BYTES + 320;
constexpr int LDS_BYTES = 147456;
constexpr int NWAVES = 8;

#define LAS __attribute__((address_space(3)))
typedef unsigned short bf16;
typedef float f32x4 __attribute__((ext_vector_type(4)));
typedef float f32x2 __attribute__((ext_vector_type(2)));
typedef unsigned u32x4 __attribute__((ext_vector_type(4)));
typedef unsigned u32x2 __attribute__((ext_vector_type(2)));
typedef short bf16x8 __attribute__((ext_vector_type(8)));
typedef short s16x4 __attribute__((ext_vector_type(4)));
#define LDS_WAIT() asm volatile("s_waitcnt lgkmcnt(0)" ::: "memory")
#define VM_WAIT() asm volatile("s_waitcnt vmcnt(0)" ::: "memory")

typedef __bf16 hwbf16x2 __attribute__((ext_vector_type(2)));
__device__ __forceinline__ unsigned pk2(float lo, float hi) { const f32x2 v = {lo, hi}; const hwbf16x2 b = __builtin_convertvector(v, hwbf16x2); return __builtin_bit_cast(unsigned, b); }
__device__ __forceinline__ unsigned f2bf(float f) { return pk2(f, 0.f) & 0xffffu; }
__device__ __forceinline__ float bf2f(unsigned b) { return __builtin_bit_cast(float, b << 16); }
__device__ __forceinline__ float bflo(unsigned w) { return __builtin_bit_cast(float, w << 16); }
__device__ __forceinline__ float bfhi(unsigned w) { return __builtin_bit_cast(float, w & 0xffff0000u); }
__device__ __forceinline__ float wave_sum(float v) {
#pragma unroll
    for (int o = 1; o < 64; o <<= 1) v += __shfl_xor(v, o);
    return v;
}
__device__ __forceinline__ float wave_max(float v) {
#pragma unroll
    for (int o = 1; o < 64; o <<= 1) v = fmaxf(v, __shfl_xor(v, o));
    return v;
}
__device__ __forceinline__ float sigmoid_f(float x) { return __builtin_amdgcn_rcpf(1.f + __builtin_amdgcn_exp2f(-1.4426950408889634f * x)); }
__device__ __forceinline__ float silu_f(float x) { return x * sigmoid_f(x); }
__device__ __forceinline__ float logsigmoid_f(float x) { return fminf(x, 0.f) - log1pf(__expf(-fabsf(x))); }

#define XB_TMO      128
#define XB_XCNT(j)  (256  + 64 * (j))
#define XB_XSUB(j)  (1280 + 64 * (j))
#define XB_XGEN(j)  (2304 + 64 * (j))
#define XB_TOP      3328
#define XB_TOPGEN   3392
#define XCD_BAR_WORDS 3456
#define XB_SPIN_CAP (1u << 22)

__device__ __forceinline__ unsigned xb_ld(unsigned* p)              { return __hip_atomic_load(p, __ATOMIC_RELAXED, __HIP_MEMORY_SCOPE_AGENT); }
__device__ __forceinline__ unsigned xb_add(unsigned* p, unsigned v) { return __hip_atomic_fetch_add(p, v, __ATOMIC_RELAXED, __HIP_MEMORY_SCOPE_AGENT); }
__device__ __forceinline__ unsigned xb_xcc_id() { return (unsigned)__builtin_amdgcn_s_getreg((3 << 11) | 20) & 0xFu; }
#define XB_SPIN(cond, bar) do { unsigned _sp = 0; while (cond) { __builtin_amdgcn_s_sleep(1); \
    if ((++_sp & 255u) == 0u) { if (xb_ld(&(bar)[XB_TMO])) break; if (_sp > XB_SPIN_CAP) { atomicAdd(&(bar)[XB_TMO], 1u); break; } } } } while (0)

struct XcdBarrier {
    unsigned* bar; unsigned x;
    volatile LAS unsigned* st;
};

__device__ __forceinline__ XcdBarrier xcd_barrier_post(unsigned* bar, volatile LAS unsigned* st) {
    XcdBarrier b; b.bar = bar; b.x = xb_xcc_id(); b.st = st;
    if (threadIdx.x == 0) (void)xb_add(&bar[XB_XCNT(b.x)], 1u);
    return b;
}
__device__ __forceinline__ void xcd_barrier_complete(unsigned* bar, unsigned x, unsigned& nloc, unsigned& nx) {
    const unsigned G = gridDim.x * gridDim.y * gridDim.z;
    unsigned sum, cnt, mine, sp = 0u;
    for (;;) {
        sum = 0u; cnt = 0u; mine = 0u;
#pragma unroll
        for (unsigned j = 0; j < 16; ++j) { const unsigned c = xb_ld(&bar[XB_XCNT(j)]); sum += c; cnt += (c > 0u) ? 1u : 0u; mine = (j == x) ? c : mine; }
        if (sum == G) break;
        __builtin_amdgcn_s_sleep(1);
        if ((++sp & 255u) == 0u) { if (xb_ld(&bar[XB_TMO])) break; if (sp > XB_SPIN_CAP) { atomicAdd(&bar[XB_TMO], 1u); break; } }
    }
    nloc = mine > 0u ? mine : 1u; nx = cnt > 0u ? cnt : 1u;
}

__device__ __forceinline__ void xcd_barrier(const XcdBarrier& b) {
    asm volatile("s_waitcnt vmcnt(0)" ::: "memory");
    __syncthreads();
    if (threadIdx.x == 0) {
        unsigned* bar = b.bar;
        __builtin_amdgcn_s_waitcnt(0);
        unsigned nloc = b.st[0], nx = b.st[1];
        if (nloc == 0u) { xcd_barrier_complete(bar, b.x, nloc, nx); b.st[0] = nloc; b.st[1] = nx; }
        const unsigned old = xb_add(&bar[XB_XSUB(b.x)], 1u);
        const unsigned gen = old / nloc;
        if (old + 1u == (gen + 1u) * nloc) {
            __builtin_amdgcn_fence(__ATOMIC_RELEASE, "agent");
            asm volatile("s_waitcnt vmcnt(0)" ::: "memory");
            const unsigned og = xb_add(&bar[XB_TOP], 1u);
            const unsigned tg = og / nx;
            if (og + 1u == (tg + 1u) * nx) xb_add(&bar[XB_TOPGEN], 1u);
            else XB_SPIN(xb_ld(&bar[XB_TOPGEN]) == tg, bar);
            __builtin_amdgcn_fence(__ATOMIC_ACQUIRE, "agent");
            xb_add(&bar[XB_XGEN(b.x)], 1u);
            asm volatile("s_waitcnt vmcnt(0)" ::: "memory");
        } else {
            XB_SPIN(xb_ld(&bar[XB_XGEN(b.x)]) == gen, bar);
            __builtin_amdgcn_fence(__ATOMIC_ACQUIRE, "agent");
            asm volatile("s_waitcnt vmcnt(0)" ::: "memory");
        }
    }
    __syncthreads();
}


struct Args { const float* in[28]; float* out; unsigned char* ws; int g_lo, g_hi, l_lo, l_hi, ph_lo, ph_hi, prep, use_bar; };
typedef const __attribute__((address_space(4))) Args* ArgsP;
enum { I_X = 0, I_META, I_T5, I_GPREMIX, I_WIN, I_BIN, I_WA2, I_BA, I_GGLA, I_WBRG, I_GDQ, I_WUQ, I_WIQ, I_GDKV, I_WUV, I_LNG, I_LNB, I_WBRD,
       I_CONV, I_FB, I_GML, I_WBRM, I_WOUT, I_GPOSTMIX, I_GPREMLP, I_WUP, I_WDN, I_GPOSTMLP };

__device__ __forceinline__ int win_src(int n) {
    if (n < 3072) return n;
    if (n < 6144) return n - 3072 + 3544;
    if (n < 9216) return n - 6144 + 6624;
    if (n < 9472) return n - 9216 + 3088;
    if (n < 9600) return n - 9472 + 3344;
    if (n < 9664) return n - 9600 + 3472;
    if (n < 9680) return n - 9664 + 3072;
    if (n < 9688) return n - 9680 + 3536;
    if (n < 9692) return n - 9688 + 6616;
    if (n < 9696) return n - 9692 + 6620;
    return -1;
}
struct CmIdent { __device__ __forceinline__ int operator()(int n) const { return n; } };
struct CmWin { __device__ __forceinline__ int operator()(int n) const { return win_src(n); } };

template <class CM>
__device__ __forceinline__ void tr_item(const float* __restrict__ W, int ldw, bf16* __restrict__ WT, int Kd, LAS float* scr, int k0, int ns0, int nd0, int lane, CM cm) {
    const int sc = cm(ns0 + (lane & 31));
#pragma unroll 8
    for (int i = 0; i < 32; ++i) { const int kk = 2 * i + (lane >> 5); scr[kk * 33 + (lane & 31)] = sc >= 0 ? W[(size_t)(k0 + kk) * ldw + sc] : 0.f; }
    LDS_WAIT();
    const int c = lane & 7;
#pragma unroll
    for (int j = 0; j < 4; ++j) { const int n = (lane >> 3) + 8 * j; const LAS float* s = scr + (8 * c) * 33 + n;
        u32x4 o; o.x = pk2(s[0 * 33], s[1 * 33]); o.y = pk2(s[2 * 33], s[3 * 33]); o.z = pk2(s[4 * 33], s[5 * 33]); o.w = pk2(s[6 * 33], s[7 * 33]);
        *(u32x4*)(WT + (size_t)(nd0 + n) * Kd + k0 + 8 * c) = o; }
    LDS_WAIT();
}

__device__ __forceinline__ void prep_weights(ArgsP a, LAS unsigned char* lds, int gw, int ngw, int wave, int lane) {
    LAS float* scr = (LAS float*)(lds + wave * 16384);
    unsigned char* ws = a->ws;
    constexpr int I_WIN_N = 16 * 304, I_UQ = 4 * 64, I_IQ = 4 * 16, I_SQ = 16 * 32, I_UP = 16 * 128, I_DN = 64 * 32, I_WBD = 512, I_B = NZ / 64;
    constexpr int PER_L = I_WIN_N + I_UQ + I_IQ + 3 * I_SQ + I_UP + I_DN + I_WBD + I_B;
    for (int it = gw; it < NL * PER_L; it += ngw) {
        const int l = it / PER_L; int r = it % PER_L;
        if (r < I_WIN_N) { const int kb = r / 304, nb = r % 304;
            tr_item(a->in[I_WIN] + (size_t)l * D * NCOLS, NCOLS, (bf16*)(ws + WS_WIN) + (size_t)l * NZ * D, D, scr, kb * 64, nb * 32, nb * 32, lane, CmWin()); continue; }
        r -= I_WIN_N;
        if (r < I_UQ) { const int kb = r / 64, nb = r % 64;
            tr_item(a->in[I_WUQ] + (size_t)l * 256 * 2048, 2048, (bf16*)(ws + WS_WQQ) + (size_t)l * NQQ * 256, 256, scr, kb * 64, nb * 32, nb * 32, lane, CmIdent()); continue; }
        r -= I_UQ;
        if (r < I_IQ) { const int kb = r / 16, nb = r % 16;
            tr_item(a->in[I_WIQ] + (size_t)l * 256 * 512, 512, (bf16*)(ws + WS_WQQ) + (size_t)l * NQQ * 256, 256, scr, kb * 64, nb * 32, 2048 + nb * 32, lane, CmIdent()); continue; }
        r -= I_IQ;
        if (r < I_SQ) { const int kb = r / 32, nb = r % 32;
            tr_item(a->in[I_WBRG] + (size_t)l * D * D, D, (bf16*)(ws + WS_WBG) + (size_t)l * D * D, D, scr, kb * 64, nb * 32, nb * 32, lane, CmIdent()); continue; }
        r -= I_SQ;
        if (r < I_SQ) { const int kb = r / 32, nb = r % 32;
            tr_item(a->in[I_WBRM] + (size_t)l * D * D, D, (bf16*)(ws + WS_WBM) + (size_t)l * D * D, D, scr, kb * 64, nb * 32, nb * 32, lane, CmIdent()); continue; }
        r -= I_SQ;
        if (r < I_SQ) { const int kb = r / 32, nb = r % 32;
            tr_item(a->in[I_WOUT] + (size_t)l * D * D, D, (bf16*)(ws + WS_WOUT) + (size_t)l * D * D, D, scr, kb * 64, nb * 32, nb * 32, lane, CmIdent()); continue; }
        r -= I_SQ;
        if (r < I_UP) { const int kb = r / 128, nb = r % 128;
            tr_item(a->in[I_WUP] + (size_t)l * D * DFF, DFF, (bf16*)(ws + WS_WUP) + (size_t)l * DFF * D, D, scr, kb * 64, nb * 32, nb * 32, lane, CmIdent()); continue; }
        r -= I_UP;
        if (r < I_DN) { const int kb = r / 32, nb = r % 32;
            tr_item(a->in[I_WDN] + (size_t)l * DFF * D, D, (bf16*)(ws + WS_WDN) + (size_t)l * D * DFF, DFF, scr, kb * 64, nb * 32, nb * 32, lane, CmIdent()); continue; }
        r -= I_DN;
        if (r < I_WBD) {
            const int h = r >> 5, ch = (r >> 4) & 1, nb = r & 15, c = ch * 64 + lane;
            const float* uv = a->in[I_WUV] + ((size_t)(l * 16 + h) * 128 + c) * 64;
            const float* wb = a->in[I_WBRD] + ((size_t)l * D + h * 64) * D + nb * 64;
            bf16* o = (bf16*)(ws + WS_WBD) + (size_t)l * D * 2048 + (size_t)(h >> 3) * D * D + (size_t)(nb * 64) * D + (h & 7) * 128 + c;
            f32x4 w[16];
#pragma unroll
            for (int i = 0; i < 16; ++i) w[i] = *(const f32x4*)(uv + 4 * i);
            for (int nn = 0; nn < 64; ++nn) {
                float acc = 0.f;
#pragma unroll
                for (int i = 0; i < 16; ++i) { acc += w[i].x * wb[(size_t)(4 * i + 0) * D + nn] + w[i].y * wb[(size_t)(4 * i + 1) * D + nn] + w[i].z * wb[(size_t)(4 * i + 2) * D + nn] + w[i].w * wb[(size_t)(4 * i + 3) * D + nn]; }
                o[(size_t)nn * D] = (bf16)f2bf(acc);
            }
            continue; }
        r -= I_WBD;
        { const int n = r * 64 + lane; const int sc = win_src(n);
          ((float*)(ws + WS_BIN))[l * NZ + n] = sc >= 0 ? a->in[I_BIN][l * NCOLS + sc] : 0.f; }
    }
}

__device__ __forceinline__ float* hrow(ArgsP a, int g, int r) {
    return r < MR ? a->out + ((size_t)g * MR + r) * D : (float*)(a->ws + WS_HM) + (size_t)(r - MR) * D;
}
__device__ __forceinline__ void rms_row_bf16(const f32x4 (&v)[4], const float* __restrict__ gain, bf16* __restrict__ orow, int lane) {
    float s = 0.f;
#pragma unroll
    for (int j = 0; j < 4; ++j) s += (v[j].x * v[j].x + v[j].y * v[j].y) + (v[j].z * v[j].z + v[j].w * v[j].w);
    const float r = rsqrtf(wave_sum(s) * (1.f / D) + EPS);
#pragma unroll
    for (int j = 0; j < 4; ++j) { const f32x4 gg = *(const f32x4*)(gain + 4 * lane + 256 * j); const f32x4 o = v[j] * r * gg;
        u32x2 w; w.x = pk2(o.x, o.y); w.y = pk2(o.z, o.w); *(u32x2*)(orow + 4 * lane + 256 * j) = w; }
}
__device__ __forceinline__ void p0_init(ArgsP a, int g, int gw, int ngw, int lane) {
    bf16* XN = (bf16*)(a->ws + WS_XN);
    for (int r = gw; r < MT; r += ngw) {
        const float* src = r < MR ? a->in[I_X] + ((size_t)g * MR + r) * D : a->in[I_META] + (size_t)(r - MR) * D;
        float* hd = hrow(a, g, r);
        f32x4 v[4];
#pragma unroll
        for (int j = 0; j < 4; ++j) { v[j] = *(const f32x4*)(src + 4 * lane + 256 * j); *(f32x4*)(hd + 4 * lane + 256 * j) = v[j]; }
        rms_row_bf16(v, a->in[I_GPREMIX], XN + (size_t)r * D, lane);
    }
}
template <bool DRY = false>
__device__ __forceinline__ void p_norm_res(ArgsP a, int g, const float* gpost, const float* gpre, int gw, int ngw, int lane) {
    bf16* XN = (bf16*)(a->ws + (DRY ? WS_Z + 100 * MiB : WS_XN)); const bf16* Y = (const bf16*)(a->ws + WS_Y);
    for (int r = gw; r < MT; r += ngw) {
        float* hd = hrow(a, g, r); float* hw = DRY ? (float*)(a->ws + WS_Z) + (size_t)r * D : hd;
        f32x4 y[4], v[4]; float s = 0.f;
#pragma unroll
        for (int j = 0; j < 4; ++j) { { const u32x2 yw = *(const u32x2*)(Y + (size_t)r * D + 4 * lane + 256 * j); y[j] = (f32x4){bflo(yw.x), bfhi(yw.x), bflo(yw.y), bfhi(yw.y)}; } v[j] = *(const f32x4*)(hd + 4 * lane + 256 * j);
            s += (y[j].x * y[j].x + y[j].y * y[j].y) + (y[j].z * y[j].z + y[j].w * y[j].w); }
        const float rr = rsqrtf(wave_sum(s) * (1.f / D) + EPS);
#pragma unroll
        for (int j = 0; j < 4; ++j) { const f32x4 gg = *(const f32x4*)(gpost + 4 * lane + 256 * j); v[j] = v[j] + y[j] * rr * gg; *(f32x4*)(hw + 4 * lane + 256 * j) = v[j]; }
        if (gpre) rms_row_bf16(v, gpre, XN + (size_t)r * D, lane);
    }
}

template <class F> struct EpiT {
    static constexpr bool PERM = true, AFTER_DRAIN = false;
    F f;
    __device__ __forceinline__ void operator()(const f32x4 (&acc)[2][2][4][2], const pg8::Unit& u, int wr, int wc, int fr, int fq) const {
        const int row0 = u.pm * 256 + wr * 64 + fr, col0 = u.pn * 256 + wc * 32 + 8 * fq;
#pragma unroll
        for (int ai = 0; ai < 2; ++ai)
#pragma unroll
            for (int m = 0; m < 4; ++m)
#pragma unroll
                for (int bj = 0; bj < 2; ++bj) { f.apply(row0 + ai * 128 + m * 16, col0 + bj * 128, acc[ai][bj][m][0], acc[ai][bj][m][1]); asm volatile("" ::: "memory"); }
    }
};
__device__ __forceinline__ void st_bf16x8(bf16* p, f32x4 v0, f32x4 v1) { u32x4 w; w.x = pk2(v0.x, v0.y); w.y = pk2(v0.z, v0.w); w.z = pk2(v1.x, v1.y); w.w = pk2(v1.z, v1.w); *(u32x4*)p = w; }
__device__ __forceinline__ void ld_bf16x8(const bf16* p, f32x4& v0, f32x4& v1) { const u32x4 w = *(const u32x4*)p;
    v0 = (f32x4){bflo(w.x), bfhi(w.x), bflo(w.y), bfhi(w.y)}; v1 = (f32x4){bflo(w.z), bfhi(w.z), bflo(w.w), bfhi(w.w)}; }

struct FIn {
    bf16* Z; float* ZF; const float* bias;
    __device__ __forceinline__ void apply(int row, int col, f32x4 v0, f32x4 v1) const {
        v0 += *(const f32x4*)(bias + col); v1 += *(const f32x4*)(bias + col + 4);
        const int t = col >> 8;
        if (t >= 36) { float* p = ZF + (size_t)row * ZFW + (col - ZB); *(f32x4*)p = v0; *(f32x4*)(p + 4) = v1; return; }
        if (t < 2) { v0 *= 0.08838834764831845f; v1 *= 0.08838834764831845f; }
        else if (t >= 8 && t < 12) {
#pragma unroll
            for (int i = 0; i < 4; ++i) { v0[i] = silu_f(v0[i]); v1[i] = silu_f(v1[i]); } }
        else if (t >= 20) {
#pragma unroll
            for (int i = 0; i < 4; ++i) { v0[i] = sigmoid_f(v0[i]); v1[i] = sigmoid_f(v1[i]); } }
        st_bf16x8(Z + (size_t)row * ZB + col, v0, v1);
    }
};
struct FQQ {
    bf16* QQ;
    __device__ __forceinline__ void apply(int row, int col, f32x4 v0, f32x4 v1) const {
        const float s = col < 2048 ? 0.08838834764831845f : 0.125f;
        st_bf16x8(QQ + (size_t)row * NQQ + col, v0 * s, v1 * s);
    }
};
template <int IDX> struct FBr {
    const bf16* Z; float* Y; bf16* MIX;
    __device__ __forceinline__ void apply(int row, int col, f32x4 v0, f32x4 v1) const {
        f32x4 g0, g1; ld_bf16x8(Z + (size_t)row * ZB + ZC_GATE + IDX * 1024 + col, g0, g1);
        float* y = Y + (size_t)row * D + col;
        f32x4 a0 = v0 * g0, a1 = v1 * g1;
        if (IDX > 0) { a0 += *(const f32x4*)y; a1 += *(const f32x4*)(y + 4); }
        if (IDX < 2) { *(f32x4*)y = a0; *(f32x4*)(y + 4) = a1; }
        else st_bf16x8(MIX + (size_t)row * D + col, a0, a1);
    }
};
struct FY {
    bf16* Y;
    __device__ __forceinline__ void apply(int row, int col, f32x4 v0, f32x4 v1) const { st_bf16x8(Y + (size_t)row * D + col, v0, v1); }
};
struct FUp {
    bf16* U;
    __device__ __forceinline__ void apply(int row, int col, f32x4 v0, f32x4 v1) const {
#pragma unroll
        for (int i = 0; i < 4; ++i) { const float p = fmaxf(v0[i], 0.f), q = fmaxf(v1[i], 0.f); v0[i] = p * p; v1[i] = q * q; }
        st_bf16x8(U + (size_t)row * DFF + col, v0, v1);
    }
};

template <class F>
__device__ __forceinline__ void mini_gemm(const bf16* __restrict__ A, const bf16* __restrict__ Bt, int N, int K, const F& f, int gw, int ngw, int lane) {
    const int fr = lane & 15, fq = lane >> 4;
    for (int wt = gw; wt < N / 32; wt += ngw) {
        const int n0 = wt * 32;
        f32x4 acc0 = {0.f, 0.f, 0.f, 0.f}, acc1 = {0.f, 0.f, 0.f, 0.f};
        const bf16* ap = A + (size_t)(MR + fr) * K + fq * 8;
        const bf16* b0 = Bt + (size_t)(n0 + pg8::perm32(fr)) * K + fq * 8;
        const bf16* b1 = Bt + (size_t)(n0 + pg8::perm32(16 + fr)) * K + fq * 8;
        for (int k = 0; k < K; k += 256) {
            bf16x8 av[8], w0[8], w1[8];
#pragma unroll
            for (int u = 0; u < 8; ++u) { av[u] = *(const bf16x8*)(ap + k + 32 * u); w0[u] = *(const bf16x8*)(b0 + k + 32 * u); w1[u] = *(const bf16x8*)(b1 + k + 32 * u); }
#pragma unroll
            for (int u = 0; u < 8; ++u) {
                acc0 = __builtin_amdgcn_mfma_f32_16x16x32_bf16(w0[u], av[u], acc0, 0, 0, 0);
                acc1 = __builtin_amdgcn_mfma_f32_16x16x32_bf16(w1[u], av[u], acc1, 0, 0, 0);
            }
        }
        f.apply(MR + fr, n0 + 8 * fq, acc0, acc1);
    }
}
template <class F, bool ALIGN = true>
__device__ __forceinline__ void run_gemm(LAS unsigned char* lds, const bf16* A, const bf16* Bt, int N, int K, const F& f, int gw, int ngw, int lane) {
    asm volatile("" : "+s"(K)); asm volatile("" : "+s"(N));
    pg8::Gemm g{A, Bt, MR, N, K}; pg8::StaticOrder S; S.init(MR, N, (int)gridDim.x, (int)blockIdx.x);
    EpiT<F> E{f};
    pg8::gemm_phase<EpiT<F>, pg8::StaticOrder, ALIGN, true>((PG8_LAS unsigned char*)lds, g, S, E);
    mini_gemm(A, Bt, N, K, f, gw, ngw, lane);
}

struct ChainOrder {
    pg8::StaticOrder S;
    __device__ __forceinline__ bool next(int i, pg8::Unit& u) const { if (!S.next(i >> 2, u)) return false; u.sub = i & 3; return true; }
    __device__ __forceinline__ void a_ready(const pg8::Unit&) const {}
    __device__ __forceinline__ void done(const pg8::Unit&) const {}
};
struct EpiMix {
    static constexpr bool PERM = true, AFTER_DRAIN = false;
    const bf16* Z; bf16* MIX;
    __device__ __forceinline__ void mid(f32x4 (&acc)[2][2][4][2], const pg8::Unit& u, int wr, int wc, int fr, int fq) const {
        if (u.sub == 1) return;
        const int gi = u.sub == 0 ? 0 : 1;
        const int row0 = u.pm * 256 + wr * 64 + fr, col0 = u.pn * 256 + wc * 32 + 8 * fq;
#pragma unroll
        for (int ai = 0; ai < 2; ++ai)
#pragma unroll
            for (int m = 0; m < 4; ++m)
#pragma unroll
                for (int bj = 0; bj < 2; ++bj) {
                    const bf16* gp = Z + (size_t)(row0 + ai * 128 + m * 16) * ZB + ZC_GATE + gi * 1024 + col0 + bj * 128;
                    f32x4 a0, a1, b0, b1; ld_bf16x8(gp, a0, a1); ld_bf16x8(gp + 1024, b0, b1);
                    f32x4 r0, r1;
                    r0.x = a0.x * __builtin_amdgcn_rcpf(b0.x); r0.y = a0.y * __builtin_amdgcn_rcpf(b0.y); r0.z = a0.z * __builtin_amdgcn_rcpf(b0.z); r0.w = a0.w * __builtin_amdgcn_rcpf(b0.w);
                    r1.x = a1.x * __builtin_amdgcn_rcpf(b1.x); r1.y = a1.y * __builtin_amdgcn_rcpf(b1.y); r1.z = a1.z * __builtin_amdgcn_rcpf(b1.z); r1.w = a1.w * __builtin_amdgcn_rcpf(b1.w);
                    acc[ai][bj][m][0] *= r0; acc[ai][bj][m][1] *= r1;
                    asm volatile("" ::: "memory");
                }
    }
    __device__ __forceinline__ void operator()(const f32x4 (&acc)[2][2][4][2], const pg8::Unit& u, int wr, int wc, int fr, int fq) const {
        const int row0 = u.pm * 256 + wr * 64 + fr, col0 = u.pn * 256 + wc * 32 + 8 * fq;
#pragma unroll
        for (int ai = 0; ai < 2; ++ai)
#pragma unroll
            for (int m = 0; m < 4; ++m)
#pragma unroll
                for (int bj = 0; bj < 2; ++bj) {
                    const int row = row0 + ai * 128 + m * 16, col = col0 + bj * 128;
                    f32x4 g0, g1; ld_bf16x8(Z + (size_t)row * ZB + ZC_GATE + 2 * 1024 + col, g0, g1);
                    st_bf16x8(MIX + (size_t)row * D + col, acc[ai][bj][m][0] * g0, acc[ai][bj][m][1] * g1);
                    asm volatile("" ::: "memory");
                }
    }
};

__device__ __forceinline__ int prow(int r, int j) {
    if (r < MR) { const int s = r & (SEQ - 1); return (s - j >= 0) ? r - j : MR + (NMETA + s - j); }
    const int t = r - MR; return (t - j >= 0) ? r - j : -1;
}
__device__ __forceinline__ void p2_prep(ArgsP a, int l, int gw, int ngw, int lane) {
    unsigned char* ws = a->ws;
    const bf16* Z = (const bf16*)(ws + WS_Z);
    for (int r = gw; r < MT; r += ngw) {
        const float* zf = (const float*)(ws + WS_ZF) + (size_t)r * ZFW;
        {
            f32x4 v = *(const f32x4*)(zf + ZF_CQ + 4 * lane);
            const float rr = rsqrtf(wave_sum((v.x * v.x + v.y * v.y) + (v.z * v.z + v.w * v.w)) * (1.f / 256.f) + EPS);
            const f32x4 gg = *(const f32x4*)(a->in[I_GDQ] + l * 256 + 4 * lane); v = v * rr * gg;
            u32x2 w; w.x = pk2(v.x, v.y); w.y = pk2(v.z, v.w); *(u32x2*)((bf16*)(ws + WS_CQN) + (size_t)r * 256 + 4 * lane) = w;
        }
        {
            f32x2 v = *(const f32x2*)(zf + ZF_CKV + 2 * lane);
            const float rr = rsqrtf(wave_sum(v.x * v.x + v.y * v.y) * (1.f / 128.f) + EPS);
            const f32x2 gg = *(const f32x2*)(a->in[I_GDKV] + l * 128 + 2 * lane);
            *(unsigned*)((bf16*)(ws + WS_KV) + (size_t)r * 128 + 2 * lane) = pk2(v.x * rr * gg.x, v.y * rr * gg.y);
        }
        {
            const float v = zf[ZF_IK + lane]; const float mu = wave_sum(v) * (1.f / 64.f); const float d = v - mu;
            const float var = wave_sum(d * d) * (1.f / 64.f);
            const float y = d * rsqrtf(var + EPS) * a->in[I_LNG][l * 64 + lane] + a->in[I_LNB][l * 64 + lane];
            ((bf16*)(ws + WS_KI))[(size_t)r * 64 + lane] = (bf16)f2bf(y);
        }
        if (lane < 8) ((float*)(ws + WS_WI))[(size_t)r * 8 + lane] = zf[ZF_IW + lane] * 0.35355339059327373f;
    }
    float* DDp = (float*)(ws + WS_DD);
    for (int it = gw; it < 257 * 8; it += ngw) {
        const int cid = it >> 3, mx = (it >> 2) & 1, h = it & 3;
        const int nrows = cid == 256 ? NMETA : 64, rbase = cid == 256 ? MR : cid * 64;
        const int k0 = 2 * lane;
        if (!mx) {
            float w0[16], w1[16];
#pragma unroll
            for (int j = 0; j < 16; ++j) { const f32x2 w = *(const f32x2*)(a->in[I_WA2] + (size_t)(l * 16 + j) * 512 + h * 128 + k0); w0[j] = w.x; w1[j] = w.y; }
            const f32x2 bb = *(const f32x2*)(a->in[I_BA] + l * 512 + h * 128 + k0);
            bf16* __restrict__ QG = (bf16*)(ws + WS_G);
            const bf16* __restrict__ Zr = Z; const float* __restrict__ ZFr = (const float*)(ws + WS_ZF);
            float G0 = 0.f, G1 = 0.f;
            f32x4 pa[4][4]; unsigned pq[4], pk[4];
#define P2G_LOAD(t0) do { _Pragma("unroll") for (int i = 0; i < 4; ++i) { const int r_ = rbase + (t0) + i; const float* zf_ = ZFr + (size_t)r_ * ZFW + ZF_A; \
                pa[i][0] = *(const f32x4*)zf_; pa[i][1] = *(const f32x4*)(zf_ + 4); pa[i][2] = *(const f32x4*)(zf_ + 8); pa[i][3] = *(const f32x4*)(zf_ + 12); \
                pq[i] = *(const unsigned*)(Zr + (size_t)r_ * ZB + ZC_GQ + h * 128 + k0); pk[i] = *(const unsigned*)(Zr + (size_t)r_ * ZB + ZC_GK + h * 128 + k0); } } while (0)
            P2G_LOAD(0);
            for (int t0 = 0; t0 < nrows; t0 += 4) {
                f32x4 ca[4][4]; unsigned cqw[4], ckw[4];
#pragma unroll
                for (int i = 0; i < 4; ++i) { ca[i][0] = pa[i][0]; ca[i][1] = pa[i][1]; ca[i][2] = pa[i][2]; ca[i][3] = pa[i][3]; cqw[i] = pq[i]; ckw[i] = pk[i]; }
                if (t0 + 4 < nrows) P2G_LOAD(t0 + 4);
#pragma unroll
                for (int i = 0; i < 4; ++i) {
                    const int r = rbase + t0 + i;
                    const float av[16] = {ca[i][0].x, ca[i][0].y, ca[i][0].z, ca[i][0].w, ca[i][1].x, ca[i][1].y, ca[i][1].z, ca[i][1].w, ca[i][2].x, ca[i][2].y, ca[i][2].z, ca[i][2].w, ca[i][3].x, ca[i][3].y, ca[i][3].z, ca[i][3].w};
                    float s0 = bb.x, s1 = bb.y;
#pragma unroll
                    for (int j = 0; j < 16; ++j) { s0 += av[j] * w0[j]; s1 += av[j] * w1[j]; }
                    G0 += logsigmoid_f(s0) * 0.0625f; G1 += logsigmoid_f(s1) * 0.0625f;
                    const float e0 = __expf(G0), e1 = __expf(G1), i0 = __expf(-G0), i1 = __expf(-G1);
                    *(unsigned*)(QG + (size_t)r * 1024 + h * 128 + k0) = pk2(bflo(cqw[i]) * e0, bfhi(cqw[i]) * e1);
                    *(unsigned*)(QG + (size_t)r * 1024 + 512 + h * 128 + k0) = pk2(bflo(ckw[i]) * i0, bfhi(ckw[i]) * i1);
                }
            }
#undef P2G_LOAD
            *(f32x2*)(DDp + ((size_t)cid * 4 + h) * 128 + k0) = (f32x2){__expf(G0), __expf(G1)};
        } else {
            float cq[4][2], ck[4][2];
#pragma unroll
            for (int tap = 0; tap < 4; ++tap) { const f32x2 wq = *(const f32x2*)(a->in[I_CONV] + (size_t)(l * 4 + tap) * 1024 + h * 128 + k0), wk = *(const f32x2*)(a->in[I_CONV] + (size_t)(l * 4 + tap) * 1024 + 512 + h * 128 + k0);
                cq[tap][0] = wq.x; cq[tap][1] = wq.y; ck[tap][0] = wk.x; ck[tap][1] = wk.y; }
            const float fb = a->in[I_FB][l * 4 + h];
            bf16* __restrict__ QM = (bf16*)(ws + WS_QKC);
            const bf16* __restrict__ Zr = Z; const float* __restrict__ ZFr = (const float*)(ws + WS_ZF);
            float xq[3][2], xk[3][2];
#pragma unroll
            for (int j = 0; j < 3; ++j) {
                const int rp = prow(rbase, j + 1);
                unsigned qw = 0u, kw = 0u;
                if (rp >= 0) { qw = *(const unsigned*)(Z + (size_t)rp * ZB + ZC_MQ + h * 128 + k0); kw = *(const unsigned*)(Z + (size_t)rp * ZB + ZC_MK + h * 128 + k0); }
                xq[j][0] = bflo(qw); xq[j][1] = bfhi(qw); xk[j][0] = bflo(kw); xk[j][1] = bfhi(kw);
            }
            float bsum = 0.f;
            float pli[4], plf[4]; unsigned pq[4], pk[4];
#define P2M_LOAD(t0) do { _Pragma("unroll") for (int i = 0; i < 4; ++i) { const int r_ = rbase + (t0) + i; const float* zf_ = ZFr + (size_t)r_ * ZFW; \
                pli[i] = zf_[ZF_MI + h]; plf[i] = zf_[ZF_MF + h]; \
                pq[i] = *(const unsigned*)(Zr + (size_t)r_ * ZB + ZC_MQ + h * 128 + k0); pk[i] = *(const unsigned*)(Zr + (size_t)r_ * ZB + ZC_MK + h * 128 + k0); } } while (0)
            P2M_LOAD(0);
            for (int t0 = 0; t0 < nrows; t0 += 4) {
                float cli[4], clf[4]; unsigned cqw[4], ckw[4];
#pragma unroll
                for (int i = 0; i < 4; ++i) { cli[i] = pli[i]; clf[i] = plf[i]; cqw[i] = pq[i]; ckw[i] = pk[i]; }
                if (t0 + 4 < nrows) P2M_LOAD(t0 + 4);
#pragma unroll
                for (int i = 0; i < 4; ++i) {
                    const int r = rbase + t0 + i;
                    const float li = cli[i], lf = logsigmoid_f(clf[i] + fb);
                    bsum += lf;
                    const float q0 = bflo(cqw[i]), q1 = bfhi(cqw[i]), kk0 = bflo(ckw[i]), kk1 = bfhi(ckw[i]);
                    const float yq0 = cq[3][0] * q0 + cq[2][0] * xq[0][0] + cq[1][0] * xq[1][0] + cq[0][0] * xq[2][0];
                    const float yq1 = cq[3][1] * q1 + cq[2][1] * xq[0][1] + cq[1][1] * xq[1][1] + cq[0][1] * xq[2][1];
                    const float yk0 = ck[3][0] * kk0 + ck[2][0] * xk[0][0] + ck[1][0] * xk[1][0] + ck[0][0] * xk[2][0];
                    const float yk1 = ck[3][1] * kk1 + ck[2][1] * xk[0][1] + ck[1][1] * xk[1][1] + ck[0][1] * xk[2][1];
                    xq[2][0] = xq[1][0]; xq[2][1] = xq[1][1]; xq[1][0] = xq[0][0]; xq[1][1] = xq[0][1]; xq[0][0] = q0; xq[0][1] = q1;
                    xk[2][0] = xk[1][0]; xk[2][1] = xk[1][1]; xk[1][0] = xk[0][0]; xk[1][1] = xk[0][1]; xk[0][0] = kk0; xk[0][1] = kk1;
                    const float eq = __expf(bsum) * 0.08838834764831845f, ek = __expf(li - bsum);
                    *(unsigned*)(QM + (size_t)r * 1024 + h * 128 + k0) = pk2(silu_f(yq0) * eq, silu_f(yq1) * eq);
                    *(unsigned*)(QM + (size_t)r * 1024 + 512 + h * 128 + k0) = pk2(silu_f(yk0) * ek, silu_f(yk1) * ek);
                }
            }
#undef P2M_LOAD
            const float dd = __expf(bsum);
            *(f32x2*)(DDp + ((size_t)(257 + cid) * 4 + h) * 128 + k0) = (f32x2){dd, dd};
        }
    }
}

constexpr int SC_QS = 272, SC_VS = 144;
constexpr int SC_QT = 0, SC_KT = 2 * 17408, SC_VT = 4 * 17408, SC_AT = SC_VT + 2 * 9216, SC_SB = SC_AT + 9216, SC_DD = SC_SB + 18432, SC_NB = SC_DD + 1024, SC_END = SC_NB + 256;
static_assert(SC_END <= RING_BYTES, "scan LDS");
__device__ __forceinline__ bf16x8 tr8(LAS unsigned char* base, int stride, int row0, int col0, int lane) {
    const int fq = lane >> 4, q4 = (lane & 15) >> 2, p4 = lane & 3;
    LAS unsigned char* p = base + (row0 + 8 * fq + q4) * stride + (col0 + 4 * p4) * 2;
    const s16x4 lo = __builtin_amdgcn_ds_read_tr16_b64_v4i16((LAS s16x4*)p);
    const s16x4 hi = __builtin_amdgcn_ds_read_tr16_b64_v4i16((LAS s16x4*)(p + 4 * stride));
    return __builtin_shufflevector(lo, hi, 0, 1, 2, 3, 4, 5, 6, 7);
}
template <bool ML>
__device__ __forceinline__ void scan_unit(ArgsP a, LAS unsigned char* lds, int b, int h, int vs, int tid_in) {
    int tid = tid_in; asm volatile("" : "+v"(tid));
    unsigned char* ws = a->ws;
    const bf16* Z = (const bf16*)(ws + WS_Z);
    const bf16* QK = (const bf16*)(ws + (ML ? WS_QKC : WS_G));
    const float* DDp = (const float*)(ws + WS_DD) + (ML ? (size_t)257 * 512 : 0);
    bf16* O = (bf16*)(ws + (ML ? WS_OM : WS_OG));
    const int lane = tid & 63, wave = __builtin_amdgcn_readfirstlane(tid >> 6), fr = lane & 15, fq = lane >> 4;
    const int vt = wave & 3, hh = wave >> 2;
    for (int i = tid; i < (18432 + 1024 + 256) / 4; i += 512) ((LAS unsigned*)(lds + SC_SB))[i] = 0u;
    f32x4 S[4], nacc[4];
#pragma unroll
    for (int i = 0; i < 4; ++i) { S[i] = (f32x4){0.f, 0.f, 0.f, 0.f}; nacc[i] = (f32x4){0.f, 0.f, 0.f, 0.f}; }
    const bf16x8 ones = {(short)0x3F80, (short)0x3F80, (short)0x3F80, (short)0x3F80, (short)0x3F80, (short)0x3F80, (short)0x3F80, (short)0x3F80};
    u32x4 gq[2], gk[2], gv; float gd = 0.f;
    const int vcol = (ML ? ZC_MV : ZC_GV) + h * 256 + vs * 64;
#define SCAN_LOAD(c) do { const int c_ = (c); \
        _Pragma("unroll") for (int e = 0; e < 2; ++e) { const int pid = tid + 512 * e, t = pid >> 4, ch = pid & 15; \
            const bool ok = c_ > 0 || t >= 48; const int row = c_ == 0 ? MR + t - 48 : b * SEQ + (c_ - 1) * 64 + t; \
            gq[e] = ok ? *(const u32x4*)(QK + (size_t)row * 1024 + h * 128 + ch * 8) : (u32x4){0u, 0u, 0u, 0u}; \
            gk[e] = ok ? *(const u32x4*)(QK + (size_t)row * 1024 + 512 + h * 128 + ch * 8) : (u32x4){0u, 0u, 0u, 0u}; } \
        { const int t = tid >> 3, ch = tid & 7; const bool ok = c_ > 0 || t >= 48; const int row = c_ == 0 ? MR + t - 48 : b * SEQ + (c_ - 1) * 64 + t; \
          gv = ok ? *(const u32x4*)(Z + (size_t)row * ZB + vcol + ch * 8) : (u32x4){0u, 0u, 0u, 0u}; } \
        if (tid < 128) { const int cid = c_ == 0 ? 256 : b * 32 + (c_ - 1); gd = DDp[((size_t)cid * 4 + h) * 128 + tid]; } } while (0)
#define SCAN_STORE(buf) do { const int bo_ = (buf); \
        _Pragma("unroll") for (int e = 0; e < 2; ++e) { const int pid = tid + 512 * e, t = pid >> 4, ch = pid & 15; \
            *(LAS u32x4*)(lds + SC_QT + bo_ * 17408 + t * SC_QS + ch * 16) = gq[e]; *(LAS u32x4*)(lds + SC_KT + bo_ * 17408 + t * SC_QS + ch * 16) = gk[e]; } \
        { const int t = tid >> 3, ch = tid & 7; *(LAS u32x4*)(lds + SC_VT + bo_ * 9216 + t * SC_VS + ch * 16) = gv; } \
        if (tid < 128) ((LAS float*)(lds + SC_DD))[bo_ * 128 + tid] = gd; } while (0)
    SCAN_LOAD(0);
    __syncthreads();
    SCAN_STORE(0);
    __syncthreads();
    for (int c = 0; c < 33; ++c) {
        const int buf = c & 1;
        LAS unsigned char* QT = lds + SC_QT + buf * 17408; LAS unsigned char* KT = lds + SC_KT + buf * 17408; LAS unsigned char* VT = lds + SC_VT + buf * 9216;
        LAS unsigned char* AT = lds + SC_AT; LAS unsigned char* SB = lds + SC_SB;
        const LAS float* ddL = (const LAS float*)(lds + SC_DD) + buf * 128;
        if (c + 1 < 33) SCAN_LOAD(c + 1);
        {
            const int ti = wave >> 1;
#pragma unroll
            for (int sj = 0; sj < 2; ++sj) {
                const int si = 2 * (wave & 1) + sj;
                f32x4 acc = {0.f, 0.f, 0.f, 0.f};
#pragma unroll
                for (int ks = 0; ks < 4; ++ks) {
                    const bf16x8 qa = *(const LAS bf16x8*)(QT + (16 * ti + fr) * SC_QS + (32 * ks + 8 * fq) * 2);
                    const bf16x8 kb = *(const LAS bf16x8*)(KT + (16 * si + fr) * SC_QS + (32 * ks + 8 * fq) * 2);
                    acc = __builtin_amdgcn_mfma_f32_16x16x32_bf16(qa, kb, acc, 0, 0, 0);
                }
                const int sg = 16 * si + fr, tg = 16 * ti + 4 * fq;
                LAS bf16* ap = (LAS bf16*)(AT + tg * SC_VS) + sg;
                ap[0 * (SC_VS / 2)] = (bf16)(sg <= tg + 0 ? f2bf(acc.x) : 0u);
                ap[1 * (SC_VS / 2)] = (bf16)(sg <= tg + 1 ? f2bf(acc.y) : 0u);
                ap[2 * (SC_VS / 2)] = (bf16)(sg <= tg + 2 ? f2bf(acc.z) : 0u);
                ap[3 * (SC_VS / 2)] = (bf16)(sg <= tg + 3 ? f2bf(acc.w) : 0u);
            }
        }
        {
            const bf16x8 vb0 = tr8(VT, SC_VS, 0, 16 * vt, lane), vb1 = tr8(VT, SC_VS, 32, 16 * vt, lane);
#pragma unroll
            for (int i = 0; i < 4; ++i) {
                const int kt = 4 * hh + i;
                const bf16x8 ka0 = tr8(KT, SC_QS, 0, 16 * kt, lane), ka1 = tr8(KT, SC_QS, 32, 16 * kt, lane);
                f32x4 acc = S[i];
                acc = __builtin_amdgcn_mfma_f32_16x16x32_bf16(ka0, vb0, acc, 0, 0, 0);
                acc = __builtin_amdgcn_mfma_f32_16x16x32_bf16(ka1, vb1, acc, 0, 0, 0);
                const f32x4 dv = *(const LAS f32x4*)(ddL + 16 * kt + 4 * fq);
                S[i] = acc * dv;
                if (ML) {
                    f32x4 na = nacc[i];
                    na = __builtin_amdgcn_mfma_f32_16x16x32_bf16(ka0, ones, na, 0, 0, 0);
                    na = __builtin_amdgcn_mfma_f32_16x16x32_bf16(ka1, ones, na, 0, 0, 0);
                    nacc[i] = na * dv;
                }
            }
        }
        LDS_WAIT();
        __syncthreads();
        {
            const bf16x8 vb0 = tr8(VT, SC_VS, 0, 16 * vt, lane), vb1 = tr8(VT, SC_VS, 32, 16 * vt, lane);
            bf16x8 sb[4];
#pragma unroll
            for (int ks = 0; ks < 4; ++ks) sb[ks] = tr8(SB, SC_VS, 32 * ks, 16 * vt, lane);
            bf16x8 nb[4];
            if (ML) {
#pragma unroll
                for (int ks = 0; ks < 4; ++ks) nb[ks] = *(const LAS bf16x8*)(lds + SC_NB + (32 * ks + 8 * fq) * 2);
            }
#pragma unroll
            for (int tj = 0; tj < 2; ++tj) {
                const int ti = 2 * hh + tj;
                f32x4 acc = {0.f, 0.f, 0.f, 0.f}, den = {0.f, 0.f, 0.f, 0.f};
#pragma unroll
                for (int ks = 0; ks < 4; ++ks) {
                    const bf16x8 qa = *(const LAS bf16x8*)(QT + (16 * ti + fr) * SC_QS + (32 * ks + 8 * fq) * 2);
                    acc = __builtin_amdgcn_mfma_f32_16x16x32_bf16(qa, sb[ks], acc, 0, 0, 0);
                    if (ML) den = __builtin_amdgcn_mfma_f32_16x16x32_bf16(qa, nb[ks], den, 0, 0, 0);
                }
                const bf16x8 aa0 = *(const LAS bf16x8*)(AT + (16 * ti + fr) * SC_VS + (8 * fq) * 2), aa1 = *(const LAS bf16x8*)(AT + (16 * ti + fr) * SC_VS + (32 + 8 * fq) * 2);
                acc = __builtin_amdgcn_mfma_f32_16x16x32_bf16(aa0, vb0, acc, 0, 0, 0);
                acc = __builtin_amdgcn_mfma_f32_16x16x32_bf16(aa1, vb1, acc, 0, 0, 0);
                if (ML) {
                    den = __builtin_amdgcn_mfma_f32_16x16x32_bf16(aa0, ones, den, 0, 0, 0);
                    den = __builtin_amdgcn_mfma_f32_16x16x32_bf16(aa1, ones, den, 0, 0, 0);
                    acc.x *= __builtin_amdgcn_rcpf(fmaxf(fabsf(den.x), 1.f)); acc.y *= __builtin_amdgcn_rcpf(fmaxf(fabsf(den.y), 1.f)); acc.z *= __builtin_amdgcn_rcpf(fmaxf(fabsf(den.z), 1.f)); acc.w *= __builtin_amdgcn_rcpf(fmaxf(fabsf(den.w), 1.f));
                }
                const int t0 = 16 * ti + 4 * fq;
                const int rowb = c == 0 ? MR + t0 - 48 : b * SEQ + (c - 1) * 64 + t0;
                bf16* op = O + (size_t)rowb * 1024 + h * 256 + vs * 64 + 16 * vt + fr;
                if (c > 0 || t0 >= 48) { op[0] = (bf16)f2bf(acc.x); op[1024] = (bf16)f2bf(acc.y); op[2048] = (bf16)f2bf(acc.z); op[3072] = (bf16)f2bf(acc.w); }
            }
        }
        LDS_WAIT();
        __syncthreads();
        {
#pragma unroll
            for (int i = 0; i < 4; ++i) {
                const int k0 = 16 * (4 * hh + i) + 4 * fq;
                LAS bf16* sp = (LAS bf16*)(SB + k0 * SC_VS) + 16 * vt + fr;
                sp[0 * (SC_VS / 2)] = (bf16)f2bf(S[i].x); sp[1 * (SC_VS / 2)] = (bf16)f2bf(S[i].y); sp[2 * (SC_VS / 2)] = (bf16)f2bf(S[i].z); sp[3 * (SC_VS / 2)] = (bf16)f2bf(S[i].w);
                if (ML && vt == 0 && fr == 0) { LAS bf16* np = (LAS bf16*)(lds + SC_NB) + k0; np[0] = (bf16)f2bf(nacc[i].x); np[1] = (bf16)f2bf(nacc[i].y); np[2] = (bf16)f2bf(nacc[i].z); np[3] = (bf16)f2bf(nacc[i].w); }
            }
            if (c + 1 < 33) SCAN_STORE(buf ^ 1);
        }
        LDS_WAIT();
        __syncthreads();
    }
#undef SCAN_LOAD
#undef SCAN_STORE
}

template <bool DRY = false>
__device__ __forceinline__ void p6_headnorm(ArgsP a, int l, int gw, int ngw, int lane) {
    unsigned char* ws = a->ws; const bf16* Z = (const bf16*)(ws + WS_Z);
    for (int it = gw; it < MT * 8; it += ngw) {
        const int r = it >> 3, mx = (it >> 2) & 1, h = it & 3;
        bf16* op = (bf16*)(ws + (mx ? WS_OM : WS_OG)) + (size_t)r * 1024 + h * 256 + 4 * lane;
        const u32x2 w = *(const u32x2*)op; f32x4 v = {bflo(w.x), bfhi(w.x), bflo(w.y), bfhi(w.y)};
        const float rr = rsqrtf(wave_sum((v.x * v.x + v.y * v.y) + (v.z * v.z + v.w * v.w)) * (1.f / 256.f) + EPS);
        const f32x4 gg = *(const f32x4*)(a->in[mx ? I_GML : I_GGLA] + l * 256 + 4 * lane);
        const u32x2 gw2 = *(const u32x2*)(Z + (size_t)r * ZB + (mx ? ZC_MO : ZC_GR) + h * 256 + 4 * lane);
        const f32x4 gt = {bflo(gw2.x), bfhi(gw2.x), bflo(gw2.y), bfhi(gw2.y)};
        v = v * rr * gg * gt;
        u32x2 o; o.x = pk2(v.x, v.y); o.y = pk2(v.z, v.w); *(u32x2*)(DRY ? (bf16*)(ws + WS_XN) + ((size_t)r * 1024 + h * 256 + 4 * lane) : op) = o;
    }
}

__device__ __forceinline__ int krow(int b, int s) { return s < NMETA ? MR + s : b * SEQ + (s - NMETA); }
__device__ __forceinline__ int t5_bucket(int n) {
    if (n < 16) return n < 0 ? 0 : n;
    const int lg = 16 + (int)(__logf((float)n * (1.f / 16.f)) / 2.0794415416798357f * 16.f);
    return lg < 31 ? lg : 31;
}
__device__ __forceinline__ unsigned off_b(unsigned row, unsigned ch) { return 256u * row + 16u * (ch ^ (((row & 3) << 2) | ((row >> 2) & 3))); }
__device__ __forceinline__ s16x4 tr_rd(LAS unsigned char* p) { return __builtin_amdgcn_ds_read_tr16_b64_v4i16((LAS s16x4*)p); }

constexpr int DW2_STRIDE = 9216, DW2_TILE = 0, DW2_SEL = 8192, DW2_BK = 8704, DSA2_T5 = 8 * DW2_STRIDE, DSA2_BT = DSA2_T5 + 2048 + 64;

template <bool DENSE_ONLY>
__device__ __forceinline__ void dsa_unit(ArgsP a, LAS unsigned char* lds, int b, int c, int nq, int wave, int lane_in) {
    int lane = lane_in; asm volatile("" : "+v"(lane));
    unsigned char* ws = a->ws;
    const bf16* QQ = (const bf16*)(ws + WS_QQ); const bf16* KI = (const bf16*)(ws + WS_KI); const bf16* KV = (const bf16*)(ws + WS_KV);
    unsigned* SC = (unsigned*)(ws + WS_SC) + (size_t)blockIdx.x * 64 * SC_PITCH;
    const int r0 = DENSE_ONLY ? MR : b * SEQ + 64 * c, p0 = DENSE_ONLY ? 0 : NMETA + 64 * c;
    const int fr = lane & 15, fq = lane >> 4;
    if (!DENSE_ONLY) {
        const int qt = wave & 3, kh = wave >> 2;
        if (p0 + 16 * qt + 15 >= 256) {
            const int qrow = r0 + 16 * qt + fr, pq = p0 + 16 * qt + fr;
            bf16x8 qf[8][2];
#pragma unroll
            for (int h = 0; h < 8; ++h)
#pragma unroll
                for (int ks = 0; ks < 2; ++ks) qf[h][ks] = *(const bf16x8*)(QQ + (size_t)qrow * NQQ + 2048 + h * 64 + ks * 32 + 8 * fq);
            float wi[8];
            { const f32x4 w0 = *(const f32x4*)((const float*)(ws + WS_WI) + (size_t)qrow * 8), w1 = *(const f32x4*)((const float*)(ws + WS_WI) + (size_t)qrow * 8 + 4);
              wi[0] = w0.x; wi[1] = w0.y; wi[2] = w0.z; wi[3] = w0.w; wi[4] = w1.x; wi[5] = w1.y; wi[6] = w1.z; wi[7] = w1.w; }
            const int nkt = 2 + 4 * c + qt;
            unsigned* scq = SC + (size_t)(16 * qt + fr) * SC_PITCH + 4 * fq;
            for (int kt0 = kh; kt0 < nkt; kt0 += 8) {
                bf16x8 a0[4], a1[4];
#pragma unroll
                for (int j = 0; j < 4; ++j) { const int kt = kt0 + 2 * j < nkt ? kt0 + 2 * j : nkt - 1;
                    const bf16* kp = KI + (size_t)krow(b, 16 * kt + fr) * 64 + 8 * fq;
                    a0[j] = *(const bf16x8*)kp; a1[j] = *(const bf16x8*)(kp + 32); }
#pragma unroll
                for (int j = 0; j < 4; ++j) {
                    const int kt = kt0 + 2 * j;
                    float s0 = 0.f, s1 = 0.f, s2 = 0.f, s3 = 0.f;
#pragma unroll
                    for (int h = 0; h < 8; ++h) {
                        f32x4 acc = {0.f, 0.f, 0.f, 0.f};
                        acc = __builtin_amdgcn_mfma_f32_16x16x32_bf16(a0[j], qf[h][0], acc, 0, 0, 0);
                        acc = __builtin_amdgcn_mfma_f32_16x16x32_bf16(a1[j], qf[h][1], acc, 0, 0, 0);
                        s0 += wi[h] * fmaxf(acc.x, 0.f); s1 += wi[h] * fmaxf(acc.y, 0.f); s2 += wi[h] * fmaxf(acc.z, 0.f); s3 += wi[h] * fmaxf(acc.w, 0.f);
                    }
                    const int kb = 16 * kt + 4 * fq;
                    u32x4 o;
                    { const unsigned bits = __builtin_bit_cast(unsigned, s0); o.x = (kb + 0) <= pq ? (bits ^ ((bits >> 31) ? 0xffffffffu : 0x80000000u)) : 0u; }
                    { const unsigned bits = __builtin_bit_cast(unsigned, s1); o.y = (kb + 1) <= pq ? (bits ^ ((bits >> 31) ? 0xffffffffu : 0x80000000u)) : 0u; }
                    { const unsigned bits = __builtin_bit_cast(unsigned, s2); o.z = (kb + 2) <= pq ? (bits ^ ((bits >> 31) ? 0xffffffffu : 0x80000000u)) : 0u; }
                    { const unsigned bits = __builtin_bit_cast(unsigned, s3); o.w = (kb + 3) <= pq ? (bits ^ ((bits >> 31) ? 0xffffffffu : 0x80000000u)) : 0u; }
                    if (kt < nkt) *(u32x4*)(scq + 16 * kt) = o;
                }
            }
        }
        VM_WAIT();
        __syncthreads();
    }
    LAS unsigned char* wl = lds + wave * DW2_STRIDE;
    LAS unsigned char* tile = wl + DW2_TILE;
    LAS unsigned short* selL = (LAS unsigned short*)(wl + DW2_SEL);
    LAS unsigned short* bkL = (LAS unsigned short*)(wl + DW2_BK);
    const LAS float* t5L = (const LAS float*)(lds + DSA2_T5);
    const LAS unsigned short* bkT = (const LAS unsigned short*)(lds + DSA2_BT);
    const int nqw = DENSE_ONLY ? 2 : 8;
    for (int qi_ = 0; qi_ < nqw; ++qi_) {
        asm volatile("" : "+v"(lane));
        const int iq = wave * nqw + qi_;
        if (iq >= nq) break;
        const int p = p0 + iq, nk = p + 1, qrow = r0 + iq;
        int nsel;
        if (!DENSE_ONLY && nk > 256) {
            const unsigned* scr = SC + (size_t)iq * SC_PITCH;
            unsigned u[33];
#pragma unroll
            for (int i = 0; i < 33; ++i) { const int s = lane + 64 * i; u[i] = s < nk ? __hip_atomic_load(scr + s, __ATOMIC_RELAXED, __HIP_MEMORY_SCOPE_AGENT) : 0u; }
            unsigned tau = 0u;
            for (int bit = 31; bit >= 16; --bit) {
                const unsigned cand = tau | (1u << bit);
                int cnt = 0;
#pragma unroll
                for (int i = 0; i < 33; ++i) cnt += __popcll(__ballot(u[i] >= cand));
                if (cnt >= 256) tau = cand;
            }
            {
                const unsigned hi = tau >> 16;
                int cab = 0, ncand = 0;
                LAS unsigned short* candL = (LAS unsigned short*)tile;
                const unsigned long long ltm = (1ull << lane) - 1ull;
#pragma unroll
                for (int i = 0; i < 33; ++i) {
                    const unsigned uh = u[i] >> 16;
                    cab += __popcll(__ballot(uh > hi));
                    const unsigned long long mc = __ballot(uh == hi);
                    if (mc != 0ull) { if (uh == hi) candL[ncand + __popcll(mc & ltm)] = (unsigned short)(u[i] & 0xffffu); ncand += __popcll(mc); }
                }
                LDS_WAIT();
                const int need = 256 - cab;
                unsigned lo = 0u;
                if (ncand <= 64) {
                    const unsigned v = lane < ncand ? (unsigned)candL[lane] + 1u : 0u;
                    for (int bit = 15; bit >= 0; --bit) { const unsigned cand = lo | (1u << bit); if (__popcll(__ballot(v >= cand + 1u)) >= need) lo = cand; }
                } else {
                    for (int bit = 15; bit >= 0; --bit) {
                        const unsigned cand = lo | (1u << bit); int cnt = 0;
                        for (int j = lane; j < ((ncand + 63) & ~63); j += 64) { const unsigned v = j < ncand ? (unsigned)candL[j] + 1u : 0u; cnt += __popcll(__ballot(v >= cand + 1u)); }
                        if (cnt >= need) lo = cand;
                    }
                }
                tau |= lo;
                LDS_WAIT();
            }
            int cgt = 0;
#pragma unroll
            for (int i = 0; i < 33; ++i) cgt += __popcll(__ballot(u[i] > tau));
            const int rem = 256 - cgt;
            const unsigned long long lt = (1ull << lane) - 1ull;
            int base = 0, eqseen = 0;
#pragma unroll
            for (int i = 0; i < 33; ++i) {
                const bool gt = u[i] > tau, eq = u[i] == tau;
                const unsigned long long meq = __ballot(eq);
                const bool take = gt || (eq && (eqseen + __popcll(meq & lt)) < rem);
                const unsigned long long mt = __ballot(take);
                if (take) { const int pos = base + __popcll(mt & lt), s = lane + 64 * i; selL[pos] = (unsigned short)s; bkL[pos] = bkT[p - s]; }
                base += __popcll(mt); eqseen += __popcll(meq);
            }
            nsel = 256;
        } else {
#pragma unroll
            for (int m = 0; m < 4; ++m) { const int s = lane + 64 * m; selL[s] = (unsigned short)(s < nk ? s : 0); bkL[s] = bkT[s < nk ? p - s : 0]; }
            nsel = nk;
        }
        asm volatile("" : "+v"(lane));
        bf16x8 qB[4];
#pragma unroll
        for (int ks = 0; ks < 4; ++ks) qB[ks] = *(const bf16x8*)(QQ + (size_t)qrow * NQQ + fr * 128 + ks * 32 + 8 * fq);
        LDS_WAIT();
        f32x4 O[8];
#pragma unroll
        for (int nt = 0; nt < 8; ++nt) O[nt] = (f32x4){0.f, 0.f, 0.f, 0.f};
        float qss = 0.f;
#pragma unroll
        for (int ks = 0; ks < 4; ++ks) { const u32x4 w = __builtin_bit_cast(u32x4, qB[ks]);
            qss += (bflo(w.x) * bflo(w.x) + bfhi(w.x) * bfhi(w.x)) + (bflo(w.y) * bflo(w.y) + bfhi(w.y) * bfhi(w.y)) + (bflo(w.z) * bflo(w.z) + bfhi(w.z) * bfhi(w.z)) + (bflo(w.w) * bflo(w.w) + bfhi(w.w) * bfhi(w.w)); }
        qss += __shfl_xor(qss, 16); qss += __shfl_xor(qss, 32);
        const float mb = sqrtf(qss) * t5L[512] + t5L[513];
        float lrun = 0.f;
        const int nblk = (nsel + 31) >> 5;
        u32x4 gv[8];
#pragma unroll
        for (int e = 0; e < 8; ++e) { const int pid = lane + 64 * e, ri = pid >> 4, ch = pid & 15;
            const int key = ri < nsel ? (int)selL[ri] : 0;
            gv[e] = *(const u32x4*)(KV + (size_t)krow(b, key) * 128 + ch * 8); }
        for (int blk = 0; blk < nblk; ++blk) {
#pragma unroll
            for (int e = 0; e < 8; ++e) { const int pid = lane + 64 * e, ri = pid >> 4, ch = pid & 15; *(LAS u32x4*)(tile + off_b(ri, ch)) = gv[e]; }
            if (blk + 1 < nblk) {
#pragma unroll
                for (int e = 0; e < 8; ++e) { const int pid = lane + 64 * e, ri = pid >> 4, ch = pid & 15, j = 32 * (blk + 1) + ri;
                    const int key = j < nsel ? (int)selL[j] : 0;
                    gv[e] = *(const u32x4*)(KV + (size_t)krow(b, key) * 128 + ch * 8); }
            }
            LDS_WAIT();
            f32x4 s0 = {0.f, 0.f, 0.f, 0.f}, s1 = {0.f, 0.f, 0.f, 0.f};
#pragma unroll
            for (int ks = 0; ks < 4; ++ks) {
                const bf16x8 k0 = *(const LAS bf16x8*)(tile + off_b(fr, 4 * ks + fq)), k1 = *(const LAS bf16x8*)(tile + off_b(16 + fr, 4 * ks + fq));
                s0 = __builtin_amdgcn_mfma_f32_16x16x32_bf16(k0, qB[ks], s0, 0, 0, 0);
                s1 = __builtin_amdgcn_mfma_f32_16x16x32_bf16(k1, qB[ks], s1, 0, 0, 0);
            }
            const int j0 = 32 * blk + 4 * fq;
            const u32x2 b0 = *(const LAS u32x2*)(bkL + j0), b1 = *(const LAS u32x2*)(bkL + j0 + 16);
            const float p00 = (j0 + 0) < nsel ? __expf(s0.x + t5L[(b0.x & 0xffffu) + fr] - mb) : 0.f, p01 = (j0 + 1) < nsel ? __expf(s0.y + t5L[(b0.x >> 16) + fr] - mb) : 0.f;
            const float p02 = (j0 + 2) < nsel ? __expf(s0.z + t5L[(b0.y & 0xffffu) + fr] - mb) : 0.f, p03 = (j0 + 3) < nsel ? __expf(s0.w + t5L[(b0.y >> 16) + fr] - mb) : 0.f;
            const float p10 = (j0 + 16) < nsel ? __expf(s1.x + t5L[(b1.x & 0xffffu) + fr] - mb) : 0.f, p11 = (j0 + 17) < nsel ? __expf(s1.y + t5L[(b1.x >> 16) + fr] - mb) : 0.f;
            const float p12 = (j0 + 18) < nsel ? __expf(s1.z + t5L[(b1.y & 0xffffu) + fr] - mb) : 0.f, p13 = (j0 + 19) < nsel ? __expf(s1.w + t5L[(b1.y >> 16) + fr] - mb) : 0.f;
            lrun += ((p00 + p01) + (p02 + p03)) + ((p10 + p11) + (p12 + p13));
            u32x4 pw; pw.x = pk2(p00, p01); pw.y = pk2(p02, p03); pw.z = pk2(p10, p11); pw.w = pk2(p12, p13);
            const bf16x8 pa = __builtin_bit_cast(bf16x8, pw);
            const unsigned q4 = (unsigned)(fr >> 2), p4 = (unsigned)(lane & 3);
#pragma unroll
            for (int nt = 0; nt < 8; ++nt) {
                const s16x4 vlo = tr_rd(tile + off_b(4 * fq + q4, 2 * nt + (p4 >> 1)) + 8 * (p4 & 1));
                const s16x4 vhi = tr_rd(tile + off_b(16 + 4 * fq + q4, 2 * nt + (p4 >> 1)) + 8 * (p4 & 1));
                const bf16x8 vb = __builtin_shufflevector(vlo, vhi, 0, 1, 2, 3, 4, 5, 6, 7);
                O[nt] = __builtin_amdgcn_mfma_f32_16x16x32_bf16(pa, vb, O[nt], 0, 0, 0);
            }
        }
        float lt2 = lrun + __shfl_xor(lrun, 16); lt2 += __shfl_xor(lt2, 32);
        const float inv = 1.f / lt2;
        float ir[4];
#pragma unroll
        for (int r = 0; r < 4; ++r) ir[r] = __shfl(inv, 4 * fq + r);
        bf16* od = (bf16*)(ws + WS_OD) + (size_t)qrow * 1024 + fr;
#pragma unroll
        for (int nt = 0; nt < 8; ++nt)
#pragma unroll
            for (int r = 0; r < 4; ++r) { const int hd = 4 * fq + r; od[(size_t)(hd >> 3) * MT * 1024 + (hd & 7) * 128 + 16 * nt] = (bf16)f2bf(O[nt][r] * ir[r]); }
        LDS_WAIT();
    }
}
__device__ __forceinline__ void p5_dsa(ArgsP a, LAS unsigned char* lds, int l, int tid, int wave, int lane) {
    LAS float* t5L = (LAS float*)(lds + DSA2_T5);
    __syncthreads();
    t5L[tid] = a->in[I_T5][tid];
    for (int n = tid; n < TT; n += 512) ((LAS unsigned short*)(lds + DSA2_BT))[n] = (unsigned short)(t5_bucket(n) * 16);
    if (tid < 64) {
        const float g0 = fabsf(a->in[I_GDKV][l * 128 + tid]), g1 = fabsf(a->in[I_GDKV][l * 128 + 64 + tid]);
        const float gm = wave_max(fmaxf(g0, g1));
        float tm = 0.f;
#pragma unroll
        for (int i = 0; i < 8; ++i) tm = fmaxf(tm, fabsf(a->in[I_T5][tid + 64 * i]));
        tm = wave_max(tm);
        if (tid == 0) { t5L[512] = 11.313708498984761f * gm; t5L[513] = tm; }
    }
    __syncthreads();
    for (int u = blockIdx.x; u < 256; u += gridDim.x) {
        dsa_unit<false>(a, lds, u >> 5, u & 31, 64, wave, lane);
        __syncthreads();
    }
    if (blockIdx.x == 0) dsa_unit<true>(a, lds, 0, 0, 16, wave, lane);
}

__global__ void __launch_bounds__(NWAVES * 64, 2) fwd(Args a_) {
    extern __shared__ __attribute__((aligned(16))) unsigned char lds_raw[];
    LAS unsigned char* lds = (LAS unsigned char*)lds_raw;
    volatile LAS unsigned* MISC = (volatile LAS unsigned*)(lds + MISC_OFF);
    if (threadIdx.x < 32) MISC[threadIdx.x] = 0u;
    __syncthreads();
    const int g_lo = a_.g_lo, g_hi = a_.g_hi, l_lo = a_.l_lo, l_hi = a_.l_hi, ph_lo = a_.ph_lo, ph_hi = a_.ph_hi, use_bar = a_.use_bar;
    XcdBarrier bar; bar.bar = (unsigned*)(a_.ws + WS_CTL) + CW_BAR; bar.x = 0; bar.st = nullptr;
    if (use_bar) bar = xcd_barrier_post((unsigned*)(a_.ws + WS_CTL) + CW_BAR, MISC + 8);
#define GRID_BAR() do { if (use_bar) xcd_barrier(bar); } while (0)
#ifndef PHMASK
#define PHMASK 0xFFFF
#endif
#ifndef PROBE_PH
#define PROBE_PH -1
#endif
#ifndef PROBE_MASK
#define PROBE_MASK 0
#endif
#define PROBED(k) ((PROBE_MASK >> (k)) & 1)
#ifndef P1_ALIGN
#define P1_ALIGN true
#endif
#define PH(k) (((PHMASK >> (k)) & 1) && ph_lo <= (k) && (k) < ph_hi)
#define PBEGIN ArgsP a = (ArgsP)__builtin_amdgcn_kernarg_segment_ptr(); asm volatile("" : "+s"(a)); unsigned char* ws = a->ws; \
    int tid_ = threadIdx.x; asm volatile("" : "+v"(tid_)); const int tid = tid_, lane = tid & 63, wave = __builtin_amdgcn_readfirstlane(tid >> 6); const int gw = blockIdx.x * NWAVES + wave, ngw = gridDim.x * NWAVES; (void)ws; (void)gw; (void)ngw; (void)lane;

    if (((PHMASK >> 13) & 1) && a_.prep) { PBEGIN prep_weights(a, lds, gw, ngw, wave, lane); GRID_BAR(); }

    for (int g = g_lo; g < g_hi; ++g) {
        for (int l = l_lo; l < l_hi; ++l) {
            if (PH(0) && l == 0) { PBEGIN p0_init(a, g, gw, ngw, lane); GRID_BAR(); }
            if (PH(1)) { PBEGIN
                FIn f{(bf16*)(ws + WS_Z), (float*)(ws + WS_ZF), (const float*)(ws + WS_BIN) + l * NZ};
                run_gemm<FIn, P1_ALIGN>(lds, (const bf16*)(ws + WS_XN), (const bf16*)(ws + WS_WIN) + (size_t)l * NZ * D, NZ, D, f, gw, ngw, lane);
                if (PROBED(1)) { run_gemm(lds, (const bf16*)(ws + WS_XN), (const bf16*)(ws + WS_WIN) + (size_t)l * NZ * D, NZ, D, f, gw, ngw, lane); }
                GRID_BAR();
            }
            if (PH(2)) { PBEGIN p2_prep(a, l, gw, ngw, lane); if (PROBED(2)) { p2_prep(a, l, gw, ngw, lane); } GRID_BAR(); }
            if (PH(3)) { PBEGIN
                FQQ f{(bf16*)(ws + WS_QQ)};
                run_gemm(lds, (const bf16*)(ws + WS_CQN), (const bf16*)(ws + WS_WQQ) + (size_t)l * NQQ * 256, NQQ, 256, f, gw, ngw, lane);
                if (PROBED(3)) { run_gemm(lds, (const bf16*)(ws + WS_CQN), (const bf16*)(ws + WS_WQQ) + (size_t)l * NQQ * 256, NQQ, 256, f, gw, ngw, lane); }
            }
            if (PH(4)) { PBEGIN
                for (int u = blockIdx.x; u < 256; u += gridDim.x) {
                    const int b = (u >> 4) & 7, h = (u >> 2) & 3, vs = u & 3;
                    if (u >> 7) scan_unit<true>(a, lds, b, h, vs, tid); else scan_unit<false>(a, lds, b, h, vs, tid);
                }
#if PROBE_PH == 4
                for (int u = blockIdx.x; u < 256; u += gridDim.x) {
                    const int b = (u >> 4) & 7, h = (u >> 2) & 3, vs = u & 3;
                    if (u >> 7) scan_unit<true>(a, lds, b, h, vs, tid); else scan_unit<false>(a, lds, b, h, vs, tid);
                }
#endif
                GRID_BAR();
            }
            if (PH(5)) { PBEGIN p5_dsa(a, lds, l, tid, wave, lane); }
#if PROBE_PH == 5
            if (PH(5)) { PBEGIN p5_dsa(a, lds, l, tid, wave, lane); }
#endif
            if (PH(6)) { PBEGIN p6_headnorm(a, l, gw, ngw, lane); if (PROBED(6)) p6_headnorm<true>(a, l, gw, ngw, lane); GRID_BAR(); }
            if (PH(7)) {
                __syncthreads();
                { PBEGIN
                  const bf16* OD0 = (const bf16*)(ws + WS_OD); const bf16* OD1 = OD0 + (size_t)MT * 1024;
                  const bf16* WB0 = (const bf16*)(ws + WS_WBD) + (size_t)l * D * 2048; const bf16* WB1 = WB0 + (size_t)D * D;
                  int Kc = D, Nc = D; asm volatile("" : "+s"(Kc)); asm volatile("" : "+s"(Nc));
                  pg8::Gemm g{(const bf16*)(ws + WS_OG), (const bf16*)(ws + WS_WBG) + (size_t)l * D * D, MR, Nc, Kc, OD0, OD1, (const bf16*)(ws + WS_OM), WB0, WB1, (const bf16*)(ws + WS_WBM) + (size_t)l * D * D};
                  ChainOrder S; S.S.init(MR, Nc, (int)gridDim.x, (int)blockIdx.x);
                  EpiMix E{(const bf16*)(ws + WS_Z), (bf16*)(ws + WS_MIX)};
                  pg8::gemm_phase<EpiMix, ChainOrder, true, true, true>((PG8_LAS unsigned char*)lds, g, S, E);
                  FBr<0> f0{(const bf16*)(ws + WS_Z), (float*)(ws + WS_Y), (bf16*)(ws + WS_MIX)};
                  mini_gemm((const bf16*)(ws + WS_OG), (const bf16*)(ws + WS_WBG) + (size_t)l * D * D, Nc, Kc, f0, gw, ngw, lane);
                  FBr<1> f1{(const bf16*)(ws + WS_Z), (float*)(ws + WS_Y), (bf16*)(ws + WS_MIX)};
                  mini_gemm(OD0, WB0, Nc, Kc, f1, gw, ngw, lane);
                  mini_gemm(OD1, WB1, Nc, Kc, f1, gw, ngw, lane);
                  FBr<2> f2{(const bf16*)(ws + WS_Z), (float*)(ws + WS_Y), (bf16*)(ws + WS_MIX)};
                  mini_gemm((const bf16*)(ws + WS_OM), (const bf16*)(ws + WS_WBM) + (size_t)l * D * D, Nc, Kc, f2, gw, ngw, lane);
                }
#if PROBED(7)
                { PBEGIN
                  const bf16* OD0 = (const bf16*)(ws + WS_OD); const bf16* OD1 = OD0 + (size_t)MT * 1024;
                  const bf16* WB0 = (const bf16*)(ws + WS_WBD) + (size_t)l * D * 2048; const bf16* WB1 = WB0 + (size_t)D * D;
                  int Kc = D, Nc = D; asm volatile("" : "+s"(Kc)); asm volatile("" : "+s"(Nc));
                  pg8::Gemm g{(const bf16*)(ws + WS_OG), (const bf16*)(ws + WS_WBG) + (size_t)l * D * D, MR, Nc, Kc, OD0, OD1, (const bf16*)(ws + WS_OM), WB0, WB1, (const bf16*)(ws + WS_WBM) + (size_t)l * D * D};
                  ChainOrder S; S.S.init(MR, Nc, (int)gridDim.x, (int)blockIdx.x);
                  EpiMix E{(const bf16*)(ws + WS_Z), (bf16*)(ws + WS_MIX)};
                  pg8::gemm_phase<EpiMix, ChainOrder, true, true, true>((PG8_LAS unsigned char*)lds, g, S, E);
                  FBr<0> f0{(const bf16*)(ws + WS_Z), (float*)(ws + WS_Y), (bf16*)(ws + WS_MIX)};
                  mini_gemm((const bf16*)(ws + WS_OG), (const bf16*)(ws + WS_WBG) + (size_t)l * D * D, Nc, Kc, f0, gw, ngw, lane);
                  FBr<1> f1{(const bf16*)(ws + WS_Z), (float*)(ws + WS_Y), (bf16*)(ws + WS_MIX)};
                  mini_gemm(OD0, WB0, Nc, Kc, f1, gw, ngw, lane);
                  mini_gemm(OD1, WB1, Nc, Kc, f1, gw, ngw, lane);
                  FBr<2> f2{(const bf16*)(ws + WS_Z), (float*)(ws + WS_Y), (bf16*)(ws + WS_MIX)};
                  mini_gemm((const bf16*)(ws + WS_OM), (const bf16*)(ws + WS_WBM) + (size_t)l * D * D, Nc, Kc, f2, gw, ngw, lane);
                }
#endif
                GRID_BAR();
            }
            if (PH(8)) { PBEGIN
                FY f{(bf16*)(ws + WS_Y)};
                run_gemm(lds, (const bf16*)(ws + WS_MIX), (const bf16*)(ws + WS_WOUT) + (size_t)l * D * D, D, D, f, gw, ngw, lane);
                if (PROBED(8)) { run_gemm(lds, (const bf16*)(ws + WS_MIX), (const bf16*)(ws + WS_WOUT) + (size_t)l * D * D, D, D, f, gw, ngw, lane); }
                GRID_BAR();
            }
            if (PH(9)) { PBEGIN if (PROBED(9)) p_norm_res<true>(a, g, a->in[I_GPOSTMIX] + l * D, a->in[I_GPREMLP] + l * D, gw, ngw, lane); p_norm_res(a, g, a->in[I_GPOSTMIX] + l * D, a->in[I_GPREMLP] + l * D, gw, ngw, lane); GRID_BAR(); }
            if (PH(10)) { PBEGIN
                FUp f{(bf16*)(ws + WS_Z)};
                run_gemm(lds, (const bf16*)(ws + WS_XN), (const bf16*)(ws + WS_WUP) + (size_t)l * DFF * D, DFF, D, f, gw, ngw, lane);
                if (PROBED(10)) { run_gemm(lds, (const bf16*)(ws + WS_XN), (const bf16*)(ws + WS_WUP) + (size_t)l * DFF * D, DFF, D, f, gw, ngw, lane); }
                GRID_BAR();
            }
            if (PH(11)) { PBEGIN
                FY f{(bf16*)(ws + WS_Y)};
                run_gemm(lds, (const bf16*)(ws + WS_Z), (const bf16*)(ws + WS_WDN) + (size_t)l * D * DFF, D, DFF, f, gw, ngw, lane);
                if (PROBED(11)) { run_gemm(lds, (const bf16*)(ws + WS_Z), (const bf16*)(ws + WS_WDN) + (size_t)l * D * DFF, D, DFF, f, gw, ngw, lane); }
                GRID_BAR();
            }
            if (PH(12)) { PBEGIN if (PROBED(12)) p_norm_res<true>(a, g, a->in[I_GPOSTMLP] + l * D, l + 1 < NL ? a->in[I_GPREMIX] + (l + 1) * D : nullptr, gw, ngw, lane); p_norm_res(a, g, a->in[I_GPOSTMLP] + l * D, l + 1 < NL ? a->in[I_GPREMIX] + (l + 1) * D : nullptr, gw, ngw, lane); GRID_BAR(); }
        }
    }
#undef PH
#undef GRID_BAR
#undef PBEGIN
}

#ifndef MK_ONE_LAUNCH
#define MK_ONE_LAUNCH 1
#endif
extern "C" void kernel_launch(void* const* d_in, const int* in_sizes, int n_in, void* d_out, int out_size, void* d_ws, size_t ws_size, hipStream_t stream) {
    static int grid = 0;
    if (grid == 0) {
        if (n_in != 28 || out_size != NB * SEQ * D || ws_size < WS_END) { fprintf(stderr, "kernel_launch: unexpected shapes (n_in %d out %d ws %zu need %zu)\n", n_in, out_size, ws_size, (size_t)WS_END); grid = -1; return; }
        int dev = 0, cus = 0, per_cu = 0;
        if (hipGetDevice(&dev) != hipSuccess || hipDeviceGetAttribute(&cus, hipDeviceAttributeMultiprocessorCount, dev) != hipSuccess) { grid = -1; return; }
        if (hipFuncSetAttribute((const void*)fwd, hipFuncAttributeMaxDynamicSharedMemorySize, LDS_BYTES) != hipSuccess) { fprintf(stderr, "kernel_launch: hipFuncSetAttribute failed\n"); grid = -1; return; }
        if (hipOccupancyMaxActiveBlocksPerMultiprocessor(&per_cu, (const void*)fwd, NWAVES * 64, LDS_BYTES) != hipSuccess || per_cu < 1) { fprintf(stderr, "kernel_launch: occupancy query says %d\n", per_cu); }
        (void)hipGetLastError();
        grid = cus;
    }
    if (grid < 0) return;
    (void)hipMemsetAsync((char*)d_ws + WS_CTL, 0, CTL_ZERO_BYTES, stream);
    Args a{};
    for (int i = 0; i < 28; ++i) a.in[i] = (const float*)d_in[i];
    a.out = (float*)d_out; a.ws = (unsigned char*)d_ws;
#if MK_ONE_LAUNCH
    a.g_lo = 0; a.g_hi = NG; a.l_lo = 0; a.l_hi = NL; a.ph_lo = 0; a.ph_hi = 13; a.prep = 1; a.use_bar = 1;
    hipLaunchKernelGGL(fwd, dim3(grid), dim3(NWAVES * 64), LDS_BYTES, stream, a);
#else
    a.use_bar = 0;
    a.prep = 1; a.g_lo = 0; a.g_hi = 0; a.l_lo = 0; a.l_hi = 0; a.ph_lo = 0; a.ph_hi = 0;
    hipLaunchKernelGGL(fwd, dim3(grid), dim3(NWAVES * 64), LDS_BYTES, stream, a);
    a.prep = 0;
    static const int cuts[] = {0, 1, 2, 3, 5, 7, 8, 9, 10, 11, 12, 13};
    for (int g = 0; g < NG; ++g) for (int l = 0; l < NL; ++l) for (int c = 0; c < 11; ++c) {
        if (c == 0 && l != 0) continue;
        a.g_lo = g; a.g_hi = g + 1; a.l_lo = l; a.l_hi = l + 1; a.ph_lo = cuts[c]; a.ph_hi = cuts[c + 1];
        hipLaunchKernelGGL(fwd, dim3(grid), dim3(NWAVES * 64), LDS_BYTES, stream, a);
    }
#endif
    const hipError_t le = hipPeekAtLastError();
    if (le != hipSuccess) fprintf(stderr, "kernel_launch: launch failed: %s\n", hipGetErrorName(le));
}
```

```cpp
#include <hip/hip_runtime.h>
#include <cstdio>
#include <cstdint>
namespace pg8 {
#define PG8_LAS __attribute__((address_space(3)))
typedef unsigned short bf16_t;
typedef short bf16x8 __attribute__((ext_vector_type(8)));
typedef float f32x4 __attribute__((ext_vector_type(4)));
typedef unsigned u32x4 __attribute__((ext_vector_type(4)));
constexpr int BM = 256, BK = 64, HALF = 128, HTB = HALF * BK * 2  , STAGE_BYTES = 8 * HTB, NXCD = 8, WGM = 8;

__host__ __device__ __forceinline__ int lds_byte(int r, int c) { const int st = (r >> 4) * 2 + (c >> 5), rr = r & 15, cc = c & 31, ob = rr * 64 + cc * 2; return st * 1024 + (ob ^ (((ob >> 9) & 1) << 5)); }
__host__ __device__ __forceinline__ void stage_rc(int b, int& R, int& C) { const int st = b / 1024, sb = b % 1024, swz = sb ^ (((sb >> 9) & 1) << 5); R = (st >> 1) * 16 + swz / 64; C = (st & 1) * 32 + (swz % 64) / 2; }
__host__ __device__ __forceinline__ int perm32(int rho) { const int n = rho >> 4, i = rho & 15; return 8 * (i >> 2) + 4 * n + (i & 3); }

struct Unit { int pm, pn, sub; };
struct Gemm { const bf16_t* A; const bf16_t* Bt; int M, N, K; const bf16_t *A1, *A2, *A3, *B1, *B2, *B3; };

struct StaticOrder {
    int nM, nN, nwg, G, c;
    __host__ __device__ void init(int M, int N, int G_, int c_) { nM = M / BM; nN = N / BM; nwg = nM * nN; G = G_; c = c_; }
    __host__ __device__ bool next(int i, Unit& u) const {
        const long L = (long)i * G + c; if (L >= nwg) return false;
        int wgid = (int)L; { const int q = nwg / NXCD, r = nwg % NXCD, xcd = wgid % NXCD, off = wgid / NXCD; wgid = (xcd < r ? xcd * (q + 1) : r * (q + 1) + (xcd - r) * q) + off; }
        const int nig = WGM * nN, gid = wgid / nig, fm = gid * WGM, gsz = (nM - fm) < WGM ? (nM - fm) : WGM;
        u.pm = fm + ((wgid % nig) % gsz); u.pn = (wgid % nig) / gsz; u.sub = 0; return true;
    }
    __device__ __forceinline__ void a_ready(const Unit&) const {}
    __device__ __forceinline__ void done(const Unit&) const {}
};

__device__ __forceinline__ unsigned cvt_pk_bf16(float lo, float hi) { unsigned r; asm volatile("v_cvt_pk_bf16_f32 %0, %1, %2" : "=v"(r) : "v"(lo), "v"(hi)); return r; }
template <class Epi, class Sched, bool ALIGN_EPI = false, bool SP2 = false, bool CHAIN = false>
__device__ __forceinline__ void gemm_phase(PG8_LAS unsigned char* lds, const Gemm g, const Sched& S, const Epi& E) {
    int tid_ = threadIdx.x; asm volatile("" : "+v"(tid_));
    const int tid = tid_, wid = __builtin_amdgcn_readfirstlane(tid >> 6), lane = tid & 63, wr = wid >> 2, wc = wid & 3, fr = lane & 15, fq = lane >> 4;
    const int K = g.K, nt = K / BK;
    unsigned voffA[2], voffB[2];
#pragma unroll
    for (int i = 0; i < 2; ++i) { int R, C; stage_rc(tid * 16 + i * 8192, R, C); const int Rb = Epi::PERM ? ((R & ~31) + perm32(R & 31)) : R;
        voffA[i] = (unsigned)(R * K + C) * 2u; voffB[i] = (unsigned)(Rb * K + C) * 2u; }
    const size_t kstep = (size_t)(BK * 2);
    const size_t hstep = (size_t)HALF * K * 2;
    const size_t tstep = 2 * hstep;
    const unsigned ldsw = (unsigned)wid * 1024u;
    const int aoff = lds_byte(wr * 64 + fr, fq * 8), boff = lds_byte(wc * 32 + fr, fq * 8);
#define PG8_SA(b, h) (((b) * 2 + (h)) * HTB)
#define PG8_SB(b, h) ((4 + (b) * 2 + (h)) * HTB)
#define PG8_STAGE(bufoff, gbase, voff) do { _Pragma("unroll") for (int _i = 0; _i < 2; ++_i) \
        __builtin_amdgcn_global_load_lds((const unsigned*)((const char*)(gbase) + (voff)[_i]), (PG8_LAS unsigned*)(lds + (bufoff) + ldsw + _i * 8192), 16, 0, 0); } while (0)
#define PG8_LDA(dst, b, h) do { _Pragma("unroll") for (int m = 0; m < 4; ++m) _Pragma("unroll") for (int k = 0; k < 2; ++k) dst[m][k] = *(const PG8_LAS bf16x8*)(lds + PG8_SA(b, h) + aoff + m * 2048 + k * 1024); } while (0)
#define PG8_LDB(dst, b, h) do { _Pragma("unroll") for (int n = 0; n < 2; ++n) _Pragma("unroll") for (int k = 0; k < 2; ++k) dst[n][k] = *(const PG8_LAS bf16x8*)(lds + PG8_SB(b, h) + boff + n * 2048 + k * 1024); } while (0)
#define PG8_MMA(ai, bj, At, Bt) do { __builtin_amdgcn_s_setprio(1); _Pragma("unroll") for (int m = 0; m < 4; ++m) _Pragma("unroll") for (int n = 0; n < 2; ++n) _Pragma("unroll") for (int k = 0; k < 2; ++k) \
        acc[ai][bj][m][n] = __builtin_amdgcn_mfma_f32_16x16x32_bf16(Bt[n][k], At[m][k], acc[ai][bj][m][n], 0, 0, 0); __builtin_amdgcn_s_setprio(0); } while (0)
#define PG8_WAIT_V(n) asm volatile("s_waitcnt vmcnt(" #n ")" ::: "memory")
#define PG8_WAIT_L(n) asm volatile("s_waitcnt lgkmcnt(" #n ")" ::: "memory")
#define PG8_BAR __builtin_amdgcn_s_barrier()
#define PG8_SCHED __builtin_amdgcn_sched_barrier(0)
    Unit cur, nxt; int ui = 0;
    if (!S.next(0, cur)) return;
    f32x4 acc[2][2][4][2];
#pragma unroll
    for (int a = 0; a < 2; ++a)
#pragma unroll
        for (int b = 0; b < 2; ++b)
#pragma unroll
            for (int m = 0; m < 4; ++m)
#pragma unroll
                for (int n = 0; n < 2; ++n) acc[a][b][m][n] = (f32x4){0.f, 0.f, 0.f, 0.f};
    bf16x8 At[4][2], B0[2][2], B1[2][2];
#define PG8_ABASE(u) ((const char*)(!CHAIN || (u).sub == 0 ? g.A : (u).sub == 1 ? g.A1 : (u).sub == 2 ? g.A2 : g.A3) + (size_t)(u).pm * tstep)
#define PG8_BBASE(u) ((const char*)(!CHAIN || (u).sub == 0 ? g.Bt : (u).sub == 1 ? g.B1 : (u).sub == 2 ? g.B2 : g.B3) + (size_t)(u).pn * tstep)
    const char* cA = PG8_ABASE(cur); const char* cB = PG8_BBASE(cur);
    S.a_ready(cur);
    if constexpr (SP2) {
        PG8_STAGE(PG8_SB(0, 0), cB, voffB); PG8_STAGE(PG8_SB(0, 1), cB + hstep, voffB); PG8_STAGE(PG8_SA(0, 0), cA, voffA); PG8_STAGE(PG8_SA(0, 1), cA + hstep, voffA);
        if (wr == 1) PG8_BAR;
        PG8_WAIT_V(2); PG8_BAR;
        PG8_STAGE(PG8_SB(1, 0), cB + kstep, voffB); PG8_STAGE(PG8_SA(1, 0), cA + kstep, voffA); PG8_STAGE(PG8_SB(1, 1), cB + hstep + kstep, voffB);
        PG8_WAIT_V(6); PG8_BAR;
    } else {
        PG8_STAGE(PG8_SB(0, 0), cB, voffB); PG8_STAGE(PG8_SA(0, 0), cA, voffA); PG8_STAGE(PG8_SB(0, 1), cB + hstep, voffB); PG8_STAGE(PG8_SA(0, 1), cA + hstep, voffA);
        if (wr == 1) PG8_BAR;
        PG8_WAIT_V(4); PG8_BAR;
        PG8_STAGE(PG8_SB(1, 0), cB + kstep, voffB); PG8_STAGE(PG8_SA(1, 0), cA + kstep, voffA); PG8_STAGE(PG8_SB(1, 1), cB + hstep + kstep, voffB);
        PG8_WAIT_V(6); PG8_BAR;
    }
    for (;;) {
        const bool has_next = S.next(ui + 1, nxt);
        const char* nA = has_next ? PG8_ABASE(nxt) : cA; const char* nB = has_next ? PG8_BBASE(nxt) : cB;
        for (int t = 0; t < nt; t += 2) {
            const bool last = (t == nt - 2);
            const char* a1 = cA + (size_t)(t + 1) * kstep;
            const char* a2 = last ? nA : cA + (size_t)(t + 2) * kstep; const char* b2 = last ? nB : cB + (size_t)(t + 2) * kstep;
            const char* a3 = a2 + kstep; const char* b3 = b2 + kstep;
            if (last && has_next) S.a_ready(nxt);
            if constexpr (SP2) {
            PG8_LDB(B0, 0, 0); PG8_LDB(B1, 0, 1); PG8_SCHED; PG8_LDA(At, 0, 0); PG8_STAGE(PG8_SA(1, 1), a1 + hstep, voffA);
            PG8_WAIT_V(8); PG8_WAIT_L(0); PG8_BAR; PG8_MMA(0, 0, At, B0); PG8_MMA(0, 1, At, B1); PG8_BAR; PG8_SCHED;
            PG8_LDA(At, 0, 1); PG8_STAGE(PG8_SB(0, 0), b2, voffB); PG8_STAGE(PG8_SB(0, 1), b2 + hstep, voffB); PG8_STAGE(PG8_SA(0, 0), a2, voffA);
            PG8_WAIT_V(8); PG8_WAIT_L(0); PG8_BAR; PG8_MMA(1, 0, At, B0); PG8_MMA(1, 1, At, B1); PG8_BAR; PG8_SCHED;
            PG8_LDB(B0, 1, 0); PG8_LDB(B1, 1, 1); PG8_SCHED; PG8_LDA(At, 1, 0); PG8_STAGE(PG8_SA(0, 1), a2 + hstep, voffA);
            PG8_WAIT_V(8); PG8_WAIT_L(0); PG8_BAR; PG8_MMA(0, 0, At, B0); PG8_MMA(0, 1, At, B1); PG8_BAR; PG8_SCHED;
            PG8_LDA(At, 1, 1); PG8_STAGE(PG8_SB(1, 0), b3, voffB); PG8_STAGE(PG8_SB(1, 1), b3 + hstep, voffB); PG8_STAGE(PG8_SA(1, 0), a3, voffA);
            PG8_WAIT_V(8); PG8_WAIT_L(0); PG8_BAR; PG8_MMA(1, 0, At, B0); PG8_MMA(1, 1, At, B1); PG8_BAR; PG8_SCHED;
            } else {
            PG8_LDB(B0, 0, 0); PG8_SCHED; PG8_LDA(At, 0, 0); PG8_STAGE(PG8_SA(1, 1), a1 + hstep, voffA);
            PG8_WAIT_L(8); PG8_BAR; PG8_WAIT_L(0); PG8_MMA(0, 0, At, B0); PG8_BAR; PG8_SCHED;
            PG8_LDB(B1, 0, 1); PG8_STAGE(PG8_SB(0, 0), b2, voffB);
            PG8_BAR; PG8_WAIT_L(0); PG8_MMA(0, 1, At, B1); PG8_BAR;
            PG8_LDA(At, 0, 1); PG8_STAGE(PG8_SA(0, 0), a2, voffA);
            PG8_BAR; PG8_WAIT_L(0); PG8_MMA(1, 0, At, B0); PG8_BAR; PG8_SCHED;
            PG8_STAGE(PG8_SB(0, 1), b2 + hstep, voffB);
            PG8_WAIT_V(6); PG8_BAR; PG8_MMA(1, 1, At, B1); PG8_BAR;
            PG8_LDB(B0, 1, 0); PG8_SCHED; PG8_LDA(At, 1, 0); PG8_STAGE(PG8_SA(0, 1), a2 + hstep, voffA);
            PG8_WAIT_L(8); PG8_BAR; PG8_WAIT_L(0); PG8_MMA(0, 0, At, B0); PG8_BAR; PG8_SCHED;
            PG8_LDB(B1, 1, 1); PG8_STAGE(PG8_SB(1, 0), b3, voffB);
            PG8_BAR; PG8_WAIT_L(0); PG8_MMA(0, 1, At, B1); PG8_BAR;
            PG8_LDA(At, 1, 1); PG8_STAGE(PG8_SA(1, 0), a3, voffA);
            PG8_BAR; PG8_WAIT_L(0); PG8_MMA(1, 0, At, B0); PG8_BAR; PG8_SCHED;
            PG8_STAGE(PG8_SB(1, 1), b3 + hstep, voffB);
            PG8_WAIT_V(6); PG8_BAR; PG8_MMA(1, 1, At, B1); PG8_BAR;
            }
        }
        if constexpr (ALIGN_EPI) { if (wr == 0) PG8_BAR; }
        if constexpr (CHAIN) { if (cur.sub < 3) E.mid(acc, cur, wr, wc, fr, fq); else E(acc, cur, wr, wc, fr, fq); S.done(cur); }
        else if constexpr (!Epi::AFTER_DRAIN) { E(acc, cur, wr, wc, fr, fq); S.done(cur); }
        if (!has_next) break;
        if (!CHAIN || cur.sub == 3)
#pragma unroll
        for (int a = 0; a < 2; ++a)
#pragma unroll
            for (int b = 0; b < 2; ++b)
#pragma unroll
                for (int m = 0; m < 4; ++m)
#pragma unroll
                    for (int n = 0; n < 2; ++n) acc[a][b][m][n] = (f32x4){0.f, 0.f, 0.f, 0.f};
        cur = nxt; cA = nA; cB = nB; ++ui;
        if constexpr (ALIGN_EPI) { if (wr == 1) PG8_BAR; }
    }
    PG8_WAIT_V(0);
    if constexpr (!ALIGN_EPI) { if (wr == 0) PG8_BAR; }
    PG8_BAR;
    if constexpr (Epi::AFTER_DRAIN) { E.fused(acc, cur, wr, wc, fr, fq, lds, wid, lane); S.done(cur); }
#undef PG8_ABASE
#undef PG8_BBASE
#undef PG8_SA
#undef PG8_SB
#undef PG8_STAGE
#undef PG8_LDA
#undef PG8_LDB
#undef PG8_MMA
#undef PG8_WAIT_V
#undef PG8_WAIT_L
#undef PG8_BAR
#undef PG8_SCHED
}
}

constexpr int NB = 32, SEQ = 2048, NMETA = 16, TT = SEQ + NMETA, D = 1024, NL = 4, DFF = 4096;
constexpr int NG = 4, GB = NB / NG, MR = GB * SEQ  , MT = MR + NMETA  ;
constexpr int NCOLS = 9696, NZ = 9728, ZB = 9216, ZFW = 512;
constexpr float EPS = 1e-6f;
constexpr int ZC_GQ = 0, ZC_GK = 512, ZC_GV = 1024, ZC_GR = 2048, ZC_MQ = 3072, ZC_MK = 3584, ZC_MV = 4096, ZC_MO = 5120, ZC_GATE = 6144;
constexpr int ZF_CQ = 0, ZF_CKV = 256, ZF_IK = 384, ZF_A = 448, ZF_IW = 464, ZF_MI = 472, ZF_MF = 476;
constexpr int NQQ = 2560;

constexpr size_t MiB = 1u << 20;
constexpr size_t WS_CTL = 0, CTL_ZERO_BYTES = 1 * MiB;
constexpr size_t WS_BIN = 1 * MiB;
constexpr size_t WS_WIN = 2 * MiB;
constexpr size_t WS_WQQ = 78 * MiB;
constexpr size_t WS_WBG = 83 * MiB;
constexpr size_t WS_WBM = 91 * MiB;
constexpr size_t WS_WBD = 99 * MiB;
constexpr size_t WS_WOUT = 115 * MiB;
constexpr size_t WS_WUP = 123 * MiB;
constexpr size_t WS_WDN = 155 * MiB;
constexpr size_t WS_HM = 187 * MiB;
constexpr size_t WS_XN = 188 * MiB;
constexpr size_t WS_ZF = 221 * MiB;
constexpr size_t WS_CQN = 254 * MiB;
constexpr size_t WS_KV = 263 * MiB;
constexpr size_t WS_KI = 268 * MiB;
constexpr size_t WS_WI = 271 * MiB;
constexpr size_t WS_LIF = 272 * MiB;
constexpr size_t WS_G = 273 * MiB;
constexpr size_t WS_QKC = 306 * MiB;
constexpr size_t WS_QQ = 339 * MiB;
constexpr size_t WS_OG = 420 * MiB;
constexpr size_t WS_OM = 453 * MiB;
constexpr size_t WS_OD = 486 * MiB;
constexpr size_t WS_Z = 551 * MiB;
constexpr size_t WS_MIX = 840 * MiB;
constexpr size_t WS_Y = 873 * MiB;
constexpr size_t WS_SC = 840 * MiB;
constexpr size_t WS_DD = 1020 * MiB;
constexpr size_t WS_END = 1024 * MiB;
constexpr int SC_PITCH = 2080;
static_assert(WS_Z + (size_t)MT * ZB * 2 <= WS_MIX && WS_Y + (size_t)MT * D * 4 <= WS_END && WS_SC + (size_t)256 * 64 * SC_PITCH * 4 <= WS_END, "ws map");

constexpr int CW_BAR = 4096;

constexpr int RING_BYTES = 131072;
constexpr int MISC_OFF = RING_BYTES + 320;
constexpr int LDS_BYTES = 147456;
constexpr int NWAVES = 8;

#define LAS __attribute__((address_space(3)))
typedef unsigned short bf16;
typedef float f32x4 __attribute__((ext_vector_type(4)));
typedef float f32x2 __attribute__((ext_vector_type(2)));
typedef unsigned u32x4 __attribute__((ext_vector_type(4)));
typedef unsigned u32x2 __attribute__((ext_vector_type(2)));
typedef short bf16x8 __attribute__((ext_vector_type(8)));
typedef short s16x4 __attribute__((ext_vector_type(4)));
#define LDS_WAIT() asm volatile("s_waitcnt lgkmcnt(0)" ::: "memory")
#define VM_WAIT() asm volatile("s_waitcnt vmcnt(0)" ::: "memory")

typedef __bf16 hwbf16x2 __attribute__((ext_vector_type(2)));
__device__ __forceinline__ unsigned pk2(float lo, float hi) { const f32x2 v = {lo, hi}; const hwbf16x2 b = __builtin_convertvector(v, hwbf16x2); return __builtin_bit_cast(unsigned, b); }
__device__ __forceinline__ unsigned f2bf(float f) { return pk2(f, 0.f) & 0xffffu; }
__device__ __forceinline__ float bf2f(unsigned b) { return __builtin_bit_cast(float, b << 16); }
__device__ __forceinline__ float bflo(unsigned w) { return __builtin_bit_cast(float, w << 16); }
__device__ __forceinline__ float bfhi(unsigned w) { return __builtin_bit_cast(float, w & 0xffff0000u); }
__device__ __forceinline__ float wave_sum(float v) {
#pragma unroll
    for (int o = 1; o < 64; o <<= 1) v += __shfl_xor(v, o);
    return v;
}
__device__ __forceinline__ float wave_max(float v) {
#pragma unroll
    for (int o = 1; o < 64; o <<= 1) v = fmaxf(v, __shfl_xor(v, o));
    return v;
}
__device__ __forceinline__ float sigmoid_f(float x) { return __builtin_amdgcn_rcpf(1.f + __builtin_amdgcn_exp2f(-1.4426950408889634f * x)); }
__device__ __forceinline__ float silu_f(float x) { return x * sigmoid_f(x); }
__device__ __forceinline__ float logsigmoid_f(float x) { return fminf(x, 0.f) - log1pf(__expf(-fabsf(x))); }

#define XB_TMO      128
#define XB_XCNT(j)  (256  + 64 * (j))
#define XB_XSUB(j)  (1280 + 64 * (j))
#define XB_XGEN(j)  (2304 + 64 * (j))
#define XB_TOP      3328
#define XB_TOPGEN   3392
#define XCD_BAR_WORDS 3456
#define XB_SPIN_CAP (1u << 22)

__device__ __forceinline__ unsigned xb_ld(unsigned* p)              { return __hip_atomic_load(p, __ATOMIC_RELAXED, __HIP_MEMORY_SCOPE_AGENT); }
__device__ __forceinline__ unsigned xb_add(unsigned* p, unsigned v) { return __hip_atomic_fetch_add(p, v, __ATOMIC_RELAXED, __HIP_MEMORY_SCOPE_AGENT); }
__device__ __forceinline__ unsigned xb_xcc_id() { return (unsigned)__builtin_amdgcn_s_getreg((3 << 11) | 20) & 0xFu; }
#define XB_SPIN(cond, bar) do { unsigned _sp = 0; while (cond) { __builtin_amdgcn_s_sleep(1); \
    if ((++_sp & 255u) == 0u) { if (xb_ld(&(bar)[XB_TMO])) break; if (_sp > XB_SPIN_CAP) { atomicAdd(&(bar)[XB_TMO], 1u); break; } } } } while (0)

struct XcdBarrier {
    unsigned* bar; unsigned x;
    volatile LAS unsigned* st;
};

__device__ __forceinline__ XcdBarrier xcd_barrier_post(unsigned* bar, volatile LAS unsigned* st) {
    XcdBarrier b; b.bar = bar; b.x = xb_xcc_id(); b.st = st;
    if (threadIdx.x == 0) (void)xb_add(&bar[XB_XCNT(b.x)], 1u);
    return b;
}
__device__ __forceinline__ void xcd_barrier_complete(unsigned* bar, unsigned x, unsigned& nloc, unsigned& nx) {
    const unsigned G = gridDim.x * gridDim.y * gridDim.z;
    unsigned sum, cnt, mine, sp = 0u;
    for (;;) {
        sum = 0u; cnt = 0u; mine = 0u;
#pragma unroll
        for (unsigned j = 0; j < 16; ++j) { const unsigned c = xb_ld(&bar[XB_XCNT(j)]); sum += c; cnt += (c > 0u) ? 1u : 0u; mine = (j == x) ? c : mine; }
        if (sum == G) break;
        __builtin_amdgcn_s_sleep(1);
        if ((++sp & 255u) == 0u) { if (xb_ld(&bar[XB_TMO])) break; if (sp > XB_SPIN_CAP) { atomicAdd(&bar[XB_TMO], 1u); break; } }
    }
    nloc = mine > 0u ? mine : 1u; nx = cnt > 0u ? cnt : 1u;
}

__device__ __forceinline__ void xcd_barrier(const XcdBarrier& b) {
    asm volatile("s_waitcnt vmcnt(0)" ::: "memory");
    __syncthreads();
    if (threadIdx.x == 0) {
        unsigned* bar = b.bar;
        __builtin_amdgcn_s_waitcnt(0);
        unsigned nloc = b.st[0], nx = b.st[1];
        if (nloc == 0u) { xcd_barrier_complete(bar, b.x, nloc, nx); b.st[0] = nloc; b.st[1] = nx; }
        const unsigned old = xb_add(&bar[XB_XSUB(b.x)], 1u);
        const unsigned gen = old / nloc;
        if (old + 1u == (gen + 1u) * nloc) {
            __builtin_amdgcn_fence(__ATOMIC_RELEASE, "agent");
            asm volatile("s_waitcnt vmcnt(0)" ::: "memory");
            const unsigned og = xb_add(&bar[XB_TOP], 1u);
            const unsigned tg = og / nx;
            if (og + 1u == (tg + 1u) * nx) xb_add(&bar[XB_TOPGEN], 1u);
            else XB_SPIN(xb_ld(&bar[XB_TOPGEN]) == tg, bar);
            __builtin_amdgcn_fence(__ATOMIC_ACQUIRE, "agent");
            xb_add(&bar[XB_XGEN(b.x)], 1u);
            asm volatile("s_waitcnt vmcnt(0)" ::: "memory");
        } else {
            XB_SPIN(xb_ld(&bar[XB_XGEN(b.x)]) == gen, bar);
            __builtin_amdgcn_fence(__ATOMIC_ACQUIRE, "agent");
            asm volatile("s_waitcnt vmcnt(0)" ::: "memory");
        }
    }
    __syncthreads();
}


struct Args { const float* in[28]; float* out; unsigned char* ws; int g_lo, g_hi, l_lo, l_hi, ph_lo, ph_hi, prep, use_bar; };
typedef const __attribute__((address_space(4))) Args* ArgsP;
enum { I_X = 0, I_META, I_T5, I_GPREMIX, I_WIN, I_BIN, I_WA2, I_BA, I_GGLA, I_WBRG, I_GDQ, I_WUQ, I_WIQ, I_GDKV, I_WUV, I_LNG, I_LNB, I_WBRD,
       I_CONV, I_FB, I_GML, I_WBRM, I_WOUT, I_GPOSTMIX, I_GPREMLP, I_WUP, I_WDN, I_GPOSTMLP };

__device__ __forceinline__ int win_src(int n) {
    if (n < 3072) return n;
    if (n < 6144) return n - 3072 + 3544;
    if (n < 9216) return n - 6144 + 6624;
    if (n < 9472) return n - 9216 + 3088;
    if (n < 9600) return n - 9472 + 3344;
    if (n < 9664) return n - 9600 + 3472;
    if (n < 9680) return n - 9664 + 3072;
    if (n < 9688) return n - 9680 + 3536;
    if (n < 9692) return n - 9688 + 6616;
    if (n < 9696) return n - 9692 + 6620;
    return -1;
}
struct CmIdent { __device__ __forceinline__ int operator()(int n) const { return n; } };
struct CmWin { __device__ __forceinline__ int operator()(int n) const { return win_src(n); } };

template <class CM>
__device__ __forceinline__ void tr_item(const float* __restrict__ W, int ldw, bf16* __restrict__ WT, int Kd, LAS float* scr, int k0, int ns0, int nd0, int lane, CM cm) {
    const int sc = cm(ns0 + (lane & 31));
#pragma unroll 8
    for (int i = 0; i < 32; ++i) { const int kk = 2 * i + (lane >> 5); scr[kk * 33 + (lane & 31)] = sc >= 0 ? W[(size_t)(k0 + kk) * ldw + sc] : 0.f; }
    LDS_WAIT();
    const int c = lane & 7;
#pragma unroll
    for (int j = 0; j < 4; ++j) { const int n = (lane >> 3) + 8 * j; const LAS float* s = scr + (8 * c) * 33 + n;
        u32x4 o; o.x = pk2(s[0 * 33], s[1 * 33]); o.y = pk2(s[2 * 33], s[3 * 33]); o.z = pk2(s[4 * 33], s[5 * 33]); o.w = pk2(s[6 * 33], s[7 * 33]);
        *(u32x4*)(WT + (size_t)(nd0 + n) * Kd + k0 + 8 * c) = o; }
    LDS_WAIT();
}

__device__ __forceinline__ void prep_weights(ArgsP a, LAS unsigned char* lds, int gw, int ngw, int wave, int lane) {
    LAS float* scr = (LAS float*)(lds + wave * 16384);
    unsigned char* ws = a->ws;
    constexpr int I_WIN_N = 16 * 304, I_UQ = 4 * 64, I_IQ = 4 * 16, I_SQ = 16 * 32, I_UP = 16 * 128, I_DN = 64 * 32, I_WBD = 512, I_B = NZ / 64;
    constexpr int PER_L = I_WIN_N + I_UQ + I_IQ + 3 * I_SQ + I_UP + I_DN + I_WBD + I_B;
    for (int it = gw; it < NL * PER_L; it += ngw) {
        const int l = it / PER_L; int r = it % PER_L;
        if (r < I_WIN_N) { const int kb = r / 304, nb = r % 304;
            tr_item(a->in[I_WIN] + (size_t)l * D * NCOLS, NCOLS, (bf16*)(ws + WS_WIN) + (size_t)l * NZ * D, D, scr, kb * 64, nb * 32, nb * 32, lane, CmWin()); continue; }
        r -= I_WIN_N;
        if (r < I_UQ) { const int kb = r / 64, nb = r % 64;
            tr_item(a->in[I_WUQ] + (size_t)l * 256 * 2048, 2048, (bf16*)(ws + WS_WQQ) + (size_t)l * NQQ * 256, 256, scr, kb * 64, nb * 32, nb * 32, lane, CmIdent()); continue; }
        r -= I_UQ;
        if (r < I_IQ) { const int kb = r / 16, nb = r % 16;
            tr_item(a->in[I_WIQ] + (size_t)l * 256 * 512, 512, (bf16*)(ws + WS_WQQ) + (size_t)l * NQQ * 256, 256, scr, kb * 64, nb * 32, 2048 + nb * 32, lane, CmIdent()); continue; }
        r -= I_IQ;
        if (r < I_SQ) { const int kb = r / 32, nb = r % 32;
            tr_item(a->in[I_WBRG] + (size_t)l * D * D, D, (bf16*)(ws + WS_WBG) + (size_t)l * D * D, D, scr, kb * 64, nb * 32, nb * 32, lane, CmIdent()); continue; }
        r -= I_SQ;
        if (r < I_SQ) { const int kb = r / 32, nb = r % 32;
            tr_item(a->in[I_WBRM] + (size_t)l * D * D, D, (bf16*)(ws + WS_WBM) + (size_t)l * D * D, D, scr, kb * 64, nb * 32, nb * 32, lane, CmIdent()); continue; }
        r -= I_SQ;
        if (r < I_SQ) { const int kb = r / 32, nb = r % 32;
            tr_item(a->in[I_WOUT] + (size_t)l * D * D, D, (bf16*)(ws + WS_WOUT) + (size_t)l * D * D, D, scr, kb * 64, nb * 32, nb * 32, lane, CmIdent()); continue; }
        r -= I_SQ;
        if (r < I_UP) { const int kb = r / 128, nb = r % 128;
            tr_item(a->in[I_WUP] + (size_t)l * D * DFF, DFF, (bf16*)(ws + WS_WUP) + (size_t)l * DFF * D, D, scr, kb * 64, nb * 32, nb * 32, lane, CmIdent()); continue; }
        r -= I_UP;
        if (r < I_DN) { const int kb = r / 32, nb = r % 32;
            tr_item(a->in[I_WDN] + (size_t)l * DFF * D, D, (bf16*)(ws + WS_WDN) + (size_t)l * D * DFF, DFF, scr, kb * 64, nb * 32, nb * 32, lane, CmIdent()); continue; }
        r -= I_DN;
        if (r < I_WBD) {
            const int h = r >> 5, ch = (r >> 4) & 1, nb = r & 15, c = ch * 64 + lane;
            const float* uv = a->in[I_WUV] + ((size_t)(l * 16 + h) * 128 + c) * 64;
            const float* wb = a->in[I_WBRD] + ((size_t)l * D + h * 64) * D + nb * 64;
            bf16* o = (bf16*)(ws + WS_WBD) + (size_t)l * D * 2048 + (size_t)(h >> 3) * D * D + (size_t)(nb * 64) * D + (h & 7) * 128 + c;
            f32x4 w[16];
#pragma unroll
            for (int i = 0; i < 16; ++i) w[i] = *(const f32x4*)(uv + 4 * i);
            for (int nn = 0; nn < 64; ++nn) {
                float acc = 0.f;
#pragma unroll
                for (int i = 0; i < 16; ++i) { acc += w[i].x * wb[(size_t)(4 * i + 0) * D + nn] + w[i].y * wb[(size_t)(4 * i + 1) * D + nn] + w[i].z * wb[(size_t)(4 * i + 2) * D + nn] + w[i].w * wb[(size_t)(4 * i + 3) * D + nn]; }
                o[(size_t)nn * D] = (bf16)f2bf(acc);
            }
            continue; }
        r -= I_WBD;
        { const int n = r * 64 + lane; const int sc = win_src(n);
          ((float*)(ws + WS_BIN))[l * NZ + n] = sc >= 0 ? a->in[I_BIN][l * NCOLS + sc] : 0.f; }
    }
}

__device__ __forceinline__ float* hrow(ArgsP a, int g, int r) {
    return r < MR ? a->out + ((size_t)g * MR + r) * D : (float*)(a->ws + WS_HM) + (size_t)(r - MR) * D;
}
__device__ __forceinline__ void rms_row_bf16(const f32x4 (&v)[4], const float* __restrict__ gain, bf16* __restrict__ orow, int lane) {
    float s = 0.f;
#pragma unroll
    for (int j = 0; j < 4; ++j) s += (v[j].x * v[j].x + v[j].y * v[j].y) + (v[j].z * v[j].z + v[j].w * v[j].w);
    const float r = rsqrtf(wave_sum(s) * (1.f / D) + EPS);
#pragma unroll
    for (int j = 0; j < 4; ++j) { const f32x4 gg = *(const f32x4*)(gain + 4 * lane + 256 * j); const f32x4 o = v[j] * r * gg;
        u32x2 w; w.x = pk2(o.x, o.y); w.y = pk2(o.z, o.w); *(u32x2*)(orow + 4 * lane + 256 * j) = w; }
}
__device__ __forceinline__ void p0_init(ArgsP a, int g, int gw, int ngw, int lane) {
    bf16* XN = (bf16*)(a->ws + WS_XN);
    for (int r = gw; r < MT; r += ngw) {
        const float* src = r < MR ? a->in[I_X] + ((size_t)g * MR + r) * D : a->in[I_META] + (size_t)(r - MR) * D;
        float* hd = hrow(a, g, r);
        f32x4 v[4];
#pragma unroll
        for (int j = 0; j < 4; ++j) { v[j] = *(const f32x4*)(src + 4 * lane + 256 * j); *(f32x4*)(hd + 4 * lane + 256 * j) = v[j]; }
        rms_row_bf16(v, a->in[I_GPREMIX], XN + (size_t)r * D, lane);
    }
}
template <bool DRY = false>
__device__ __forceinline__ void p_norm_res(ArgsP a, int g, const float* gpost, const float* gpre, int gw, int ngw, int lane) {
    bf16* XN = (bf16*)(a->ws + (DRY ? WS_Z + 100 * MiB : WS_XN)); const bf16* Y = (const bf16*)(a->ws + WS_Y);
    for (int r = gw; r < MT; r += ngw) {
        float* hd = hrow(a, g, r); float* hw = DRY ? (float*)(a->ws + WS_Z) + (size_t)r * D : hd;
        f32x4 y[4], v[4]; float s = 0.f;
#pragma unroll
        for (int j = 0; j < 4; ++j) { { const u32x2 yw = *(const u32x2*)(Y + (size_t)r * D + 4 * lane + 256 * j); y[j] = (f32x4){bflo(yw.x), bfhi(yw.x), bflo(yw.y), bfhi(yw.y)}; } v[j] = *(const f32x4*)(hd + 4 * lane + 256 * j);
            s += (y[j].x * y[j].x + y[j].y * y[j].y) + (y[j].z * y[j].z + y[j].w * y[j].w); }
        const float rr = rsqrtf(wave_sum(s) * (1.f / D) + EPS);
#pragma unroll
        for (int j = 0; j < 4; ++j) { const f32x4 gg = *(const f32x4*)(gpost + 4 * lane + 256 * j); v[j] = v[j] + y[j] * rr * gg; *(f32x4*)(hw + 4 * lane + 256 * j) = v[j]; }
        if (gpre) rms_row_bf16(v, gpre, XN + (size_t)r * D, lane);
    }
}

template <class F> struct EpiT {
    static constexpr bool PERM = true, AFTER_DRAIN = false;
    F f;
    __device__ __forceinline__ void operator()(const f32x4 (&acc)[2][2][4][2], const pg8::Unit& u, int wr, int wc, int fr, int fq) const {
        const int row0 = u.pm * 256 + wr * 64 + fr, col0 = u.pn * 256 + wc * 32 + 8 * fq;
        if constexpr (F::HAS_BIAS) {
            const f32x4 b00 = *(const f32x4*)(f.bias + col0), b01 = *(const f32x4*)(f.bias + col0 + 4), b10 = *(const f32x4*)(f.bias + col0 + 128), b11 = *(const f32x4*)(f.bias + col0 + 132);
#pragma unroll
            for (int ai = 0; ai < 2; ++ai)
#pragma unroll
                for (int m = 0; m < 4; ++m) { f.apply(row0 + ai * 128 + m * 16, col0, acc[ai][0][m][0] + b00, acc[ai][0][m][1] + b01); f.apply(row0 + ai * 128 + m * 16, col0 + 128, acc[ai][1][m][0] + b10, acc[ai][1][m][1] + b11); }
            return;
        }
#pragma unroll
        for (int ai = 0; ai < 2; ++ai)
#pragma unroll
            for (int m = 0; m < 4; ++m)
#pragma unroll
                for (int bj = 0; bj < 2; ++bj) f.apply(row0 + ai * 128 + m * 16, col0 + bj * 128, acc[ai][bj][m][0], acc[ai][bj][m][1]);
    }
};
__device__ __forceinline__ void st_bf16x8(bf16* p, f32x4 v0, f32x4 v1) { u32x4 w; w.x = pk2(v0.x, v0.y); w.y = pk2(v0.z, v0.w); w.z = pk2(v1.x, v1.y); w.w = pk2(v1.z, v1.w); *(u32x4*)p = w; }
__device__ __forceinline__ void ld_bf16x8(const bf16* p, f32x4& v0, f32x4& v1) { const u32x4 w = *(const u32x4*)p;
    v0 = (f32x4){bflo(w.x), bfhi(w.x), bflo(w.y), bfhi(w.y)}; v1 = (f32x4){bflo(w.z), bfhi(w.z), bflo(w.w), bfhi(w.w)}; }

struct FIn {
    static constexpr bool HAS_BIAS = true;
    bf16* Z; float* ZF; const float* bias;
    __device__ __forceinline__ void apply(int row, int col, f32x4 v0, f32x4 v1) const {
        const int t = col >> 8;
        if (t >= 36) { float* p = ZF + (size_t)row * ZFW + (col - ZB); *(f32x4*)p = v0; *(f32x4*)(p + 4) = v1; return; }
        if (t < 2) { v0 *= 0.08838834764831845f; v1 *= 0.08838834764831845f; }
        else if (t >= 8 && t < 12) {
#pragma unroll
            for (int i = 0; i < 4; ++i) { v0[i] = silu_f(v0[i]); v1[i] = silu_f(v1[i]); } }
        else if (t >= 20) {
#pragma unroll
            for (int i = 0; i < 4; ++i) { v0[i] = sigmoid_f(v0[i]); v1[i] = sigmoid_f(v1[i]); } }
        st_bf16x8(Z + (size_t)row * ZB + col, v0, v1);
    }
};
struct FQQ {
    static constexpr bool HAS_BIAS = false;
    bf16* QQ;
    __device__ __forceinline__ void apply(int row, int col, f32x4 v0, f32x4 v1) const {
        const float s = col < 2048 ? 0.08838834764831845f : 0.125f;
        st_bf16x8(QQ + (size_t)row * NQQ + col, v0 * s, v1 * s);
    }
};
template <int IDX> struct FBr {
    static constexpr bool HAS_BIAS = false;
    const bf16* Z; float* Y; bf16* MIX;
    __device__ __forceinline__ void apply(int row, int col, f32x4 v0, f32x4 v1) const {
        f32x4 g0, g1; ld_bf16x8(Z + (size_t)row * ZB + ZC_GATE + IDX * 1024 + col, g0, g1);
        float* y = Y + (size_t)row * D + col;
        f32x4 a0 = v0 * g0, a1 = v1 * g1;
        if (IDX > 0) { a0 += *(const f32x4*)y; a1 += *(const f32x4*)(y + 4); }
        if (IDX < 2) { *(f32x4*)y = a0; *(f32x4*)(y + 4) = a1; }
        else st_bf16x8(MIX + (size_t)row * D + col, a0, a1);
    }
};
struct FY {
    static constexpr bool HAS_BIAS = false;
    bf16* Y;
    __device__ __forceinline__ void apply(int row, int col, f32x4 v0, f32x4 v1) const { st_bf16x8(Y + (size_t)row * D + col, v0, v1); }
};
struct FUp {
    static constexpr bool HAS_BIAS = false;
    bf16* U;
    __device__ __forceinline__ void apply(int row, int col, f32x4 v0, f32x4 v1) const {
#pragma unroll
        for (int i = 0; i < 4; ++i) { const float p = fmaxf(v0[i], 0.f), q = fmaxf(v1[i], 0.f); v0[i] = p * p; v1[i] = q * q; }
        st_bf16x8(U + (size_t)row * DFF + col, v0, v1);
    }
};

template <class F>
__device__ __forceinline__ void mini_gemm(const bf16* __restrict__ A, const bf16* __restrict__ Bt, int N, int K, const F& f, int gw, int ngw, int lane) {
    const int fr = lane & 15, fq = lane >> 4;
    for (int wt = gw; wt < N / 32; wt += ngw) {
        const int n0 = wt * 32;
        f32x4 acc0 = {0.f, 0.f, 0.f, 0.f}, acc1 = {0.f, 0.f, 0.f, 0.f};
        const bf16* ap = A + (size_t)(MR + fr) * K + fq * 8;
        const bf16* b0 = Bt + (size_t)(n0 + pg8::perm32(fr)) * K + fq * 8;
        const bf16* b1 = Bt + (size_t)(n0 + pg8::perm32(16 + fr)) * K + fq * 8;
        for (int k = 0; k < K; k += 256) {
            bf16x8 av[8], w0[8], w1[8];
#pragma unroll
            for (int u = 0; u < 8; ++u) { av[u] = *(const bf16x8*)(ap + k + 32 * u); w0[u] = *(const bf16x8*)(b0 + k + 32 * u); w1[u] = *(const bf16x8*)(b1 + k + 32 * u); }
#pragma unroll
            for (int u = 0; u < 8; ++u) {
                acc0 = __builtin_amdgcn_mfma_f32_16x16x32_bf16(w0[u], av[u], acc0, 0, 0, 0);
                acc1 = __builtin_amdgcn_mfma_f32_16x16x32_bf16(w1[u], av[u], acc1, 0, 0, 0);
            }
        }
        if constexpr (F::HAS_BIAS) { acc0 += *(const f32x4*)(f.bias + n0 + 8 * fq); acc1 += *(const f32x4*)(f.bias + n0 + 8 * fq + 4); }
        f.apply(MR + fr, n0 + 8 * fq, acc0, acc1);
    }
}
template <class F, bool ALIGN = true>
__device__ __forceinline__ void run_gemm(LAS unsigned char* lds, const bf16* A, const bf16* Bt, int N, int K, const F& f, int gw, int ngw, int lane) {
    asm volatile("" : "+s"(K)); asm volatile("" : "+s"(N));
    pg8::Gemm g{A, Bt, MR, N, K}; pg8::StaticOrder S; S.init(MR, N, (int)gridDim.x, (int)blockIdx.x);
    EpiT<F> E{f};
    pg8::gemm_phase<EpiT<F>, pg8::StaticOrder, ALIGN, true>((PG8_LAS unsigned char*)lds, g, S, E);
    mini_gemm(A, Bt, N, K, f, gw, ngw, lane);
}

struct ChainOrder {
    pg8::StaticOrder S;
    __device__ __forceinline__ bool next(int i, pg8::Unit& u) const { if (!S.next(i >> 2, u)) return false; u.sub = i & 3; return true; }
    __device__ __forceinline__ void a_ready(const pg8::Unit&) const {}
    __device__ __forceinline__ void done(const pg8::Unit&) const {}
};
struct EpiMix {
    static constexpr bool PERM = true, AFTER_DRAIN = false;
    const bf16* Z; bf16* MIX;
    __device__ __forceinline__ void mid(f32x4 (&acc)[2][2][4][2], const pg8::Unit& u, int wr, int wc, int fr, int fq) const {
        if (u.sub == 1) return;
        const int gi = u.sub == 0 ? 0 : 1;
        const int row0 = u.pm * 256 + wr * 64 + fr, col0 = u.pn * 256 + wc * 32 + 8 * fq;
#pragma unroll
        for (int ai = 0; ai < 2; ++ai) {
            u32x4 ga[4][2], gb[4][2];
#pragma unroll
            for (int m = 0; m < 4; ++m)
#pragma unroll
                for (int bj = 0; bj < 2; ++bj) { const bf16* gp = Z + (size_t)(row0 + ai * 128 + m * 16) * ZB + ZC_GATE + gi * 1024 + col0 + bj * 128;
                    ga[m][bj] = *(const u32x4*)gp; gb[m][bj] = *(const u32x4*)(gp + 1024); }
#pragma unroll
            for (int m = 0; m < 4; ++m)
#pragma unroll
                for (int bj = 0; bj < 2; ++bj) {
                    const u32x4 a = ga[m][bj], b = gb[m][bj];
                    f32x4 r0, r1;
                    r0.x = bflo(a.x) * __builtin_amdgcn_rcpf(bflo(b.x)); r0.y = bfhi(a.x) * __builtin_amdgcn_rcpf(bfhi(b.x)); r0.z = bflo(a.y) * __builtin_amdgcn_rcpf(bflo(b.y)); r0.w = bfhi(a.y) * __builtin_amdgcn_rcpf(bfhi(b.y));
                    r1.x = bflo(a.z) * __builtin_amdgcn_rcpf(bflo(b.z)); r1.y = bfhi(a.z) * __builtin_amdgcn_rcpf(bfhi(b.z)); r1.z = bflo(a.w) * __builtin_amdgcn_rcpf(bflo(b.w)); r1.w = bfhi(a.w) * __builtin_amdgcn_rcpf(bfhi(b.w));
                    acc[ai][bj][m][0] *= r0; acc[ai][bj][m][1] *= r1;
                }
            asm volatile("" ::: "memory");
        }
    }
    __device__ __forceinline__ void operator()(const f32x4 (&acc)[2][2][4][2], const pg8::Unit& u, int wr, int wc, int fr, int fq) const {
        const int row0 = u.pm * 256 + wr * 64 + fr, col0 = u.pn * 256 + wc * 32 + 8 * fq;
#pragma unroll
        for (int ai = 0; ai < 2; ++ai) {
            u32x4 gc[4][2];
#pragma unroll
            for (int m = 0; m < 4; ++m)
#pragma unroll
                for (int bj = 0; bj < 2; ++bj) gc[m][bj] = *(const u32x4*)(Z + (size_t)(row0 + ai * 128 + m * 16) * ZB + ZC_GATE + 2 * 1024 + col0 + bj * 128);
#pragma unroll
            for (int m = 0; m < 4; ++m)
#pragma unroll
                for (int bj = 0; bj < 2; ++bj) {
                    const u32x4 w = gc[m][bj];
                    const f32x4 g0 = {bflo(w.x), bfhi(w.x), bflo(w.y), bfhi(w.y)}, g1 = {bflo(w.z), bfhi(w.z), bflo(w.w), bfhi(w.w)};
                    st_bf16x8(MIX + (size_t)(row0 + ai * 128 + m * 16) * D + col0 + bj * 128, acc[ai][bj][m][0] * g0, acc[ai][bj][m][1] * g1);
                }
            asm volatile("" ::: "memory");
        }
    }
};

__device__ __forceinline__ int prow(int r, int j) {
    if (r < MR) { const int s = r & (SEQ - 1); return (s - j >= 0) ? r - j : MR + (NMETA + s - j); }
    const int t = r - MR; return (t - j >= 0) ? r - j : -1;
}
__device__ __forceinline__ void p2_prep(ArgsP a, int l, int gw, int ngw, int lane) {
    unsigned char* ws = a->ws;
    const bf16* Z = (const bf16*)(ws + WS_Z);
    for (int r = gw; r < MT; r += ngw) {
        const float* zf = (const float*)(ws + WS_ZF) + (size_t)r * ZFW;
        {
            f32x4 v = *(const f32x4*)(zf + ZF_CQ + 4 * lane);
            const float rr = rsqrtf(wave_sum((v.x * v.x + v.y * v.y) + (v.z * v.z + v.w * v.w)) * (1.f / 256.f) + EPS);
            const f32x4 gg = *(const f32x4*)(a->in[I_GDQ] + l * 256 + 4 * lane); v = v * rr * gg;
            u32x2 w; w.x = pk2(v.x, v.y); w.y = pk2(v.z, v.w); *(u32x2*)((bf16*)(ws + WS_CQN) + (size_t)r * 256 + 4 * lane) = w;
        }
        {
            f32x2 v = *(const f32x2*)(zf + ZF_CKV + 2 * lane);
            const float rr = rsqrtf(wave_sum(v.x * v.x + v.y * v.y) * (1.f / 128.f) + EPS);
            const f32x2 gg = *(const f32x2*)(a->in[I_GDKV] + l * 128 + 2 * lane);
            *(unsigned*)((bf16*)(ws + WS_KV) + (size_t)r * 128 + 2 * lane) = pk2(v.x * rr * gg.x, v.y * rr * gg.y);
        }
        {
            const float v = zf[ZF_IK + lane]; const float mu = wave_sum(v) * (1.f / 64.f); const float d = v - mu;
            const float var = wave_sum(d * d) * (1.f / 64.f);
            const float y = d * rsqrtf(var + EPS) * a->in[I_LNG][l * 64 + lane] + a->in[I_LNB][l * 64 + lane];
            ((bf16*)(ws + WS_KI))[(size_t)r * 64 + lane] = (bf16)f2bf(y);
        }
        if (lane < 8) ((float*)(ws + WS_WI))[(size_t)r * 8 + lane] = zf[ZF_IW + lane] * 0.35355339059327373f;
    }
    float* DDp = (float*)(ws + WS_DD);
    for (int it = gw; it < 257 * 8; it += ngw) {
        const int cid = it >> 3, mx = (it >> 2) & 1, h = it & 3;
        const int nrows = cid == 256 ? NMETA : 64, rbase = cid == 256 ? MR : cid * 64;
        const int k0 = 2 * lane;
        if (!mx) {
            float w0[16], w1[16];
#pragma unroll
            for (int j = 0; j < 16; ++j) { const f32x2 w = *(const f32x2*)(a->in[I_WA2] + (size_t)(l * 16 + j) * 512 + h * 128 + k0); w0[j] = w.x; w1[j] = w.y; }
            const f32x2 bb = *(const f32x2*)(a->in[I_BA] + l * 512 + h * 128 + k0);
            bf16* __restrict__ QG = (bf16*)(ws + WS_G);
            const bf16* __restrict__ Zr = Z; const float* __restrict__ ZFr = (const float*)(ws + WS_ZF);
            float G0 = 0.f, G1 = 0.f;
            f32x4 pa[4][4]; unsigned pq[4], pk[4];
#define P2G_LOAD(t0) do { _Pragma("unroll") for (int i = 0; i < 4; ++i) { const int r_ = rbase + (t0) + i; const float* zf_ = ZFr + (size_t)r_ * ZFW + ZF_A; \
                pa[i][0] = *(const f32x4*)zf_; pa[i][1] = *(const f32x4*)(zf_ + 4); pa[i][2] = *(const f32x4*)(zf_ + 8); pa[i][3] = *(const f32x4*)(zf_ + 12); \
                pq[i] = *(const unsigned*)(Zr + (size_t)r_ * ZB + ZC_GQ + h * 128 + k0); pk[i] = *(const unsigned*)(Zr + (size_t)r_ * ZB + ZC_GK + h * 128 + k0); } } while (0)
            P2G_LOAD(0);
            for (int t0 = 0; t0 < nrows; t0 += 4) {
                f32x4 ca[4][4]; unsigned cqw[4], ckw[4];
#pragma unroll
                for (int i = 0; i < 4; ++i) { ca[i][0] = pa[i][0]; ca[i][1] = pa[i][1]; ca[i][2] = pa[i][2]; ca[i][3] = pa[i][3]; cqw[i] = pq[i]; ckw[i] = pk[i]; }
                if (t0 + 4 < nrows) P2G_LOAD(t0 + 4);
#pragma unroll
                for (int i = 0; i < 4; ++i) {
                    const int r = rbase + t0 + i;
                    const float av[16] = {ca[i][0].x, ca[i][0].y, ca[i][0].z, ca[i][0].w, ca[i][1].x, ca[i][1].y, ca[i][1].z, ca[i][1].w, ca[i][2].x, ca[i][2].y, ca[i][2].z, ca[i][2].w, ca[i][3].x, ca[i][3].y, ca[i][3].z, ca[i][3].w};
                    float s0 = bb.x, s1 = bb.y;
#pragma unroll
                    for (int j = 0; j < 16; ++j) { s0 += av[j] * w0[j]; s1 += av[j] * w1[j]; }
                    G0 += logsigmoid_f(s0) * 0.0625f; G1 += logsigmoid_f(s1) * 0.0625f;
                    const float e0 = __expf(G0), e1 = __expf(G1), i0 = __expf(-G0), i1 = __expf(-G1);
                    *(unsigned*)(QG + (size_t)r * 1024 + h * 128 + k0) = pk2(bflo(cqw[i]) * e0, bfhi(cqw[i]) * e1);
                    *(unsigned*)(QG + (size_t)r * 1024 + 512 + h * 128 + k0) = pk2(bflo(ckw[i]) * i0, bfhi(ckw[i]) * i1);
                }
            }
#undef P2G_LOAD
            *(f32x2*)(DDp + ((size_t)cid * 4 + h) * 128 + k0) = (f32x2){__expf(G0), __expf(G1)};
        } else {
            float cq[4][2], ck[4][2];
#pragma unroll
            for (int tap = 0; tap < 4; ++tap) { const f32x2 wq = *(const f32x2*)(a->in[I_CONV] + (size_t)(l * 4 + tap) * 1024 + h * 128 + k0), wk = *(const f32x2*)(a->in[I_CONV] + (size_t)(l * 4 + tap) * 1024 + 512 + h * 128 + k0);
                cq[tap][0] = wq.x; cq[tap][1] = wq.y; ck[tap][0] = wk.x; ck[tap][1] = wk.y; }
            const float fb = a->in[I_FB][l * 4 + h];
            bf16* __restrict__ QM = (bf16*)(ws + WS_QKC);
            const bf16* __restrict__ Zr = Z; const float* __restrict__ ZFr = (const float*)(ws + WS_ZF);
            float xq[3][2], xk[3][2];
#pragma unroll
            for (int j = 0; j < 3; ++j) {
                const int rp = prow(rbase, j + 1);
                unsigned qw = 0u, kw = 0u;
                if (rp >= 0) { qw = *(const unsigned*)(Z + (size_t)rp * ZB + ZC_MQ + h * 128 + k0); kw = *(const unsigned*)(Z + (size_t)rp * ZB + ZC_MK + h * 128 + k0); }
                xq[j][0] = bflo(qw); xq[j][1] = bfhi(qw); xk[j][0] = bflo(kw); xk[j][1] = bfhi(kw);
            }
            float bsum = 0.f;
            float pli[4], plf[4]; unsigned pq[4], pk[4];
#define P2M_LOAD(t0) do { _Pragma("unroll") for (int i = 0; i < 4; ++i) { const int r_ = rbase + (t0) + i; const float* zf_ = ZFr + (size_t)r_ * ZFW; \
                pli[i] = zf_[ZF_MI + h]; plf[i] = zf_[ZF_MF + h]; \
                pq[i] = *(const unsigned*)(Zr + (size_t)r_ * ZB + ZC_MQ + h * 128 + k0); pk[i] = *(const unsigned*)(Zr + (size_t)r_ * ZB + ZC_MK + h * 128 + k0); } } while (0)
            P2M_LOAD(0);
            for (int t0 = 0; t0 < nrows; t0 += 4) {
                float cli[4], clf[4]; unsigned cqw[4], ckw[4];
#pragma unroll
                for (int i = 0; i < 4; ++i) { cli[i] = pli[i]; clf[i] = plf[i]; cqw[i] = pq[i]; ckw[i] = pk[i]; }
                if (t0 + 4 < nrows) P2M_LOAD(t0 + 4);
#pragma unroll
                for (int i = 0; i < 4; ++i) {
                    const int r = rbase + t0 + i;
                    const float li = cli[i], lf = logsigmoid_f(clf[i] + fb);
                    bsum += lf;
                    const float q0 = bflo(cqw[i]), q1 = bfhi(cqw[i]), kk0 = bflo(ckw[i]), kk1 = bfhi(ckw[i]);
                    const float yq0 = cq[3][0] * q0 + cq[2][0] * xq[0][0] + cq[1][0] * xq[1][0] + cq[0][0] * xq[2][0];
                    const float yq1 = cq[3][1] * q1 + cq[2][1] * xq[0][1] + cq[1][1] * xq[1][1] + cq[0][1] * xq[2][1];
                    const float yk0 = ck[3][0] * kk0 + ck[2][0] * xk[0][0] + ck[1][0] * xk[1][0] + ck[0][0] * xk[2][0];
                    const float yk1 = ck[3][1] * kk1 + ck[2][1] * xk[0][1] + ck[1][1] * xk[1][1] + ck[0][1] * xk[2][1];
                    xq[2][0] = xq[1][0]; xq[2][1] = xq[1][1]; xq[1][0] = xq[0][0]; xq[1][1] = xq[0][1]; xq[0][0] = q0; xq[0][1] = q1;
                    xk[2][0] = xk[1][0]; xk[2][1] = xk[1][1]; xk[1][0] = xk[0][0]; xk[1][1] = xk[0][1]; xk[0][0] = kk0; xk[0][1] = kk1;
                    const float eq = __expf(bsum) * 0.08838834764831845f, ek = __expf(li - bsum);
                    *(unsigned*)(QM + (size_t)r * 1024 + h * 128 + k0) = pk2(silu_f(yq0) * eq, silu_f(yq1) * eq);
                    *(unsigned*)(QM + (size_t)r * 1024 + 512 + h * 128 + k0) = pk2(silu_f(yk0) * ek, silu_f(yk1) * ek);
                }
            }
#undef P2M_LOAD
            const float dd = __expf(bsum);
            *(f32x2*)(DDp + ((size_t)(257 + cid) * 4 + h) * 128 + k0) = (f32x2){dd, dd};
        }
    }
}

constexpr int SC_QS = 272, SC_VS = 144;
constexpr int SC_QT = 0, SC_KT = 2 * 17408, SC_VT = 4 * 17408, SC_AT = SC_VT + 2 * 9216, SC_SB = SC_AT + 9216, SC_DD = SC_SB + 18432, SC_NB = SC_DD + 1024, SC_END = SC_NB + 256;
static_assert(SC_END <= RING_BYTES, "scan LDS");
__device__ __forceinline__ bf16x8 tr8(LAS unsigned char* base, int stride, int row0, int col0, int lane) {
    const int fq = lane >> 4, q4 = (lane & 15) >> 2, p4 = lane & 3;
    LAS unsigned char* p = base + (row0 + 8 * fq + q4) * stride + (col0 + 4 * p4) * 2;
    const s16x4 lo = __builtin_amdgcn_ds_read_tr16_b64_v4i16((LAS s16x4*)p);
    const s16x4 hi = __builtin_amdgcn_ds_read_tr16_b64_v4i16((LAS s16x4*)(p + 4 * stride));
    return __builtin_shufflevector(lo, hi, 0, 1, 2, 3, 4, 5, 6, 7);
}
template <bool ML>
__device__ __forceinline__ void scan_unit(ArgsP a, LAS unsigned char* lds, int b, int h, int vs, int tid_in) {
    int tid = tid_in; asm volatile("" : "+v"(tid));
    unsigned char* ws = a->ws;
    const bf16* Z = (const bf16*)(ws + WS_Z);
    const bf16* QK = (const bf16*)(ws + (ML ? WS_QKC : WS_G));
    const float* DDp = (const float*)(ws + WS_DD) + (ML ? (size_t)257 * 512 : 0);
    bf16* O = (bf16*)(ws + (ML ? WS_OM : WS_OG));
    const int lane = tid & 63, wave = __builtin_amdgcn_readfirstlane(tid >> 6), fr = lane & 15, fq = lane >> 4;
    const int vt = wave & 3, hh = wave >> 2;
    for (int i = tid; i < (18432 + 1024 + 256) / 4; i += 512) ((LAS unsigned*)(lds + SC_SB))[i] = 0u;
    f32x4 S[4], nacc[4];
#pragma unroll
    for (int i = 0; i < 4; ++i) { S[i] = (f32x4){0.f, 0.f, 0.f, 0.f}; nacc[i] = (f32x4){0.f, 0.f, 0.f, 0.f}; }
    const bf16x8 ones = {(short)0x3F80, (short)0x3F80, (short)0x3F80, (short)0x3F80, (short)0x3F80, (short)0x3F80, (short)0x3F80, (short)0x3F80};
    u32x4 gq[2], gk[2], gv; float gd = 0.f;
    const int vcol = (ML ? ZC_MV : ZC_GV) + h * 256 + vs * 64;
#define SCAN_LOAD(c) do { const int c_ = (c); \
        _Pragma("unroll") for (int e = 0; e < 2; ++e) { const int pid = tid + 512 * e, t = pid >> 4, ch = pid & 15; \
            const bool ok = c_ > 0 || t >= 48; const int row = c_ == 0 ? MR + t - 48 : b * SEQ + (c_ - 1) * 64 + t; \
            gq[e] = ok ? *(const u32x4*)(QK + (size_t)row * 1024 + h * 128 + ch * 8) : (u32x4){0u, 0u, 0u, 0u}; \
            gk[e] = ok ? *(const u32x4*)(QK + (size_t)row * 1024 + 512 + h * 128 + ch * 8) : (u32x4){0u, 0u, 0u, 0u}; } \
        { const int t = tid >> 3, ch = tid & 7; const bool ok = c_ > 0 || t >= 48; const int row = c_ == 0 ? MR + t - 48 : b * SEQ + (c_ - 1) * 64 + t; \
          gv = ok ? *(const u32x4*)(Z + (size_t)row * ZB + vcol + ch * 8) : (u32x4){0u, 0u, 0u, 0u}; } \
        if (tid < 128) { const int cid = c_ == 0 ? 256 : b * 32 + (c_ - 1); gd = DDp[((size_t)cid * 4 + h) * 128 + tid]; } } while (0)
#define SCAN_STORE(buf) do { const int bo_ = (buf); \
        _Pragma("unroll") for (int e = 0; e < 2; ++e) { const int pid = tid + 512 * e, t = pid >> 4, ch = pid & 15; \
            *(LAS u32x4*)(lds + SC_QT + bo_ * 17408 + t * SC_QS + ch * 16) = gq[e]; *(LAS u32x4*)(lds + SC_KT + bo_ * 17408 + t * SC_QS + ch * 16) = gk[e]; } \
        { const int t = tid >> 3, ch = tid & 7; *(LAS u32x4*)(lds + SC_VT + bo_ * 9216 + t * SC_VS + ch * 16) = gv; } \
        if (tid < 128) ((LAS float*)(lds + SC_DD))[bo_ * 128 + tid] = gd; } while (0)
    SCAN_LOAD(0);
    __syncthreads();
    SCAN_STORE(0);
    __syncthreads();
    for (int c = 0; c < 33; ++c) {
        const int buf = c & 1;
        LAS unsigned char* QT = lds + SC_QT + buf * 17408; LAS unsigned char* KT = lds + SC_KT + buf * 17408; LAS unsigned char* VT = lds + SC_VT + buf * 9216;
        LAS unsigned char* AT = lds + SC_AT; LAS unsigned char* SB = lds + SC_SB;
        const LAS float* ddL = (const LAS float*)(lds + SC_DD) + buf * 128;
        if (c + 1 < 33) SCAN_LOAD(c + 1);
        {
            const int ti = wave >> 1;
#pragma unroll
            for (int sj = 0; sj < 2; ++sj) {
                const int si = 2 * (wave & 1) + sj;
                f32x4 acc = {0.f, 0.f, 0.f, 0.f};
#pragma unroll
                for (int ks = 0; ks < 4; ++ks) {
                    const bf16x8 qa = *(const LAS bf16x8*)(QT + (16 * ti + fr) * SC_QS + (32 * ks + 8 * fq) * 2);
                    const bf16x8 kb = *(const LAS bf16x8*)(KT + (16 * si + fr) * SC_QS + (32 * ks + 8 * fq) * 2);
                    acc = __builtin_amdgcn_mfma_f32_16x16x32_bf16(qa, kb, acc, 0, 0, 0);
                }
                const int sg = 16 * si + fr, tg = 16 * ti + 4 * fq;
                LAS bf16* ap = (LAS bf16*)(AT + tg * SC_VS) + sg;
                ap[0 * (SC_VS / 2)] = (bf16)(sg <= tg + 0 ? f2bf(acc.x) : 0u);
                ap[1 * (SC_VS / 2)] = (bf16)(sg <= tg + 1 ? f2bf(acc.y) : 0u);
                ap[2 * (SC_VS / 2)] = (bf16)(sg <= tg + 2 ? f2bf(acc.z) : 0u);
                ap[3 * (SC_VS / 2)] = (bf16)(sg <= tg + 3 ? f2bf(acc.w) : 0u);
            }
        }
        {
            const bf16x8 vb0 = tr8(VT, SC_VS, 0, 16 * vt, lane), vb1 = tr8(VT, SC_VS, 32, 16 * vt, lane);
#pragma unroll
            for (int i = 0; i < 4; ++i) {
                const int kt = 4 * hh + i;
                const bf16x8 ka0 = tr8(KT, SC_QS, 0, 16 * kt, lane), ka1 = tr8(KT, SC_QS, 32, 16 * kt, lane);
                f32x4 acc = S[i];
                acc = __builtin_amdgcn_mfma_f32_16x16x32_bf16(ka0, vb0, acc, 0, 0, 0);
                acc = __builtin_amdgcn_mfma_f32_16x16x32_bf16(ka1, vb1, acc, 0, 0, 0);
                const f32x4 dv = *(const LAS f32x4*)(ddL + 16 * kt + 4 * fq);
                S[i] = acc * dv;
                if (ML) {
                    f32x4 na = nacc[i];
                    na = __builtin_amdgcn_mfma_f32_16x16x32_bf16(ka0, ones, na, 0, 0, 0);
                    na = __builtin_amdgcn_mfma_f32_16x16x32_bf16(ka1, ones, na, 0, 0, 0);
                    nacc[i] = na * dv;
                }
            }
        }
        LDS_WAIT();
        __syncthreads();
        {
            const bf16x8 vb0 = tr8(VT, SC_VS, 0, 16 * vt, lane), vb1 = tr8(VT, SC_VS, 32, 16 * vt, lane);
            bf16x8 sb[4];
#pragma unroll
            for (int ks = 0; ks < 4; ++ks) sb[ks] = tr8(SB, SC_VS, 32 * ks, 16 * vt, lane);
            bf16x8 nb[4];
            if (ML) {
#pragma unroll
                for (int ks = 0; ks < 4; ++ks) nb[ks] = *(const LAS bf16x8*)(lds + SC_NB + (32 * ks + 8 * fq) * 2);
            }
#pragma unroll
            for (int tj = 0; tj < 2; ++tj) {
                const int ti = 2 * hh + tj;
                f32x4 acc = {0.f, 0.f, 0.f, 0.f}, den = {0.f, 0.f, 0.f, 0.f};
#pragma unroll
                for (int ks = 0; ks < 4; ++ks) {
                    const bf16x8 qa = *(const LAS bf16x8*)(QT + (16 * ti + fr) * SC_QS + (32 * ks + 8 * fq) * 2);
                    acc = __builtin_amdgcn_mfma_f32_16x16x32_bf16(qa, sb[ks], acc, 0, 0, 0);
                    if (ML) den = __builtin_amdgcn_mfma_f32_16x16x32_bf16(qa, nb[ks], den, 0, 0, 0);
                }
                const bf16x8 aa0 = *(const LAS bf16x8*)(AT + (16 * ti + fr) * SC_VS + (8 * fq) * 2), aa1 = *(const LAS bf16x8*)(AT + (16 * ti + fr) * SC_VS + (32 + 8 * fq) * 2);
                acc = __builtin_amdgcn_mfma_f32_16x16x32_bf16(aa0, vb0, acc, 0, 0, 0);
                acc = __builtin_amdgcn_mfma_f32_16x16x32_bf16(aa1, vb1, acc, 0, 0, 0);
                if (ML) {
                    den = __builtin_amdgcn_mfma_f32_16x16x32_bf16(aa0, ones, den, 0, 0, 0);
                    den = __builtin_amdgcn_mfma_f32_16x16x32_bf16(aa1, ones, den, 0, 0, 0);
                    acc.x *= __builtin_amdgcn_rcpf(fmaxf(fabsf(den.x), 1.f)); acc.y *= __builtin_amdgcn_rcpf(fmaxf(fabsf(den.y), 1.f)); acc.z *= __builtin_amdgcn_rcpf(fmaxf(fabsf(den.z), 1.f)); acc.w *= __builtin_amdgcn_rcpf(fmaxf(fabsf(den.w), 1.f));
                }
                const int t0 = 16 * ti + 4 * fq;
                const int rowb = c == 0 ? MR + t0 - 48 : b * SEQ + (c - 1) * 64 + t0;
                bf16* op = O + (size_t)rowb * 1024 + h * 256 + vs * 64 + 16 * vt + fr;
                if (c > 0 || t0 >= 48) { op[0] = (bf16)f2bf(acc.x); op[1024] = (bf16)f2bf(acc.y); op[2048] = (bf16)f2bf(acc.z); op[3072] = (bf16)f2bf(acc.w); }
            }
        }
        LDS_WAIT();
        __syncthreads();
        {
#pragma unroll
            for (int i = 0; i < 4; ++i) {
                const int k0 = 16 * (4 * hh + i) + 4 * fq;
                LAS bf16* sp = (LAS bf16*)(SB + k0 * SC_VS) + 16 * vt + fr;
                sp[0 * (SC_VS / 2)] = (bf16)f2bf(S[i].x); sp[1 * (SC_VS / 2)] = (bf16)f2bf(S[i].y); sp[2 * (SC_VS / 2)] = (bf16)f2bf(S[i].z); sp[3 * (SC_VS / 2)] = (bf16)f2bf(S[i].w);
                if (ML && vt == 0 && fr == 0) { LAS bf16* np = (LAS bf16*)(lds + SC_NB) + k0; np[0] = (bf16)f2bf(nacc[i].x); np[1] = (bf16)f2bf(nacc[i].y); np[2] = (bf16)f2bf(nacc[i].z); np[3] = (bf16)f2bf(nacc[i].w); }
            }
            if (c + 1 < 33) SCAN_STORE(buf ^ 1);
        }
        LDS_WAIT();
        __syncthreads();
    }
#undef SCAN_LOAD
#undef SCAN_STORE
}

template <bool DRY = false>
__device__ __forceinline__ void p6_headnorm(ArgsP a, int l, int gw, int ngw, int lane) {
    unsigned char* ws = a->ws; const bf16* Z = (const bf16*)(ws + WS_Z);
    for (int it = gw; it < MT * 8; it += ngw) {
        const int r = it >> 3, mx = (it >> 2) & 1, h = it & 3;
        bf16* op = (bf16*)(ws + (mx ? WS_OM : WS_OG)) + (size_t)r * 1024 + h * 256 + 4 * lane;
        const u32x2 w = *(const u32x2*)op; f32x4 v = {bflo(w.x), bfhi(w.x), bflo(w.y), bfhi(w.y)};
        const float rr = rsqrtf(wave_sum((v.x * v.x + v.y * v.y) + (v.z * v.z + v.w * v.w)) * (1.f / 256.f) + EPS);
        const f32x4 gg = *(const f32x4*)(a->in[mx ? I_GML : I_GGLA] + l * 256 + 4 * lane);
        const u32x2 gw2 = *(const u32x2*)(Z + (size_t)r * ZB + (mx ? ZC_MO : ZC_GR) + h * 256 + 4 * lane);
        const f32x4 gt = {bflo(gw2.x), bfhi(gw2.x), bflo(gw2.y), bfhi(gw2.y)};
        v = v * rr * gg * gt;
        u32x2 o; o.x = pk2(v.x, v.y); o.y = pk2(v.z, v.w); *(u32x2*)(DRY ? (bf16*)(ws + WS_XN) + ((size_t)r * 1024 + h * 256 + 4 * lane) : op) = o;
    }
}

__device__ __forceinline__ int krow(int b, int s) { return s < NMETA ? MR + s : b * SEQ + (s - NMETA); }
__device__ __forceinline__ int t5_bucket(int n) {
    if (n < 16) return n < 0 ? 0 : n;
    const int lg = 16 + (int)(__logf((float)n * (1.f / 16.f)) / 2.0794415416798357f * 16.f);
    return lg < 31 ? lg : 31;
}
__device__ __forceinline__ unsigned off_b(unsigned row, unsigned ch) { return 256u * row + 16u * (ch ^ (((row & 3) << 2) | ((row >> 2) & 3))); }
__device__ __forceinline__ s16x4 tr_rd(LAS unsigned char* p) { return __builtin_amdgcn_ds_read_tr16_b64_v4i16((LAS s16x4*)p); }

constexpr int DW2_STRIDE = 9216, DW2_TILE = 0, DW2_SEL = 8192, DW2_BK = 8704, DSA2_T5 = 8 * DW2_STRIDE, DSA2_BT = DSA2_T5 + 2048 + 64;

template <bool DENSE_ONLY>
__device__ __forceinline__ void dsa_unit(ArgsP a, LAS unsigned char* lds, int b, int c, int nq, int wave, int lane_in) {
    int lane = lane_in; asm volatile("" : "+v"(lane));
    unsigned char* ws = a->ws;
    const bf16* QQ = (const bf16*)(ws + WS_QQ); const bf16* KI = (const bf16*)(ws + WS_KI); const bf16* KV = (const bf16*)(ws + WS_KV);
    unsigned* SC = (unsigned*)(ws + WS_SC) + (size_t)blockIdx.x * 64 * SC_PITCH;
    const int r0 = DENSE_ONLY ? MR : b * SEQ + 64 * c, p0 = DENSE_ONLY ? 0 : NMETA + 64 * c;
    const int fr = lane & 15, fq = lane >> 4;
    if (!DENSE_ONLY) {
        const int qt = wave & 3, kh = wave >> 2;
        if (p0 + 16 * qt + 15 >= 256) {
            const int qrow = r0 + 16 * qt + fr, pq = p0 + 16 * qt + fr;
            bf16x8 qf[8][2];
#pragma unroll
            for (int h = 0; h < 8; ++h)
#pragma unroll
                for (int ks = 0; ks < 2; ++ks) qf[h][ks] = *(const bf16x8*)(QQ + (size_t)qrow * NQQ + 2048 + h * 64 + ks * 32 + 8 * fq);
            float wi[8];
            { const f32x4 w0 = *(const f32x4*)((const float*)(ws + WS_WI) + (size_t)qrow * 8), w1 = *(const f32x4*)((const float*)(ws + WS_WI) + (size_t)qrow * 8 + 4);
              wi[0] = w0.x; wi[1] = w0.y; wi[2] = w0.z; wi[3] = w0.w; wi[4] = w1.x; wi[5] = w1.y; wi[6] = w1.z; wi[7] = w1.w; }
            const int nkt = 2 + 4 * c + qt;
            unsigned* scq = SC + (size_t)(16 * qt + fr) * SC_PITCH + 4 * fq;
            for (int kt0 = kh; kt0 < nkt; kt0 += 8) {
                bf16x8 a0[4], a1[4];
#pragma unroll
                for (int j = 0; j < 4; ++j) { const int kt = kt0 + 2 * j < nkt ? kt0 + 2 * j : nkt - 1;
                    const bf16* kp = KI + (size_t)krow(b, 16 * kt + fr) * 64 + 8 * fq;
                    a0[j] = *(const bf16x8*)kp; a1[j] = *(const bf16x8*)(kp + 32); }
#pragma unroll
                for (int j = 0; j < 4; ++j) {
                    const int kt = kt0 + 2 * j;
                    float s0 = 0.f, s1 = 0.f, s2 = 0.f, s3 = 0.f;
#pragma unroll
                    for (int h = 0; h < 8; ++h) {
                        f32x4 acc = {0.f, 0.f, 0.f, 0.f};
                        acc = __builtin_amdgcn_mfma_f32_16x16x32_bf16(a0[j], qf[h][0], acc, 0, 0, 0);
                        acc = __builtin_amdgcn_mfma_f32_16x16x32_bf16(a1[j], qf[h][1], acc, 0, 0, 0);
                        s0 += wi[h] * fmaxf(acc.x, 0.f); s1 += wi[h] * fmaxf(acc.y, 0.f); s2 += wi[h] * fmaxf(acc.z, 0.f); s3 += wi[h] * fmaxf(acc.w, 0.f);
                    }
                    const int kb = 16 * kt + 4 * fq;
                    u32x4 o;
                    { const unsigned bits = __builtin_bit_cast(unsigned, s0); o.x = (kb + 0) <= pq ? (bits ^ ((bits >> 31) ? 0xffffffffu : 0x80000000u)) : 0u; }
                    { const unsigned bits = __builtin_bit_cast(unsigned, s1); o.y = (kb + 1) <= pq ? (bits ^ ((bits >> 31) ? 0xffffffffu : 0x80000000u)) : 0u; }
                    { const unsigned bits = __builtin_bit_cast(unsigned, s2); o.z = (kb + 2) <= pq ? (bits ^ ((bits >> 31) ? 0xffffffffu : 0x80000000u)) : 0u; }
                    { const unsigned bits = __builtin_bit_cast(unsigned, s3); o.w = (kb + 3) <= pq ? (bits ^ ((bits >> 31) ? 0xffffffffu : 0x80000000u)) : 0u; }
                    if (kt < nkt) *(u32x4*)(scq + 16 * kt) = o;
                }
            }
        }
        VM_WAIT();
        __syncthreads();
    }
    LAS unsigned char* wl = lds + wave * DW2_STRIDE;
    LAS unsigned char* tile = wl + DW2_TILE;
    LAS unsigned short* selL = (LAS unsigned short*)(wl + DW2_SEL);
    LAS unsigned short* bkL = (LAS unsigned short*)(wl + DW2_BK);
    const LAS float* t5L = (const LAS float*)(lds + DSA2_T5);
    const LAS unsigned short* bkT = (const LAS unsigned short*)(lds + DSA2_BT);
    const int nqw = DENSE_ONLY ? 2 : 8;
    for (int qi_ = 0; qi_ < nqw; ++qi_) {
        asm volatile("" : "+v"(lane));
        const int iq = wave * nqw + qi_;
        if (iq >= nq) break;
        const int p = p0 + iq, nk = p + 1, qrow = r0 + iq;
        int nsel;
        if (!DENSE_ONLY && nk > 256) {
            const unsigned* scr = SC + (size_t)iq * SC_PITCH;
            unsigned u[33];
#pragma unroll
            for (int i = 0; i < 33; ++i) { const int s = lane + 64 * i; u[i] = s < nk ? __hip_atomic_load(scr + s, __ATOMIC_RELAXED, __HIP_MEMORY_SCOPE_AGENT) : 0u; }
            unsigned tau = 0u;
            for (int bit = 31; bit >= 16; --bit) {
                const unsigned cand = tau | (1u << bit);
                int cnt = 0;
#pragma unroll
                for (int i = 0; i < 33; ++i) cnt += __popcll(__ballot(u[i] >= cand));
                if (cnt >= 256) tau = cand;
            }
            {
                const unsigned hi = tau >> 16;
                int cab = 0, ncand = 0;
                LAS unsigned short* candL = (LAS unsigned short*)tile;
                const unsigned long long ltm = (1ull << lane) - 1ull;
#pragma unroll
                for (int i = 0; i < 33; ++i) {
                    const unsigned uh = u[i] >> 16;
                    cab += __popcll(__ballot(uh > hi));
                    const unsigned long long mc = __ballot(uh == hi);
                    if (mc != 0ull) { if (uh == hi) candL[ncand + __popcll(mc & ltm)] = (unsigned short)(u[i] & 0xffffu); ncand += __popcll(mc); }
                }
                LDS_WAIT();
                const int need = 256 - cab;
                unsigned lo = 0u;
                if (ncand <= 64) {
                    const unsigned v = lane < ncand ? (unsigned)candL[lane] + 1u : 0u;
                    for (int bit = 15; bit >= 0; --bit) { const unsigned cand = lo | (1u << bit); if (__popcll(__ballot(v >= cand + 1u)) >= need) lo = cand; }
                } else {
                    for (int bit = 15; bit >= 0; --bit) {
                        const unsigned cand = lo | (1u << bit); int cnt = 0;
                        for (int j = lane; j < ((ncand + 63) & ~63); j += 64) { const unsigned v = j < ncand ? (unsigned)candL[j] + 1u : 0u; cnt += __popcll(__ballot(v >= cand + 1u)); }
                        if (cnt >= need) lo = cand;
                    }
                }
                tau |= lo;
                LDS_WAIT();
            }
            int cgt = 0;
#pragma unroll
            for (int i = 0; i < 33; ++i) cgt += __popcll(__ballot(u[i] > tau));
            const int rem = 256 - cgt;
            const unsigned long long lt = (1ull << lane) - 1ull;
            int base = 0, eqseen = 0;
            unsigned short bkv[33];
#pragma unroll
            for (int i = 0; i < 33; ++i) { const int d = p - (lane + 64 * i); bkv[i] = bkT[d > 0 ? d : 0]; }
#pragma unroll
            for (int i = 0; i < 33; ++i) {
                const bool gt = u[i] > tau, eq = u[i] == tau;
                const unsigned long long meq = __ballot(eq);
                const bool take = gt || (eq && (eqseen + __popcll(meq & lt)) < rem);
                const unsigned long long mt = __ballot(take);
                if (take) { const int pos = base + __popcll(mt & lt), s = lane + 64 * i; selL[pos] = (unsigned short)s; bkL[pos] = bkv[i]; }
                base += __popcll(mt); eqseen += __popcll(meq);
            }
            nsel = 256;
        } else {
#pragma unroll
            for (int m = 0; m < 4; ++m) { const int s = lane + 64 * m; selL[s] = (unsigned short)(s < nk ? s : 0); bkL[s] = bkT[s < nk ? p - s : 0]; }
            nsel = nk;
        }
        asm volatile("" : "+v"(lane));
        bf16x8 qB[4];
#pragma unroll
        for (int ks = 0; ks < 4; ++ks) qB[ks] = *(const bf16x8*)(QQ + (size_t)qrow * NQQ + fr * 128 + ks * 32 + 8 * fq);
        LDS_WAIT();
        f32x4 O[8];
#pragma unroll
        for (int nt = 0; nt < 8; ++nt) O[nt] = (f32x4){0.f, 0.f, 0.f, 0.f};
        float qss = 0.f;
#pragma unroll
        for (int ks = 0; ks < 4; ++ks) { const u32x4 w = __builtin_bit_cast(u32x4, qB[ks]);
            qss += (bflo(w.x) * bflo(w.x) + bfhi(w.x) * bfhi(w.x)) + (bflo(w.y) * bflo(w.y) + bfhi(w.y) * bfhi(w.y)) + (bflo(w.z) * bflo(w.z) + bfhi(w.z) * bfhi(w.z)) + (bflo(w.w) * bflo(w.w) + bfhi(w.w) * bfhi(w.w)); }
        qss += __shfl_xor(qss, 16); qss += __shfl_xor(qss, 32);
        const float mb = sqrtf(qss) * t5L[512] + t5L[513];
        float lrun = 0.f;
        const int nblk = (nsel + 31) >> 5;
#define DSA_GATHER(GV, blk_) do { _Pragma("unroll") for (int e = 0; e < 8; ++e) { const int pid = lane + 64 * e, ri = pid >> 4, ch = pid & 15, j = 32 * (blk_) + ri; \
            const int key = (int)selL[j]; GV[e] = *(const u32x4*)(KV + (size_t)krow(b, key) * 128 + ch * 8); } } while (0)
#define DSA_PUT(GV) do { _Pragma("unroll") for (int e = 0; e < 8; ++e) { const int pid = lane + 64 * e, ri = pid >> 4, ch = pid & 15; *(LAS u32x4*)(tile + off_b(ri, ch)) = GV[e]; } } while (0)
        u32x4 gvA[8], gvB[8];
        DSA_GATHER(gvA, 0);
        if (nblk > 1) DSA_GATHER(gvB, 1);
        for (int blk0 = 0; blk0 < nblk; blk0 += 2) {
#pragma unroll
            for (int half = 0; half < 2; ++half) {
                const int blk = blk0 + half;
                if (blk < nblk) {
                    if (half == 0) { DSA_PUT(gvA); if (blk + 2 < nblk) DSA_GATHER(gvA, blk + 2); }
                    else { DSA_PUT(gvB); if (blk + 2 < nblk) DSA_GATHER(gvB, blk + 2); }
                    LDS_WAIT();
                    f32x4 s0 = {0.f, 0.f, 0.f, 0.f}, s1 = {0.f, 0.f, 0.f, 0.f};
        #pragma unroll
                    for (int ks = 0; ks < 4; ++ks) {
                        const bf16x8 k0 = *(const LAS bf16x8*)(tile + off_b(fr, 4 * ks + fq)), k1 = *(const LAS bf16x8*)(tile + off_b(16 + fr, 4 * ks + fq));
                        s0 = __builtin_amdgcn_mfma_f32_16x16x32_bf16(k0, qB[ks], s0, 0, 0, 0);
                        s1 = __builtin_amdgcn_mfma_f32_16x16x32_bf16(k1, qB[ks], s1, 0, 0, 0);
                    }
                    const int j0 = 32 * blk + 4 * fq;
                    const u32x2 b0 = *(const LAS u32x2*)(bkL + j0), b1 = *(const LAS u32x2*)(bkL + j0 + 16);
                    const float t00 = t5L[(b0.x & 0xffffu) + fr], t01 = t5L[(b0.x >> 16) + fr], t02 = t5L[(b0.y & 0xffffu) + fr], t03 = t5L[(b0.y >> 16) + fr];
                    const float t10 = t5L[(b1.x & 0xffffu) + fr], t11 = t5L[(b1.x >> 16) + fr], t12 = t5L[(b1.y & 0xffffu) + fr], t13 = t5L[(b1.y >> 16) + fr];
                    const float e00 = __expf(s0.x + t00 - mb), e01 = __expf(s0.y + t01 - mb), e02 = __expf(s0.z + t02 - mb), e03 = __expf(s0.w + t03 - mb);
                    const float e10 = __expf(s1.x + t10 - mb), e11 = __expf(s1.y + t11 - mb), e12 = __expf(s1.z + t12 - mb), e13 = __expf(s1.w + t13 - mb);
                    const float p00 = (j0 + 0) < nsel ? e00 : 0.f, p01 = (j0 + 1) < nsel ? e01 : 0.f, p02 = (j0 + 2) < nsel ? e02 : 0.f, p03 = (j0 + 3) < nsel ? e03 : 0.f;
                    const float p10 = (j0 + 16) < nsel ? e10 : 0.f, p11 = (j0 + 17) < nsel ? e11 : 0.f, p12 = (j0 + 18) < nsel ? e12 : 0.f, p13 = (j0 + 19) < nsel ? e13 : 0.f;
                    lrun += ((p00 + p01) + (p02 + p03)) + ((p10 + p11) + (p12 + p13));
                    u32x4 pw; pw.x = pk2(p00, p01); pw.y = pk2(p02, p03); pw.z = pk2(p10, p11); pw.w = pk2(p12, p13);
                    const bf16x8 pa = __builtin_bit_cast(bf16x8, pw);
                    const unsigned q4 = (unsigned)(fr >> 2), p4 = (unsigned)(lane & 3);
        #pragma unroll
                    for (int nt = 0; nt < 8; ++nt) {
                        const s16x4 vlo = tr_rd(tile + off_b(4 * fq + q4, 2 * nt + (p4 >> 1)) + 8 * (p4 & 1));
                        const s16x4 vhi = tr_rd(tile + off_b(16 + 4 * fq + q4, 2 * nt + (p4 >> 1)) + 8 * (p4 & 1));
                        const bf16x8 vb = __builtin_shufflevector(vlo, vhi, 0, 1, 2, 3, 4, 5, 6, 7);
                        O[nt] = __builtin_amdgcn_mfma_f32_16x16x32_bf16(pa, vb, O[nt], 0, 0, 0);
                    }

                }
            }
        }
#undef DSA_GATHER
#undef DSA_PUT
        float lt2 = lrun + __shfl_xor(lrun, 16); lt2 += __shfl_xor(lt2, 32);
        const float inv = 1.f / lt2;
        float ir[4];
#pragma unroll
        for (int r = 0; r < 4; ++r) ir[r] = __shfl(inv, 4 * fq + r);
        bf16* od = (bf16*)(ws + WS_OD) + (size_t)qrow * 1024 + fr;
#pragma unroll
        for (int nt = 0; nt < 8; ++nt)
#pragma unroll
            for (int r = 0; r < 4; ++r) { const int hd = 4 * fq + r; od[(size_t)(hd >> 3) * MT * 1024 + (hd & 7) * 128 + 16 * nt] = (bf16)f2bf(O[nt][r] * ir[r]); }
        LDS_WAIT();
    }
}
__device__ __forceinline__ void p5_dsa(ArgsP a, LAS unsigned char* lds, int l, int tid, int wave, int lane) {
    LAS float* t5L = (LAS float*)(lds + DSA2_T5);
    __syncthreads();
    t5L[tid] = a->in[I_T5][tid];
    for (int n = tid; n < TT; n += 512) ((LAS unsigned short*)(lds + DSA2_BT))[n] = (unsigned short)(t5_bucket(n) * 16);
    if (tid < 64) {
        const float g0 = fabsf(a->in[I_GDKV][l * 128 + tid]), g1 = fabsf(a->in[I_GDKV][l * 128 + 64 + tid]);
        const float gm = wave_max(fmaxf(g0, g1));
        float tm = 0.f;
#pragma unroll
        for (int i = 0; i < 8; ++i) tm = fmaxf(tm, fabsf(a->in[I_T5][tid + 64 * i]));
        tm = wave_max(tm);
        if (tid == 0) { t5L[512] = 11.313708498984761f * gm; t5L[513] = tm; }
    }
    __syncthreads();
    for (int u = blockIdx.x; u < 256; u += gridDim.x) {
        dsa_unit<false>(a, lds, u >> 5, u & 31, 64, wave, lane);
        __syncthreads();
    }
    if (blockIdx.x == 0) dsa_unit<true>(a, lds, 0, 0, 16, wave, lane);
}

__global__ void __launch_bounds__(NWAVES * 64, 2) fwd(Args a_) {
    extern __shared__ __attribute__((aligned(16))) unsigned char lds_raw[];
    LAS unsigned char* lds = (LAS unsigned char*)lds_raw;
    volatile LAS unsigned* MISC = (volatile LAS unsigned*)(lds + MISC_OFF);
    if (threadIdx.x < 32) MISC[threadIdx.x] = 0u;
    __syncthreads();
    const int g_lo = a_.g_lo, g_hi = a_.g_hi, l_lo = a_.l_lo, l_hi = a_.l_hi, ph_lo = a_.ph_lo, ph_hi = a_.ph_hi, use_bar = a_.use_bar;
    XcdBarrier bar; bar.bar = (unsigned*)(a_.ws + WS_CTL) + CW_BAR; bar.x = 0; bar.st = nullptr;
    if (use_bar) bar = xcd_barrier_post((unsigned*)(a_.ws + WS_CTL) + CW_BAR, MISC + 8);
#define GRID_BAR() do { if (use_bar) xcd_barrier(bar); } while (0)
#ifndef PHMASK
#define PHMASK 0xFFFF
#endif
#ifndef PROBE_PH
#define PROBE_PH -1
#endif
#ifndef PROBE_MASK
#define PROBE_MASK 0
#endif
#define PROBED(k) ((PROBE_MASK >> (k)) & 1)
#ifndef P1_ALIGN
#define P1_ALIGN true
#endif
#define PH(k) (((PHMASK >> (k)) & 1) && ph_lo <= (k) && (k) < ph_hi)
#define PBEGIN ArgsP a = (ArgsP)__builtin_amdgcn_kernarg_segment_ptr(); asm volatile("" : "+s"(a)); unsigned char* ws = a->ws; \
    int tid_ = threadIdx.x; asm volatile("" : "+v"(tid_)); const int tid = tid_, lane = tid & 63, wave = __builtin_amdgcn_readfirstlane(tid >> 6); const int gw = blockIdx.x * NWAVES + wave, ngw = gridDim.x * NWAVES; (void)ws; (void)gw; (void)ngw; (void)lane;

    if (((PHMASK >> 13) & 1) && a_.prep) { PBEGIN prep_weights(a, lds, gw, ngw, wave, lane); GRID_BAR(); }

    for (int g = g_lo; g < g_hi; ++g) {
        for (int l = l_lo; l < l_hi; ++l) {
            if (PH(0) && l == 0) { PBEGIN p0_init(a, g, gw, ngw, lane); GRID_BAR(); }
            if (PH(1)) { PBEGIN
                FIn f{(bf16*)(ws + WS_Z), (float*)(ws + WS_ZF), (const float*)(ws + WS_BIN) + l * NZ};
                run_gemm<FIn, P1_ALIGN>(lds, (const bf16*)(ws + WS_XN), (const bf16*)(ws + WS_WIN) + (size_t)l * NZ * D, NZ, D, f, gw, ngw, lane);
                if (PROBED(1)) { run_gemm(lds, (const bf16*)(ws + WS_XN), (const bf16*)(ws + WS_WIN) + (size_t)l * NZ * D, NZ, D, f, gw, ngw, lane); }
                GRID_BAR();
            }
            if (PH(2)) { PBEGIN p2_prep(a, l, gw, ngw, lane); if (PROBED(2)) { p2_prep(a, l, gw, ngw, lane); } GRID_BAR(); }
            if (PH(3)) { PBEGIN
                FQQ f{(bf16*)(ws + WS_QQ)};
                run_gemm(lds, (const bf16*)(ws + WS_CQN), (const bf16*)(ws + WS_WQQ) + (size_t)l * NQQ * 256, NQQ, 256, f, gw, ngw, lane);
                if (PROBED(3)) { run_gemm(lds, (const bf16*)(ws + WS_CQN), (const bf16*)(ws + WS_WQQ) + (size_t)l * NQQ * 256, NQQ, 256, f, gw, ngw, lane); }
            }
            if (PH(4)) { PBEGIN
                for (int u = blockIdx.x; u < 256; u += gridDim.x) {
                    const int b = (u >> 4) & 7, h = (u >> 2) & 3, vs = u & 3;
                    if (u >> 7) scan_unit<true>(a, lds, b, h, vs, tid); else scan_unit<false>(a, lds, b, h, vs, tid);
                }
#if PROBE_PH == 4
                for (int u = blockIdx.x; u < 256; u += gridDim.x) {
                    const int b = (u >> 4) & 7, h = (u >> 2) & 3, vs = u & 3;
                    if (u >> 7) scan_unit<true>(a, lds, b, h, vs, tid); else scan_unit<false>(a, lds, b, h, vs, tid);
                }
#endif
                GRID_BAR();
            }
            if (PH(5)) { PBEGIN p5_dsa(a, lds, l, tid, wave, lane); }
#if PROBE_PH == 5
            if (PH(5)) { PBEGIN p5_dsa(a, lds, l, tid, wave, lane); }
#endif
            if (PH(6)) { PBEGIN p6_headnorm(a, l, gw, ngw, lane); if (PROBED(6)) p6_headnorm<true>(a, l, gw, ngw, lane); GRID_BAR(); }
            if (PH(7)) {
                __syncthreads();
                { PBEGIN
                  const bf16* OD0 = (const bf16*)(ws + WS_OD); const bf16* OD1 = OD0 + (size_t)MT * 1024;
                  const bf16* WB0 = (const bf16*)(ws + WS_WBD) + (size_t)l * D * 2048; const bf16* WB1 = WB0 + (size_t)D * D;
                  int Kc = D, Nc = D; asm volatile("" : "+s"(Kc)); asm volatile("" : "+s"(Nc));
                  pg8::Gemm g{(const bf16*)(ws + WS_OG), (const bf16*)(ws + WS_WBG) + (size_t)l * D * D, MR, Nc, Kc, OD0, OD1, (const bf16*)(ws + WS_OM), WB0, WB1, (const bf16*)(ws + WS_WBM) + (size_t)l * D * D};
                  ChainOrder S; S.S.init(MR, Nc, (int)gridDim.x, (int)blockIdx.x);
                  EpiMix E{(const bf16*)(ws + WS_Z), (bf16*)(ws + WS_MIX)};
                  pg8::gemm_phase<EpiMix, ChainOrder, true, true, true>((PG8_LAS unsigned char*)lds, g, S, E);
                  FBr<0> f0{(const bf16*)(ws + WS_Z), (float*)(ws + WS_Y), (bf16*)(ws + WS_MIX)};
                  mini_gemm((const bf16*)(ws + WS_OG), (const bf16*)(ws + WS_WBG) + (size_t)l * D * D, Nc, Kc, f0, gw, ngw, lane);
                  FBr<1> f1{(const bf16*)(ws + WS_Z), (float*)(ws + WS_Y), (bf16*)(ws + WS_MIX)};
                  mini_gemm(OD0, WB0, Nc, Kc, f1, gw, ngw, lane);
                  mini_gemm(OD1, WB1, Nc, Kc, f1, gw, ngw, lane);
                  FBr<2> f2{(const bf16*)(ws + WS_Z), (float*)(ws + WS_Y), (bf16*)(ws + WS_MIX)};
                  mini_gemm((const bf16*)(ws + WS_OM), (const bf16*)(ws + WS_WBM) + (size_t)l * D * D, Nc, Kc, f2, gw, ngw, lane);
                }
#if PROBED(7)
                { PBEGIN
                  const bf16* OD0 = (const bf16*)(ws + WS_OD); const bf16* OD1 = OD0 + (size_t)MT * 1024;
                  const bf16* WB0 = (const bf16*)(ws + WS_WBD) + (size_t)l * D * 2048; const bf16* WB1 = WB0 + (size_t)D * D;
                  int Kc = D, Nc = D; asm volatile("" : "+s"(Kc)); asm volatile("" : "+s"(Nc));
                  pg8::Gemm g{(const bf16*)(ws + WS_OG), (const bf16*)(ws + WS_WBG) + (size_t)l * D * D, MR, Nc, Kc, OD0, OD1, (const bf16*)(ws + WS_OM), WB0, WB1, (const bf16*)(ws + WS_WBM) + (size_t)l * D * D};
                  ChainOrder S; S.S.init(MR, Nc, (int)gridDim.x, (int)blockIdx.x);
                  EpiMix E{(const bf16*)(ws + WS_Z), (bf16*)(ws + WS_MIX)};
                  pg8::gemm_phase<EpiMix, ChainOrder, true, true, true>((PG8_LAS unsigned char*)lds, g, S, E);
                  FBr<0> f0{(const bf16*)(ws + WS_Z), (float*)(ws + WS_Y), (bf16*)(ws + WS_MIX)};
                  mini_gemm((const bf16*)(ws + WS_OG), (const bf16*)(ws + WS_WBG) + (size_t)l * D * D, Nc, Kc, f0, gw, ngw, lane);
                  FBr<1> f1{(const bf16*)(ws + WS_Z), (float*)(ws + WS_Y), (bf16*)(ws + WS_MIX)};
                  mini_gemm(OD0, WB0, Nc, Kc, f1, gw, ngw, lane);
                  mini_gemm(OD1, WB1, Nc, Kc, f1, gw, ngw, lane);
                  FBr<2> f2{(const bf16*)(ws + WS_Z), (float*)(ws + WS_Y), (bf16*)(ws + WS_MIX)};
                  mini_gemm((const bf16*)(ws + WS_OM), (const bf16*)(ws + WS_WBM) + (size_t)l * D * D, Nc, Kc, f2, gw, ngw, lane);
                }
#endif
                GRID_BAR();
            }
            if (PH(8)) { PBEGIN
                FY f{(bf16*)(ws + WS_Y)};
                run_gemm(lds, (const bf16*)(ws + WS_MIX), (const bf16*)(ws + WS_WOUT) + (size_t)l * D * D, D, D, f, gw, ngw, lane);
                if (PROBED(8)) { run_gemm(lds, (const bf16*)(ws + WS_MIX), (const bf16*)(ws + WS_WOUT) + (size_t)l * D * D, D, D, f, gw, ngw, lane); }
                GRID_BAR();
            }
            if (PH(9)) { PBEGIN if (PROBED(9)) p_norm_res<true>(a, g, a->in[I_GPOSTMIX] + l * D, a->in[I_GPREMLP] + l * D, gw, ngw, lane); p_norm_res(a, g, a->in[I_GPOSTMIX] + l * D, a->in[I_GPREMLP] + l * D, gw, ngw, lane); GRID_BAR(); }
            if (PH(10)) { PBEGIN
                FUp f{(bf16*)(ws + WS_Z)};
                run_gemm(lds, (const bf16*)(ws + WS_XN), (const bf16*)(ws + WS_WUP) + (size_t)l * DFF * D, DFF, D, f, gw, ngw, lane);
                if (PROBED(10)) { run_gemm(lds, (const bf16*)(ws + WS_XN), (const bf16*)(ws + WS_WUP) + (size_t)l * DFF * D, DFF, D, f, gw, ngw, lane); }
                GRID_BAR();
            }
            if (PH(11)) { PBEGIN
                FY f{(bf16*)(ws + WS_Y)};
                run_gemm(lds, (const bf16*)(ws + WS_Z), (const bf16*)(ws + WS_WDN) + (size_t)l * D * DFF, D, DFF, f, gw, ngw, lane);
                if (PROBED(11)) { run_gemm(lds, (const bf16*)(ws + WS_Z), (const bf16*)(ws + WS_WDN) + (size_t)l * D * DFF, D, DFF, f, gw, ngw, lane); }
                GRID_BAR();
            }
            if (PH(12)) { PBEGIN if (PROBED(12)) p_norm_res<true>(a, g, a->in[I_GPOSTMLP] + l * D, l + 1 < NL ? a->in[I_GPREMIX] + (l + 1) * D : nullptr, gw, ngw, lane); p_norm_res(a, g, a->in[I_GPOSTMLP] + l * D, l + 1 < NL ? a->in[I_GPREMIX] + (l + 1) * D : nullptr, gw, ngw, lane); GRID_BAR(); }
        }
    }
#undef PH
#undef GRID_BAR
#undef PBEGIN
}

#ifndef MK_ONE_LAUNCH
#define MK_ONE_LAUNCH 1
#endif
extern "C" void kernel_launch(void* const* d_in, const int* in_sizes, int n_in, void* d_out, int out_size, void* d_ws, size_t ws_size, hipStream_t stream) {
    static int grid = 0;
    if (grid == 0) {
        if (n_in != 28 || out_size != NB * SEQ * D || ws_size < WS_END) { fprintf(stderr, "kernel_launch: unexpected shapes (n_in %d out %d ws %zu need %zu)\n", n_in, out_size, ws_size, (size_t)WS_END); grid = -1; return; }
        int dev = 0, cus = 0, per_cu = 0;
        if (hipGetDevice(&dev) != hipSuccess || hipDeviceGetAttribute(&cus, hipDeviceAttributeMultiprocessorCount, dev) != hipSuccess) { grid = -1; return; }
        if (hipFuncSetAttribute((const void*)fwd, hipFuncAttributeMaxDynamicSharedMemorySize, LDS_BYTES) != hipSuccess) { fprintf(stderr, "kernel_launch: hipFuncSetAttribute failed\n"); grid = -1; return; }
        if (hipOccupancyMaxActiveBlocksPerMultiprocessor(&per_cu, (const void*)fwd, NWAVES * 64, LDS_BYTES) != hipSuccess || per_cu < 1) { fprintf(stderr, "kernel_launch: occupancy query says %d\n", per_cu); }
        (void)hipGetLastError();
        grid = cus;
    }
    if (grid < 0) return;
    (void)hipMemsetAsync((char*)d_ws + WS_CTL, 0, CTL_ZERO_BYTES, stream);
    Args a{};
    for (int i = 0; i < 28; ++i) a.in[i] = (const float*)d_in[i];
    a.out = (float*)d_out; a.ws = (unsigned char*)d_ws;
#if MK_ONE_LAUNCH
    a.g_lo = 0; a.g_hi = NG; a.l_lo = 0; a.l_hi = NL; a.ph_lo = 0; a.ph_hi = 13; a.prep = 1; a.use_bar = 1;
    hipLaunchKernelGGL(fwd, dim3(grid), dim3(NWAVES * 64), LDS_BYTES, stream, a);
#else
    a.use_bar = 0;
    a.prep = 1; a.g_lo = 0; a.g_hi = 0; a.l_lo = 0; a.l_hi = 0; a.ph_lo = 0; a.ph_hi = 0;
    hipLaunchKernelGGL(fwd, dim3(grid), dim3(NWAVES * 64), LDS_BYTES, stream, a);
    a.prep = 0;
    static const int cuts[] = {0, 1, 2, 3, 5, 7, 8, 9, 10, 11, 12, 13};
    for (int g = 0; g < NG; ++g) for (int l = 0; l < NL; ++l) for (int c = 0; c < 11; ++c) {
        if (c == 0 && l != 0) continue;
        a.g_lo = g; a.g_hi = g + 1; a.l_lo = l; a.l_hi = l + 1; a.ph_lo = cuts[c]; a.ph_hi = cuts[c + 1];
        hipLaunchKernelGGL(fwd, dim3(grid), dim3(NWAVES * 64), LDS_BYTES, stream, a);
    }
#endif
    const hipError_t le = hipPeekAtLastError();
    if (le != hipSuccess) fprintf(stderr, "kernel_launch: launch failed: %s\n", hipGetErrorName(le));
}
```

```cpp
#include <hip/hip_runtime.h>
#include <cstdio>
#include <cstdint>
namespace pg8 {
#define PG8_LAS __attribute__((address_space(3)))
typedef unsigned short bf16_t;
typedef short bf16x8 __attribute__((ext_vector_type(8)));
typedef float f32x4 __attribute__((ext_vector_type(4)));
typedef unsigned u32x4 __attribute__((ext_vector_type(4)));
constexpr int BM = 256, BK = 64, HALF = 128, HTB = HALF * BK * 2  , STAGE_BYTES = 8 * HTB, NXCD = 8, WGM = 8;

__host__ __device__ __forceinline__ int lds_byte(int r, int c) { const int st = (r >> 4) * 2 + (c >> 5), rr = r & 15, cc = c & 31, ob = rr * 64 + cc * 2; return st * 1024 + (ob ^ (((ob >> 9) & 1) << 5)); }
__host__ __device__ __forceinline__ void stage_rc(int b, int& R, int& C) { const int st = b / 1024, sb = b % 1024, swz = sb ^ (((sb >> 9) & 1) << 5); R = (st >> 1) * 16 + swz / 64; C = (st & 1) * 32 + (swz % 64) / 2; }
__host__ __device__ __forceinline__ int perm32(int rho) { const int n = rho >> 4, i = rho & 15; return 8 * (i >> 2) + 4 * n + (i & 3); }

struct Unit { int pm, pn, sub; };
struct Gemm { const bf16_t* A; const bf16_t* Bt; int M, N, K; const bf16_t *A1, *A2, *A3, *B1, *B2, *B3; };

struct StaticOrder {
    int nM, nN, nwg, G, c;
    __host__ __device__ void init(int M, int N, int G_, int c_) { nM = M / BM; nN = N / BM; nwg = nM * nN; G = G_; c = c_; }
    __host__ __device__ bool next(int i, Unit& u) const {
        const long L = (long)i * G + c; if (L >= nwg) return false;
        int wgid = (int)L; { const int q = nwg / NXCD, r = nwg % NXCD, xcd = wgid % NXCD, off = wgid / NXCD; wgid = (xcd < r ? xcd * (q + 1) : r * (q + 1) + (xcd - r) * q) + off; }
        const int nig = WGM * nN, gid = wgid / nig, fm = gid * WGM, gsz = (nM - fm) < WGM ? (nM - fm) : WGM;
        u.pm = fm + ((wgid % nig) % gsz); u.pn = (wgid % nig) / gsz; u.sub = 0; return true;
    }
    __device__ __forceinline__ void a_ready(const Unit&) const {}
    __device__ __forceinline__ void done(const Unit&) const {}
};

__device__ __forceinline__ unsigned cvt_pk_bf16(float lo, float hi) { unsigned r; asm volatile("v_cvt_pk_bf16_f32 %0, %1, %2" : "=v"(r) : "v"(lo), "v"(hi)); return r; }
template <class Epi, class Sched, bool ALIGN_EPI = false, bool SP2 = false, bool CHAIN = false>
__device__ __forceinline__ void gemm_phase(PG8_LAS unsigned char* lds, const Gemm g, const Sched& S, const Epi& E) {
    int tid_ = threadIdx.x; asm volatile("" : "+v"(tid_));
    const int tid = tid_, wid = __builtin_amdgcn_readfirstlane(tid >> 6), lane = tid & 63, wr = wid >> 2, wc = wid & 3, fr = lane & 15, fq = lane >> 4;
    const int K = g.K, nt = K / BK;
    unsigned voffA[2], voffB[2];
#pragma unroll
    for (int i = 0; i < 2; ++i) { int R, C; stage_rc(tid * 16 + i * 8192, R, C); const int Rb = Epi::PERM ? ((R & ~31) + perm32(R & 31)) : R;
        voffA[i] = (unsigned)(R * K + C) * 2u; voffB[i] = (unsigned)(Rb * K + C) * 2u; }
    const size_t kstep = (size_t)(BK * 2);
    const size_t hstep = (size_t)HALF * K * 2;
    const size_t tstep = 2 * hstep;
    const unsigned ldsw = (unsigned)wid * 1024u;
    const int aoff = lds_byte(wr * 64 + fr, fq * 8), boff = lds_byte(wc * 32 + fr, fq * 8);
#define PG8_SA(b, h) (((b) * 2 + (h)) * HTB)
#define PG8_SB(b, h) ((4 + (b) * 2 + (h)) * HTB)
#define PG8_STAGE(bufoff, gbase, voff) do { _Pragma("unroll") for (int _i = 0; _i < 2; ++_i) \
        __builtin_amdgcn_global_load_lds((const unsigned*)((const char*)(gbase) + (voff)[_i]), (PG8_LAS unsigned*)(lds + (bufoff) + ldsw + _i * 8192), 16, 0, 0); } while (0)
#define PG8_LDA(dst, b, h) do { _Pragma("unroll") for (int m = 0; m < 4; ++m) _Pragma("unroll") for (int k = 0; k < 2; ++k) dst[m][k] = *(const PG8_LAS bf16x8*)(lds + PG8_SA(b, h) + aoff + m * 2048 + k * 1024); } while (0)
#define PG8_LDB(dst, b, h) do { _Pragma("unroll") for (int n = 0; n < 2; ++n) _Pragma("unroll") for (int k = 0; k < 2; ++k) dst[n][k] = *(const PG8_LAS bf16x8*)(lds + PG8_SB(b, h) + boff + n * 2048 + k * 1024); } while (0)
#define PG8_MMA(ai, bj, At, Bt) do { __builtin_amdgcn_s_setprio(1); _Pragma("unroll") for (int m = 0; m < 4; ++m) _Pragma("unroll") for (int n = 0; n < 2; ++n) _Pragma("unroll") for (int k = 0; k < 2; ++k) \
        acc[ai][bj][m][n] = __builtin_amdgcn_mfma_f32_16x16x32_bf16(Bt[n][k], At[m][k], acc[ai][bj][m][n], 0, 0, 0); __builtin_amdgcn_s_setprio(0); } while (0)
#define PG8_WAIT_V(n) asm volatile("s_waitcnt vmcnt(" #n ")" ::: "memory")
#define PG8_WAIT_L(n) asm volatile("s_waitcnt lgkmcnt(" #n ")" ::: "memory")
#define PG8_BAR __builtin_amdgcn_s_barrier()
#define PG8_SCHED __builtin_amdgcn_sched_barrier(0)
    Unit cur, nxt; int ui = 0;
    if (!S.next(0, cur)) return;
    f32x4 acc[2][2][4][2];
#pragma unroll
    for (int a = 0; a < 2; ++a)
#pragma unroll
        for (int b = 0; b < 2; ++b)
#pragma unroll
            for (int m = 0; m < 4; ++m)
#pragma unroll
                for (int n = 0; n < 2; ++n) acc[a][b][m][n] = (f32x4){0.f, 0.f, 0.f, 0.f};
    bf16x8 At[4][2], B0[2][2], B1[2][2];
#define PG8_ABASE(u) ((const char*)(!CHAIN || (u).sub == 0 ? g.A : (u).sub == 1 ? g.A1 : (u).sub == 2 ? g.A2 : g.A3) + (size_t)(u).pm * tstep)
#define PG8_BBASE(u) ((const char*)(!CHAIN || (u).sub == 0 ? g.Bt : (u).sub == 1 ? g.B1 : (u).sub == 2 ? g.B2 : g.B3) + (size_t)(u).pn * tstep)
    const char* cA = PG8_ABASE(cur); const char* cB = PG8_BBASE(cur);
    S.a_ready(cur);
    if constexpr (SP2) {
        PG8_STAGE(PG8_SB(0, 0), cB, voffB); PG8_STAGE(PG8_SB(0, 1), cB + hstep, voffB); PG8_STAGE(PG8_SA(0, 0), cA, voffA); PG8_STAGE(PG8_SA(0, 1), cA + hstep, voffA);
        if (wr == 1) PG8_BAR;
        PG8_WAIT_V(2); PG8_BAR;
        PG8_STAGE(PG8_SB(1, 0), cB + kstep, voffB); PG8_STAGE(PG8_SA(1, 0), cA + kstep, voffA); PG8_STAGE(PG8_SB(1, 1), cB + hstep + kstep, voffB);
        PG8_WAIT_V(6); PG8_BAR;
    } else {
        PG8_STAGE(PG8_SB(0, 0), cB, voffB); PG8_STAGE(PG8_SA(0, 0), cA, voffA); PG8_STAGE(PG8_SB(0, 1), cB + hstep, voffB); PG8_STAGE(PG8_SA(0, 1), cA + hstep, voffA);
        if (wr == 1) PG8_BAR;
        PG8_WAIT_V(4); PG8_BAR;
        PG8_STAGE(PG8_SB(1, 0), cB + kstep, voffB); PG8_STAGE(PG8_SA(1, 0), cA + kstep, voffA); PG8_STAGE(PG8_SB(1, 1), cB + hstep + kstep, voffB);
        PG8_WAIT_V(6); PG8_BAR;
    }
    for (;;) {
        const bool has_next = S.next(ui + 1, nxt);
        const char* nA = has_next ? PG8_ABASE(nxt) : cA; const char* nB = has_next ? PG8_BBASE(nxt) : cB;
        for (int t = 0; t < nt; t += 2) {
            const bool last = (t == nt - 2);
            const char* a1 = cA + (size_t)(t + 1) * kstep;
            const char* a2 = last ? nA : cA + (size_t)(t + 2) * kstep; const char* b2 = last ? nB : cB + (size_t)(t + 2) * kstep;
            const char* a3 = a2 + kstep; const char* b3 = b2 + kstep;
            if (last && has_next) S.a_ready(nxt);
            if constexpr (SP2) {
            PG8_LDB(B0, 0, 0); PG8_LDB(B1, 0, 1); PG8_SCHED; PG8_LDA(At, 0, 0); PG8_STAGE(PG8_SA(1, 1), a1 + hstep, voffA);
            PG8_WAIT_V(8); PG8_WAIT_L(0); PG8_BAR; PG8_MMA(0, 0, At, B0); PG8_MMA(0, 1, At, B1); PG8_BAR; PG8_SCHED;
            PG8_LDA(At, 0, 1); PG8_STAGE(PG8_SB(0, 0), b2, voffB); PG8_STAGE(PG8_SB(0, 1), b2 + hstep, voffB); PG8_STAGE(PG8_SA(0, 0), a2, voffA);
            PG8_WAIT_V(8); PG8_WAIT_L(0); PG8_BAR; PG8_MMA(1, 0, At, B0); PG8_MMA(1, 1, At, B1); PG8_BAR; PG8_SCHED;
            PG8_LDB(B0, 1, 0); PG8_LDB(B1, 1, 1); PG8_SCHED; PG8_LDA(At, 1, 0); PG8_STAGE(PG8_SA(0, 1), a2 + hstep, voffA);
            PG8_WAIT_V(8); PG8_WAIT_L(0); PG8_BAR; PG8_MMA(0, 0, At, B0); PG8_MMA(0, 1, At, B1); PG8_BAR; PG8_SCHED;
            PG8_LDA(At, 1, 1); PG8_STAGE(PG8_SB(1, 0), b3, voffB); PG8_STAGE(PG8_SB(1, 1), b3 + hstep, voffB); PG8_STAGE(PG8_SA(1, 0), a3, voffA);
            PG8_WAIT_V(8); PG8_WAIT_L(0); PG8_BAR; PG8_MMA(1, 0, At, B0); PG8_MMA(1, 1, At, B1); PG8_BAR; PG8_SCHED;
            } else {
            PG8_LDB(B0, 0, 0); PG8_SCHED; PG8_LDA(At, 0, 0); PG8_STAGE(PG8_SA(1, 1), a1 + hstep, voffA);
            PG8_WAIT_L(8); PG8_BAR; PG8_WAIT_L(0); PG8_MMA(0, 0, At, B0); PG8_BAR; PG8_SCHED;
            PG8_LDB(B1, 0, 1); PG8_STAGE(PG8_SB(0, 0), b2, voffB);
            PG8_BAR; PG8_WAIT_L(0); PG8_MMA(0, 1, At, B1); PG8_BAR;
            PG8_LDA(At, 0, 1); PG8_STAGE(PG8_SA(0, 0), a2, voffA);
            PG8_BAR; PG8_WAIT_L(0); PG8_MMA(1, 0, At, B0); PG8_BAR; PG8_SCHED;
            PG8_STAGE(PG8_SB(0, 1), b2 + hstep, voffB);
            PG8_WAIT_V(6); PG8_BAR; PG8_MMA(1, 1, At, B1); PG8_BAR;
            PG8_LDB(B0, 1, 0); PG8_SCHED; PG8_LDA(At, 1, 0); PG8_STAGE(PG8_SA(0, 1), a2 + hstep, voffA);
            PG8_WAIT_L(8); PG8_BAR; PG8_WAIT_L(0); PG8_MMA(0, 0, At, B0); PG8_BAR; PG8_SCHED;
            PG8_LDB(B1, 1, 1); PG8_STAGE(PG8_SB(1, 0), b3, voffB);
            PG8_BAR; PG8_WAIT_L(0); PG8_MMA(0, 1, At, B1); PG8_BAR;
            PG8_LDA(At, 1, 1); PG8_STAGE(PG8_SA(1, 0), a3, voffA);
            PG8_BAR; PG8_WAIT_L(0); PG8_MMA(1, 0, At, B0); PG8_BAR; PG8_SCHED;
            PG8_STAGE(PG8_SB(1, 1), b3 + hstep, voffB);
            PG8_WAIT_V(6); PG8_BAR; PG8_MMA(1, 1, At, B1); PG8_BAR;
            }
        }
        if constexpr (ALIGN_EPI) { if (wr == 0) PG8_BAR; }
        if constexpr (CHAIN) { if (cur.sub < 3) E.mid(acc, cur, wr, wc, fr, fq); else E(acc, cur, wr, wc, fr, fq); S.done(cur); }
        else if constexpr (!Epi::AFTER_DRAIN) { E(acc, cur, wr, wc, fr, fq); S.done(cur); }
        if (!has_next) break;
        if (!CHAIN || cur.sub == 3)
#pragma unroll
        for (int a = 0; a < 2; ++a)
#pragma unroll
            for (int b = 0; b < 2; ++b)
#pragma unroll
                for (int m = 0; m < 4; ++m)
#pragma unroll
                    for (int n = 0; n < 2; ++n) acc[a][b][m][n] = (f32x4){0.f, 0.f, 0.f, 0.f};
        cur = nxt; cA = nA; cB = nB; ++ui;
        if constexpr (ALIGN_EPI) { if (wr == 1) PG8_BAR; }
    }
    PG8_WAIT_V(0);
    if constexpr (!ALIGN_EPI) { if (wr == 0) PG8_BAR; }
    PG8_BAR;
    if constexpr (Epi::AFTER_DRAIN) { E.fused(acc, cur, wr, wc, fr, fq, lds, wid, lane); S.done(cur); }
#undef PG8_ABASE
#undef PG8_BBASE
#undef PG8_SA
#undef PG8_SB
#undef PG8_STAGE
#undef PG8_LDA
#undef PG8_LDB
#undef PG8_MMA
#undef PG8_WAIT_V
#undef PG8_WAIT_L
#undef PG8_BAR
#undef PG8_SCHED
}
}

constexpr int NB = 32, SEQ = 2048, NMETA = 16, TT = SEQ + NMETA, D = 1024, NL = 4, DFF = 4096;
constexpr int NG = 4, GB = NB / NG, MR = GB * SEQ  , MT = MR + NMETA  ;
constexpr int NCOLS = 9696, NZ = 9728, ZB = 9216, ZFW = 512;
constexpr float EPS = 1e-6f;
constexpr int ZC_GQ = 0, ZC_GK = 512, ZC_GV = 1024, ZC_GR = 2048, ZC_MQ = 3072, ZC_MK = 3584, ZC_MV = 4096, ZC_MO = 5120, ZC_GATE = 6144;
constexpr int ZF_CQ = 0, ZF_CKV = 256, ZF_IK = 384, ZF_A = 448, ZF_IW = 464, ZF_MI = 472, ZF_MF = 476;
constexpr int NQQ = 2560;

constexpr size_t MiB = 1u << 20;
constexpr size_t WS_CTL = 0, CTL_ZERO_BYTES = 1 * MiB;
constexpr size_t WS_BIN = 1 * MiB;
constexpr size_t WS_WIN = 2 * MiB;
constexpr size_t WS_WQQ = 78 * MiB;
constexpr size_t WS_WBG = 83 * MiB;
constexpr size_t WS_WBM = 91 * MiB;
constexpr size_t WS_WBD = 99 * MiB;
constexpr size_t WS_WOUT = 115 * MiB;
constexpr size_t WS_WUP = 123 * MiB;
constexpr size_t WS_WDN = 155 * MiB;
constexpr size_t WS_HM = 187 * MiB;
constexpr size_t WS_XN = 188 * MiB;
constexpr size_t WS_ZF = 221 * MiB;
constexpr size_t WS_CQN = 254 * MiB;
constexpr size_t WS_KV = 263 * MiB;
constexpr size_t WS_KI = 268 * MiB;
constexpr size_t WS_WI = 271 * MiB;
constexpr size_t WS_LIF = 272 * MiB;
constexpr size_t WS_G = 273 * MiB;
constexpr size_t WS_QKC = 306 * MiB;
constexpr size_t WS_QQ = 339 * MiB;
constexpr size_t WS_OG = 420 * MiB;
constexpr size_t WS_OM = 453 * MiB;
constexpr size_t WS_OD = 486 * MiB;
constexpr size_t WS_Z = 551 * MiB;
constexpr size_t WS_MIX = 840 * MiB;
constexpr size_t WS_Y = 873 * MiB;
constexpr size_t WS_SC = 840 * MiB;
constexpr size_t WS_DD = 1020 * MiB;
constexpr size_t WS_END = 1024 * MiB;
constexpr int SC_PITCH = 2080;
static_assert(WS_Z + (size_t)MT * ZB * 2 <= WS_MIX && WS_Y + (size_t)MT * D * 4 <= WS_END && WS_SC + (size_t)256 * 64 * SC_PITCH * 4 <= WS_END, "ws map");

constexpr int CW_BAR = 4096;

constexpr int RING_BYTES = 131072;
constexpr int MISC_OFF = RING_BYTES + 320;
constexpr int LDS_BYTES = 147456;
constexpr int NWAVES = 8;

#define LAS __attribute__((address_space(3)))
typedef unsigned short bf16;
typedef float f32x4 __attribute__((ext_vector_type(4)));
typedef float f32x2 __attribute__((ext_vector_type(2)));
typedef unsigned u32x4 __attribute__((ext_vector_type(4)));
typedef unsigned u32x2 __attribute__((ext_vector_type(2)));
typedef short bf16x8 __attribute__((ext_vector_type(8)));
typedef short s16x4 __attribute__((ext_vector_type(4)));
#define LDS_WAIT() asm volatile("s_waitcnt lgkmcnt(0)" ::: "memory")
#define VM_WAIT() asm volatile("s_waitcnt vmcnt(0)" ::: "memory")

typedef __bf16 hwbf16x2 __attribute__((ext_vector_type(2)));
__device__ __forceinline__ unsigned pk2(float lo, float hi) { const f32x2 v = {lo, hi}; const hwbf16x2 b = __builtin_convertvector(v, hwbf16x2); return __builtin_bit_cast(unsigned, b); }
__device__ __forceinline__ unsigned f2bf(float f) { return pk2(f, 0.f) & 0xffffu; }
__device__ __forceinline__ float bf2f(unsigned b) { return __builtin_bit_cast(float, b << 16); }
__device__ __forceinline__ float bflo(unsigned w) { return __builtin_bit_cast(float, w << 16); }
__device__ __forceinline__ float bfhi(unsigned w) { return __builtin_bit_cast(float, w & 0xffff0000u); }
__device__ __forceinline__ float wave_sum(float v) {
#pragma unroll
    for (int o = 1; o < 64; o <<= 1) v += __shfl_xor(v, o);
    return v;
}
__device__ __forceinline__ float wave_max(float v) {
#pragma unroll
    for (int o = 1; o < 64; o <<= 1) v = fmaxf(v, __shfl_xor(v, o));
    return v;
}
__device__ __forceinline__ float sigmoid_f(float x) { return __builtin_amdgcn_rcpf(1.f + __builtin_amdgcn_exp2f(-1.4426950408889634f * x)); }
__device__ __forceinline__ float silu_f(float x) { return x * sigmoid_f(x); }
__device__ __forceinline__ float logsigmoid_f(float x) { return fminf(x, 0.f) - 0.6931471805599453f * __builtin_amdgcn_logf(1.f + __builtin_amdgcn_exp2f(-1.4426950408889634f * fabsf(x))); }

#define XB_TMO      128
#define XB_XCNT(j)  (256  + 64 * (j))
#define XB_XSUB(j)  (1280 + 64 * (j))
#define XB_XGEN(j)  (2304 + 64 * (j))
#define XB_TOP      3328
#define XB_TOPGEN   3392
#define XCD_BAR_WORDS 3456
#define XB_SPIN_CAP (1u << 22)

__device__ __forceinline__ unsigned xb_ld(unsigned* p)              { return __hip_atomic_load(p, __ATOMIC_RELAXED, __HIP_MEMORY_SCOPE_AGENT); }
__device__ __forceinline__ unsigned xb_add(unsigned* p, unsigned v) { return __hip_atomic_fetch_add(p, v, __ATOMIC_RELAXED, __HIP_MEMORY_SCOPE_AGENT); }
__device__ __forceinline__ unsigned xb_xcc_id() { return (unsigned)__builtin_amdgcn_s_getreg((3 << 11) | 20) & 0xFu; }
#define XB_SPIN(cond, bar) do { unsigned _sp = 0; while (cond) { __builtin_amdgcn_s_sleep(1); \
    if ((++_sp & 255u) == 0u) { if (xb_ld(&(bar)[XB_TMO])) break; if (_sp > XB_SPIN_CAP) { atomicAdd(&(bar)[XB_TMO], 1u); break; } } } } while (0)

struct XcdBarrier {
    unsigned* bar; unsigned x;
    volatile LAS unsigned* st;
};

__device__ __forceinline__ XcdBarrier xcd_barrier_post(unsigned* bar, volatile LAS unsigned* st) {
    XcdBarrier b; b.bar = bar; b.x = xb_xcc_id(); b.st = st;
    if (threadIdx.x == 0) (void)xb_add(&bar[XB_XCNT(b.x)], 1u);
    return b;
}
__device__ __forceinline__ void xcd_barrier_complete(unsigned* bar, unsigned x, unsigned& nloc, unsigned& nx) {
    const unsigned G = gridDim.x * gridDim.y * gridDim.z;
    unsigned sum, cnt, mine, sp = 0u;
    for (;;) {
        sum = 0u; cnt = 0u; mine = 0u;
#pragma unroll
        for (unsigned j = 0; j < 16; ++j) { const unsigned c = xb_ld(&bar[XB_XCNT(j)]); sum += c; cnt += (c > 0u) ? 1u : 0u; mine = (j == x) ? c : mine; }
        if (sum == G) break;
        __builtin_amdgcn_s_sleep(1);
        if ((++sp & 255u) == 0u) { if (xb_ld(&bar[XB_TMO])) break; if (sp > XB_SPIN_CAP) { atomicAdd(&bar[XB_TMO], 1u); break; } }
    }
    nloc = mine > 0u ? mine : 1u; nx = cnt > 0u ? cnt : 1u;
}

__device__ __forceinline__ void xcd_barrier(const XcdBarrier& b) {
    asm volatile("s_waitcnt vmcnt(0)" ::: "memory");
    __syncthreads();
    if (threadIdx.x == 0) {
        unsigned* bar = b.bar;
        __builtin_amdgcn_s_waitcnt(0);
        unsigned nloc = b.st[0], nx = b.st[1];
        if (nloc == 0u) { xcd_barrier_complete(bar, b.x, nloc, nx); b.st[0] = nloc; b.st[1] = nx; }
        const unsigned old = xb_add(&bar[XB_XSUB(b.x)], 1u);
        const unsigned gen = old / nloc;
        if (old + 1u == (gen + 1u) * nloc) {
            __builtin_amdgcn_fence(__ATOMIC_RELEASE, "agent");
            asm volatile("s_waitcnt vmcnt(0)" ::: "memory");
            const unsigned og = xb_add(&bar[XB_TOP], 1u);
            const unsigned tg = og / nx;
            if (og + 1u == (tg + 1u) * nx) xb_add(&bar[XB_TOPGEN], 1u);
            else XB_SPIN(xb_ld(&bar[XB_TOPGEN]) == tg, bar);
            __builtin_amdgcn_fence(__ATOMIC_ACQUIRE, "agent");
            xb_add(&bar[XB_XGEN(b.x)], 1u);
            asm volatile("s_waitcnt vmcnt(0)" ::: "memory");
        } else {
            XB_SPIN(xb_ld(&bar[XB_XGEN(b.x)]) == gen, bar);
            __builtin_amdgcn_fence(__ATOMIC_ACQUIRE, "agent");
            asm volatile("s_waitcnt vmcnt(0)" ::: "memory");
        }
    }
    __syncthreads();
}


struct Args { const float* in[28]; float* out; unsigned char* ws; int g_lo, g_hi, l_lo, l_hi, ph_lo, ph_hi, prep, use_bar; };
typedef const __attribute__((address_space(4))) Args* ArgsP;
enum { I_X = 0, I_META, I_T5, I_GPREMIX, I_WIN, I_BIN, I_WA2, I_BA, I_GGLA, I_WBRG, I_GDQ, I_WUQ, I_WIQ, I_GDKV, I_WUV, I_LNG, I_LNB, I_WBRD,
       I_CONV, I_FB, I_GML, I_WBRM, I_WOUT, I_GPOSTMIX, I_GPREMLP, I_WUP, I_WDN, I_GPOSTMLP };

__device__ __forceinline__ int win_src(int n) {
    if (n < 3072) return n;
    if (n < 6144) return n - 3072 + 3544;
    if (n < 9216) return n - 6144 + 6624;
    if (n < 9472) return n - 9216 + 3088;
    if (n < 9600) return n - 9472 + 3344;
    if (n < 9664) return n - 9600 + 3472;
    if (n < 9680) return n - 9664 + 3072;
    if (n < 9688) return n - 9680 + 3536;
    if (n < 9692) return n - 9688 + 6616;
    if (n < 9696) return n - 9692 + 6620;
    return -1;
}
struct CmIdent { __device__ __forceinline__ int operator()(int n) const { return n; } };
struct CmWin { __device__ __forceinline__ int operator()(int n) const { return win_src(n); } };

template <class CM>
__device__ __forceinline__ void tr_item(const float* __restrict__ W, int ldw, bf16* __restrict__ WT, int Kd, LAS float* scr, int k0, int ns0, int nd0, int lane, CM cm) {
    const int sc = cm(ns0 + (lane & 31));
#pragma unroll 8
    for (int i = 0; i < 32; ++i) { const int kk = 2 * i + (lane >> 5); scr[kk * 33 + (lane & 31)] = sc >= 0 ? W[(size_t)(k0 + kk) * ldw + sc] : 0.f; }
    LDS_WAIT();
    const int c = lane & 7;
#pragma unroll
    for (int j = 0; j < 4; ++j) { const int n = (lane >> 3) + 8 * j; const LAS float* s = scr + (8 * c) * 33 + n;
        u32x4 o; o.x = pk2(s[0 * 33], s[1 * 33]); o.y = pk2(s[2 * 33], s[3 * 33]); o.z = pk2(s[4 * 33], s[5 * 33]); o.w = pk2(s[6 * 33], s[7 * 33]);
        *(u32x4*)(WT + (size_t)(nd0 + n) * Kd + k0 + 8 * c) = o; }
    LDS_WAIT();
}

__device__ __forceinline__ void prep_weights(ArgsP a, LAS unsigned char* lds, int gw, int ngw, int wave, int lane) {
    LAS float* scr = (LAS float*)(lds + wave * 16384);
    unsigned char* ws = a->ws;
    constexpr int I_WIN_N = 16 * 304, I_UQ = 4 * 64, I_IQ = 4 * 16, I_SQ = 16 * 32, I_UP = 16 * 128, I_DN = 64 * 32, I_WBD = 512, I_B = NZ / 64;
    constexpr int PER_L = I_WIN_N + I_UQ + I_IQ + 3 * I_SQ + I_UP + I_DN + I_WBD + I_B;
    for (int it = gw; it < NL * PER_L; it += ngw) {
        const int l = it / PER_L; int r = it % PER_L;
        if (r < I_WIN_N) { const int kb = r / 304, nb = r % 304;
            tr_item(a->in[I_WIN] + (size_t)l * D * NCOLS, NCOLS, (bf16*)(ws + WS_WIN) + (size_t)l * NZ * D, D, scr, kb * 64, nb * 32, nb * 32, lane, CmWin()); continue; }
        r -= I_WIN_N;
        if (r < I_UQ) { const int kb = r / 64, nb = r % 64;
            tr_item(a->in[I_WUQ] + (size_t)l * 256 * 2048, 2048, (bf16*)(ws + WS_WQQ) + (size_t)l * NQQ * 256, 256, scr, kb * 64, nb * 32, nb * 32, lane, CmIdent()); continue; }
        r -= I_UQ;
        if (r < I_IQ) { const int kb = r / 16, nb = r % 16;
            tr_item(a->in[I_WIQ] + (size_t)l * 256 * 512, 512, (bf16*)(ws + WS_WQQ) + (size_t)l * NQQ * 256, 256, scr, kb * 64, nb * 32, 2048 + nb * 32, lane, CmIdent()); continue; }
        r -= I_IQ;
        if (r < I_SQ) { const int kb = r / 32, nb = r % 32;
            tr_item(a->in[I_WBRG] + (size_t)l * D * D, D, (bf16*)(ws + WS_WBG) + (size_t)l * D * D, D, scr, kb * 64, nb * 32, nb * 32, lane, CmIdent()); continue; }
        r -= I_SQ;
        if (r < I_SQ) { const int kb = r / 32, nb = r % 32;
            tr_item(a->in[I_WBRM] + (size_t)l * D * D, D, (bf16*)(ws + WS_WBM) + (size_t)l * D * D, D, scr, kb * 64, nb * 32, nb * 32, lane, CmIdent()); continue; }
        r -= I_SQ;
        if (r < I_SQ) { const int kb = r / 32, nb = r % 32;
            tr_item(a->in[I_WOUT] + (size_t)l * D * D, D, (bf16*)(ws + WS_WOUT) + (size_t)l * D * D, D, scr, kb * 64, nb * 32, nb * 32, lane, CmIdent()); continue; }
        r -= I_SQ;
        if (r < I_UP) { const int kb = r / 128, nb = r % 128;
            tr_item(a->in[I_WUP] + (size_t)l * D * DFF, DFF, (bf16*)(ws + WS_WUP) + (size_t)l * DFF * D, D, scr, kb * 64, nb * 32, nb * 32, lane, CmIdent()); continue; }
        r -= I_UP;
        if (r < I_DN) { const int kb = r / 32, nb = r % 32;
            tr_item(a->in[I_WDN] + (size_t)l * DFF * D, D, (bf16*)(ws + WS_WDN) + (size_t)l * D * DFF, DFF, scr, kb * 64, nb * 32, nb * 32, lane, CmIdent()); continue; }
        r -= I_DN;
        if (r < I_WBD) {
            const int h = r >> 5, ch = (r >> 4) & 1, nb = r & 15, c = ch * 64 + lane;
            const float* uv = a->in[I_WUV] + ((size_t)(l * 16 + h) * 128 + c) * 64;
            const float* wb = a->in[I_WBRD] + ((size_t)l * D + h * 64) * D + nb * 64;
            bf16* o = (bf16*)(ws + WS_WBD) + (size_t)l * D * 2048 + (size_t)(h >> 3) * D * D + (size_t)(nb * 64) * D + (h & 7) * 128 + c;
            f32x4 w[16];
#pragma unroll
            for (int i = 0; i < 16; ++i) w[i] = *(const f32x4*)(uv + 4 * i);
            for (int nn = 0; nn < 64; ++nn) {
                float acc = 0.f;
#pragma unroll
                for (int i = 0; i < 16; ++i) { acc += w[i].x * wb[(size_t)(4 * i + 0) * D + nn] + w[i].y * wb[(size_t)(4 * i + 1) * D + nn] + w[i].z * wb[(size_t)(4 * i + 2) * D + nn] + w[i].w * wb[(size_t)(4 * i + 3) * D + nn]; }
                o[(size_t)nn * D] = (bf16)f2bf(acc);
            }
            continue; }
        r -= I_WBD;
        { const int n = r * 64 + lane; const int sc = win_src(n);
          ((float*)(ws + WS_BIN))[l * NZ + n] = sc >= 0 ? a->in[I_BIN][l * NCOLS + sc] : 0.f; }
    }
}

__device__ __forceinline__ float* hrow(ArgsP a, int g, int r) {
    return r < MR ? a->out + ((size_t)g * MR + r) * D : (float*)(a->ws + WS_HM) + (size_t)(r - MR) * D;
}
__device__ __forceinline__ void rms_row_bf16(const f32x4 (&v)[4], const float* __restrict__ gain, bf16* __restrict__ orow, int lane) {
    float s = 0.f;
#pragma unroll
    for (int j = 0; j < 4; ++j) s += (v[j].x * v[j].x + v[j].y * v[j].y) + (v[j].z * v[j].z + v[j].w * v[j].w);
    const float r = rsqrtf(wave_sum(s) * (1.f / D) + EPS);
#pragma unroll
    for (int j = 0; j < 4; ++j) { const f32x4 gg = *(const f32x4*)(gain + 4 * lane + 256 * j); const f32x4 o = v[j] * r * gg;
        u32x2 w; w.x = pk2(o.x, o.y); w.y = pk2(o.z, o.w); *(u32x2*)(orow + 4 * lane + 256 * j) = w; }
}
__device__ __forceinline__ void p0_init(ArgsP a, int g, int gw, int ngw, int lane) {
    bf16* XN = (bf16*)(a->ws + WS_XN);
    for (int r = gw; r < MT; r += ngw) {
        const float* src = r < MR ? a->in[I_X] + ((size_t)g * MR + r) * D : a->in[I_META] + (size_t)(r - MR) * D;
        float* hd = hrow(a, g, r);
        f32x4 v[4];
#pragma unroll
        for (int j = 0; j < 4; ++j) { v[j] = *(const f32x4*)(src + 4 * lane + 256 * j); *(f32x4*)(hd + 4 * lane + 256 * j) = v[j]; }
        rms_row_bf16(v, a->in[I_GPREMIX], XN + (size_t)r * D, lane);
    }
}
template <bool DRY = false>
__device__ __forceinline__ void p_norm_res(ArgsP a, int g, const float* gpost, const float* gpre, int gw, int ngw, int lane) {
    bf16* XN = (bf16*)(a->ws + (DRY ? WS_Z + 100 * MiB : WS_XN)); const bf16* Y = (const bf16*)(a->ws + WS_Y);
    for (int r = gw; r < MT; r += ngw) {
        float* hd = hrow(a, g, r); float* hw = DRY ? (float*)(a->ws + WS_Z) + (size_t)r * D : hd;
        f32x4 y[4], v[4]; float s = 0.f;
#pragma unroll
        for (int j = 0; j < 4; ++j) { { const u32x2 yw = *(const u32x2*)(Y + (size_t)r * D + 4 * lane + 256 * j); y[j] = (f32x4){bflo(yw.x), bfhi(yw.x), bflo(yw.y), bfhi(yw.y)}; } v[j] = *(const f32x4*)(hd + 4 * lane + 256 * j);
            s += (y[j].x * y[j].x + y[j].y * y[j].y) + (y[j].z * y[j].z + y[j].w * y[j].w); }
        const float rr = rsqrtf(wave_sum(s) * (1.f / D) + EPS);
#pragma unroll
        for (int j = 0; j < 4; ++j) { const f32x4 gg = *(const f32x4*)(gpost + 4 * lane + 256 * j); v[j] = v[j] + y[j] * rr * gg; *(f32x4*)(hw + 4 * lane + 256 * j) = v[j]; }
        if (gpre) rms_row_bf16(v, gpre, XN + (size_t)r * D, lane);
    }
}

template <class F> struct EpiT {
    static constexpr bool PERM = true, AFTER_DRAIN = false;
    F f;
    __device__ __forceinline__ void operator()(const f32x4 (&acc)[2][2][4][2], const pg8::Unit& u, int wr, int wc, int fr, int fq) const {
        const int row0 = u.pm * 256 + wr * 64 + fr, col0 = u.pn * 256 + wc * 32 + 8 * fq;
        if constexpr (F::HAS_BIAS) {
            const f32x4 b00 = *(const f32x4*)(f.bias + col0), b01 = *(const f32x4*)(f.bias + col0 + 4), b10 = *(const f32x4*)(f.bias + col0 + 128), b11 = *(const f32x4*)(f.bias + col0 + 132);
#pragma unroll
            for (int ai = 0; ai < 2; ++ai)
#pragma unroll
                for (int m = 0; m < 4; ++m) { f.apply(row0 + ai * 128 + m * 16, col0, acc[ai][0][m][0] + b00, acc[ai][0][m][1] + b01); f.apply(row0 + ai * 128 + m * 16, col0 + 128, acc[ai][1][m][0] + b10, acc[ai][1][m][1] + b11); }
            return;
        }
#pragma unroll
        for (int ai = 0; ai < 2; ++ai)
#pragma unroll
            for (int m = 0; m < 4; ++m)
#pragma unroll
                for (int bj = 0; bj < 2; ++bj) f.apply(row0 + ai * 128 + m * 16, col0 + bj * 128, acc[ai][bj][m][0], acc[ai][bj][m][1]);
    }
};
__device__ __forceinline__ void st_bf16x8(bf16* p, f32x4 v0, f32x4 v1) { u32x4 w; w.x = pk2(v0.x, v0.y); w.y = pk2(v0.z, v0.w); w.z = pk2(v1.x, v1.y); w.w = pk2(v1.z, v1.w); *(u32x4*)p = w; }
__device__ __forceinline__ void ld_bf16x8(const bf16* p, f32x4& v0, f32x4& v1) { const u32x4 w = *(const u32x4*)p;
    v0 = (f32x4){bflo(w.x), bfhi(w.x), bflo(w.y), bfhi(w.y)}; v1 = (f32x4){bflo(w.z), bfhi(w.z), bflo(w.w), bfhi(w.w)}; }

struct FIn {
    static constexpr bool HAS_BIAS = true, STAGGER = true;
    bf16* Z; float* ZF; const float* bias;
    __device__ __forceinline__ void apply(int row, int col, f32x4 v0, f32x4 v1) const {
        const int t = col >> 8;
        if (t >= 36) { float* p = ZF + (size_t)row * ZFW + (col - ZB); *(f32x4*)p = v0; *(f32x4*)(p + 4) = v1; return; }
        if (t < 2) { v0 *= 0.08838834764831845f; v1 *= 0.08838834764831845f; }
        else if (t >= 8 && t < 12) {
#pragma unroll
            for (int i = 0; i < 4; ++i) { v0[i] = silu_f(v0[i]); v1[i] = silu_f(v1[i]); } }
        else if (t >= 20) {
#pragma unroll
            for (int i = 0; i < 4; ++i) { v0[i] = sigmoid_f(v0[i]); v1[i] = sigmoid_f(v1[i]); } }
        st_bf16x8(Z + (size_t)row * ZB + col, v0, v1);
    }
};
struct FQQ {
    static constexpr bool HAS_BIAS = false, STAGGER = false;
    bf16* QQ;
    __device__ __forceinline__ void apply(int row, int col, f32x4 v0, f32x4 v1) const {
        const float s = col < 2048 ? 0.08838834764831845f : 0.125f;
        st_bf16x8(QQ + (size_t)row * NQQ + col, v0 * s, v1 * s);
    }
};
template <int IDX> struct FBr {
    static constexpr bool HAS_BIAS = false;
    const bf16* Z; float* Y; bf16* MIX;
    __device__ __forceinline__ void apply(int row, int col, f32x4 v0, f32x4 v1) const {
        f32x4 g0, g1; ld_bf16x8(Z + (size_t)row * ZB + ZC_GATE + IDX * 1024 + col, g0, g1);
        float* y = Y + (size_t)row * D + col;
        f32x4 a0 = v0 * g0, a1 = v1 * g1;
        if (IDX > 0) { a0 += *(const f32x4*)y; a1 += *(const f32x4*)(y + 4); }
        if (IDX < 2) { *(f32x4*)y = a0; *(f32x4*)(y + 4) = a1; }
        else st_bf16x8(MIX + (size_t)row * D + col, a0, a1);
    }
};
struct FY {
    static constexpr bool HAS_BIAS = false, STAGGER = false;
    bf16* Y;
    __device__ __forceinline__ void apply(int row, int col, f32x4 v0, f32x4 v1) const { st_bf16x8(Y + (size_t)row * D + col, v0, v1); }
};
struct FUp {
    static constexpr bool HAS_BIAS = false, STAGGER = true;
    bf16* U;
    __device__ __forceinline__ void apply(int row, int col, f32x4 v0, f32x4 v1) const {
#pragma unroll
        for (int i = 0; i < 4; ++i) { const float p = fmaxf(v0[i], 0.f), q = fmaxf(v1[i], 0.f); v0[i] = p * p; v1[i] = q * q; }
        st_bf16x8(U + (size_t)row * DFF + col, v0, v1);
    }
};

template <class F>
__device__ __forceinline__ void mini_gemm(LAS unsigned char* lds, const bf16* __restrict__ A, const bf16* __restrict__ Bt, int N, int K, const F& f, int tid_in) {
    int tid = tid_in; asm volatile("" : "+v"(tid));
    const int lane = tid & 63, wave = __builtin_amdgcn_readfirstlane(tid >> 6), fr = lane & 15, fq = lane >> 4;
    LAS float* red = (LAS float*)lds;
    const int kw = K >> 3, kbeg = wave * kw;
    for (int wt = blockIdx.x; wt < N / 32; wt += gridDim.x) {
        const int n0 = wt * 32;
        f32x4 acc0 = {0.f, 0.f, 0.f, 0.f}, acc1 = {0.f, 0.f, 0.f, 0.f};
        const bf16* ap = A + (size_t)(MR + fr) * K + fq * 8 + kbeg;
        const bf16* b0 = Bt + (size_t)(n0 + pg8::perm32(fr)) * K + fq * 8 + kbeg;
        const bf16* b1 = Bt + (size_t)(n0 + pg8::perm32(16 + fr)) * K + fq * 8 + kbeg;
        if (kw < 128) {
            const bf16x8 av = *(const bf16x8*)ap, w0 = *(const bf16x8*)b0, w1 = *(const bf16x8*)b1;
            acc0 = __builtin_amdgcn_mfma_f32_16x16x32_bf16(w0, av, acc0, 0, 0, 0);
            acc1 = __builtin_amdgcn_mfma_f32_16x16x32_bf16(w1, av, acc1, 0, 0, 0);
        } else {
            for (int k = 0; k < kw; k += 128) {
                bf16x8 av[4], w0[4], w1[4];
#pragma unroll
                for (int u = 0; u < 4; ++u) { av[u] = *(const bf16x8*)(ap + k + 32 * u); w0[u] = *(const bf16x8*)(b0 + k + 32 * u); w1[u] = *(const bf16x8*)(b1 + k + 32 * u); }
#pragma unroll
                for (int u = 0; u < 4; ++u) {
                    acc0 = __builtin_amdgcn_mfma_f32_16x16x32_bf16(w0[u], av[u], acc0, 0, 0, 0);
                    acc1 = __builtin_amdgcn_mfma_f32_16x16x32_bf16(w1[u], av[u], acc1, 0, 0, 0);
                }
            }
        }
        *(LAS f32x4*)(red + (wave * 64 + lane) * 8) = acc0; *(LAS f32x4*)(red + (wave * 64 + lane) * 8 + 4) = acc1;
        LDS_WAIT();
        __syncthreads();
        if (wave == 0) {
            f32x4 s0 = {0.f, 0.f, 0.f, 0.f}, s1 = {0.f, 0.f, 0.f, 0.f};
#pragma unroll
            for (int w = 0; w < 8; ++w) { s0 += *(const LAS f32x4*)(red + (w * 64 + lane) * 8); s1 += *(const LAS f32x4*)(red + (w * 64 + lane) * 8 + 4); }
            if constexpr (F::HAS_BIAS) { s0 += *(const f32x4*)(f.bias + n0 + 8 * fq); s1 += *(const f32x4*)(f.bias + n0 + 8 * fq + 4); }
            f.apply(MR + fr, n0 + 8 * fq, s0, s1);
        }
        __syncthreads();
    }
}
template <class F, bool ALIGN = true>
__device__ __forceinline__ void run_gemm(LAS unsigned char* lds, const bf16* A, const bf16* Bt, int N, int K, const F& f, int gw, int ngw, int lane) {
    asm volatile("" : "+s"(K)); asm volatile("" : "+s"(N));
    pg8::Gemm g{A, Bt, MR, N, K}; pg8::StaticOrder S; S.init(MR, N, (int)gridDim.x, (int)blockIdx.x);
    EpiT<F> E{f};
#if defined(STAGGER_TICKS)
    if (F::STAGGER) {
        const unsigned long long t0 = __builtin_amdgcn_s_memrealtime(), dl = (unsigned long long)(blockIdx.x & 3u) * STAGGER_TICKS;
        while (__builtin_amdgcn_s_memrealtime() - t0 < dl) __builtin_amdgcn_s_sleep(4);
    }
#endif
    pg8::gemm_phase<EpiT<F>, pg8::StaticOrder, ALIGN, true>((PG8_LAS unsigned char*)lds, g, S, E);
    mini_gemm(lds, A, Bt, N, K, f, (int)threadIdx.x);
}

struct ChainOrder {
    pg8::StaticOrder S;
    __device__ __forceinline__ bool next(int i, pg8::Unit& u) const { if (!S.next(i >> 2, u)) return false; u.sub = i & 3; return true; }
    __device__ __forceinline__ void a_ready(const pg8::Unit&) const {}
    __device__ __forceinline__ void done(const pg8::Unit&) const {}
};
struct EpiMix {
    static constexpr bool PERM = true, AFTER_DRAIN = false;
    const bf16* Z; bf16* MIX;
    __device__ __forceinline__ void mid(f32x4 (&acc)[2][2][4][2], const pg8::Unit& u, int wr, int wc, int fr, int fq) const {
        if (u.sub == 1) return;
        const int gi = u.sub == 0 ? 0 : 1;
        const int row0 = u.pm * 256 + wr * 64 + fr, col0 = u.pn * 256 + wc * 32 + 8 * fq;
#pragma unroll
        for (int ai = 0; ai < 2; ++ai) {
            u32x4 ga[4][2], gb[4][2];
#pragma unroll
            for (int m = 0; m < 4; ++m)
#pragma unroll
                for (int bj = 0; bj < 2; ++bj) { const bf16* gp = Z + (size_t)(row0 + ai * 128 + m * 16) * ZB + ZC_GATE + gi * 1024 + col0 + bj * 128;
                    ga[m][bj] = *(const u32x4*)gp; gb[m][bj] = *(const u32x4*)(gp + 1024); }
#pragma unroll
            for (int m = 0; m < 4; ++m)
#pragma unroll
                for (int bj = 0; bj < 2; ++bj) {
                    const u32x4 a = ga[m][bj], b = gb[m][bj];
                    f32x4 r0, r1;
                    r0.x = bflo(a.x) * __builtin_amdgcn_rcpf(bflo(b.x)); r0.y = bfhi(a.x) * __builtin_amdgcn_rcpf(bfhi(b.x)); r0.z = bflo(a.y) * __builtin_amdgcn_rcpf(bflo(b.y)); r0.w = bfhi(a.y) * __builtin_amdgcn_rcpf(bfhi(b.y));
                    r1.x = bflo(a.z) * __builtin_amdgcn_rcpf(bflo(b.z)); r1.y = bfhi(a.z) * __builtin_amdgcn_rcpf(bfhi(b.z)); r1.z = bflo(a.w) * __builtin_amdgcn_rcpf(bflo(b.w)); r1.w = bfhi(a.w) * __builtin_amdgcn_rcpf(bfhi(b.w));
                    acc[ai][bj][m][0] *= r0; acc[ai][bj][m][1] *= r1;
                }
            asm volatile("" ::: "memory");
        }
    }
    __device__ __forceinline__ void operator()(const f32x4 (&acc)[2][2][4][2], const pg8::Unit& u, int wr, int wc, int fr, int fq) const {
        const int row0 = u.pm * 256 + wr * 64 + fr, col0 = u.pn * 256 + wc * 32 + 8 * fq;
#pragma unroll
        for (int ai = 0; ai < 2; ++ai) {
            u32x4 gc[4][2];
#pragma unroll
            for (int m = 0; m < 4; ++m)
#pragma unroll
                for (int bj = 0; bj < 2; ++bj) gc[m][bj] = *(const u32x4*)(Z + (size_t)(row0 + ai * 128 + m * 16) * ZB + ZC_GATE + 2 * 1024 + col0 + bj * 128);
#pragma unroll
            for (int m = 0; m < 4; ++m)
#pragma unroll
                for (int bj = 0; bj < 2; ++bj) {
                    const u32x4 w = gc[m][bj];
                    const f32x4 g0 = {bflo(w.x), bfhi(w.x), bflo(w.y), bfhi(w.y)}, g1 = {bflo(w.z), bfhi(w.z), bflo(w.w), bfhi(w.w)};
                    st_bf16x8(MIX + (size_t)(row0 + ai * 128 + m * 16) * D + col0 + bj * 128, acc[ai][bj][m][0] * g0, acc[ai][bj][m][1] * g1);
                }
            asm volatile("" ::: "memory");
        }
    }
};

__device__ __forceinline__ int prow(int r, int j) {
    if (r < MR) { const int s = r & (SEQ - 1); return (s - j >= 0) ? r - j : MR + (NMETA + s - j); }
    const int t = r - MR; return (t - j >= 0) ? r - j : -1;
}
__device__ __forceinline__ void p2_prep(ArgsP a, int l, int gw, int ngw, int lane) {
    unsigned char* ws = a->ws;
    const bf16* Z = (const bf16*)(ws + WS_Z);
    for (int r = gw; r < MT; r += ngw) {
        const float* zf = (const float*)(ws + WS_ZF) + (size_t)r * ZFW;
        f32x4 vq = *(const f32x4*)(zf + ZF_CQ + 4 * lane);
        f32x2 vk = *(const f32x2*)(zf + ZF_CKV + 2 * lane);
        const float vi = zf[ZF_IK + lane];
        const float vw = zf[ZF_IW + (lane & 7)];
        const f32x4 gq = *(const f32x4*)(a->in[I_GDQ] + l * 256 + 4 * lane);
        const f32x2 gk = *(const f32x2*)(a->in[I_GDKV] + l * 128 + 2 * lane);
        const float lg = a->in[I_LNG][l * 64 + lane], lb = a->in[I_LNB][l * 64 + lane];
        float s1 = (vq.x * vq.x + vq.y * vq.y) + (vq.z * vq.z + vq.w * vq.w), s2 = vk.x * vk.x + vk.y * vk.y, s3 = vi;
#pragma unroll
        for (int o = 1; o < 64; o <<= 1) { s1 += __shfl_xor(s1, o); s2 += __shfl_xor(s2, o); s3 += __shfl_xor(s3, o); }
        const float d = vi - s3 * (1.f / 64.f);
        const float var = wave_sum(d * d) * (1.f / 64.f);
        const float r1 = rsqrtf(s1 * (1.f / 256.f) + EPS), r2 = rsqrtf(s2 * (1.f / 128.f) + EPS);
        vq = vq * r1 * gq;
        { u32x2 w; w.x = pk2(vq.x, vq.y); w.y = pk2(vq.z, vq.w); *(u32x2*)((bf16*)(ws + WS_CQN) + (size_t)r * 256 + 4 * lane) = w; }
        *(unsigned*)((bf16*)(ws + WS_KV) + (size_t)r * 128 + 2 * lane) = pk2(vk.x * r2 * gk.x, vk.y * r2 * gk.y);
        ((bf16*)(ws + WS_KI))[(size_t)r * 64 + lane] = (bf16)f2bf(d * rsqrtf(var + EPS) * lg + lb);
        if (lane < 8) ((float*)(ws + WS_WI))[(size_t)r * 8 + lane] = vw * 0.35355339059327373f;
    }
    float* DDp = (float*)(ws + WS_DD);
    for (int it = gw; it < 257 * 8; it += ngw) {
        const int cid = it >> 3, mx = (it >> 2) & 1, h = it & 3;
        const int nrows = cid == 256 ? NMETA : 64, rbase = cid == 256 ? MR : cid * 64;
        const int k0 = 2 * lane;
        if (!mx) {
            float w0[16], w1[16];
#pragma unroll
            for (int j = 0; j < 16; ++j) { const f32x2 w = *(const f32x2*)(a->in[I_WA2] + (size_t)(l * 16 + j) * 512 + h * 128 + k0); w0[j] = w.x; w1[j] = w.y; }
            const f32x2 bb = *(const f32x2*)(a->in[I_BA] + l * 512 + h * 128 + k0);
            bf16* __restrict__ QG = (bf16*)(ws + WS_G);
            const bf16* __restrict__ Zr = Z; const float* __restrict__ ZFr = (const float*)(ws + WS_ZF);
            float G0 = 0.f, G1 = 0.f;
            f32x4 pa[4][4]; unsigned pq[4], pk[4];
#define P2G_LOAD(t0) do { _Pragma("unroll") for (int i = 0; i < 4; ++i) { const int r_ = rbase + (t0) + i; const float* zf_ = ZFr + (size_t)r_ * ZFW + ZF_A; \
                pa[i][0] = *(const f32x4*)zf_; pa[i][1] = *(const f32x4*)(zf_ + 4); pa[i][2] = *(const f32x4*)(zf_ + 8); pa[i][3] = *(const f32x4*)(zf_ + 12); \
                pq[i] = *(const unsigned*)(Zr + (size_t)r_ * ZB + ZC_GQ + h * 128 + k0); pk[i] = *(const unsigned*)(Zr + (size_t)r_ * ZB + ZC_GK + h * 128 + k0); } } while (0)
            P2G_LOAD(0);
            for (int t0 = 0; t0 < nrows; t0 += 4) {
                f32x4 ca[4][4]; unsigned cqw[4], ckw[4];
#pragma unroll
                for (int i = 0; i < 4; ++i) { ca[i][0] = pa[i][0]; ca[i][1] = pa[i][1]; ca[i][2] = pa[i][2]; ca[i][3] = pa[i][3]; cqw[i] = pq[i]; ckw[i] = pk[i]; }
                if (t0 + 4 < nrows) P2G_LOAD(t0 + 4);
#pragma unroll
                for (int i = 0; i < 4; ++i) {
                    const int r = rbase + t0 + i;
                    const float av[16] = {ca[i][0].x, ca[i][0].y, ca[i][0].z, ca[i][0].w, ca[i][1].x, ca[i][1].y, ca[i][1].z, ca[i][1].w, ca[i][2].x, ca[i][2].y, ca[i][2].z, ca[i][2].w, ca[i][3].x, ca[i][3].y, ca[i][3].z, ca[i][3].w};
                    float s0 = bb.x, s1 = bb.y;
#pragma unroll
                    for (int j = 0; j < 16; ++j) { s0 += av[j] * w0[j]; s1 += av[j] * w1[j]; }
                    G0 += logsigmoid_f(s0) * 0.0625f; G1 += logsigmoid_f(s1) * 0.0625f;
                    const float e0 = __expf(G0), e1 = __expf(G1), i0 = __builtin_amdgcn_rcpf(e0), i1 = __builtin_amdgcn_rcpf(e1);
                    *(unsigned*)(QG + (size_t)r * 1024 + h * 128 + k0) = pk2(bflo(cqw[i]) * e0, bfhi(cqw[i]) * e1);
                    *(unsigned*)(QG + (size_t)r * 1024 + 512 + h * 128 + k0) = pk2(bflo(ckw[i]) * i0, bfhi(ckw[i]) * i1);
                }
            }
#undef P2G_LOAD
            *(f32x2*)(DDp + ((size_t)cid * 4 + h) * 128 + k0) = (f32x2){__expf(G0), __expf(G1)};
        } else {
            float cq[4][2], ck[4][2];
#pragma unroll
            for (int tap = 0; tap < 4; ++tap) { const f32x2 wq = *(const f32x2*)(a->in[I_CONV] + (size_t)(l * 4 + tap) * 1024 + h * 128 + k0), wk = *(const f32x2*)(a->in[I_CONV] + (size_t)(l * 4 + tap) * 1024 + 512 + h * 128 + k0);
                cq[tap][0] = wq.x; cq[tap][1] = wq.y; ck[tap][0] = wk.x; ck[tap][1] = wk.y; }
            const float fb = a->in[I_FB][l * 4 + h];
            bf16* __restrict__ QM = (bf16*)(ws + WS_QKC);
            const bf16* __restrict__ Zr = Z; const float* __restrict__ ZFr = (const float*)(ws + WS_ZF);
            float xq[3][2], xk[3][2];
#pragma unroll
            for (int j = 0; j < 3; ++j) {
                const int rp = prow(rbase, j + 1);
                unsigned qw = 0u, kw = 0u;
                if (rp >= 0) { qw = *(const unsigned*)(Z + (size_t)rp * ZB + ZC_MQ + h * 128 + k0); kw = *(const unsigned*)(Z + (size_t)rp * ZB + ZC_MK + h * 128 + k0); }
                xq[j][0] = bflo(qw); xq[j][1] = bfhi(qw); xk[j][0] = bflo(kw); xk[j][1] = bfhi(kw);
            }
            float bsum = 0.f;
            float pli[4], plf[4]; unsigned pq[4], pk[4];
#define P2M_LOAD(t0) do { _Pragma("unroll") for (int i = 0; i < 4; ++i) { const int r_ = rbase + (t0) + i; const float* zf_ = ZFr + (size_t)r_ * ZFW; \
                pli[i] = zf_[ZF_MI + h]; plf[i] = zf_[ZF_MF + h]; \
                pq[i] = *(const unsigned*)(Zr + (size_t)r_ * ZB + ZC_MQ + h * 128 + k0); pk[i] = *(const unsigned*)(Zr + (size_t)r_ * ZB + ZC_MK + h * 128 + k0); } } while (0)
            P2M_LOAD(0);
            for (int t0 = 0; t0 < nrows; t0 += 4) {
                float cli[4], clf[4]; unsigned cqw[4], ckw[4];
#pragma unroll
                for (int i = 0; i < 4; ++i) { cli[i] = pli[i]; clf[i] = plf[i]; cqw[i] = pq[i]; ckw[i] = pk[i]; }
                if (t0 + 4 < nrows) P2M_LOAD(t0 + 4);
#pragma unroll
                for (int i = 0; i < 4; ++i) {
                    const int r = rbase + t0 + i;
                    const float li = cli[i], lf = logsigmoid_f(clf[i] + fb);
                    bsum += lf;
                    const float q0 = bflo(cqw[i]), q1 = bfhi(cqw[i]), kk0 = bflo(ckw[i]), kk1 = bfhi(ckw[i]);
                    const float yq0 = cq[3][0] * q0 + cq[2][0] * xq[0][0] + cq[1][0] * xq[1][0] + cq[0][0] * xq[2][0];
                    const float yq1 = cq[3][1] * q1 + cq[2][1] * xq[0][1] + cq[1][1] * xq[1][1] + cq[0][1] * xq[2][1];
                    const float yk0 = ck[3][0] * kk0 + ck[2][0] * xk[0][0] + ck[1][0] * xk[1][0] + ck[0][0] * xk[2][0];
                    const float yk1 = ck[3][1] * kk1 + ck[2][1] * xk[0][1] + ck[1][1] * xk[1][1] + ck[0][1] * xk[2][1];
                    xq[2][0] = xq[1][0]; xq[2][1] = xq[1][1]; xq[1][0] = xq[0][0]; xq[1][1] = xq[0][1]; xq[0][0] = q0; xq[0][1] = q1;
                    xk[2][0] = xk[1][0]; xk[2][1] = xk[1][1]; xk[1][0] = xk[0][0]; xk[1][1] = xk[0][1]; xk[0][0] = kk0; xk[0][1] = kk1;
                    const float eq = __expf(bsum) * 0.08838834764831845f, ek = __expf(li - bsum);
                    *(unsigned*)(QM + (size_t)r * 1024 + h * 128 + k0) = pk2(silu_f(yq0) * eq, silu_f(yq1) * eq);
                    *(unsigned*)(QM + (size_t)r * 1024 + 512 + h * 128 + k0) = pk2(silu_f(yk0) * ek, silu_f(yk1) * ek);
                }
            }
#undef P2M_LOAD
            const float dd = __expf(bsum);
            *(f32x2*)(DDp + ((size_t)(257 + cid) * 4 + h) * 128 + k0) = (f32x2){dd, dd};
        }
    }
}

constexpr int SC_QS = 272, SC_VS = 144;
constexpr int SC_QT = 0, SC_KT = 2 * 17408, SC_VT = 4 * 17408, SC_AT = SC_VT + 2 * 9216, SC_SB = SC_AT + 9216, SC_DD = SC_SB + 18432, SC_NB = SC_DD + 1024, SC_END = SC_NB + 256;
static_assert(SC_END <= RING_BYTES, "scan LDS");
__device__ __forceinline__ bf16x8 tr8(LAS unsigned char* base, int stride, int row0, int col0, int lane) {
    const int fq = lane >> 4, q4 = (lane & 15) >> 2, p4 = lane & 3;
    LAS unsigned char* p = base + (row0 + 8 * fq + q4) * stride + (col0 + 4 * p4) * 2;
    const s16x4 lo = __builtin_amdgcn_ds_read_tr16_b64_v4i16((LAS s16x4*)p);
    const s16x4 hi = __builtin_amdgcn_ds_read_tr16_b64_v4i16((LAS s16x4*)(p + 4 * stride));
    return __builtin_shufflevector(lo, hi, 0, 1, 2, 3, 4, 5, 6, 7);
}
template <bool ML>
__device__ __forceinline__ void scan_unit(ArgsP a, LAS unsigned char* lds, int b, int h, int vs, int tid_in) {
    int tid = tid_in; asm volatile("" : "+v"(tid));
    unsigned char* ws = a->ws;
    const bf16* Z = (const bf16*)(ws + WS_Z);
    const bf16* QK = (const bf16*)(ws + (ML ? WS_QKC : WS_G));
    const float* DDp = (const float*)(ws + WS_DD) + (ML ? (size_t)257 * 512 : 0);
    bf16* O = (bf16*)(ws + (ML ? WS_OM : WS_OG));
    const int lane = tid & 63, wave = __builtin_amdgcn_readfirstlane(tid >> 6), fr = lane & 15, fq = lane >> 4;
    const int vt = wave & 3, hh = wave >> 2;
    for (int i = tid; i < (18432 + 1024 + 256) / 4; i += 512) ((LAS unsigned*)(lds + SC_SB))[i] = 0u;
    f32x4 S[4], nacc[4];
#pragma unroll
    for (int i = 0; i < 4; ++i) { S[i] = (f32x4){0.f, 0.f, 0.f, 0.f}; nacc[i] = (f32x4){0.f, 0.f, 0.f, 0.f}; }
    const bf16x8 ones = {(short)0x3F80, (short)0x3F80, (short)0x3F80, (short)0x3F80, (short)0x3F80, (short)0x3F80, (short)0x3F80, (short)0x3F80};
    u32x4 gq[2], gk[2], gv; float gd = 0.f;
    const int vcol = (ML ? ZC_MV : ZC_GV) + h * 256 + vs * 64;
    const bf16* zpage = (const bf16*)(ws + WS_CTL + 512 * 1024);
#define SCAN_LOAD(c) do { const int c_ = (c); \
        _Pragma("unroll") for (int e = 0; e < 2; ++e) { const int pid = tid + 512 * e, t = pid >> 4, ch = pid & 15; \
            const bool ok = c_ > 0 || t >= 48; const int row = c_ == 0 ? MR + t - 48 : b * SEQ + (c_ - 1) * 64 + t; \
            const bf16* qp_ = ok ? QK + (size_t)row * 1024 + h * 128 + ch * 8 : zpage; \
            gq[e] = *(const u32x4*)qp_; gk[e] = *(const u32x4*)(qp_ + 512); } \
        { const int t = tid >> 3, ch = tid & 7; const bool ok = c_ > 0 || t >= 48; const int row = c_ == 0 ? MR + t - 48 : b * SEQ + (c_ - 1) * 64 + t; \
          gv = *(const u32x4*)(ok ? Z + (size_t)row * ZB + vcol + ch * 8 : zpage); } \
        { const int cid = c_ == 0 ? 256 : b * 32 + (c_ - 1); gd = DDp[((size_t)cid * 4 + h) * 128 + (tid & 127)]; } } while (0)
#define SCAN_STORE(buf) do { const int bo_ = (buf); \
        _Pragma("unroll") for (int e = 0; e < 2; ++e) { const int pid = tid + 512 * e, t = pid >> 4, ch = pid & 15; \
            *(LAS u32x4*)(lds + SC_QT + bo_ * 17408 + t * SC_QS + ch * 16) = gq[e]; *(LAS u32x4*)(lds + SC_KT + bo_ * 17408 + t * SC_QS + ch * 16) = gk[e]; } \
        { const int t = tid >> 3, ch = tid & 7; *(LAS u32x4*)(lds + SC_VT + bo_ * 9216 + t * SC_VS + ch * 16) = gv; } \
        if (tid < 128) ((LAS float*)(lds + SC_DD))[bo_ * 128 + tid] = gd; } while (0)
    SCAN_LOAD(0);
    __syncthreads();
    SCAN_STORE(0);
    __syncthreads();
    for (int c = 0; c < 33; ++c) {
        const int buf = c & 1;
        LAS unsigned char* QT = lds + SC_QT + buf * 17408; LAS unsigned char* KT = lds + SC_KT + buf * 17408; LAS unsigned char* VT = lds + SC_VT + buf * 9216;
        LAS unsigned char* AT = lds + SC_AT; LAS unsigned char* SB = lds + SC_SB;
        const LAS float* ddL = (const LAS float*)(lds + SC_DD) + buf * 128;
        if (c + 1 < 33) SCAN_LOAD(c + 1);
        {
            const int ti = wave >> 1;
#pragma unroll
            for (int sj = 0; sj < 2; ++sj) {
                const int si = 2 * (wave & 1) + sj;
                f32x4 acc = {0.f, 0.f, 0.f, 0.f};
                bf16x8 qa[4], kb[4];
#pragma unroll
                for (int ks = 0; ks < 4; ++ks) { qa[ks] = *(const LAS bf16x8*)(QT + (16 * ti + fr) * SC_QS + (32 * ks + 8 * fq) * 2); kb[ks] = *(const LAS bf16x8*)(KT + (16 * si + fr) * SC_QS + (32 * ks + 8 * fq) * 2); }
                asm volatile("" ::: "memory");
#pragma unroll
                for (int ks = 0; ks < 4; ++ks) acc = __builtin_amdgcn_mfma_f32_16x16x32_bf16(qa[ks], kb[ks], acc, 0, 0, 0);
                const int sg = 16 * si + fr, tg = 16 * ti + 4 * fq;
                LAS bf16* ap = (LAS bf16*)(AT + tg * SC_VS) + sg;
                ap[0 * (SC_VS / 2)] = (bf16)(sg <= tg + 0 ? f2bf(acc.x) : 0u);
                ap[1 * (SC_VS / 2)] = (bf16)(sg <= tg + 1 ? f2bf(acc.y) : 0u);
                ap[2 * (SC_VS / 2)] = (bf16)(sg <= tg + 2 ? f2bf(acc.z) : 0u);
                ap[3 * (SC_VS / 2)] = (bf16)(sg <= tg + 3 ? f2bf(acc.w) : 0u);
            }
        }
        {
            const bf16x8 vb0 = tr8(VT, SC_VS, 0, 16 * vt, lane), vb1 = tr8(VT, SC_VS, 32, 16 * vt, lane);
#pragma unroll
            for (int i = 0; i < 4; ++i) {
                const int kt = 4 * hh + i;
                const bf16x8 ka0 = tr8(KT, SC_QS, 0, 16 * kt, lane), ka1 = tr8(KT, SC_QS, 32, 16 * kt, lane);
                f32x4 acc = S[i];
                acc = __builtin_amdgcn_mfma_f32_16x16x32_bf16(ka0, vb0, acc, 0, 0, 0);
                acc = __builtin_amdgcn_mfma_f32_16x16x32_bf16(ka1, vb1, acc, 0, 0, 0);
                const f32x4 dv = *(const LAS f32x4*)(ddL + 16 * kt + 4 * fq);
                S[i] = acc * dv;
                if (ML) {
                    f32x4 na = nacc[i];
                    na = __builtin_amdgcn_mfma_f32_16x16x32_bf16(ka0, ones, na, 0, 0, 0);
                    na = __builtin_amdgcn_mfma_f32_16x16x32_bf16(ka1, ones, na, 0, 0, 0);
                    nacc[i] = na * dv;
                }
            }
        }
        LDS_WAIT();
        __syncthreads();
        {
            const bf16x8 vb0 = tr8(VT, SC_VS, 0, 16 * vt, lane), vb1 = tr8(VT, SC_VS, 32, 16 * vt, lane);
            bf16x8 sb[4];
#pragma unroll
            for (int ks = 0; ks < 4; ++ks) sb[ks] = tr8(SB, SC_VS, 32 * ks, 16 * vt, lane);
            bf16x8 nb[4];
            if (ML) {
#pragma unroll
                for (int ks = 0; ks < 4; ++ks) nb[ks] = *(const LAS bf16x8*)(lds + SC_NB + (32 * ks + 8 * fq) * 2);
            }
#pragma unroll
            for (int tj = 0; tj < 2; ++tj) {
                const int ti = 2 * hh + tj;
                f32x4 acc = {0.f, 0.f, 0.f, 0.f}, den = {0.f, 0.f, 0.f, 0.f};
                bf16x8 qa[4];
#pragma unroll
                for (int ks = 0; ks < 4; ++ks) qa[ks] = *(const LAS bf16x8*)(QT + (16 * ti + fr) * SC_QS + (32 * ks + 8 * fq) * 2);
                const bf16x8 aa0 = *(const LAS bf16x8*)(AT + (16 * ti + fr) * SC_VS + (8 * fq) * 2), aa1 = *(const LAS bf16x8*)(AT + (16 * ti + fr) * SC_VS + (32 + 8 * fq) * 2);
                asm volatile("" ::: "memory");
#pragma unroll
                for (int ks = 0; ks < 4; ++ks) {
                    acc = __builtin_amdgcn_mfma_f32_16x16x32_bf16(qa[ks], sb[ks], acc, 0, 0, 0);
                    if (ML) den = __builtin_amdgcn_mfma_f32_16x16x32_bf16(qa[ks], nb[ks], den, 0, 0, 0);
                }
                acc = __builtin_amdgcn_mfma_f32_16x16x32_bf16(aa0, vb0, acc, 0, 0, 0);
                acc = __builtin_amdgcn_mfma_f32_16x16x32_bf16(aa1, vb1, acc, 0, 0, 0);
                if (ML) {
                    den = __builtin_amdgcn_mfma_f32_16x16x32_bf16(aa0, ones, den, 0, 0, 0);
                    den = __builtin_amdgcn_mfma_f32_16x16x32_bf16(aa1, ones, den, 0, 0, 0);
                    acc.x *= __builtin_amdgcn_rcpf(fmaxf(fabsf(den.x), 1.f)); acc.y *= __builtin_amdgcn_rcpf(fmaxf(fabsf(den.y), 1.f)); acc.z *= __builtin_amdgcn_rcpf(fmaxf(fabsf(den.z), 1.f)); acc.w *= __builtin_amdgcn_rcpf(fmaxf(fabsf(den.w), 1.f));
                }
                const int t0 = 16 * ti + 4 * fq;
                const int rowb = c == 0 ? MR + t0 - 48 : b * SEQ + (c - 1) * 64 + t0;
                bf16* op = O + (size_t)rowb * 1024 + h * 256 + vs * 64 + 16 * vt + fr;
                if (c > 0 || t0 >= 48) { op[0] = (bf16)f2bf(acc.x); op[1024] = (bf16)f2bf(acc.y); op[2048] = (bf16)f2bf(acc.z); op[3072] = (bf16)f2bf(acc.w); }
            }
        }
        LDS_WAIT();
        __syncthreads();
        {
#pragma unroll
            for (int i = 0; i < 4; ++i) {
                const int k0 = 16 * (4 * hh + i) + 4 * fq;
                LAS bf16* sp = (LAS bf16*)(SB + k0 * SC_VS) + 16 * vt + fr;
                sp[0 * (SC_VS / 2)] = (bf16)f2bf(S[i].x); sp[1 * (SC_VS / 2)] = (bf16)f2bf(S[i].y); sp[2 * (SC_VS / 2)] = (bf16)f2bf(S[i].z); sp[3 * (SC_VS / 2)] = (bf16)f2bf(S[i].w);
                if (ML && vt == 0 && fr == 0) { LAS bf16* np = (LAS bf16*)(lds + SC_NB) + k0; np[0] = (bf16)f2bf(nacc[i].x); np[1] = (bf16)f2bf(nacc[i].y); np[2] = (bf16)f2bf(nacc[i].z); np[3] = (bf16)f2bf(nacc[i].w); }
            }
            if (c + 1 < 33) SCAN_STORE(buf ^ 1);
        }
        LDS_WAIT();
        __syncthreads();
    }
#undef SCAN_LOAD
#undef SCAN_STORE
}

template <bool DRY = false>
__device__ __forceinline__ void p6_headnorm(ArgsP a, int l, int gw, int ngw, int lane) {
    unsigned char* ws = a->ws; const bf16* Z = (const bf16*)(ws + WS_Z);
    for (int it = gw; it < MT * 8; it += ngw) {
        const int r = it >> 3, mx = (it >> 2) & 1, h = it & 3;
        bf16* op = (bf16*)(ws + (mx ? WS_OM : WS_OG)) + (size_t)r * 1024 + h * 256 + 4 * lane;
        const u32x2 w = *(const u32x2*)op; f32x4 v = {bflo(w.x), bfhi(w.x), bflo(w.y), bfhi(w.y)};
        const float rr = rsqrtf(wave_sum((v.x * v.x + v.y * v.y) + (v.z * v.z + v.w * v.w)) * (1.f / 256.f) + EPS);
        const f32x4 gg = *(const f32x4*)(a->in[mx ? I_GML : I_GGLA] + l * 256 + 4 * lane);
        const u32x2 gw2 = *(const u32x2*)(Z + (size_t)r * ZB + (mx ? ZC_MO : ZC_GR) + h * 256 + 4 * lane);
        const f32x4 gt = {bflo(gw2.x), bfhi(gw2.x), bflo(gw2.y), bfhi(gw2.y)};
        v = v * rr * gg * gt;
        u32x2 o; o.x = pk2(v.x, v.y); o.y = pk2(v.z, v.w); *(u32x2*)(DRY ? (bf16*)(ws + WS_XN) + ((size_t)r * 1024 + h * 256 + 4 * lane) : op) = o;
    }
}

__device__ __forceinline__ int krow(int b, int s) { return s < NMETA ? MR + s : b * SEQ + (s - NMETA); }
__device__ __forceinline__ int t5_bucket(int n) {
    if (n < 16) return n < 0 ? 0 : n;
    const int lg = 16 + (int)(__logf((float)n * (1.f / 16.f)) / 2.0794415416798357f * 16.f);
    return lg < 31 ? lg : 31;
}
__device__ __forceinline__ unsigned off_b(unsigned row, unsigned ch) { return 256u * row + 16u * (ch ^ (((row & 3) << 2) | ((row >> 2) & 3))); }
__device__ __forceinline__ s16x4 tr_rd(LAS unsigned char* p) { return __builtin_amdgcn_ds_read_tr16_b64_v4i16((LAS s16x4*)p); }

constexpr int DW2_STRIDE = 9216, DW2_TILE = 0, DW2_SEL = 8192, DW2_BK = 8704, DSA2_T5 = 8 * DW2_STRIDE, DSA2_BT = DSA2_T5 + 2048 + 64;

template <bool DENSE_ONLY>
__device__ __forceinline__ void dsa_unit(ArgsP a, LAS unsigned char* lds, int b, int c, int nq, int wave, int lane_in) {
    int lane = lane_in; asm volatile("" : "+v"(lane));
    unsigned char* ws = a->ws;
    const bf16* QQ = (const bf16*)(ws + WS_QQ); const bf16* KI = (const bf16*)(ws + WS_KI); const bf16* KV = (const bf16*)(ws + WS_KV);
    unsigned* SC = (unsigned*)(ws + WS_SC) + (size_t)blockIdx.x * 64 * SC_PITCH;
    const int r0 = DENSE_ONLY ? MR : b * SEQ + 64 * c, p0 = DENSE_ONLY ? 0 : NMETA + 64 * c;
    const int fr = lane & 15, fq = lane >> 4;
    if (!DENSE_ONLY) {
        const int qt = wave & 3, kh = wave >> 2;
        if (p0 + 16 * qt + 15 >= 256) {
            const int qrow = r0 + 16 * qt + fr, pq = p0 + 16 * qt + fr;
            bf16x8 qf[8][2];
#pragma unroll
            for (int h = 0; h < 8; ++h)
#pragma unroll
                for (int ks = 0; ks < 2; ++ks) qf[h][ks] = *(const bf16x8*)(QQ + (size_t)qrow * NQQ + 2048 + h * 64 + ks * 32 + 8 * fq);
            float wi[8];
            { const f32x4 w0 = *(const f32x4*)((const float*)(ws + WS_WI) + (size_t)qrow * 8), w1 = *(const f32x4*)((const float*)(ws + WS_WI) + (size_t)qrow * 8 + 4);
              wi[0] = w0.x; wi[1] = w0.y; wi[2] = w0.z; wi[3] = w0.w; wi[4] = w1.x; wi[5] = w1.y; wi[6] = w1.z; wi[7] = w1.w; }
            const int nkt = 2 + 4 * c + qt;
            unsigned* scq = SC + (size_t)(16 * qt + fr) * SC_PITCH + 4 * fq;
            bf16x8 pa0[4], pa1[4];
#define DSA_KLOAD(kt0_) do { _Pragma("unroll") for (int j = 0; j < 4; ++j) { const int kt_ = (kt0_) + 2 * j < nkt ? (kt0_) + 2 * j : nkt - 1; \
                const bf16* kp_ = KI + (size_t)krow(b, 16 * kt_ + fr) * 64 + 8 * fq; pa0[j] = *(const bf16x8*)kp_; pa1[j] = *(const bf16x8*)(kp_ + 32); } } while (0)
            DSA_KLOAD(kh);
            for (int kt0 = kh; kt0 < nkt; kt0 += 8) {
                bf16x8 a0[4], a1[4];
#pragma unroll
                for (int j = 0; j < 4; ++j) { a0[j] = pa0[j]; a1[j] = pa1[j]; }
                if (kt0 + 8 < nkt) DSA_KLOAD(kt0 + 8);
#pragma unroll
                for (int j = 0; j < 4; ++j) {
                    const int kt = kt0 + 2 * j;
                    float s0 = 0.f, s1 = 0.f, s2 = 0.f, s3 = 0.f;
#pragma unroll
                    for (int h = 0; h < 8; ++h) {
                        f32x4 acc = {0.f, 0.f, 0.f, 0.f};
                        acc = __builtin_amdgcn_mfma_f32_16x16x32_bf16(a0[j], qf[h][0], acc, 0, 0, 0);
                        acc = __builtin_amdgcn_mfma_f32_16x16x32_bf16(a1[j], qf[h][1], acc, 0, 0, 0);
                        s0 += wi[h] * fmaxf(acc.x, 0.f); s1 += wi[h] * fmaxf(acc.y, 0.f); s2 += wi[h] * fmaxf(acc.z, 0.f); s3 += wi[h] * fmaxf(acc.w, 0.f);
                    }
                    const int kb = 16 * kt + 4 * fq;
                    u32x4 o;
                    { const unsigned bits = __builtin_bit_cast(unsigned, s0); o.x = (kb + 0) <= pq ? (bits ^ ((bits >> 31) ? 0xffffffffu : 0x80000000u)) : 0u; }
                    { const unsigned bits = __builtin_bit_cast(unsigned, s1); o.y = (kb + 1) <= pq ? (bits ^ ((bits >> 31) ? 0xffffffffu : 0x80000000u)) : 0u; }
                    { const unsigned bits = __builtin_bit_cast(unsigned, s2); o.z = (kb + 2) <= pq ? (bits ^ ((bits >> 31) ? 0xffffffffu : 0x80000000u)) : 0u; }
                    { const unsigned bits = __builtin_bit_cast(unsigned, s3); o.w = (kb + 3) <= pq ? (bits ^ ((bits >> 31) ? 0xffffffffu : 0x80000000u)) : 0u; }
                    if (kt < nkt) *(u32x4*)(scq + 16 * kt) = o;
                }
            }
#undef DSA_KLOAD
        }
        VM_WAIT();
        __syncthreads();
    }
    LAS unsigned char* wl = lds + wave * DW2_STRIDE;
    LAS unsigned char* tile = wl + DW2_TILE;
    LAS unsigned short* selL = (LAS unsigned short*)(wl + DW2_SEL);
    LAS unsigned short* bkL = (LAS unsigned short*)(wl + DW2_BK);
    const LAS float* t5L = (const LAS float*)(lds + DSA2_T5);
    const LAS unsigned short* bkT = (const LAS unsigned short*)(lds + DSA2_BT);
    const int nqw = DENSE_ONLY ? 2 : 8;
    for (int qi_ = 0; qi_ < nqw; ++qi_) {
        asm volatile("" : "+v"(lane));
        const int iq = wave * nqw + qi_;
        if (iq >= nq) break;
        const int p = p0 + iq, nk = p + 1, qrow = r0 + iq;
        int nsel;
        if (!DENSE_ONLY && nk > 256) {
            const unsigned* scr = SC + (size_t)iq * SC_PITCH;
            unsigned u[33];
#pragma unroll
            for (int i = 0; i < 33; ++i) { const int s = lane + 64 * i; u[i] = s < nk ? __hip_atomic_load(scr + s, __ATOMIC_RELAXED, __HIP_MEMORY_SCOPE_AGENT) : 0u; }
            unsigned tau = 0u;
            for (int bit = 31; bit >= 16; --bit) {
                const unsigned cand = tau | (1u << bit);
                int cnt = 0;
#pragma unroll
                for (int i = 0; i < 33; ++i) cnt += __popcll(__ballot(u[i] >= cand));
                if (cnt >= 256) tau = cand;
            }
            {
                const unsigned hi = tau >> 16;
                int cab = 0, ncand = 0;
                LAS unsigned short* candL = (LAS unsigned short*)tile;
                const unsigned long long ltm = (1ull << lane) - 1ull;
#pragma unroll
                for (int i = 0; i < 33; ++i) {
                    const unsigned uh = u[i] >> 16;
                    cab += __popcll(__ballot(uh > hi));
                    const unsigned long long mc = __ballot(uh == hi);
                    if (mc != 0ull) { if (uh == hi) candL[ncand + __popcll(mc & ltm)] = (unsigned short)(u[i] & 0xffffu); ncand += __popcll(mc); }
                }
                LDS_WAIT();
                const int need = 256 - cab;
                unsigned lo = 0u;
                if (ncand <= 64) {
                    const unsigned v = lane < ncand ? (unsigned)candL[lane] + 1u : 0u;
                    for (int bit = 15; bit >= 0; --bit) { const unsigned cand = lo | (1u << bit); if (__popcll(__ballot(v >= cand + 1u)) >= need) lo = cand; }
                } else {
                    for (int bit = 15; bit >= 0; --bit) {
                        const unsigned cand = lo | (1u << bit); int cnt = 0;
                        for (int j = lane; j < ((ncand + 63) & ~63); j += 64) { const unsigned v = j < ncand ? (unsigned)candL[j] + 1u : 0u; cnt += __popcll(__ballot(v >= cand + 1u)); }
                        if (cnt >= need) lo = cand;
                    }
                }
                tau |= lo;
                LDS_WAIT();
            }
            int cgt = 0;
#pragma unroll
            for (int i = 0; i < 33; ++i) cgt += __popcll(__ballot(u[i] > tau));
            const int rem = 256 - cgt;
            const unsigned long long lt = (1ull << lane) - 1ull;
            int base = 0, eqseen = 0;
            unsigned short bkv[33];
#pragma unroll
            for (int i = 0; i < 33; ++i) { const int d = p - (lane + 64 * i); bkv[i] = bkT[d > 0 ? d : 0]; }
#pragma unroll
            for (int i = 0; i < 33; ++i) {
                const bool gt = u[i] > tau, eq = u[i] == tau;
                const unsigned long long meq = __ballot(eq);
                const bool take = gt || (eq && (eqseen + __popcll(meq & lt)) < rem);
                const unsigned long long mt = __ballot(take);
                if (take) { const int pos = base + __popcll(mt & lt), s = lane + 64 * i; selL[pos] = (unsigned short)s; bkL[pos] = bkv[i]; }
                base += __popcll(mt); eqseen += __popcll(meq);
            }
            nsel = 256;
        } else {
#pragma unroll
            for (int m = 0; m < 4; ++m) { const int s = lane + 64 * m; selL[s] = (unsigned short)(s < nk ? s : 0); bkL[s] = bkT[s < nk ? p - s : 0]; }
            nsel = nk;
        }
        asm volatile("" : "+v"(lane));
        bf16x8 qB[4];
#pragma unroll
        for (int ks = 0; ks < 4; ++ks) qB[ks] = *(const bf16x8*)(QQ + (size_t)qrow * NQQ + fr * 128 + ks * 32 + 8 * fq);
        LDS_WAIT();
        f32x4 O[8];
#pragma unroll
        for (int nt = 0; nt < 8; ++nt) O[nt] = (f32x4){0.f, 0.f, 0.f, 0.f};
        float qss = 0.f;
#pragma unroll
        for (int ks = 0; ks < 4; ++ks) { const u32x4 w = __builtin_bit_cast(u32x4, qB[ks]);
            qss += (bflo(w.x) * bflo(w.x) + bfhi(w.x) * bfhi(w.x)) + (bflo(w.y) * bflo(w.y) + bfhi(w.y) * bfhi(w.y)) + (bflo(w.z) * bflo(w.z) + bfhi(w.z) * bfhi(w.z)) + (bflo(w.w) * bflo(w.w) + bfhi(w.w) * bfhi(w.w)); }
        qss += __shfl_xor(qss, 16); qss += __shfl_xor(qss, 32);
        const float mb = sqrtf(qss) * t5L[512] + t5L[513];
        float lrun = 0.f;
        const int nblk = (nsel + 31) >> 5;
#define DSA_GATHER(GV, blk_) do { _Pragma("unroll") for (int e = 0; e < 8; ++e) { const int pid = lane + 64 * e, ri = pid >> 4, ch = pid & 15, j = 32 * (blk_) + ri; \
            const int key = (int)selL[j]; GV[e] = *(const u32x4*)(KV + (size_t)krow(b, key) * 128 + ch * 8); } } while (0)
#define DSA_PUT(GV) do { _Pragma("unroll") for (int e = 0; e < 8; ++e) { const int pid = lane + 64 * e, ri = pid >> 4, ch = pid & 15; *(LAS u32x4*)(tile + off_b(ri, ch)) = GV[e]; } } while (0)
        u32x4 gvA[8], gvB[8];
        DSA_GATHER(gvA, 0);
        if (nblk > 1) DSA_GATHER(gvB, 1);
        for (int blk0 = 0; blk0 < nblk; blk0 += 2) {
#pragma unroll
            for (int half = 0; half < 2; ++half) {
                const int blk = blk0 + half;
                if (blk < nblk) {
                    if (half == 0) { DSA_PUT(gvA); if (blk + 2 < nblk) DSA_GATHER(gvA, blk + 2); }
                    else { DSA_PUT(gvB); if (blk + 2 < nblk) DSA_GATHER(gvB, blk + 2); }
                    LDS_WAIT();
                    f32x4 s0 = {0.f, 0.f, 0.f, 0.f}, s1 = {0.f, 0.f, 0.f, 0.f};
        #pragma unroll
                    for (int ks = 0; ks < 4; ++ks) {
                        const bf16x8 k0 = *(const LAS bf16x8*)(tile + off_b(fr, 4 * ks + fq)), k1 = *(const LAS bf16x8*)(tile + off_b(16 + fr, 4 * ks + fq));
                        s0 = __builtin_amdgcn_mfma_f32_16x16x32_bf16(k0, qB[ks], s0, 0, 0, 0);
                        s1 = __builtin_amdgcn_mfma_f32_16x16x32_bf16(k1, qB[ks], s1, 0, 0, 0);
                    }
                    const int j0 = 32 * blk + 4 * fq;
                    const u32x2 b0 = *(const LAS u32x2*)(bkL + j0), b1 = *(const LAS u32x2*)(bkL + j0 + 16);
                    const float t00 = t5L[(b0.x & 0xffffu) + fr], t01 = t5L[(b0.x >> 16) + fr], t02 = t5L[(b0.y & 0xffffu) + fr], t03 = t5L[(b0.y >> 16) + fr];
                    const float t10 = t5L[(b1.x & 0xffffu) + fr], t11 = t5L[(b1.x >> 16) + fr], t12 = t5L[(b1.y & 0xffffu) + fr], t13 = t5L[(b1.y >> 16) + fr];
                    const float e00 = __expf(s0.x + t00 - mb), e01 = __expf(s0.y + t01 - mb), e02 = __expf(s0.z + t02 - mb), e03 = __expf(s0.w + t03 - mb);
                    const float e10 = __expf(s1.x + t10 - mb), e11 = __expf(s1.y + t11 - mb), e12 = __expf(s1.z + t12 - mb), e13 = __expf(s1.w + t13 - mb);
                    const float p00 = (j0 + 0) < nsel ? e00 : 0.f, p01 = (j0 + 1) < nsel ? e01 : 0.f, p02 = (j0 + 2) < nsel ? e02 : 0.f, p03 = (j0 + 3) < nsel ? e03 : 0.f;
                    const float p10 = (j0 + 16) < nsel ? e10 : 0.f, p11 = (j0 + 17) < nsel ? e11 : 0.f, p12 = (j0 + 18) < nsel ? e12 : 0.f, p13 = (j0 + 19) < nsel ? e13 : 0.f;
                    lrun += ((p00 + p01) + (p02 + p03)) + ((p10 + p11) + (p12 + p13));
                    u32x4 pw; pw.x = pk2(p00, p01); pw.y = pk2(p02, p03); pw.z = pk2(p10, p11); pw.w = pk2(p12, p13);
                    const bf16x8 pa = __builtin_bit_cast(bf16x8, pw);
                    const unsigned q4 = (unsigned)(fr >> 2), p4 = (unsigned)(lane & 3);
        #pragma unroll
                    for (int nt = 0; nt < 8; ++nt) {
                        const s16x4 vlo = tr_rd(tile + off_b(4 * fq + q4, 2 * nt + (p4 >> 1)) + 8 * (p4 & 1));
                        const s16x4 vhi = tr_rd(tile + off_b(16 + 4 * fq + q4, 2 * nt + (p4 >> 1)) + 8 * (p4 & 1));
                        const bf16x8 vb = __builtin_shufflevector(vlo, vhi, 0, 1, 2, 3, 4, 5, 6, 7);
                        O[nt] = __builtin_amdgcn_mfma_f32_16x16x32_bf16(pa, vb, O[nt], 0, 0, 0);
                    }

                }
            }
        }
#undef DSA_GATHER
#undef DSA_PUT
        float lt2 = lrun + __shfl_xor(lrun, 16); lt2 += __shfl_xor(lt2, 32);
        const float inv = 1.f / lt2;
        float ir[4];
#pragma unroll
        for (int r = 0; r < 4; ++r) ir[r] = __shfl(inv, 4 * fq + r);
        bf16* od = (bf16*)(ws + WS_OD) + (size_t)qrow * 1024 + fr;
#pragma unroll
        for (int nt = 0; nt < 8; ++nt)
#pragma unroll
            for (int r = 0; r < 4; ++r) { const int hd = 4 * fq + r; od[(size_t)(hd >> 3) * MT * 1024 + (hd & 7) * 128 + 16 * nt] = (bf16)f2bf(O[nt][r] * ir[r]); }
        LDS_WAIT();
    }
}
__device__ __forceinline__ void p5_dsa(ArgsP a, LAS unsigned char* lds, int l, int tid, int wave, int lane) {
    LAS float* t5L = (LAS float*)(lds + DSA2_T5);
    __syncthreads();
    t5L[tid] = a->in[I_T5][tid];
    for (int n = tid; n < TT; n += 512) ((LAS unsigned short*)(lds + DSA2_BT))[n] = (unsigned short)(t5_bucket(n) * 16);
    if (tid < 64) {
        const float g0 = fabsf(a->in[I_GDKV][l * 128 + tid]), g1 = fabsf(a->in[I_GDKV][l * 128 + 64 + tid]);
        const float gm = wave_max(fmaxf(g0, g1));
        float tm = 0.f;
#pragma unroll
        for (int i = 0; i < 8; ++i) tm = fmaxf(tm, fabsf(a->in[I_T5][tid + 64 * i]));
        tm = wave_max(tm);
        if (tid == 0) { t5L[512] = 11.313708498984761f * gm; t5L[513] = tm; }
    }
    __syncthreads();
    for (int u = blockIdx.x; u < 256; u += gridDim.x) {
        dsa_unit<false>(a, lds, u >> 5, u & 31, 64, wave, lane);
        __syncthreads();
    }
    if (blockIdx.x == 0) dsa_unit<true>(a, lds, 0, 0, 16, wave, lane);
}

__global__ void __launch_bounds__(NWAVES * 64, 2) fwd(Args a_) {
    extern __shared__ __attribute__((aligned(16))) unsigned char lds_raw[];
    LAS unsigned char* lds = (LAS unsigned char*)lds_raw;
    volatile LAS unsigned* MISC = (volatile LAS unsigned*)(lds + MISC_OFF);
    if (threadIdx.x < 32) MISC[threadIdx.x] = 0u;
    __syncthreads();
    const int g_lo = a_.g_lo, g_hi = a_.g_hi, l_lo = a_.l_lo, l_hi = a_.l_hi, ph_lo = a_.ph_lo, ph_hi = a_.ph_hi, use_bar = a_.use_bar;
    XcdBarrier bar; bar.bar = (unsigned*)(a_.ws + WS_CTL) + CW_BAR; bar.x = 0; bar.st = nullptr;
    if (use_bar) bar = xcd_barrier_post((unsigned*)(a_.ws + WS_CTL) + CW_BAR, MISC + 8);
#if defined(DIAG_SEL)
    int diag_site = 0; if (threadIdx.x == 0) MISC[15] = (unsigned)__builtin_amdgcn_s_memrealtime();
#define DIAG_STAMP(site) do { if (blockIdx.x == 0 && threadIdx.x == 0) { const unsigned now_ = (unsigned)__builtin_amdgcn_s_memrealtime(); MISC[16 + (site)] += now_ - MISC[15]; MISC[15] = now_; } } while (0)
#define GRID_BAR() do { if (use_bar) xcd_barrier(bar); DIAG_STAMP(diag_site); ++diag_site; } while (0)
#else
#define GRID_BAR() do { if (use_bar) xcd_barrier(bar); } while (0)
#endif
#ifndef PHMASK
#define PHMASK 0xFFFF
#endif
#ifndef PROBE_PH
#define PROBE_PH -1
#endif
#ifndef PROBE_MASK
#define PROBE_MASK 0
#endif
#define PROBED(k) ((PROBE_MASK >> (k)) & 1)
#ifndef P1_ALIGN
#define P1_ALIGN true
#endif
#define PH(k) (((PHMASK >> (k)) & 1) && ph_lo <= (k) && (k) < ph_hi)
#define PBEGIN ArgsP a = (ArgsP)__builtin_amdgcn_kernarg_segment_ptr(); asm volatile("" : "+s"(a)); unsigned char* ws = a->ws; \
    int tid_ = threadIdx.x; asm volatile("" : "+v"(tid_)); const int tid = tid_, lane = tid & 63, wave = __builtin_amdgcn_readfirstlane(tid >> 6); const int gw = blockIdx.x * NWAVES + wave, ngw = gridDim.x * NWAVES; (void)ws; (void)gw; (void)ngw; (void)lane;

#if defined(DIAG_SEL)
    diag_site = 15;
#endif
    if (((PHMASK >> 13) & 1) && a_.prep) { PBEGIN prep_weights(a, lds, gw, ngw, wave, lane); GRID_BAR(); }

    for (int g = g_lo; g < g_hi; ++g) {
        for (int l = l_lo; l < l_hi; ++l) {
#if defined(DIAG_SEL)
            diag_site = (l == 0) ? 0 : 1;
#endif
            if (PH(0) && l == 0) { PBEGIN p0_init(a, g, gw, ngw, lane); GRID_BAR(); }
            if (PH(1)) { PBEGIN
                FIn f{(bf16*)(ws + WS_Z), (float*)(ws + WS_ZF), (const float*)(ws + WS_BIN) + l * NZ};
                run_gemm<FIn, P1_ALIGN>(lds, (const bf16*)(ws + WS_XN), (const bf16*)(ws + WS_WIN) + (size_t)l * NZ * D, NZ, D, f, gw, ngw, lane);
                if (PROBED(1)) { run_gemm(lds, (const bf16*)(ws + WS_XN), (const bf16*)(ws + WS_WIN) + (size_t)l * NZ * D, NZ, D, f, gw, ngw, lane); }
                GRID_BAR();
            }
            if (PH(2)) { PBEGIN p2_prep(a, l, gw, ngw, lane); if (PROBED(2)) { p2_prep(a, l, gw, ngw, lane); } GRID_BAR(); }
            if (PH(3)) { PBEGIN
                FQQ f{(bf16*)(ws + WS_QQ)};
                run_gemm(lds, (const bf16*)(ws + WS_CQN), (const bf16*)(ws + WS_WQQ) + (size_t)l * NQQ * 256, NQQ, 256, f, gw, ngw, lane);
                if (PROBED(3)) { run_gemm(lds, (const bf16*)(ws + WS_CQN), (const bf16*)(ws + WS_WQQ) + (size_t)l * NQQ * 256, NQQ, 256, f, gw, ngw, lane); }
            }
            if (PH(4)) { PBEGIN
                for (int u = blockIdx.x; u < 256; u += gridDim.x) {
                    const int b = (u >> 4) & 7, h = (u >> 2) & 3, vs = u & 3;
                    if (u >> 7) scan_unit<true>(a, lds, b, h, vs, tid); else scan_unit<false>(a, lds, b, h, vs, tid);
                }
#if PROBE_PH == 4
                for (int u = blockIdx.x; u < 256; u += gridDim.x) {
                    const int b = (u >> 4) & 7, h = (u >> 2) & 3, vs = u & 3;
                    if (u >> 7) scan_unit<true>(a, lds, b, h, vs, tid); else scan_unit<false>(a, lds, b, h, vs, tid);
                }
#endif
                GRID_BAR();
            }
            if (PH(5)) { PBEGIN p5_dsa(a, lds, l, tid, wave, lane); }
#if PROBE_PH == 5
            if (PH(5)) { PBEGIN p5_dsa(a, lds, l, tid, wave, lane); }
#endif
            if (PH(6)) { PBEGIN p6_headnorm(a, l, gw, ngw, lane); if (PROBED(6)) p6_headnorm<true>(a, l, gw, ngw, lane); GRID_BAR(); }
            if (PH(7)) {
                __syncthreads();
                { PBEGIN
                  const bf16* OD0 = (const bf16*)(ws + WS_OD); const bf16* OD1 = OD0 + (size_t)MT * 1024;
                  const bf16* WB0 = (const bf16*)(ws + WS_WBD) + (size_t)l * D * 2048; const bf16* WB1 = WB0 + (size_t)D * D;
                  int Kc = D, Nc = D; asm volatile("" : "+s"(Kc)); asm volatile("" : "+s"(Nc));
                  pg8::Gemm g{(const bf16*)(ws + WS_OG), (const bf16*)(ws + WS_WBG) + (size_t)l * D * D, MR, Nc, Kc, OD0, OD1, (const bf16*)(ws + WS_OM), WB0, WB1, (const bf16*)(ws + WS_WBM) + (size_t)l * D * D};
                  ChainOrder S; S.S.init(MR, Nc, (int)gridDim.x, (int)blockIdx.x);
                  EpiMix E{(const bf16*)(ws + WS_Z), (bf16*)(ws + WS_MIX)};
                  pg8::gemm_phase<EpiMix, ChainOrder, true, true, true>((PG8_LAS unsigned char*)lds, g, S, E);
                  FBr<0> f0{(const bf16*)(ws + WS_Z), (float*)(ws + WS_Y), (bf16*)(ws + WS_MIX)};
                  mini_gemm(lds, (const bf16*)(ws + WS_OG), (const bf16*)(ws + WS_WBG) + (size_t)l * D * D, Nc, Kc, f0, (int)threadIdx.x);
                  FBr<1> f1{(const bf16*)(ws + WS_Z), (float*)(ws + WS_Y), (bf16*)(ws + WS_MIX)};
                  mini_gemm(lds, OD0, WB0, Nc, Kc, f1, (int)threadIdx.x);
                  mini_gemm(lds, OD1, WB1, Nc, Kc, f1, (int)threadIdx.x);
                  FBr<2> f2{(const bf16*)(ws + WS_Z), (float*)(ws + WS_Y), (bf16*)(ws + WS_MIX)};
                  mini_gemm(lds, (const bf16*)(ws + WS_OM), (const bf16*)(ws + WS_WBM) + (size_t)l * D * D, Nc, Kc, f2, (int)threadIdx.x);
                }
#if PROBED(7)
                { PBEGIN
                  const bf16* OD0 = (const bf16*)(ws + WS_OD); const bf16* OD1 = OD0 + (size_t)MT * 1024;
                  const bf16* WB0 = (const bf16*)(ws + WS_WBD) + (size_t)l * D * 2048; const bf16* WB1 = WB0 + (size_t)D * D;
                  int Kc = D, Nc = D; asm volatile("" : "+s"(Kc)); asm volatile("" : "+s"(Nc));
                  pg8::Gemm g{(const bf16*)(ws + WS_OG), (const bf16*)(ws + WS_WBG) + (size_t)l * D * D, MR, Nc, Kc, OD0, OD1, (const bf16*)(ws + WS_OM), WB0, WB1, (const bf16*)(ws + WS_WBM) + (size_t)l * D * D};
                  ChainOrder S; S.S.init(MR, Nc, (int)gridDim.x, (int)blockIdx.x);
                  EpiMix E{(const bf16*)(ws + WS_Z), (bf16*)(ws + WS_MIX)};
                  pg8::gemm_phase<EpiMix, ChainOrder, true, true, true>((PG8_LAS unsigned char*)lds, g, S, E);
                  FBr<0> f0{(const bf16*)(ws + WS_Z), (float*)(ws + WS_Y), (bf16*)(ws + WS_MIX)};
                  mini_gemm(lds, (const bf16*)(ws + WS_OG), (const bf16*)(ws + WS_WBG) + (size_t)l * D * D, Nc, Kc, f0, (int)threadIdx.x);
                  FBr<1> f1{(const bf16*)(ws + WS_Z), (float*)(ws + WS_Y), (bf16*)(ws + WS_MIX)};
                  mini_gemm(lds, OD0, WB0, Nc, Kc, f1, (int)threadIdx.x);
                  mini_gemm(lds, OD1, WB1, Nc, Kc, f1, (int)threadIdx.x);
                  FBr<2> f2{(const bf16*)(ws + WS_Z), (float*)(ws + WS_Y), (bf16*)(ws + WS_MIX)};
                  mini_gemm(lds, (const bf16*)(ws + WS_OM), (const bf16*)(ws + WS_WBM) + (size_t)l * D * D, Nc, Kc, f2, (int)threadIdx.x);
                }
#endif
                GRID_BAR();
            }
            if (PH(8)) { PBEGIN
                FY f{(bf16*)(ws + WS_Y)};
                run_gemm(lds, (const bf16*)(ws + WS_MIX), (const bf16*)(ws + WS_WOUT) + (size_t)l * D * D, D, D, f, gw, ngw, lane);
                if (PROBED(8)) { run_gemm(lds, (const bf16*)(ws + WS_MIX), (const bf16*)(ws + WS_WOUT) + (size_t)l * D * D, D, D, f, gw, ngw, lane); }
                GRID_BAR();
            }
            if (PH(9)) { PBEGIN if (PROBED(9)) p_norm_res<true>(a, g, a->in[I_GPOSTMIX] + l * D, a->in[I_GPREMLP] + l * D, gw, ngw, lane); p_norm_res(a, g, a->in[I_GPOSTMIX] + l * D, a->in[I_GPREMLP] + l * D, gw, ngw, lane); GRID_BAR(); }
            if (PH(10)) { PBEGIN
                FUp f{(bf16*)(ws + WS_Z)};
                run_gemm(lds, (const bf16*)(ws + WS_XN), (const bf16*)(ws + WS_WUP) + (size_t)l * DFF * D, DFF, D, f, gw, ngw, lane);
                if (PROBED(10)) { run_gemm(lds, (const bf16*)(ws + WS_XN), (const bf16*)(ws + WS_WUP) + (size_t)l * DFF * D, DFF, D, f, gw, ngw, lane); }
                GRID_BAR();
            }
            if (PH(11)) { PBEGIN
                FY f{(bf16*)(ws + WS_Y)};
                run_gemm(lds, (const bf16*)(ws + WS_Z), (const bf16*)(ws + WS_WDN) + (size_t)l * D * DFF, D, DFF, f, gw, ngw, lane);
                if (PROBED(11)) { run_gemm(lds, (const bf16*)(ws + WS_Z), (const bf16*)(ws + WS_WDN) + (size_t)l * D * DFF, D, DFF, f, gw, ngw, lane); }
                GRID_BAR();
            }
            if (PH(12)) { PBEGIN if (PROBED(12)) p_norm_res<true>(a, g, a->in[I_GPOSTMLP] + l * D, l + 1 < NL ? a->in[I_GPREMIX] + (l + 1) * D : nullptr, gw, ngw, lane); p_norm_res(a, g, a->in[I_GPOSTMLP] + l * D, l + 1 < NL ? a->in[I_GPREMIX] + (l + 1) * D : nullptr, gw, ngw, lane); GRID_BAR(); }
        }
    }
#if defined(DIAG_SEL)
    if (blockIdx.x == 0 && threadIdx.x == 0) { unsigned tot = 0; for (int i = 0; i < 16; ++i) tot += MISC[16 + i];
        a_.out[12345] = DIAG_SEL == 99 ? 100.f + (float)tot * 0.0001f : 100.f + 900.f * (float)MISC[16 + DIAG_SEL] / (float)tot; }
#endif
#undef PH
#undef GRID_BAR
#undef PBEGIN
}

#ifndef MK_ONE_LAUNCH
#define MK_ONE_LAUNCH 1
#endif
extern "C" void kernel_launch(void* const* d_in, const int* in_sizes, int n_in, void* d_out, int out_size, void* d_ws, size_t ws_size, hipStream_t stream) {
    static int grid = 0;
    if (grid == 0) {
        if (n_in != 28 || out_size != NB * SEQ * D || ws_size < WS_END) { fprintf(stderr, "kernel_launch: unexpected shapes (n_in %d out %d ws %zu need %zu)\n", n_in, out_size, ws_size, (size_t)WS_END); grid = -1; return; }
        int dev = 0, cus = 0, per_cu = 0;
        if (hipGetDevice(&dev) != hipSuccess || hipDeviceGetAttribute(&cus, hipDeviceAttributeMultiprocessorCount, dev) != hipSuccess) { grid = -1; return; }
        if (hipFuncSetAttribute((const void*)fwd, hipFuncAttributeMaxDynamicSharedMemorySize, LDS_BYTES) != hipSuccess) { fprintf(stderr, "kernel_launch: hipFuncSetAttribute failed\n"); grid = -1; return; }
        if (hipOccupancyMaxActiveBlocksPerMultiprocessor(&per_cu, (const void*)fwd, NWAVES * 64, LDS_BYTES) != hipSuccess || per_cu < 1) { fprintf(stderr, "kernel_launch: occupancy query says %d\n", per_cu); }
        (void)hipGetLastError();
        grid = cus;
    }
    if (grid < 0) return;
    (void)hipMemsetAsync((char*)d_ws + WS_CTL, 0, CTL_ZERO_BYTES, stream);
    Args a{};
    for (int i = 0; i < 28; ++i) a.in[i] = (const float*)d_in[i];
    a.out = (float*)d_out; a.ws = (unsigned char*)d_ws;
#if MK_ONE_LAUNCH
    a.g_lo = 0; a.g_hi = NG; a.l_lo = 0; a.l_hi = NL; a.ph_lo = 0; a.ph_hi = 13; a.prep = 1; a.use_bar = 1;
    hipLaunchKernelGGL(fwd, dim3(grid), dim3(NWAVES * 64), LDS_BYTES, stream, a);
#else
    a.use_bar = 0;
    a.prep = 1; a.g_lo = 0; a.g_hi = 0; a.l_lo = 0; a.l_hi = 0; a.ph_lo = 0; a.ph_hi = 0;
    hipLaunchKernelGGL(fwd, dim3(grid), dim3(NWAVES * 64), LDS_BYTES, stream, a);
    a.prep = 0;
    static const int cuts[] = {0, 1, 2, 3, 5, 7, 8, 9, 10, 11, 12, 13};
    for (int g = 0; g < NG; ++g) for (int l = 0; l < NL; ++l) for (int c = 0; c < 11; ++c) {
        if (c == 0 && l != 0) continue;
        a.g_lo = g; a.g_hi = g + 1; a.l_lo = l; a.l_hi = l + 1; a.ph_lo = cuts[c]; a.ph_hi = cuts[c + 1];
        hipLaunchKernelGGL(fwd, dim3(grid), dim3(NWAVES * 64), LDS_BYTES, stream, a);
    }
#endif
    const hipError_t le = hipPeekAtLastError();
    if (le != hipSuccess) fprintf(stderr, "kernel_launch: launch failed: %s\n", hipGetErrorName(le));
}
```

```cpp
#include <hip/hip_runtime.h>
#include <cstdio>
#include <cstdint>
namespace pg8 {
#define PG8_LAS __attribute__((address_space(3)))
typedef unsigned short bf16_t;
typedef short bf16x8 __attribute__((ext_vector_type(8)));
typedef float f32x4 __attribute__((ext_vector_type(4)));
typedef unsigned u32x4 __attribute__((ext_vector_type(4)));
constexpr int BM = 256, BK = 64, HALF = 128, HTB = HALF * BK * 2  , STAGE_BYTES = 8 * HTB, NXCD = 8, WGM = 8;

__host__ __device__ __forceinline__ int lds_byte(int r, int c) { const int st = (r >> 4) * 2 + (c >> 5), rr = r & 15, cc = c & 31, ob = rr * 64 + cc * 2; return st * 1024 + (ob ^ (((ob >> 9) & 1) << 5)); }
__host__ __device__ __forceinline__ void stage_rc(int b, int& R, int& C) { const int st = b / 1024, sb = b % 1024, swz = sb ^ (((sb >> 9) & 1) << 5); R = (st >> 1) * 16 + swz / 64; C = (st & 1) * 32 + (swz % 64) / 2; }
__host__ __device__ __forceinline__ int perm32(int rho) { const int n = rho >> 4, i = rho & 15; return 8 * (i >> 2) + 4 * n + (i & 3); }

struct Unit { int pm, pn, sub; };
struct Gemm { const bf16_t* A; const bf16_t* Bt; int M, N, K; const bf16_t *A1, *A2, *A3, *B1, *B2, *B3; };

struct StaticOrder {
    int nM, nN, nwg, G, c;
    __host__ __device__ void init(int M, int N, int G_, int c_) { nM = M / BM; nN = N / BM; nwg = nM * nN; G = G_; c = c_; }
    __host__ __device__ bool next(int i, Unit& u) const {
        const long L = (long)i * G + c; if (L >= nwg) return false;
        int wgid = (int)L; { const int q = nwg / NXCD, r = nwg % NXCD, xcd = wgid % NXCD, off = wgid / NXCD; wgid = (xcd < r ? xcd * (q + 1) : r * (q + 1) + (xcd - r) * q) + off; }
        const int nig = WGM * nN, gid = wgid / nig, fm = gid * WGM, gsz = (nM - fm) < WGM ? (nM - fm) : WGM;
        u.pm = fm + ((wgid % nig) % gsz); u.pn = (wgid % nig) / gsz; u.sub = 0; return true;
    }
    __device__ __forceinline__ void a_ready(const Unit&) const {}
    __device__ __forceinline__ void done(const Unit&) const {}
};

__device__ __forceinline__ unsigned cvt_pk_bf16(float lo, float hi) { unsigned r; asm volatile("v_cvt_pk_bf16_f32 %0, %1, %2" : "=v"(r) : "v"(lo), "v"(hi)); return r; }
template <class Epi, class Sched, bool ALIGN_EPI = false, bool SP2 = false, bool CHAIN = false>
__device__ __forceinline__ void gemm_phase(PG8_LAS unsigned char* lds, const Gemm g, const Sched& S, const Epi& E) {
    int tid_ = threadIdx.x; asm volatile("" : "+v"(tid_));
    const int tid = tid_, wid = __builtin_amdgcn_readfirstlane(tid >> 6), lane = tid & 63, wr = wid >> 2, wc = wid & 3, fr = lane & 15, fq = lane >> 4;
    const int K = g.K, nt = K / BK;
    unsigned voffA[2], voffB[2];
#pragma unroll
    for (int i = 0; i < 2; ++i) { int R, C; stage_rc(tid * 16 + i * 8192, R, C); const int Rb = Epi::PERM ? ((R & ~31) + perm32(R & 31)) : R;
        voffA[i] = (unsigned)(R * K + C) * 2u; voffB[i] = (unsigned)(Rb * K + C) * 2u; }
    const size_t kstep = (size_t)(BK * 2);
    const size_t hstep = (size_t)HALF * K * 2;
    const size_t tstep = 2 * hstep;
    const unsigned ldsw = (unsigned)wid * 1024u;
    const int aoff = lds_byte(wr * 64 + fr, fq * 8), boff = lds_byte(wc * 32 + fr, fq * 8);
#define PG8_SA(b, h) (((b) * 2 + (h)) * HTB)
#define PG8_SB(b, h) ((4 + (b) * 2 + (h)) * HTB)
#define PG8_STAGE(bufoff, gbase, voff) do { _Pragma("unroll") for (int _i = 0; _i < 2; ++_i) \
        __builtin_amdgcn_global_load_lds((const unsigned*)((const char*)(gbase) + (voff)[_i]), (PG8_LAS unsigned*)(lds + (bufoff) + ldsw + _i * 8192), 16, 0, 0); } while (0)
#define PG8_LDA(dst, b, h) do { _Pragma("unroll") for (int m = 0; m < 4; ++m) _Pragma("unroll") for (int k = 0; k < 2; ++k) dst[m][k] = *(const PG8_LAS bf16x8*)(lds + PG8_SA(b, h) + aoff + m * 2048 + k * 1024); } while (0)
#define PG8_LDB(dst, b, h) do { _Pragma("unroll") for (int n = 0; n < 2; ++n) _Pragma("unroll") for (int k = 0; k < 2; ++k) dst[n][k] = *(const PG8_LAS bf16x8*)(lds + PG8_SB(b, h) + boff + n * 2048 + k * 1024); } while (0)
#define PG8_MMA(ai, bj, At, Bt) do { __builtin_amdgcn_s_setprio(1); _Pragma("unroll") for (int m = 0; m < 4; ++m) _Pragma("unroll") for (int n = 0; n < 2; ++n) _Pragma("unroll") for (int k = 0; k < 2; ++k) \
        acc[ai][bj][m][n] = __builtin_amdgcn_mfma_f32_16x16x32_bf16(Bt[n][k], At[m][k], acc[ai][bj][m][n], 0, 0, 0); __builtin_amdgcn_s_setprio(0); } while (0)
#define PG8_WAIT_V(n) asm volatile("s_waitcnt vmcnt(" #n ")" ::: "memory")
#define PG8_WAIT_L(n) asm volatile("s_waitcnt lgkmcnt(" #n ")" ::: "memory")
#define PG8_BAR __builtin_amdgcn_s_barrier()
#define PG8_SCHED __builtin_amdgcn_sched_barrier(0)
    Unit cur, nxt; int ui = 0;
    if (!S.next(0, cur)) return;
    f32x4 acc[2][2][4][2];
#pragma unroll
    for (int a = 0; a < 2; ++a)
#pragma unroll
        for (int b = 0; b < 2; ++b)
#pragma unroll
            for (int m = 0; m < 4; ++m)
#pragma unroll
                for (int n = 0; n < 2; ++n) acc[a][b][m][n] = (f32x4){0.f, 0.f, 0.f, 0.f};
    bf16x8 At[4][2], B0[2][2], B1[2][2];
#define PG8_ABASE(u) ((const char*)(!CHAIN || (u).sub == 0 ? g.A : (u).sub == 1 ? g.A1 : (u).sub == 2 ? g.A2 : g.A3) + (size_t)(u).pm * tstep)
#define PG8_BBASE(u) ((const char*)(!CHAIN || (u).sub == 0 ? g.Bt : (u).sub == 1 ? g.B1 : (u).sub == 2 ? g.B2 : g.B3) + (size_t)(u).pn * tstep)
    const char* cA = PG8_ABASE(cur); const char* cB = PG8_BBASE(cur);
    S.a_ready(cur);
    if constexpr (SP2) {
        PG8_STAGE(PG8_SB(0, 0), cB, voffB); PG8_STAGE(PG8_SB(0, 1), cB + hstep, voffB); PG8_STAGE(PG8_SA(0, 0), cA, voffA); PG8_STAGE(PG8_SA(0, 1), cA + hstep, voffA);
        if (wr == 1) PG8_BAR;
        PG8_WAIT_V(2); PG8_BAR;
        PG8_STAGE(PG8_SB(1, 0), cB + kstep, voffB); PG8_STAGE(PG8_SA(1, 0), cA + kstep, voffA); PG8_STAGE(PG8_SB(1, 1), cB + hstep + kstep, voffB);
        PG8_WAIT_V(6); PG8_BAR;
    } else {
        PG8_STAGE(PG8_SB(0, 0), cB, voffB); PG8_STAGE(PG8_SA(0, 0), cA, voffA); PG8_STAGE(PG8_SB(0, 1), cB + hstep, voffB); PG8_STAGE(PG8_SA(0, 1), cA + hstep, voffA);
        if (wr == 1) PG8_BAR;
        PG8_WAIT_V(4); PG8_BAR;
        PG8_STAGE(PG8_SB(1, 0), cB + kstep, voffB); PG8_STAGE(PG8_SA(1, 0), cA + kstep, voffA); PG8_STAGE(PG8_SB(1, 1), cB + hstep + kstep, voffB);
        PG8_WAIT_V(6); PG8_BAR;
    }
    for (;;) {
        const bool has_next = S.next(ui + 1, nxt);
        const char* nA = has_next ? PG8_ABASE(nxt) : cA; const char* nB = has_next ? PG8_BBASE(nxt) : cB;
        for (int t = 0; t < nt; t += 2) {
            const bool last = (t == nt - 2);
            const char* a1 = cA + (size_t)(t + 1) * kstep;
            const char* a2 = last ? nA : cA + (size_t)(t + 2) * kstep; const char* b2 = last ? nB : cB + (size_t)(t + 2) * kstep;
            const char* a3 = a2 + kstep; const char* b3 = b2 + kstep;
            if (last && has_next) S.a_ready(nxt);
            if constexpr (SP2) {
            PG8_LDB(B0, 0, 0); PG8_LDB(B1, 0, 1); PG8_SCHED; PG8_LDA(At, 0, 0); PG8_STAGE(PG8_SA(1, 1), a1 + hstep, voffA);
            PG8_WAIT_V(8); PG8_WAIT_L(0); PG8_BAR; PG8_MMA(0, 0, At, B0); PG8_MMA(0, 1, At, B1); PG8_BAR; PG8_SCHED;
            PG8_LDA(At, 0, 1); PG8_STAGE(PG8_SB(0, 0), b2, voffB); PG8_STAGE(PG8_SB(0, 1), b2 + hstep, voffB); PG8_STAGE(PG8_SA(0, 0), a2, voffA);
            PG8_WAIT_V(8); PG8_WAIT_L(0); PG8_BAR; PG8_MMA(1, 0, At, B0); PG8_MMA(1, 1, At, B1); PG8_BAR; PG8_SCHED;
            PG8_LDB(B0, 1, 0); PG8_LDB(B1, 1, 1); PG8_SCHED; PG8_LDA(At, 1, 0); PG8_STAGE(PG8_SA(0, 1), a2 + hstep, voffA);
            PG8_WAIT_V(8); PG8_WAIT_L(0); PG8_BAR; PG8_MMA(0, 0, At, B0); PG8_MMA(0, 1, At, B1); PG8_BAR; PG8_SCHED;
            PG8_LDA(At, 1, 1); PG8_STAGE(PG8_SB(1, 0), b3, voffB); PG8_STAGE(PG8_SB(1, 1), b3 + hstep, voffB); PG8_STAGE(PG8_SA(1, 0), a3, voffA);
            PG8_WAIT_V(8); PG8_WAIT_L(0); PG8_BAR; PG8_MMA(1, 0, At, B0); PG8_MMA(1, 1, At, B1); PG8_BAR; PG8_SCHED;
            } else {
            PG8_LDB(B0, 0, 0); PG8_SCHED; PG8_LDA(At, 0, 0); PG8_STAGE(PG8_SA(1, 1), a1 + hstep, voffA);
            PG8_WAIT_L(8); PG8_BAR; PG8_WAIT_L(0); PG8_MMA(0, 0, At, B0); PG8_BAR; PG8_SCHED;
            PG8_LDB(B1, 0, 1); PG8_STAGE(PG8_SB(0, 0), b2, voffB);
            PG8_BAR; PG8_WAIT_L(0); PG8_MMA(0, 1, At, B1); PG8_BAR;
            PG8_LDA(At, 0, 1); PG8_STAGE(PG8_SA(0, 0), a2, voffA);
            PG8_BAR; PG8_WAIT_L(0); PG8_MMA(1, 0, At, B0); PG8_BAR; PG8_SCHED;
            PG8_STAGE(PG8_SB(0, 1), b2 + hstep, voffB);
            PG8_WAIT_V(6); PG8_BAR; PG8_MMA(1, 1, At, B1); PG8_BAR;
            PG8_LDB(B0, 1, 0); PG8_SCHED; PG8_LDA(At, 1, 0); PG8_STAGE(PG8_SA(0, 1), a2 + hstep, voffA);
            PG8_WAIT_L(8); PG8_BAR; PG8_WAIT_L(0); PG8_MMA(0, 0, At, B0); PG8_BAR; PG8_SCHED;
            PG8_LDB(B1, 1, 1); PG8_STAGE(PG8_SB(1, 0), b3, voffB);
            PG8_BAR; PG8_WAIT_L(0); PG8_MMA(0, 1, At, B1); PG8_BAR;
            PG8_LDA(At, 1, 1); PG8_STAGE(PG8_SA(1, 0), a3, voffA);
            PG8_BAR; PG8_WAIT_L(0); PG8_MMA(1, 0, At, B0); PG8_BAR; PG8_SCHED;
            PG8_STAGE(PG8_SB(1, 1), b3 + hstep, voffB);
            PG8_WAIT_V(6); PG8_BAR; PG8_MMA(1, 1, At, B1); PG8_BAR;
            }
        }
        if constexpr (ALIGN_EPI) { if (wr == 0) PG8_BAR; }
        if constexpr (CHAIN) { if (cur.sub < 3) E.mid(acc, cur, wr, wc, fr, fq); else E(acc, cur, wr, wc, fr, fq); S.done(cur); }
        else if constexpr (!Epi::AFTER_DRAIN) { E(acc, cur, wr, wc, fr, fq); S.done(cur); }
        if (!has_next) break;
        if (!CHAIN || cur.sub == 3)
#pragma unroll
        for (int a = 0; a < 2; ++a)
#pragma unroll
            for (int b = 0; b < 2; ++b)
#pragma unroll
                for (int m = 0; m < 4; ++m)
#pragma unroll
                    for (int n = 0; n < 2; ++n) acc[a][b][m][n] = (f32x4){0.f, 0.f, 0.f, 0.f};
        cur = nxt; cA = nA; cB = nB; ++ui;
        if constexpr (ALIGN_EPI) { if (wr == 1) PG8_BAR; }
    }
    PG8_WAIT_V(0);
    if constexpr (!ALIGN_EPI) { if (wr == 0) PG8_BAR; }
    PG8_BAR;
    if constexpr (Epi::AFTER_DRAIN) { E.fused(acc, cur, wr, wc, fr, fq, lds, wid, lane); S.done(cur); }
#undef PG8_ABASE
#undef PG8_BBASE
#undef PG8_SA
#undef PG8_SB
#undef PG8_STAGE
#undef PG8_LDA
#undef PG8_LDB
#undef PG8_MMA
#undef PG8_WAIT_V
#undef PG8_WAIT_L
#undef PG8_BAR
#undef PG8_SCHED
}
}

constexpr int NB = 32, SEQ = 2048, NMETA = 16, TT = SEQ + NMETA, D = 1024, NL = 4, DFF = 4096;
constexpr int NG = 4, GB = NB / NG, MR = GB * SEQ  , MT = MR + NMETA  ;
constexpr int NCOLS = 9696, NZ = 9728, ZB = 9216, ZFW = 512;
constexpr float EPS = 1e-6f;
constexpr int ZC_GQ = 0, ZC_GK = 512, ZC_GV = 1024, ZC_GR = 2048, ZC_MQ = 3072, ZC_MK = 3584, ZC_MV = 4096, ZC_MO = 5120, ZC_GATE = 6144;
constexpr int ZF_CQ = 0, ZF_CKV = 256, ZF_IK = 384, ZF_A = 448, ZF_IW = 464, ZF_MI = 472, ZF_MF = 476;
constexpr int NQQ = 2560;

constexpr size_t MiB = 1u << 20;
constexpr size_t WS_CTL = 0, CTL_ZERO_BYTES = 1 * MiB;
constexpr size_t WS_BIN = 1 * MiB;
constexpr size_t WS_WIN = 2 * MiB;
constexpr size_t WS_WQQ = 78 * MiB;
constexpr size_t WS_WBG = 83 * MiB;
constexpr size_t WS_WBM = 91 * MiB;
constexpr size_t WS_WBD = 99 * MiB;
constexpr size_t WS_WOUT = 115 * MiB;
constexpr size_t WS_WUP = 123 * MiB;
constexpr size_t WS_WDN = 155 * MiB;
constexpr size_t WS_HM = 187 * MiB;
constexpr size_t WS_XN = 188 * MiB;
constexpr size_t WS_ZF = 221 * MiB;
constexpr size_t WS_CQN = 254 * MiB;
constexpr size_t WS_KV = 263 * MiB;
constexpr size_t WS_KI = 268 * MiB;
constexpr size_t WS_WI = 271 * MiB;
constexpr size_t WS_LIF = 272 * MiB;
constexpr size_t WS_G = 273 * MiB;
constexpr size_t WS_QKC = 306 * MiB;
constexpr size_t WS_QQ = 339 * MiB;
constexpr size_t WS_OG = 420 * MiB;
constexpr size_t WS_OM = 453 * MiB;
constexpr size_t WS_OD = 486 * MiB;
constexpr size_t WS_Z = 551 * MiB;
constexpr size_t WS_MIX = 840 * MiB;
constexpr size_t WS_Y = 873 * MiB;
constexpr size_t WS_SC = 840 * MiB;
constexpr size_t WS_DD = 1020 * MiB;
constexpr size_t WS_END = 1024 * MiB;
constexpr int SC_PITCH = 2080;
static_assert(WS_Z + (size_t)MT * ZB * 2 <= WS_MIX && WS_Y + (size_t)MT * D * 4 <= WS_END && WS_SC + (size_t)256 * 64 * SC_PITCH * 4 <= WS_END, "ws map");

constexpr int CW_BAR = 4096;

constexpr int RING_BYTES = 131072;
constexpr int MISC_OFF = RING_BYTES + 320;
constexpr int LDS_BYTES = 147456;
constexpr int NWAVES = 8;

#define LAS __attribute__((address_space(3)))
typedef unsigned short bf16;
typedef float f32x4 __attribute__((ext_vector_type(4)));
typedef float f32x2 __attribute__((ext_vector_type(2)));
typedef unsigned u32x4 __attribute__((ext_vector_type(4)));
typedef unsigned u32x2 __attribute__((ext_vector_type(2)));
typedef short bf16x8 __attribute__((ext_vector_type(8)));
typedef short s16x4 __attribute__((ext_vector_type(4)));
#define LDS_WAIT() asm volatile("s_waitcnt lgkmcnt(0)" ::: "memory")
#define VM_WAIT() asm volatile("s_waitcnt vmcnt(0)" ::: "memory")

typedef __bf16 hwbf16x2 __attribute__((ext_vector_type(2)));
__device__ __forceinline__ unsigned pk2(float lo, float hi) { const f32x2 v = {lo, hi}; const hwbf16x2 b = __builtin_convertvector(v, hwbf16x2); return __builtin_bit_cast(unsigned, b); }
__device__ __forceinline__ unsigned f2bf(float f) { return pk2(f, 0.f) & 0xffffu; }
__device__ __forceinline__ float bf2f(unsigned b) { return __builtin_bit_cast(float, b << 16); }
__device__ __forceinline__ float bflo(unsigned w) { return __builtin_bit_cast(float, w << 16); }
__device__ __forceinline__ float bfhi(unsigned w) { return __builtin_bit_cast(float, w & 0xffff0000u); }
__device__ __forceinline__ float wave_sum(float v) {
#pragma unroll
    for (int o = 1; o < 64; o <<= 1) v += __shfl_xor(v, o);
    return v;
}
__device__ __forceinline__ float wave_max(float v) {
#pragma unroll
    for (int o = 1; o < 64; o <<= 1) v = fmaxf(v, __shfl_xor(v, o));
    return v;
}
__device__ __forceinline__ float sigmoid_f(float x) { return __builtin_amdgcn_rcpf(1.f + __builtin_amdgcn_exp2f(-1.4426950408889634f * x)); }
__device__ __forceinline__ float silu_f(float x) { return x * sigmoid_f(x); }
__device__ __forceinline__ float logsigmoid_f(float x) { return fminf(x, 0.f) - 0.6931471805599453f * __builtin_amdgcn_logf(1.f + __builtin_amdgcn_exp2f(-1.4426950408889634f * fabsf(x))); }

#define XB_TMO      128
#define XB_XCNT(j)  (256  + 64 * (j))
#define XB_XSUB(j)  (1280 + 64 * (j))
#define XB_XGEN(j)  (2304 + 64 * (j))
#define XB_TOP      3328
#define XB_TOPGEN   3392
#define XCD_BAR_WORDS 3456
#define XB_SPIN_CAP (1u << 22)

__device__ __forceinline__ unsigned xb_ld(unsigned* p)              { return __hip_atomic_load(p, __ATOMIC_RELAXED, __HIP_MEMORY_SCOPE_AGENT); }
__device__ __forceinline__ unsigned xb_add(unsigned* p, unsigned v) { return __hip_atomic_fetch_add(p, v, __ATOMIC_RELAXED, __HIP_MEMORY_SCOPE_AGENT); }
__device__ __forceinline__ unsigned xb_xcc_id() { return (unsigned)__builtin_amdgcn_s_getreg((3 << 11) | 20) & 0xFu; }
#define XB_SPIN(cond, bar) do { unsigned _sp = 0; while (cond) { __builtin_amdgcn_s_sleep(1); \
    if ((++_sp & 255u) == 0u) { if (xb_ld(&(bar)[XB_TMO])) break; if (_sp > XB_SPIN_CAP) { atomicAdd(&(bar)[XB_TMO], 1u); break; } } } } while (0)

struct XcdBarrier {
    unsigned* bar; unsigned x;
    volatile LAS unsigned* st;
};

__device__ __forceinline__ XcdBarrier xcd_barrier_post(unsigned* bar, volatile LAS unsigned* st) {
    XcdBarrier b; b.bar = bar; b.x = xb_xcc_id(); b.st = st;
    if (threadIdx.x == 0) (void)xb_add(&bar[XB_XCNT(b.x)], 1u);
    return b;
}
__device__ __forceinline__ void xcd_barrier_complete(unsigned* bar, unsigned x, unsigned& nloc, unsigned& nx) {
    const unsigned G = gridDim.x * gridDim.y * gridDim.z;
    unsigned sum, cnt, mine, sp = 0u;
    for (;;) {
        sum = 0u; cnt = 0u; mine = 0u;
#pragma unroll
        for (unsigned j = 0; j < 16; ++j) { const unsigned c = xb_ld(&bar[XB_XCNT(j)]); sum += c; cnt += (c > 0u) ? 1u : 0u; mine = (j == x) ? c : mine; }
        if (sum == G) break;
        __builtin_amdgcn_s_sleep(1);
        if ((++sp & 255u) == 0u) { if (xb_ld(&bar[XB_TMO])) break; if (sp > XB_SPIN_CAP) { atomicAdd(&bar[XB_TMO], 1u); break; } }
    }
    nloc = mine > 0u ? mine : 1u; nx = cnt > 0u ? cnt : 1u;
}

__device__ __forceinline__ void xcd_barrier(const XcdBarrier& b) {
    asm volatile("s_waitcnt vmcnt(0)" ::: "memory");
    __syncthreads();
    if (threadIdx.x == 0) {
        unsigned* bar = b.bar;
        __builtin_amdgcn_s_waitcnt(0);
        unsigned nloc = b.st[0], nx = b.st[1];
        if (nloc == 0u) { xcd_barrier_complete(bar, b.x, nloc, nx); b.st[0] = nloc; b.st[1] = nx; }
        const unsigned old = xb_add(&bar[XB_XSUB(b.x)], 1u);
        const unsigned gen = old / nloc;
        if (old + 1u == (gen + 1u) * nloc) {
            __builtin_amdgcn_fence(__ATOMIC_RELEASE, "agent");
            asm volatile("s_waitcnt vmcnt(0)" ::: "memory");
            const unsigned og = xb_add(&bar[XB_TOP], 1u);
            const unsigned tg = og / nx;
            if (og + 1u == (tg + 1u) * nx) xb_add(&bar[XB_TOPGEN], 1u);
            else XB_SPIN(xb_ld(&bar[XB_TOPGEN]) == tg, bar);
            __builtin_amdgcn_fence(__ATOMIC_ACQUIRE, "agent");
            xb_add(&bar[XB_XGEN(b.x)], 1u);
            asm volatile("s_waitcnt vmcnt(0)" ::: "memory");
        } else {
            XB_SPIN(xb_ld(&bar[XB_XGEN(b.x)]) == gen, bar);
            __builtin_amdgcn_fence(__ATOMIC_ACQUIRE, "agent");
            asm volatile("s_waitcnt vmcnt(0)" ::: "memory");
        }
    }
    __syncthreads();
}


struct Args { const float* in[28]; float* out; unsigned char* ws; int g_lo, g_hi, l_lo, l_hi, ph_lo, ph_hi, prep, use_bar; };
typedef const __attribute__((address_space(4))) Args* ArgsP;
enum { I_X = 0, I_META, I_T5, I_GPREMIX, I_WIN, I_BIN, I_WA2, I_BA, I_GGLA, I_WBRG, I_GDQ, I_WUQ, I_WIQ, I_GDKV, I_WUV, I_LNG, I_LNB, I_WBRD,
       I_CONV, I_FB, I_GML, I_WBRM, I_WOUT, I_GPOSTMIX, I_GPREMLP, I_WUP, I_WDN, I_GPOSTMLP };

__device__ __forceinline__ int win_src(int n) {
    if (n < 3072) return n;
    if (n < 6144) return n - 3072 + 3544;
    if (n < 9216) return n - 6144 + 6624;
    if (n < 9472) return n - 9216 + 3088;
    if (n < 9600) return n - 9472 + 3344;
    if (n < 9664) return n - 9600 + 3472;
    if (n < 9680) return n - 9664 + 3072;
    if (n < 9688) return n - 9680 + 3536;
    if (n < 9692) return n - 9688 + 6616;
    if (n < 9696) return n - 9692 + 6620;
    return -1;
}
struct CmIdent { __device__ __forceinline__ int operator()(int n) const { return n; } };
struct CmWin { __device__ __forceinline__ int operator()(int n) const { return win_src(n); } };

template <class CM>
__device__ __forceinline__ void tr_item(const float* __restrict__ W, int ldw, bf16* __restrict__ WT, int Kd, LAS float* scr, int k0, int ns0, int nd0, int lane, CM cm) {
    const int sc = cm(ns0 + (lane & 31)); const int scc = sc >= 0 ? sc : 0; const float msk = sc >= 0 ? 1.f : 0.f;
    float wv[32];
#pragma unroll
    for (int i = 0; i < 32; ++i) { const int kk = 2 * i + (lane >> 5); wv[i] = W[(size_t)(k0 + kk) * ldw + scc]; }
#pragma unroll
    for (int i = 0; i < 32; ++i) { const int kk = 2 * i + (lane >> 5); scr[kk * 33 + (lane & 31)] = wv[i] * msk; }
    LDS_WAIT();
    const int c = lane & 7;
#pragma unroll
    for (int j = 0; j < 4; ++j) { const int n = (lane >> 3) + 8 * j; const LAS float* s = scr + (8 * c) * 33 + n;
        u32x4 o; o.x = pk2(s[0 * 33], s[1 * 33]); o.y = pk2(s[2 * 33], s[3 * 33]); o.z = pk2(s[4 * 33], s[5 * 33]); o.w = pk2(s[6 * 33], s[7 * 33]);
        *(u32x4*)(WT + (size_t)(nd0 + n) * Kd + k0 + 8 * c) = o; }
    LDS_WAIT();
}

__device__ __forceinline__ void prep_weights(ArgsP a, LAS unsigned char* lds, int gw, int ngw, int wave, int lane) {
    LAS float* scr = (LAS float*)(lds + wave * 16384);
    unsigned char* ws = a->ws;
    constexpr int I_WIN_N = 16 * 304, I_UQ = 4 * 64, I_IQ = 4 * 16, I_SQ = 16 * 32, I_UP = 16 * 128, I_DN = 64 * 32, I_WBD = 4096, I_B = NZ / 64;
    constexpr int PER_L = I_WIN_N + I_UQ + I_IQ + 3 * I_SQ + I_UP + I_DN + I_WBD + I_B;
    for (int it = gw; it < NL * PER_L; it += ngw) {
        const int l = it / PER_L; int r = it % PER_L;
        if (r < I_WIN_N) { const int kb = r / 304, nb = r % 304;
            tr_item(a->in[I_WIN] + (size_t)l * D * NCOLS, NCOLS, (bf16*)(ws + WS_WIN) + (size_t)l * NZ * D, D, scr, kb * 64, nb * 32, nb * 32, lane, CmWin()); continue; }
        r -= I_WIN_N;
        if (r < I_UQ) { const int kb = r / 64, nb = r % 64;
            tr_item(a->in[I_WUQ] + (size_t)l * 256 * 2048, 2048, (bf16*)(ws + WS_WQQ) + (size_t)l * NQQ * 256, 256, scr, kb * 64, nb * 32, nb * 32, lane, CmIdent()); continue; }
        r -= I_UQ;
        if (r < I_IQ) { const int kb = r / 16, nb = r % 16;
            tr_item(a->in[I_WIQ] + (size_t)l * 256 * 512, 512, (bf16*)(ws + WS_WQQ) + (size_t)l * NQQ * 256, 256, scr, kb * 64, nb * 32, 2048 + nb * 32, lane, CmIdent()); continue; }
        r -= I_IQ;
        if (r < I_SQ) { const int kb = r / 32, nb = r % 32;
            tr_item(a->in[I_WBRG] + (size_t)l * D * D, D, (bf16*)(ws + WS_WBG) + (size_t)l * D * D, D, scr, kb * 64, nb * 32, nb * 32, lane, CmIdent()); continue; }
        r -= I_SQ;
        if (r < I_SQ) { const int kb = r / 32, nb = r % 32;
            tr_item(a->in[I_WBRM] + (size_t)l * D * D, D, (bf16*)(ws + WS_WBM) + (size_t)l * D * D, D, scr, kb * 64, nb * 32, nb * 32, lane, CmIdent()); continue; }
        r -= I_SQ;
        if (r < I_SQ) { const int kb = r / 32, nb = r % 32;
            tr_item(a->in[I_WOUT] + (size_t)l * D * D, D, (bf16*)(ws + WS_WOUT) + (size_t)l * D * D, D, scr, kb * 64, nb * 32, nb * 32, lane, CmIdent()); continue; }
        r -= I_SQ;
        if (r < I_UP) { const int kb = r / 128, nb = r % 128;
            tr_item(a->in[I_WUP] + (size_t)l * D * DFF, DFF, (bf16*)(ws + WS_WUP) + (size_t)l * DFF * D, D, scr, kb * 64, nb * 32, nb * 32, lane, CmIdent()); continue; }
        r -= I_UP;
        if (r < I_DN) { const int kb = r / 32, nb = r % 32;
            tr_item(a->in[I_WDN] + (size_t)l * DFF * D, D, (bf16*)(ws + WS_WDN) + (size_t)l * D * DFF, DFF, scr, kb * 64, nb * 32, nb * 32, lane, CmIdent()); continue; }
        r -= I_DN;
        if (r < I_WBD) {
            const int h = r >> 8, nb = (r >> 4) & 15, cb = r & 15, n = nb * 64 + lane, c0 = cb * 8;
            const float* uv = a->in[I_WUV] + ((size_t)(l * 16 + h) * 128 + c0) * 64;
            const float* wb = a->in[I_WBRD] + ((size_t)l * D + h * 64) * D + n;
            float acc[8];
#pragma unroll
            for (int j = 0; j < 8; ++j) acc[j] = 0.f;
            for (int d0 = 0; d0 < 64; d0 += 8) {
                float wv[8];
#pragma unroll
                for (int e = 0; e < 8; ++e) wv[e] = wb[(size_t)(d0 + e) * D];
#pragma unroll
                for (int j = 0; j < 8; ++j) { const f32x4 u0 = *(const f32x4*)(uv + j * 64 + d0), u1 = *(const f32x4*)(uv + j * 64 + d0 + 4);
                    acc[j] += (u0.x * wv[0] + u0.y * wv[1]) + (u0.z * wv[2] + u0.w * wv[3]) + (u1.x * wv[4] + u1.y * wv[5]) + (u1.z * wv[6] + u1.w * wv[7]); }
            }
            bf16* o = (bf16*)(ws + WS_WBD) + (size_t)l * D * 2048 + (size_t)(h >> 3) * D * D + (size_t)n * D + (h & 7) * 128 + c0;
            u32x4 ow; ow.x = pk2(acc[0], acc[1]); ow.y = pk2(acc[2], acc[3]); ow.z = pk2(acc[4], acc[5]); ow.w = pk2(acc[6], acc[7]);
            *(u32x4*)o = ow;
            continue; }
        r -= I_WBD;
        { const int n = r * 64 + lane; const int sc = win_src(n);
          ((float*)(ws + WS_BIN))[l * NZ + n] = sc >= 0 ? a->in[I_BIN][l * NCOLS + sc] : 0.f; }
    }
}

__device__ __forceinline__ float* hrow(ArgsP a, int g, int r) {
    return r < MR ? a->out + ((size_t)g * MR + r) * D : (float*)(a->ws + WS_HM) + (size_t)(r - MR) * D;
}
__device__ __forceinline__ void rms_row_bf16(const f32x4 (&v)[4], const float* __restrict__ gain, bf16* __restrict__ orow, int lane) {
    float s = 0.f;
#pragma unroll
    for (int j = 0; j < 4; ++j) s += (v[j].x * v[j].x + v[j].y * v[j].y) + (v[j].z * v[j].z + v[j].w * v[j].w);
    const float r = rsqrtf(wave_sum(s) * (1.f / D) + EPS);
#pragma unroll
    for (int j = 0; j < 4; ++j) { const f32x4 gg = *(const f32x4*)(gain + 4 * lane + 256 * j); const f32x4 o = v[j] * r * gg;
        u32x2 w; w.x = pk2(o.x, o.y); w.y = pk2(o.z, o.w); *(u32x2*)(orow + 4 * lane + 256 * j) = w; }
}
__device__ __forceinline__ void p0_init(ArgsP a, int g, int gw, int ngw, int lane) {
    bf16* XN = (bf16*)(a->ws + WS_XN);
    for (int r = gw; r < MT; r += ngw) {
        const float* src = r < MR ? a->in[I_X] + ((size_t)g * MR + r) * D : a->in[I_META] + (size_t)(r - MR) * D;
        float* hd = hrow(a, g, r);
        f32x4 v[4];
#pragma unroll
        for (int j = 0; j < 4; ++j) { v[j] = *(const f32x4*)(src + 4 * lane + 256 * j); *(f32x4*)(hd + 4 * lane + 256 * j) = v[j]; }
        rms_row_bf16(v, a->in[I_GPREMIX], XN + (size_t)r * D, lane);
    }
}
template <bool DRY = false>
__device__ __forceinline__ void p_norm_res(ArgsP a, int g, const float* gpost, const float* gpre, int gw, int ngw, int lane) {
    bf16* XN = (bf16*)(a->ws + (DRY ? WS_Z + 100 * MiB : WS_XN)); const bf16* Y = (const bf16*)(a->ws + WS_Y);
    f32x4 gp[4], gq[4];
#pragma unroll
    for (int j = 0; j < 4; ++j) { gp[j] = *(const f32x4*)(gpost + 4 * lane + 256 * j); gq[j] = gpre ? *(const f32x4*)(gpre + 4 * lane + 256 * j) : (f32x4){0.f, 0.f, 0.f, 0.f}; }
    for (int r0 = gw * 2; r0 < MT; r0 += ngw * 2) {
        float* hd[2]; float* hw[2]; u32x2 yw[2][4]; f32x4 v[2][4]; float s[2];
#pragma unroll
        for (int i = 0; i < 2; ++i) { const int r = r0 + i; hd[i] = hrow(a, g, r); hw[i] = DRY ? (float*)(a->ws + WS_Z) + (size_t)r * D : hd[i];
#pragma unroll
            for (int j = 0; j < 4; ++j) { yw[i][j] = *(const u32x2*)(Y + (size_t)r * D + 4 * lane + 256 * j); v[i][j] = *(const f32x4*)(hd[i] + 4 * lane + 256 * j); } }
        f32x4 y[2][4];
#pragma unroll
        for (int i = 0; i < 2; ++i) { s[i] = 0.f;
#pragma unroll
            for (int j = 0; j < 4; ++j) { y[i][j] = (f32x4){bflo(yw[i][j].x), bfhi(yw[i][j].x), bflo(yw[i][j].y), bfhi(yw[i][j].y)};
                s[i] += (y[i][j].x * y[i][j].x + y[i][j].y * y[i][j].y) + (y[i][j].z * y[i][j].z + y[i][j].w * y[i][j].w); } }
#pragma unroll
        for (int o = 1; o < 64; o <<= 1) { s[0] += __shfl_xor(s[0], o); s[1] += __shfl_xor(s[1], o); }
        float s2[2];
#pragma unroll
        for (int i = 0; i < 2; ++i) { const float rr = rsqrtf(s[i] * (1.f / D) + EPS); s2[i] = 0.f;
#pragma unroll
            for (int j = 0; j < 4; ++j) { v[i][j] = v[i][j] + y[i][j] * rr * gp[j]; *(f32x4*)(hw[i] + 4 * lane + 256 * j) = v[i][j];
                s2[i] += (v[i][j].x * v[i][j].x + v[i][j].y * v[i][j].y) + (v[i][j].z * v[i][j].z + v[i][j].w * v[i][j].w); } }
        if (gpre) {
#pragma unroll
            for (int o = 1; o < 64; o <<= 1) { s2[0] += __shfl_xor(s2[0], o); s2[1] += __shfl_xor(s2[1], o); }
#pragma unroll
            for (int i = 0; i < 2; ++i) { const float r2 = rsqrtf(s2[i] * (1.f / D) + EPS);
#pragma unroll
                for (int j = 0; j < 4; ++j) { const f32x4 o4 = v[i][j] * r2 * gq[j]; u32x2 w; w.x = pk2(o4.x, o4.y); w.y = pk2(o4.z, o4.w); *(u32x2*)(XN + (size_t)(r0 + i) * D + 4 * lane + 256 * j) = w; } }
        }
    }
}

template <class F> struct EpiT {
    static constexpr bool PERM = true, AFTER_DRAIN = false;
    F f;
    __device__ __forceinline__ void operator()(const f32x4 (&acc)[2][2][4][2], const pg8::Unit& u, int wr, int wc, int fr, int fq) const {
        const int row0 = u.pm * 256 + wr * 64 + fr, col0 = u.pn * 256 + wc * 32 + 8 * fq;
        if constexpr (F::HAS_BIAS) {
            const f32x4 b00 = *(const f32x4*)(f.bias + col0), b01 = *(const f32x4*)(f.bias + col0 + 4), b10 = *(const f32x4*)(f.bias + col0 + 128), b11 = *(const f32x4*)(f.bias + col0 + 132);
#pragma unroll
            for (int ai = 0; ai < 2; ++ai)
#pragma unroll
                for (int m = 0; m < 4; ++m) { f.apply(row0 + ai * 128 + m * 16, col0, acc[ai][0][m][0] + b00, acc[ai][0][m][1] + b01); f.apply(row0 + ai * 128 + m * 16, col0 + 128, acc[ai][1][m][0] + b10, acc[ai][1][m][1] + b11); }
            return;
        }
#pragma unroll
        for (int ai = 0; ai < 2; ++ai)
#pragma unroll
            for (int m = 0; m < 4; ++m)
#pragma unroll
                for (int bj = 0; bj < 2; ++bj) f.apply(row0 + ai * 128 + m * 16, col0 + bj * 128, acc[ai][bj][m][0], acc[ai][bj][m][1]);
    }
};
__device__ __forceinline__ void st_bf16x8(bf16* p, f32x4 v0, f32x4 v1) { u32x4 w; w.x = pk2(v0.x, v0.y); w.y = pk2(v0.z, v0.w); w.z = pk2(v1.x, v1.y); w.w = pk2(v1.z, v1.w); *(u32x4*)p = w; }
__device__ __forceinline__ void ld_bf16x8(const bf16* p, f32x4& v0, f32x4& v1) { const u32x4 w = *(const u32x4*)p;
    v0 = (f32x4){bflo(w.x), bfhi(w.x), bflo(w.y), bfhi(w.y)}; v1 = (f32x4){bflo(w.z), bfhi(w.z), bflo(w.w), bfhi(w.w)}; }

struct FIn {
    static constexpr bool HAS_BIAS = true, STAGGER = true;
    bf16* Z; float* ZF; const float* bias;
    __device__ __forceinline__ void apply(int row, int col, f32x4 v0, f32x4 v1) const {
        const int t = col >> 8;
        if (t >= 36) { float* p = ZF + (size_t)row * ZFW + (col - ZB); *(f32x4*)p = v0; *(f32x4*)(p + 4) = v1; return; }
        if (t < 2) { v0 *= 0.08838834764831845f; v1 *= 0.08838834764831845f; }
        else if (t >= 8 && t < 12) {
#pragma unroll
            for (int i = 0; i < 4; ++i) { v0[i] = silu_f(v0[i]); v1[i] = silu_f(v1[i]); } }
        else if (t >= 20) {
#pragma unroll
            for (int i = 0; i < 4; ++i) { v0[i] = sigmoid_f(v0[i]); v1[i] = sigmoid_f(v1[i]); } }
        st_bf16x8(Z + (size_t)row * ZB + col, v0, v1);
    }
};
struct FQQ {
    static constexpr bool HAS_BIAS = false, STAGGER = false;
    bf16* QQ;
    __device__ __forceinline__ void apply(int row, int col, f32x4 v0, f32x4 v1) const {
        const float s = col < 2048 ? 0.08838834764831845f : 0.125f;
        st_bf16x8(QQ + (size_t)row * NQQ + col, v0 * s, v1 * s);
    }
};
template <int IDX> struct FBr {
    static constexpr bool HAS_BIAS = false;
    const bf16* Z; float* Y; bf16* MIX;
    __device__ __forceinline__ void apply(int row, int col, f32x4 v0, f32x4 v1) const {
        f32x4 g0, g1; ld_bf16x8(Z + (size_t)row * ZB + ZC_GATE + IDX * 1024 + col, g0, g1);
        float* y = Y + (size_t)row * D + col;
        f32x4 a0 = v0 * g0, a1 = v1 * g1;
        if (IDX > 0) { a0 += *(const f32x4*)y; a1 += *(const f32x4*)(y + 4); }
        if (IDX < 2) { *(f32x4*)y = a0; *(f32x4*)(y + 4) = a1; }
        else st_bf16x8(MIX + (size_t)row * D + col, a0, a1);
    }
};
struct FY {
    static constexpr bool HAS_BIAS = false, STAGGER = false;
    bf16* Y;
    __device__ __forceinline__ void apply(int row, int col, f32x4 v0, f32x4 v1) const { st_bf16x8(Y + (size_t)row * D + col, v0, v1); }
};
struct FUp {
    static constexpr bool HAS_BIAS = false, STAGGER = true;
    bf16* U;
    __device__ __forceinline__ void apply(int row, int col, f32x4 v0, f32x4 v1) const {
#pragma unroll
        for (int i = 0; i < 4; ++i) { const float p = fmaxf(v0[i], 0.f), q = fmaxf(v1[i], 0.f); v0[i] = p * p; v1[i] = q * q; }
        st_bf16x8(U + (size_t)row * DFF + col, v0, v1);
    }
};

template <class F>
__device__ __forceinline__ void mini_gemm(LAS unsigned char* lds, const bf16* __restrict__ A, const bf16* __restrict__ Bt, int N, int K, const F& f, int tid_in) {
    int tid = tid_in; asm volatile("" : "+v"(tid));
    const int lane = tid & 63, wave = __builtin_amdgcn_readfirstlane(tid >> 6), fr = lane & 15, fq = lane >> 4;
    LAS float* red = (LAS float*)lds;
    const int kw = K >> 3, kbeg = wave * kw;
    for (int wt = blockIdx.x; wt < N / 32; wt += gridDim.x) {
        const int n0 = wt * 32;
        f32x4 acc0 = {0.f, 0.f, 0.f, 0.f}, acc1 = {0.f, 0.f, 0.f, 0.f};
        const bf16* ap = A + (size_t)(MR + fr) * K + fq * 8 + kbeg;
        const bf16* b0 = Bt + (size_t)(n0 + pg8::perm32(fr)) * K + fq * 8 + kbeg;
        const bf16* b1 = Bt + (size_t)(n0 + pg8::perm32(16 + fr)) * K + fq * 8 + kbeg;
        if (kw < 128) {
            const bf16x8 av = *(const bf16x8*)ap, w0 = *(const bf16x8*)b0, w1 = *(const bf16x8*)b1;
            acc0 = __builtin_amdgcn_mfma_f32_16x16x32_bf16(w0, av, acc0, 0, 0, 0);
            acc1 = __builtin_amdgcn_mfma_f32_16x16x32_bf16(w1, av, acc1, 0, 0, 0);
        } else {
            for (int k = 0; k < kw; k += 128) {
                bf16x8 av[4], w0[4], w1[4];
#pragma unroll
                for (int u = 0; u < 4; ++u) { av[u] = *(const bf16x8*)(ap + k + 32 * u); w0[u] = *(const bf16x8*)(b0 + k + 32 * u); w1[u] = *(const bf16x8*)(b1 + k + 32 * u); }
#pragma unroll
                for (int u = 0; u < 4; ++u) {
                    acc0 = __builtin_amdgcn_mfma_f32_16x16x32_bf16(w0[u], av[u], acc0, 0, 0, 0);
                    acc1 = __builtin_amdgcn_mfma_f32_16x16x32_bf16(w1[u], av[u], acc1, 0, 0, 0);
                }
            }
        }
        *(LAS f32x4*)(red + (wave * 64 + lane) * 8) = acc0; *(LAS f32x4*)(red + (wave * 64 + lane) * 8 + 4) = acc1;
        LDS_WAIT();
        __syncthreads();
        if (wave == 0) {
            f32x4 s0 = {0.f, 0.f, 0.f, 0.f}, s1 = {0.f, 0.f, 0.f, 0.f};
#pragma unroll
            for (int w = 0; w < 8; ++w) { s0 += *(const LAS f32x4*)(red + (w * 64 + lane) * 8); s1 += *(const LAS f32x4*)(red + (w * 64 + lane) * 8 + 4); }
            if constexpr (F::HAS_BIAS) { s0 += *(const f32x4*)(f.bias + n0 + 8 * fq); s1 += *(const f32x4*)(f.bias + n0 + 8 * fq + 4); }
            f.apply(MR + fr, n0 + 8 * fq, s0, s1);
        }
        __syncthreads();
    }
}
template <class F, bool ALIGN = true>
__device__ __forceinline__ void run_gemm(LAS unsigned char* lds, const bf16* A, const bf16* Bt, int N, int K, const F& f, int gw, int ngw, int lane) {
    asm volatile("" : "+s"(K)); asm volatile("" : "+s"(N));
    pg8::Gemm g{A, Bt, MR, N, K}; pg8::StaticOrder S; S.init(MR, N, (int)gridDim.x, (int)blockIdx.x);
    EpiT<F> E{f};
#if defined(STAGGER_TICKS)
    if (F::STAGGER) {
        const unsigned long long t0 = __builtin_amdgcn_s_memrealtime(), dl = (unsigned long long)(blockIdx.x & 3u) * STAGGER_TICKS;
        while (__builtin_amdgcn_s_memrealtime() - t0 < dl) __builtin_amdgcn_s_sleep(4);
    }
#endif
    pg8::gemm_phase<EpiT<F>, pg8::StaticOrder, ALIGN, true>((PG8_LAS unsigned char*)lds, g, S, E);
    mini_gemm(lds, A, Bt, N, K, f, (int)threadIdx.x);
}

struct ChainOrder {
    pg8::StaticOrder S;
    __device__ __forceinline__ bool next(int i, pg8::Unit& u) const { if (!S.next(i >> 2, u)) return false; u.sub = i & 3; return true; }
    __device__ __forceinline__ void a_ready(const pg8::Unit&) const {}
    __device__ __forceinline__ void done(const pg8::Unit&) const {}
};
struct EpiMix {
    static constexpr bool PERM = true, AFTER_DRAIN = false;
    const bf16* Z; bf16* MIX;
    __device__ __forceinline__ void mid(f32x4 (&acc)[2][2][4][2], const pg8::Unit& u, int wr, int wc, int fr, int fq) const {
        if (u.sub == 1) return;
        const int gi = u.sub == 0 ? 0 : 1;
        const int row0 = u.pm * 256 + wr * 64 + fr, col0 = u.pn * 256 + wc * 32 + 8 * fq;
#pragma unroll
        for (int ai = 0; ai < 2; ++ai) {
            u32x4 ga[4][2], gb[4][2];
#pragma unroll
            for (int m = 0; m < 4; ++m)
#pragma unroll
                for (int bj = 0; bj < 2; ++bj) { const bf16* gp = Z + (size_t)(row0 + ai * 128 + m * 16) * ZB + ZC_GATE + gi * 1024 + col0 + bj * 128;
                    ga[m][bj] = *(const u32x4*)gp; gb[m][bj] = *(const u32x4*)(gp + 1024); }
#pragma unroll
            for (int m = 0; m < 4; ++m)
#pragma unroll
                for (int bj = 0; bj < 2; ++bj) {
                    const u32x4 a = ga[m][bj], b = gb[m][bj];
                    f32x4 r0, r1;
                    r0.x = bflo(a.x) * __builtin_amdgcn_rcpf(bflo(b.x)); r0.y = bfhi(a.x) * __builtin_amdgcn_rcpf(bfhi(b.x)); r0.z = bflo(a.y) * __builtin_amdgcn_rcpf(bflo(b.y)); r0.w = bfhi(a.y) * __builtin_amdgcn_rcpf(bfhi(b.y));
                    r1.x = bflo(a.z) * __builtin_amdgcn_rcpf(bflo(b.z)); r1.y = bfhi(a.z) * __builtin_amdgcn_rcpf(bfhi(b.z)); r1.z = bflo(a.w) * __builtin_amdgcn_rcpf(bflo(b.w)); r1.w = bfhi(a.w) * __builtin_amdgcn_rcpf(bfhi(b.w));
                    acc[ai][bj][m][0] *= r0; acc[ai][bj][m][1] *= r1;
                }
            asm volatile("" ::: "memory");
        }
    }
    __device__ __forceinline__ void operator()(const f32x4 (&acc)[2][2][4][2], const pg8::Unit& u, int wr, int wc, int fr, int fq) const {
        const int row0 = u.pm * 256 + wr * 64 + fr, col0 = u.pn * 256 + wc * 32 + 8 * fq;
#pragma unroll
        for (int ai = 0; ai < 2; ++ai) {
            u32x4 gc[4][2];
#pragma unroll
            for (int m = 0; m < 4; ++m)
#pragma unroll
                for (int bj = 0; bj < 2; ++bj) gc[m][bj] = *(const u32x4*)(Z + (size_t)(row0 + ai * 128 + m * 16) * ZB + ZC_GATE + 2 * 1024 + col0 + bj * 128);
#pragma unroll
            for (int m = 0; m < 4; ++m)
#pragma unroll
                for (int bj = 0; bj < 2; ++bj) {
                    const u32x4 w = gc[m][bj];
                    const f32x4 g0 = {bflo(w.x), bfhi(w.x), bflo(w.y), bfhi(w.y)}, g1 = {bflo(w.z), bfhi(w.z), bflo(w.w), bfhi(w.w)};
                    st_bf16x8(MIX + (size_t)(row0 + ai * 128 + m * 16) * D + col0 + bj * 128, acc[ai][bj][m][0] * g0, acc[ai][bj][m][1] * g1);
                }
            asm volatile("" ::: "memory");
        }
    }
};

__device__ __forceinline__ int prow(int r, int j) {
    if (r < MR) { const int s = r & (SEQ - 1); return (s - j >= 0) ? r - j : MR + (NMETA + s - j); }
    const int t = r - MR; return (t - j >= 0) ? r - j : -1;
}
__device__ __forceinline__ void p2_prep(ArgsP a, int l, int gw, int ngw, int lane) {
    unsigned char* ws = a->ws;
    const bf16* Z = (const bf16*)(ws + WS_Z);
    for (int r = gw; r < MT; r += ngw) {
        const float* zf = (const float*)(ws + WS_ZF) + (size_t)r * ZFW;
        f32x4 vq = *(const f32x4*)(zf + ZF_CQ + 4 * lane);
        f32x2 vk = *(const f32x2*)(zf + ZF_CKV + 2 * lane);
        const float vi = zf[ZF_IK + lane];
        const float vw = zf[ZF_IW + (lane & 7)];
        const f32x4 gq = *(const f32x4*)(a->in[I_GDQ] + l * 256 + 4 * lane);
        const f32x2 gk = *(const f32x2*)(a->in[I_GDKV] + l * 128 + 2 * lane);
        const float lg = a->in[I_LNG][l * 64 + lane], lb = a->in[I_LNB][l * 64 + lane];
        float s1 = (vq.x * vq.x + vq.y * vq.y) + (vq.z * vq.z + vq.w * vq.w), s2 = vk.x * vk.x + vk.y * vk.y, s3 = vi;
#pragma unroll
        for (int o = 1; o < 64; o <<= 1) { s1 += __shfl_xor(s1, o); s2 += __shfl_xor(s2, o); s3 += __shfl_xor(s3, o); }
        const float d = vi - s3 * (1.f / 64.f);
        const float var = wave_sum(d * d) * (1.f / 64.f);
        const float r1 = rsqrtf(s1 * (1.f / 256.f) + EPS), r2 = rsqrtf(s2 * (1.f / 128.f) + EPS);
        vq = vq * r1 * gq;
        { u32x2 w; w.x = pk2(vq.x, vq.y); w.y = pk2(vq.z, vq.w); *(u32x2*)((bf16*)(ws + WS_CQN) + (size_t)r * 256 + 4 * lane) = w; }
        *(unsigned*)((bf16*)(ws + WS_KV) + (size_t)r * 128 + 2 * lane) = pk2(vk.x * r2 * gk.x, vk.y * r2 * gk.y);
        ((bf16*)(ws + WS_KI))[(size_t)r * 64 + lane] = (bf16)f2bf(d * rsqrtf(var + EPS) * lg + lb);
        if (lane < 8) ((float*)(ws + WS_WI))[(size_t)r * 8 + lane] = vw * 0.35355339059327373f;
    }
    float* DDp = (float*)(ws + WS_DD);
    for (int it = gw; it < 257 * 8; it += ngw) {
        const int cid = it >> 3, mx = (it >> 2) & 1, h = it & 3;
        const int nrows = cid == 256 ? NMETA : 64, rbase = cid == 256 ? MR : cid * 64;
        const int k0 = 2 * lane;
        if (!mx) {
            float w0[16], w1[16];
#pragma unroll
            for (int j = 0; j < 16; ++j) { const f32x2 w = *(const f32x2*)(a->in[I_WA2] + (size_t)(l * 16 + j) * 512 + h * 128 + k0); w0[j] = w.x; w1[j] = w.y; }
            const f32x2 bb = *(const f32x2*)(a->in[I_BA] + l * 512 + h * 128 + k0);
            bf16* __restrict__ QG = (bf16*)(ws + WS_G);
            const bf16* __restrict__ Zr = Z; const float* __restrict__ ZFr = (const float*)(ws + WS_ZF);
            float G0 = 0.f, G1 = 0.f;
            f32x4 pa[4][4]; unsigned pq[4], pk[4];
#define P2G_LOAD(t0) do { _Pragma("unroll") for (int i = 0; i < 4; ++i) { const int r_ = rbase + (t0) + i; const float* zf_ = ZFr + (size_t)r_ * ZFW + ZF_A; \
                pa[i][0] = *(const f32x4*)zf_; pa[i][1] = *(const f32x4*)(zf_ + 4); pa[i][2] = *(const f32x4*)(zf_ + 8); pa[i][3] = *(const f32x4*)(zf_ + 12); \
                pq[i] = *(const unsigned*)(Zr + (size_t)r_ * ZB + ZC_GQ + h * 128 + k0); pk[i] = *(const unsigned*)(Zr + (size_t)r_ * ZB + ZC_GK + h * 128 + k0); } } while (0)
            P2G_LOAD(0);
            for (int t0 = 0; t0 < nrows; t0 += 4) {
                f32x4 ca[4][4]; unsigned cqw[4], ckw[4];
#pragma unroll
                for (int i = 0; i < 4; ++i) { ca[i][0] = pa[i][0]; ca[i][1] = pa[i][1]; ca[i][2] = pa[i][2]; ca[i][3] = pa[i][3]; cqw[i] = pq[i]; ckw[i] = pk[i]; }
                if (t0 + 4 < nrows) P2G_LOAD(t0 + 4);
#pragma unroll
                for (int i = 0; i < 4; ++i) {
                    const int r = rbase + t0 + i;
                    const float av[16] = {ca[i][0].x, ca[i][0].y, ca[i][0].z, ca[i][0].w, ca[i][1].x, ca[i][1].y, ca[i][1].z, ca[i][1].w, ca[i][2].x, ca[i][2].y, ca[i][2].z, ca[i][2].w, ca[i][3].x, ca[i][3].y, ca[i][3].z, ca[i][3].w};
                    float s0 = bb.x, s1 = bb.y;
#pragma unroll
                    for (int j = 0; j < 16; ++j) { s0 += av[j] * w0[j]; s1 += av[j] * w1[j]; }
                    G0 += logsigmoid_f(s0) * 0.0625f; G1 += logsigmoid_f(s1) * 0.0625f;
                    const float e0 = __expf(G0), e1 = __expf(G1), i0 = __builtin_amdgcn_rcpf(e0), i1 = __builtin_amdgcn_rcpf(e1);
                    *(unsigned*)(QG + (size_t)r * 1024 + h * 128 + k0) = pk2(bflo(cqw[i]) * e0, bfhi(cqw[i]) * e1);
                    *(unsigned*)(QG + (size_t)r * 1024 + 512 + h * 128 + k0) = pk2(bflo(ckw[i]) * i0, bfhi(ckw[i]) * i1);
                }
            }
#undef P2G_LOAD
            *(f32x2*)(DDp + ((size_t)cid * 4 + h) * 128 + k0) = (f32x2){__expf(G0), __expf(G1)};
        } else {
            float cq[4][2], ck[4][2];
#pragma unroll
            for (int tap = 0; tap < 4; ++tap) { const f32x2 wq = *(const f32x2*)(a->in[I_CONV] + (size_t)(l * 4 + tap) * 1024 + h * 128 + k0), wk = *(const f32x2*)(a->in[I_CONV] + (size_t)(l * 4 + tap) * 1024 + 512 + h * 128 + k0);
                cq[tap][0] = wq.x; cq[tap][1] = wq.y; ck[tap][0] = wk.x; ck[tap][1] = wk.y; }
            const float fb = a->in[I_FB][l * 4 + h];
            bf16* __restrict__ QM = (bf16*)(ws + WS_QKC);
            const bf16* __restrict__ Zr = Z; const float* __restrict__ ZFr = (const float*)(ws + WS_ZF);
            float xq[3][2], xk[3][2];
#pragma unroll
            for (int j = 0; j < 3; ++j) {
                const int rp = prow(rbase, j + 1);
                unsigned qw = 0u, kw = 0u;
                if (rp >= 0) { qw = *(const unsigned*)(Z + (size_t)rp * ZB + ZC_MQ + h * 128 + k0); kw = *(const unsigned*)(Z + (size_t)rp * ZB + ZC_MK + h * 128 + k0); }
                xq[j][0] = bflo(qw); xq[j][1] = bfhi(qw); xk[j][0] = bflo(kw); xk[j][1] = bfhi(kw);
            }
            float bsum = 0.f;
            float pli[4], plf[4]; unsigned pq[4], pk[4];
#define P2M_LOAD(t0) do { _Pragma("unroll") for (int i = 0; i < 4; ++i) { const int r_ = rbase + (t0) + i; const float* zf_ = ZFr + (size_t)r_ * ZFW; \
                pli[i] = zf_[ZF_MI + h]; plf[i] = zf_[ZF_MF + h]; \
                pq[i] = *(const unsigned*)(Zr + (size_t)r_ * ZB + ZC_MQ + h * 128 + k0); pk[i] = *(const unsigned*)(Zr + (size_t)r_ * ZB + ZC_MK + h * 128 + k0); } } while (0)
            P2M_LOAD(0);
            for (int t0 = 0; t0 < nrows; t0 += 4) {
                float cli[4], clf[4]; unsigned cqw[4], ckw[4];
#pragma unroll
                for (int i = 0; i < 4; ++i) { cli[i] = pli[i]; clf[i] = plf[i]; cqw[i] = pq[i]; ckw[i] = pk[i]; }
                if (t0 + 4 < nrows) P2M_LOAD(t0 + 4);
#pragma unroll
                for (int i = 0; i < 4; ++i) {
                    const int r = rbase + t0 + i;
                    const float li = cli[i], lf = logsigmoid_f(clf[i] + fb);
                    bsum += lf;
                    const float q0 = bflo(cqw[i]), q1 = bfhi(cqw[i]), kk0 = bflo(ckw[i]), kk1 = bfhi(ckw[i]);
                    const float yq0 = cq[3][0] * q0 + cq[2][0] * xq[0][0] + cq[1][0] * xq[1][0] + cq[0][0] * xq[2][0];
                    const float yq1 = cq[3][1] * q1 + cq[2][1] * xq[0][1] + cq[1][1] * xq[1][1] + cq[0][1] * xq[2][1];
                    const float yk0 = ck[3][0] * kk0 + ck[2][0] * xk[0][0] + ck[1][0] * xk[1][0] + ck[0][0] * xk[2][0];
                    const float yk1 = ck[3][1] * kk1 + ck[2][1] * xk[0][1] + ck[1][1] * xk[1][1] + ck[0][1] * xk[2][1];
                    xq[2][0] = xq[1][0]; xq[2][1] = xq[1][1]; xq[1][0] = xq[0][0]; xq[1][1] = xq[0][1]; xq[0][0] = q0; xq[0][1] = q1;
                    xk[2][0] = xk[1][0]; xk[2][1] = xk[1][1]; xk[1][0] = xk[0][0]; xk[1][1] = xk[0][1]; xk[0][0] = kk0; xk[0][1] = kk1;
                    const float eq = __expf(bsum) * 0.08838834764831845f, ek = __expf(li - bsum);
                    *(unsigned*)(QM + (size_t)r * 1024 + h * 128 + k0) = pk2(silu_f(yq0) * eq, silu_f(yq1) * eq);
                    *(unsigned*)(QM + (size_t)r * 1024 + 512 + h * 128 + k0) = pk2(silu_f(yk0) * ek, silu_f(yk1) * ek);
                }
            }
#undef P2M_LOAD
            const float dd = __expf(bsum);
            *(f32x2*)(DDp + ((size_t)(257 + cid) * 4 + h) * 128 + k0) = (f32x2){dd, dd};
        }
    }
}

constexpr int SC_QS = 272, SC_VS = 144;
constexpr int SC_QT = 0, SC_KT = 2 * 17408, SC_VT = 4 * 17408, SC_AT = SC_VT + 2 * 9216, SC_SB = SC_AT + 9216, SC_DD = SC_SB + 18432, SC_NB = SC_DD + 1024, SC_END = SC_NB + 256;
static_assert(SC_END <= RING_BYTES, "scan LDS");
__device__ __forceinline__ bf16x8 tr8(LAS unsigned char* base, int stride, int row0, int col0, int lane) {
    const int fq = lane >> 4, q4 = (lane & 15) >> 2, p4 = lane & 3;
    LAS unsigned char* p = base + (row0 + 8 * fq + q4) * stride + (col0 + 4 * p4) * 2;
    const s16x4 lo = __builtin_amdgcn_ds_read_tr16_b64_v4i16((LAS s16x4*)p);
    const s16x4 hi = __builtin_amdgcn_ds_read_tr16_b64_v4i16((LAS s16x4*)(p + 4 * stride));
    return __builtin_shufflevector(lo, hi, 0, 1, 2, 3, 4, 5, 6, 7);
}
template <bool ML>
__device__ __forceinline__ void scan_unit(ArgsP a, LAS unsigned char* lds, int b, int h, int vs, int tid_in) {
    int tid = tid_in; asm volatile("" : "+v"(tid));
    unsigned char* ws = a->ws;
    const bf16* Z = (const bf16*)(ws + WS_Z);
    const bf16* QK = (const bf16*)(ws + (ML ? WS_QKC : WS_G));
    const float* DDp = (const float*)(ws + WS_DD) + (ML ? (size_t)257 * 512 : 0);
    bf16* O = (bf16*)(ws + (ML ? WS_OM : WS_OG));
    const int lane = tid & 63, wave = __builtin_amdgcn_readfirstlane(tid >> 6), fr = lane & 15, fq = lane >> 4;
    const int vt = wave & 3, hh = wave >> 2;
    for (int i = tid; i < (18432 + 1024 + 256) / 4; i += 512) ((LAS unsigned*)(lds + SC_SB))[i] = 0u;
    f32x4 S[4], nacc[4];
#pragma unroll
    for (int i = 0; i < 4; ++i) { S[i] = (f32x4){0.f, 0.f, 0.f, 0.f}; nacc[i] = (f32x4){0.f, 0.f, 0.f, 0.f}; }
    const bf16x8 ones = {(short)0x3F80, (short)0x3F80, (short)0x3F80, (short)0x3F80, (short)0x3F80, (short)0x3F80, (short)0x3F80, (short)0x3F80};
    u32x4 gq[2], gk[2], gv; float gd = 0.f;
    const int vcol = (ML ? ZC_MV : ZC_GV) + h * 256 + vs * 64;
    const bf16* zpage = (const bf16*)(ws + WS_CTL + 512 * 1024);
#define SCAN_LOAD(c) do { const int c_ = (c); \
        _Pragma("unroll") for (int e = 0; e < 2; ++e) { const int pid = tid + 512 * e, t = pid >> 4, ch = pid & 15; \
            const bool ok = c_ > 0 || t >= 48; const int row = c_ == 0 ? MR + t - 48 : b * SEQ + (c_ - 1) * 64 + t; \
            const bf16* qp_ = ok ? QK + (size_t)row * 1024 + h * 128 + ch * 8 : zpage; \
            gq[e] = *(const u32x4*)qp_; gk[e] = *(const u32x4*)(qp_ + 512); } \
        { const int t = tid >> 3, ch = tid & 7; const bool ok = c_ > 0 || t >= 48; const int row = c_ == 0 ? MR + t - 48 : b * SEQ + (c_ - 1) * 64 + t; \
          gv = *(const u32x4*)(ok ? Z + (size_t)row * ZB + vcol + ch * 8 : zpage); } \
        { const int cid = c_ == 0 ? 256 : b * 32 + (c_ - 1); gd = DDp[((size_t)cid * 4 + h) * 128 + (tid & 127)]; } } while (0)
#define SCAN_STORE(buf) do { const int bo_ = (buf); \
        _Pragma("unroll") for (int e = 0; e < 2; ++e) { const int pid = tid + 512 * e, t = pid >> 4, ch = pid & 15; \
            *(LAS u32x4*)(lds + SC_QT + bo_ * 17408 + t * SC_QS + ch * 16) = gq[e]; *(LAS u32x4*)(lds + SC_KT + bo_ * 17408 + t * SC_QS + ch * 16) = gk[e]; } \
        { const int t = tid >> 3, ch = tid & 7; *(LAS u32x4*)(lds + SC_VT + bo_ * 9216 + t * SC_VS + ch * 16) = gv; } \
        if (tid < 128) ((LAS float*)(lds + SC_DD))[bo_ * 128 + tid] = gd; } while (0)
    SCAN_LOAD(0);
    __syncthreads();
    SCAN_STORE(0);
    __syncthreads();
    for (int c = 0; c < 33; ++c) {
        const int buf = c & 1;
        LAS unsigned char* QT = lds + SC_QT + buf * 17408; LAS unsigned char* KT = lds + SC_KT + buf * 17408; LAS unsigned char* VT = lds + SC_VT + buf * 9216;
        LAS unsigned char* AT = lds + SC_AT; LAS unsigned char* SB = lds + SC_SB;
        const LAS float* ddL = (const LAS float*)(lds + SC_DD) + buf * 128;
        if (c + 1 < 33) SCAN_LOAD(c + 1);
        {
            const int ti = wave >> 1;
#pragma unroll
            for (int sj = 0; sj < 2; ++sj) {
                const int si = 2 * (wave & 1) + sj;
                f32x4 acc = {0.f, 0.f, 0.f, 0.f};
                bf16x8 qa[4], kb[4];
#pragma unroll
                for (int ks = 0; ks < 4; ++ks) { qa[ks] = *(const LAS bf16x8*)(QT + (16 * ti + fr) * SC_QS + (32 * ks + 8 * fq) * 2); kb[ks] = *(const LAS bf16x8*)(KT + (16 * si + fr) * SC_QS + (32 * ks + 8 * fq) * 2); }
                asm volatile("" ::: "memory");
#pragma unroll
                for (int ks = 0; ks < 4; ++ks) acc = __builtin_amdgcn_mfma_f32_16x16x32_bf16(qa[ks], kb[ks], acc, 0, 0, 0);
                const int sg = 16 * si + fr, tg = 16 * ti + 4 * fq;
                LAS bf16* ap = (LAS bf16*)(AT + tg * SC_VS) + sg;
                ap[0 * (SC_VS / 2)] = (bf16)(sg <= tg + 0 ? f2bf(acc.x) : 0u);
                ap[1 * (SC_VS / 2)] = (bf16)(sg <= tg + 1 ? f2bf(acc.y) : 0u);
                ap[2 * (SC_VS / 2)] = (bf16)(sg <= tg + 2 ? f2bf(acc.z) : 0u);
                ap[3 * (SC_VS / 2)] = (bf16)(sg <= tg + 3 ? f2bf(acc.w) : 0u);
            }
        }
        {
            const bf16x8 vb0 = tr8(VT, SC_VS, 0, 16 * vt, lane), vb1 = tr8(VT, SC_VS, 32, 16 * vt, lane);
#pragma unroll
            for (int i = 0; i < 4; ++i) {
                const int kt = 4 * hh + i;
                const bf16x8 ka0 = tr8(KT, SC_QS, 0, 16 * kt, lane), ka1 = tr8(KT, SC_QS, 32, 16 * kt, lane);
                f32x4 acc = S[i];
                acc = __builtin_amdgcn_mfma_f32_16x16x32_bf16(ka0, vb0, acc, 0, 0, 0);
                acc = __builtin_amdgcn_mfma_f32_16x16x32_bf16(ka1, vb1, acc, 0, 0, 0);
                const f32x4 dv = *(const LAS f32x4*)(ddL + 16 * kt + 4 * fq);
                S[i] = acc * dv;
                if (ML) {
                    f32x4 na = nacc[i];
                    na = __builtin_amdgcn_mfma_f32_16x16x32_bf16(ka0, ones, na, 0, 0, 0);
                    na = __builtin_amdgcn_mfma_f32_16x16x32_bf16(ka1, ones, na, 0, 0, 0);
                    nacc[i] = na * dv;
                }
            }
        }
        LDS_WAIT();
        __syncthreads();
        {
            const bf16x8 vb0 = tr8(VT, SC_VS, 0, 16 * vt, lane), vb1 = tr8(VT, SC_VS, 32, 16 * vt, lane);
            bf16x8 sb[4];
#pragma unroll
            for (int ks = 0; ks < 4; ++ks) sb[ks] = tr8(SB, SC_VS, 32 * ks, 16 * vt, lane);
            bf16x8 nb[4];
            if (ML) {
#pragma unroll
                for (int ks = 0; ks < 4; ++ks) nb[ks] = *(const LAS bf16x8*)(lds + SC_NB + (32 * ks + 8 * fq) * 2);
            }
#pragma unroll
            for (int tj = 0; tj < 2; ++tj) {
                const int ti = 2 * hh + tj;
                f32x4 acc = {0.f, 0.f, 0.f, 0.f}, den = {0.f, 0.f, 0.f, 0.f};
                bf16x8 qa[4];
#pragma unroll
                for (int ks = 0; ks < 4; ++ks) qa[ks] = *(const LAS bf16x8*)(QT + (16 * ti + fr) * SC_QS + (32 * ks + 8 * fq) * 2);
                const bf16x8 aa0 = *(const LAS bf16x8*)(AT + (16 * ti + fr) * SC_VS + (8 * fq) * 2), aa1 = *(const LAS bf16x8*)(AT + (16 * ti + fr) * SC_VS + (32 + 8 * fq) * 2);
                asm volatile("" ::: "memory");
#pragma unroll
                for (int ks = 0; ks < 4; ++ks) {
                    acc = __builtin_amdgcn_mfma_f32_16x16x32_bf16(qa[ks], sb[ks], acc, 0, 0, 0);
                    if (ML) den = __builtin_amdgcn_mfma_f32_16x16x32_bf16(qa[ks], nb[ks], den, 0, 0, 0);
                }
                acc = __builtin_amdgcn_mfma_f32_16x16x32_bf16(aa0, vb0, acc, 0, 0, 0);
                acc = __builtin_amdgcn_mfma_f32_16x16x32_bf16(aa1, vb1, acc, 0, 0, 0);
                if (ML) {
                    den = __builtin_amdgcn_mfma_f32_16x16x32_bf16(aa0, ones, den, 0, 0, 0);
                    den = __builtin_amdgcn_mfma_f32_16x16x32_bf16(aa1, ones, den, 0, 0, 0);
                    acc.x *= __builtin_amdgcn_rcpf(fmaxf(fabsf(den.x), 1.f)); acc.y *= __builtin_amdgcn_rcpf(fmaxf(fabsf(den.y), 1.f)); acc.z *= __builtin_amdgcn_rcpf(fmaxf(fabsf(den.z), 1.f)); acc.w *= __builtin_amdgcn_rcpf(fmaxf(fabsf(den.w), 1.f));
                }
                const int t0 = 16 * ti + 4 * fq;
                const int rowb = c == 0 ? MR + t0 - 48 : b * SEQ + (c - 1) * 64 + t0;
                bf16* op = O + (size_t)rowb * 1024 + h * 256 + vs * 64 + 16 * vt + fr;
                if (c > 0 || t0 >= 48) { op[0] = (bf16)f2bf(acc.x); op[1024] = (bf16)f2bf(acc.y); op[2048] = (bf16)f2bf(acc.z); op[3072] = (bf16)f2bf(acc.w); }
            }
        }
        LDS_WAIT();
        __syncthreads();
        {
#pragma unroll
            for (int i = 0; i < 4; ++i) {
                const int k0 = 16 * (4 * hh + i) + 4 * fq;
                LAS bf16* sp = (LAS bf16*)(SB + k0 * SC_VS) + 16 * vt + fr;
                sp[0 * (SC_VS / 2)] = (bf16)f2bf(S[i].x); sp[1 * (SC_VS / 2)] = (bf16)f2bf(S[i].y); sp[2 * (SC_VS / 2)] = (bf16)f2bf(S[i].z); sp[3 * (SC_VS / 2)] = (bf16)f2bf(S[i].w);
                if (ML && vt == 0 && fr == 0) { LAS bf16* np = (LAS bf16*)(lds + SC_NB) + k0; np[0] = (bf16)f2bf(nacc[i].x); np[1] = (bf16)f2bf(nacc[i].y); np[2] = (bf16)f2bf(nacc[i].z); np[3] = (bf16)f2bf(nacc[i].w); }
            }
            if (c + 1 < 33) SCAN_STORE(buf ^ 1);
        }
        LDS_WAIT();
        __syncthreads();
    }
#undef SCAN_LOAD
#undef SCAN_STORE
}

template <bool DRY = false>
__device__ __forceinline__ void p6_headnorm(ArgsP a, int l, int gw, int ngw, int lane) {
    unsigned char* ws = a->ws; const bf16* Z = (const bf16*)(ws + WS_Z);
    const f32x4 gg0 = *(const f32x4*)(a->in[I_GGLA] + l * 256 + 4 * lane), gg1 = *(const f32x4*)(a->in[I_GML] + l * 256 + 4 * lane);
    for (int it0 = gw * 4; it0 < MT * 8; it0 += ngw * 4) {
        u32x2 w[4], gw2[4]; bf16* op[4];
#pragma unroll
        for (int i = 0; i < 4; ++i) { const int it = it0 + i, r = it >> 3, mx = (it >> 2) & 1, h = it & 3;
            op[i] = (bf16*)(ws + (mx ? WS_OM : WS_OG)) + (size_t)r * 1024 + h * 256 + 4 * lane;
            w[i] = *(const u32x2*)op[i];
            gw2[i] = *(const u32x2*)(Z + (size_t)r * ZB + (mx ? ZC_MO : ZC_GR) + h * 256 + 4 * lane); }
        f32x4 v[4]; float ss[4];
#pragma unroll
        for (int i = 0; i < 4; ++i) { v[i] = (f32x4){bflo(w[i].x), bfhi(w[i].x), bflo(w[i].y), bfhi(w[i].y)}; ss[i] = (v[i].x * v[i].x + v[i].y * v[i].y) + (v[i].z * v[i].z + v[i].w * v[i].w); }
#pragma unroll
        for (int o = 1; o < 64; o <<= 1) {
#pragma unroll
            for (int i = 0; i < 4; ++i) ss[i] += __shfl_xor(ss[i], o);
        }
#pragma unroll
        for (int i = 0; i < 4; ++i) {
            const int mx = ((it0 + i) >> 2) & 1;
            const float rr = rsqrtf(ss[i] * (1.f / 256.f) + EPS);
            const f32x4 gt = {bflo(gw2[i].x), bfhi(gw2[i].x), bflo(gw2[i].y), bfhi(gw2[i].y)};
            const f32x4 o4 = v[i] * rr * (mx ? gg1 : gg0) * gt;
            u32x2 o; o.x = pk2(o4.x, o4.y); o.y = pk2(o4.z, o4.w);
            *(u32x2*)(DRY ? (bf16*)(ws + WS_XN) + ((size_t)((it0 + i) >> 3) * 1024 + ((it0 + i) & 3) * 256 + 4 * lane) : op[i]) = o;
        }
    }
}

__device__ __forceinline__ int krow(int b, int s) { return s < NMETA ? MR + s : b * SEQ + (s - NMETA); }
__device__ __forceinline__ int t5_bucket(int n) {
    if (n < 16) return n < 0 ? 0 : n;
    const int lg = 16 + (int)(__logf((float)n * (1.f / 16.f)) / 2.0794415416798357f * 16.f);
    return lg < 31 ? lg : 31;
}
__device__ __forceinline__ unsigned off_b(unsigned row, unsigned ch) { return 256u * row + 16u * (ch ^ (((row & 3) << 2) | ((row >> 2) & 3))); }
__device__ __forceinline__ s16x4 tr_rd(LAS unsigned char* p) { return __builtin_amdgcn_ds_read_tr16_b64_v4i16((LAS s16x4*)p); }

constexpr int DW2_STRIDE = 9472, DW2_TILE = 0, DW2_SEL = 8192, DW2_BK = 8832, DSA2_T5 = 8 * DW2_STRIDE, DSA2_BT = DSA2_T5 + 2048 + 64;

__device__ __forceinline__ int wave_sum_dpp(int x) {
    x += __builtin_amdgcn_update_dpp(0, x, 0xB1, 0xf, 0xf, false);
    x += __builtin_amdgcn_update_dpp(0, x, 0x4E, 0xf, 0xf, false);
    x += __builtin_amdgcn_update_dpp(0, x, 0x141, 0xf, 0xf, false);
    x += __builtin_amdgcn_update_dpp(0, x, 0x140, 0xf, 0xf, false);
    return __builtin_amdgcn_readlane(x, 0) + __builtin_amdgcn_readlane(x, 16) + __builtin_amdgcn_readlane(x, 32) + __builtin_amdgcn_readlane(x, 48);
}
__device__ __forceinline__ int wave_scan_dpp(int x) {
    x += __builtin_amdgcn_update_dpp(0, x, 0x111, 0xf, 0xf, false);
    x += __builtin_amdgcn_update_dpp(0, x, 0x112, 0xf, 0xf, false);
    x += __builtin_amdgcn_update_dpp(0, x, 0x114, 0xf, 0xf, false);
    x += __builtin_amdgcn_update_dpp(0, x, 0x118, 0xf, 0xf, false);
    x += __builtin_amdgcn_update_dpp(0, x, 0x142, 0xa, 0xf, false);
    x += __builtin_amdgcn_update_dpp(0, x, 0x143, 0xc, 0xf, false);
    return x;
}
#if defined(DIAG_SEL)
#ifndef DIAG_BLK
#define DIAG_BLK 31
#endif
#define DSTAMP(slot) do { if (blockIdx.x == DIAG_BLK && threadIdx.x == 0) { volatile LAS unsigned* M_ = (volatile LAS unsigned*)(lds + MISC_OFF); const unsigned now_ = (unsigned)__builtin_amdgcn_s_memrealtime(); M_[slot] += now_ - M_[14]; M_[14] = now_; } } while (0)
#else
#define DSTAMP(slot) do {} while (0)
#endif
template <bool DENSE_ONLY>
__device__ __forceinline__ void dsa_unit(ArgsP a, LAS unsigned char* lds, int b, int c, int nq, int wave, int lane_in) {
    int lane = lane_in; asm volatile("" : "+v"(lane));
    unsigned char* ws = a->ws;
    const bf16* QQ = (const bf16*)(ws + WS_QQ); const bf16* KI = (const bf16*)(ws + WS_KI); const bf16* KV = (const bf16*)(ws + WS_KV);
    unsigned* SC = (unsigned*)(ws + WS_SC) + (size_t)blockIdx.x * 64 * SC_PITCH;
    const int r0 = DENSE_ONLY ? MR : b * SEQ + 64 * c, p0 = DENSE_ONLY ? 0 : NMETA + 64 * c;
    const int fr = lane & 15, fq = lane >> 4;
    if (!DENSE_ONLY) {
        const int qt = wave & 3, kh = wave >> 2;
        if (p0 + 16 * qt + 15 >= 256) {
            const int qrow = r0 + 16 * qt + fr, pq = p0 + 16 * qt + fr;
            bf16x8 qf[8][2];
#pragma unroll
            for (int h = 0; h < 8; ++h)
#pragma unroll
                for (int ks = 0; ks < 2; ++ks) qf[h][ks] = *(const bf16x8*)(QQ + (size_t)qrow * NQQ + 2048 + h * 64 + ks * 32 + 8 * fq);
            float wi[8];
            { const f32x4 w0 = *(const f32x4*)((const float*)(ws + WS_WI) + (size_t)qrow * 8), w1 = *(const f32x4*)((const float*)(ws + WS_WI) + (size_t)qrow * 8 + 4);
              wi[0] = w0.x; wi[1] = w0.y; wi[2] = w0.z; wi[3] = w0.w; wi[4] = w1.x; wi[5] = w1.y; wi[6] = w1.z; wi[7] = w1.w; }
            const int nkt = 2 + 4 * c + qt;
            unsigned* scq = SC + (size_t)(16 * qt + fr) * SC_PITCH + 4 * fq;
            bf16x8 pa0[4], pa1[4];
#define DSA_KLOAD(kt0_) do { _Pragma("unroll") for (int j = 0; j < 4; ++j) { const int kt_ = (kt0_) + 2 * j < nkt ? (kt0_) + 2 * j : nkt - 1; \
                const bf16* kp_ = KI + (size_t)krow(b, 16 * kt_ + fr) * 64 + 8 * fq; pa0[j] = *(const bf16x8*)kp_; pa1[j] = *(const bf16x8*)(kp_ + 32); } } while (0)
            DSA_KLOAD(kh);
            for (int kt0 = kh; kt0 < nkt; kt0 += 8) {
                bf16x8 a0[4], a1[4];
#pragma unroll
                for (int j = 0; j < 4; ++j) { a0[j] = pa0[j]; a1[j] = pa1[j]; }
                if (kt0 + 8 < nkt) DSA_KLOAD(kt0 + 8);
#pragma unroll
                for (int j = 0; j < 4; ++j) {
                    const int kt = kt0 + 2 * j;
                    float s0 = 0.f, s1 = 0.f, s2 = 0.f, s3 = 0.f;
#pragma unroll
                    for (int h = 0; h < 8; ++h) {
                        f32x4 acc = {0.f, 0.f, 0.f, 0.f};
                        acc = __builtin_amdgcn_mfma_f32_16x16x32_bf16(a0[j], qf[h][0], acc, 0, 0, 0);
                        acc = __builtin_amdgcn_mfma_f32_16x16x32_bf16(a1[j], qf[h][1], acc, 0, 0, 0);
                        s0 += wi[h] * fmaxf(acc.x, 0.f); s1 += wi[h] * fmaxf(acc.y, 0.f); s2 += wi[h] * fmaxf(acc.z, 0.f); s3 += wi[h] * fmaxf(acc.w, 0.f);
                    }
                    const int kb = 16 * kt + 4 * fq;
                    u32x4 o;
                    { const unsigned bits = __builtin_bit_cast(unsigned, s0); o.x = (kb + 0) <= pq ? (bits ^ ((bits >> 31) ? 0xffffffffu : 0x80000000u)) : 0u; }
                    { const unsigned bits = __builtin_bit_cast(unsigned, s1); o.y = (kb + 1) <= pq ? (bits ^ ((bits >> 31) ? 0xffffffffu : 0x80000000u)) : 0u; }
                    { const unsigned bits = __builtin_bit_cast(unsigned, s2); o.z = (kb + 2) <= pq ? (bits ^ ((bits >> 31) ? 0xffffffffu : 0x80000000u)) : 0u; }
                    { const unsigned bits = __builtin_bit_cast(unsigned, s3); o.w = (kb + 3) <= pq ? (bits ^ ((bits >> 31) ? 0xffffffffu : 0x80000000u)) : 0u; }
                    if (kt < nkt) *(u32x4*)(scq + 16 * kt) = o;
                }
            }
#undef DSA_KLOAD
        }
        VM_WAIT();
        __syncthreads();
        DSTAMP(24);
    }
    LAS unsigned char* wl = lds + wave * DW2_STRIDE;
    LAS unsigned char* tile = wl + DW2_TILE;
    LAS unsigned short* selL = (LAS unsigned short*)(wl + DW2_SEL);
    LAS unsigned short* bkL = (LAS unsigned short*)(wl + DW2_BK);
    const LAS float* t5L = (const LAS float*)(lds + DSA2_T5);
    const LAS unsigned short* bkT = (const LAS unsigned short*)(lds + DSA2_BT);
    const int nqw = DENSE_ONLY ? 2 : 8;
    unsigned u[33];
#define DSA_ULOAD(iq_) do { const int nk_ = p0 + (iq_) + 1; const unsigned* scr_ = SC + (size_t)(iq_) * SC_PITCH; \
        _Pragma("unroll") for (int i = 0; i < 33; ++i) { const int s = lane + 64 * i; u[i] = s < nk_ ? __hip_atomic_load(scr_ + s, __ATOMIC_RELAXED, __HIP_MEMORY_SCOPE_AGENT) : 0u; } } while (0)
    if (!DENSE_ONLY && p0 + wave * nqw + 1 > 256) DSA_ULOAD(wave * nqw);
    for (int qi_ = 0; qi_ < nqw; ++qi_) {
        asm volatile("" : "+v"(lane));
        const int iq = wave * nqw + qi_;
        if (iq >= nq) break;
        const int p = p0 + iq, nk = p + 1, qrow = r0 + iq;
        int nsel;
        if (!DENSE_ONLY && nk > 256) {
            unsigned tau = 0u;
            for (int bit = 31; bit >= 16; --bit) {
                const unsigned cand = tau | (1u << bit);
                int cnt = 0;
#pragma unroll
                for (int i = 0; i < 33; ++i) cnt += (u[i] >= cand) ? 1 : 0;
                if (wave_sum_dpp(cnt) >= 256) tau = cand;
            }
            DSTAMP(16);
            {
                const unsigned hi = tau >> 16;
                int cab = 0, cc = 0;
#pragma unroll
                for (int i = 0; i < 33; ++i) { const unsigned uh = u[i] >> 16; cab += (uh > hi) ? 1 : 0; cc += (uh == hi) ? 1 : 0; }
                cab = wave_sum_dpp(cab);
                const int cin = wave_scan_dpp(cc);
                const int ncand = __builtin_amdgcn_readlane(cin, 63);
                LAS unsigned short* candL = (LAS unsigned short*)tile;
                int off = cin - cc;
#pragma unroll
                for (int i = 0; i < 33; ++i) { const bool is = (u[i] >> 16) == hi; candL[is ? off : 3072 + lane] = (unsigned short)(u[i] & 0xffffu); off += is ? 1 : 0; }
                LDS_WAIT();
                const int need = 256 - cab;
                unsigned lo = 0u;
                if (ncand <= 64) {
                    const unsigned v = lane < ncand ? (unsigned)candL[lane] + 1u : 0u;
                    for (int bit = 15; bit >= 0; --bit) { const unsigned cand = lo | (1u << bit); if (__popcll(__ballot(v >= cand + 1u)) >= need) lo = cand; }
                } else {
                    for (int bit = 15; bit >= 0; --bit) {
                        const unsigned cand = lo | (1u << bit); int cnt = 0;
                        for (int j = lane; j < ((ncand + 63) & ~63); j += 64) { const unsigned v = j < ncand ? (unsigned)candL[j] + 1u : 0u; cnt += __popcll(__ballot(v >= cand + 1u)); }
                        if (cnt >= need) lo = cand;
                    }
                }
                tau |= lo;
                LDS_WAIT();
            }
            DSTAMP(17);
            unsigned short bkv[33];
#pragma unroll
            for (int i = 0; i < 33; ++i) { const int d = p - (lane + 64 * i); bkv[i] = bkT[d > 0 ? d : 0]; }
            int cge = 0, ceq = 0;
#pragma unroll
            for (int i = 0; i < 33; ++i) { cge += (u[i] >= tau) ? 1 : 0; ceq += (u[i] == tau) ? 1 : 0; }
            const int tge = wave_sum_dpp(cge);
            if (tge == 256) {
                const int cin = wave_scan_dpp(cge);
                int off = cin - cge;
#pragma unroll
                for (int i = 0; i < 33; ++i) { const bool take = u[i] >= tau; const int pos = take ? off : 256 + lane;
                    selL[pos] = (unsigned short)(lane + 64 * i); bkL[pos] = bkv[i]; off += take ? 1 : 0; }
            } else {
                const int rem = 256 - (tge - wave_sum_dpp(ceq));
                const unsigned long long lt = (1ull << lane) - 1ull;
                int base = 0, eqseen = 0;
#pragma unroll
                for (int i = 0; i < 33; ++i) {
                    const bool gt = u[i] > tau, eq = u[i] == tau;
                    const unsigned long long meq = __ballot(eq);
                    const bool take = gt || (eq && (eqseen + __popcll(meq & lt)) < rem);
                    const unsigned long long mt = __ballot(take);
                    const int pos = take ? base + __popcll(mt & lt) : 256 + lane;
                    selL[pos] = (unsigned short)(lane + 64 * i); bkL[pos] = bkv[i];
                    base += __popcll(mt); eqseen += __popcll(meq);
                }
            }
            nsel = 256;
        } else {
#pragma unroll
            for (int m = 0; m < 4; ++m) { const int s = lane + 64 * m; selL[s] = (unsigned short)(s < nk ? s : 0); bkL[s] = bkT[s < nk ? p - s : 0]; }
            nsel = nk;
        }
        DSTAMP(25);
        if (!DENSE_ONLY && qi_ + 1 < nqw && nk + 1 > 256) DSA_ULOAD(iq + 1);
        asm volatile("" : "+v"(lane));
        bf16x8 qB[4];
#pragma unroll
        for (int ks = 0; ks < 4; ++ks) qB[ks] = *(const bf16x8*)(QQ + (size_t)qrow * NQQ + fr * 128 + ks * 32 + 8 * fq);
        LDS_WAIT();
        f32x4 O[8];
#pragma unroll
        for (int nt = 0; nt < 8; ++nt) O[nt] = (f32x4){0.f, 0.f, 0.f, 0.f};
        float qss = 0.f;
#pragma unroll
        for (int ks = 0; ks < 4; ++ks) { const u32x4 w = __builtin_bit_cast(u32x4, qB[ks]);
            qss += (bflo(w.x) * bflo(w.x) + bfhi(w.x) * bfhi(w.x)) + (bflo(w.y) * bflo(w.y) + bfhi(w.y) * bfhi(w.y)) + (bflo(w.z) * bflo(w.z) + bfhi(w.z) * bfhi(w.z)) + (bflo(w.w) * bflo(w.w) + bfhi(w.w) * bfhi(w.w)); }
        qss += __shfl_xor(qss, 16); qss += __shfl_xor(qss, 32);
        const float mb = sqrtf(qss) * t5L[512] + t5L[513];
        float lrun = 0.f;
        const int nblk = (nsel + 31) >> 5;
#define DSA_GATHER(GV, blk_) do { _Pragma("unroll") for (int e = 0; e < 8; ++e) { const int pid = lane + 64 * e, ri = pid >> 4, ch = pid & 15, j = 32 * (blk_) + ri; \
            const int key = (int)selL[j]; GV[e] = *(const u32x4*)(KV + (size_t)krow(b, key) * 128 + ch * 8); } } while (0)
#define DSA_PUT(GV) do { _Pragma("unroll") for (int e = 0; e < 8; ++e) { const int pid = lane + 64 * e, ri = pid >> 4, ch = pid & 15; *(LAS u32x4*)(tile + off_b(ri, ch)) = GV[e]; } } while (0)
        u32x4 gvA[8], gvB[8];
        DSA_GATHER(gvA, 0);
        if (nblk > 1) DSA_GATHER(gvB, 1);
        for (int blk0 = 0; blk0 < nblk; blk0 += 2) {
#pragma unroll
            for (int half = 0; half < 2; ++half) {
                const int blk = blk0 + half;
                if (blk < nblk) {
                    if (half == 0) { DSA_PUT(gvA); if (blk + 2 < nblk) DSA_GATHER(gvA, blk + 2); }
                    else { DSA_PUT(gvB); if (blk + 2 < nblk) DSA_GATHER(gvB, blk + 2); }
                    LDS_WAIT();
                    f32x4 s0 = {0.f, 0.f, 0.f, 0.f}, s1 = {0.f, 0.f, 0.f, 0.f};
        #pragma unroll
                    for (int ks = 0; ks < 4; ++ks) {
                        const bf16x8 k0 = *(const LAS bf16x8*)(tile + off_b(fr, 4 * ks + fq)), k1 = *(const LAS bf16x8*)(tile + off_b(16 + fr, 4 * ks + fq));
                        s0 = __builtin_amdgcn_mfma_f32_16x16x32_bf16(k0, qB[ks], s0, 0, 0, 0);
                        s1 = __builtin_amdgcn_mfma_f32_16x16x32_bf16(k1, qB[ks], s1, 0, 0, 0);
                    }
                    const int j0 = 32 * blk + 4 * fq;
                    const u32x2 b0 = *(const LAS u32x2*)(bkL + j0), b1 = *(const LAS u32x2*)(bkL + j0 + 16);
                    const float t00 = t5L[(b0.x & 0xffffu) + fr], t01 = t5L[(b0.x >> 16) + fr], t02 = t5L[(b0.y & 0xffffu) + fr], t03 = t5L[(b0.y >> 16) + fr];
                    const float t10 = t5L[(b1.x & 0xffffu) + fr], t11 = t5L[(b1.x >> 16) + fr], t12 = t5L[(b1.y & 0xffffu) + fr], t13 = t5L[(b1.y >> 16) + fr];
                    const float e00 = __expf(s0.x + t00 - mb), e01 = __expf(s0.y + t01 - mb), e02 = __expf(s0.z + t02 - mb), e03 = __expf(s0.w + t03 - mb);
                    const float e10 = __expf(s1.x + t10 - mb), e11 = __expf(s1.y + t11 - mb), e12 = __expf(s1.z + t12 - mb), e13 = __expf(s1.w + t13 - mb);
                    const float p00 = (j0 + 0) < nsel ? e00 : 0.f, p01 = (j0 + 1) < nsel ? e01 : 0.f, p02 = (j0 + 2) < nsel ? e02 : 0.f, p03 = (j0 + 3) < nsel ? e03 : 0.f;
                    const float p10 = (j0 + 16) < nsel ? e10 : 0.f, p11 = (j0 + 17) < nsel ? e11 : 0.f, p12 = (j0 + 18) < nsel ? e12 : 0.f, p13 = (j0 + 19) < nsel ? e13 : 0.f;
                    lrun += ((p00 + p01) + (p02 + p03)) + ((p10 + p11) + (p12 + p13));
                    u32x4 pw; pw.x = pk2(p00, p01); pw.y = pk2(p02, p03); pw.z = pk2(p10, p11); pw.w = pk2(p12, p13);
                    const bf16x8 pa = __builtin_bit_cast(bf16x8, pw);
                    const unsigned q4 = (unsigned)(fr >> 2), p4 = (unsigned)(lane & 3);
        #pragma unroll
                    for (int nt = 0; nt < 8; ++nt) {
                        const s16x4 vlo = tr_rd(tile + off_b(4 * fq + q4, 2 * nt + (p4 >> 1)) + 8 * (p4 & 1));
                        const s16x4 vhi = tr_rd(tile + off_b(16 + 4 * fq + q4, 2 * nt + (p4 >> 1)) + 8 * (p4 & 1));
                        const bf16x8 vb = __builtin_shufflevector(vlo, vhi, 0, 1, 2, 3, 4, 5, 6, 7);
                        O[nt] = __builtin_amdgcn_mfma_f32_16x16x32_bf16(pa, vb, O[nt], 0, 0, 0);
                    }

                }
            }
        }
#undef DSA_GATHER
#undef DSA_PUT
        float lt2 = lrun + __shfl_xor(lrun, 16); lt2 += __shfl_xor(lt2, 32);
        const float inv = 1.f / lt2;
        float ir[4];
#pragma unroll
        for (int r = 0; r < 4; ++r) ir[r] = __shfl(inv, 4 * fq + r);
        bf16* od = (bf16*)(ws + WS_OD) + (size_t)qrow * 1024 + fr;
#pragma unroll
        for (int nt = 0; nt < 8; ++nt)
#pragma unroll
            for (int r = 0; r < 4; ++r) { const int hd = 4 * fq + r; od[(size_t)(hd >> 3) * MT * 1024 + (hd & 7) * 128 + 16 * nt] = (bf16)f2bf(O[nt][r] * ir[r]); }
        LDS_WAIT();
        DSTAMP(26);
    }
}
__device__ __forceinline__ void p5_dsa(ArgsP a, LAS unsigned char* lds, int l, int tid, int wave, int lane) {
    LAS float* t5L = (LAS float*)(lds + DSA2_T5);
    __syncthreads();
    t5L[tid] = a->in[I_T5][tid];
    for (int n = tid; n < TT; n += 512) ((LAS unsigned short*)(lds + DSA2_BT))[n] = (unsigned short)(t5_bucket(n) * 16);
    if (tid < 64) {
        const float g0 = fabsf(a->in[I_GDKV][l * 128 + tid]), g1 = fabsf(a->in[I_GDKV][l * 128 + 64 + tid]);
        const float gm = wave_max(fmaxf(g0, g1));
        float tm = 0.f;
#pragma unroll
        for (int i = 0; i < 8; ++i) tm = fmaxf(tm, fabsf(a->in[I_T5][tid + 64 * i]));
        tm = wave_max(tm);
        if (tid == 0) { t5L[512] = 11.313708498984761f * gm; t5L[513] = tm; }
    }
    __syncthreads();
    for (int u = blockIdx.x; u < 256; u += gridDim.x) {
        dsa_unit<false>(a, lds, u >> 5, u & 31, 64, wave, lane);
        __syncthreads();
    }
    if (blockIdx.x == 0) dsa_unit<true>(a, lds, 0, 0, 16, wave, lane);
}

__global__ void __launch_bounds__(NWAVES * 64, 2) fwd(Args a_) {
    extern __shared__ __attribute__((aligned(16))) unsigned char lds_raw[];
    LAS unsigned char* lds = (LAS unsigned char*)lds_raw;
    volatile LAS unsigned* MISC = (volatile LAS unsigned*)(lds + MISC_OFF);
    if (threadIdx.x < 32) MISC[threadIdx.x] = 0u;
    __syncthreads();
    const int g_lo = a_.g_lo, g_hi = a_.g_hi, l_lo = a_.l_lo, l_hi = a_.l_hi, ph_lo = a_.ph_lo, ph_hi = a_.ph_hi, use_bar = a_.use_bar;
    XcdBarrier bar; bar.bar = (unsigned*)(a_.ws + WS_CTL) + CW_BAR; bar.x = 0; bar.st = nullptr;
    if (use_bar) bar = xcd_barrier_post((unsigned*)(a_.ws + WS_CTL) + CW_BAR, MISC + 8);
#if defined(DIAG_SEL)
#ifndef DIAG_BLK
#define DIAG_BLK 31
#endif
    int diag_site = 0; if (threadIdx.x == 0) MISC[15] = (unsigned)__builtin_amdgcn_s_memrealtime();
#define DIAG_STAMP(site) do { if (blockIdx.x == 0 && threadIdx.x == 0) { const unsigned now_ = (unsigned)__builtin_amdgcn_s_memrealtime(); MISC[16 + (site)] += now_ - MISC[15]; MISC[15] = now_; } } while (0)
#define GRID_BAR() do { if (use_bar) xcd_barrier(bar); DIAG_STAMP(diag_site); ++diag_site; } while (0)
#else
#define GRID_BAR() do { if (use_bar) xcd_barrier(bar); } while (0)
#endif
#ifndef PHMASK
#define PHMASK 0xFFFF
#endif
#ifndef PROBE_PH
#define PROBE_PH -1
#endif
#ifndef PROBE_MASK
#define PROBE_MASK 0
#endif
#define PROBED(k) ((PROBE_MASK >> (k)) & 1)
#ifndef P1_ALIGN
#define P1_ALIGN true
#endif
#define PH(k) (((PHMASK >> (k)) & 1) && ph_lo <= (k) && (k) < ph_hi)
#define PBEGIN ArgsP a = (ArgsP)__builtin_amdgcn_kernarg_segment_ptr(); asm volatile("" : "+s"(a)); unsigned char* ws = a->ws; \
    int tid_ = threadIdx.x; asm volatile("" : "+v"(tid_)); const int tid = tid_, lane = tid & 63, wave = __builtin_amdgcn_readfirstlane(tid >> 6); const int gw = blockIdx.x * NWAVES + wave, ngw = gridDim.x * NWAVES; (void)ws; (void)gw; (void)ngw; (void)lane;

#if defined(DIAG_SEL)
    diag_site = 15;
#endif
    if (((PHMASK >> 13) & 1) && a_.prep) { PBEGIN prep_weights(a, lds, gw, ngw, wave, lane); GRID_BAR(); }

    for (int g = g_lo; g < g_hi; ++g) {
        for (int l = l_lo; l < l_hi; ++l) {
#if defined(DIAG_SEL)
            diag_site = (l == 0) ? 0 : 1;
#endif
            if (PH(0) && l == 0) { PBEGIN p0_init(a, g, gw, ngw, lane); GRID_BAR(); }
            if (PH(1)) { PBEGIN
                FIn f{(bf16*)(ws + WS_Z), (float*)(ws + WS_ZF), (const float*)(ws + WS_BIN) + l * NZ};
                run_gemm<FIn, P1_ALIGN>(lds, (const bf16*)(ws + WS_XN), (const bf16*)(ws + WS_WIN) + (size_t)l * NZ * D, NZ, D, f, gw, ngw, lane);
                if (PROBED(1)) { run_gemm(lds, (const bf16*)(ws + WS_XN), (const bf16*)(ws + WS_WIN) + (size_t)l * NZ * D, NZ, D, f, gw, ngw, lane); }
                GRID_BAR();
            }
            if (PH(2)) { PBEGIN p2_prep(a, l, gw, ngw, lane); if (PROBED(2)) { p2_prep(a, l, gw, ngw, lane); } GRID_BAR(); }
            if (PH(3)) { PBEGIN
                FQQ f{(bf16*)(ws + WS_QQ)};
                run_gemm(lds, (const bf16*)(ws + WS_CQN), (const bf16*)(ws + WS_WQQ) + (size_t)l * NQQ * 256, NQQ, 256, f, gw, ngw, lane);
                if (PROBED(3)) { run_gemm(lds, (const bf16*)(ws + WS_CQN), (const bf16*)(ws + WS_WQQ) + (size_t)l * NQQ * 256, NQQ, 256, f, gw, ngw, lane); }
            }
            if (PH(4)) { PBEGIN
                for (int u = blockIdx.x; u < 256; u += gridDim.x) {
                    const int b = (u >> 4) & 7, h = (u >> 2) & 3, vs = u & 3;
                    if (u >> 7) scan_unit<true>(a, lds, b, h, vs, tid); else scan_unit<false>(a, lds, b, h, vs, tid);
                }
#if PROBE_PH == 4
                for (int u = blockIdx.x; u < 256; u += gridDim.x) {
                    const int b = (u >> 4) & 7, h = (u >> 2) & 3, vs = u & 3;
                    if (u >> 7) scan_unit<true>(a, lds, b, h, vs, tid); else scan_unit<false>(a, lds, b, h, vs, tid);
                }
#endif
                GRID_BAR();
            }
#if defined(DIAG_SEL)
            if (blockIdx.x == DIAG_BLK && threadIdx.x == 0) MISC[14] = (unsigned)__builtin_amdgcn_s_memrealtime();
#endif
            if (PH(5)) { PBEGIN p5_dsa(a, lds, l, tid, wave, lane); }
#if defined(DIAG_SEL)
            __syncthreads(); DSTAMP(27);
#endif
#if PROBE_PH == 5
            if (PH(5)) { PBEGIN p5_dsa(a, lds, l, tid, wave, lane); }
#endif
            if (PH(6)) { PBEGIN p6_headnorm(a, l, gw, ngw, lane); if (PROBED(6)) p6_headnorm<true>(a, l, gw, ngw, lane);
#if defined(DIAG_SEL)
                DSTAMP(28);
#endif
                GRID_BAR();
#if defined(DIAG_SEL)
                DSTAMP(29);
#endif
            }
            if (PH(7)) {
                __syncthreads();
                { PBEGIN
                  const bf16* OD0 = (const bf16*)(ws + WS_OD); const bf16* OD1 = OD0 + (size_t)MT * 1024;
                  const bf16* WB0 = (const bf16*)(ws + WS_WBD) + (size_t)l * D * 2048; const bf16* WB1 = WB0 + (size_t)D * D;
                  int Kc = D, Nc = D; asm volatile("" : "+s"(Kc)); asm volatile("" : "+s"(Nc));
                  pg8::Gemm g{(const bf16*)(ws + WS_OG), (const bf16*)(ws + WS_WBG) + (size_t)l * D * D, MR, Nc, Kc, OD0, OD1, (const bf16*)(ws + WS_OM), WB0, WB1, (const bf16*)(ws + WS_WBM) + (size_t)l * D * D};
                  ChainOrder S; S.S.init(MR, Nc, (int)gridDim.x, (int)blockIdx.x);
                  EpiMix E{(const bf16*)(ws + WS_Z), (bf16*)(ws + WS_MIX)};
                  pg8::gemm_phase<EpiMix, ChainOrder, true, true, true>((PG8_LAS unsigned char*)lds, g, S, E);
                  FBr<0> f0{(const bf16*)(ws + WS_Z), (float*)(ws + WS_Y), (bf16*)(ws + WS_MIX)};
                  mini_gemm(lds, (const bf16*)(ws + WS_OG), (const bf16*)(ws + WS_WBG) + (size_t)l * D * D, Nc, Kc, f0, (int)threadIdx.x);
                  FBr<1> f1{(const bf16*)(ws + WS_Z), (float*)(ws + WS_Y), (bf16*)(ws + WS_MIX)};
                  mini_gemm(lds, OD0, WB0, Nc, Kc, f1, (int)threadIdx.x);
                  mini_gemm(lds, OD1, WB1, Nc, Kc, f1, (int)threadIdx.x);
                  FBr<2> f2{(const bf16*)(ws + WS_Z), (float*)(ws + WS_Y), (bf16*)(ws + WS_MIX)};
                  mini_gemm(lds, (const bf16*)(ws + WS_OM), (const bf16*)(ws + WS_WBM) + (size_t)l * D * D, Nc, Kc, f2, (int)threadIdx.x);
                }
#if PROBED(7)
                { PBEGIN
                  const bf16* OD0 = (const bf16*)(ws + WS_OD); const bf16* OD1 = OD0 + (size_t)MT * 1024;
                  const bf16* WB0 = (const bf16*)(ws + WS_WBD) + (size_t)l * D * 2048; const bf16* WB1 = WB0 + (size_t)D * D;
                  int Kc = D, Nc = D; asm volatile("" : "+s"(Kc)); asm volatile("" : "+s"(Nc));
                  pg8::Gemm g{(const bf16*)(ws + WS_OG), (const bf16*)(ws + WS_WBG) + (size_t)l * D * D, MR, Nc, Kc, OD0, OD1, (const bf16*)(ws + WS_OM), WB0, WB1, (const bf16*)(ws + WS_WBM) + (size_t)l * D * D};
                  ChainOrder S; S.S.init(MR, Nc, (int)gridDim.x, (int)blockIdx.x);
                  EpiMix E{(const bf16*)(ws + WS_Z), (bf16*)(ws + WS_MIX)};
                  pg8::gemm_phase<EpiMix, ChainOrder, true, true, true>((PG8_LAS unsigned char*)lds, g, S, E);
                  FBr<0> f0{(const bf16*)(ws + WS_Z), (float*)(ws + WS_Y), (bf16*)(ws + WS_MIX)};
                  mini_gemm(lds, (const bf16*)(ws + WS_OG), (const bf16*)(ws + WS_WBG) + (size_t)l * D * D, Nc, Kc, f0, (int)threadIdx.x);
                  FBr<1> f1{(const bf16*)(ws + WS_Z), (float*)(ws + WS_Y), (bf16*)(ws + WS_MIX)};
                  mini_gemm(lds, OD0, WB0, Nc, Kc, f1, (int)threadIdx.x);
                  mini_gemm(lds, OD1, WB1, Nc, Kc, f1, (int)threadIdx.x);
                  FBr<2> f2{(const bf16*)(ws + WS_Z), (float*)(ws + WS_Y), (bf16*)(ws + WS_MIX)};
                  mini_gemm(lds, (const bf16*)(ws + WS_OM), (const bf16*)(ws + WS_WBM) + (size_t)l * D * D, Nc, Kc, f2, (int)threadIdx.x);
                }
#endif
                GRID_BAR();
            }
            if (PH(8)) { PBEGIN
                FY f{(bf16*)(ws + WS_Y)};
                run_gemm(lds, (const bf16*)(ws + WS_MIX), (const bf16*)(ws + WS_WOUT) + (size_t)l * D * D, D, D, f, gw, ngw, lane);
                if (PROBED(8)) { run_gemm(lds, (const bf16*)(ws + WS_MIX), (const bf16*)(ws + WS_WOUT) + (size_t)l * D * D, D, D, f, gw, ngw, lane); }
                GRID_BAR();
            }
            if (PH(9)) { PBEGIN if (PROBED(9)) p_norm_res<true>(a, g, a->in[I_GPOSTMIX] + l * D, a->in[I_GPREMLP] + l * D, gw, ngw, lane); p_norm_res(a, g, a->in[I_GPOSTMIX] + l * D, a->in[I_GPREMLP] + l * D, gw, ngw, lane); GRID_BAR(); }
            if (PH(10)) { PBEGIN
                FUp f{(bf16*)(ws + WS_Z)};
                run_gemm(lds, (const bf16*)(ws + WS_XN), (const bf16*)(ws + WS_WUP) + (size_t)l * DFF * D, DFF, D, f, gw, ngw, lane);
                if (PROBED(10)) { run_gemm(lds, (const bf16*)(ws + WS_XN), (const bf16*)(ws + WS_WUP) + (size_t)l * DFF * D, DFF, D, f, gw, ngw, lane); }
                GRID_BAR();
            }
            if (PH(11)) { PBEGIN
                FY f{(bf16*)(ws + WS_Y)};
                run_gemm(lds, (const bf16*)(ws + WS_Z), (const bf16*)(ws + WS_WDN) + (size_t)l * D * DFF, D, DFF, f, gw, ngw, lane);
                if (PROBED(11)) { run_gemm(lds, (const bf16*)(ws + WS_Z), (const bf16*)(ws + WS_WDN) + (size_t)l * D * DFF, D, DFF, f, gw, ngw, lane); }
                GRID_BAR();
            }
            if (PH(12)) { PBEGIN if (PROBED(12)) p_norm_res<true>(a, g, a->in[I_GPOSTMLP] + l * D, l + 1 < NL ? a->in[I_GPREMIX] + (l + 1) * D : nullptr, gw, ngw, lane); p_norm_res(a, g, a->in[I_GPOSTMLP] + l * D, l + 1 < NL ? a->in[I_GPREMIX] + (l + 1) * D : nullptr, gw, ngw, lane); GRID_BAR(); }
        }
    }
#if defined(DIAG_SEL)
    if ((DIAG_SEL >= 24 || DIAG_SEL == 16 || DIAG_SEL == 17) && blockIdx.x == DIAG_BLK && threadIdx.x == 0) { unsigned tot = 0; for (int i = 24; i < 30; ++i) tot += MISC[i]; tot += MISC[16] + MISC[17];
        a_.out[12345] = 100.f + 900.f * (float)MISC[DIAG_SEL] / (float)tot; }
    if (DIAG_SEL < 24 && DIAG_SEL != 16 && DIAG_SEL != 17 && blockIdx.x == 0 && threadIdx.x == 0) { unsigned tot = 0; for (int i = 0; i < 16; ++i) tot += MISC[16 + i];
        a_.out[12345] = DIAG_SEL == 99 ? 100.f + (float)tot * 0.0001f : 100.f + 900.f * (float)MISC[16 + DIAG_SEL] / (float)tot; }
#endif
#undef PH
#undef GRID_BAR
#undef PBEGIN
}

#ifndef MK_ONE_LAUNCH
#define MK_ONE_LAUNCH 1
#endif
extern "C" void kernel_launch(void* const* d_in, const int* in_sizes, int n_in, void* d_out, int out_size, void* d_ws, size_t ws_size, hipStream_t stream) {
    static int grid = 0;
    if (grid == 0) {
        if (n_in != 28 || out_size != NB * SEQ * D || ws_size < WS_END) { fprintf(stderr, "kernel_launch: unexpected shapes (n_in %d out %d ws %zu need %zu)\n", n_in, out_size, ws_size, (size_t)WS_END); grid = -1; return; }
        int dev = 0, cus = 0, per_cu = 0;
        if (hipGetDevice(&dev) != hipSuccess || hipDeviceGetAttribute(&cus, hipDeviceAttributeMultiprocessorCount, dev) != hipSuccess) { grid = -1; return; }
        if (hipFuncSetAttribute((const void*)fwd, hipFuncAttributeMaxDynamicSharedMemorySize, LDS_BYTES) != hipSuccess) { fprintf(stderr, "kernel_launch: hipFuncSetAttribute failed\n"); grid = -1; return; }
        if (hipOccupancyMaxActiveBlocksPerMultiprocessor(&per_cu, (const void*)fwd, NWAVES * 64, LDS_BYTES) != hipSuccess || per_cu < 1) { fprintf(stderr, "kernel_launch: occupancy query says %d\n", per_cu); }
        (void)hipGetLastError();
        grid = cus;
    }
    if (grid < 0) return;
    (void)hipMemsetAsync((char*)d_ws + WS_CTL, 0, CTL_ZERO_BYTES, stream);
    Args a{};
    for (int i = 0; i < 28; ++i) a.in[i] = (const float*)d_in[i];
    a.out = (float*)d_out; a.ws = (unsigned char*)d_ws;
#if MK_ONE_LAUNCH
    a.g_lo = 0; a.g_hi = NG; a.l_lo = 0; a.l_hi = NL; a.ph_lo = 0; a.ph_hi = 13; a.prep = 1; a.use_bar = 1;
    hipLaunchKernelGGL(fwd, dim3(grid), dim3(NWAVES * 64), LDS_BYTES, stream, a);
#else
    a.use_bar = 0;
    a.prep = 1; a.g_lo = 0; a.g_hi = 0; a.l_lo = 0; a.l_hi = 0; a.ph_lo = 0; a.ph_hi = 0;
    hipLaunchKernelGGL(fwd, dim3(grid), dim3(NWAVES * 64), LDS_BYTES, stream, a);
    a.prep = 0;
    static const int cuts[] = {0, 1, 2, 3, 5, 7, 8, 9, 10, 11, 12, 13};
    for (int g = 0; g < NG; ++g) for (int l = 0; l < NL; ++l) for (int c = 0; c < 11; ++c) {
        if (c == 0 && l != 0) continue;
        a.g_lo = g; a.g_hi = g + 1; a.l_lo = l; a.l_hi = l + 1; a.ph_lo = cuts[c]; a.ph_hi = cuts[c + 1];
        hipLaunchKernelGGL(fwd, dim3(grid), dim3(NWAVES * 64), LDS_BYTES, stream, a);
    }
#endif
    const hipError_t le = hipPeekAtLastError();
    if (le != hipSuccess) fprintf(stderr, "kernel_launch: launch failed: %s\n", hipGetErrorName(le));
}
```

```cpp
#include <hip/hip_runtime.h>
#include <cstdio>
#include <cstdint>
namespace pg8 {
#define PG8_LAS __attribute__((address_space(3)))
typedef unsigned short bf16_t;
typedef short bf16x8 __attribute__((ext_vector_type(8)));
typedef float f32x4 __attribute__((ext_vector_type(4)));
typedef unsigned u32x4 __attribute__((ext_vector_type(4)));
constexpr int BM = 256, BK = 64, HALF = 128, HTB = HALF * BK * 2  , STAGE_BYTES = 8 * HTB, NXCD = 8, WGM = 8;

__host__ __device__ __forceinline__ int lds_byte(int r, int c) { const int st = (r >> 4) * 2 + (c >> 5), rr = r & 15, cc = c & 31, ob = rr * 64 + cc * 2; return st * 1024 + (ob ^ (((ob >> 9) & 1) << 5)); }
__host__ __device__ __forceinline__ void stage_rc(int b, int& R, int& C) { const int st = b / 1024, sb = b % 1024, swz = sb ^ (((sb >> 9) & 1) << 5); R = (st >> 1) * 16 + swz / 64; C = (st & 1) * 32 + (swz % 64) / 2; }
__host__ __device__ __forceinline__ int perm32(int rho) { const int n = rho >> 4, i = rho & 15; return 8 * (i >> 2) + 4 * n + (i & 3); }

struct Unit { int pm, pn, sub; };
struct Gemm { const bf16_t* A; const bf16_t* Bt; int M, N, K; const bf16_t *A1, *A2, *A3, *B1, *B2, *B3; };

struct StaticOrder {
    int nM, nN, nwg, G, c;
    __host__ __device__ void init(int M, int N, int G_, int c_) { nM = M / BM; nN = N / BM; nwg = nM * nN; G = G_; c = c_; }
    __host__ __device__ bool next(int i, Unit& u) const {
        const long L = (long)i * G + c; if (L >= nwg) return false;
        int wgid = (int)L; { const int q = nwg / NXCD, r = nwg % NXCD, xcd = wgid % NXCD, off = wgid / NXCD; wgid = (xcd < r ? xcd * (q + 1) : r * (q + 1) + (xcd - r) * q) + off; }
        const int nig = WGM * nN, gid = wgid / nig, fm = gid * WGM, gsz = (nM - fm) < WGM ? (nM - fm) : WGM;
        u.pm = fm + ((wgid % nig) % gsz); u.pn = (wgid % nig) / gsz; u.sub = 0; return true;
    }
    __device__ __forceinline__ void a_ready(const Unit&) const {}
    __device__ __forceinline__ void done(const Unit&) const {}
};

__device__ __forceinline__ unsigned cvt_pk_bf16(float lo, float hi) { unsigned r; asm volatile("v_cvt_pk_bf16_f32 %0, %1, %2" : "=v"(r) : "v"(lo), "v"(hi)); return r; }
template <class Epi, class Sched, bool ALIGN_EPI = false, bool SP2 = false, bool CHAIN = false>
__device__ __forceinline__ void gemm_phase(PG8_LAS unsigned char* lds, const Gemm g, const Sched& S, const Epi& E) {
    int tid_ = threadIdx.x; asm volatile("" : "+v"(tid_));
    const int tid = tid_, wid = __builtin_amdgcn_readfirstlane(tid >> 6), lane = tid & 63, wr = wid >> 2, wc = wid & 3, fr = lane & 15, fq = lane >> 4;
    const int K = g.K, nt = K / BK;
    unsigned voffA[2], voffB[2];
#pragma unroll
    for (int i = 0; i < 2; ++i) { int R, C; stage_rc(tid * 16 + i * 8192, R, C); const int Rb = Epi::PERM ? ((R & ~31) + perm32(R & 31)) : R;
        voffA[i] = (unsigned)(R * K + C) * 2u; voffB[i] = (unsigned)(Rb * K + C) * 2u; }
    const size_t kstep = (size_t)(BK * 2);
    const size_t hstep = (size_t)HALF * K * 2;
    const size_t tstep = 2 * hstep;
    const unsigned ldsw = (unsigned)wid * 1024u;
    const int aoff = lds_byte(wr * 64 + fr, fq * 8), boff = lds_byte(wc * 32 + fr, fq * 8);
#define PG8_SA(b, h) (((b) * 2 + (h)) * HTB)
#define PG8_SB(b, h) ((4 + (b) * 2 + (h)) * HTB)
#define PG8_STAGE(bufoff, gbase, voff) do { _Pragma("unroll") for (int _i = 0; _i < 2; ++_i) \
        __builtin_amdgcn_global_load_lds((const unsigned*)((const char*)(gbase) + (voff)[_i]), (PG8_LAS unsigned*)(lds + (bufoff) + ldsw + _i * 8192), 16, 0, 0); } while (0)
#define PG8_LDA(dst, b, h) do { _Pragma("unroll") for (int m = 0; m < 4; ++m) _Pragma("unroll") for (int k = 0; k < 2; ++k) dst[m][k] = *(const PG8_LAS bf16x8*)(lds + PG8_SA(b, h) + aoff + m * 2048 + k * 1024); } while (0)
#define PG8_LDB(dst, b, h) do { _Pragma("unroll") for (int n = 0; n < 2; ++n) _Pragma("unroll") for (int k = 0; k < 2; ++k) dst[n][k] = *(const PG8_LAS bf16x8*)(lds + PG8_SB(b, h) + boff + n * 2048 + k * 1024); } while (0)
#define PG8_MMA(ai, bj, At, Bt) do { __builtin_amdgcn_s_setprio(1); _Pragma("unroll") for (int m = 0; m < 4; ++m) _Pragma("unroll") for (int n = 0; n < 2; ++n) _Pragma("unroll") for (int k = 0; k < 2; ++k) \
        acc[ai][bj][m][n] = __builtin_amdgcn_mfma_f32_16x16x32_bf16(Bt[n][k], At[m][k], acc[ai][bj][m][n], 0, 0, 0); __builtin_amdgcn_s_setprio(0); } while (0)
#define PG8_WAIT_V(n) asm volatile("s_waitcnt vmcnt(" #n ")" ::: "memory")
#define PG8_WAIT_L(n) asm volatile("s_waitcnt lgkmcnt(" #n ")" ::: "memory")
#define PG8_BAR __builtin_amdgcn_s_barrier()
#define PG8_SCHED __builtin_amdgcn_sched_barrier(0)
    Unit cur, nxt; int ui = 0;
    if (!S.next(0, cur)) return;
    f32x4 acc[2][2][4][2];
#pragma unroll
    for (int a = 0; a < 2; ++a)
#pragma unroll
        for (int b = 0; b < 2; ++b)
#pragma unroll
            for (int m = 0; m < 4; ++m)
#pragma unroll
                for (int n = 0; n < 2; ++n) acc[a][b][m][n] = (f32x4){0.f, 0.f, 0.f, 0.f};
    bf16x8 At[4][2], B0[2][2], B1[2][2];
#define PG8_ABASE(u) ((const char*)(!CHAIN || (u).sub == 0 ? g.A : (u).sub == 1 ? g.A1 : (u).sub == 2 ? g.A2 : g.A3) + (size_t)(u).pm * tstep)
#define PG8_BBASE(u) ((const char*)(!CHAIN || (u).sub == 0 ? g.Bt : (u).sub == 1 ? g.B1 : (u).sub == 2 ? g.B2 : g.B3) + (size_t)(u).pn * tstep)
    const char* cA = PG8_ABASE(cur); const char* cB = PG8_BBASE(cur);
    S.a_ready(cur);
    if constexpr (SP2) {
        PG8_STAGE(PG8_SB(0, 0), cB, voffB); PG8_STAGE(PG8_SB(0, 1), cB + hstep, voffB); PG8_STAGE(PG8_SA(0, 0), cA, voffA); PG8_STAGE(PG8_SA(0, 1), cA + hstep, voffA);
        if (wr == 1) PG8_BAR;
        PG8_WAIT_V(2); PG8_BAR;
        PG8_STAGE(PG8_SB(1, 0), cB + kstep, voffB); PG8_STAGE(PG8_SA(1, 0), cA + kstep, voffA); PG8_STAGE(PG8_SB(1, 1), cB + hstep + kstep, voffB);
        PG8_WAIT_V(6); PG8_BAR;
    } else {
        PG8_STAGE(PG8_SB(0, 0), cB, voffB); PG8_STAGE(PG8_SA(0, 0), cA, voffA); PG8_STAGE(PG8_SB(0, 1), cB + hstep, voffB); PG8_STAGE(PG8_SA(0, 1), cA + hstep, voffA);
        if (wr == 1) PG8_BAR;
        PG8_WAIT_V(4); PG8_BAR;
        PG8_STAGE(PG8_SB(1, 0), cB + kstep, voffB); PG8_STAGE(PG8_SA(1, 0), cA + kstep, voffA); PG8_STAGE(PG8_SB(1, 1), cB + hstep + kstep, voffB);
        PG8_WAIT_V(6); PG8_BAR;
    }
    for (;;) {
        const bool has_next = S.next(ui + 1, nxt);
        const char* nA = has_next ? PG8_ABASE(nxt) : cA; const char* nB = has_next ? PG8_BBASE(nxt) : cB;
        for (int t = 0; t < nt; t += 2) {
            const bool last = (t == nt - 2);
            const char* a1 = cA + (size_t)(t + 1) * kstep;
            const char* a2 = last ? nA : cA + (size_t)(t + 2) * kstep; const char* b2 = last ? nB : cB + (size_t)(t + 2) * kstep;
            const char* a3 = a2 + kstep; const char* b3 = b2 + kstep;
            if (last && has_next) S.a_ready(nxt);
            if constexpr (SP2) {
            PG8_LDB(B0, 0, 0); PG8_LDB(B1, 0, 1); PG8_SCHED; PG8_LDA(At, 0, 0); PG8_STAGE(PG8_SA(1, 1), a1 + hstep, voffA);
            PG8_WAIT_V(8); PG8_WAIT_L(0); PG8_BAR; PG8_MMA(0, 0, At, B0); PG8_MMA(0, 1, At, B1); PG8_BAR; PG8_SCHED;
            PG8_LDA(At, 0, 1); PG8_STAGE(PG8_SB(0, 0), b2, voffB); PG8_STAGE(PG8_SB(0, 1), b2 + hstep, voffB); PG8_STAGE(PG8_SA(0, 0), a2, voffA);
            PG8_WAIT_V(8); PG8_WAIT_L(0); PG8_BAR; PG8_MMA(1, 0, At, B0); PG8_MMA(1, 1, At, B1); PG8_BAR; PG8_SCHED;
            PG8_LDB(B0, 1, 0); PG8_LDB(B1, 1, 1); PG8_SCHED; PG8_LDA(At, 1, 0); PG8_STAGE(PG8_SA(0, 1), a2 + hstep, voffA);
            PG8_WAIT_V(8); PG8_WAIT_L(0); PG8_BAR; PG8_MMA(0, 0, At, B0); PG8_MMA(0, 1, At, B1); PG8_BAR; PG8_SCHED;
            PG8_LDA(At, 1, 1); PG8_STAGE(PG8_SB(1, 0), b3, voffB); PG8_STAGE(PG8_SB(1, 1), b3 + hstep, voffB); PG8_STAGE(PG8_SA(1, 0), a3, voffA);
            PG8_WAIT_V(8); PG8_WAIT_L(0); PG8_BAR; PG8_MMA(1, 0, At, B0); PG8_MMA(1, 1, At, B1); PG8_BAR; PG8_SCHED;
            } else {
            PG8_LDB(B0, 0, 0); PG8_SCHED; PG8_LDA(At, 0, 0); PG8_STAGE(PG8_SA(1, 1), a1 + hstep, voffA);
            PG8_WAIT_L(8); PG8_BAR; PG8_WAIT_L(0); PG8_MMA(0, 0, At, B0); PG8_BAR; PG8_SCHED;
            PG8_LDB(B1, 0, 1); PG8_STAGE(PG8_SB(0, 0), b2, voffB);
            PG8_BAR; PG8_WAIT_L(0); PG8_MMA(0, 1, At, B1); PG8_BAR;
            PG8_LDA(At, 0, 1); PG8_STAGE(PG8_SA(0, 0), a2, voffA);
            PG8_BAR; PG8_WAIT_L(0); PG8_MMA(1, 0, At, B0); PG8_BAR; PG8_SCHED;
            PG8_STAGE(PG8_SB(0, 1), b2 + hstep, voffB);
            PG8_WAIT_V(6); PG8_BAR; PG8_MMA(1, 1, At, B1); PG8_BAR;
            PG8_LDB(B0, 1, 0); PG8_SCHED; PG8_LDA(At, 1, 0); PG8_STAGE(PG8_SA(0, 1), a2 + hstep, voffA);
            PG8_WAIT_L(8); PG8_BAR; PG8_WAIT_L(0); PG8_MMA(0, 0, At, B0); PG8_BAR; PG8_SCHED;
            PG8_LDB(B1, 1, 1); PG8_STAGE(PG8_SB(1, 0), b3, voffB);
            PG8_BAR; PG8_WAIT_L(0); PG8_MMA(0, 1, At, B1); PG8_BAR;
            PG8_LDA(At, 1, 1); PG8_STAGE(PG8_SA(1, 0), a3, voffA);
            PG8_BAR; PG8_WAIT_L(0); PG8_MMA(1, 0, At, B0); PG8_BAR; PG8_SCHED;
            PG8_STAGE(PG8_SB(1, 1), b3 + hstep, voffB);
            PG8_WAIT_V(6); PG8_BAR; PG8_MMA(1, 1, At, B1); PG8_BAR;
            }
        }
        if constexpr (ALIGN_EPI) { if (wr == 0) PG8_BAR; }
        if constexpr (CHAIN) { if (cur.sub < 3) E.mid(acc, cur, wr, wc, fr, fq); else E(acc, cur, wr, wc, fr, fq); S.done(cur); }
        else if constexpr (!Epi::AFTER_DRAIN) { E(acc, cur, wr, wc, fr, fq); S.done(cur); }
        if (!has_next) break;
        if (!CHAIN || cur.sub == 3)
#pragma unroll
        for (int a = 0; a < 2; ++a)
#pragma unroll
            for (int b = 0; b < 2; ++b)
#pragma unroll
                for (int m = 0; m < 4; ++m)
#pragma unroll
                    for (int n = 0; n < 2; ++n) acc[a][b][m][n] = (f32x4){0.f, 0.f, 0.f, 0.f};
        cur = nxt; cA = nA; cB = nB; ++ui;
        if constexpr (ALIGN_EPI) { if (wr == 1) PG8_BAR; }
    }
    PG8_WAIT_V(0);
    if constexpr (!ALIGN_EPI) { if (wr == 0) PG8_BAR; }
    PG8_BAR;
    if constexpr (Epi::AFTER_DRAIN) { E.fused(acc, cur, wr, wc, fr, fq, lds, wid, lane); S.done(cur); }
#undef PG8_ABASE
#undef PG8_BBASE
#undef PG8_SA
#undef PG8_SB
#undef PG8_STAGE
#undef PG8_LDA
#undef PG8_LDB
#undef PG8_MMA
#undef PG8_WAIT_V
#undef PG8_WAIT_L
#undef PG8_BAR
#undef PG8_SCHED
}
}

constexpr int NB = 32, SEQ = 2048, NMETA = 16, TT = SEQ + NMETA, D = 1024, NL = 4, DFF = 4096;
constexpr int NG = 4, GB = NB / NG, MR = GB * SEQ  , MT = MR + NMETA  ;
constexpr int NCOLS = 9696, NZ = 9728, ZB = 9216, ZFW = 512;
constexpr float EPS = 1e-6f;
constexpr int ZC_GQ = 0, ZC_GK = 512, ZC_GV = 1024, ZC_GR = 2048, ZC_MQ = 3072, ZC_MK = 3584, ZC_MV = 4096, ZC_MO = 5120, ZC_GATE = 6144;
constexpr int ZF_CQ = 0, ZF_CKV = 256, ZF_IK = 384, ZF_A = 448, ZF_IW = 464, ZF_MI = 472, ZF_MF = 476;
constexpr int NQQ = 2560;

constexpr size_t MiB = 1u << 20;
constexpr size_t WS_CTL = 0, CTL_ZERO_BYTES = 1 * MiB;
constexpr size_t WS_BIN = 1 * MiB;
constexpr size_t WS_WIN = 2 * MiB;
constexpr size_t WS_WQQ = 78 * MiB;
constexpr size_t WS_WBG = 83 * MiB;
constexpr size_t WS_WBM = 91 * MiB;
constexpr size_t WS_WBD = 99 * MiB;
constexpr size_t WS_WOUT = 115 * MiB;
constexpr size_t WS_WUP = 123 * MiB;
constexpr size_t WS_WDN = 155 * MiB;
constexpr size_t WS_HM = 187 * MiB;
constexpr size_t WS_XN = 188 * MiB;
constexpr size_t WS_ZF = 221 * MiB;
constexpr size_t WS_CQN = 254 * MiB;
constexpr size_t WS_KV = 263 * MiB;
constexpr size_t WS_KI = 268 * MiB;
constexpr size_t WS_WI = 271 * MiB;
constexpr size_t WS_LIF = 272 * MiB;
constexpr size_t WS_G = 273 * MiB;
constexpr size_t WS_QKC = 306 * MiB;
constexpr size_t WS_QQ = 339 * MiB;
constexpr size_t WS_OG = 420 * MiB;
constexpr size_t WS_OM = 453 * MiB;
constexpr size_t WS_OD = 486 * MiB;
constexpr size_t WS_Z = 551 * MiB;
constexpr size_t WS_MIX = 840 * MiB;
constexpr size_t WS_Y = 873 * MiB;
constexpr size_t WS_SC = 840 * MiB;
constexpr size_t WS_DD = 1020 * MiB;
constexpr size_t WS_END = 1024 * MiB;
constexpr int SC_PITCH = 2080;
static_assert(WS_Z + (size_t)MT * ZB * 2 <= WS_MIX && WS_Y + (size_t)MT * D * 4 <= WS_END && WS_SC + (size_t)256 * 64 * SC_PITCH * 4 <= WS_END, "ws map");

constexpr int CW_BAR = 4096;

constexpr int RING_BYTES = 139264;
constexpr int MISC_OFF = RING_BYTES + 320;
constexpr int LDS_BYTES = 147456;
constexpr int NWAVES = 8;

#define LAS __attribute__((address_space(3)))
typedef unsigned short bf16;
typedef float f32x4 __attribute__((ext_vector_type(4)));
typedef float f32x2 __attribute__((ext_vector_type(2)));
typedef unsigned u32x4 __attribute__((ext_vector_type(4)));
typedef unsigned u32x2 __attribute__((ext_vector_type(2)));
typedef short bf16x8 __attribute__((ext_vector_type(8)));
typedef short s16x4 __attribute__((ext_vector_type(4)));
#define LDS_WAIT() asm volatile("s_waitcnt lgkmcnt(0)" ::: "memory")
#define VM_WAIT() asm volatile("s_waitcnt vmcnt(0)" ::: "memory")
#define LDS_BARRIER() do { asm volatile("s_waitcnt lgkmcnt(0)" ::: "memory"); __builtin_amdgcn_s_barrier(); asm volatile("" ::: "memory"); } while (0)

typedef __bf16 hwbf16x2 __attribute__((ext_vector_type(2)));
__device__ __forceinline__ unsigned pk2(float lo, float hi) { const f32x2 v = {lo, hi}; const hwbf16x2 b = __builtin_convertvector(v, hwbf16x2); return __builtin_bit_cast(unsigned, b); }
__device__ __forceinline__ unsigned f2bf(float f) { return pk2(f, 0.f) & 0xffffu; }
__device__ __forceinline__ float bf2f(unsigned b) { return __builtin_bit_cast(float, b << 16); }
__device__ __forceinline__ float bflo(unsigned w) { return __builtin_bit_cast(float, w << 16); }
__device__ __forceinline__ float bfhi(unsigned w) { return __builtin_bit_cast(float, w & 0xffff0000u); }
__device__ __forceinline__ float wave_sum(float v) {
#pragma unroll
    for (int o = 1; o < 64; o <<= 1) v += __shfl_xor(v, o);
    return v;
}
__device__ __forceinline__ float wave_max(float v) {
#pragma unroll
    for (int o = 1; o < 64; o <<= 1) v = fmaxf(v, __shfl_xor(v, o));
    return v;
}
__device__ __forceinline__ float sigmoid_f(float x) { return __builtin_amdgcn_rcpf(1.f + __builtin_amdgcn_exp2f(-1.4426950408889634f * x)); }
__device__ __forceinline__ float silu_f(float x) { return x * sigmoid_f(x); }
__device__ __forceinline__ float logsigmoid_f(float x) { return fminf(x, 0.f) - 0.6931471805599453f * __builtin_amdgcn_logf(1.f + __builtin_amdgcn_exp2f(-1.4426950408889634f * fabsf(x))); }

#define XB_TMO      128
#define XB_XCNT(j)  (256  + 64 * (j))
#define XB_XSUB(j)  (1280 + 64 * (j))
#define XB_XGEN(j)  (2304 + 64 * (j))
#define XB_TOP      3328
#define XB_TOPGEN   3392
#define XCD_BAR_WORDS 3456
#define XB_SPIN_CAP (1u << 22)

__device__ __forceinline__ unsigned xb_ld(unsigned* p)              { return __hip_atomic_load(p, __ATOMIC_RELAXED, __HIP_MEMORY_SCOPE_AGENT); }
__device__ __forceinline__ unsigned xb_add(unsigned* p, unsigned v) { return __hip_atomic_fetch_add(p, v, __ATOMIC_RELAXED, __HIP_MEMORY_SCOPE_AGENT); }
__device__ __forceinline__ unsigned xb_xcc_id() { return (unsigned)__builtin_amdgcn_s_getreg((3 << 11) | 20) & 0xFu; }
#define XB_SPIN(cond, bar) do { unsigned _sp = 0; while (cond) { __builtin_amdgcn_s_sleep(1); \
    if ((++_sp & 255u) == 0u) { if (xb_ld(&(bar)[XB_TMO])) break; if (_sp > XB_SPIN_CAP) { atomicAdd(&(bar)[XB_TMO], 1u); break; } } } } while (0)

struct XcdBarrier {
    unsigned* bar; unsigned x;
    volatile LAS unsigned* st;
};

__device__ __forceinline__ XcdBarrier xcd_barrier_post(unsigned* bar, volatile LAS unsigned* st) {
    XcdBarrier b; b.bar = bar; b.x = xb_xcc_id(); b.st = st;
    if (threadIdx.x == 0) (void)xb_add(&bar[XB_XCNT(b.x)], 1u);
    return b;
}
__device__ __forceinline__ void xcd_barrier_complete(unsigned* bar, unsigned x, unsigned& nloc, unsigned& nx) {
    const unsigned G = gridDim.x * gridDim.y * gridDim.z;
    unsigned sum, cnt, mine, sp = 0u;
    for (;;) {
        sum = 0u; cnt = 0u; mine = 0u;
#pragma unroll
        for (unsigned j = 0; j < 16; ++j) { const unsigned c = xb_ld(&bar[XB_XCNT(j)]); sum += c; cnt += (c > 0u) ? 1u : 0u; mine = (j == x) ? c : mine; }
        if (sum == G) break;
        __builtin_amdgcn_s_sleep(1);
        if ((++sp & 255u) == 0u) { if (xb_ld(&bar[XB_TMO])) break; if (sp > XB_SPIN_CAP) { atomicAdd(&bar[XB_TMO], 1u); break; } }
    }
    nloc = mine > 0u ? mine : 1u; nx = cnt > 0u ? cnt : 1u;
}

__device__ __forceinline__ void xcd_barrier(const XcdBarrier& b) {
    asm volatile("s_waitcnt vmcnt(0)" ::: "memory");
    __syncthreads();
    if (threadIdx.x == 0) {
        unsigned* bar = b.bar;
        __builtin_amdgcn_s_waitcnt(0);
        unsigned nloc = b.st[0], nx = b.st[1];
        if (nloc == 0u) { xcd_barrier_complete(bar, b.x, nloc, nx); b.st[0] = nloc; b.st[1] = nx; }
        const unsigned old = xb_add(&bar[XB_XSUB(b.x)], 1u);
        const unsigned gen = old / nloc;
        if (old + 1u == (gen + 1u) * nloc) {
            __builtin_amdgcn_fence(__ATOMIC_RELEASE, "agent");
            asm volatile("s_waitcnt vmcnt(0)" ::: "memory");
            const unsigned og = xb_add(&bar[XB_TOP], 1u);
            const unsigned tg = og / nx;
            if (og + 1u == (tg + 1u) * nx) xb_add(&bar[XB_TOPGEN], 1u);
            else XB_SPIN(xb_ld(&bar[XB_TOPGEN]) == tg, bar);
            __builtin_amdgcn_fence(__ATOMIC_ACQUIRE, "agent");
            xb_add(&bar[XB_XGEN(b.x)], 1u);
            asm volatile("s_waitcnt vmcnt(0)" ::: "memory");
        } else {
            XB_SPIN(xb_ld(&bar[XB_XGEN(b.x)]) == gen, bar);
            __builtin_amdgcn_fence(__ATOMIC_ACQUIRE, "agent");
            asm volatile("s_waitcnt vmcnt(0)" ::: "memory");
        }
    }
    __syncthreads();
}


struct Args { const float* in[28]; float* out; unsigned char* ws; int g_lo, g_hi, l_lo, l_hi, ph_lo, ph_hi, prep, use_bar; };
typedef const __attribute__((address_space(4))) Args* ArgsP;
enum { I_X = 0, I_META, I_T5, I_GPREMIX, I_WIN, I_BIN, I_WA2, I_BA, I_GGLA, I_WBRG, I_GDQ, I_WUQ, I_WIQ, I_GDKV, I_WUV, I_LNG, I_LNB, I_WBRD,
       I_CONV, I_FB, I_GML, I_WBRM, I_WOUT, I_GPOSTMIX, I_GPREMLP, I_WUP, I_WDN, I_GPOSTMLP };

__device__ __forceinline__ int win_src(int n) {
    if (n < 3072) return n;
    if (n < 6144) return n - 3072 + 3544;
    if (n < 9216) return n - 6144 + 6624;
    if (n < 9472) return n - 9216 + 3088;
    if (n < 9600) return n - 9472 + 3344;
    if (n < 9664) return n - 9600 + 3472;
    if (n < 9680) return n - 9664 + 3072;
    if (n < 9688) return n - 9680 + 3536;
    if (n < 9692) return n - 9688 + 6616;
    if (n < 9696) return n - 9692 + 6620;
    return -1;
}
struct CmIdent { __device__ __forceinline__ int operator()(int n) const { return n; } };
struct CmWin { __device__ __forceinline__ int operator()(int n) const { return win_src(n); } };

template <class CM>
__device__ __forceinline__ void tr_item(const float* __restrict__ W, int ldw, bf16* __restrict__ WT, int Kd, LAS float* scr, int k0, int ns0, int nd0, int lane, CM cm) {
    const int sc = cm(ns0 + (lane & 31)); const int scc = sc >= 0 ? sc : 0; const float msk = sc >= 0 ? 1.f : 0.f;
    float wv[32];
#pragma unroll
    for (int i = 0; i < 32; ++i) { const int kk = 2 * i + (lane >> 5); wv[i] = W[(size_t)(k0 + kk) * ldw + scc]; }
#pragma unroll
    for (int i = 0; i < 32; ++i) { const int kk = 2 * i + (lane >> 5); scr[kk * 33 + (lane & 31)] = wv[i] * msk; }
    LDS_WAIT();
    const int c = lane & 7;
#pragma unroll
    for (int j = 0; j < 4; ++j) { const int n = (lane >> 3) + 8 * j; const LAS float* s = scr + (8 * c) * 33 + n;
        u32x4 o; o.x = pk2(s[0 * 33], s[1 * 33]); o.y = pk2(s[2 * 33], s[3 * 33]); o.z = pk2(s[4 * 33], s[5 * 33]); o.w = pk2(s[6 * 33], s[7 * 33]);
        *(u32x4*)(WT + (size_t)(nd0 + n) * Kd + k0 + 8 * c) = o; }
    LDS_WAIT();
}

__device__ __forceinline__ void prep_weights(ArgsP a, LAS unsigned char* lds, int gw, int ngw, int wave, int lane) {
    LAS float* scr = (LAS float*)(lds + wave * 16384);
    unsigned char* ws = a->ws;
    constexpr int I_WIN_N = 16 * 304, I_UQ = 4 * 64, I_IQ = 4 * 16, I_SQ = 16 * 32, I_UP = 16 * 128, I_DN = 64 * 32, I_WBD = 4096, I_B = NZ / 64;
    constexpr int PER_L = I_WIN_N + I_UQ + I_IQ + 3 * I_SQ + I_UP + I_DN + I_WBD + I_B;
    for (int it = gw; it < NL * PER_L; it += ngw) {
        const int l = it / PER_L; int r = it % PER_L;
        if (r < I_WIN_N) { const int kb = r / 304, nb = r % 304;
            tr_item(a->in[I_WIN] + (size_t)l * D * NCOLS, NCOLS, (bf16*)(ws + WS_WIN) + (size_t)l * NZ * D, D, scr, kb * 64, nb * 32, nb * 32, lane, CmWin()); continue; }
        r -= I_WIN_N;
        if (r < I_UQ) { const int kb = r / 64, nb = r % 64;
            tr_item(a->in[I_WUQ] + (size_t)l * 256 * 2048, 2048, (bf16*)(ws + WS_WQQ) + (size_t)l * NQQ * 256, 256, scr, kb * 64, nb * 32, nb * 32, lane, CmIdent()); continue; }
        r -= I_UQ;
        if (r < I_IQ) { const int kb = r / 16, nb = r % 16;
            tr_item(a->in[I_WIQ] + (size_t)l * 256 * 512, 512, (bf16*)(ws + WS_WQQ) + (size_t)l * NQQ * 256, 256, scr, kb * 64, nb * 32, 2048 + nb * 32, lane, CmIdent()); continue; }
        r -= I_IQ;
        if (r < I_SQ) { const int kb = r / 32, nb = r % 32;
            tr_item(a->in[I_WBRG] + (size_t)l * D * D, D, (bf16*)(ws + WS_WBG) + (size_t)l * D * D, D, scr, kb * 64, nb * 32, nb * 32, lane, CmIdent()); continue; }
        r -= I_SQ;
        if (r < I_SQ) { const int kb = r / 32, nb = r % 32;
            tr_item(a->in[I_WBRM] + (size_t)l * D * D, D, (bf16*)(ws + WS_WBM) + (size_t)l * D * D, D, scr, kb * 64, nb * 32, nb * 32, lane, CmIdent()); continue; }
        r -= I_SQ;
        if (r < I_SQ) { const int kb = r / 32, nb = r % 32;
            tr_item(a->in[I_WOUT] + (size_t)l * D * D, D, (bf16*)(ws + WS_WOUT) + (size_t)l * D * D, D, scr, kb * 64, nb * 32, nb * 32, lane, CmIdent()); continue; }
        r -= I_SQ;
        if (r < I_UP) { const int kb = r / 128, nb = r % 128;
            tr_item(a->in[I_WUP] + (size_t)l * D * DFF, DFF, (bf16*)(ws + WS_WUP) + (size_t)l * DFF * D, D, scr, kb * 64, nb * 32, nb * 32, lane, CmIdent()); continue; }
        r -= I_UP;
        if (r < I_DN) { const int kb = r / 32, nb = r % 32;
            tr_item(a->in[I_WDN] + (size_t)l * DFF * D, D, (bf16*)(ws + WS_WDN) + (size_t)l * D * DFF, DFF, scr, kb * 64, nb * 32, nb * 32, lane, CmIdent()); continue; }
        r -= I_DN;
        if (r < I_WBD) {
            const int h = r >> 8, nb = (r >> 4) & 15, cb = r & 15, n = nb * 64 + lane, c0 = cb * 8;
            const float* uv = a->in[I_WUV] + ((size_t)(l * 16 + h) * 128 + c0) * 64;
            const float* wb = a->in[I_WBRD] + ((size_t)l * D + h * 64) * D + n;
            float acc[8];
#pragma unroll
            for (int j = 0; j < 8; ++j) acc[j] = 0.f;
            for (int d0 = 0; d0 < 64; d0 += 8) {
                float wv[8];
#pragma unroll
                for (int e = 0; e < 8; ++e) wv[e] = wb[(size_t)(d0 + e) * D];
#pragma unroll
                for (int j = 0; j < 8; ++j) { const f32x4 u0 = *(const f32x4*)(uv + j * 64 + d0), u1 = *(const f32x4*)(uv + j * 64 + d0 + 4);
                    acc[j] += (u0.x * wv[0] + u0.y * wv[1]) + (u0.z * wv[2] + u0.w * wv[3]) + (u1.x * wv[4] + u1.y * wv[5]) + (u1.z * wv[6] + u1.w * wv[7]); }
            }
            bf16* o = (bf16*)(ws + WS_WBD) + (size_t)l * D * 2048 + (size_t)(h >> 3) * D * D + (size_t)n * D + (h & 7) * 128 + c0;
            u32x4 ow; ow.x = pk2(acc[0], acc[1]); ow.y = pk2(acc[2], acc[3]); ow.z = pk2(acc[4], acc[5]); ow.w = pk2(acc[6], acc[7]);
            *(u32x4*)o = ow;
            continue; }
        r -= I_WBD;
        { const int n = r * 64 + lane; const int sc = win_src(n);
          ((float*)(ws + WS_BIN))[l * NZ + n] = sc >= 0 ? a->in[I_BIN][l * NCOLS + sc] : 0.f; }
    }
}

__device__ __forceinline__ float* hrow(ArgsP a, int g, int r) {
    return r < MR ? a->out + ((size_t)g * MR + r) * D : (float*)(a->ws + WS_HM) + (size_t)(r - MR) * D;
}
__device__ __forceinline__ void rms_row_bf16(const f32x4 (&v)[4], const float* __restrict__ gain, bf16* __restrict__ orow, int lane) {
    float s = 0.f;
#pragma unroll
    for (int j = 0; j < 4; ++j) s += (v[j].x * v[j].x + v[j].y * v[j].y) + (v[j].z * v[j].z + v[j].w * v[j].w);
    const float r = rsqrtf(wave_sum(s) * (1.f / D) + EPS);
#pragma unroll
    for (int j = 0; j < 4; ++j) { const f32x4 gg = *(const f32x4*)(gain + 4 * lane + 256 * j); const f32x4 o = v[j] * r * gg;
        u32x2 w; w.x = pk2(o.x, o.y); w.y = pk2(o.z, o.w); *(u32x2*)(orow + 4 * lane + 256 * j) = w; }
}
__device__ __forceinline__ void p0_init(ArgsP a, int g, int gw, int ngw, int lane) {
    bf16* XN = (bf16*)(a->ws + WS_XN);
    for (int r = gw; r < MT; r += ngw) {
        const float* src = r < MR ? a->in[I_X] + ((size_t)g * MR + r) * D : a->in[I_META] + (size_t)(r - MR) * D;
        float* hd = hrow(a, g, r);
        f32x4 v[4];
#pragma unroll
        for (int j = 0; j < 4; ++j) { v[j] = *(const f32x4*)(src + 4 * lane + 256 * j); *(f32x4*)(hd + 4 * lane + 256 * j) = v[j]; }
        rms_row_bf16(v, a->in[I_GPREMIX], XN + (size_t)r * D, lane);
    }
}
template <bool DRY = false>
__device__ __forceinline__ void p_norm_res(ArgsP a, int g, const float* gpost, const float* gpre, int gw, int ngw, int lane) {
    bf16* XN = (bf16*)(a->ws + (DRY ? WS_Z + 100 * MiB : WS_XN)); const bf16* Y = (const bf16*)(a->ws + WS_Y);
    f32x4 gp[4], gq[4];
#pragma unroll
    for (int j = 0; j < 4; ++j) { gp[j] = *(const f32x4*)(gpost + 4 * lane + 256 * j); gq[j] = gpre ? *(const f32x4*)(gpre + 4 * lane + 256 * j) : (f32x4){0.f, 0.f, 0.f, 0.f}; }
    for (int r0 = gw * 2; r0 < MT; r0 += ngw * 2) {
        float* hd[2]; float* hw[2]; u32x2 yw[2][4]; f32x4 v[2][4]; float s[2];
#pragma unroll
        for (int i = 0; i < 2; ++i) { const int r = r0 + i; hd[i] = hrow(a, g, r); hw[i] = DRY ? (float*)(a->ws + WS_Z) + (size_t)r * D : hd[i];
#pragma unroll
            for (int j = 0; j < 4; ++j) { yw[i][j] = *(const u32x2*)(Y + (size_t)r * D + 4 * lane + 256 * j); v[i][j] = *(const f32x4*)(hd[i] + 4 * lane + 256 * j); } }
        f32x4 y[2][4];
#pragma unroll
        for (int i = 0; i < 2; ++i) { s[i] = 0.f;
#pragma unroll
            for (int j = 0; j < 4; ++j) { y[i][j] = (f32x4){bflo(yw[i][j].x), bfhi(yw[i][j].x), bflo(yw[i][j].y), bfhi(yw[i][j].y)};
                s[i] += (y[i][j].x * y[i][j].x + y[i][j].y * y[i][j].y) + (y[i][j].z * y[i][j].z + y[i][j].w * y[i][j].w); } }
#pragma unroll
        for (int o = 1; o < 64; o <<= 1) { s[0] += __shfl_xor(s[0], o); s[1] += __shfl_xor(s[1], o); }
        float s2[2];
#pragma unroll
        for (int i = 0; i < 2; ++i) { const float rr = rsqrtf(s[i] * (1.f / D) + EPS); s2[i] = 0.f;
#pragma unroll
            for (int j = 0; j < 4; ++j) { v[i][j] = v[i][j] + y[i][j] * rr * gp[j]; *(f32x4*)(hw[i] + 4 * lane + 256 * j) = v[i][j];
                s2[i] += (v[i][j].x * v[i][j].x + v[i][j].y * v[i][j].y) + (v[i][j].z * v[i][j].z + v[i][j].w * v[i][j].w); } }
        if (gpre) {
#pragma unroll
            for (int o = 1; o < 64; o <<= 1) { s2[0] += __shfl_xor(s2[0], o); s2[1] += __shfl_xor(s2[1], o); }
#pragma unroll
            for (int i = 0; i < 2; ++i) { const float r2 = rsqrtf(s2[i] * (1.f / D) + EPS);
#pragma unroll
                for (int j = 0; j < 4; ++j) { const f32x4 o4 = v[i][j] * r2 * gq[j]; u32x2 w; w.x = pk2(o4.x, o4.y); w.y = pk2(o4.z, o4.w); *(u32x2*)(XN + (size_t)(r0 + i) * D + 4 * lane + 256 * j) = w; } }
        }
    }
}

template <class F> struct EpiT {
    static constexpr bool PERM = true, AFTER_DRAIN = false;
    F f;
    __device__ __forceinline__ void operator()(const f32x4 (&acc)[2][2][4][2], const pg8::Unit& u, int wr, int wc, int fr, int fq) const {
        const int row0 = u.pm * 256 + wr * 64 + fr, col0 = u.pn * 256 + wc * 32 + 8 * fq;
        if constexpr (F::HAS_BIAS) {
            const f32x4 b00 = *(const f32x4*)(f.bias + col0), b01 = *(const f32x4*)(f.bias + col0 + 4), b10 = *(const f32x4*)(f.bias + col0 + 128), b11 = *(const f32x4*)(f.bias + col0 + 132);
#pragma unroll
            for (int ai = 0; ai < 2; ++ai)
#pragma unroll
                for (int m = 0; m < 4; ++m) { f.apply(row0 + ai * 128 + m * 16, col0, acc[ai][0][m][0] + b00, acc[ai][0][m][1] + b01); f.apply(row0 + ai * 128 + m * 16, col0 + 128, acc[ai][1][m][0] + b10, acc[ai][1][m][1] + b11); }
            return;
        }
#pragma unroll
        for (int ai = 0; ai < 2; ++ai)
#pragma unroll
            for (int m = 0; m < 4; ++m)
#pragma unroll
                for (int bj = 0; bj < 2; ++bj) f.apply(row0 + ai * 128 + m * 16, col0 + bj * 128, acc[ai][bj][m][0], acc[ai][bj][m][1]);
    }
};
__device__ __forceinline__ void st_bf16x8(bf16* p, f32x4 v0, f32x4 v1) { u32x4 w; w.x = pk2(v0.x, v0.y); w.y = pk2(v0.z, v0.w); w.z = pk2(v1.x, v1.y); w.w = pk2(v1.z, v1.w); *(u32x4*)p = w; }
__device__ __forceinline__ void st_bf16x8_nt(bf16* p, f32x4 v0, f32x4 v1) { u32x4 w; w.x = pk2(v0.x, v0.y); w.y = pk2(v0.z, v0.w); w.z = pk2(v1.x, v1.y); w.w = pk2(v1.z, v1.w); __builtin_nontemporal_store(w, (u32x4*)p); }
__device__ __forceinline__ void ld_bf16x8(const bf16* p, f32x4& v0, f32x4& v1) { const u32x4 w = *(const u32x4*)p;
    v0 = (f32x4){bflo(w.x), bfhi(w.x), bflo(w.y), bfhi(w.y)}; v1 = (f32x4){bflo(w.z), bfhi(w.z), bflo(w.w), bfhi(w.w)}; }

#if defined(NT_STORES)
#define ST_BIG st_bf16x8_nt
#else
#define ST_BIG st_bf16x8
#endif
struct FIn {
    static constexpr bool HAS_BIAS = true, STAGGER = true;
    bf16* Z; float* ZF; const float* bias;
    __device__ __forceinline__ void apply(int row, int col, f32x4 v0, f32x4 v1) const {
        const int t = col >> 8;
        if (t >= 36) { float* p = ZF + (size_t)row * ZFW + (col - ZB); *(f32x4*)p = v0; *(f32x4*)(p + 4) = v1; return; }
        if (t < 2) { v0 *= 0.08838834764831845f; v1 *= 0.08838834764831845f; }
        else if (t >= 8 && t < 12) {
#pragma unroll
            for (int i = 0; i < 4; ++i) { v0[i] = silu_f(v0[i]); v1[i] = silu_f(v1[i]); } }
        else if (t >= 20) {
#pragma unroll
            for (int i = 0; i < 4; ++i) { v0[i] = sigmoid_f(v0[i]); v1[i] = sigmoid_f(v1[i]); } }
        ST_BIG(Z + (size_t)row * ZB + col, v0, v1);
    }
};
struct FQQ {
    static constexpr bool HAS_BIAS = false, STAGGER = false;
    bf16* QQ;
    __device__ __forceinline__ void apply(int row, int col, f32x4 v0, f32x4 v1) const {
        const float s = col < 2048 ? 0.08838834764831845f : 0.125f;
        st_bf16x8(QQ + (size_t)row * NQQ + col, v0 * s, v1 * s);
    }
};
template <int IDX> struct FBr {
    static constexpr bool HAS_BIAS = false;
    const bf16* Z; float* Y; bf16* MIX;
    __device__ __forceinline__ void apply(int row, int col, f32x4 v0, f32x4 v1) const {
        f32x4 g0, g1; ld_bf16x8(Z + (size_t)row * ZB + ZC_GATE + IDX * 1024 + col, g0, g1);
        float* y = Y + (size_t)row * D + col;
        f32x4 a0 = v0 * g0, a1 = v1 * g1;
        if (IDX > 0) { a0 += *(const f32x4*)y; a1 += *(const f32x4*)(y + 4); }
        if (IDX < 2) { *(f32x4*)y = a0; *(f32x4*)(y + 4) = a1; }
        else st_bf16x8(MIX + (size_t)row * D + col, a0, a1);
    }
};
struct FY {
    static constexpr bool HAS_BIAS = false, STAGGER = false;
    bf16* Y;
    __device__ __forceinline__ void apply(int row, int col, f32x4 v0, f32x4 v1) const { st_bf16x8(Y + (size_t)row * D + col, v0, v1); }
};
struct FUp {
    static constexpr bool HAS_BIAS = false, STAGGER = true;
    bf16* U;
    __device__ __forceinline__ void apply(int row, int col, f32x4 v0, f32x4 v1) const {
#pragma unroll
        for (int i = 0; i < 4; ++i) { const float p = fmaxf(v0[i], 0.f), q = fmaxf(v1[i], 0.f); v0[i] = p * p; v1[i] = q * q; }
#if defined(PROBE_NOSTORE)
        if (v0.x == 12345.678f) st_bf16x8(U + (size_t)row * DFF + col, v0, v1);
#else
        ST_BIG(U + (size_t)row * DFF + col, v0, v1);
#endif
    }
};

template <class F>
__device__ __forceinline__ void mini_gemm(LAS unsigned char* lds, const bf16* __restrict__ A, const bf16* __restrict__ Bt, int N, int K, const F& f, int tid_in) {
    int tid = tid_in; asm volatile("" : "+v"(tid));
    const int lane = tid & 63, wave = __builtin_amdgcn_readfirstlane(tid >> 6), fr = lane & 15, fq = lane >> 4;
    LAS float* red = (LAS float*)lds;
    const int kw = K >> 3, kbeg = wave * kw;
    for (int wt = blockIdx.x; wt < N / 32; wt += gridDim.x) {
        const int n0 = wt * 32;
        f32x4 acc0 = {0.f, 0.f, 0.f, 0.f}, acc1 = {0.f, 0.f, 0.f, 0.f};
        const bf16* ap = A + (size_t)(MR + fr) * K + fq * 8 + kbeg;
        const bf16* b0 = Bt + (size_t)(n0 + pg8::perm32(fr)) * K + fq * 8 + kbeg;
        const bf16* b1 = Bt + (size_t)(n0 + pg8::perm32(16 + fr)) * K + fq * 8 + kbeg;
        if (kw < 128) {
            const bf16x8 av = *(const bf16x8*)ap, w0 = *(const bf16x8*)b0, w1 = *(const bf16x8*)b1;
            acc0 = __builtin_amdgcn_mfma_f32_16x16x32_bf16(w0, av, acc0, 0, 0, 0);
            acc1 = __builtin_amdgcn_mfma_f32_16x16x32_bf16(w1, av, acc1, 0, 0, 0);
        } else {
            for (int k = 0; k < kw; k += 128) {
                bf16x8 av[4], w0[4], w1[4];
#pragma unroll
                for (int u = 0; u < 4; ++u) { av[u] = *(const bf16x8*)(ap + k + 32 * u); w0[u] = *(const bf16x8*)(b0 + k + 32 * u); w1[u] = *(const bf16x8*)(b1 + k + 32 * u); }
#pragma unroll
                for (int u = 0; u < 4; ++u) {
                    acc0 = __builtin_amdgcn_mfma_f32_16x16x32_bf16(w0[u], av[u], acc0, 0, 0, 0);
                    acc1 = __builtin_amdgcn_mfma_f32_16x16x32_bf16(w1[u], av[u], acc1, 0, 0, 0);
                }
            }
        }
        *(LAS f32x4*)(red + (wave * 64 + lane) * 8) = acc0; *(LAS f32x4*)(red + (wave * 64 + lane) * 8 + 4) = acc1;
        LDS_WAIT();
        __syncthreads();
        if (wave == 0) {
            f32x4 s0 = {0.f, 0.f, 0.f, 0.f}, s1 = {0.f, 0.f, 0.f, 0.f};
#pragma unroll
            for (int w = 0; w < 8; ++w) { s0 += *(const LAS f32x4*)(red + (w * 64 + lane) * 8); s1 += *(const LAS f32x4*)(red + (w * 64 + lane) * 8 + 4); }
            if constexpr (F::HAS_BIAS) { s0 += *(const f32x4*)(f.bias + n0 + 8 * fq); s1 += *(const f32x4*)(f.bias + n0 + 8 * fq + 4); }
            f.apply(MR + fr, n0 + 8 * fq, s0, s1);
        }
        __syncthreads();
    }
}
template <class F, bool ALIGN = true>
__device__ __forceinline__ void run_gemm(LAS unsigned char* lds, const bf16* A, const bf16* Bt, int N, int K, const F& f, int gw, int ngw, int lane) {
    asm volatile("" : "+s"(K)); asm volatile("" : "+s"(N));
    pg8::Gemm g{A, Bt, MR, N, K}; pg8::StaticOrder S; S.init(MR, N, (int)gridDim.x, (int)blockIdx.x);
    EpiT<F> E{f};
#if defined(STAGGER_TICKS)
    if (F::STAGGER) {
        const unsigned long long t0 = __builtin_amdgcn_s_memrealtime(), dl = (unsigned long long)(blockIdx.x & 3u) * STAGGER_TICKS;
        while (__builtin_amdgcn_s_memrealtime() - t0 < dl) __builtin_amdgcn_s_sleep(4);
    }
#endif
    pg8::gemm_phase<EpiT<F>, pg8::StaticOrder, ALIGN, true>((PG8_LAS unsigned char*)lds, g, S, E);
    mini_gemm(lds, A, Bt, N, K, f, (int)threadIdx.x);
}

struct ChainOrder {
    pg8::StaticOrder S;
    __device__ __forceinline__ bool next(int i, pg8::Unit& u) const { if (!S.next(i >> 2, u)) return false; u.sub = i & 3; return true; }
    __device__ __forceinline__ void a_ready(const pg8::Unit&) const {}
    __device__ __forceinline__ void done(const pg8::Unit&) const {}
};
struct EpiMix {
    static constexpr bool PERM = true, AFTER_DRAIN = false;
    const bf16* Z; bf16* MIX;
    __device__ __forceinline__ void mid(f32x4 (&acc)[2][2][4][2], const pg8::Unit& u, int wr, int wc, int fr, int fq) const {
        if (u.sub == 1) return;
        const int gi = u.sub == 0 ? 0 : 1;
        const int row0 = u.pm * 256 + wr * 64 + fr, col0 = u.pn * 256 + wc * 32 + 8 * fq;
#pragma unroll
        for (int ai = 0; ai < 2; ++ai) {
            u32x4 ga[4][2], gb[4][2];
#pragma unroll
            for (int m = 0; m < 4; ++m)
#pragma unroll
                for (int bj = 0; bj < 2; ++bj) { const bf16* gp = Z + (size_t)(row0 + ai * 128 + m * 16) * ZB + ZC_GATE + gi * 1024 + col0 + bj * 128;
                    ga[m][bj] = *(const u32x4*)gp; gb[m][bj] = *(const u32x4*)(gp + 1024); }
#pragma unroll
            for (int m = 0; m < 4; ++m)
#pragma unroll
                for (int bj = 0; bj < 2; ++bj) {
                    const u32x4 a = ga[m][bj], b = gb[m][bj];
                    f32x4 r0, r1;
                    r0.x = bflo(a.x) * __builtin_amdgcn_rcpf(bflo(b.x)); r0.y = bfhi(a.x) * __builtin_amdgcn_rcpf(bfhi(b.x)); r0.z = bflo(a.y) * __builtin_amdgcn_rcpf(bflo(b.y)); r0.w = bfhi(a.y) * __builtin_amdgcn_rcpf(bfhi(b.y));
                    r1.x = bflo(a.z) * __builtin_amdgcn_rcpf(bflo(b.z)); r1.y = bfhi(a.z) * __builtin_amdgcn_rcpf(bfhi(b.z)); r1.z = bflo(a.w) * __builtin_amdgcn_rcpf(bflo(b.w)); r1.w = bfhi(a.w) * __builtin_amdgcn_rcpf(bfhi(b.w));
                    acc[ai][bj][m][0] *= r0; acc[ai][bj][m][1] *= r1;
                }
            asm volatile("" ::: "memory");
        }
    }
    __device__ __forceinline__ void operator()(const f32x4 (&acc)[2][2][4][2], const pg8::Unit& u, int wr, int wc, int fr, int fq) const {
        const int row0 = u.pm * 256 + wr * 64 + fr, col0 = u.pn * 256 + wc * 32 + 8 * fq;
#pragma unroll
        for (int ai = 0; ai < 2; ++ai) {
            u32x4 gc[4][2];
#pragma unroll
            for (int m = 0; m < 4; ++m)
#pragma unroll
                for (int bj = 0; bj < 2; ++bj) gc[m][bj] = *(const u32x4*)(Z + (size_t)(row0 + ai * 128 + m * 16) * ZB + ZC_GATE + 2 * 1024 + col0 + bj * 128);
#pragma unroll
            for (int m = 0; m < 4; ++m)
#pragma unroll
                for (int bj = 0; bj < 2; ++bj) {
                    const u32x4 w = gc[m][bj];
                    const f32x4 g0 = {bflo(w.x), bfhi(w.x), bflo(w.y), bfhi(w.y)}, g1 = {bflo(w.z), bfhi(w.z), bflo(w.w), bfhi(w.w)};
                    st_bf16x8(MIX + (size_t)(row0 + ai * 128 + m * 16) * D + col0 + bj * 128, acc[ai][bj][m][0] * g0, acc[ai][bj][m][1] * g1);
                }
            asm volatile("" ::: "memory");
        }
    }
};

__device__ __forceinline__ int prow(int r, int j) {
    if (r < MR) { const int s = r & (SEQ - 1); return (s - j >= 0) ? r - j : MR + (NMETA + s - j); }
    const int t = r - MR; return (t - j >= 0) ? r - j : -1;
}
__device__ __forceinline__ void p2_prep(ArgsP a, int l, int gw, int ngw, int lane) {
    unsigned char* ws = a->ws;
    const bf16* Z = (const bf16*)(ws + WS_Z);
    for (int r = gw; r < MT; r += ngw) {
        const float* zf = (const float*)(ws + WS_ZF) + (size_t)r * ZFW;
        f32x4 vq = *(const f32x4*)(zf + ZF_CQ + 4 * lane);
        f32x2 vk = *(const f32x2*)(zf + ZF_CKV + 2 * lane);
        const float vi = zf[ZF_IK + lane];
        const float vw = zf[ZF_IW + (lane & 7)];
        const f32x4 gq = *(const f32x4*)(a->in[I_GDQ] + l * 256 + 4 * lane);
        const f32x2 gk = *(const f32x2*)(a->in[I_GDKV] + l * 128 + 2 * lane);
        const float lg = a->in[I_LNG][l * 64 + lane], lb = a->in[I_LNB][l * 64 + lane];
        float s1 = (vq.x * vq.x + vq.y * vq.y) + (vq.z * vq.z + vq.w * vq.w), s2 = vk.x * vk.x + vk.y * vk.y, s3 = vi;
#pragma unroll
        for (int o = 1; o < 64; o <<= 1) { s1 += __shfl_xor(s1, o); s2 += __shfl_xor(s2, o); s3 += __shfl_xor(s3, o); }
        const float d = vi - s3 * (1.f / 64.f);
        const float var = wave_sum(d * d) * (1.f / 64.f);
        const float r1 = rsqrtf(s1 * (1.f / 256.f) + EPS), r2 = rsqrtf(s2 * (1.f / 128.f) + EPS);
        vq = vq * r1 * gq;
        { u32x2 w; w.x = pk2(vq.x, vq.y); w.y = pk2(vq.z, vq.w); *(u32x2*)((bf16*)(ws + WS_CQN) + (size_t)r * 256 + 4 * lane) = w; }
        *(unsigned*)((bf16*)(ws + WS_KV) + (size_t)r * 128 + 2 * lane) = pk2(vk.x * r2 * gk.x, vk.y * r2 * gk.y);
        ((bf16*)(ws + WS_KI))[(size_t)r * 64 + lane] = (bf16)f2bf(d * rsqrtf(var + EPS) * lg + lb);
        if (lane < 8) ((float*)(ws + WS_WI))[(size_t)r * 8 + lane] = vw * 0.35355339059327373f;
    }
}
__device__ __forceinline__ void p2_chunks(ArgsP a, LAS unsigned char* lds, int l, int gw, int ngw, int wave, int lane) {
    unsigned char* ws = a->ws;
    const bf16* Z = (const bf16*)(ws + WS_Z);
    float* DDp = (float*)(ws + WS_DD);
    LAS float* stg = (LAS float*)(lds + wave * 5120);
    for (int it = gw; it < 257 * 8; it += ngw) {
        const int cid = it >> 3, mx = (it >> 2) & 1, h = it & 3;
        const int nrows = cid == 256 ? NMETA : 64, rbase = cid == 256 ? MR : cid * 64;
        const int k0 = 2 * lane;
        const float* ZFr = (const float*)(ws + WS_ZF);
        const int rl = rbase + (lane < nrows ? lane : 0);
        if (!mx) {
            { const float* zf = ZFr + (size_t)rl * ZFW + ZF_A;
              const f32x4 a0 = *(const f32x4*)zf, a1 = *(const f32x4*)(zf + 4), a2 = *(const f32x4*)(zf + 8), a3 = *(const f32x4*)(zf + 12);
              *(LAS f32x4*)(stg + lane * 16) = a0; *(LAS f32x4*)(stg + lane * 16 + 4) = a1; *(LAS f32x4*)(stg + lane * 16 + 8) = a2; *(LAS f32x4*)(stg + lane * 16 + 12) = a3; }
            float w0[16], w1[16];
#pragma unroll
            for (int j = 0; j < 16; ++j) { const f32x2 w = *(const f32x2*)(a->in[I_WA2] + (size_t)(l * 16 + j) * 512 + h * 128 + k0); w0[j] = w.x; w1[j] = w.y; }
            const f32x2 bb = *(const f32x2*)(a->in[I_BA] + l * 512 + h * 128 + k0);
            bf16* QG = (bf16*)(ws + WS_G);
            float G0 = 0.f, G1 = 0.f;
            unsigned pq[16], pk[16];
#define P2G_LOAD(t0) do { _Pragma("unroll") for (int i = 0; i < 16; ++i) { const int r_ = rbase + (t0) + i; \
                pq[i] = *(const unsigned*)(Z + (size_t)r_ * ZB + ZC_GQ + h * 128 + k0); pk[i] = *(const unsigned*)(Z + (size_t)r_ * ZB + ZC_GK + h * 128 + k0); } } while (0)
            P2G_LOAD(0);
            LDS_WAIT();
            for (int t0 = 0; t0 < nrows; t0 += 16) {
                unsigned cqw[16], ckw[16];
#pragma unroll
                for (int i = 0; i < 16; ++i) { cqw[i] = pq[i]; ckw[i] = pk[i]; }
                if (t0 + 16 < nrows) P2G_LOAD(t0 + 16);
#pragma unroll
                for (int i = 0; i < 16; ++i) {
                    const int r = rbase + t0 + i;
                    const LAS float* ar = stg + (t0 + i) * 16;
                    const f32x4 a0 = *(const LAS f32x4*)ar, a1 = *(const LAS f32x4*)(ar + 4), a2 = *(const LAS f32x4*)(ar + 8), a3 = *(const LAS f32x4*)(ar + 12);
                    const float av[16] = {a0.x, a0.y, a0.z, a0.w, a1.x, a1.y, a1.z, a1.w, a2.x, a2.y, a2.z, a2.w, a3.x, a3.y, a3.z, a3.w};
                    float s0 = bb.x, s1 = bb.y;
#pragma unroll
                    for (int j = 0; j < 16; ++j) { s0 += av[j] * w0[j]; s1 += av[j] * w1[j]; }
                    G0 += logsigmoid_f(s0) * 0.0625f; G1 += logsigmoid_f(s1) * 0.0625f;
                    const float e0 = __expf(G0), e1 = __expf(G1), i0 = __builtin_amdgcn_rcpf(e0), i1 = __builtin_amdgcn_rcpf(e1);
                    *(unsigned*)(QG + (size_t)r * 1024 + h * 128 + k0) = pk2(bflo(cqw[i]) * e0, bfhi(cqw[i]) * e1);
                    *(unsigned*)(QG + (size_t)r * 1024 + 512 + h * 128 + k0) = pk2(bflo(ckw[i]) * i0, bfhi(ckw[i]) * i1);
                }
            }
#undef P2G_LOAD
            *(f32x2*)(DDp + ((size_t)cid * 4 + h) * 128 + k0) = (f32x2){__expf(G0), __expf(G1)};
            LDS_WAIT();
        } else {
            { const float* zf = ZFr + (size_t)rl * ZFW; stg[lane * 2] = zf[ZF_MI + h]; stg[lane * 2 + 1] = zf[ZF_MF + h]; }
            float cq[4][2], ck[4][2];
#pragma unroll
            for (int tap = 0; tap < 4; ++tap) { const f32x2 wq = *(const f32x2*)(a->in[I_CONV] + (size_t)(l * 4 + tap) * 1024 + h * 128 + k0), wk = *(const f32x2*)(a->in[I_CONV] + (size_t)(l * 4 + tap) * 1024 + 512 + h * 128 + k0);
                cq[tap][0] = wq.x; cq[tap][1] = wq.y; ck[tap][0] = wk.x; ck[tap][1] = wk.y; }
            const float fb = a->in[I_FB][l * 4 + h];
            bf16* QM = (bf16*)(ws + WS_QKC);
            float xq[3][2], xk[3][2];
#pragma unroll
            for (int j = 0; j < 3; ++j) {
                const int rp = prow(rbase, j + 1);
                const int rpc = rp >= 0 ? rp : rbase; const float m = rp >= 0 ? 1.f : 0.f;
                const unsigned qw = *(const unsigned*)(Z + (size_t)rpc * ZB + ZC_MQ + h * 128 + k0), kw = *(const unsigned*)(Z + (size_t)rpc * ZB + ZC_MK + h * 128 + k0);
                xq[j][0] = bflo(qw) * m; xq[j][1] = bfhi(qw) * m; xk[j][0] = bflo(kw) * m; xk[j][1] = bfhi(kw) * m;
            }
            float bsum = 0.f;
            unsigned pq[16], pk[16];
#define P2M_LOAD(t0) do { _Pragma("unroll") for (int i = 0; i < 16; ++i) { const int r_ = rbase + (t0) + i; \
                pq[i] = *(const unsigned*)(Z + (size_t)r_ * ZB + ZC_MQ + h * 128 + k0); pk[i] = *(const unsigned*)(Z + (size_t)r_ * ZB + ZC_MK + h * 128 + k0); } } while (0)
            P2M_LOAD(0);
            LDS_WAIT();
            for (int t0 = 0; t0 < nrows; t0 += 16) {
                unsigned cqw[16], ckw[16];
#pragma unroll
                for (int i = 0; i < 16; ++i) { cqw[i] = pq[i]; ckw[i] = pk[i]; }
                if (t0 + 16 < nrows) P2M_LOAD(t0 + 16);
#pragma unroll
                for (int i = 0; i < 16; ++i) {
                    const int r = rbase + t0 + i;
                    const f32x2 gt = *(const LAS f32x2*)(stg + (t0 + i) * 2);
                    const float li = gt.x, lf = logsigmoid_f(gt.y + fb);
                    bsum += lf;
                    const float q0 = bflo(cqw[i]), q1 = bfhi(cqw[i]), kk0 = bflo(ckw[i]), kk1 = bfhi(ckw[i]);
                    const float yq0 = cq[3][0] * q0 + cq[2][0] * xq[0][0] + cq[1][0] * xq[1][0] + cq[0][0] * xq[2][0];
                    const float yq1 = cq[3][1] * q1 + cq[2][1] * xq[0][1] + cq[1][1] * xq[1][1] + cq[0][1] * xq[2][1];
                    const float yk0 = ck[3][0] * kk0 + ck[2][0] * xk[0][0] + ck[1][0] * xk[1][0] + ck[0][0] * xk[2][0];
                    const float yk1 = ck[3][1] * kk1 + ck[2][1] * xk[0][1] + ck[1][1] * xk[1][1] + ck[0][1] * xk[2][1];
                    xq[2][0] = xq[1][0]; xq[2][1] = xq[1][1]; xq[1][0] = xq[0][0]; xq[1][1] = xq[0][1]; xq[0][0] = q0; xq[0][1] = q1;
                    xk[2][0] = xk[1][0]; xk[2][1] = xk[1][1]; xk[1][0] = xk[0][0]; xk[1][1] = xk[0][1]; xk[0][0] = kk0; xk[0][1] = kk1;
                    const float eq = __expf(bsum) * 0.08838834764831845f, ek = __expf(li - bsum);
                    *(unsigned*)(QM + (size_t)r * 1024 + h * 128 + k0) = pk2(silu_f(yq0) * eq, silu_f(yq1) * eq);
                    *(unsigned*)(QM + (size_t)r * 1024 + 512 + h * 128 + k0) = pk2(silu_f(yk0) * ek, silu_f(yk1) * ek);
                }
            }
#undef P2M_LOAD
            const float dd = __expf(bsum);
            *(f32x2*)(DDp + ((size_t)(257 + cid) * 4 + h) * 128 + k0) = (f32x2){dd, dd};
            LDS_WAIT();
        }
    }
}

constexpr int SC_QS = 272, SC_VS = 144;
constexpr int SC_QT = 0, SC_KT = 2 * 17408, SC_VT = 4 * 17408, SC_AT = SC_VT + 2 * 9216, SC_SB = SC_AT + 9216, SC_DD = SC_SB + 2 * 18432, SC_NB = SC_DD + 1024, SC_END = SC_NB + 512;
static_assert(SC_END <= RING_BYTES, "scan LDS");
__device__ __forceinline__ bf16x8 tr8(LAS unsigned char* base, int stride, int row0, int col0, int lane) {
    const int fq = lane >> 4, q4 = (lane & 15) >> 2, p4 = lane & 3;
    LAS unsigned char* p = base + (row0 + 8 * fq + q4) * stride + (col0 + 4 * p4) * 2;
    const s16x4 lo = __builtin_amdgcn_ds_read_tr16_b64_v4i16((LAS s16x4*)p);
    const s16x4 hi = __builtin_amdgcn_ds_read_tr16_b64_v4i16((LAS s16x4*)(p + 4 * stride));
    return __builtin_shufflevector(lo, hi, 0, 1, 2, 3, 4, 5, 6, 7);
}
template <bool ML>
__device__ __forceinline__ void scan_unit(ArgsP a, LAS unsigned char* lds, int b, int h, int vs, int tid_in) {
    int tid = tid_in; asm volatile("" : "+v"(tid));
    unsigned char* ws = a->ws;
    const bf16* Z = (const bf16*)(ws + WS_Z);
    const bf16* QK = (const bf16*)(ws + (ML ? WS_QKC : WS_G));
    const float* DDp = (const float*)(ws + WS_DD) + (ML ? (size_t)257 * 512 : 0);
    bf16* O = (bf16*)(ws + (ML ? WS_OM : WS_OG));
    const int lane = tid & 63, wave = __builtin_amdgcn_readfirstlane(tid >> 6), fr = lane & 15, fq = lane >> 4;
    const int vt = wave & 3, hh = wave >> 2;
    for (int i = tid; i < (2 * 18432 + 1024 + 512) / 4; i += 512) ((LAS unsigned*)(lds + SC_SB))[i] = 0u;
    f32x4 S[4], nacc[4];
#pragma unroll
    for (int i = 0; i < 4; ++i) { S[i] = (f32x4){0.f, 0.f, 0.f, 0.f}; nacc[i] = (f32x4){0.f, 0.f, 0.f, 0.f}; }
    const bf16x8 ones = {(short)0x3F80, (short)0x3F80, (short)0x3F80, (short)0x3F80, (short)0x3F80, (short)0x3F80, (short)0x3F80, (short)0x3F80};
    u32x4 gq[2], gk[2], gv; float gd = 0.f;
    const int vcol = (ML ? ZC_MV : ZC_GV) + h * 256 + vs * 64;
    const bf16* zpage = (const bf16*)(ws + WS_CTL + 512 * 1024);
#define SCAN_LOAD(c) do { const int c_ = (c); \
        _Pragma("unroll") for (int e = 0; e < 2; ++e) { const int pid = tid + 512 * e, t = pid >> 4, ch = pid & 15; \
            const bool ok = c_ > 0 || t >= 48; const int row = c_ == 0 ? MR + t - 48 : b * SEQ + (c_ - 1) * 64 + t; \
            const bf16* qp_ = ok ? QK + (size_t)row * 1024 + h * 128 + ch * 8 : zpage; \
            gq[e] = *(const u32x4*)qp_; gk[e] = *(const u32x4*)(qp_ + 512); } \
        { const int t = tid >> 3, ch = tid & 7; const bool ok = c_ > 0 || t >= 48; const int row = c_ == 0 ? MR + t - 48 : b * SEQ + (c_ - 1) * 64 + t; \
          gv = *(const u32x4*)(ok ? Z + (size_t)row * ZB + vcol + ch * 8 : zpage); } \
        { const int cid = c_ == 0 ? 256 : b * 32 + (c_ - 1); gd = DDp[((size_t)cid * 4 + h) * 128 + (tid & 127)]; } } while (0)
#define SCAN_STORE(buf) do { const int bo_ = (buf); \
        _Pragma("unroll") for (int e = 0; e < 2; ++e) { const int pid = tid + 512 * e, t = pid >> 4, ch = pid & 15; \
            *(LAS u32x4*)(lds + SC_QT + bo_ * 17408 + t * SC_QS + ch * 16) = gq[e]; *(LAS u32x4*)(lds + SC_KT + bo_ * 17408 + t * SC_QS + ch * 16) = gk[e]; } \
        { const int t = tid >> 3, ch = tid & 7; *(LAS u32x4*)(lds + SC_VT + bo_ * 9216 + t * SC_VS + ch * 16) = gv; } \
        if (tid < 128) ((LAS float*)(lds + SC_DD))[bo_ * 128 + tid] = gd; } while (0)
    SCAN_LOAD(0);
    __syncthreads();
    SCAN_STORE(0);
    __syncthreads();
    for (int c = 0; c < 33; ++c) {
        const int buf = c & 1;
        LAS unsigned char* QT = lds + SC_QT + buf * 17408; LAS unsigned char* KT = lds + SC_KT + buf * 17408; LAS unsigned char* VT = lds + SC_VT + buf * 9216;
        LAS unsigned char* AT = lds + SC_AT; LAS unsigned char* SB = lds + SC_SB + buf * 18432; LAS unsigned char* SBn = lds + SC_SB + (buf ^ 1) * 18432;
        const LAS float* ddL = (const LAS float*)(lds + SC_DD) + buf * 128;
        if (c + 1 < 33) SCAN_LOAD(c + 1);
        {
            const int ti = wave >> 1;
#pragma unroll
            for (int sj = 0; sj < 2; ++sj) {
                const int si = 2 * (wave & 1) + sj;
                f32x4 acc = {0.f, 0.f, 0.f, 0.f};
                bf16x8 qa[4], kb[4];
#pragma unroll
                for (int ks = 0; ks < 4; ++ks) { qa[ks] = *(const LAS bf16x8*)(QT + (16 * ti + fr) * SC_QS + (32 * ks + 8 * fq) * 2); kb[ks] = *(const LAS bf16x8*)(KT + (16 * si + fr) * SC_QS + (32 * ks + 8 * fq) * 2); }
                asm volatile("" ::: "memory");
#pragma unroll
                for (int ks = 0; ks < 4; ++ks) acc = __builtin_amdgcn_mfma_f32_16x16x32_bf16(qa[ks], kb[ks], acc, 0, 0, 0);
                const int sg = 16 * si + fr, tg = 16 * ti + 4 * fq;
                LAS bf16* ap = (LAS bf16*)(AT + tg * SC_VS) + sg;
                ap[0 * (SC_VS / 2)] = (bf16)(sg <= tg + 0 ? f2bf(acc.x) : 0u);
                ap[1 * (SC_VS / 2)] = (bf16)(sg <= tg + 1 ? f2bf(acc.y) : 0u);
                ap[2 * (SC_VS / 2)] = (bf16)(sg <= tg + 2 ? f2bf(acc.z) : 0u);
                ap[3 * (SC_VS / 2)] = (bf16)(sg <= tg + 3 ? f2bf(acc.w) : 0u);
            }
        }
        {
            const bf16x8 vb0 = tr8(VT, SC_VS, 0, 16 * vt, lane), vb1 = tr8(VT, SC_VS, 32, 16 * vt, lane);
#pragma unroll
            for (int i = 0; i < 4; ++i) {
                const int kt = 4 * hh + i;
                const bf16x8 ka0 = tr8(KT, SC_QS, 0, 16 * kt, lane), ka1 = tr8(KT, SC_QS, 32, 16 * kt, lane);
                f32x4 acc = S[i];
                acc = __builtin_amdgcn_mfma_f32_16x16x32_bf16(ka0, vb0, acc, 0, 0, 0);
                acc = __builtin_amdgcn_mfma_f32_16x16x32_bf16(ka1, vb1, acc, 0, 0, 0);
                const f32x4 dv = *(const LAS f32x4*)(ddL + 16 * kt + 4 * fq);
                S[i] = acc * dv;
                if (ML) {
                    f32x4 na = nacc[i];
                    na = __builtin_amdgcn_mfma_f32_16x16x32_bf16(ka0, ones, na, 0, 0, 0);
                    na = __builtin_amdgcn_mfma_f32_16x16x32_bf16(ka1, ones, na, 0, 0, 0);
                    nacc[i] = na * dv;
                }
            }
        }
        {
#pragma unroll
            for (int i = 0; i < 4; ++i) {
                const int k0 = 16 * (4 * hh + i) + 4 * fq;
                LAS bf16* sp = (LAS bf16*)(SBn + k0 * SC_VS) + 16 * vt + fr;
                sp[0 * (SC_VS / 2)] = (bf16)f2bf(S[i].x); sp[1 * (SC_VS / 2)] = (bf16)f2bf(S[i].y); sp[2 * (SC_VS / 2)] = (bf16)f2bf(S[i].z); sp[3 * (SC_VS / 2)] = (bf16)f2bf(S[i].w);
                if (ML && vt == 0 && fr == 0) { LAS bf16* np = (LAS bf16*)(lds + SC_NB + (buf ^ 1) * 256) + k0; np[0] = (bf16)f2bf(nacc[i].x); np[1] = (bf16)f2bf(nacc[i].y); np[2] = (bf16)f2bf(nacc[i].z); np[3] = (bf16)f2bf(nacc[i].w); }
            }
        }
        LDS_BARRIER();
#if defined(DIAG_SEL)
        if (blockIdx.x == 0 && tid == 0) { volatile LAS unsigned* M_ = (volatile LAS unsigned*)(lds + MISC_OFF); const unsigned now_ = (unsigned)__builtin_amdgcn_s_memrealtime(); M_[16 + 12] += now_ - M_[15]; M_[15] = now_; }
#endif
        {
            const bf16x8 vb0 = tr8(VT, SC_VS, 0, 16 * vt, lane), vb1 = tr8(VT, SC_VS, 32, 16 * vt, lane);
            bf16x8 sb[4];
#pragma unroll
            for (int ks = 0; ks < 4; ++ks) sb[ks] = tr8(SB, SC_VS, 32 * ks, 16 * vt, lane);
            bf16x8 nb[4];
            if (ML) {
#pragma unroll
                for (int ks = 0; ks < 4; ++ks) nb[ks] = *(const LAS bf16x8*)(lds + SC_NB + buf * 256 + (32 * ks + 8 * fq) * 2);
            }
            u32x2 ow[2];
#pragma unroll
            for (int tj = 0; tj < 2; ++tj) {
                const int ti = 2 * hh + tj;
                f32x4 acc = {0.f, 0.f, 0.f, 0.f}, den = {0.f, 0.f, 0.f, 0.f};
                bf16x8 qa[4];
#pragma unroll
                for (int ks = 0; ks < 4; ++ks) qa[ks] = *(const LAS bf16x8*)(QT + (16 * ti + fr) * SC_QS + (32 * ks + 8 * fq) * 2);
                const bf16x8 aa0 = *(const LAS bf16x8*)(AT + (16 * ti + fr) * SC_VS + (8 * fq) * 2), aa1 = *(const LAS bf16x8*)(AT + (16 * ti + fr) * SC_VS + (32 + 8 * fq) * 2);
                asm volatile("" ::: "memory");
#pragma unroll
                for (int ks = 0; ks < 4; ++ks) {
                    acc = __builtin_amdgcn_mfma_f32_16x16x32_bf16(sb[ks], qa[ks], acc, 0, 0, 0);
                    if (ML) den = __builtin_amdgcn_mfma_f32_16x16x32_bf16(nb[ks], qa[ks], den, 0, 0, 0);
                }
                acc = __builtin_amdgcn_mfma_f32_16x16x32_bf16(vb0, aa0, acc, 0, 0, 0);
                acc = __builtin_amdgcn_mfma_f32_16x16x32_bf16(vb1, aa1, acc, 0, 0, 0);
                if (ML) {
                    den = __builtin_amdgcn_mfma_f32_16x16x32_bf16(ones, aa0, den, 0, 0, 0);
                    den = __builtin_amdgcn_mfma_f32_16x16x32_bf16(ones, aa1, den, 0, 0, 0);
                    const float rd = __builtin_amdgcn_rcpf(fmaxf(fabsf(den.x), 1.f));
                    acc *= rd;
                }
                ow[tj].x = pk2(acc.x, acc.y); ow[tj].y = pk2(acc.z, acc.w);
            }
            if (c + 1 < 33) SCAN_STORE(buf ^ 1);
#pragma unroll
            for (int tj = 0; tj < 2; ++tj) {
                const int t = 16 * (2 * hh + tj) + fr;
                const bool okr = c > 0 || t >= 48;
                const int rowb = c == 0 ? MR + t - 48 : b * SEQ + (c - 1) * 64 + t;
                bf16* op = okr ? O + (size_t)rowb * 1024 + h * 256 + vs * 64 + 16 * vt + 4 * fq : (bf16*)(ws + WS_LIF) + (size_t)tid * 4;
                *(u32x2*)op = ow[tj];
            }
        }
        LDS_BARRIER();
#if defined(DIAG_SEL)
        if (blockIdx.x == 0 && tid == 0) { volatile LAS unsigned* M_ = (volatile LAS unsigned*)(lds + MISC_OFF); const unsigned now_ = (unsigned)__builtin_amdgcn_s_memrealtime(); M_[16 + 13] += now_ - M_[15]; M_[15] = now_; }
#endif
    }
#undef SCAN_LOAD
#undef SCAN_STORE
}

template <bool DRY = false>
__device__ __forceinline__ void p6_headnorm(ArgsP a, int l, int gw, int ngw, int lane) {
    unsigned char* ws = a->ws; const bf16* Z = (const bf16*)(ws + WS_Z);
    const f32x4 gg0 = *(const f32x4*)(a->in[I_GGLA] + l * 256 + 4 * lane), gg1 = *(const f32x4*)(a->in[I_GML] + l * 256 + 4 * lane);
    for (int it0 = gw * 4; it0 < MT * 8; it0 += ngw * 4) {
        u32x2 w[4], gw2[4]; bf16* op[4];
#pragma unroll
        for (int i = 0; i < 4; ++i) { const int it = it0 + i, r = it >> 3, mx = (it >> 2) & 1, h = it & 3;
            op[i] = (bf16*)(ws + (mx ? WS_OM : WS_OG)) + (size_t)r * 1024 + h * 256 + 4 * lane;
            w[i] = *(const u32x2*)op[i];
            gw2[i] = *(const u32x2*)(Z + (size_t)r * ZB + (mx ? ZC_MO : ZC_GR) + h * 256 + 4 * lane); }
        f32x4 v[4]; float ss[4];
#pragma unroll
        for (int i = 0; i < 4; ++i) { v[i] = (f32x4){bflo(w[i].x), bfhi(w[i].x), bflo(w[i].y), bfhi(w[i].y)}; ss[i] = (v[i].x * v[i].x + v[i].y * v[i].y) + (v[i].z * v[i].z + v[i].w * v[i].w); }
#pragma unroll
        for (int o = 1; o < 64; o <<= 1) {
#pragma unroll
            for (int i = 0; i < 4; ++i) ss[i] += __shfl_xor(ss[i], o);
        }
#pragma unroll
        for (int i = 0; i < 4; ++i) {
            const int mx = ((it0 + i) >> 2) & 1;
            const float rr = rsqrtf(ss[i] * (1.f / 256.f) + EPS);
            const f32x4 gt = {bflo(gw2[i].x), bfhi(gw2[i].x), bflo(gw2[i].y), bfhi(gw2[i].y)};
            const f32x4 o4 = v[i] * rr * (mx ? gg1 : gg0) * gt;
            u32x2 o; o.x = pk2(o4.x, o4.y); o.y = pk2(o4.z, o4.w);
            *(u32x2*)(DRY ? (bf16*)(ws + WS_XN) + ((size_t)((it0 + i) >> 3) * 1024 + ((it0 + i) & 3) * 256 + 4 * lane) : op[i]) = o;
        }
    }
}

__device__ __forceinline__ int krow(int b, int s) { return s < NMETA ? MR + s : b * SEQ + (s - NMETA); }
__device__ __forceinline__ int t5_bucket(int n) {
    if (n < 16) return n < 0 ? 0 : n;
    const int lg = 16 + (int)(__logf((float)n * (1.f / 16.f)) / 2.0794415416798357f * 16.f);
    return lg < 31 ? lg : 31;
}
__device__ __forceinline__ unsigned off_b(unsigned row, unsigned ch) { return 256u * row + 16u * (ch ^ (((row & 3) << 2) | ((row >> 2) & 3))); }
__device__ __forceinline__ s16x4 tr_rd(LAS unsigned char* p) { return __builtin_amdgcn_ds_read_tr16_b64_v4i16((LAS s16x4*)p); }

constexpr int DW2_STRIDE = 9472, DW2_TILE = 0, DW2_SEL = 8192, DW2_BK = 8832, DSA2_T5 = 8 * DW2_STRIDE, DSA2_BT = DSA2_T5 + 2048 + 64;

__device__ __forceinline__ int wave_sum_dpp(int x) {
    x += __builtin_amdgcn_update_dpp(0, x, 0xB1, 0xf, 0xf, false);
    x += __builtin_amdgcn_update_dpp(0, x, 0x4E, 0xf, 0xf, false);
    x += __builtin_amdgcn_update_dpp(0, x, 0x141, 0xf, 0xf, false);
    x += __builtin_amdgcn_update_dpp(0, x, 0x140, 0xf, 0xf, false);
    return __builtin_amdgcn_readlane(x, 0) + __builtin_amdgcn_readlane(x, 16) + __builtin_amdgcn_readlane(x, 32) + __builtin_amdgcn_readlane(x, 48);
}
__device__ __forceinline__ int wave_scan_dpp(int x) {
    x += __builtin_amdgcn_update_dpp(0, x, 0x111, 0xf, 0xf, false);
    x += __builtin_amdgcn_update_dpp(0, x, 0x112, 0xf, 0xf, false);
    x += __builtin_amdgcn_update_dpp(0, x, 0x114, 0xf, 0xf, false);
    x += __builtin_amdgcn_update_dpp(0, x, 0x118, 0xf, 0xf, false);
    x += __builtin_amdgcn_update_dpp(0, x, 0x142, 0xa, 0xf, false);
    x += __builtin_amdgcn_update_dpp(0, x, 0x143, 0xc, 0xf, false);
    return x;
}
#if defined(DIAG_SEL)
#ifndef DIAG_BLK
#define DIAG_BLK 31
#endif
#define DSTAMP(slot) do { if (blockIdx.x == DIAG_BLK && threadIdx.x == 0) { volatile LAS unsigned* M_ = (volatile LAS unsigned*)(lds + MISC_OFF); const unsigned now_ = (unsigned)__builtin_amdgcn_s_memrealtime(); M_[slot] += now_ - M_[14]; M_[14] = now_; } } while (0)
#else
#define DSTAMP(slot) do {} while (0)
#endif
template <bool DENSE_ONLY>
__device__ __forceinline__ void dsa_unit(ArgsP a, LAS unsigned char* lds, int b, int c, int nq, int wave, int lane_in) {
    int lane = lane_in; asm volatile("" : "+v"(lane));
    unsigned char* ws = a->ws;
    const bf16* QQ = (const bf16*)(ws + WS_QQ); const bf16* KI = (const bf16*)(ws + WS_KI); const bf16* KV = (const bf16*)(ws + WS_KV);
    unsigned* SC = (unsigned*)(ws + WS_SC) + (size_t)blockIdx.x * 64 * SC_PITCH;
    const int r0 = DENSE_ONLY ? MR : b * SEQ + 64 * c, p0 = DENSE_ONLY ? 0 : NMETA + 64 * c;
    const int fr = lane & 15, fq = lane >> 4;
    if (!DENSE_ONLY) {
        const int qt = wave & 3, kh = wave >> 2;
        if (p0 + 16 * qt + 15 >= 256) {
            const int qrow = r0 + 16 * qt + fr, pq = p0 + 16 * qt + fr;
            bf16x8 qf[8][2];
#pragma unroll
            for (int h = 0; h < 8; ++h)
#pragma unroll
                for (int ks = 0; ks < 2; ++ks) qf[h][ks] = *(const bf16x8*)(QQ + (size_t)qrow * NQQ + 2048 + h * 64 + ks * 32 + 8 * fq);
            float wi[8];
            { const f32x4 w0 = *(const f32x4*)((const float*)(ws + WS_WI) + (size_t)qrow * 8), w1 = *(const f32x4*)((const float*)(ws + WS_WI) + (size_t)qrow * 8 + 4);
              wi[0] = w0.x; wi[1] = w0.y; wi[2] = w0.z; wi[3] = w0.w; wi[4] = w1.x; wi[5] = w1.y; wi[6] = w1.z; wi[7] = w1.w; }
            const int nkt = 2 + 4 * c + qt;
            unsigned* scq = SC + (size_t)(16 * qt + fr) * SC_PITCH + 4 * fq;
            bf16x8 pa0[4], pa1[4];
#define DSA_KLOAD(kt0_) do { _Pragma("unroll") for (int j = 0; j < 4; ++j) { const int kt_ = (kt0_) + 2 * j < nkt ? (kt0_) + 2 * j : nkt - 1; \
                const bf16* kp_ = KI + (size_t)krow(b, 16 * kt_ + fr) * 64 + 8 * fq; pa0[j] = *(const bf16x8*)kp_; pa1[j] = *(const bf16x8*)(kp_ + 32); } } while (0)
            DSA_KLOAD(kh);
            for (int kt0 = kh; kt0 < nkt; kt0 += 8) {
                bf16x8 a0[4], a1[4];
#pragma unroll
                for (int j = 0; j < 4; ++j) { a0[j] = pa0[j]; a1[j] = pa1[j]; }
                if (kt0 + 8 < nkt) DSA_KLOAD(kt0 + 8);
#pragma unroll
                for (int j = 0; j < 4; ++j) {
                    const int kt = kt0 + 2 * j;
                    float s0 = 0.f, s1 = 0.f, s2 = 0.f, s3 = 0.f;
#pragma unroll
                    for (int h = 0; h < 8; ++h) {
                        f32x4 acc = {0.f, 0.f, 0.f, 0.f};
                        acc = __builtin_amdgcn_mfma_f32_16x16x32_bf16(a0[j], qf[h][0], acc, 0, 0, 0);
                        acc = __builtin_amdgcn_mfma_f32_16x16x32_bf16(a1[j], qf[h][1], acc, 0, 0, 0);
                        s0 += wi[h] * fmaxf(acc.x, 0.f); s1 += wi[h] * fmaxf(acc.y, 0.f); s2 += wi[h] * fmaxf(acc.z, 0.f); s3 += wi[h] * fmaxf(acc.w, 0.f);
                    }
                    const int kb = 16 * kt + 4 * fq;
                    u32x4 o;
                    { const unsigned bits = __builtin_bit_cast(unsigned, s0); o.x = (kb + 0) <= pq ? (bits ^ ((bits >> 31) ? 0xffffffffu : 0x80000000u)) : 0u; }
                    { const unsigned bits = __builtin_bit_cast(unsigned, s1); o.y = (kb + 1) <= pq ? (bits ^ ((bits >> 31) ? 0xffffffffu : 0x80000000u)) : 0u; }
                    { const unsigned bits = __builtin_bit_cast(unsigned, s2); o.z = (kb + 2) <= pq ? (bits ^ ((bits >> 31) ? 0xffffffffu : 0x80000000u)) : 0u; }
                    { const unsigned bits = __builtin_bit_cast(unsigned, s3); o.w = (kb + 3) <= pq ? (bits ^ ((bits >> 31) ? 0xffffffffu : 0x80000000u)) : 0u; }
                    if (kt < nkt) *(u32x4*)(scq + 16 * kt) = o;
                }
            }
#undef DSA_KLOAD
        }
        VM_WAIT();
        __syncthreads();
        DSTAMP(24);
    }
    LAS unsigned char* wl = lds + wave * DW2_STRIDE;
    LAS unsigned char* tile = wl + DW2_TILE;
    LAS unsigned short* selL = (LAS unsigned short*)(wl + DW2_SEL);
    LAS unsigned short* bkL = (LAS unsigned short*)(wl + DW2_BK);
    const LAS float* t5L = (const LAS float*)(lds + DSA2_T5);
    const LAS unsigned short* bkT = (const LAS unsigned short*)(lds + DSA2_BT);
    const int nqw = DENSE_ONLY ? 2 : 8;
    unsigned u[33];
#define DSA_ULOAD(iq_) do { const int nk_ = p0 + (iq_) + 1; const unsigned* scr_ = SC + (size_t)(iq_) * SC_PITCH; \
        _Pragma("unroll") for (int i = 0; i < 33; ++i) { const int s = lane + 64 * i; u[i] = s < nk_ ? __hip_atomic_load(scr_ + s, __ATOMIC_RELAXED, __HIP_MEMORY_SCOPE_AGENT) : 0u; } } while (0)
    for (int qi_ = 0; qi_ < nqw; ++qi_) {
        asm volatile("" : "+v"(lane));
        const int iq = wave * nqw + qi_;
        if (iq >= nq) break;
        const int p = p0 + iq, nk = p + 1, qrow = r0 + iq;
        int nsel;
        if (!DENSE_ONLY && nk > 256) {
            DSA_ULOAD(iq);
            unsigned tau = 0u;
            for (int bit = 31; bit >= 16; --bit) {
                const unsigned cand = tau | (1u << bit);
                int cnt = 0;
#pragma unroll
                for (int i = 0; i < 33; ++i) cnt += (u[i] >= cand) ? 1 : 0;
                if (wave_sum_dpp(cnt) >= 256) tau = cand;
            }
            DSTAMP(16);
            {
                const unsigned hi = tau >> 16;
                int cab = 0, cc = 0;
#pragma unroll
                for (int i = 0; i < 33; ++i) { const unsigned uh = u[i] >> 16; cab += (uh > hi) ? 1 : 0; cc += (uh == hi) ? 1 : 0; }
                cab = wave_sum_dpp(cab);
                const int cin = wave_scan_dpp(cc);
                const int ncand = __builtin_amdgcn_readlane(cin, 63);
                LAS unsigned short* candL = (LAS unsigned short*)tile;
                int off = cin - cc;
#pragma unroll
                for (int i = 0; i < 33; ++i) { const bool is = (u[i] >> 16) == hi; candL[is ? off : 3072 + lane] = (unsigned short)(u[i] & 0xffffu); off += is ? 1 : 0; }
                LDS_WAIT();
                const int need = 256 - cab;
                unsigned lo = 0u;
                if (ncand <= 64) {
                    const unsigned v = lane < ncand ? (unsigned)candL[lane] + 1u : 0u;
                    for (int bit = 15; bit >= 0; --bit) { const unsigned cand = lo | (1u << bit); if (__popcll(__ballot(v >= cand + 1u)) >= need) lo = cand; }
                } else {
                    for (int bit = 15; bit >= 0; --bit) {
                        const unsigned cand = lo | (1u << bit); int cnt = 0;
                        for (int j = lane; j < ((ncand + 63) & ~63); j += 64) { const unsigned v = j < ncand ? (unsigned)candL[j] + 1u : 0u; cnt += __popcll(__ballot(v >= cand + 1u)); }
                        if (cnt >= need) lo = cand;
                    }
                }
                tau |= lo;
                LDS_WAIT();
            }
            DSTAMP(17);
            unsigned short bkv[33];
#pragma unroll
            for (int i = 0; i < 33; ++i) { const int d = p - (lane + 64 * i); bkv[i] = bkT[d > 0 ? d : 0]; }
            int cge = 0, ceq = 0;
#pragma unroll
            for (int i = 0; i < 33; ++i) { cge += (u[i] >= tau) ? 1 : 0; ceq += (u[i] == tau) ? 1 : 0; }
            const int tge = wave_sum_dpp(cge);
            if (tge == 256) {
                const int cin = wave_scan_dpp(cge);
                int off = cin - cge;
#pragma unroll
                for (int i = 0; i < 33; ++i) { const bool take = u[i] >= tau; const int pos = take ? off : 256 + lane;
                    selL[pos] = (unsigned short)(lane + 64 * i); bkL[pos] = bkv[i]; off += take ? 1 : 0; }
            } else {
                const int rem = 256 - (tge - wave_sum_dpp(ceq));
                const unsigned long long lt = (1ull << lane) - 1ull;
                int base = 0, eqseen = 0;
#pragma unroll
                for (int i = 0; i < 33; ++i) {
                    const bool gt = u[i] > tau, eq = u[i] == tau;
                    const unsigned long long meq = __ballot(eq);
                    const bool take = gt || (eq && (eqseen + __popcll(meq & lt)) < rem);
                    const unsigned long long mt = __ballot(take);
                    const int pos = take ? base + __popcll(mt & lt) : 256 + lane;
                    selL[pos] = (unsigned short)(lane + 64 * i); bkL[pos] = bkv[i];
                    base += __popcll(mt); eqseen += __popcll(meq);
                }
            }
            nsel = 256;
        } else {
#pragma unroll
            for (int m = 0; m < 4; ++m) { const int s = lane + 64 * m; selL[s] = (unsigned short)(s < nk ? s : 0); bkL[s] = bkT[s < nk ? p - s : 0]; }
            nsel = nk;
        }
        DSTAMP(25);
        asm volatile("" : "+v"(lane));
        bf16x8 qB[4];
#pragma unroll
        for (int ks = 0; ks < 4; ++ks) qB[ks] = *(const bf16x8*)(QQ + (size_t)qrow * NQQ + fr * 128 + ks * 32 + 8 * fq);
        LDS_WAIT();
        f32x4 O[8];
#pragma unroll
        for (int nt = 0; nt < 8; ++nt) O[nt] = (f32x4){0.f, 0.f, 0.f, 0.f};
        float qss = 0.f;
#pragma unroll
        for (int ks = 0; ks < 4; ++ks) { const u32x4 w = __builtin_bit_cast(u32x4, qB[ks]);
            qss += (bflo(w.x) * bflo(w.x) + bfhi(w.x) * bfhi(w.x)) + (bflo(w.y) * bflo(w.y) + bfhi(w.y) * bfhi(w.y)) + (bflo(w.z) * bflo(w.z) + bfhi(w.z) * bfhi(w.z)) + (bflo(w.w) * bflo(w.w) + bfhi(w.w) * bfhi(w.w)); }
        qss += __shfl_xor(qss, 16); qss += __shfl_xor(qss, 32);
        const float mb = sqrtf(qss) * t5L[512] + t5L[513];
        float lrun = 0.f;
        const int nblk = (nsel + 31) >> 5;
#define DSA_GATHER(GV, blk_) do { _Pragma("unroll") for (int e = 0; e < 8; ++e) { const int pid = lane + 64 * e, ri = pid >> 4, ch = pid & 15, j = 32 * (blk_) + ri; \
            const int key = (int)selL[j]; GV[e] = *(const u32x4*)(KV + (size_t)krow(b, key) * 128 + ch * 8); } } while (0)
#define DSA_PUT(GV) do { _Pragma("unroll") for (int e = 0; e < 8; ++e) { const int pid = lane + 64 * e, ri = pid >> 4, ch = pid & 15; *(LAS u32x4*)(tile + off_b(ri, ch)) = GV[e]; } } while (0)
        u32x4 gvA[8], gvB[8];
        DSA_GATHER(gvA, 0);
        if (nblk > 1) DSA_GATHER(gvB, 1);
        for (int blk0 = 0; blk0 < nblk; blk0 += 2) {
#pragma unroll
            for (int half = 0; half < 2; ++half) {
                const int blk = blk0 + half;
                if (blk < nblk) {
                    if (half == 0) { DSA_PUT(gvA); if (blk + 2 < nblk) DSA_GATHER(gvA, blk + 2); }
                    else { DSA_PUT(gvB); if (blk + 2 < nblk) DSA_GATHER(gvB, blk + 2); }
                    LDS_WAIT();
                    f32x4 s0 = {0.f, 0.f, 0.f, 0.f}, s1 = {0.f, 0.f, 0.f, 0.f};
        #pragma unroll
                    for (int ks = 0; ks < 4; ++ks) {
                        const bf16x8 k0 = *(const LAS bf16x8*)(tile + off_b(fr, 4 * ks + fq)), k1 = *(const LAS bf16x8*)(tile + off_b(16 + fr, 4 * ks + fq));
                        s0 = __builtin_amdgcn_mfma_f32_16x16x32_bf16(k0, qB[ks], s0, 0, 0, 0);
                        s1 = __builtin_amdgcn_mfma_f32_16x16x32_bf16(k1, qB[ks], s1, 0, 0, 0);
                    }
                    const int j0 = 32 * blk + 4 * fq;
                    const u32x2 b0 = *(const LAS u32x2*)(bkL + j0), b1 = *(const LAS u32x2*)(bkL + j0 + 16);
                    const float t00 = t5L[(b0.x & 0xffffu) + fr], t01 = t5L[(b0.x >> 16) + fr], t02 = t5L[(b0.y & 0xffffu) + fr], t03 = t5L[(b0.y >> 16) + fr];
                    const float t10 = t5L[(b1.x & 0xffffu) + fr], t11 = t5L[(b1.x >> 16) + fr], t12 = t5L[(b1.y & 0xffffu) + fr], t13 = t5L[(b1.y >> 16) + fr];
                    const float e00 = __expf(s0.x + t00 - mb), e01 = __expf(s0.y + t01 - mb), e02 = __expf(s0.z + t02 - mb), e03 = __expf(s0.w + t03 - mb);
                    const float e10 = __expf(s1.x + t10 - mb), e11 = __expf(s1.y + t11 - mb), e12 = __expf(s1.z + t12 - mb), e13 = __expf(s1.w + t13 - mb);
                    const float p00 = (j0 + 0) < nsel ? e00 : 0.f, p01 = (j0 + 1) < nsel ? e01 : 0.f, p02 = (j0 + 2) < nsel ? e02 : 0.f, p03 = (j0 + 3) < nsel ? e03 : 0.f;
                    const float p10 = (j0 + 16) < nsel ? e10 : 0.f, p11 = (j0 + 17) < nsel ? e11 : 0.f, p12 = (j0 + 18) < nsel ? e12 : 0.f, p13 = (j0 + 19) < nsel ? e13 : 0.f;
                    lrun += ((p00 + p01) + (p02 + p03)) + ((p10 + p11) + (p12 + p13));
                    u32x4 pw; pw.x = pk2(p00, p01); pw.y = pk2(p02, p03); pw.z = pk2(p10, p11); pw.w = pk2(p12, p13);
                    const bf16x8 pa = __builtin_bit_cast(bf16x8, pw);
                    const unsigned q4 = (unsigned)(fr >> 2), p4 = (unsigned)(lane & 3);
        #pragma unroll
                    for (int nt = 0; nt < 8; ++nt) {
                        const s16x4 vlo = tr_rd(tile + off_b(4 * fq + q4, 2 * nt + (p4 >> 1)) + 8 * (p4 & 1));
                        const s16x4 vhi = tr_rd(tile + off_b(16 + 4 * fq + q4, 2 * nt + (p4 >> 1)) + 8 * (p4 & 1));
                        const bf16x8 vb = __builtin_shufflevector(vlo, vhi, 0, 1, 2, 3, 4, 5, 6, 7);
                        O[nt] = __builtin_amdgcn_mfma_f32_16x16x32_bf16(pa, vb, O[nt], 0, 0, 0);
                    }

                }
            }
        }
#undef DSA_GATHER
#undef DSA_PUT
        float lt2 = lrun + __shfl_xor(lrun, 16); lt2 += __shfl_xor(lt2, 32);
        const float inv = 1.f / lt2;
        float ir[4];
#pragma unroll
        for (int r = 0; r < 4; ++r) ir[r] = __shfl(inv, 4 * fq + r);
        bf16* od = (bf16*)(ws + WS_OD) + (size_t)qrow * 1024 + fr;
#pragma unroll
        for (int nt = 0; nt < 8; ++nt)
#pragma unroll
            for (int r = 0; r < 4; ++r) { const int hd = 4 * fq + r; od[(size_t)(hd >> 3) * MT * 1024 + (hd & 7) * 128 + 16 * nt] = (bf16)f2bf(O[nt][r] * ir[r]); }
        LDS_WAIT();
        DSTAMP(26);
    }
}
__device__ __forceinline__ void p5_dsa(ArgsP a, LAS unsigned char* lds, int l, int tid, int wave, int lane) {
    LAS float* t5L = (LAS float*)(lds + DSA2_T5);
    __syncthreads();
    t5L[tid] = a->in[I_T5][tid];
    for (int n = tid; n < TT; n += 512) ((LAS unsigned short*)(lds + DSA2_BT))[n] = (unsigned short)(t5_bucket(n) * 16);
    if (tid < 64) {
        const float g0 = fabsf(a->in[I_GDKV][l * 128 + tid]), g1 = fabsf(a->in[I_GDKV][l * 128 + 64 + tid]);
        const float gm = wave_max(fmaxf(g0, g1));
        float tm = 0.f;
#pragma unroll
        for (int i = 0; i < 8; ++i) tm = fmaxf(tm, fabsf(a->in[I_T5][tid + 64 * i]));
        tm = wave_max(tm);
        if (tid == 0) { t5L[512] = 11.313708498984761f * gm; t5L[513] = tm; }
    }
    __syncthreads();
    for (int u = blockIdx.x; u < 256; u += gridDim.x) {
        dsa_unit<false>(a, lds, u >> 5, u & 31, 64, wave, lane);
        __syncthreads();
    }
    if (blockIdx.x == 0) dsa_unit<true>(a, lds, 0, 0, 16, wave, lane);
}

__global__ void __launch_bounds__(NWAVES * 64, 2) fwd(Args a_) {
    extern __shared__ __attribute__((aligned(16))) unsigned char lds_raw[];
    LAS unsigned char* lds = (LAS unsigned char*)lds_raw;
    volatile LAS unsigned* MISC = (volatile LAS unsigned*)(lds + MISC_OFF);
    if (threadIdx.x < 32) MISC[threadIdx.x] = 0u;
    __syncthreads();
    const int g_lo = a_.g_lo, g_hi = a_.g_hi, l_lo = a_.l_lo, l_hi = a_.l_hi, ph_lo = a_.ph_lo, ph_hi = a_.ph_hi, use_bar = a_.use_bar;
    XcdBarrier bar; bar.bar = (unsigned*)(a_.ws + WS_CTL) + CW_BAR; bar.x = 0; bar.st = nullptr;
    if (use_bar) bar = xcd_barrier_post((unsigned*)(a_.ws + WS_CTL) + CW_BAR, MISC + 8);
#if defined(DIAG_SEL)
#ifndef DIAG_BLK
#define DIAG_BLK 31
#endif
    int diag_site = 0; if (threadIdx.x == 0) MISC[15] = (unsigned)__builtin_amdgcn_s_memrealtime();
#define DIAG_STAMP(site) do { if (blockIdx.x == 0 && threadIdx.x == 0) { const unsigned now_ = (unsigned)__builtin_amdgcn_s_memrealtime(); MISC[16 + (site)] += now_ - MISC[15]; MISC[15] = now_; } } while (0)
#define GRID_BAR() do { if (use_bar) xcd_barrier(bar); DIAG_STAMP(diag_site); ++diag_site; } while (0)
#else
#define GRID_BAR() do { if (use_bar) xcd_barrier(bar); } while (0)
#endif
#ifndef PHMASK
#define PHMASK 0xFFFF
#endif
#ifndef PROBE_PH
#define PROBE_PH -1
#endif
#ifndef PROBE_MASK
#define PROBE_MASK 0
#endif
#define PROBED(k) ((PROBE_MASK >> (k)) & 1)
#ifndef P1_ALIGN
#define P1_ALIGN true
#endif
#define PH(k) (((PHMASK >> (k)) & 1) && ph_lo <= (k) && (k) < ph_hi)
#define PBEGIN ArgsP a = (ArgsP)__builtin_amdgcn_kernarg_segment_ptr(); asm volatile("" : "+s"(a)); unsigned char* ws = a->ws; \
    int tid_ = threadIdx.x; asm volatile("" : "+v"(tid_)); const int tid = tid_, lane = tid & 63, wave = __builtin_amdgcn_readfirstlane(tid >> 6); const int gw = blockIdx.x * NWAVES + wave, ngw = gridDim.x * NWAVES; (void)ws; (void)gw; (void)ngw; (void)lane;

#if defined(DIAG_SEL)
    diag_site = 15;
#endif
    if (((PHMASK >> 13) & 1) && a_.prep) { PBEGIN prep_weights(a, lds, gw, ngw, wave, lane); GRID_BAR(); }

    for (int g = g_lo; g < g_hi; ++g) {
        for (int l = l_lo; l < l_hi; ++l) {
#if defined(DIAG_SEL)
            diag_site = (l == 0) ? 0 : 1;
#endif
            if (PH(0) && l == 0) { PBEGIN p0_init(a, g, gw, ngw, lane); GRID_BAR(); }
            if (PH(1)) { PBEGIN
                FIn f{(bf16*)(ws + WS_Z), (float*)(ws + WS_ZF), (const float*)(ws + WS_BIN) + l * NZ};
                run_gemm<FIn, P1_ALIGN>(lds, (const bf16*)(ws + WS_XN), (const bf16*)(ws + WS_WIN) + (size_t)l * NZ * D, NZ, D, f, gw, ngw, lane);
                if (PROBED(1)) { run_gemm(lds, (const bf16*)(ws + WS_XN), (const bf16*)(ws + WS_WIN) + (size_t)l * NZ * D, NZ, D, f, gw, ngw, lane); }
                GRID_BAR();
            }
            if (PH(2)) {
                { PBEGIN p2_prep(a, l, gw, ngw, lane); }
#if defined(DIAG_SEL)
                __syncthreads(); DIAG_STAMP(14);
#endif
                { PBEGIN __syncthreads(); p2_chunks(a, lds, l, gw, ngw, wave, lane); }
                GRID_BAR();
            }
            if (PH(3)) { PBEGIN
                FQQ f{(bf16*)(ws + WS_QQ)};
                run_gemm(lds, (const bf16*)(ws + WS_CQN), (const bf16*)(ws + WS_WQQ) + (size_t)l * NQQ * 256, NQQ, 256, f, gw, ngw, lane);
                if (PROBED(3)) { run_gemm(lds, (const bf16*)(ws + WS_CQN), (const bf16*)(ws + WS_WQQ) + (size_t)l * NQQ * 256, NQQ, 256, f, gw, ngw, lane); }
            }
#if defined(DIAG_SEL)
            __syncthreads(); DIAG_STAMP(11);
#endif
            if (PH(4)) { PBEGIN
                for (int u = blockIdx.x; u < 256; u += gridDim.x) {
                    const int b = (u >> 4) & 7, h = (u >> 2) & 3, vs = u & 3;
                    if (u >> 7) scan_unit<true>(a, lds, b, h, vs, tid); else scan_unit<false>(a, lds, b, h, vs, tid);
                }
#if PROBE_PH == 4
                for (int u = blockIdx.x; u < 256; u += gridDim.x) {
                    const int b = (u >> 4) & 7, h = (u >> 2) & 3, vs = u & 3;
                    if (u >> 7) scan_unit<true>(a, lds, b, h, vs, tid); else scan_unit<false>(a, lds, b, h, vs, tid);
                }
#endif
                GRID_BAR();
            }
#if defined(DIAG_SEL)
            if (blockIdx.x == DIAG_BLK && threadIdx.x == 0) MISC[14] = (unsigned)__builtin_amdgcn_s_memrealtime();
#endif
            if (PH(5)) { PBEGIN p5_dsa(a, lds, l, tid, wave, lane); }
#if defined(DIAG_SEL)
            __syncthreads(); DSTAMP(27);
#endif
#if PROBE_PH == 5
            if (PH(5)) { PBEGIN p5_dsa(a, lds, l, tid, wave, lane); }
#endif
            if (PH(6)) { PBEGIN p6_headnorm(a, l, gw, ngw, lane); if (PROBED(6)) p6_headnorm<true>(a, l, gw, ngw, lane);
#if defined(DIAG_SEL)
                DSTAMP(28);
#endif
                GRID_BAR();
#if defined(DIAG_SEL)
                DSTAMP(29);
#endif
            }
            if (PH(7)) {
                __syncthreads();
                { PBEGIN
                  const bf16* OD0 = (const bf16*)(ws + WS_OD); const bf16* OD1 = OD0 + (size_t)MT * 1024;
                  const bf16* WB0 = (const bf16*)(ws + WS_WBD) + (size_t)l * D * 2048; const bf16* WB1 = WB0 + (size_t)D * D;
                  int Kc = D, Nc = D; asm volatile("" : "+s"(Kc)); asm volatile("" : "+s"(Nc));
                  pg8::Gemm g{(const bf16*)(ws + WS_OG), (const bf16*)(ws + WS_WBG) + (size_t)l * D * D, MR, Nc, Kc, OD0, OD1, (const bf16*)(ws + WS_OM), WB0, WB1, (const bf16*)(ws + WS_WBM) + (size_t)l * D * D};
                  ChainOrder S; S.S.init(MR, Nc, (int)gridDim.x, (int)blockIdx.x);
                  EpiMix E{(const bf16*)(ws + WS_Z), (bf16*)(ws + WS_MIX)};
                  pg8::gemm_phase<EpiMix, ChainOrder, true, true, true>((PG8_LAS unsigned char*)lds, g, S, E);
                  FBr<0> f0{(const bf16*)(ws + WS_Z), (float*)(ws + WS_Y), (bf16*)(ws + WS_MIX)};
                  mini_gemm(lds, (const bf16*)(ws + WS_OG), (const bf16*)(ws + WS_WBG) + (size_t)l * D * D, Nc, Kc, f0, (int)threadIdx.x);
                  FBr<1> f1{(const bf16*)(ws + WS_Z), (float*)(ws + WS_Y), (bf16*)(ws + WS_MIX)};
                  mini_gemm(lds, OD0, WB0, Nc, Kc, f1, (int)threadIdx.x);
                  mini_gemm(lds, OD1, WB1, Nc, Kc, f1, (int)threadIdx.x);
                  FBr<2> f2{(const bf16*)(ws + WS_Z), (float*)(ws + WS_Y), (bf16*)(ws + WS_MIX)};
                  mini_gemm(lds, (const bf16*)(ws + WS_OM), (const bf16*)(ws + WS_WBM) + (size_t)l * D * D, Nc, Kc, f2, (int)threadIdx.x);
                }
#if PROBED(7)
                { PBEGIN
                  const bf16* OD0 = (const bf16*)(ws + WS_OD); const bf16* OD1 = OD0 + (size_t)MT * 1024;
                  const bf16* WB0 = (const bf16*)(ws + WS_WBD) + (size_t)l * D * 2048; const bf16* WB1 = WB0 + (size_t)D * D;
                  int Kc = D, Nc = D; asm volatile("" : "+s"(Kc)); asm volatile("" : "+s"(Nc));
                  pg8::Gemm g{(const bf16*)(ws + WS_OG), (const bf16*)(ws + WS_WBG) + (size_t)l * D * D, MR, Nc, Kc, OD0, OD1, (const bf16*)(ws + WS_OM), WB0, WB1, (const bf16*)(ws + WS_WBM) + (size_t)l * D * D};
                  ChainOrder S; S.S.init(MR, Nc, (int)gridDim.x, (int)blockIdx.x);
                  EpiMix E{(const bf16*)(ws + WS_Z), (bf16*)(ws + WS_MIX)};
                  pg8::gemm_phase<EpiMix, ChainOrder, true, true, true>((PG8_LAS unsigned char*)lds, g, S, E);
                  FBr<0> f0{(const bf16*)(ws + WS_Z), (float*)(ws + WS_Y), (bf16*)(ws + WS_MIX)};
                  mini_gemm(lds, (const bf16*)(ws + WS_OG), (const bf16*)(ws + WS_WBG) + (size_t)l * D * D, Nc, Kc, f0, (int)threadIdx.x);
                  FBr<1> f1{(const bf16*)(ws + WS_Z), (float*)(ws + WS_Y), (bf16*)(ws + WS_MIX)};
                  mini_gemm(lds, OD0, WB0, Nc, Kc, f1, (int)threadIdx.x);
                  mini_gemm(lds, OD1, WB1, Nc, Kc, f1, (int)threadIdx.x);
                  FBr<2> f2{(const bf16*)(ws + WS_Z), (float*)(ws + WS_Y), (bf16*)(ws + WS_MIX)};
                  mini_gemm(lds, (const bf16*)(ws + WS_OM), (const bf16*)(ws + WS_WBM) + (size_t)l * D * D, Nc, Kc, f2, (int)threadIdx.x);
                }
#endif
                GRID_BAR();
            }
            if (PH(8)) { PBEGIN
                FY f{(bf16*)(ws + WS_Y)};
                run_gemm(lds, (const bf16*)(ws + WS_MIX), (const bf16*)(ws + WS_WOUT) + (size_t)l * D * D, D, D, f, gw, ngw, lane);
                if (PROBED(8)) { run_gemm(lds, (const bf16*)(ws + WS_MIX), (const bf16*)(ws + WS_WOUT) + (size_t)l * D * D, D, D, f, gw, ngw, lane); }
                GRID_BAR();
            }
            if (PH(9)) { PBEGIN if (PROBED(9)) p_norm_res<true>(a, g, a->in[I_GPOSTMIX] + l * D, a->in[I_GPREMLP] + l * D, gw, ngw, lane); p_norm_res(a, g, a->in[I_GPOSTMIX] + l * D, a->in[I_GPREMLP] + l * D, gw, ngw, lane); GRID_BAR(); }
            if (PH(10)) { PBEGIN
                FUp f{(bf16*)(ws + WS_Z)};
                run_gemm(lds, (const bf16*)(ws + WS_XN), (const bf16*)(ws + WS_WUP) + (size_t)l * DFF * D, DFF, D, f, gw, ngw, lane);
                if (PROBED(10)) { run_gemm(lds, (const bf16*)(ws + WS_XN), (const bf16*)(ws + WS_WUP) + (size_t)l * DFF * D, DFF, D, f, gw, ngw, lane); }
                GRID_BAR();
            }
            if (PH(11)) { PBEGIN
                FY f{(bf16*)(ws + WS_Y)};
                run_gemm(lds, (const bf16*)(ws + WS_Z), (const bf16*)(ws + WS_WDN) + (size_t)l * D * DFF, D, DFF, f, gw, ngw, lane);
                if (PROBED(11)) { run_gemm(lds, (const bf16*)(ws + WS_Z), (const bf16*)(ws + WS_WDN) + (size_t)l * D * DFF, D, DFF, f, gw, ngw, lane); }
                GRID_BAR();
            }
            if (PH(12)) { PBEGIN if (PROBED(12)) p_norm_res<true>(a, g, a->in[I_GPOSTMLP] + l * D, l + 1 < NL ? a->in[I_GPREMIX] + (l + 1) * D : nullptr, gw, ngw, lane); p_norm_res(a, g, a->in[I_GPOSTMLP] + l * D, l + 1 < NL ? a->in[I_GPREMIX] + (l + 1) * D : nullptr, gw, ngw, lane); GRID_BAR(); }
        }
    }
#if defined(DIAG_SEL)
    if ((DIAG_SEL >= 24 || DIAG_SEL == 16 || DIAG_SEL == 17) && blockIdx.x == DIAG_BLK && threadIdx.x == 0) { unsigned tot = 0; for (int i = 24; i < 30; ++i) tot += MISC[i]; tot += MISC[16] + MISC[17];
        a_.out[12345] = 100.f + 900.f * (float)MISC[DIAG_SEL] / (float)tot; }
    if (DIAG_SEL < 24 && DIAG_SEL != 16 && DIAG_SEL != 17 && blockIdx.x == 0 && threadIdx.x == 0) { unsigned tot = 0; for (int i = 0; i < 16; ++i) tot += MISC[16 + i];
#if defined(DIAG_ABS)
        a_.out[12345] = 100.f + (float)MISC[16 + DIAG_SEL] * 0.001f; }
#else
        a_.out[12345] = DIAG_SEL == 99 ? 100.f + (float)tot * 0.0001f : 100.f + 900.f * (float)MISC[16 + DIAG_SEL] / (float)tot; }
#endif
#endif
#undef PH
#undef GRID_BAR
#undef PBEGIN
}

#ifndef MK_ONE_LAUNCH
#define MK_ONE_LAUNCH 1
#endif
extern "C" void kernel_launch(void* const* d_in, const int* in_sizes, int n_in, void* d_out, int out_size, void* d_ws, size_t ws_size, hipStream_t stream) {
    static int grid = 0;
    if (grid == 0) {
        if (n_in != 28 || out_size != NB * SEQ * D || ws_size < WS_END) { fprintf(stderr, "kernel_launch: unexpected shapes (n_in %d out %d ws %zu need %zu)\n", n_in, out_size, ws_size, (size_t)WS_END); grid = -1; return; }
        int dev = 0, cus = 0, per_cu = 0;
        if (hipGetDevice(&dev) != hipSuccess || hipDeviceGetAttribute(&cus, hipDeviceAttributeMultiprocessorCount, dev) != hipSuccess) { grid = -1; return; }
        if (hipFuncSetAttribute((const void*)fwd, hipFuncAttributeMaxDynamicSharedMemorySize, LDS_BYTES) != hipSuccess) { fprintf(stderr, "kernel_launch: hipFuncSetAttribute failed\n"); grid = -1; return; }
        if (hipOccupancyMaxActiveBlocksPerMultiprocessor(&per_cu, (const void*)fwd, NWAVES * 64, LDS_BYTES) != hipSuccess || per_cu < 1) { fprintf(stderr, "kernel_launch: occupancy query says %d\n", per_cu); }
        (void)hipGetLastError();
        grid = cus;
    }
    if (grid < 0) return;
    (void)hipMemsetAsync((char*)d_ws + WS_CTL, 0, CTL_ZERO_BYTES, stream);
    Args a{};
    for (int i = 0; i < 28; ++i) a.in[i] = (const float*)d_in[i];
    a.out = (float*)d_out; a.ws = (unsigned char*)d_ws;
#if MK_ONE_LAUNCH
    a.g_lo = 0; a.g_hi = NG; a.l_lo = 0; a.l_hi = NL; a.ph_lo = 0; a.ph_hi = 13; a.prep = 1; a.use_bar = 1;
    hipLaunchKernelGGL(fwd, dim3(grid), dim3(NWAVES * 64), LDS_BYTES, stream, a);
#else
    a.use_bar = 0;
    a.prep = 1; a.g_lo = 0; a.g_hi = 0; a.l_lo = 0; a.l_hi = 0; a.ph_lo = 0; a.ph_hi = 0;
    hipLaunchKernelGGL(fwd, dim3(grid), dim3(NWAVES * 64), LDS_BYTES, stream, a);
    a.prep = 0;
    static const int cuts[] = {0, 1, 2, 3, 5, 7, 8, 9, 10, 11, 12, 13};
    for (int g = 0; g < NG; ++g) for (int l = 0; l < NL; ++l) for (int c = 0; c < 11; ++c) {
        if (c == 0 && l != 0) continue;
        a.g_lo = g; a.g_hi = g + 1; a.l_lo = l; a.l_hi = l + 1; a.ph_lo = cuts[c]; a.ph_hi = cuts[c + 1];
        hipLaunchKernelGGL(fwd, dim3(grid), dim3(NWAVES * 64), LDS_BYTES, stream, a);
    }
#endif
    const hipError_t le = hipPeekAtLastError();
    if (le != hipSuccess) fprintf(stderr, "kernel_launch: launch failed: %s\n", hipGetErrorName(le));
}
```

```cpp
#include <hip/hip_runtime.h>
#include <cstdio>
#include <cstdint>
namespace pg8 {
#define PG8_LAS __attribute__((address_space(3)))
typedef unsigned short bf16_t;
typedef short bf16x8 __attribute__((ext_vector_type(8)));
typedef float f32x4 __attribute__((ext_vector_type(4)));
typedef unsigned u32x4 __attribute__((ext_vector_type(4)));
constexpr int BM = 256, BK = 64, HALF = 128, HTB = HALF * BK * 2  , STAGE_BYTES = 8 * HTB, NXCD = 8, WGM = 8;

__host__ __device__ __forceinline__ int lds_byte(int r, int c) { const int st = (r >> 4) * 2 + (c >> 5), rr = r & 15, cc = c & 31, ob = rr * 64 + cc * 2; return st * 1024 + (ob ^ (((ob >> 9) & 1) << 5)); }
__host__ __device__ __forceinline__ void stage_rc(int b, int& R, int& C) { const int st = b / 1024, sb = b % 1024, swz = sb ^ (((sb >> 9) & 1) << 5); R = (st >> 1) * 16 + swz / 64; C = (st & 1) * 32 + (swz % 64) / 2; }
__host__ __device__ __forceinline__ int perm32(int rho) { const int n = rho >> 4, i = rho & 15; return 8 * (i >> 2) + 4 * n + (i & 3); }

struct Unit { int pm, pn, sub; };
struct Gemm { const bf16_t* A; const bf16_t* Bt; int M, N, K; const bf16_t *A1, *A2, *A3, *B1, *B2, *B3; };

struct StaticOrder {
    int nM, nN, nwg, G, c;
    __host__ __device__ void init(int M, int N, int G_, int c_) { nM = M / BM; nN = N / BM; nwg = nM * nN; G = G_; c = c_; }
    __host__ __device__ bool next(int i, Unit& u) const {
        const long L = (long)i * G + c; if (L >= nwg) return false;
        int wgid = (int)L; { const int q = nwg / NXCD, r = nwg % NXCD, xcd = wgid % NXCD, off = wgid / NXCD; wgid = (xcd < r ? xcd * (q + 1) : r * (q + 1) + (xcd - r) * q) + off; }
        const int nig = WGM * nN, gid = wgid / nig, fm = gid * WGM, gsz = (nM - fm) < WGM ? (nM - fm) : WGM;
        u.pm = fm + ((wgid % nig) % gsz); u.pn = (wgid % nig) / gsz; u.sub = 0; return true;
    }
    __device__ __forceinline__ void a_ready(const Unit&) const {}
    __device__ __forceinline__ void done(const Unit&) const {}
};

__device__ __forceinline__ unsigned cvt_pk_bf16(float lo, float hi) { unsigned r; asm volatile("v_cvt_pk_bf16_f32 %0, %1, %2" : "=v"(r) : "v"(lo), "v"(hi)); return r; }
template <class Epi, class Sched, bool ALIGN_EPI = false, bool SP2 = false, bool CHAIN = false>
__device__ __forceinline__ void gemm_phase(PG8_LAS unsigned char* lds, const Gemm g, const Sched& S, const Epi& E) {
    int tid_ = threadIdx.x; asm volatile("" : "+v"(tid_));
    const int tid = tid_, wid = __builtin_amdgcn_readfirstlane(tid >> 6), lane = tid & 63, wr = wid >> 2, wc = wid & 3, fr = lane & 15, fq = lane >> 4;
    const int K = g.K, nt = K / BK;
    unsigned voffA[2], voffB[2];
#pragma unroll
    for (int i = 0; i < 2; ++i) { int R, C; stage_rc(tid * 16 + i * 8192, R, C); const int Rb = Epi::PERM ? ((R & ~31) + perm32(R & 31)) : R;
        voffA[i] = (unsigned)(R * K + C) * 2u; voffB[i] = (unsigned)(Rb * K + C) * 2u; }
    const size_t kstep = (size_t)(BK * 2);
    const size_t hstep = (size_t)HALF * K * 2;
    const size_t tstep = 2 * hstep;
    const unsigned ldsw = (unsigned)wid * 1024u;
    const int aoff = lds_byte(wr * 64 + fr, fq * 8), boff = lds_byte(wc * 32 + fr, fq * 8);
#define PG8_SA(b, h) (((b) * 2 + (h)) * HTB)
#define PG8_SB(b, h) ((4 + (b) * 2 + (h)) * HTB)
#define PG8_STAGE(bufoff, gbase, voff) do { _Pragma("unroll") for (int _i = 0; _i < 2; ++_i) \
        __builtin_amdgcn_global_load_lds((const unsigned*)((const char*)(gbase) + (voff)[_i]), (PG8_LAS unsigned*)(lds + (bufoff) + ldsw + _i * 8192), 16, 0, 0); } while (0)
#define PG8_LDA(dst, b, h) do { _Pragma("unroll") for (int m = 0; m < 4; ++m) _Pragma("unroll") for (int k = 0; k < 2; ++k) dst[m][k] = *(const PG8_LAS bf16x8*)(lds + PG8_SA(b, h) + aoff + m * 2048 + k * 1024); } while (0)
#define PG8_LDB(dst, b, h) do { _Pragma("unroll") for (int n = 0; n < 2; ++n) _Pragma("unroll") for (int k = 0; k < 2; ++k) dst[n][k] = *(const PG8_LAS bf16x8*)(lds + PG8_SB(b, h) + boff + n * 2048 + k * 1024); } while (0)
#define PG8_MMA(ai, bj, At, Bt) do { __builtin_amdgcn_s_setprio(1); _Pragma("unroll") for (int m = 0; m < 4; ++m) _Pragma("unroll") for (int n = 0; n < 2; ++n) _Pragma("unroll") for (int k = 0; k < 2; ++k) \
        acc[ai][bj][m][n] = __builtin_amdgcn_mfma_f32_16x16x32_bf16(Bt[n][k], At[m][k], acc[ai][bj][m][n], 0, 0, 0); __builtin_amdgcn_s_setprio(0); } while (0)
#define PG8_WAIT_V(n) asm volatile("s_waitcnt vmcnt(" #n ")" ::: "memory")
#define PG8_WAIT_L(n) asm volatile("s_waitcnt lgkmcnt(" #n ")" ::: "memory")
#define PG8_BAR __builtin_amdgcn_s_barrier()
#define PG8_SCHED __builtin_amdgcn_sched_barrier(0)
    Unit cur, nxt; int ui = 0;
    if (!S.next(0, cur)) return;
    f32x4 acc[2][2][4][2];
#pragma unroll
    for (int a = 0; a < 2; ++a)
#pragma unroll
        for (int b = 0; b < 2; ++b)
#pragma unroll
            for (int m = 0; m < 4; ++m)
#pragma unroll
                for (int n = 0; n < 2; ++n) acc[a][b][m][n] = (f32x4){0.f, 0.f, 0.f, 0.f};
    bf16x8 At[4][2], B0[2][2], B1[2][2];
#define PG8_ABASE(u) ((const char*)(!CHAIN || (u).sub == 0 ? g.A : (u).sub == 1 ? g.A1 : (u).sub == 2 ? g.A2 : g.A3) + (size_t)(u).pm * tstep)
#define PG8_BBASE(u) ((const char*)(!CHAIN || (u).sub == 0 ? g.Bt : (u).sub == 1 ? g.B1 : (u).sub == 2 ? g.B2 : g.B3) + (size_t)(u).pn * tstep)
    const char* cA = PG8_ABASE(cur); const char* cB = PG8_BBASE(cur);
    S.a_ready(cur);
    if constexpr (SP2) {
        PG8_STAGE(PG8_SB(0, 0), cB, voffB); PG8_STAGE(PG8_SB(0, 1), cB + hstep, voffB); PG8_STAGE(PG8_SA(0, 0), cA, voffA); PG8_STAGE(PG8_SA(0, 1), cA + hstep, voffA);
        if (wr == 1) PG8_BAR;
        PG8_WAIT_V(2); PG8_BAR;
        PG8_STAGE(PG8_SB(1, 0), cB + kstep, voffB); PG8_STAGE(PG8_SA(1, 0), cA + kstep, voffA); PG8_STAGE(PG8_SB(1, 1), cB + hstep + kstep, voffB);
        PG8_WAIT_V(6); PG8_BAR;
    } else {
        PG8_STAGE(PG8_SB(0, 0), cB, voffB); PG8_STAGE(PG8_SA(0, 0), cA, voffA); PG8_STAGE(PG8_SB(0, 1), cB + hstep, voffB); PG8_STAGE(PG8_SA(0, 1), cA + hstep, voffA);
        if (wr == 1) PG8_BAR;
        PG8_WAIT_V(4); PG8_BAR;
        PG8_STAGE(PG8_SB(1, 0), cB + kstep, voffB); PG8_STAGE(PG8_SA(1, 0), cA + kstep, voffA); PG8_STAGE(PG8_SB(1, 1), cB + hstep + kstep, voffB);
        PG8_WAIT_V(6); PG8_BAR;
    }
    for (;;) {
        const bool has_next = S.next(ui + 1, nxt);
        const char* nA = has_next ? PG8_ABASE(nxt) : cA; const char* nB = has_next ? PG8_BBASE(nxt) : cB;
        for (int t = 0; t < nt; t += 2) {
            const bool last = (t == nt - 2);
            const char* a1 = cA + (size_t)(t + 1) * kstep;
            const char* a2 = last ? nA : cA + (size_t)(t + 2) * kstep; const char* b2 = last ? nB : cB + (size_t)(t + 2) * kstep;
            const char* a3 = a2 + kstep; const char* b3 = b2 + kstep;
            if (last && has_next) S.a_ready(nxt);
            if constexpr (SP2) {
            PG8_LDB(B0, 0, 0); PG8_LDB(B1, 0, 1); PG8_SCHED; PG8_LDA(At, 0, 0); PG8_STAGE(PG8_SA(1, 1), a1 + hstep, voffA);
            PG8_WAIT_V(8); PG8_WAIT_L(0); PG8_BAR; PG8_MMA(0, 0, At, B0); PG8_MMA(0, 1, At, B1); PG8_BAR; PG8_SCHED;
            PG8_LDA(At, 0, 1); PG8_STAGE(PG8_SB(0, 0), b2, voffB); PG8_STAGE(PG8_SB(0, 1), b2 + hstep, voffB); PG8_STAGE(PG8_SA(0, 0), a2, voffA);
            PG8_WAIT_V(8); PG8_WAIT_L(0); PG8_BAR; PG8_MMA(1, 0, At, B0); PG8_MMA(1, 1, At, B1); PG8_BAR; PG8_SCHED;
            PG8_LDB(B0, 1, 0); PG8_LDB(B1, 1, 1); PG8_SCHED; PG8_LDA(At, 1, 0); PG8_STAGE(PG8_SA(0, 1), a2 + hstep, voffA);
            PG8_WAIT_V(8); PG8_WAIT_L(0); PG8_BAR; PG8_MMA(0, 0, At, B0); PG8_MMA(0, 1, At, B1); PG8_BAR; PG8_SCHED;
            PG8_LDA(At, 1, 1); PG8_STAGE(PG8_SB(1, 0), b3, voffB); PG8_STAGE(PG8_SB(1, 1), b3 + hstep, voffB); PG8_STAGE(PG8_SA(1, 0), a3, voffA);
            PG8_WAIT_V(8); PG8_WAIT_L(0); PG8_BAR; PG8_MMA(1, 0, At, B0); PG8_MMA(1, 1, At, B1); PG8_BAR; PG8_SCHED;
            } else {
            PG8_LDB(B0, 0, 0); PG8_SCHED; PG8_LDA(At, 0, 0); PG8_STAGE(PG8_SA(1, 1), a1 + hstep, voffA);
            PG8_WAIT_L(8); PG8_BAR; PG8_WAIT_L(0); PG8_MMA(0, 0, At, B0); PG8_BAR; PG8_SCHED;
            PG8_LDB(B1, 0, 1); PG8_STAGE(PG8_SB(0, 0), b2, voffB);
            PG8_BAR; PG8_WAIT_L(0); PG8_MMA(0, 1, At, B1); PG8_BAR;
            PG8_LDA(At, 0, 1); PG8_STAGE(PG8_SA(0, 0), a2, voffA);
            PG8_BAR; PG8_WAIT_L(0); PG8_MMA(1, 0, At, B0); PG8_BAR; PG8_SCHED;
            PG8_STAGE(PG8_SB(0, 1), b2 + hstep, voffB);
            PG8_WAIT_V(6); PG8_BAR; PG8_MMA(1, 1, At, B1); PG8_BAR;
            PG8_LDB(B0, 1, 0); PG8_SCHED; PG8_LDA(At, 1, 0); PG8_STAGE(PG8_SA(0, 1), a2 + hstep, voffA);
            PG8_WAIT_L(8); PG8_BAR; PG8_WAIT_L(0); PG8_MMA(0, 0, At, B0); PG8_BAR; PG8_SCHED;
            PG8_LDB(B1, 1, 1); PG8_STAGE(PG8_SB(1, 0), b3, voffB);
            PG8_BAR; PG8_WAIT_L(0); PG8_MMA(0, 1, At, B1); PG8_BAR;
            PG8_LDA(At, 1, 1); PG8_STAGE(PG8_SA(1, 0), a3, voffA);
            PG8_BAR; PG8_WAIT_L(0); PG8_MMA(1, 0, At, B0); PG8_BAR; PG8_SCHED;
            PG8_STAGE(PG8_SB(1, 1), b3 + hstep, voffB);
            PG8_WAIT_V(6); PG8_BAR; PG8_MMA(1, 1, At, B1); PG8_BAR;
            }
        }
        if constexpr (ALIGN_EPI) { if (wr == 0) PG8_BAR; }
        if constexpr (CHAIN) { if (cur.sub < 3) E.mid(acc, cur, wr, wc, fr, fq); else E(acc, cur, wr, wc, fr, fq); S.done(cur); }
        else if constexpr (!Epi::AFTER_DRAIN) { E(acc, cur, wr, wc, fr, fq); S.done(cur); }
        if (!has_next) break;
        if (!CHAIN || cur.sub == 3)
#pragma unroll
        for (int a = 0; a < 2; ++a)
#pragma unroll
            for (int b = 0; b < 2; ++b)
#pragma unroll
                for (int m = 0; m < 4; ++m)
#pragma unroll
                    for (int n = 0; n < 2; ++n) acc[a][b][m][n] = (f32x4){0.f, 0.f, 0.f, 0.f};
        cur = nxt; cA = nA; cB = nB; ++ui;
        if constexpr (ALIGN_EPI) { if (wr == 1) PG8_BAR; }
    }
    PG8_WAIT_V(0);
    if constexpr (!ALIGN_EPI) { if (wr == 0) PG8_BAR; }
    PG8_BAR;
    if constexpr (Epi::AFTER_DRAIN) { E.fused(acc, cur, wr, wc, fr, fq, lds, wid, lane); S.done(cur); }
#undef PG8_ABASE
#undef PG8_BBASE
#undef PG8_SA
#undef PG8_SB
#undef PG8_STAGE
#undef PG8_LDA
#undef PG8_LDB
#undef PG8_MMA
#undef PG8_WAIT_V
#undef PG8_WAIT_L
#undef PG8_BAR
#undef PG8_SCHED
}
}

constexpr int NB = 32, SEQ = 2048, NMETA = 16, TT = SEQ + NMETA, D = 1024, NL = 4, DFF = 4096;
constexpr int NG = 4, GB = NB / NG, MR = GB * SEQ  , MT = MR + NMETA  ;
constexpr int NCOLS = 9696, NZ = 9728, ZB = 9216, ZFW = 512;
constexpr float EPS = 1e-6f;
constexpr int ZC_GQ = 0, ZC_GK = 512, ZC_GV = 1024, ZC_GR = 2048, ZC_MQ = 3072, ZC_MK = 3584, ZC_MV = 4096, ZC_MO = 5120, ZC_GATE = 6144;
constexpr int ZF_CQ = 0, ZF_CKV = 256, ZF_IK = 384, ZF_A = 448, ZF_IW = 464, ZF_MI = 472, ZF_MF = 476;
constexpr int NQQ = 2560;

constexpr size_t MiB = 1u << 20;
constexpr size_t WS_CTL = 0, CTL_ZERO_BYTES = 1 * MiB;
constexpr size_t WS_BIN = 1 * MiB;
constexpr size_t WS_WIN = 2 * MiB;
constexpr size_t WS_WQQ = 78 * MiB;
constexpr size_t WS_WBG = 83 * MiB;
constexpr size_t WS_WBM = 91 * MiB;
constexpr size_t WS_WBD = 99 * MiB;
constexpr size_t WS_WOUT = 115 * MiB;
constexpr size_t WS_WUP = 123 * MiB;
constexpr size_t WS_WDN = 155 * MiB;
constexpr size_t WS_HM = 187 * MiB;
constexpr size_t WS_XN = 188 * MiB;
constexpr size_t WS_ZF = 221 * MiB;
constexpr size_t WS_CQN = 254 * MiB;
constexpr size_t WS_KV = 263 * MiB;
constexpr size_t WS_KI = 268 * MiB;
constexpr size_t WS_WI = 271 * MiB;
constexpr size_t WS_LIF = 272 * MiB;
constexpr size_t WS_G = 273 * MiB;
constexpr size_t WS_QKC = 306 * MiB;
constexpr size_t WS_QQ = 339 * MiB;
constexpr size_t WS_OG = 420 * MiB;
constexpr size_t WS_OM = 453 * MiB;
constexpr size_t WS_OD = 486 * MiB;
constexpr size_t WS_Z = 551 * MiB;
constexpr size_t WS_MIX = 840 * MiB;
constexpr size_t WS_Y = 873 * MiB;
constexpr size_t WS_SC = 840 * MiB;
constexpr size_t WS_DD = 1020 * MiB;
constexpr size_t WS_END = 1024 * MiB;
constexpr int SC_PITCH = 2080;
static_assert(WS_Z + (size_t)MT * ZB * 2 <= WS_MIX && WS_Y + (size_t)MT * D * 4 <= WS_END && WS_SC + (size_t)256 * 64 * SC_PITCH * 4 <= WS_END, "ws map");

constexpr int CW_BAR = 4096;

constexpr int RING_BYTES = 139264;
constexpr int MISC_OFF = RING_BYTES + 320;
constexpr int LDS_BYTES = 147456;
constexpr int NWAVES = 8;

#define LAS __attribute__((address_space(3)))
typedef unsigned short bf16;
typedef float f32x4 __attribute__((ext_vector_type(4)));
typedef float f32x2 __attribute__((ext_vector_type(2)));
typedef unsigned u32x4 __attribute__((ext_vector_type(4)));
typedef unsigned u32x2 __attribute__((ext_vector_type(2)));
typedef short bf16x8 __attribute__((ext_vector_type(8)));
typedef short s16x4 __attribute__((ext_vector_type(4)));
#define LDS_WAIT() asm volatile("s_waitcnt lgkmcnt(0)" ::: "memory")
#define VM_WAIT() asm volatile("s_waitcnt vmcnt(0)" ::: "memory")
#define LDS_BARRIER() do { asm volatile("s_waitcnt lgkmcnt(0)" ::: "memory"); __builtin_amdgcn_s_barrier(); asm volatile("" ::: "memory"); } while (0)

typedef __bf16 hwbf16x2 __attribute__((ext_vector_type(2)));
__device__ __forceinline__ unsigned pk2(float lo, float hi) { const f32x2 v = {lo, hi}; const hwbf16x2 b = __builtin_convertvector(v, hwbf16x2); return __builtin_bit_cast(unsigned, b); }
__device__ __forceinline__ unsigned f2bf(float f) { return pk2(f, 0.f) & 0xffffu; }
__device__ __forceinline__ float bf2f(unsigned b) { return __builtin_bit_cast(float, b << 16); }
__device__ __forceinline__ float bflo(unsigned w) { return __builtin_bit_cast(float, w << 16); }
__device__ __forceinline__ float bfhi(unsigned w) { return __builtin_bit_cast(float, w & 0xffff0000u); }
__device__ __forceinline__ float wave_sum(float v) {
#pragma unroll
    for (int o = 1; o < 64; o <<= 1) v += __shfl_xor(v, o);
    return v;
}
__device__ __forceinline__ float wave_max(float v) {
#pragma unroll
    for (int o = 1; o < 64; o <<= 1) v = fmaxf(v, __shfl_xor(v, o));
    return v;
}
__device__ __forceinline__ float sigmoid_f(float x) { return __builtin_amdgcn_rcpf(1.f + __builtin_amdgcn_exp2f(-1.4426950408889634f * x)); }
__device__ __forceinline__ float silu_f(float x) { return x * sigmoid_f(x); }
__device__ __forceinline__ float logsigmoid_f(float x) { return fminf(x, 0.f) - 0.6931471805599453f * __builtin_amdgcn_logf(1.f + __builtin_amdgcn_exp2f(-1.4426950408889634f * fabsf(x))); }

#define XB_TMO      128
#define XB_XCNT(j)  (256  + 64 * (j))
#define XB_XSUB(j)  (1280 + 64 * (j))
#define XB_XGEN(j)  (2304 + 64 * (j))
#define XB_TOP      3328
#define XB_TOPGEN   3392
#define XCD_BAR_WORDS 3456
#define XB_SPIN_CAP (1u << 22)

__device__ __forceinline__ unsigned xb_ld(unsigned* p)              { return __hip_atomic_load(p, __ATOMIC_RELAXED, __HIP_MEMORY_SCOPE_AGENT); }
__device__ __forceinline__ unsigned xb_add(unsigned* p, unsigned v) { return __hip_atomic_fetch_add(p, v, __ATOMIC_RELAXED, __HIP_MEMORY_SCOPE_AGENT); }
__device__ __forceinline__ unsigned xb_xcc_id() { return (unsigned)__builtin_amdgcn_s_getreg((3 << 11) | 20) & 0xFu; }
#define XB_SPIN(cond, bar) do { unsigned _sp = 0; while (cond) { __builtin_amdgcn_s_sleep(1); \
    if ((++_sp & 255u) == 0u) { if (xb_ld(&(bar)[XB_TMO])) break; if (_sp > XB_SPIN_CAP) { atomicAdd(&(bar)[XB_TMO], 1u); break; } } } } while (0)

struct XcdBarrier {
    unsigned* bar; unsigned x;
    volatile LAS unsigned* st;
};

__device__ __forceinline__ XcdBarrier xcd_barrier_post(unsigned* bar, volatile LAS unsigned* st) {
    XcdBarrier b; b.bar = bar; b.x = xb_xcc_id(); b.st = st;
    if (threadIdx.x == 0) (void)xb_add(&bar[XB_XCNT(b.x)], 1u);
    return b;
}
__device__ __forceinline__ void xcd_barrier_complete(unsigned* bar, unsigned x, unsigned& nloc, unsigned& nx) {
    const unsigned G = gridDim.x * gridDim.y * gridDim.z;
    unsigned sum, cnt, mine, sp = 0u;
    for (;;) {
        sum = 0u; cnt = 0u; mine = 0u;
#pragma unroll
        for (unsigned j = 0; j < 16; ++j) { const unsigned c = xb_ld(&bar[XB_XCNT(j)]); sum += c; cnt += (c > 0u) ? 1u : 0u; mine = (j == x) ? c : mine; }
        if (sum == G) break;
        __builtin_amdgcn_s_sleep(1);
        if ((++sp & 255u) == 0u) { if (xb_ld(&bar[XB_TMO])) break; if (sp > XB_SPIN_CAP) { atomicAdd(&bar[XB_TMO], 1u); break; } }
    }
    nloc = mine > 0u ? mine : 1u; nx = cnt > 0u ? cnt : 1u;
}

__device__ __forceinline__ void xcd_barrier(const XcdBarrier& b) {
    asm volatile("s_waitcnt vmcnt(0)" ::: "memory");
    __syncthreads();
    if (threadIdx.x == 0) {
        unsigned* bar = b.bar;
        __builtin_amdgcn_s_waitcnt(0);
        unsigned nloc = b.st[0], nx = b.st[1];
        if (nloc == 0u) { xcd_barrier_complete(bar, b.x, nloc, nx); b.st[0] = nloc; b.st[1] = nx; }
        const unsigned old = xb_add(&bar[XB_XSUB(b.x)], 1u);
        const unsigned gen = old / nloc;
        if (old + 1u == (gen + 1u) * nloc) {
            __builtin_amdgcn_fence(__ATOMIC_RELEASE, "agent");
            asm volatile("s_waitcnt vmcnt(0)" ::: "memory");
            const unsigned og = xb_add(&bar[XB_TOP], 1u);
            const unsigned tg = og / nx;
            if (og + 1u == (tg + 1u) * nx) xb_add(&bar[XB_TOPGEN], 1u);
            else XB_SPIN(xb_ld(&bar[XB_TOPGEN]) == tg, bar);
            __builtin_amdgcn_fence(__ATOMIC_ACQUIRE, "agent");
            xb_add(&bar[XB_XGEN(b.x)], 1u);
            asm volatile("s_waitcnt vmcnt(0)" ::: "memory");
        } else {
            XB_SPIN(xb_ld(&bar[XB_XGEN(b.x)]) == gen, bar);
            __builtin_amdgcn_fence(__ATOMIC_ACQUIRE, "agent");
            asm volatile("s_waitcnt vmcnt(0)" ::: "memory");
        }
    }
    __syncthreads();
}


struct Args { const float* in[28]; float* out; unsigned char* ws; int g_lo, g_hi, l_lo, l_hi, ph_lo, ph_hi, prep, use_bar; };
typedef const __attribute__((address_space(4))) Args* ArgsP;
enum { I_X = 0, I_META, I_T5, I_GPREMIX, I_WIN, I_BIN, I_WA2, I_BA, I_GGLA, I_WBRG, I_GDQ, I_WUQ, I_WIQ, I_GDKV, I_WUV, I_LNG, I_LNB, I_WBRD,
       I_CONV, I_FB, I_GML, I_WBRM, I_WOUT, I_GPOSTMIX, I_GPREMLP, I_WUP, I_WDN, I_GPOSTMLP };

__device__ __forceinline__ int win_src(int n) {
    if (n < 3072) return n;
    if (n < 6144) return n - 3072 + 3544;
    if (n < 9216) return n - 6144 + 6624;
    if (n < 9472) return n - 9216 + 3088;
    if (n < 9600) return n - 9472 + 3344;
    if (n < 9664) return n - 9600 + 3472;
    if (n < 9680) return n - 9664 + 3072;
    if (n < 9688) return n - 9680 + 3536;
    if (n < 9692) return n - 9688 + 6616;
    if (n < 9696) return n - 9692 + 6620;
    return -1;
}
struct CmIdent { __device__ __forceinline__ int operator()(int n) const { return n; } };
struct CmWin { __device__ __forceinline__ int operator()(int n) const { return win_src(n); } };

template <class CM>
__device__ __forceinline__ void tr_item(const float* __restrict__ W, int ldw, bf16* __restrict__ WT, int Kd, LAS float* scr, int k0, int ns0, int nd0, int lane, CM cm) {
    const int sc = cm(ns0 + (lane & 31)); const int scc = sc >= 0 ? sc : 0; const float msk = sc >= 0 ? 1.f : 0.f;
    float wv[32];
#pragma unroll
    for (int i = 0; i < 32; ++i) { const int kk = 2 * i + (lane >> 5); wv[i] = W[(size_t)(k0 + kk) * ldw + scc]; }
#pragma unroll
    for (int i = 0; i < 32; ++i) { const int kk = 2 * i + (lane >> 5); scr[kk * 33 + (lane & 31)] = wv[i] * msk; }
    LDS_WAIT();
    const int c = lane & 7;
#pragma unroll
    for (int j = 0; j < 4; ++j) { const int n = (lane >> 3) + 8 * j; const LAS float* s = scr + (8 * c) * 33 + n;
        u32x4 o; o.x = pk2(s[0 * 33], s[1 * 33]); o.y = pk2(s[2 * 33], s[3 * 33]); o.z = pk2(s[4 * 33], s[5 * 33]); o.w = pk2(s[6 * 33], s[7 * 33]);
        *(u32x4*)(WT + (size_t)(nd0 + n) * Kd + k0 + 8 * c) = o; }
    LDS_WAIT();
}

__device__ __forceinline__ void prep_weights(ArgsP a, LAS unsigned char* lds, int gw, int ngw, int wave, int lane) {
    LAS float* scr = (LAS float*)(lds + wave * 16384);
    unsigned char* ws = a->ws;
    constexpr int I_WIN_N = 16 * 304, I_UQ = 4 * 64, I_IQ = 4 * 16, I_SQ = 16 * 32, I_UP = 16 * 128, I_DN = 64 * 32, I_WBD = 4096, I_B = NZ / 64;
    constexpr int PER_L = I_WIN_N + I_UQ + I_IQ + 3 * I_SQ + I_UP + I_DN + I_WBD + I_B;
    for (int it = gw; it < NL * PER_L; it += ngw) {
        const int l = it / PER_L; int r = it % PER_L;
        if (r < I_WIN_N) { const int kb = r / 304, nb = r % 304;
            tr_item(a->in[I_WIN] + (size_t)l * D * NCOLS, NCOLS, (bf16*)(ws + WS_WIN) + (size_t)l * NZ * D, D, scr, kb * 64, nb * 32, nb * 32, lane, CmWin()); continue; }
        r -= I_WIN_N;
        if (r < I_UQ) { const int kb = r / 64, nb = r % 64;
            tr_item(a->in[I_WUQ] + (size_t)l * 256 * 2048, 2048, (bf16*)(ws + WS_WQQ) + (size_t)l * NQQ * 256, 256, scr, kb * 64, nb * 32, nb * 32, lane, CmIdent()); continue; }
        r -= I_UQ;
        if (r < I_IQ) { const int kb = r / 16, nb = r % 16;
            tr_item(a->in[I_WIQ] + (size_t)l * 256 * 512, 512, (bf16*)(ws + WS_WQQ) + (size_t)l * NQQ * 256, 256, scr, kb * 64, nb * 32, 2048 + nb * 32, lane, CmIdent()); continue; }
        r -= I_IQ;
        if (r < I_SQ) { const int kb = r / 32, nb = r % 32;
            tr_item(a->in[I_WBRG] + (size_t)l * D * D, D, (bf16*)(ws + WS_WBG) + (size_t)l * D * D, D, scr, kb * 64, nb * 32, nb * 32, lane, CmIdent()); continue; }
        r -= I_SQ;
        if (r < I_SQ) { const int kb = r / 32, nb = r % 32;
            tr_item(a->in[I_WBRM] + (size_t)l * D * D, D, (bf16*)(ws + WS_WBM) + (size_t)l * D * D, D, scr, kb * 64, nb * 32, nb * 32, lane, CmIdent()); continue; }
        r -= I_SQ;
        if (r < I_SQ) { const int kb = r / 32, nb = r % 32;
            tr_item(a->in[I_WOUT] + (size_t)l * D * D, D, (bf16*)(ws + WS_WOUT) + (size_t)l * D * D, D, scr, kb * 64, nb * 32, nb * 32, lane, CmIdent()); continue; }
        r -= I_SQ;
        if (r < I_UP) { const int kb = r / 128, nb = r % 128;
            tr_item(a->in[I_WUP] + (size_t)l * D * DFF, DFF, (bf16*)(ws + WS_WUP) + (size_t)l * DFF * D, D, scr, kb * 64, nb * 32, nb * 32, lane, CmIdent()); continue; }
        r -= I_UP;
        if (r < I_DN) { const int kb = r / 32, nb = r % 32;
            tr_item(a->in[I_WDN] + (size_t)l * DFF * D, D, (bf16*)(ws + WS_WDN) + (size_t)l * D * DFF, DFF, scr, kb * 64, nb * 32, nb * 32, lane, CmIdent()); continue; }
        r -= I_DN;
        if (r < I_WBD) {
            const int h = r >> 8, nb = (r >> 4) & 15, cb = r & 15, n = nb * 64 + lane, c0 = cb * 8;
            const float* uv = a->in[I_WUV] + ((size_t)(l * 16 + h) * 128 + c0) * 64;
            const float* wb = a->in[I_WBRD] + ((size_t)l * D + h * 64) * D + n;
            float acc[8];
#pragma unroll
            for (int j = 0; j < 8; ++j) acc[j] = 0.f;
            for (int d0 = 0; d0 < 64; d0 += 8) {
                float wv[8];
#pragma unroll
                for (int e = 0; e < 8; ++e) wv[e] = wb[(size_t)(d0 + e) * D];
#pragma unroll
                for (int j = 0; j < 8; ++j) { const f32x4 u0 = *(const f32x4*)(uv + j * 64 + d0), u1 = *(const f32x4*)(uv + j * 64 + d0 + 4);
                    acc[j] += (u0.x * wv[0] + u0.y * wv[1]) + (u0.z * wv[2] + u0.w * wv[3]) + (u1.x * wv[4] + u1.y * wv[5]) + (u1.z * wv[6] + u1.w * wv[7]); }
            }
            bf16* o = (bf16*)(ws + WS_WBD) + (size_t)l * D * 2048 + (size_t)(h >> 3) * D * D + (size_t)n * D + (h & 7) * 128 + c0;
            u32x4 ow; ow.x = pk2(acc[0], acc[1]); ow.y = pk2(acc[2], acc[3]); ow.z = pk2(acc[4], acc[5]); ow.w = pk2(acc[6], acc[7]);
            *(u32x4*)o = ow;
            continue; }
        r -= I_WBD;
        { const int n = r * 64 + lane; const int sc = win_src(n);
          ((float*)(ws + WS_BIN))[l * NZ + n] = sc >= 0 ? a->in[I_BIN][l * NCOLS + sc] : 0.f; }
    }
}

__device__ __forceinline__ float* hrow(ArgsP a, int g, int r) {
    return r < MR ? a->out + ((size_t)g * MR + r) * D : (float*)(a->ws + WS_HM) + (size_t)(r - MR) * D;
}
__device__ __forceinline__ void rms_row_bf16(const f32x4 (&v)[4], const float* __restrict__ gain, bf16* __restrict__ orow, int lane) {
    float s = 0.f;
#pragma unroll
    for (int j = 0; j < 4; ++j) s += (v[j].x * v[j].x + v[j].y * v[j].y) + (v[j].z * v[j].z + v[j].w * v[j].w);
    const float r = rsqrtf(wave_sum(s) * (1.f / D) + EPS);
#pragma unroll
    for (int j = 0; j < 4; ++j) { const f32x4 gg = *(const f32x4*)(gain + 4 * lane + 256 * j); const f32x4 o = v[j] * r * gg;
        u32x2 w; w.x = pk2(o.x, o.y); w.y = pk2(o.z, o.w); *(u32x2*)(orow + 4 * lane + 256 * j) = w; }
}
__device__ __forceinline__ void p0_init(ArgsP a, int g, int gw, int ngw, int lane) {
    bf16* XN = (bf16*)(a->ws + WS_XN);
    for (int r = gw; r < MT; r += ngw) {
        const float* src = r < MR ? a->in[I_X] + ((size_t)g * MR + r) * D : a->in[I_META] + (size_t)(r - MR) * D;
        float* hd = hrow(a, g, r);
        f32x4 v[4];
#pragma unroll
        for (int j = 0; j < 4; ++j) { v[j] = *(const f32x4*)(src + 4 * lane + 256 * j); *(f32x4*)(hd + 4 * lane + 256 * j) = v[j]; }
        rms_row_bf16(v, a->in[I_GPREMIX], XN + (size_t)r * D, lane);
    }
}
template <bool DRY = false>
__device__ __forceinline__ void p_norm_res(ArgsP a, int g, const float* gpost, const float* gpre, int gw, int ngw, int lane, int rbeg = 0) {
    bf16* XN = (bf16*)(a->ws + (DRY ? WS_Z + 100 * MiB : WS_XN)); const bf16* Y = (const bf16*)(a->ws + WS_Y);
    f32x4 gp[4], gq[4];
#pragma unroll
    for (int j = 0; j < 4; ++j) { gp[j] = *(const f32x4*)(gpost + 4 * lane + 256 * j); gq[j] = gpre ? *(const f32x4*)(gpre + 4 * lane + 256 * j) : (f32x4){0.f, 0.f, 0.f, 0.f}; }
    for (int r0 = rbeg + gw * 2; r0 < MT; r0 += ngw * 2) {
        float* hd[2]; float* hw[2]; u32x2 yw[2][4]; f32x4 v[2][4]; float s[2];
#pragma unroll
        for (int i = 0; i < 2; ++i) { const int r = r0 + i; hd[i] = hrow(a, g, r); hw[i] = DRY ? (float*)(a->ws + WS_Z) + (size_t)r * D : hd[i];
#pragma unroll
            for (int j = 0; j < 4; ++j) { yw[i][j] = *(const u32x2*)(Y + (size_t)r * D + 4 * lane + 256 * j); v[i][j] = *(const f32x4*)(hd[i] + 4 * lane + 256 * j); } }
        f32x4 y[2][4];
#pragma unroll
        for (int i = 0; i < 2; ++i) { s[i] = 0.f;
#pragma unroll
            for (int j = 0; j < 4; ++j) { y[i][j] = (f32x4){bflo(yw[i][j].x), bfhi(yw[i][j].x), bflo(yw[i][j].y), bfhi(yw[i][j].y)};
                s[i] += (y[i][j].x * y[i][j].x + y[i][j].y * y[i][j].y) + (y[i][j].z * y[i][j].z + y[i][j].w * y[i][j].w); } }
#pragma unroll
        for (int o = 1; o < 64; o <<= 1) { s[0] += __shfl_xor(s[0], o); s[1] += __shfl_xor(s[1], o); }
        float s2[2];
#pragma unroll
        for (int i = 0; i < 2; ++i) { const float rr = rsqrtf(s[i] * (1.f / D) + EPS); s2[i] = 0.f;
#pragma unroll
            for (int j = 0; j < 4; ++j) { v[i][j] = v[i][j] + y[i][j] * rr * gp[j]; *(f32x4*)(hw[i] + 4 * lane + 256 * j) = v[i][j];
                s2[i] += (v[i][j].x * v[i][j].x + v[i][j].y * v[i][j].y) + (v[i][j].z * v[i][j].z + v[i][j].w * v[i][j].w); } }
        if (gpre) {
#pragma unroll
            for (int o = 1; o < 64; o <<= 1) { s2[0] += __shfl_xor(s2[0], o); s2[1] += __shfl_xor(s2[1], o); }
#pragma unroll
            for (int i = 0; i < 2; ++i) { const float r2 = rsqrtf(s2[i] * (1.f / D) + EPS);
#pragma unroll
                for (int j = 0; j < 4; ++j) { const f32x4 o4 = v[i][j] * r2 * gq[j]; u32x2 w; w.x = pk2(o4.x, o4.y); w.y = pk2(o4.z, o4.w); *(u32x2*)(XN + (size_t)(r0 + i) * D + 4 * lane + 256 * j) = w; } }
        }
    }
}

template <class F> struct EpiT {
    static constexpr bool PERM = true, AFTER_DRAIN = false;
    F f;
    __device__ __forceinline__ void operator()(const f32x4 (&acc)[2][2][4][2], const pg8::Unit& u, int wr, int wc, int fr, int fq) const {
        const int row0 = u.pm * 256 + wr * 64 + fr, col0 = u.pn * 256 + wc * 32 + 8 * fq;
        if constexpr (F::HAS_BIAS) {
            const f32x4 b00 = *(const f32x4*)(f.bias + col0), b01 = *(const f32x4*)(f.bias + col0 + 4), b10 = *(const f32x4*)(f.bias + col0 + 128), b11 = *(const f32x4*)(f.bias + col0 + 132);
#pragma unroll
            for (int ai = 0; ai < 2; ++ai)
#pragma unroll
                for (int m = 0; m < 4; ++m) { f.apply(row0 + ai * 128 + m * 16, col0, acc[ai][0][m][0] + b00, acc[ai][0][m][1] + b01); f.apply(row0 + ai * 128 + m * 16, col0 + 128, acc[ai][1][m][0] + b10, acc[ai][1][m][1] + b11); }
            return;
        }
#pragma unroll
        for (int ai = 0; ai < 2; ++ai)
#pragma unroll
            for (int m = 0; m < 4; ++m)
#pragma unroll
                for (int bj = 0; bj < 2; ++bj) f.apply(row0 + ai * 128 + m * 16, col0 + bj * 128, acc[ai][bj][m][0], acc[ai][bj][m][1]);
    }
};
__device__ __forceinline__ void st_bf16x8(bf16* p, f32x4 v0, f32x4 v1) { u32x4 w; w.x = pk2(v0.x, v0.y); w.y = pk2(v0.z, v0.w); w.z = pk2(v1.x, v1.y); w.w = pk2(v1.z, v1.w); *(u32x4*)p = w; }
__device__ __forceinline__ void st_bf16x8_nt(bf16* p, f32x4 v0, f32x4 v1) { u32x4 w; w.x = pk2(v0.x, v0.y); w.y = pk2(v0.z, v0.w); w.z = pk2(v1.x, v1.y); w.w = pk2(v1.z, v1.w); __builtin_nontemporal_store(w, (u32x4*)p); }
__device__ __forceinline__ void ld_bf16x8(const bf16* p, f32x4& v0, f32x4& v1) { const u32x4 w = *(const u32x4*)p;
    v0 = (f32x4){bflo(w.x), bfhi(w.x), bflo(w.y), bfhi(w.y)}; v1 = (f32x4){bflo(w.z), bfhi(w.z), bflo(w.w), bfhi(w.w)}; }

#if defined(NT_STORES)
#define ST_BIG st_bf16x8_nt
#else
#define ST_BIG st_bf16x8
#endif
struct FIn {
    static constexpr bool HAS_BIAS = true, STAGGER = true;
    bf16* Z; float* ZF; const float* bias;
    __device__ __forceinline__ void apply(int row, int col, f32x4 v0, f32x4 v1) const {
        const int t = col >> 8;
        if (t >= 36) { float* p = ZF + (size_t)row * ZFW + (col - ZB); *(f32x4*)p = v0; *(f32x4*)(p + 4) = v1; return; }
        if (t < 2) { v0 *= 0.08838834764831845f; v1 *= 0.08838834764831845f; }
        else if (t >= 8 && t < 12) {
#pragma unroll
            for (int i = 0; i < 4; ++i) { v0[i] = silu_f(v0[i]); v1[i] = silu_f(v1[i]); } }
        else if (t >= 20) {
#pragma unroll
            for (int i = 0; i < 4; ++i) { v0[i] = sigmoid_f(v0[i]); v1[i] = sigmoid_f(v1[i]); } }
        ST_BIG(Z + (size_t)row * ZB + col, v0, v1);
    }
};
struct FQQ {
    static constexpr bool HAS_BIAS = false, STAGGER = false;
    bf16* QQ;
    __device__ __forceinline__ void apply(int row, int col, f32x4 v0, f32x4 v1) const {
        const float s = col < 2048 ? 0.08838834764831845f : 0.125f;
        st_bf16x8(QQ + (size_t)row * NQQ + col, v0 * s, v1 * s);
    }
};
template <int IDX> struct FBr {
    static constexpr bool HAS_BIAS = false;
    const bf16* Z; float* Y; bf16* MIX;
    __device__ __forceinline__ void apply(int row, int col, f32x4 v0, f32x4 v1) const {
        f32x4 g0, g1; ld_bf16x8(Z + (size_t)row * ZB + ZC_GATE + IDX * 1024 + col, g0, g1);
        float* y = Y + (size_t)row * D + col;
        f32x4 a0 = v0 * g0, a1 = v1 * g1;
        if (IDX > 0) { a0 += *(const f32x4*)y; a1 += *(const f32x4*)(y + 4); }
        if (IDX < 2) { *(f32x4*)y = a0; *(f32x4*)(y + 4) = a1; }
        else st_bf16x8(MIX + (size_t)row * D + col, a0, a1);
    }
};
struct FY {
    static constexpr bool HAS_BIAS = false, STAGGER = false;
    bf16* Y;
    __device__ __forceinline__ void apply(int row, int col, f32x4 v0, f32x4 v1) const { st_bf16x8(Y + (size_t)row * D + col, v0, v1); }
};
struct FUp {
    static constexpr bool HAS_BIAS = false, STAGGER = true;
    bf16* U;
    __device__ __forceinline__ void apply(int row, int col, f32x4 v0, f32x4 v1) const {
#pragma unroll
        for (int i = 0; i < 4; ++i) { const float p = fmaxf(v0[i], 0.f), q = fmaxf(v1[i], 0.f); v0[i] = p * p; v1[i] = q * q; }
#if defined(PROBE_NOSTORE)
        if (v0.x == 12345.678f) st_bf16x8(U + (size_t)row * DFF + col, v0, v1);
#else
        ST_BIG(U + (size_t)row * DFF + col, v0, v1);
#endif
    }
};

template <class F>
__device__ __forceinline__ void mini_gemm(LAS unsigned char* lds, const bf16* __restrict__ A, const bf16* __restrict__ Bt, int N, int K, const F& f, int tid_in) {
    int tid = tid_in; asm volatile("" : "+v"(tid));
    const int lane = tid & 63, wave = __builtin_amdgcn_readfirstlane(tid >> 6), fr = lane & 15, fq = lane >> 4;
    LAS float* red = (LAS float*)lds;
    const int kw = K >> 3, kbeg = wave * kw;
    for (int wt = blockIdx.x; wt < N / 32; wt += gridDim.x) {
        const int n0 = wt * 32;
        f32x4 acc0 = {0.f, 0.f, 0.f, 0.f}, acc1 = {0.f, 0.f, 0.f, 0.f};
        const bf16* ap = A + (size_t)(MR + fr) * K + fq * 8 + kbeg;
        const bf16* b0 = Bt + (size_t)(n0 + pg8::perm32(fr)) * K + fq * 8 + kbeg;
        const bf16* b1 = Bt + (size_t)(n0 + pg8::perm32(16 + fr)) * K + fq * 8 + kbeg;
        if (kw < 128) {
            const bf16x8 av = *(const bf16x8*)ap, w0 = *(const bf16x8*)b0, w1 = *(const bf16x8*)b1;
            acc0 = __builtin_amdgcn_mfma_f32_16x16x32_bf16(w0, av, acc0, 0, 0, 0);
            acc1 = __builtin_amdgcn_mfma_f32_16x16x32_bf16(w1, av, acc1, 0, 0, 0);
        } else {
            for (int k = 0; k < kw; k += 128) {
                bf16x8 av[4], w0[4], w1[4];
#pragma unroll
                for (int u = 0; u < 4; ++u) { av[u] = *(const bf16x8*)(ap + k + 32 * u); w0[u] = *(const bf16x8*)(b0 + k + 32 * u); w1[u] = *(const bf16x8*)(b1 + k + 32 * u); }
#pragma unroll
                for (int u = 0; u < 4; ++u) {
                    acc0 = __builtin_amdgcn_mfma_f32_16x16x32_bf16(w0[u], av[u], acc0, 0, 0, 0);
                    acc1 = __builtin_amdgcn_mfma_f32_16x16x32_bf16(w1[u], av[u], acc1, 0, 0, 0);
                }
            }
        }
        *(LAS f32x4*)(red + (wave * 64 + lane) * 8) = acc0; *(LAS f32x4*)(red + (wave * 64 + lane) * 8 + 4) = acc1;
        LDS_WAIT();
        __syncthreads();
        if (wave == 0) {
            f32x4 s0 = {0.f, 0.f, 0.f, 0.f}, s1 = {0.f, 0.f, 0.f, 0.f};
#pragma unroll
            for (int w = 0; w < 8; ++w) { s0 += *(const LAS f32x4*)(red + (w * 64 + lane) * 8); s1 += *(const LAS f32x4*)(red + (w * 64 + lane) * 8 + 4); }
            if constexpr (F::HAS_BIAS) { s0 += *(const f32x4*)(f.bias + n0 + 8 * fq); s1 += *(const f32x4*)(f.bias + n0 + 8 * fq + 4); }
            f.apply(MR + fr, n0 + 8 * fq, s0, s1);
        }
        __syncthreads();
    }
}
template <class F, bool ALIGN = true>
__device__ __forceinline__ void run_gemm(LAS unsigned char* lds, const bf16* A, const bf16* Bt, int N, int K, const F& f, int gw, int ngw, int lane) {
    asm volatile("" : "+s"(K)); asm volatile("" : "+s"(N));
    pg8::Gemm g{A, Bt, MR, N, K}; pg8::StaticOrder S; S.init(MR, N, (int)gridDim.x, (int)blockIdx.x);
    EpiT<F> E{f};
#if defined(STAGGER_TICKS)
    if (F::STAGGER) {
        const unsigned long long t0 = __builtin_amdgcn_s_memrealtime(), dl = (unsigned long long)(blockIdx.x & 3u) * STAGGER_TICKS;
        while (__builtin_amdgcn_s_memrealtime() - t0 < dl) __builtin_amdgcn_s_sleep(4);
    }
#endif
    pg8::gemm_phase<EpiT<F>, pg8::StaticOrder, ALIGN, true>((PG8_LAS unsigned char*)lds, g, S, E);
    mini_gemm(lds, A, Bt, N, K, f, (int)threadIdx.x);
}

struct ChainOrder {
    pg8::StaticOrder S;
    __device__ __forceinline__ bool next(int i, pg8::Unit& u) const { if (!S.next(i >> 2, u)) return false; u.sub = i & 3; return true; }
    __device__ __forceinline__ void a_ready(const pg8::Unit&) const {}
    __device__ __forceinline__ void done(const pg8::Unit&) const {}
};
struct EpiMix {
    static constexpr bool PERM = true, AFTER_DRAIN = false;
    const bf16* Z; bf16* MIX;
    __device__ __forceinline__ void mid(f32x4 (&acc)[2][2][4][2], const pg8::Unit& u, int wr, int wc, int fr, int fq) const {
        if (u.sub == 1) return;
        const int gi = u.sub == 0 ? 0 : 1;
        const int row0 = u.pm * 256 + wr * 64 + fr, col0 = u.pn * 256 + wc * 32 + 8 * fq;
#pragma unroll
        for (int ai = 0; ai < 2; ++ai) {
            u32x4 ga[4][2], gb[4][2];
#pragma unroll
            for (int m = 0; m < 4; ++m)
#pragma unroll
                for (int bj = 0; bj < 2; ++bj) { const bf16* gp = Z + (size_t)(row0 + ai * 128 + m * 16) * ZB + ZC_GATE + gi * 1024 + col0 + bj * 128;
                    ga[m][bj] = *(const u32x4*)gp; gb[m][bj] = *(const u32x4*)(gp + 1024); }
#pragma unroll
            for (int m = 0; m < 4; ++m)
#pragma unroll
                for (int bj = 0; bj < 2; ++bj) {
                    const u32x4 a = ga[m][bj], b = gb[m][bj];
                    f32x4 r0, r1;
                    r0.x = bflo(a.x) * __builtin_amdgcn_rcpf(bflo(b.x)); r0.y = bfhi(a.x) * __builtin_amdgcn_rcpf(bfhi(b.x)); r0.z = bflo(a.y) * __builtin_amdgcn_rcpf(bflo(b.y)); r0.w = bfhi(a.y) * __builtin_amdgcn_rcpf(bfhi(b.y));
                    r1.x = bflo(a.z) * __builtin_amdgcn_rcpf(bflo(b.z)); r1.y = bfhi(a.z) * __builtin_amdgcn_rcpf(bfhi(b.z)); r1.z = bflo(a.w) * __builtin_amdgcn_rcpf(bflo(b.w)); r1.w = bfhi(a.w) * __builtin_amdgcn_rcpf(bfhi(b.w));
                    acc[ai][bj][m][0] *= r0; acc[ai][bj][m][1] *= r1;
                }
            asm volatile("" ::: "memory");
        }
    }
    __device__ __forceinline__ void operator()(const f32x4 (&acc)[2][2][4][2], const pg8::Unit& u, int wr, int wc, int fr, int fq) const {
        const int row0 = u.pm * 256 + wr * 64 + fr, col0 = u.pn * 256 + wc * 32 + 8 * fq;
#pragma unroll
        for (int ai = 0; ai < 2; ++ai) {
            u32x4 gc[4][2];
#pragma unroll
            for (int m = 0; m < 4; ++m)
#pragma unroll
                for (int bj = 0; bj < 2; ++bj) gc[m][bj] = *(const u32x4*)(Z + (size_t)(row0 + ai * 128 + m * 16) * ZB + ZC_GATE + 2 * 1024 + col0 + bj * 128);
#pragma unroll
            for (int m = 0; m < 4; ++m)
#pragma unroll
                for (int bj = 0; bj < 2; ++bj) {
                    const u32x4 w = gc[m][bj];
                    const f32x4 g0 = {bflo(w.x), bfhi(w.x), bflo(w.y), bfhi(w.y)}, g1 = {bflo(w.z), bfhi(w.z), bflo(w.w), bfhi(w.w)};
                    st_bf16x8(MIX + (size_t)(row0 + ai * 128 + m * 16) * D + col0 + bj * 128, acc[ai][bj][m][0] * g0, acc[ai][bj][m][1] * g1);
                }
            asm volatile("" ::: "memory");
        }
    }
};

constexpr int CW_XCNT = 16384;
struct RmsExchange {
    float* xbuf; unsigned* cnt; unsigned* tmo; unsigned target;
    __device__ __forceinline__ void run(const f32x4 (&v)[2][2][4][2], const pg8::Unit& u, int wr, int wc, int fr, int fq, LAS unsigned char* lds, int wid, int lane) const {
        LAS float* P = (LAS float*)lds;
        LAS float* S = (LAS float*)(lds + 8192);
#pragma unroll
        for (int ai = 0; ai < 2; ++ai)
#pragma unroll
            for (int m = 0; m < 4; ++m) {
                float s = 0.f;
#pragma unroll
                for (int bj = 0; bj < 2; ++bj)
#pragma unroll
                    for (int n = 0; n < 2; ++n) { const f32x4 x = v[ai][bj][m][n]; s += (x.x * x.x + x.y * x.y) + (x.z * x.z + x.w * x.w); }
                s += __shfl_xor(s, 16); s += __shfl_xor(s, 32);
                if (fq == 0) P[(ai * 128 + wr * 64 + m * 16 + fr) * 4 + wc] = s;
            }
        LDS_BARRIER();
        const int row = wid * 32 + (lane & 31);
        if (lane < 32) {
            const f32x4 p = *(const LAS f32x4*)(P + row * 4);
            __hip_atomic_store(xbuf + ((size_t)(u.pm * 256 + row) * 4 + u.pn), (p.x + p.y) + (p.z + p.w), __ATOMIC_RELAXED, __HIP_MEMORY_SCOPE_AGENT);
        }
        asm volatile("s_waitcnt vmcnt(0)" ::: "memory");
        if (lane == 0) __hip_atomic_fetch_add(cnt + 64 * u.pm, 1u, __ATOMIC_RELAXED, __HIP_MEMORY_SCOPE_AGENT);
        if (wid == 0) {
            const unsigned long long t0 = __builtin_amdgcn_s_memrealtime();
            for (;;) {
                if ((unsigned)__builtin_amdgcn_readfirstlane(__hip_atomic_load(cnt + 64 * u.pm, __ATOMIC_RELAXED, __HIP_MEMORY_SCOPE_AGENT)) >= target) break;
                if (__builtin_amdgcn_s_memrealtime() - t0 > 2000000ull) { if (lane == 0) __hip_atomic_store(tmo, 1u, __ATOMIC_RELAXED, __HIP_MEMORY_SCOPE_AGENT); break; }
                __builtin_amdgcn_s_sleep(2);
            }
            __builtin_amdgcn_fence(__ATOMIC_ACQUIRE, "agent");
        }
        asm volatile("s_waitcnt vmcnt(0) lgkmcnt(0)" ::: "memory"); __builtin_amdgcn_s_barrier(); asm volatile("" ::: "memory");
        if (lane < 32) {
            const float* slot = xbuf + (size_t)(u.pm * 256 + row) * 4; float t = 0.f;
#pragma unroll
            for (int q = 0; q < 4; ++q) t += __hip_atomic_load(slot + q, __ATOMIC_RELAXED, __HIP_MEMORY_SCOPE_AGENT);
            S[row] = rsqrtf(t * (1.f / D) + EPS);
        }
        LDS_BARRIER();
    }
};
struct EpiResNorm {
    static constexpr bool PERM = true, AFTER_DRAIN = true;
    float* hb; bf16* XN; const float* gpost; const float* gpre; RmsExchange e1, e2;
    __device__ __forceinline__ void fused(f32x4 (&acc)[2][2][4][2], const pg8::Unit& u, int wr, int wc, int fr, int fq, LAS unsigned char* lds, int wid, int lane) const {
        const LAS float* S = (const LAS float*)(lds + 8192);
        const int col0 = u.pn * 256 + wc * 32 + 8 * fq;
        f32x4 g0[2], g1[2];
#pragma unroll
        for (int bj = 0; bj < 2; ++bj) { g0[bj] = *(const f32x4*)(gpost + col0 + bj * 128); g1[bj] = *(const f32x4*)(gpost + col0 + bj * 128 + 4); }
        e1.run(acc, u, wr, wc, fr, fq, lds, wid, lane);
#pragma unroll
        for (int ai = 0; ai < 2; ++ai)
#pragma unroll
            for (int m = 0; m < 4; ++m) {
                const int rl = ai * 128 + wr * 64 + m * 16 + fr; const float rs = S[rl];
                float* hp = hb + (size_t)(u.pm * 256 + rl) * D + col0;
                f32x4 h00 = *(const f32x4*)hp, h01 = *(const f32x4*)(hp + 4), h10 = *(const f32x4*)(hp + 128), h11 = *(const f32x4*)(hp + 132);
                h00 += acc[ai][0][m][0] * rs * g0[0]; h01 += acc[ai][0][m][1] * rs * g1[0]; h10 += acc[ai][1][m][0] * rs * g0[1]; h11 += acc[ai][1][m][1] * rs * g1[1];
                *(f32x4*)hp = h00; *(f32x4*)(hp + 4) = h01; *(f32x4*)(hp + 128) = h10; *(f32x4*)(hp + 132) = h11;
                acc[ai][0][m][0] = h00; acc[ai][0][m][1] = h01; acc[ai][1][m][0] = h10; acc[ai][1][m][1] = h11;
                asm volatile("" : "+v"(acc[ai][0][m][0]), "+v"(acc[ai][0][m][1]), "+v"(acc[ai][1][m][0]), "+v"(acc[ai][1][m][1]));
                if (m & 1) asm volatile("" ::: "memory");
            }
        if (!gpre) return;
        e2.run(acc, u, wr, wc, fr, fq, lds, wid, lane);
#pragma unroll
        for (int bj = 0; bj < 2; ++bj) { g0[bj] = *(const f32x4*)(gpre + col0 + bj * 128); g1[bj] = *(const f32x4*)(gpre + col0 + bj * 128 + 4); }
#pragma unroll
        for (int ai = 0; ai < 2; ++ai)
#pragma unroll
            for (int m = 0; m < 4; ++m) {
                const int rl = ai * 128 + wr * 64 + m * 16 + fr; const float rs = S[rl];
                bf16* xp = XN + (size_t)(u.pm * 256 + rl) * D + col0;
                st_bf16x8(xp, acc[ai][0][m][0] * rs * g0[0], acc[ai][0][m][1] * rs * g1[0]);
                st_bf16x8(xp + 128, acc[ai][1][m][0] * rs * g0[1], acc[ai][1][m][1] * rs * g1[1]);
            }
    }
};

__device__ __forceinline__ int prow(int r, int j) {
    if (r < MR) { const int s = r & (SEQ - 1); return (s - j >= 0) ? r - j : MR + (NMETA + s - j); }
    const int t = r - MR; return (t - j >= 0) ? r - j : -1;
}
__device__ __forceinline__ void p2_prep(ArgsP a, int l, int gw, int ngw, int lane) {
    unsigned char* ws = a->ws;
    const bf16* Z = (const bf16*)(ws + WS_Z);
    for (int r = gw; r < MT; r += ngw) {
        const float* zf = (const float*)(ws + WS_ZF) + (size_t)r * ZFW;
        f32x4 vq = *(const f32x4*)(zf + ZF_CQ + 4 * lane);
        f32x2 vk = *(const f32x2*)(zf + ZF_CKV + 2 * lane);
        const float vi = zf[ZF_IK + lane];
        const float vw = zf[ZF_IW + (lane & 7)];
        const f32x4 gq = *(const f32x4*)(a->in[I_GDQ] + l * 256 + 4 * lane);
        const f32x2 gk = *(const f32x2*)(a->in[I_GDKV] + l * 128 + 2 * lane);
        const float lg = a->in[I_LNG][l * 64 + lane], lb = a->in[I_LNB][l * 64 + lane];
        float s1 = (vq.x * vq.x + vq.y * vq.y) + (vq.z * vq.z + vq.w * vq.w), s2 = vk.x * vk.x + vk.y * vk.y, s3 = vi;
#pragma unroll
        for (int o = 1; o < 64; o <<= 1) { s1 += __shfl_xor(s1, o); s2 += __shfl_xor(s2, o); s3 += __shfl_xor(s3, o); }
        const float d = vi - s3 * (1.f / 64.f);
        const float var = wave_sum(d * d) * (1.f / 64.f);
        const float r1 = rsqrtf(s1 * (1.f / 256.f) + EPS), r2 = rsqrtf(s2 * (1.f / 128.f) + EPS);
        vq = vq * r1 * gq;
        { u32x2 w; w.x = pk2(vq.x, vq.y); w.y = pk2(vq.z, vq.w); *(u32x2*)((bf16*)(ws + WS_CQN) + (size_t)r * 256 + 4 * lane) = w; }
        *(unsigned*)((bf16*)(ws + WS_KV) + (size_t)r * 128 + 2 * lane) = pk2(vk.x * r2 * gk.x, vk.y * r2 * gk.y);
        ((bf16*)(ws + WS_KI))[(size_t)r * 64 + lane] = (bf16)f2bf(d * rsqrtf(var + EPS) * lg + lb);
        if (lane < 8) ((float*)(ws + WS_WI))[(size_t)r * 8 + lane] = vw * 0.35355339059327373f;
    }
}
__device__ __forceinline__ void p2_chunks(ArgsP a, LAS unsigned char* lds, int l, int gw, int ngw, int wave, int lane) {
    unsigned char* ws = a->ws;
    const bf16* Z = (const bf16*)(ws + WS_Z);
    float* DDp = (float*)(ws + WS_DD);
    LAS float* stg = (LAS float*)(lds + wave * 5120);
    for (int it = gw; it < 257 * 8; it += ngw) {
        const int cid = it >> 3, mx = (it >> 2) & 1, h = it & 3;
        const int nrows = cid == 256 ? NMETA : 64, rbase = cid == 256 ? MR : cid * 64;
        const int k0 = 2 * lane;
        const float* ZFr = (const float*)(ws + WS_ZF);
        const int rl = rbase + (lane < nrows ? lane : 0);
        if (!mx) {
            { const float* zf = ZFr + (size_t)rl * ZFW + ZF_A;
              const f32x4 a0 = *(const f32x4*)zf, a1 = *(const f32x4*)(zf + 4), a2 = *(const f32x4*)(zf + 8), a3 = *(const f32x4*)(zf + 12);
              *(LAS f32x4*)(stg + lane * 16) = a0; *(LAS f32x4*)(stg + lane * 16 + 4) = a1; *(LAS f32x4*)(stg + lane * 16 + 8) = a2; *(LAS f32x4*)(stg + lane * 16 + 12) = a3; }
            float w0[16], w1[16];
#pragma unroll
            for (int j = 0; j < 16; ++j) { const f32x2 w = *(const f32x2*)(a->in[I_WA2] + (size_t)(l * 16 + j) * 512 + h * 128 + k0); w0[j] = w.x; w1[j] = w.y; }
            const f32x2 bb = *(const f32x2*)(a->in[I_BA] + l * 512 + h * 128 + k0);
            bf16* QG = (bf16*)(ws + WS_G);
            float G0 = 0.f, G1 = 0.f;
            unsigned pq[16], pk[16];
#define P2G_LOAD(t0) do { _Pragma("unroll") for (int i = 0; i < 16; ++i) { const int r_ = rbase + (t0) + i; \
                pq[i] = *(const unsigned*)(Z + (size_t)r_ * ZB + ZC_GQ + h * 128 + k0); pk[i] = *(const unsigned*)(Z + (size_t)r_ * ZB + ZC_GK + h * 128 + k0); } } while (0)
            P2G_LOAD(0);
            LDS_WAIT();
            for (int t0 = 0; t0 < nrows; t0 += 16) {
                unsigned cqw[16], ckw[16];
#pragma unroll
                for (int i = 0; i < 16; ++i) { cqw[i] = pq[i]; ckw[i] = pk[i]; }
                if (t0 + 16 < nrows) P2G_LOAD(t0 + 16);
#pragma unroll
                for (int i = 0; i < 16; ++i) {
                    const int r = rbase + t0 + i;
                    const LAS float* ar = stg + (t0 + i) * 16;
                    const f32x4 a0 = *(const LAS f32x4*)ar, a1 = *(const LAS f32x4*)(ar + 4), a2 = *(const LAS f32x4*)(ar + 8), a3 = *(const LAS f32x4*)(ar + 12);
                    const float av[16] = {a0.x, a0.y, a0.z, a0.w, a1.x, a1.y, a1.z, a1.w, a2.x, a2.y, a2.z, a2.w, a3.x, a3.y, a3.z, a3.w};
                    float s0 = bb.x, s1 = bb.y;
#pragma unroll
                    for (int j = 0; j < 16; ++j) { s0 += av[j] * w0[j]; s1 += av[j] * w1[j]; }
                    G0 += logsigmoid_f(s0) * 0.0625f; G1 += logsigmoid_f(s1) * 0.0625f;
                    const float e0 = __expf(G0), e1 = __expf(G1), i0 = __builtin_amdgcn_rcpf(e0), i1 = __builtin_amdgcn_rcpf(e1);
                    *(unsigned*)(QG + (size_t)r * 1024 + h * 128 + k0) = pk2(bflo(cqw[i]) * e0, bfhi(cqw[i]) * e1);
                    *(unsigned*)(QG + (size_t)r * 1024 + 512 + h * 128 + k0) = pk2(bflo(ckw[i]) * i0, bfhi(ckw[i]) * i1);
                }
            }
#undef P2G_LOAD
            *(f32x2*)(DDp + ((size_t)cid * 4 + h) * 128 + k0) = (f32x2){__expf(G0), __expf(G1)};
            LDS_WAIT();
        } else {
            { const float* zf = ZFr + (size_t)rl * ZFW; stg[lane * 2] = zf[ZF_MI + h]; stg[lane * 2 + 1] = zf[ZF_MF + h]; }
            float cq[4][2], ck[4][2];
#pragma unroll
            for (int tap = 0; tap < 4; ++tap) { const f32x2 wq = *(const f32x2*)(a->in[I_CONV] + (size_t)(l * 4 + tap) * 1024 + h * 128 + k0), wk = *(const f32x2*)(a->in[I_CONV] + (size_t)(l * 4 + tap) * 1024 + 512 + h * 128 + k0);
                cq[tap][0] = wq.x; cq[tap][1] = wq.y; ck[tap][0] = wk.x; ck[tap][1] = wk.y; }
            const float fb = a->in[I_FB][l * 4 + h];
            bf16* QM = (bf16*)(ws + WS_QKC);
            float xq[3][2], xk[3][2];
#pragma unroll
            for (int j = 0; j < 3; ++j) {
                const int rp = prow(rbase, j + 1);
                const int rpc = rp >= 0 ? rp : rbase; const float m = rp >= 0 ? 1.f : 0.f;
                const unsigned qw = *(const unsigned*)(Z + (size_t)rpc * ZB + ZC_MQ + h * 128 + k0), kw = *(const unsigned*)(Z + (size_t)rpc * ZB + ZC_MK + h * 128 + k0);
                xq[j][0] = bflo(qw) * m; xq[j][1] = bfhi(qw) * m; xk[j][0] = bflo(kw) * m; xk[j][1] = bfhi(kw) * m;
            }
            float bsum = 0.f;
            unsigned pq[16], pk[16];
#define P2M_LOAD(t0) do { _Pragma("unroll") for (int i = 0; i < 16; ++i) { const int r_ = rbase + (t0) + i; \
                pq[i] = *(const unsigned*)(Z + (size_t)r_ * ZB + ZC_MQ + h * 128 + k0); pk[i] = *(const unsigned*)(Z + (size_t)r_ * ZB + ZC_MK + h * 128 + k0); } } while (0)
            P2M_LOAD(0);
            LDS_WAIT();
            for (int t0 = 0; t0 < nrows; t0 += 16) {
                unsigned cqw[16], ckw[16];
#pragma unroll
                for (int i = 0; i < 16; ++i) { cqw[i] = pq[i]; ckw[i] = pk[i]; }
                if (t0 + 16 < nrows) P2M_LOAD(t0 + 16);
#pragma unroll
                for (int i = 0; i < 16; ++i) {
                    const int r = rbase + t0 + i;
                    const f32x2 gt = *(const LAS f32x2*)(stg + (t0 + i) * 2);
                    const float li = gt.x, lf = logsigmoid_f(gt.y + fb);
                    bsum += lf;
                    const float q0 = bflo(cqw[i]), q1 = bfhi(cqw[i]), kk0 = bflo(ckw[i]), kk1 = bfhi(ckw[i]);
                    const float yq0 = cq[3][0] * q0 + cq[2][0] * xq[0][0] + cq[1][0] * xq[1][0] + cq[0][0] * xq[2][0];
                    const float yq1 = cq[3][1] * q1 + cq[2][1] * xq[0][1] + cq[1][1] * xq[1][1] + cq[0][1] * xq[2][1];
                    const float yk0 = ck[3][0] * kk0 + ck[2][0] * xk[0][0] + ck[1][0] * xk[1][0] + ck[0][0] * xk[2][0];
                    const float yk1 = ck[3][1] * kk1 + ck[2][1] * xk[0][1] + ck[1][1] * xk[1][1] + ck[0][1] * xk[2][1];
                    xq[2][0] = xq[1][0]; xq[2][1] = xq[1][1]; xq[1][0] = xq[0][0]; xq[1][1] = xq[0][1]; xq[0][0] = q0; xq[0][1] = q1;
                    xk[2][0] = xk[1][0]; xk[2][1] = xk[1][1]; xk[1][0] = xk[0][0]; xk[1][1] = xk[0][1]; xk[0][0] = kk0; xk[0][1] = kk1;
                    const float eq = __expf(bsum) * 0.08838834764831845f, ek = __expf(li - bsum);
                    *(unsigned*)(QM + (size_t)r * 1024 + h * 128 + k0) = pk2(silu_f(yq0) * eq, silu_f(yq1) * eq);
                    *(unsigned*)(QM + (size_t)r * 1024 + 512 + h * 128 + k0) = pk2(silu_f(yk0) * ek, silu_f(yk1) * ek);
                }
            }
#undef P2M_LOAD
            const float dd = __expf(bsum);
            *(f32x2*)(DDp + ((size_t)(257 + cid) * 4 + h) * 128 + k0) = (f32x2){dd, dd};
            LDS_WAIT();
        }
    }
}

constexpr int SC_QS = 272, SC_VS = 144;
constexpr int SC_QT = 0, SC_KT = 2 * 17408, SC_VT = 4 * 17408, SC_AT = SC_VT + 2 * 9216, SC_SB = SC_AT + 9216, SC_DD = SC_SB + 2 * 18432, SC_NB = SC_DD + 1024, SC_END = SC_NB + 512;
static_assert(SC_END <= RING_BYTES, "scan LDS");
__device__ __forceinline__ bf16x8 tr8(LAS unsigned char* base, int stride, int row0, int col0, int lane) {
    const int fq = lane >> 4, q4 = (lane & 15) >> 2, p4 = lane & 3;
    LAS unsigned char* p = base + (row0 + 8 * fq + q4) * stride + (col0 + 4 * p4) * 2;
    const s16x4 lo = __builtin_amdgcn_ds_read_tr16_b64_v4i16((LAS s16x4*)p);
    const s16x4 hi = __builtin_amdgcn_ds_read_tr16_b64_v4i16((LAS s16x4*)(p + 4 * stride));
    return __builtin_shufflevector(lo, hi, 0, 1, 2, 3, 4, 5, 6, 7);
}
template <bool ML>
__device__ __forceinline__ void scan_unit(ArgsP a, LAS unsigned char* lds, int b, int h, int vs, int tid_in) {
    int tid = tid_in; asm volatile("" : "+v"(tid));
    unsigned char* ws = a->ws;
    const bf16* Z = (const bf16*)(ws + WS_Z);
    const bf16* QK = (const bf16*)(ws + (ML ? WS_QKC : WS_G));
    const float* DDp = (const float*)(ws + WS_DD) + (ML ? (size_t)257 * 512 : 0);
    bf16* O = (bf16*)(ws + (ML ? WS_OM : WS_OG));
    const int lane = tid & 63, wave = __builtin_amdgcn_readfirstlane(tid >> 6), fr = lane & 15, fq = lane >> 4;
    const int vt = wave & 3, hh = wave >> 2;
    for (int i = tid; i < (2 * 18432 + 1024 + 512) / 4; i += 512) ((LAS unsigned*)(lds + SC_SB))[i] = 0u;
    f32x4 S[4], nacc[4];
#pragma unroll
    for (int i = 0; i < 4; ++i) { S[i] = (f32x4){0.f, 0.f, 0.f, 0.f}; nacc[i] = (f32x4){0.f, 0.f, 0.f, 0.f}; }
    const bf16x8 ones = {(short)0x3F80, (short)0x3F80, (short)0x3F80, (short)0x3F80, (short)0x3F80, (short)0x3F80, (short)0x3F80, (short)0x3F80};
    u32x4 gq[2], gk[2], gv; float gd = 0.f;
    const int vcol = (ML ? ZC_MV : ZC_GV) + h * 256 + vs * 64;
    const bf16* zpage = (const bf16*)(ws + WS_CTL + 512 * 1024);
#define SCAN_LOAD(c) do { const int c_ = (c); \
        _Pragma("unroll") for (int e = 0; e < 2; ++e) { const int pid = tid + 512 * e, t = pid >> 4, ch = pid & 15; \
            const bool ok = c_ > 0 || t >= 48; const int row = c_ == 0 ? MR + t - 48 : b * SEQ + (c_ - 1) * 64 + t; \
            const bf16* qp_ = ok ? QK + (size_t)row * 1024 + h * 128 + ch * 8 : zpage; \
            gq[e] = *(const u32x4*)qp_; gk[e] = *(const u32x4*)(qp_ + 512); } \
        { const int t = tid >> 3, ch = tid & 7; const bool ok = c_ > 0 || t >= 48; const int row = c_ == 0 ? MR + t - 48 : b * SEQ + (c_ - 1) * 64 + t; \
          gv = *(const u32x4*)(ok ? Z + (size_t)row * ZB + vcol + ch * 8 : zpage); } \
        { const int cid = c_ == 0 ? 256 : b * 32 + (c_ - 1); gd = DDp[((size_t)cid * 4 + h) * 128 + (tid & 127)]; } } while (0)
#define SCAN_STORE(buf) do { const int bo_ = (buf); \
        _Pragma("unroll") for (int e = 0; e < 2; ++e) { const int pid = tid + 512 * e, t = pid >> 4, ch = pid & 15; \
            *(LAS u32x4*)(lds + SC_QT + bo_ * 17408 + t * SC_QS + ch * 16) = gq[e]; *(LAS u32x4*)(lds + SC_KT + bo_ * 17408 + t * SC_QS + ch * 16) = gk[e]; } \
        { const int t = tid >> 3, ch = tid & 7; *(LAS u32x4*)(lds + SC_VT + bo_ * 9216 + t * SC_VS + ch * 16) = gv; } \
        if (tid < 128) ((LAS float*)(lds + SC_DD))[bo_ * 128 + tid] = gd; } while (0)
    SCAN_LOAD(0);
    __syncthreads();
    SCAN_STORE(0);
    __syncthreads();
    for (int c = 0; c < 33; ++c) {
        const int buf = c & 1;
        LAS unsigned char* QT = lds + SC_QT + buf * 17408; LAS unsigned char* KT = lds + SC_KT + buf * 17408; LAS unsigned char* VT = lds + SC_VT + buf * 9216;
        LAS unsigned char* AT = lds + SC_AT; LAS unsigned char* SB = lds + SC_SB + buf * 18432; LAS unsigned char* SBn = lds + SC_SB + (buf ^ 1) * 18432;
        const LAS float* ddL = (const LAS float*)(lds + SC_DD) + buf * 128;
        if (c + 1 < 33) SCAN_LOAD(c + 1);
        {
            const int ti = wave >> 1;
#pragma unroll
            for (int sj = 0; sj < 2; ++sj) {
                const int si = 2 * (wave & 1) + sj;
                f32x4 acc = {0.f, 0.f, 0.f, 0.f};
                bf16x8 qa[4], kb[4];
#pragma unroll
                for (int ks = 0; ks < 4; ++ks) { qa[ks] = *(const LAS bf16x8*)(QT + (16 * ti + fr) * SC_QS + (32 * ks + 8 * fq) * 2); kb[ks] = *(const LAS bf16x8*)(KT + (16 * si + fr) * SC_QS + (32 * ks + 8 * fq) * 2); }
                asm volatile("" ::: "memory");
#pragma unroll
                for (int ks = 0; ks < 4; ++ks) acc = __builtin_amdgcn_mfma_f32_16x16x32_bf16(qa[ks], kb[ks], acc, 0, 0, 0);
                const int sg = 16 * si + fr, tg = 16 * ti + 4 * fq;
                LAS bf16* ap = (LAS bf16*)(AT + tg * SC_VS) + sg;
                ap[0 * (SC_VS / 2)] = (bf16)(sg <= tg + 0 ? f2bf(acc.x) : 0u);
                ap[1 * (SC_VS / 2)] = (bf16)(sg <= tg + 1 ? f2bf(acc.y) : 0u);
                ap[2 * (SC_VS / 2)] = (bf16)(sg <= tg + 2 ? f2bf(acc.z) : 0u);
                ap[3 * (SC_VS / 2)] = (bf16)(sg <= tg + 3 ? f2bf(acc.w) : 0u);
            }
        }
        {
            const bf16x8 vb0 = tr8(VT, SC_VS, 0, 16 * vt, lane), vb1 = tr8(VT, SC_VS, 32, 16 * vt, lane);
#pragma unroll
            for (int i = 0; i < 4; ++i) {
                const int kt = 4 * hh + i;
                const bf16x8 ka0 = tr8(KT, SC_QS, 0, 16 * kt, lane), ka1 = tr8(KT, SC_QS, 32, 16 * kt, lane);
                f32x4 acc = S[i];
                acc = __builtin_amdgcn_mfma_f32_16x16x32_bf16(ka0, vb0, acc, 0, 0, 0);
                acc = __builtin_amdgcn_mfma_f32_16x16x32_bf16(ka1, vb1, acc, 0, 0, 0);
                const f32x4 dv = *(const LAS f32x4*)(ddL + 16 * kt + 4 * fq);
                S[i] = acc * dv;
                if (ML) {
                    f32x4 na = nacc[i];
                    na = __builtin_amdgcn_mfma_f32_16x16x32_bf16(ka0, ones, na, 0, 0, 0);
                    na = __builtin_amdgcn_mfma_f32_16x16x32_bf16(ka1, ones, na, 0, 0, 0);
                    nacc[i] = na * dv;
                }
            }
        }
        {
#pragma unroll
            for (int i = 0; i < 4; ++i) {
                const int k0 = 16 * (4 * hh + i) + 4 * fq;
                LAS bf16* sp = (LAS bf16*)(SBn + k0 * SC_VS) + 16 * vt + fr;
                sp[0 * (SC_VS / 2)] = (bf16)f2bf(S[i].x); sp[1 * (SC_VS / 2)] = (bf16)f2bf(S[i].y); sp[2 * (SC_VS / 2)] = (bf16)f2bf(S[i].z); sp[3 * (SC_VS / 2)] = (bf16)f2bf(S[i].w);
                if (ML && vt == 0 && fr == 0) { LAS bf16* np = (LAS bf16*)(lds + SC_NB + (buf ^ 1) * 256) + k0; np[0] = (bf16)f2bf(nacc[i].x); np[1] = (bf16)f2bf(nacc[i].y); np[2] = (bf16)f2bf(nacc[i].z); np[3] = (bf16)f2bf(nacc[i].w); }
            }
        }
        LDS_BARRIER();
#if defined(DIAG_SEL)
        if (blockIdx.x == 0 && tid == 0) { volatile LAS unsigned* M_ = (volatile LAS unsigned*)(lds + MISC_OFF); const unsigned now_ = (unsigned)__builtin_amdgcn_s_memrealtime(); M_[16 + 12] += now_ - M_[15]; M_[15] = now_; }
#endif
        {
            const bf16x8 vb0 = tr8(VT, SC_VS, 0, 16 * vt, lane), vb1 = tr8(VT, SC_VS, 32, 16 * vt, lane);
            bf16x8 sb[4];
#pragma unroll
            for (int ks = 0; ks < 4; ++ks) sb[ks] = tr8(SB, SC_VS, 32 * ks, 16 * vt, lane);
            bf16x8 nb[4];
            if (ML) {
#pragma unroll
                for (int ks = 0; ks < 4; ++ks) nb[ks] = *(const LAS bf16x8*)(lds + SC_NB + buf * 256 + (32 * ks + 8 * fq) * 2);
            }
            u32x2 ow[2];
#pragma unroll
            for (int tj = 0; tj < 2; ++tj) {
                const int ti = 2 * hh + tj;
                f32x4 acc = {0.f, 0.f, 0.f, 0.f}, den = {0.f, 0.f, 0.f, 0.f};
                bf16x8 qa[4];
#pragma unroll
                for (int ks = 0; ks < 4; ++ks) qa[ks] = *(const LAS bf16x8*)(QT + (16 * ti + fr) * SC_QS + (32 * ks + 8 * fq) * 2);
                const bf16x8 aa0 = *(const LAS bf16x8*)(AT + (16 * ti + fr) * SC_VS + (8 * fq) * 2), aa1 = *(const LAS bf16x8*)(AT + (16 * ti + fr) * SC_VS + (32 + 8 * fq) * 2);
                asm volatile("" ::: "memory");
#pragma unroll
                for (int ks = 0; ks < 4; ++ks) {
                    acc = __builtin_amdgcn_mfma_f32_16x16x32_bf16(sb[ks], qa[ks], acc, 0, 0, 0);
                    if (ML) den = __builtin_amdgcn_mfma_f32_16x16x32_bf16(nb[ks], qa[ks], den, 0, 0, 0);
                }
                acc = __builtin_amdgcn_mfma_f32_16x16x32_bf16(vb0, aa0, acc, 0, 0, 0);
                acc = __builtin_amdgcn_mfma_f32_16x16x32_bf16(vb1, aa1, acc, 0, 0, 0);
                if (ML) {
                    den = __builtin_amdgcn_mfma_f32_16x16x32_bf16(ones, aa0, den, 0, 0, 0);
                    den = __builtin_amdgcn_mfma_f32_16x16x32_bf16(ones, aa1, den, 0, 0, 0);
                    const float rd = __builtin_amdgcn_rcpf(fmaxf(fabsf(den.x), 1.f));
                    acc *= rd;
                }
                ow[tj].x = pk2(acc.x, acc.y); ow[tj].y = pk2(acc.z, acc.w);
            }
            if (c + 1 < 33) SCAN_STORE(buf ^ 1);
#pragma unroll
            for (int tj = 0; tj < 2; ++tj) {
                const int t = 16 * (2 * hh + tj) + fr;
                const bool okr = c > 0 || t >= 48;
                const int rowb = c == 0 ? MR + t - 48 : b * SEQ + (c - 1) * 64 + t;
                bf16* op = okr ? O + (size_t)rowb * 1024 + h * 256 + vs * 64 + 16 * vt + 4 * fq : (bf16*)(ws + WS_BIN + 512 * 1024) + (size_t)tid * 4;
                *(u32x2*)op = ow[tj];
            }
        }
        LDS_BARRIER();
#if defined(DIAG_SEL)
        if (blockIdx.x == 0 && tid == 0) { volatile LAS unsigned* M_ = (volatile LAS unsigned*)(lds + MISC_OFF); const unsigned now_ = (unsigned)__builtin_amdgcn_s_memrealtime(); M_[16 + 13] += now_ - M_[15]; M_[15] = now_; }
#endif
    }
#undef SCAN_LOAD
#undef SCAN_STORE
}

template <bool DRY = false>
__device__ __forceinline__ void p6_headnorm(ArgsP a, int l, int gw, int ngw, int lane) {
    unsigned char* ws = a->ws; const bf16* Z = (const bf16*)(ws + WS_Z);
    const f32x4 gg0 = *(const f32x4*)(a->in[I_GGLA] + l * 256 + 4 * lane), gg1 = *(const f32x4*)(a->in[I_GML] + l * 256 + 4 * lane);
    for (int it0 = gw * 4; it0 < MT * 8; it0 += ngw * 4) {
        u32x2 w[4], gw2[4]; bf16* op[4];
#pragma unroll
        for (int i = 0; i < 4; ++i) { const int it = it0 + i, r = it >> 3, mx = (it >> 2) & 1, h = it & 3;
            op[i] = (bf16*)(ws + (mx ? WS_OM : WS_OG)) + (size_t)r * 1024 + h * 256 + 4 * lane;
            w[i] = *(const u32x2*)op[i];
            gw2[i] = *(const u32x2*)(Z + (size_t)r * ZB + (mx ? ZC_MO : ZC_GR) + h * 256 + 4 * lane); }
        f32x4 v[4]; float ss[4];
#pragma unroll
        for (int i = 0; i < 4; ++i) { v[i] = (f32x4){bflo(w[i].x), bfhi(w[i].x), bflo(w[i].y), bfhi(w[i].y)}; ss[i] = (v[i].x * v[i].x + v[i].y * v[i].y) + (v[i].z * v[i].z + v[i].w * v[i].w); }
#pragma unroll
        for (int o = 1; o < 64; o <<= 1) {
#pragma unroll
            for (int i = 0; i < 4; ++i) ss[i] += __shfl_xor(ss[i], o);
        }
#pragma unroll
        for (int i = 0; i < 4; ++i) {
            const int mx = ((it0 + i) >> 2) & 1;
            const float rr = rsqrtf(ss[i] * (1.f / 256.f) + EPS);
            const f32x4 gt = {bflo(gw2[i].x), bfhi(gw2[i].x), bflo(gw2[i].y), bfhi(gw2[i].y)};
            const f32x4 o4 = v[i] * rr * (mx ? gg1 : gg0) * gt;
            u32x2 o; o.x = pk2(o4.x, o4.y); o.y = pk2(o4.z, o4.w);
            *(u32x2*)(DRY ? (bf16*)(ws + WS_XN) + ((size_t)((it0 + i) >> 3) * 1024 + ((it0 + i) & 3) * 256 + 4 * lane) : op[i]) = o;
        }
    }
}

__device__ __forceinline__ int krow(int b, int s) { return s < NMETA ? MR + s : b * SEQ + (s - NMETA); }
__device__ __forceinline__ int t5_bucket(int n) {
    if (n < 16) return n < 0 ? 0 : n;
    const int lg = 16 + (int)(__logf((float)n * (1.f / 16.f)) / 2.0794415416798357f * 16.f);
    return lg < 31 ? lg : 31;
}
__device__ __forceinline__ unsigned off_b(unsigned row, unsigned ch) { return 256u * row + 16u * (ch ^ (((row & 3) << 2) | ((row >> 2) & 3))); }
__device__ __forceinline__ s16x4 tr_rd(LAS unsigned char* p) { return __builtin_amdgcn_ds_read_tr16_b64_v4i16((LAS s16x4*)p); }

constexpr int DW2_STRIDE = 9472, DW2_TILE = 0, DW2_SEL = 8192, DW2_BK = 8832, DSA2_T5 = 8 * DW2_STRIDE, DSA2_BT = DSA2_T5 + 2048 + 64;

__device__ __forceinline__ int wave_sum_dpp(int x) {
    x += __builtin_amdgcn_update_dpp(0, x, 0xB1, 0xf, 0xf, false);
    x += __builtin_amdgcn_update_dpp(0, x, 0x4E, 0xf, 0xf, false);
    x += __builtin_amdgcn_update_dpp(0, x, 0x141, 0xf, 0xf, false);
    x += __builtin_amdgcn_update_dpp(0, x, 0x140, 0xf, 0xf, false);
    return __builtin_amdgcn_readlane(x, 0) + __builtin_amdgcn_readlane(x, 16) + __builtin_amdgcn_readlane(x, 32) + __builtin_amdgcn_readlane(x, 48);
}
__device__ __forceinline__ int wave_scan_dpp(int x) {
    x += __builtin_amdgcn_update_dpp(0, x, 0x111, 0xf, 0xf, false);
    x += __builtin_amdgcn_update_dpp(0, x, 0x112, 0xf, 0xf, false);
    x += __builtin_amdgcn_update_dpp(0, x, 0x114, 0xf, 0xf, false);
    x += __builtin_amdgcn_update_dpp(0, x, 0x118, 0xf, 0xf, false);
    x += __builtin_amdgcn_update_dpp(0, x, 0x142, 0xa, 0xf, false);
    x += __builtin_amdgcn_update_dpp(0, x, 0x143, 0xc, 0xf, false);
    return x;
}
#if defined(DIAG_SEL)
#ifndef DIAG_BLK
#define DIAG_BLK 31
#endif
#define DSTAMP(slot) do { if (blockIdx.x == DIAG_BLK && threadIdx.x == 0) { volatile LAS unsigned* M_ = (volatile LAS unsigned*)(lds + MISC_OFF); const unsigned now_ = (unsigned)__builtin_amdgcn_s_memrealtime(); M_[slot] += now_ - M_[14]; M_[14] = now_; } } while (0)
#else
#define DSTAMP(slot) do {} while (0)
#endif
template <bool DENSE_ONLY>
__device__ __forceinline__ void dsa_unit(ArgsP a, LAS unsigned char* lds, int b, int c, int nq, int wave, int lane_in) {
    int lane = lane_in; asm volatile("" : "+v"(lane));
    unsigned char* ws = a->ws;
    const bf16* QQ = (const bf16*)(ws + WS_QQ); const bf16* KI = (const bf16*)(ws + WS_KI); const bf16* KV = (const bf16*)(ws + WS_KV);
    unsigned* SC = (unsigned*)(ws + WS_SC) + (size_t)blockIdx.x * 64 * SC_PITCH;
    const int r0 = DENSE_ONLY ? MR : b * SEQ + 64 * c, p0 = DENSE_ONLY ? 0 : NMETA + 64 * c;
    const int fr = lane & 15, fq = lane >> 4;
    if (!DENSE_ONLY) {
        const int qt = wave & 3, kh = wave >> 2;
        if (p0 + 16 * qt + 15 >= 256) {
            const int qrow = r0 + 16 * qt + fr, pq = p0 + 16 * qt + fr;
            bf16x8 qf[8][2];
#pragma unroll
            for (int h = 0; h < 8; ++h)
#pragma unroll
                for (int ks = 0; ks < 2; ++ks) qf[h][ks] = *(const bf16x8*)(QQ + (size_t)qrow * NQQ + 2048 + h * 64 + ks * 32 + 8 * fq);
            float wi[8];
            { const f32x4 w0 = *(const f32x4*)((const float*)(ws + WS_WI) + (size_t)qrow * 8), w1 = *(const f32x4*)((const float*)(ws + WS_WI) + (size_t)qrow * 8 + 4);
              wi[0] = w0.x; wi[1] = w0.y; wi[2] = w0.z; wi[3] = w0.w; wi[4] = w1.x; wi[5] = w1.y; wi[6] = w1.z; wi[7] = w1.w; }
            const int nkt = 2 + 4 * c + qt;
            unsigned* scq = SC + (size_t)(16 * qt + fr) * SC_PITCH + 4 * fq;
            bf16x8 pa0[4], pa1[4];
#define DSA_KLOAD(kt0_) do { _Pragma("unroll") for (int j = 0; j < 4; ++j) { const int kt_ = (kt0_) + 2 * j < nkt ? (kt0_) + 2 * j : nkt - 1; \
                const bf16* kp_ = KI + (size_t)krow(b, 16 * kt_ + fr) * 64 + 8 * fq; pa0[j] = *(const bf16x8*)kp_; pa1[j] = *(const bf16x8*)(kp_ + 32); } } while (0)
            DSA_KLOAD(kh);
            for (int kt0 = kh; kt0 < nkt; kt0 += 8) {
                bf16x8 a0[4], a1[4];
#pragma unroll
                for (int j = 0; j < 4; ++j) { a0[j] = pa0[j]; a1[j] = pa1[j]; }
                if (kt0 + 8 < nkt) DSA_KLOAD(kt0 + 8);
#pragma unroll
                for (int j = 0; j < 4; ++j) {
                    const int kt = kt0 + 2 * j;
                    float s0 = 0.f, s1 = 0.f, s2 = 0.f, s3 = 0.f;
#pragma unroll
                    for (int h = 0; h < 8; ++h) {
                        f32x4 acc = {0.f, 0.f, 0.f, 0.f};
                        acc = __builtin_amdgcn_mfma_f32_16x16x32_bf16(a0[j], qf[h][0], acc, 0, 0, 0);
                        acc = __builtin_amdgcn_mfma_f32_16x16x32_bf16(a1[j], qf[h][1], acc, 0, 0, 0);
                        s0 += wi[h] * fmaxf(acc.x, 0.f); s1 += wi[h] * fmaxf(acc.y, 0.f); s2 += wi[h] * fmaxf(acc.z, 0.f); s3 += wi[h] * fmaxf(acc.w, 0.f);
                    }
                    const int kb = 16 * kt + 4 * fq;
                    u32x4 o;
                    { const unsigned bits = __builtin_bit_cast(unsigned, s0); o.x = (kb + 0) <= pq ? (bits ^ ((bits >> 31) ? 0xffffffffu : 0x80000000u)) : 0u; }
                    { const unsigned bits = __builtin_bit_cast(unsigned, s1); o.y = (kb + 1) <= pq ? (bits ^ ((bits >> 31) ? 0xffffffffu : 0x80000000u)) : 0u; }
                    { const unsigned bits = __builtin_bit_cast(unsigned, s2); o.z = (kb + 2) <= pq ? (bits ^ ((bits >> 31) ? 0xffffffffu : 0x80000000u)) : 0u; }
                    { const unsigned bits = __builtin_bit_cast(unsigned, s3); o.w = (kb + 3) <= pq ? (bits ^ ((bits >> 31) ? 0xffffffffu : 0x80000000u)) : 0u; }
                    if (kt < nkt) *(u32x4*)(scq + 16 * kt) = o;
                }
            }
#undef DSA_KLOAD
        }
        VM_WAIT();
        __syncthreads();
        DSTAMP(24);
    }
    LAS unsigned char* wl = lds + wave * DW2_STRIDE;
    LAS unsigned char* tile = wl + DW2_TILE;
    LAS unsigned short* selL = (LAS unsigned short*)(wl + DW2_SEL);
    LAS unsigned short* bkL = (LAS unsigned short*)(wl + DW2_BK);
    const LAS float* t5L = (const LAS float*)(lds + DSA2_T5);
    const LAS unsigned short* bkT = (const LAS unsigned short*)(lds + DSA2_BT);
    const int nqw = DENSE_ONLY ? 2 : 8;
    unsigned u[33];
#define DSA_ULOAD(iq_) do { const int nk_ = p0 + (iq_) + 1; const unsigned* scr_ = SC + (size_t)(iq_) * SC_PITCH; \
        _Pragma("unroll") for (int i = 0; i < 33; ++i) { const int s = lane + 64 * i; u[i] = s < nk_ ? __hip_atomic_load(scr_ + s, __ATOMIC_RELAXED, __HIP_MEMORY_SCOPE_AGENT) : 0u; } } while (0)
    for (int qi_ = 0; qi_ < nqw; ++qi_) {
        asm volatile("" : "+v"(lane));
        const int iq = wave * nqw + qi_;
        if (iq >= nq) break;
        const int p = p0 + iq, nk = p + 1, qrow = r0 + iq;
        int nsel;
        if (!DENSE_ONLY && nk > 256) {
            DSA_ULOAD(iq);
            unsigned tau = 0u;
            for (int bit = 31; bit >= 16; --bit) {
                const unsigned cand = tau | (1u << bit);
                int cnt = 0;
#pragma unroll
                for (int i = 0; i < 33; ++i) cnt += (u[i] >= cand) ? 1 : 0;
                if (wave_sum_dpp(cnt) >= 256) tau = cand;
            }
            DSTAMP(16);
            {
                const unsigned hi = tau >> 16;
                int cab = 0, cc = 0;
#pragma unroll
                for (int i = 0; i < 33; ++i) { const unsigned uh = u[i] >> 16; cab += (uh > hi) ? 1 : 0; cc += (uh == hi) ? 1 : 0; }
                cab = wave_sum_dpp(cab);
                const int cin = wave_scan_dpp(cc);
                const int ncand = __builtin_amdgcn_readlane(cin, 63);
                LAS unsigned short* candL = (LAS unsigned short*)tile;
                int off = cin - cc;
#pragma unroll
                for (int i = 0; i < 33; ++i) { const bool is = (u[i] >> 16) == hi; candL[is ? off : 3072 + lane] = (unsigned short)(u[i] & 0xffffu); off += is ? 1 : 0; }
                LDS_WAIT();
                const int need = 256 - cab;
                unsigned lo = 0u;
                if (ncand <= 64) {
                    const unsigned v = lane < ncand ? (unsigned)candL[lane] + 1u : 0u;
                    for (int bit = 15; bit >= 0; --bit) { const unsigned cand = lo | (1u << bit); if (__popcll(__ballot(v >= cand + 1u)) >= need) lo = cand; }
                } else {
                    for (int bit = 15; bit >= 0; --bit) {
                        const unsigned cand = lo | (1u << bit); int cnt = 0;
                        for (int j = lane; j < ((ncand + 63) & ~63); j += 64) { const unsigned v = j < ncand ? (unsigned)candL[j] + 1u : 0u; cnt += __popcll(__ballot(v >= cand + 1u)); }
                        if (cnt >= need) lo = cand;
                    }
                }
                tau |= lo;
                LDS_WAIT();
            }
            DSTAMP(17);
            unsigned short bkv[33];
#pragma unroll
            for (int i = 0; i < 33; ++i) { const int d = p - (lane + 64 * i); bkv[i] = bkT[d > 0 ? d : 0]; }
            int cge = 0, ceq = 0;
#pragma unroll
            for (int i = 0; i < 33; ++i) { cge += (u[i] >= tau) ? 1 : 0; ceq += (u[i] == tau) ? 1 : 0; }
            const int tge = wave_sum_dpp(cge);
            if (tge == 256) {
                const int cin = wave_scan_dpp(cge);
                int off = cin - cge;
#pragma unroll
                for (int i = 0; i < 33; ++i) { const bool take = u[i] >= tau; const int pos = take ? off : 256 + lane;
                    selL[pos] = (unsigned short)(lane + 64 * i); bkL[pos] = bkv[i]; off += take ? 1 : 0; }
            } else {
                const int rem = 256 - (tge - wave_sum_dpp(ceq));
                const unsigned long long lt = (1ull << lane) - 1ull;
                int base = 0, eqseen = 0;
#pragma unroll
                for (int i = 0; i < 33; ++i) {
                    const bool gt = u[i] > tau, eq = u[i] == tau;
                    const unsigned long long meq = __ballot(eq);
                    const bool take = gt || (eq && (eqseen + __popcll(meq & lt)) < rem);
                    const unsigned long long mt = __ballot(take);
                    const int pos = take ? base + __popcll(mt & lt) : 256 + lane;
                    selL[pos] = (unsigned short)(lane + 64 * i); bkL[pos] = bkv[i];
                    base += __popcll(mt); eqseen += __popcll(meq);
                }
            }
            nsel = 256;
        } else {
#pragma unroll
            for (int m = 0; m < 4; ++m) { const int s = lane + 64 * m; selL[s] = (unsigned short)(s < nk ? s : 0); bkL[s] = bkT[s < nk ? p - s : 0]; }
            nsel = nk;
        }
        DSTAMP(25);
        asm volatile("" : "+v"(lane));
        bf16x8 qB[4];
#pragma unroll
        for (int ks = 0; ks < 4; ++ks) qB[ks] = *(const bf16x8*)(QQ + (size_t)qrow * NQQ + fr * 128 + ks * 32 + 8 * fq);
        LDS_WAIT();
        f32x4 O[8];
#pragma unroll
        for (int nt = 0; nt < 8; ++nt) O[nt] = (f32x4){0.f, 0.f, 0.f, 0.f};
        float qss = 0.f;
#pragma unroll
        for (int ks = 0; ks < 4; ++ks) { const u32x4 w = __builtin_bit_cast(u32x4, qB[ks]);
            qss += (bflo(w.x) * bflo(w.x) + bfhi(w.x) * bfhi(w.x)) + (bflo(w.y) * bflo(w.y) + bfhi(w.y) * bfhi(w.y)) + (bflo(w.z) * bflo(w.z) + bfhi(w.z) * bfhi(w.z)) + (bflo(w.w) * bflo(w.w) + bfhi(w.w) * bfhi(w.w)); }
        qss += __shfl_xor(qss, 16); qss += __shfl_xor(qss, 32);
        const float mb = sqrtf(qss) * t5L[512] + t5L[513];
        float lrun = 0.f;
        const int nblk = (nsel + 31) >> 5;
#define DSA_GATHER(GV, blk_) do { _Pragma("unroll") for (int e = 0; e < 8; ++e) { const int pid = lane + 64 * e, ri = pid >> 4, ch = pid & 15, j = 32 * (blk_) + ri; \
            const int key = (int)selL[j]; GV[e] = *(const u32x4*)(KV + (size_t)krow(b, key) * 128 + ch * 8); } } while (0)
#define DSA_PUT(GV) do { _Pragma("unroll") for (int e = 0; e < 8; ++e) { const int pid = lane + 64 * e, ri = pid >> 4, ch = pid & 15; *(LAS u32x4*)(tile + off_b(ri, ch)) = GV[e]; } } while (0)
        u32x4 gvA[8], gvB[8];
        DSA_GATHER(gvA, 0);
        if (nblk > 1) DSA_GATHER(gvB, 1);
        for (int blk0 = 0; blk0 < nblk; blk0 += 2) {
#pragma unroll
            for (int half = 0; half < 2; ++half) {
                const int blk = blk0 + half;
                if (blk < nblk) {
                    if (half == 0) { DSA_PUT(gvA); if (blk + 2 < nblk) DSA_GATHER(gvA, blk + 2); }
                    else { DSA_PUT(gvB); if (blk + 2 < nblk) DSA_GATHER(gvB, blk + 2); }
                    LDS_WAIT();
                    f32x4 s0 = {0.f, 0.f, 0.f, 0.f}, s1 = {0.f, 0.f, 0.f, 0.f};
        #pragma unroll
                    for (int ks = 0; ks < 4; ++ks) {
                        const bf16x8 k0 = *(const LAS bf16x8*)(tile + off_b(fr, 4 * ks + fq)), k1 = *(const LAS bf16x8*)(tile + off_b(16 + fr, 4 * ks + fq));
                        s0 = __builtin_amdgcn_mfma_f32_16x16x32_bf16(k0, qB[ks], s0, 0, 0, 0);
                        s1 = __builtin_amdgcn_mfma_f32_16x16x32_bf16(k1, qB[ks], s1, 0, 0, 0);
                    }
                    const int j0 = 32 * blk + 4 * fq;
                    const u32x2 b0 = *(const LAS u32x2*)(bkL + j0), b1 = *(const LAS u32x2*)(bkL + j0 + 16);
                    const float t00 = t5L[(b0.x & 0xffffu) + fr], t01 = t5L[(b0.x >> 16) + fr], t02 = t5L[(b0.y & 0xffffu) + fr], t03 = t5L[(b0.y >> 16) + fr];
                    const float t10 = t5L[(b1.x & 0xffffu) + fr], t11 = t5L[(b1.x >> 16) + fr], t12 = t5L[(b1.y & 0xffffu) + fr], t13 = t5L[(b1.y >> 16) + fr];
                    const float e00 = __expf(s0.x + t00 - mb), e01 = __expf(s0.y + t01 - mb), e02 = __expf(s0.z + t02 - mb), e03 = __expf(s0.w + t03 - mb);
                    const float e10 = __expf(s1.x + t10 - mb), e11 = __expf(s1.y + t11 - mb), e12 = __expf(s1.z + t12 - mb), e13 = __expf(s1.w + t13 - mb);
                    const float p00 = (j0 + 0) < nsel ? e00 : 0.f, p01 = (j0 + 1) < nsel ? e01 : 0.f, p02 = (j0 + 2) < nsel ? e02 : 0.f, p03 = (j0 + 3) < nsel ? e03 : 0.f;
                    const float p10 = (j0 + 16) < nsel ? e10 : 0.f, p11 = (j0 + 17) < nsel ? e11 : 0.f, p12 = (j0 + 18) < nsel ? e12 : 0.f, p13 = (j0 + 19) < nsel ? e13 : 0.f;
                    lrun += ((p00 + p01) + (p02 + p03)) + ((p10 + p11) + (p12 + p13));
                    u32x4 pw; pw.x = pk2(p00, p01); pw.y = pk2(p02, p03); pw.z = pk2(p10, p11); pw.w = pk2(p12, p13);
                    const bf16x8 pa = __builtin_bit_cast(bf16x8, pw);
                    const unsigned q4 = (unsigned)(fr >> 2), p4 = (unsigned)(lane & 3);
        #pragma unroll
                    for (int nt = 0; nt < 8; ++nt) {
                        const s16x4 vlo = tr_rd(tile + off_b(4 * fq + q4, 2 * nt + (p4 >> 1)) + 8 * (p4 & 1));
                        const s16x4 vhi = tr_rd(tile + off_b(16 + 4 * fq + q4, 2 * nt + (p4 >> 1)) + 8 * (p4 & 1));
                        const bf16x8 vb = __builtin_shufflevector(vlo, vhi, 0, 1, 2, 3, 4, 5, 6, 7);
                        O[nt] = __builtin_amdgcn_mfma_f32_16x16x32_bf16(pa, vb, O[nt], 0, 0, 0);
                    }

                }
            }
        }
#undef DSA_GATHER
#undef DSA_PUT
        float lt2 = lrun + __shfl_xor(lrun, 16); lt2 += __shfl_xor(lt2, 32);
        const float inv = 1.f / lt2;
        float ir[4];
#pragma unroll
        for (int r = 0; r < 4; ++r) ir[r] = __shfl(inv, 4 * fq + r);
        bf16* od = (bf16*)(ws + WS_OD) + (size_t)qrow * 1024 + fr;
#pragma unroll
        for (int nt = 0; nt < 8; ++nt)
#pragma unroll
            for (int r = 0; r < 4; ++r) { const int hd = 4 * fq + r; od[(size_t)(hd >> 3) * MT * 1024 + (hd & 7) * 128 + 16 * nt] = (bf16)f2bf(O[nt][r] * ir[r]); }
        LDS_WAIT();
        DSTAMP(26);
    }
}
__device__ __forceinline__ void p5_dsa(ArgsP a, LAS unsigned char* lds, int l, int tid, int wave, int lane) {
    LAS float* t5L = (LAS float*)(lds + DSA2_T5);
    __syncthreads();
    t5L[tid] = a->in[I_T5][tid];
    for (int n = tid; n < TT; n += 512) ((LAS unsigned short*)(lds + DSA2_BT))[n] = (unsigned short)(t5_bucket(n) * 16);
    if (tid < 64) {
        const float g0 = fabsf(a->in[I_GDKV][l * 128 + tid]), g1 = fabsf(a->in[I_GDKV][l * 128 + 64 + tid]);
        const float gm = wave_max(fmaxf(g0, g1));
        float tm = 0.f;
#pragma unroll
        for (int i = 0; i < 8; ++i) tm = fmaxf(tm, fabsf(a->in[I_T5][tid + 64 * i]));
        tm = wave_max(tm);
        if (tid == 0) { t5L[512] = 11.313708498984761f * gm; t5L[513] = tm; }
    }
    __syncthreads();
    for (int u = blockIdx.x; u < 256; u += gridDim.x) {
        dsa_unit<false>(a, lds, u >> 5, u & 31, 64, wave, lane);
        __syncthreads();
    }
    if (blockIdx.x == 0) dsa_unit<true>(a, lds, 0, 0, 16, wave, lane);
}

__global__ void __launch_bounds__(NWAVES * 64, 2) fwd(Args a_) {
    extern __shared__ __attribute__((aligned(16))) unsigned char lds_raw[];
    LAS unsigned char* lds = (LAS unsigned char*)lds_raw;
    volatile LAS unsigned* MISC = (volatile LAS unsigned*)(lds + MISC_OFF);
    if (threadIdx.x < 32) MISC[threadIdx.x] = 0u;
    __syncthreads();
    const int g_lo = a_.g_lo, g_hi = a_.g_hi, l_lo = a_.l_lo, l_hi = a_.l_hi, ph_lo = a_.ph_lo, ph_hi = a_.ph_hi, use_bar = a_.use_bar;
    XcdBarrier bar; bar.bar = (unsigned*)(a_.ws + WS_CTL) + CW_BAR; bar.x = 0; bar.st = nullptr;
    if (use_bar) bar = xcd_barrier_post((unsigned*)(a_.ws + WS_CTL) + CW_BAR, MISC + 8);
#if defined(DIAG_SEL)
#ifndef DIAG_BLK
#define DIAG_BLK 31
#endif
    int diag_site = 0; if (threadIdx.x == 0) MISC[15] = (unsigned)__builtin_amdgcn_s_memrealtime();
#define DIAG_STAMP(site) do { if (blockIdx.x == 0 && threadIdx.x == 0) { const unsigned now_ = (unsigned)__builtin_amdgcn_s_memrealtime(); MISC[16 + (site)] += now_ - MISC[15]; MISC[15] = now_; } } while (0)
#define GRID_BAR() do { if (use_bar) xcd_barrier(bar); DIAG_STAMP(diag_site); ++diag_site; } while (0)
#else
#define GRID_BAR() do { if (use_bar) xcd_barrier(bar); } while (0)
#endif
#ifndef PHMASK
#define PHMASK 0xFFFF
#endif
#ifndef PROBE_PH
#define PROBE_PH -1
#endif
#ifndef FUSE_NORM
#define FUSE_NORM 0
#endif
#ifndef PROBE_MASK
#define PROBE_MASK 0
#endif
#define PROBED(k) ((PROBE_MASK >> (k)) & 1)
#ifndef P1_ALIGN
#define P1_ALIGN true
#endif
#define PH(k) (((PHMASK >> (k)) & 1) && ph_lo <= (k) && (k) < ph_hi)
#define PBEGIN ArgsP a = (ArgsP)__builtin_amdgcn_kernarg_segment_ptr(); asm volatile("" : "+s"(a)); unsigned char* ws = a->ws; \
    int tid_ = threadIdx.x; asm volatile("" : "+v"(tid_)); const int tid = tid_, lane = tid & 63, wave = __builtin_amdgcn_readfirstlane(tid >> 6); const int gw = blockIdx.x * NWAVES + wave, ngw = gridDim.x * NWAVES; (void)ws; (void)gw; (void)ngw; (void)lane;

#if defined(DIAG_SEL)
    diag_site = 15;
#endif
    if (((PHMASK >> 13) & 1) && a_.prep) { PBEGIN prep_weights(a, lds, gw, ngw, wave, lane); GRID_BAR(); }

    for (int g = g_lo; g < g_hi; ++g) {
        for (int l = l_lo; l < l_hi; ++l) {
#if defined(DIAG_SEL)
            diag_site = (l == 0) ? 0 : 1;
#endif
            if (PH(0) && l == 0) { PBEGIN p0_init(a, g, gw, ngw, lane); GRID_BAR(); }
            if (PH(1)) { PBEGIN
                FIn f{(bf16*)(ws + WS_Z), (float*)(ws + WS_ZF), (const float*)(ws + WS_BIN) + l * NZ};
                run_gemm<FIn, P1_ALIGN>(lds, (const bf16*)(ws + WS_XN), (const bf16*)(ws + WS_WIN) + (size_t)l * NZ * D, NZ, D, f, gw, ngw, lane);
                if (PROBED(1)) { run_gemm(lds, (const bf16*)(ws + WS_XN), (const bf16*)(ws + WS_WIN) + (size_t)l * NZ * D, NZ, D, f, gw, ngw, lane); }
                GRID_BAR();
            }
            if (PH(2)) {
                { PBEGIN p2_prep(a, l, gw, ngw, lane); }
#if defined(DIAG_SEL)
                __syncthreads(); DIAG_STAMP(14);
#endif
                { PBEGIN __syncthreads(); p2_chunks(a, lds, l, gw, ngw, wave, lane); }
                GRID_BAR();
            }
            if (PH(3)) { PBEGIN
                FQQ f{(bf16*)(ws + WS_QQ)};
                run_gemm(lds, (const bf16*)(ws + WS_CQN), (const bf16*)(ws + WS_WQQ) + (size_t)l * NQQ * 256, NQQ, 256, f, gw, ngw, lane);
                if (PROBED(3)) { run_gemm(lds, (const bf16*)(ws + WS_CQN), (const bf16*)(ws + WS_WQQ) + (size_t)l * NQQ * 256, NQQ, 256, f, gw, ngw, lane); }
            }
#if defined(DIAG_SEL)
            __syncthreads(); DIAG_STAMP(11);
#endif
            if (PH(4)) { PBEGIN
                for (int u = blockIdx.x; u < 256; u += gridDim.x) {
                    const int b = (u >> 4) & 7, h = (u >> 2) & 3, vs = u & 3;
                    if (u >> 7) scan_unit<true>(a, lds, b, h, vs, tid); else scan_unit<false>(a, lds, b, h, vs, tid);
                }
#if PROBE_PH == 4
                for (int u = blockIdx.x; u < 256; u += gridDim.x) {
                    const int b = (u >> 4) & 7, h = (u >> 2) & 3, vs = u & 3;
                    if (u >> 7) scan_unit<true>(a, lds, b, h, vs, tid); else scan_unit<false>(a, lds, b, h, vs, tid);
                }
#endif
                GRID_BAR();
            }
#if defined(DIAG_SEL)
            if (blockIdx.x == DIAG_BLK && threadIdx.x == 0) MISC[14] = (unsigned)__builtin_amdgcn_s_memrealtime();
#endif
            if (PH(5)) { PBEGIN p5_dsa(a, lds, l, tid, wave, lane); }
#if defined(DIAG_SEL)
            __syncthreads(); DSTAMP(27);
#endif
#if PROBE_PH == 5
            if (PH(5)) { PBEGIN p5_dsa(a, lds, l, tid, wave, lane); }
#endif
            if (PH(6)) { PBEGIN p6_headnorm(a, l, gw, ngw, lane); if (PROBED(6)) p6_headnorm<true>(a, l, gw, ngw, lane);
#if defined(DIAG_SEL)
                DSTAMP(28);
#endif
                GRID_BAR();
#if defined(DIAG_SEL)
                DSTAMP(29);
#endif
            }
            if (PH(7)) {
                __syncthreads();
                { PBEGIN
                  const bf16* OD0 = (const bf16*)(ws + WS_OD); const bf16* OD1 = OD0 + (size_t)MT * 1024;
                  const bf16* WB0 = (const bf16*)(ws + WS_WBD) + (size_t)l * D * 2048; const bf16* WB1 = WB0 + (size_t)D * D;
                  int Kc = D, Nc = D; asm volatile("" : "+s"(Kc)); asm volatile("" : "+s"(Nc));
                  pg8::Gemm g{(const bf16*)(ws + WS_OG), (const bf16*)(ws + WS_WBG) + (size_t)l * D * D, MR, Nc, Kc, OD0, OD1, (const bf16*)(ws + WS_OM), WB0, WB1, (const bf16*)(ws + WS_WBM) + (size_t)l * D * D};
                  ChainOrder S; S.S.init(MR, Nc, (int)gridDim.x, (int)blockIdx.x);
                  EpiMix E{(const bf16*)(ws + WS_Z), (bf16*)(ws + WS_MIX)};
                  pg8::gemm_phase<EpiMix, ChainOrder, true, true, true>((PG8_LAS unsigned char*)lds, g, S, E);
                  FBr<0> f0{(const bf16*)(ws + WS_Z), (float*)(ws + WS_Y), (bf16*)(ws + WS_MIX)};
                  mini_gemm(lds, (const bf16*)(ws + WS_OG), (const bf16*)(ws + WS_WBG) + (size_t)l * D * D, Nc, Kc, f0, (int)threadIdx.x);
                  FBr<1> f1{(const bf16*)(ws + WS_Z), (float*)(ws + WS_Y), (bf16*)(ws + WS_MIX)};
                  mini_gemm(lds, OD0, WB0, Nc, Kc, f1, (int)threadIdx.x);
                  mini_gemm(lds, OD1, WB1, Nc, Kc, f1, (int)threadIdx.x);
                  FBr<2> f2{(const bf16*)(ws + WS_Z), (float*)(ws + WS_Y), (bf16*)(ws + WS_MIX)};
                  mini_gemm(lds, (const bf16*)(ws + WS_OM), (const bf16*)(ws + WS_WBM) + (size_t)l * D * D, Nc, Kc, f2, (int)threadIdx.x);
                }
#if PROBED(7)
                { PBEGIN
                  const bf16* OD0 = (const bf16*)(ws + WS_OD); const bf16* OD1 = OD0 + (size_t)MT * 1024;
                  const bf16* WB0 = (const bf16*)(ws + WS_WBD) + (size_t)l * D * 2048; const bf16* WB1 = WB0 + (size_t)D * D;
                  int Kc = D, Nc = D; asm volatile("" : "+s"(Kc)); asm volatile("" : "+s"(Nc));
                  pg8::Gemm g{(const bf16*)(ws + WS_OG), (const bf16*)(ws + WS_WBG) + (size_t)l * D * D, MR, Nc, Kc, OD0, OD1, (const bf16*)(ws + WS_OM), WB0, WB1, (const bf16*)(ws + WS_WBM) + (size_t)l * D * D};
                  ChainOrder S; S.S.init(MR, Nc, (int)gridDim.x, (int)blockIdx.x);
                  EpiMix E{(const bf16*)(ws + WS_Z), (bf16*)(ws + WS_MIX)};
                  pg8::gemm_phase<EpiMix, ChainOrder, true, true, true>((PG8_LAS unsigned char*)lds, g, S, E);
                  FBr<0> f0{(const bf16*)(ws + WS_Z), (float*)(ws + WS_Y), (bf16*)(ws + WS_MIX)};
                  mini_gemm(lds, (const bf16*)(ws + WS_OG), (const bf16*)(ws + WS_WBG) + (size_t)l * D * D, Nc, Kc, f0, (int)threadIdx.x);
                  FBr<1> f1{(const bf16*)(ws + WS_Z), (float*)(ws + WS_Y), (bf16*)(ws + WS_MIX)};
                  mini_gemm(lds, OD0, WB0, Nc, Kc, f1, (int)threadIdx.x);
                  mini_gemm(lds, OD1, WB1, Nc, Kc, f1, (int)threadIdx.x);
                  FBr<2> f2{(const bf16*)(ws + WS_Z), (float*)(ws + WS_Y), (bf16*)(ws + WS_MIX)};
                  mini_gemm(lds, (const bf16*)(ws + WS_OM), (const bf16*)(ws + WS_WBM) + (size_t)l * D * D, Nc, Kc, f2, (int)threadIdx.x);
                }
#endif
                GRID_BAR();
            }
            if (PH(8)) { PBEGIN
                if (FUSE_NORM && gridDim.x == 256) {
                    int Kc = D, Nc = D; asm volatile("" : "+s"(Kc)); asm volatile("" : "+s"(Nc));
                    pg8::Gemm gg{(const bf16*)(ws + WS_MIX), (const bf16*)(ws + WS_WOUT) + (size_t)l * D * D, MR, Nc, Kc};
                    pg8::StaticOrder S; S.init(MR, Nc, (int)gridDim.x, (int)blockIdx.x);
                    unsigned* ctl = (unsigned*)(ws + WS_CTL); float* xb = (float*)(ws + WS_LIF);
                    const unsigned tgt = 32u * (unsigned)(g * NL + l + 1);
                    EpiResNorm E{a->out + (size_t)g * MR * D, (bf16*)(ws + WS_XN), a->in[I_GPOSTMIX] + l * D, a->in[I_GPREMLP] + l * D,
                                 RmsExchange{xb, ctl + CW_XCNT, ctl, tgt}, RmsExchange{xb + 65536, ctl + CW_XCNT + 4096, ctl, tgt}};
                    pg8::gemm_phase<EpiResNorm, pg8::StaticOrder, false, true>((PG8_LAS unsigned char*)lds, gg, S, E);
                    FY f{(bf16*)(ws + WS_Y)};
                    mini_gemm(lds, (const bf16*)(ws + WS_MIX), (const bf16*)(ws + WS_WOUT) + (size_t)l * D * D, Nc, Kc, f, (int)threadIdx.x);
                } else {
                    FY f{(bf16*)(ws + WS_Y)};
                    run_gemm(lds, (const bf16*)(ws + WS_MIX), (const bf16*)(ws + WS_WOUT) + (size_t)l * D * D, D, D, f, gw, ngw, lane);
                }
                GRID_BAR();
            }
            if (PH(9)) { PBEGIN p_norm_res(a, g, a->in[I_GPOSTMIX] + l * D, a->in[I_GPREMLP] + l * D, gw, ngw, lane, (FUSE_NORM && gridDim.x == 256) ? MR : 0); GRID_BAR(); }
            if (PH(10)) { PBEGIN
                FUp f{(bf16*)(ws + WS_Z)};
                run_gemm(lds, (const bf16*)(ws + WS_XN), (const bf16*)(ws + WS_WUP) + (size_t)l * DFF * D, DFF, D, f, gw, ngw, lane);
                if (PROBED(10)) { run_gemm(lds, (const bf16*)(ws + WS_XN), (const bf16*)(ws + WS_WUP) + (size_t)l * DFF * D, DFF, D, f, gw, ngw, lane); }
                GRID_BAR();
            }
            if (PH(11)) { PBEGIN
                if (FUSE_NORM && gridDim.x == 256) {
                    int Kc = DFF, Nc = D; asm volatile("" : "+s"(Kc)); asm volatile("" : "+s"(Nc));
                    pg8::Gemm gg{(const bf16*)(ws + WS_Z), (const bf16*)(ws + WS_WDN) + (size_t)l * D * DFF, MR, Nc, Kc};
                    pg8::StaticOrder S; S.init(MR, Nc, (int)gridDim.x, (int)blockIdx.x);
                    unsigned* ctl = (unsigned*)(ws + WS_CTL); float* xb = (float*)(ws + WS_LIF) + 2 * 65536;
                    const unsigned tgt = 32u * (unsigned)(g * NL + l + 1);
                    EpiResNorm E{a->out + (size_t)g * MR * D, (bf16*)(ws + WS_XN), a->in[I_GPOSTMLP] + l * D, l + 1 < NL ? a->in[I_GPREMIX] + (l + 1) * D : nullptr,
                                 RmsExchange{xb, ctl + CW_XCNT + 2 * 4096, ctl, tgt}, RmsExchange{xb + 65536, ctl + CW_XCNT + 3 * 4096, ctl, 32u * (unsigned)(g * (NL - 1) + l + 1)}};
                    pg8::gemm_phase<EpiResNorm, pg8::StaticOrder, false, true>((PG8_LAS unsigned char*)lds, gg, S, E);
                    FY f{(bf16*)(ws + WS_Y)};
                    mini_gemm(lds, (const bf16*)(ws + WS_Z), (const bf16*)(ws + WS_WDN) + (size_t)l * D * DFF, Nc, Kc, f, (int)threadIdx.x);
                } else {
                    FY f{(bf16*)(ws + WS_Y)};
                    run_gemm(lds, (const bf16*)(ws + WS_Z), (const bf16*)(ws + WS_WDN) + (size_t)l * D * DFF, D, DFF, f, gw, ngw, lane);
                }
                GRID_BAR();
            }
            if (PH(12)) { PBEGIN p_norm_res(a, g, a->in[I_GPOSTMLP] + l * D, l + 1 < NL ? a->in[I_GPREMIX] + (l + 1) * D : nullptr, gw, ngw, lane, (FUSE_NORM && gridDim.x == 256) ? MR : 0); GRID_BAR(); }
        }
    }
#if defined(DIAG_SEL)
    if ((DIAG_SEL >= 24 || DIAG_SEL == 16 || DIAG_SEL == 17) && blockIdx.x == DIAG_BLK && threadIdx.x == 0) { unsigned tot = 0; for (int i = 24; i < 30; ++i) tot += MISC[i]; tot += MISC[16] + MISC[17];
        a_.out[12345] = 100.f + 900.f * (float)MISC[DIAG_SEL] / (float)tot; }
    if (DIAG_SEL < 24 && DIAG_SEL != 16 && DIAG_SEL != 17 && blockIdx.x == 0 && threadIdx.x == 0) { unsigned tot = 0; for (int i = 0; i < 16; ++i) tot += MISC[16 + i];
#if defined(DIAG_ABS)
        a_.out[12345] = 100.f + (float)MISC[16 + DIAG_SEL] * 0.001f; }
#else
        a_.out[12345] = DIAG_SEL == 99 ? 100.f + (float)tot * 0.0001f : 100.f + 900.f * (float)MISC[16 + DIAG_SEL] / (float)tot; }
#endif
#endif
#undef PH
#undef GRID_BAR
#undef PBEGIN
}

#ifndef MK_ONE_LAUNCH
#define MK_ONE_LAUNCH 1
#endif
extern "C" void kernel_launch(void* const* d_in, const int* in_sizes, int n_in, void* d_out, int out_size, void* d_ws, size_t ws_size, hipStream_t stream) {
    static int grid = 0;
    if (grid == 0) {
        if (n_in != 28 || out_size != NB * SEQ * D || ws_size < WS_END) { fprintf(stderr, "kernel_launch: unexpected shapes (n_in %d out %d ws %zu need %zu)\n", n_in, out_size, ws_size, (size_t)WS_END); grid = -1; return; }
        int dev = 0, cus = 0, per_cu = 0;
        if (hipGetDevice(&dev) != hipSuccess || hipDeviceGetAttribute(&cus, hipDeviceAttributeMultiprocessorCount, dev) != hipSuccess) { grid = -1; return; }
        if (hipFuncSetAttribute((const void*)fwd, hipFuncAttributeMaxDynamicSharedMemorySize, LDS_BYTES) != hipSuccess) { fprintf(stderr, "kernel_launch: hipFuncSetAttribute failed\n"); grid = -1; return; }
        if (hipOccupancyMaxActiveBlocksPerMultiprocessor(&per_cu, (const void*)fwd, NWAVES * 64, LDS_BYTES) != hipSuccess || per_cu < 1) { fprintf(stderr, "kernel_launch: occupancy query says %d\n", per_cu); }
        (void)hipGetLastError();
        grid = cus;
    }
    if (grid < 0) return;
    (void)hipMemsetAsync((char*)d_ws + WS_CTL, 0, CTL_ZERO_BYTES, stream);
    Args a{};
    for (int i = 0; i < 28; ++i) a.in[i] = (const float*)d_in[i];
    a.out = (float*)d_out; a.ws = (unsigned char*)d_ws;
#if MK_ONE_LAUNCH
    a.g_lo = 0; a.g_hi = NG; a.l_lo = 0; a.l_hi = NL; a.ph_lo = 0; a.ph_hi = 13; a.prep = 1; a.use_bar = 1;
    hipLaunchKernelGGL(fwd, dim3(grid), dim3(NWAVES * 64), LDS_BYTES, stream, a);
#else
    a.use_bar = 0;
    a.prep = 1; a.g_lo = 0; a.g_hi = 0; a.l_lo = 0; a.l_hi = 0; a.ph_lo = 0; a.ph_hi = 0;
    hipLaunchKernelGGL(fwd, dim3(grid), dim3(NWAVES * 64), LDS_BYTES, stream, a);
    a.prep = 0;
    static const int cuts[] = {0, 1, 2, 3, 5, 7, 8, 9, 10, 11, 12, 13};
    for (int g = 0; g < NG; ++g) for (int l = 0; l < NL; ++l) for (int c = 0; c < 11; ++c) {
        if (c == 0 && l != 0) continue;
        a.g_lo = g; a.g_hi = g + 1; a.l_lo = l; a.l_hi = l + 1; a.ph_lo = cuts[c]; a.ph_hi = cuts[c + 1];
        hipLaunchKernelGGL(fwd, dim3(grid), dim3(NWAVES * 64), LDS_BYTES, stream, a);
    }
#endif
    const hipError_t le = hipPeekAtLastError();
    if (le != hipSuccess) fprintf(stderr, "kernel_launch: launch failed: %s\n", hipGetErrorName(le));
}
```

```cpp
#include <hip/hip_runtime.h>
#include <cstdio>
#include <cstdint>
namespace pg8 {
#define PG8_LAS __attribute__((address_space(3)))
typedef unsigned short bf16_t;
typedef short bf16x8 __attribute__((ext_vector_type(8)));
typedef float f32x4 __attribute__((ext_vector_type(4)));
typedef unsigned u32x4 __attribute__((ext_vector_type(4)));
constexpr int BM = 256, BK = 64, HALF = 128, HTB = HALF * BK * 2  , STAGE_BYTES = 8 * HTB, NXCD = 8, WGM = 8;

__host__ __device__ __forceinline__ int lds_byte(int r, int c) { const int st = (r >> 4) * 2 + (c >> 5), rr = r & 15, cc = c & 31, ob = rr * 64 + cc * 2; return st * 1024 + (ob ^ (((ob >> 9) & 1) << 5)); }
__host__ __device__ __forceinline__ void stage_rc(int b, int& R, int& C) { const int st = b / 1024, sb = b % 1024, swz = sb ^ (((sb >> 9) & 1) << 5); R = (st >> 1) * 16 + swz / 64; C = (st & 1) * 32 + (swz % 64) / 2; }
__host__ __device__ __forceinline__ int perm32(int rho) { const int n = rho >> 4, i = rho & 15; return 8 * (i >> 2) + 4 * n + (i & 3); }

struct Unit { int pm, pn, sub; };
struct Gemm { const bf16_t* A; const bf16_t* Bt; int M, N, K; const bf16_t *A1, *A2, *A3, *B1, *B2, *B3; };

struct StaticOrder {
    int nM, nN, nwg, G, c;
    __host__ __device__ void init(int M, int N, int G_, int c_) { nM = M / BM; nN = N / BM; nwg = nM * nN; G = G_; c = c_; }
    __host__ __device__ bool next(int i, Unit& u) const {
        const long L = (long)i * G + c; if (L >= nwg) return false;
        int wgid = (int)L; { const int q = nwg / NXCD, r = nwg % NXCD, xcd = wgid % NXCD, off = wgid / NXCD; wgid = (xcd < r ? xcd * (q + 1) : r * (q + 1) + (xcd - r) * q) + off; }
        const int nig = WGM * nN, gid = wgid / nig, fm = gid * WGM, gsz = (nM - fm) < WGM ? (nM - fm) : WGM;
        u.pm = fm + ((wgid % nig) % gsz); u.pn = (wgid % nig) / gsz; u.sub = 0; return true;
    }
    __device__ __forceinline__ void a_ready(const Unit&) const {}
    __device__ __forceinline__ void done(const Unit&) const {}
};

__device__ __forceinline__ unsigned cvt_pk_bf16(float lo, float hi) { unsigned r; asm volatile("v_cvt_pk_bf16_f32 %0, %1, %2" : "=v"(r) : "v"(lo), "v"(hi)); return r; }
template <class Epi, class Sched, bool ALIGN_EPI = false, bool SP2 = false, bool CHAIN = false>
__device__ __forceinline__ void gemm_phase(PG8_LAS unsigned char* lds, const Gemm g, const Sched& S, const Epi& E) {
    int tid_ = threadIdx.x; asm volatile("" : "+v"(tid_));
    const int tid = tid_, wid = __builtin_amdgcn_readfirstlane(tid >> 6), lane = tid & 63, wr = wid >> 2, wc = wid & 3, fr = lane & 15, fq = lane >> 4;
    const int K = g.K, nt = K / BK;
    unsigned voffA[2], voffB[2];
#pragma unroll
    for (int i = 0; i < 2; ++i) { int R, C; stage_rc(tid * 16 + i * 8192, R, C); const int Rb = Epi::PERM ? ((R & ~31) + perm32(R & 31)) : R;
        voffA[i] = (unsigned)(R * K + C) * 2u; voffB[i] = (unsigned)(Rb * K + C) * 2u; }
    const size_t kstep = (size_t)(BK * 2);
    const size_t hstep = (size_t)HALF * K * 2;
    const size_t tstep = 2 * hstep;
    const unsigned ldsw = (unsigned)wid * 1024u;
    const int aoff = lds_byte(wr * 64 + fr, fq * 8), boff = lds_byte(wc * 32 + fr, fq * 8);
#define PG8_SA(b, h) (((b) * 2 + (h)) * HTB)
#define PG8_SB(b, h) ((4 + (b) * 2 + (h)) * HTB)
#define PG8_STAGE(bufoff, gbase, voff) do { _Pragma("unroll") for (int _i = 0; _i < 2; ++_i) \
        __builtin_amdgcn_global_load_lds((const unsigned*)((const char*)(gbase) + (voff)[_i]), (PG8_LAS unsigned*)(lds + (bufoff) + ldsw + _i * 8192), 16, 0, 0); } while (0)
#define PG8_LDA(dst, b, h) do { _Pragma("unroll") for (int m = 0; m < 4; ++m) _Pragma("unroll") for (int k = 0; k < 2; ++k) dst[m][k] = *(const PG8_LAS bf16x8*)(lds + PG8_SA(b, h) + aoff + m * 2048 + k * 1024); } while (0)
#define PG8_LDB(dst, b, h) do { _Pragma("unroll") for (int n = 0; n < 2; ++n) _Pragma("unroll") for (int k = 0; k < 2; ++k) dst[n][k] = *(const PG8_LAS bf16x8*)(lds + PG8_SB(b, h) + boff + n * 2048 + k * 1024); } while (0)
#define PG8_MMA(ai, bj, At, Bt) do { __builtin_amdgcn_s_setprio(1); _Pragma("unroll") for (int m = 0; m < 4; ++m) _Pragma("unroll") for (int n = 0; n < 2; ++n) _Pragma("unroll") for (int k = 0; k < 2; ++k) \
        acc[ai][bj][m][n] = __builtin_amdgcn_mfma_f32_16x16x32_bf16(Bt[n][k], At[m][k], acc[ai][bj][m][n], 0, 0, 0); __builtin_amdgcn_s_setprio(0); } while (0)
#define PG8_WAIT_V(n) asm volatile("s_waitcnt vmcnt(" #n ")" ::: "memory")
#define PG8_WAIT_L(n) asm volatile("s_waitcnt lgkmcnt(" #n ")" ::: "memory")
#define PG8_BAR __builtin_amdgcn_s_barrier()
#define PG8_SCHED __builtin_amdgcn_sched_barrier(0)
    Unit cur, nxt; int ui = 0;
    if (!S.next(0, cur)) return;
    f32x4 acc[2][2][4][2];
#pragma unroll
    for (int a = 0; a < 2; ++a)
#pragma unroll
        for (int b = 0; b < 2; ++b)
#pragma unroll
            for (int m = 0; m < 4; ++m)
#pragma unroll
                for (int n = 0; n < 2; ++n) acc[a][b][m][n] = (f32x4){0.f, 0.f, 0.f, 0.f};
    bf16x8 At[4][2], B0[2][2], B1[2][2];
#define PG8_ABASE(u) ((const char*)(!CHAIN || (u).sub == 0 ? g.A : (u).sub == 1 ? g.A1 : (u).sub == 2 ? g.A2 : g.A3) + (size_t)(u).pm * tstep)
#define PG8_BBASE(u) ((const char*)(!CHAIN || (u).sub == 0 ? g.Bt : (u).sub == 1 ? g.B1 : (u).sub == 2 ? g.B2 : g.B3) + (size_t)(u).pn * tstep)
    const char* cA = PG8_ABASE(cur); const char* cB = PG8_BBASE(cur);
    S.a_ready(cur);
    if constexpr (SP2) {
        PG8_STAGE(PG8_SB(0, 0), cB, voffB); PG8_STAGE(PG8_SB(0, 1), cB + hstep, voffB); PG8_STAGE(PG8_SA(0, 0), cA, voffA); PG8_STAGE(PG8_SA(0, 1), cA + hstep, voffA);
        if (wr == 1) PG8_BAR;
        PG8_WAIT_V(2); PG8_BAR;
        PG8_STAGE(PG8_SB(1, 0), cB + kstep, voffB); PG8_STAGE(PG8_SA(1, 0), cA + kstep, voffA); PG8_STAGE(PG8_SB(1, 1), cB + hstep + kstep, voffB);
        PG8_WAIT_V(6); PG8_BAR;
    } else {
        PG8_STAGE(PG8_SB(0, 0), cB, voffB); PG8_STAGE(PG8_SA(0, 0), cA, voffA); PG8_STAGE(PG8_SB(0, 1), cB + hstep, voffB); PG8_STAGE(PG8_SA(0, 1), cA + hstep, voffA);
        if (wr == 1) PG8_BAR;
        PG8_WAIT_V(4); PG8_BAR;
        PG8_STAGE(PG8_SB(1, 0), cB + kstep, voffB); PG8_STAGE(PG8_SA(1, 0), cA + kstep, voffA); PG8_STAGE(PG8_SB(1, 1), cB + hstep + kstep, voffB);
        PG8_WAIT_V(6); PG8_BAR;
    }
    for (;;) {
        const bool has_next = S.next(ui + 1, nxt);
        const char* nA = has_next ? PG8_ABASE(nxt) : cA; const char* nB = has_next ? PG8_BBASE(nxt) : cB;
        for (int t = 0; t < nt; t += 2) {
            const bool last = (t == nt - 2);
            const char* a1 = cA + (size_t)(t + 1) * kstep;
            const char* a2 = last ? nA : cA + (size_t)(t + 2) * kstep; const char* b2 = last ? nB : cB + (size_t)(t + 2) * kstep;
            const char* a3 = a2 + kstep; const char* b3 = b2 + kstep;
            if (last && has_next) S.a_ready(nxt);
            if constexpr (SP2) {
            PG8_LDB(B0, 0, 0); PG8_LDB(B1, 0, 1); PG8_SCHED; PG8_LDA(At, 0, 0); PG8_STAGE(PG8_SA(1, 1), a1 + hstep, voffA);
            PG8_WAIT_V(8); PG8_WAIT_L(0); PG8_BAR; PG8_MMA(0, 0, At, B0); PG8_MMA(0, 1, At, B1); PG8_BAR; PG8_SCHED;
            PG8_LDA(At, 0, 1); PG8_STAGE(PG8_SB(0, 0), b2, voffB); PG8_STAGE(PG8_SB(0, 1), b2 + hstep, voffB); PG8_STAGE(PG8_SA(0, 0), a2, voffA);
            PG8_WAIT_V(8); PG8_WAIT_L(0); PG8_BAR; PG8_MMA(1, 0, At, B0); PG8_MMA(1, 1, At, B1); PG8_BAR; PG8_SCHED;
            PG8_LDB(B0, 1, 0); PG8_LDB(B1, 1, 1); PG8_SCHED; PG8_LDA(At, 1, 0); PG8_STAGE(PG8_SA(0, 1), a2 + hstep, voffA);
            PG8_WAIT_V(8); PG8_WAIT_L(0); PG8_BAR; PG8_MMA(0, 0, At, B0); PG8_MMA(0, 1, At, B1); PG8_BAR; PG8_SCHED;
            PG8_LDA(At, 1, 1); PG8_STAGE(PG8_SB(1, 0), b3, voffB); PG8_STAGE(PG8_SB(1, 1), b3 + hstep, voffB); PG8_STAGE(PG8_SA(1, 0), a3, voffA);
            PG8_WAIT_V(8); PG8_WAIT_L(0); PG8_BAR; PG8_MMA(1, 0, At, B0); PG8_MMA(1, 1, At, B1); PG8_BAR; PG8_SCHED;
            } else {
            PG8_LDB(B0, 0, 0); PG8_SCHED; PG8_LDA(At, 0, 0); PG8_STAGE(PG8_SA(1, 1), a1 + hstep, voffA);
            PG8_WAIT_L(8); PG8_BAR; PG8_WAIT_L(0); PG8_MMA(0, 0, At, B0); PG8_BAR; PG8_SCHED;
            PG8_LDB(B1, 0, 1); PG8_STAGE(PG8_SB(0, 0), b2, voffB);
            PG8_BAR; PG8_WAIT_L(0); PG8_MMA(0, 1, At, B1); PG8_BAR;
            PG8_LDA(At, 0, 1); PG8_STAGE(PG8_SA(0, 0), a2, voffA);
            PG8_BAR; PG8_WAIT_L(0); PG8_MMA(1, 0, At, B0); PG8_BAR; PG8_SCHED;
            PG8_STAGE(PG8_SB(0, 1), b2 + hstep, voffB);
            PG8_WAIT_V(6); PG8_BAR; PG8_MMA(1, 1, At, B1); PG8_BAR;
            PG8_LDB(B0, 1, 0); PG8_SCHED; PG8_LDA(At, 1, 0); PG8_STAGE(PG8_SA(0, 1), a2 + hstep, voffA);
            PG8_WAIT_L(8); PG8_BAR; PG8_WAIT_L(0); PG8_MMA(0, 0, At, B0); PG8_BAR; PG8_SCHED;
            PG8_LDB(B1, 1, 1); PG8_STAGE(PG8_SB(1, 0), b3, voffB);
            PG8_BAR; PG8_WAIT_L(0); PG8_MMA(0, 1, At, B1); PG8_BAR;
            PG8_LDA(At, 1, 1); PG8_STAGE(PG8_SA(1, 0), a3, voffA);
            PG8_BAR; PG8_WAIT_L(0); PG8_MMA(1, 0, At, B0); PG8_BAR; PG8_SCHED;
            PG8_STAGE(PG8_SB(1, 1), b3 + hstep, voffB);
            PG8_WAIT_V(6); PG8_BAR; PG8_MMA(1, 1, At, B1); PG8_BAR;
            }
        }
        if constexpr (ALIGN_EPI) { if (wr == 0) PG8_BAR; }
        if constexpr (CHAIN) { if (cur.sub < 3) E.mid(acc, cur, wr, wc, fr, fq); else E(acc, cur, wr, wc, fr, fq); S.done(cur); }
        else if constexpr (!Epi::AFTER_DRAIN) { E(acc, cur, wr, wc, fr, fq); S.done(cur); }
        if (!has_next) break;
        if (!CHAIN || cur.sub == 3)
#pragma unroll
        for (int a = 0; a < 2; ++a)
#pragma unroll
            for (int b = 0; b < 2; ++b)
#pragma unroll
                for (int m = 0; m < 4; ++m)
#pragma unroll
                    for (int n = 0; n < 2; ++n) acc[a][b][m][n] = (f32x4){0.f, 0.f, 0.f, 0.f};
        cur = nxt; cA = nA; cB = nB; ++ui;
        if constexpr (ALIGN_EPI) { if (wr == 1) PG8_BAR; }
    }
    PG8_WAIT_V(0);
    if constexpr (!ALIGN_EPI) { if (wr == 0) PG8_BAR; }
    PG8_BAR;
    if constexpr (Epi::AFTER_DRAIN) { E.fused(acc, cur, wr, wc, fr, fq, lds, wid, lane); S.done(cur); }
#undef PG8_ABASE
#undef PG8_BBASE
#undef PG8_SA
#undef PG8_SB
#undef PG8_STAGE
#undef PG8_LDA
#undef PG8_LDB
#undef PG8_MMA
#undef PG8_WAIT_V
#undef PG8_WAIT_L
#undef PG8_BAR
#undef PG8_SCHED
}
}

constexpr int NB = 32, SEQ = 2048, NMETA = 16, TT = SEQ + NMETA, D = 1024, NL = 4, DFF = 4096;
constexpr int NG = 4, GB = NB / NG, MR = GB * SEQ  , MT = MR + NMETA  ;
constexpr int NCOLS = 9696, NZ = 9728, ZB = 9216, ZFW = 512;
constexpr float EPS = 1e-6f;
constexpr int ZC_GQ = 0, ZC_GK = 512, ZC_GV = 1024, ZC_GR = 2048, ZC_MQ = 3072, ZC_MK = 3584, ZC_MV = 4096, ZC_MO = 5120, ZC_GATE = 6144;
constexpr int ZF_CQ = 0, ZF_CKV = 256, ZF_IK = 384, ZF_A = 448, ZF_IW = 464, ZF_MI = 472, ZF_MF = 476;
constexpr int NQQ = 2560;

constexpr size_t MiB = 1u << 20;
constexpr size_t WS_CTL = 0, CTL_ZERO_BYTES = 1 * MiB;
constexpr size_t WS_BIN = 1 * MiB;
constexpr size_t WS_WIN = 2 * MiB;
constexpr size_t WS_WQQ = 78 * MiB;
constexpr size_t WS_WBG = 83 * MiB;
constexpr size_t WS_WBM = 91 * MiB;
constexpr size_t WS_WBD = 99 * MiB;
constexpr size_t WS_WOUT = 115 * MiB;
constexpr size_t WS_WUP = 123 * MiB;
constexpr size_t WS_WDN = 155 * MiB;
constexpr size_t WS_HM = 187 * MiB;
constexpr size_t WS_XN = 188 * MiB;
constexpr size_t WS_ZF = 221 * MiB;
constexpr size_t WS_CQN = 254 * MiB;
constexpr size_t WS_KV = 263 * MiB;
constexpr size_t WS_KI = 268 * MiB;
constexpr size_t WS_WI = 271 * MiB;
constexpr size_t WS_LIF = 272 * MiB;
constexpr size_t WS_G = 273 * MiB;
constexpr size_t WS_QKC = 306 * MiB;
constexpr size_t WS_QQ = 339 * MiB;
constexpr size_t WS_OG = 420 * MiB;
constexpr size_t WS_OM = 453 * MiB;
constexpr size_t WS_OD = 486 * MiB;
constexpr size_t WS_Z = 551 * MiB;
constexpr size_t WS_MIX = 840 * MiB;
constexpr size_t WS_Y = 873 * MiB;
constexpr size_t WS_SC = 840 * MiB;
constexpr size_t WS_DD = 1020 * MiB;
constexpr size_t WS_END = 1024 * MiB;
constexpr int SC_PITCH = 2080;
static_assert(WS_Z + (size_t)MT * ZB * 2 <= WS_MIX && WS_Y + (size_t)MT * D * 4 <= WS_END && WS_SC + (size_t)256 * 64 * SC_PITCH * 4 <= WS_END, "ws map");

constexpr int CW_BAR = 4096;

constexpr int RING_BYTES = 139264;
constexpr int MISC_OFF = RING_BYTES + 320;
constexpr int LDS_BYTES = 147456;
constexpr int NWAVES = 8;

#define LAS __attribute__((address_space(3)))
typedef unsigned short bf16;
typedef float f32x4 __attribute__((ext_vector_type(4)));
typedef float f32x2 __attribute__((ext_vector_type(2)));
typedef unsigned u32x4 __attribute__((ext_vector_type(4)));
typedef unsigned u32x2 __attribute__((ext_vector_type(2)));
typedef short bf16x8 __attribute__((ext_vector_type(8)));
typedef short s16x4 __attribute__((ext_vector_type(4)));
#define LDS_WAIT() asm volatile("s_waitcnt lgkmcnt(0)" ::: "memory")
#define VM_WAIT() asm volatile("s_waitcnt vmcnt(0)" ::: "memory")
#define LDS_BARRIER() do { asm volatile("s_waitcnt lgkmcnt(0)" ::: "memory"); __builtin_amdgcn_s_barrier(); asm volatile("" ::: "memory"); } while (0)

typedef __bf16 hwbf16x2 __attribute__((ext_vector_type(2)));
__device__ __forceinline__ unsigned pk2(float lo, float hi) { const f32x2 v = {lo, hi}; const hwbf16x2 b = __builtin_convertvector(v, hwbf16x2); return __builtin_bit_cast(unsigned, b); }
__device__ __forceinline__ unsigned f2bf(float f) { return pk2(f, 0.f) & 0xffffu; }
__device__ __forceinline__ float bf2f(unsigned b) { return __builtin_bit_cast(float, b << 16); }
__device__ __forceinline__ float bflo(unsigned w) { return __builtin_bit_cast(float, w << 16); }
__device__ __forceinline__ float bfhi(unsigned w) { return __builtin_bit_cast(float, w & 0xffff0000u); }
__device__ __forceinline__ float wave_sum(float v) {
#pragma unroll
    for (int o = 1; o < 64; o <<= 1) v += __shfl_xor(v, o);
    return v;
}
__device__ __forceinline__ float wave_max(float v) {
#pragma unroll
    for (int o = 1; o < 64; o <<= 1) v = fmaxf(v, __shfl_xor(v, o));
    return v;
}
__device__ __forceinline__ float sigmoid_f(float x) { return __builtin_amdgcn_rcpf(1.f + __builtin_amdgcn_exp2f(-1.4426950408889634f * x)); }
__device__ __forceinline__ float silu_f(float x) { return x * sigmoid_f(x); }
__device__ __forceinline__ float logsigmoid_f(float x) { return fminf(x, 0.f) - 0.6931471805599453f * __builtin_amdgcn_logf(1.f + __builtin_amdgcn_exp2f(-1.4426950408889634f * fabsf(x))); }

#define XB_TMO      128
#define XB_XCNT(j)  (256  + 64 * (j))
#define XB_XSUB(j)  (1280 + 64 * (j))
#define XB_XGEN(j)  (2304 + 64 * (j))
#define XB_TOP      3328
#define XB_TOPGEN   3392
#define XCD_BAR_WORDS 3456
#define XB_SPIN_CAP (1u << 22)

__device__ __forceinline__ unsigned xb_ld(unsigned* p)              { return __hip_atomic_load(p, __ATOMIC_RELAXED, __HIP_MEMORY_SCOPE_AGENT); }
__device__ __forceinline__ unsigned xb_add(unsigned* p, unsigned v) { return __hip_atomic_fetch_add(p, v, __ATOMIC_RELAXED, __HIP_MEMORY_SCOPE_AGENT); }
__device__ __forceinline__ unsigned xb_xcc_id() { return (unsigned)__builtin_amdgcn_s_getreg((3 << 11) | 20) & 0xFu; }
#define XB_SPIN(cond, bar) do { unsigned _sp = 0; while (cond) { __builtin_amdgcn_s_sleep(1); \
    if ((++_sp & 255u) == 0u) { if (xb_ld(&(bar)[XB_TMO])) break; if (_sp > XB_SPIN_CAP) { atomicAdd(&(bar)[XB_TMO], 1u); break; } } } } while (0)

struct XcdBarrier {
    unsigned* bar; unsigned x;
    volatile LAS unsigned* st;
};

__device__ __forceinline__ XcdBarrier xcd_barrier_post(unsigned* bar, volatile LAS unsigned* st) {
    XcdBarrier b; b.bar = bar; b.x = xb_xcc_id(); b.st = st;
    if (threadIdx.x == 0) (void)xb_add(&bar[XB_XCNT(b.x)], 1u);
    return b;
}
__device__ __forceinline__ void xcd_barrier_complete(unsigned* bar, unsigned x, unsigned& nloc, unsigned& nx) {
    const unsigned G = gridDim.x * gridDim.y * gridDim.z;
    unsigned sum, cnt, mine, sp = 0u;
    for (;;) {
        sum = 0u; cnt = 0u; mine = 0u;
#pragma unroll
        for (unsigned j = 0; j < 16; ++j) { const unsigned c = xb_ld(&bar[XB_XCNT(j)]); sum += c; cnt += (c > 0u) ? 1u : 0u; mine = (j == x) ? c : mine; }
        if (sum == G) break;
        __builtin_amdgcn_s_sleep(1);
        if ((++sp & 255u) == 0u) { if (xb_ld(&bar[XB_TMO])) break; if (sp > XB_SPIN_CAP) { atomicAdd(&bar[XB_TMO], 1u); break; } }
    }
    nloc = mine > 0u ? mine : 1u; nx = cnt > 0u ? cnt : 1u;
}

__device__ __forceinline__ void xcd_barrier(const XcdBarrier& b) {
    asm volatile("s_waitcnt vmcnt(0)" ::: "memory");
    __syncthreads();
    if (threadIdx.x == 0) {
        unsigned* bar = b.bar;
        __builtin_amdgcn_s_waitcnt(0);
        unsigned nloc = b.st[0], nx = b.st[1];
        if (nloc == 0u) { xcd_barrier_complete(bar, b.x, nloc, nx); b.st[0] = nloc; b.st[1] = nx; }
        const unsigned old = xb_add(&bar[XB_XSUB(b.x)], 1u);
        const unsigned gen = old / nloc;
        if (old + 1u == (gen + 1u) * nloc) {
            __builtin_amdgcn_fence(__ATOMIC_RELEASE, "agent");
            asm volatile("s_waitcnt vmcnt(0)" ::: "memory");
            const unsigned og = xb_add(&bar[XB_TOP], 1u);
            const unsigned tg = og / nx;
            if (og + 1u == (tg + 1u) * nx) xb_add(&bar[XB_TOPGEN], 1u);
            else XB_SPIN(xb_ld(&bar[XB_TOPGEN]) == tg, bar);
            __builtin_amdgcn_fence(__ATOMIC_ACQUIRE, "agent");
            xb_add(&bar[XB_XGEN(b.x)], 1u);
            asm volatile("s_waitcnt vmcnt(0)" ::: "memory");
        } else {
            XB_SPIN(xb_ld(&bar[XB_XGEN(b.x)]) == gen, bar);
            __builtin_amdgcn_fence(__ATOMIC_ACQUIRE, "agent");
            asm volatile("s_waitcnt vmcnt(0)" ::: "memory");
        }
    }
    __syncthreads();
}


struct Args { const float* in[28]; float* out; unsigned char* ws; int g_lo, g_hi, l_lo, l_hi, ph_lo, ph_hi, prep, use_bar; };
typedef const __attribute__((address_space(4))) Args* ArgsP;
enum { I_X = 0, I_META, I_T5, I_GPREMIX, I_WIN, I_BIN, I_WA2, I_BA, I_GGLA, I_WBRG, I_GDQ, I_WUQ, I_WIQ, I_GDKV, I_WUV, I_LNG, I_LNB, I_WBRD,
       I_CONV, I_FB, I_GML, I_WBRM, I_WOUT, I_GPOSTMIX, I_GPREMLP, I_WUP, I_WDN, I_GPOSTMLP };

__device__ __forceinline__ int win_src(int n) {
    if (n < 3072) return n;
    if (n < 6144) return n - 3072 + 3544;
    if (n < 9216) return n - 6144 + 6624;
    if (n < 9472) return n - 9216 + 3088;
    if (n < 9600) return n - 9472 + 3344;
    if (n < 9664) return n - 9600 + 3472;
    if (n < 9680) return n - 9664 + 3072;
    if (n < 9688) return n - 9680 + 3536;
    if (n < 9692) return n - 9688 + 6616;
    if (n < 9696) return n - 9692 + 6620;
    return -1;
}
struct CmIdent { __device__ __forceinline__ int operator()(int n) const { return n; } };
struct CmWin { __device__ __forceinline__ int operator()(int n) const { return win_src(n); } };

template <class CM>
__device__ __forceinline__ void tr_item(const float* __restrict__ W, int ldw, bf16* __restrict__ WT, int Kd, LAS float* scr, int k0, int ns0, int nd0, int lane, CM cm) {
    const int sc = cm(ns0 + (lane & 31)); const int scc = sc >= 0 ? sc : 0; const float msk = sc >= 0 ? 1.f : 0.f;
    float wv[32];
#pragma unroll
    for (int i = 0; i < 32; ++i) { const int kk = 2 * i + (lane >> 5); wv[i] = W[(size_t)(k0 + kk) * ldw + scc]; }
#pragma unroll
    for (int i = 0; i < 32; ++i) { const int kk = 2 * i + (lane >> 5); scr[kk * 33 + (lane & 31)] = wv[i] * msk; }
    LDS_WAIT();
    const int c = lane & 7;
#pragma unroll
    for (int j = 0; j < 4; ++j) { const int n = (lane >> 3) + 8 * j; const LAS float* s = scr + (8 * c) * 33 + n;
        u32x4 o; o.x = pk2(s[0 * 33], s[1 * 33]); o.y = pk2(s[2 * 33], s[3 * 33]); o.z = pk2(s[4 * 33], s[5 * 33]); o.w = pk2(s[6 * 33], s[7 * 33]);
        *(u32x4*)(WT + (size_t)(nd0 + n) * Kd + k0 + 8 * c) = o; }
    LDS_WAIT();
}

__device__ __forceinline__ void prep_weights(ArgsP a, LAS unsigned char* lds, int gw, int ngw, int wave, int lane) {
    LAS float* scr = (LAS float*)(lds + wave * 16384);
    unsigned char* ws = a->ws;
    constexpr int I_WIN_N = 16 * 304, I_UQ = 4 * 64, I_IQ = 4 * 16, I_SQ = 16 * 32, I_UP = 16 * 128, I_DN = 64 * 32, I_WBD = 4096, I_B = NZ / 64;
    constexpr int PER_L = I_WIN_N + I_UQ + I_IQ + 3 * I_SQ + I_UP + I_DN + I_WBD + I_B;
    for (int it = gw; it < NL * PER_L; it += ngw) {
        const int l = it / PER_L; int r = it % PER_L;
        if (r < I_WIN_N) { const int kb = r / 304, nb = r % 304;
            tr_item(a->in[I_WIN] + (size_t)l * D * NCOLS, NCOLS, (bf16*)(ws + WS_WIN) + (size_t)l * NZ * D, D, scr, kb * 64, nb * 32, nb * 32, lane, CmWin()); continue; }
        r -= I_WIN_N;
        if (r < I_UQ) { const int kb = r / 64, nb = r % 64;
            tr_item(a->in[I_WUQ] + (size_t)l * 256 * 2048, 2048, (bf16*)(ws + WS_WQQ) + (size_t)l * NQQ * 256, 256, scr, kb * 64, nb * 32, nb * 32, lane, CmIdent()); continue; }
        r -= I_UQ;
        if (r < I_IQ) { const int kb = r / 16, nb = r % 16;
            tr_item(a->in[I_WIQ] + (size_t)l * 256 * 512, 512, (bf16*)(ws + WS_WQQ) + (size_t)l * NQQ * 256, 256, scr, kb * 64, nb * 32, 2048 + nb * 32, lane, CmIdent()); continue; }
        r -= I_IQ;
        if (r < I_SQ) { const int kb = r / 32, nb = r % 32;
            tr_item(a->in[I_WBRG] + (size_t)l * D * D, D, (bf16*)(ws + WS_WBG) + (size_t)l * D * D, D, scr, kb * 64, nb * 32, nb * 32, lane, CmIdent()); continue; }
        r -= I_SQ;
        if (r < I_SQ) { const int kb = r / 32, nb = r % 32;
            tr_item(a->in[I_WBRM] + (size_t)l * D * D, D, (bf16*)(ws + WS_WBM) + (size_t)l * D * D, D, scr, kb * 64, nb * 32, nb * 32, lane, CmIdent()); continue; }
        r -= I_SQ;
        if (r < I_SQ) { const int kb = r / 32, nb = r % 32;
            tr_item(a->in[I_WOUT] + (size_t)l * D * D, D, (bf16*)(ws + WS_WOUT) + (size_t)l * D * D, D, scr, kb * 64, nb * 32, nb * 32, lane, CmIdent()); continue; }
        r -= I_SQ;
        if (r < I_UP) { const int kb = r / 128, nb = r % 128;
            tr_item(a->in[I_WUP] + (size_t)l * D * DFF, DFF, (bf16*)(ws + WS_WUP) + (size_t)l * DFF * D, D, scr, kb * 64, nb * 32, nb * 32, lane, CmIdent()); continue; }
        r -= I_UP;
        if (r < I_DN) { const int kb = r / 32, nb = r % 32;
            tr_item(a->in[I_WDN] + (size_t)l * DFF * D, D, (bf16*)(ws + WS_WDN) + (size_t)l * D * DFF, DFF, scr, kb * 64, nb * 32, nb * 32, lane, CmIdent()); continue; }
        r -= I_DN;
        if (r < I_WBD) {
            const int h = r >> 8, nb = (r >> 4) & 15, cb = r & 15, n = nb * 64 + lane, c0 = cb * 8;
            const float* uv = a->in[I_WUV] + ((size_t)(l * 16 + h) * 128 + c0) * 64;
            const float* wb = a->in[I_WBRD] + ((size_t)l * D + h * 64) * D + n;
            float acc[8];
#pragma unroll
            for (int j = 0; j < 8; ++j) acc[j] = 0.f;
            for (int d0 = 0; d0 < 64; d0 += 8) {
                float wv[8];
#pragma unroll
                for (int e = 0; e < 8; ++e) wv[e] = wb[(size_t)(d0 + e) * D];
#pragma unroll
                for (int j = 0; j < 8; ++j) { const f32x4 u0 = *(const f32x4*)(uv + j * 64 + d0), u1 = *(const f32x4*)(uv + j * 64 + d0 + 4);
                    acc[j] += (u0.x * wv[0] + u0.y * wv[1]) + (u0.z * wv[2] + u0.w * wv[3]) + (u1.x * wv[4] + u1.y * wv[5]) + (u1.z * wv[6] + u1.w * wv[7]); }
            }
            bf16* o = (bf16*)(ws + WS_WBD) + (size_t)l * D * 2048 + (size_t)(h >> 3) * D * D + (size_t)n * D + (h & 7) * 128 + c0;
            u32x4 ow; ow.x = pk2(acc[0], acc[1]); ow.y = pk2(acc[2], acc[3]); ow.z = pk2(acc[4], acc[5]); ow.w = pk2(acc[6], acc[7]);
            *(u32x4*)o = ow;
            continue; }
        r -= I_WBD;
        { const int n = r * 64 + lane; const int sc = win_src(n);
          ((float*)(ws + WS_BIN))[l * NZ + n] = sc >= 0 ? a->in[I_BIN][l * NCOLS + sc] : 0.f; }
    }
}

__device__ __forceinline__ float* hrow(ArgsP a, int g, int r) {
    return r < MR ? a->out + ((size_t)g * MR + r) * D : (float*)(a->ws + WS_HM) + (size_t)(r - MR) * D;
}
__device__ __forceinline__ void rms_row_bf16(const f32x4 (&v)[4], const float* __restrict__ gain, bf16* __restrict__ orow, int lane) {
    float s = 0.f;
#pragma unroll
    for (int j = 0; j < 4; ++j) s += (v[j].x * v[j].x + v[j].y * v[j].y) + (v[j].z * v[j].z + v[j].w * v[j].w);
    const float r = rsqrtf(wave_sum(s) * (1.f / D) + EPS);
#pragma unroll
    for (int j = 0; j < 4; ++j) { const f32x4 gg = *(const f32x4*)(gain + 4 * lane + 256 * j); const f32x4 o = v[j] * r * gg;
        u32x2 w; w.x = pk2(o.x, o.y); w.y = pk2(o.z, o.w); *(u32x2*)(orow + 4 * lane + 256 * j) = w; }
}
__device__ __forceinline__ void p0_init(ArgsP a, int g, int gw, int ngw, int lane) {
    bf16* XN = (bf16*)(a->ws + WS_XN);
    for (int r = gw; r < MT; r += ngw) {
        const float* src = r < MR ? a->in[I_X] + ((size_t)g * MR + r) * D : a->in[I_META] + (size_t)(r - MR) * D;
        float* hd = hrow(a, g, r);
        f32x4 v[4];
#pragma unroll
        for (int j = 0; j < 4; ++j) { v[j] = *(const f32x4*)(src + 4 * lane + 256 * j); *(f32x4*)(hd + 4 * lane + 256 * j) = v[j]; }
        rms_row_bf16(v, a->in[I_GPREMIX], XN + (size_t)r * D, lane);
    }
}
template <bool DRY = false>
__device__ __forceinline__ void p_norm_res(ArgsP a, int g, const float* gpost, const float* gpre, int gw, int ngw, int lane, int rbeg = 0) {
    bf16* XN = (bf16*)(a->ws + (DRY ? WS_Z + 100 * MiB : WS_XN)); const bf16* Y = (const bf16*)(a->ws + WS_Y);
    f32x4 gp[4], gq[4];
#pragma unroll
    for (int j = 0; j < 4; ++j) { gp[j] = *(const f32x4*)(gpost + 4 * lane + 256 * j); gq[j] = gpre ? *(const f32x4*)(gpre + 4 * lane + 256 * j) : (f32x4){0.f, 0.f, 0.f, 0.f}; }
    for (int r0 = rbeg + gw * 2; r0 < MT; r0 += ngw * 2) {
        float* hd[2]; float* hw[2]; u32x2 yw[2][4]; f32x4 v[2][4]; float s[2];
#pragma unroll
        for (int i = 0; i < 2; ++i) { const int r = r0 + i; hd[i] = hrow(a, g, r); hw[i] = DRY ? (float*)(a->ws + WS_Z) + (size_t)r * D : hd[i];
#pragma unroll
            for (int j = 0; j < 4; ++j) { yw[i][j] = *(const u32x2*)(Y + (size_t)r * D + 4 * lane + 256 * j); v[i][j] = *(const f32x4*)(hd[i] + 4 * lane + 256 * j); } }
        f32x4 y[2][4];
#pragma unroll
        for (int i = 0; i < 2; ++i) { s[i] = 0.f;
#pragma unroll
            for (int j = 0; j < 4; ++j) { y[i][j] = (f32x4){bflo(yw[i][j].x), bfhi(yw[i][j].x), bflo(yw[i][j].y), bfhi(yw[i][j].y)};
                s[i] += (y[i][j].x * y[i][j].x + y[i][j].y * y[i][j].y) + (y[i][j].z * y[i][j].z + y[i][j].w * y[i][j].w); } }
#pragma unroll
        for (int o = 1; o < 64; o <<= 1) { s[0] += __shfl_xor(s[0], o); s[1] += __shfl_xor(s[1], o); }
        float s2[2];
#pragma unroll
        for (int i = 0; i < 2; ++i) { const float rr = rsqrtf(s[i] * (1.f / D) + EPS); s2[i] = 0.f;
#pragma unroll
            for (int j = 0; j < 4; ++j) { v[i][j] = v[i][j] + y[i][j] * rr * gp[j]; *(f32x4*)(hw[i] + 4 * lane + 256 * j) = v[i][j];
                s2[i] += (v[i][j].x * v[i][j].x + v[i][j].y * v[i][j].y) + (v[i][j].z * v[i][j].z + v[i][j].w * v[i][j].w); } }
        if (gpre) {
#pragma unroll
            for (int o = 1; o < 64; o <<= 1) { s2[0] += __shfl_xor(s2[0], o); s2[1] += __shfl_xor(s2[1], o); }
#pragma unroll
            for (int i = 0; i < 2; ++i) { const float r2 = rsqrtf(s2[i] * (1.f / D) + EPS);
#pragma unroll
                for (int j = 0; j < 4; ++j) { const f32x4 o4 = v[i][j] * r2 * gq[j]; u32x2 w; w.x = pk2(o4.x, o4.y); w.y = pk2(o4.z, o4.w); *(u32x2*)(XN + (size_t)(r0 + i) * D + 4 * lane + 256 * j) = w; } }
        }
    }
}

template <class F> struct EpiT {
    static constexpr bool PERM = true, AFTER_DRAIN = false;
    F f;
    __device__ __forceinline__ void operator()(const f32x4 (&acc)[2][2][4][2], const pg8::Unit& u, int wr, int wc, int fr, int fq) const {
        const int row0 = u.pm * 256 + wr * 64 + fr, col0 = u.pn * 256 + wc * 32 + 8 * fq;
        if constexpr (F::HAS_BIAS) {
            const f32x4 b00 = *(const f32x4*)(f.bias + col0), b01 = *(const f32x4*)(f.bias + col0 + 4), b10 = *(const f32x4*)(f.bias + col0 + 128), b11 = *(const f32x4*)(f.bias + col0 + 132);
#pragma unroll
            for (int ai = 0; ai < 2; ++ai)
#pragma unroll
                for (int m = 0; m < 4; ++m) { f.apply(row0 + ai * 128 + m * 16, col0, acc[ai][0][m][0] + b00, acc[ai][0][m][1] + b01); f.apply(row0 + ai * 128 + m * 16, col0 + 128, acc[ai][1][m][0] + b10, acc[ai][1][m][1] + b11); }
            return;
        }
#pragma unroll
        for (int ai = 0; ai < 2; ++ai)
#pragma unroll
            for (int m = 0; m < 4; ++m)
#pragma unroll
                for (int bj = 0; bj < 2; ++bj) f.apply(row0 + ai * 128 + m * 16, col0 + bj * 128, acc[ai][bj][m][0], acc[ai][bj][m][1]);
    }
};
__device__ __forceinline__ void st_bf16x8(bf16* p, f32x4 v0, f32x4 v1) { u32x4 w; w.x = pk2(v0.x, v0.y); w.y = pk2(v0.z, v0.w); w.z = pk2(v1.x, v1.y); w.w = pk2(v1.z, v1.w); *(u32x4*)p = w; }
__device__ __forceinline__ void st_bf16x8_nt(bf16* p, f32x4 v0, f32x4 v1) { u32x4 w; w.x = pk2(v0.x, v0.y); w.y = pk2(v0.z, v0.w); w.z = pk2(v1.x, v1.y); w.w = pk2(v1.z, v1.w); __builtin_nontemporal_store(w, (u32x4*)p); }
__device__ __forceinline__ void ld_bf16x8(const bf16* p, f32x4& v0, f32x4& v1) { const u32x4 w = *(const u32x4*)p;
    v0 = (f32x4){bflo(w.x), bfhi(w.x), bflo(w.y), bfhi(w.y)}; v1 = (f32x4){bflo(w.z), bfhi(w.z), bflo(w.w), bfhi(w.w)}; }

#if defined(NT_STORES)
#define ST_BIG st_bf16x8_nt
#else
#define ST_BIG st_bf16x8
#endif
struct FIn {
    static constexpr bool HAS_BIAS = true, STAGGER = true;
    bf16* Z; float* ZF; const float* bias;
    __device__ __forceinline__ void apply(int row, int col, f32x4 v0, f32x4 v1) const {
        const int t = col >> 8;
        if (t >= 36) { float* p = ZF + (size_t)row * ZFW + (col - ZB); *(f32x4*)p = v0; *(f32x4*)(p + 4) = v1; return; }
        if (t < 2) { v0 *= 0.08838834764831845f; v1 *= 0.08838834764831845f; }
        else if (t >= 8 && t < 12) {
#pragma unroll
            for (int i = 0; i < 4; ++i) { v0[i] = silu_f(v0[i]); v1[i] = silu_f(v1[i]); } }
        else if (t >= 20) {
#pragma unroll
            for (int i = 0; i < 4; ++i) { v0[i] = sigmoid_f(v0[i]); v1[i] = sigmoid_f(v1[i]); } }
        ST_BIG(Z + (size_t)row * ZB + col, v0, v1);
    }
};
struct FQQ {
    static constexpr bool HAS_BIAS = false, STAGGER = false;
    bf16* QQ;
    __device__ __forceinline__ void apply(int row, int col, f32x4 v0, f32x4 v1) const {
        const float s = col < 2048 ? 0.08838834764831845f : 0.125f;
        st_bf16x8(QQ + (size_t)row * NQQ + col, v0 * s, v1 * s);
    }
};
template <int IDX> struct FBr {
    static constexpr bool HAS_BIAS = false;
    const bf16* Z; float* Y; bf16* MIX;
    __device__ __forceinline__ void apply(int row, int col, f32x4 v0, f32x4 v1) const {
        f32x4 g0, g1; ld_bf16x8(Z + (size_t)row * ZB + ZC_GATE + IDX * 1024 + col, g0, g1);
        float* y = Y + (size_t)row * D + col;
        f32x4 a0 = v0 * g0, a1 = v1 * g1;
        if (IDX > 0) { a0 += *(const f32x4*)y; a1 += *(const f32x4*)(y + 4); }
        if (IDX < 2) { *(f32x4*)y = a0; *(f32x4*)(y + 4) = a1; }
        else st_bf16x8(MIX + (size_t)row * D + col, a0, a1);
    }
};
struct FY {
    static constexpr bool HAS_BIAS = false, STAGGER = false;
    bf16* Y;
    __device__ __forceinline__ void apply(int row, int col, f32x4 v0, f32x4 v1) const { st_bf16x8(Y + (size_t)row * D + col, v0, v1); }
};
struct FUp {
    static constexpr bool HAS_BIAS = false, STAGGER = true;
    bf16* U;
    __device__ __forceinline__ void apply(int row, int col, f32x4 v0, f32x4 v1) const {
#pragma unroll
        for (int i = 0; i < 4; ++i) { const float p = fmaxf(v0[i], 0.f), q = fmaxf(v1[i], 0.f); v0[i] = p * p; v1[i] = q * q; }
#if defined(PROBE_NOSTORE)
        if (v0.x == 12345.678f) st_bf16x8(U + (size_t)row * DFF + col, v0, v1);
#else
        ST_BIG(U + (size_t)row * DFF + col, v0, v1);
#endif
    }
};

template <class F>
__device__ __forceinline__ void mini_gemm(LAS unsigned char* lds, const bf16* __restrict__ A, const bf16* __restrict__ Bt, int N, int K, const F& f, int tid_in) {
    int tid = tid_in; asm volatile("" : "+v"(tid));
    const int lane = tid & 63, wave = __builtin_amdgcn_readfirstlane(tid >> 6), fr = lane & 15, fq = lane >> 4;
    LAS float* red = (LAS float*)lds;
    const int kw = K >> 3, kbeg = wave * kw;
    for (int wt = blockIdx.x; wt < N / 32; wt += gridDim.x) {
        const int n0 = wt * 32;
        f32x4 acc0 = {0.f, 0.f, 0.f, 0.f}, acc1 = {0.f, 0.f, 0.f, 0.f};
        const bf16* ap = A + (size_t)(MR + fr) * K + fq * 8 + kbeg;
        const bf16* b0 = Bt + (size_t)(n0 + pg8::perm32(fr)) * K + fq * 8 + kbeg;
        const bf16* b1 = Bt + (size_t)(n0 + pg8::perm32(16 + fr)) * K + fq * 8 + kbeg;
        if (kw < 128) {
            const bf16x8 av = *(const bf16x8*)ap, w0 = *(const bf16x8*)b0, w1 = *(const bf16x8*)b1;
            acc0 = __builtin_amdgcn_mfma_f32_16x16x32_bf16(w0, av, acc0, 0, 0, 0);
            acc1 = __builtin_amdgcn_mfma_f32_16x16x32_bf16(w1, av, acc1, 0, 0, 0);
        } else {
            for (int k = 0; k < kw; k += 128) {
                bf16x8 av[4], w0[4], w1[4];
#pragma unroll
                for (int u = 0; u < 4; ++u) { av[u] = *(const bf16x8*)(ap + k + 32 * u); w0[u] = *(const bf16x8*)(b0 + k + 32 * u); w1[u] = *(const bf16x8*)(b1 + k + 32 * u); }
#pragma unroll
                for (int u = 0; u < 4; ++u) {
                    acc0 = __builtin_amdgcn_mfma_f32_16x16x32_bf16(w0[u], av[u], acc0, 0, 0, 0);
                    acc1 = __builtin_amdgcn_mfma_f32_16x16x32_bf16(w1[u], av[u], acc1, 0, 0, 0);
                }
            }
        }
        *(LAS f32x4*)(red + (wave * 64 + lane) * 8) = acc0; *(LAS f32x4*)(red + (wave * 64 + lane) * 8 + 4) = acc1;
        LDS_WAIT();
        __syncthreads();
        if (wave == 0) {
            f32x4 s0 = {0.f, 0.f, 0.f, 0.f}, s1 = {0.f, 0.f, 0.f, 0.f};
#pragma unroll
            for (int w = 0; w < 8; ++w) { s0 += *(const LAS f32x4*)(red + (w * 64 + lane) * 8); s1 += *(const LAS f32x4*)(red + (w * 64 + lane) * 8 + 4); }
            if constexpr (F::HAS_BIAS) { s0 += *(const f32x4*)(f.bias + n0 + 8 * fq); s1 += *(const f32x4*)(f.bias + n0 + 8 * fq + 4); }
            f.apply(MR + fr, n0 + 8 * fq, s0, s1);
        }
        __syncthreads();
    }
}
template <class F, bool ALIGN = true>
__device__ __forceinline__ void run_gemm(LAS unsigned char* lds, const bf16* A, const bf16* Bt, int N, int K, const F& f, int gw, int ngw, int lane) {
    asm volatile("" : "+s"(K)); asm volatile("" : "+s"(N));
    pg8::Gemm g{A, Bt, MR, N, K}; pg8::StaticOrder S; S.init(MR, N, (int)gridDim.x, (int)blockIdx.x);
    EpiT<F> E{f};
#if defined(STAGGER_TICKS)
    if (F::STAGGER) {
        const unsigned long long t0 = __builtin_amdgcn_s_memrealtime(), dl = (unsigned long long)(blockIdx.x & 3u) * STAGGER_TICKS;
        while (__builtin_amdgcn_s_memrealtime() - t0 < dl) __builtin_amdgcn_s_sleep(4);
    }
#endif
    pg8::gemm_phase<EpiT<F>, pg8::StaticOrder, ALIGN, true>((PG8_LAS unsigned char*)lds, g, S, E);
    mini_gemm(lds, A, Bt, N, K, f, (int)threadIdx.x);
}

struct ChainOrder {
    pg8::StaticOrder S;
    __device__ __forceinline__ bool next(int i, pg8::Unit& u) const { if (!S.next(i >> 2, u)) return false; u.sub = i & 3; return true; }
    __device__ __forceinline__ void a_ready(const pg8::Unit&) const {}
    __device__ __forceinline__ void done(const pg8::Unit&) const {}
};
struct EpiMix {
    static constexpr bool PERM = true, AFTER_DRAIN = false;
    const bf16* Z; bf16* MIX;
    __device__ __forceinline__ void mid(f32x4 (&acc)[2][2][4][2], const pg8::Unit& u, int wr, int wc, int fr, int fq) const {
        if (u.sub == 1) return;
        const int gi = u.sub == 0 ? 0 : 1;
        const int row0 = u.pm * 256 + wr * 64 + fr, col0 = u.pn * 256 + wc * 32 + 8 * fq;
#pragma unroll
        for (int ai = 0; ai < 2; ++ai) {
            u32x4 ga[4][2], gb[4][2];
#pragma unroll
            for (int m = 0; m < 4; ++m)
#pragma unroll
                for (int bj = 0; bj < 2; ++bj) { const bf16* gp = Z + (size_t)(row0 + ai * 128 + m * 16) * ZB + ZC_GATE + gi * 1024 + col0 + bj * 128;
                    ga[m][bj] = *(const u32x4*)gp; gb[m][bj] = *(const u32x4*)(gp + 1024); }
#pragma unroll
            for (int m = 0; m < 4; ++m)
#pragma unroll
                for (int bj = 0; bj < 2; ++bj) {
                    const u32x4 a = ga[m][bj], b = gb[m][bj];
                    f32x4 r0, r1;
                    r0.x = bflo(a.x) * __builtin_amdgcn_rcpf(bflo(b.x)); r0.y = bfhi(a.x) * __builtin_amdgcn_rcpf(bfhi(b.x)); r0.z = bflo(a.y) * __builtin_amdgcn_rcpf(bflo(b.y)); r0.w = bfhi(a.y) * __builtin_amdgcn_rcpf(bfhi(b.y));
                    r1.x = bflo(a.z) * __builtin_amdgcn_rcpf(bflo(b.z)); r1.y = bfhi(a.z) * __builtin_amdgcn_rcpf(bfhi(b.z)); r1.z = bflo(a.w) * __builtin_amdgcn_rcpf(bflo(b.w)); r1.w = bfhi(a.w) * __builtin_amdgcn_rcpf(bfhi(b.w));
                    acc[ai][bj][m][0] *= r0; acc[ai][bj][m][1] *= r1;
                }
            asm volatile("" ::: "memory");
        }
    }
    __device__ __forceinline__ void operator()(const f32x4 (&acc)[2][2][4][2], const pg8::Unit& u, int wr, int wc, int fr, int fq) const {
        const int row0 = u.pm * 256 + wr * 64 + fr, col0 = u.pn * 256 + wc * 32 + 8 * fq;
#pragma unroll
        for (int ai = 0; ai < 2; ++ai) {
            u32x4 gc[4][2];
#pragma unroll
            for (int m = 0; m < 4; ++m)
#pragma unroll
                for (int bj = 0; bj < 2; ++bj) gc[m][bj] = *(const u32x4*)(Z + (size_t)(row0 + ai * 128 + m * 16) * ZB + ZC_GATE + 2 * 1024 + col0 + bj * 128);
#pragma unroll
            for (int m = 0; m < 4; ++m)
#pragma unroll
                for (int bj = 0; bj < 2; ++bj) {
                    const u32x4 w = gc[m][bj];
                    const f32x4 g0 = {bflo(w.x), bfhi(w.x), bflo(w.y), bfhi(w.y)}, g1 = {bflo(w.z), bfhi(w.z), bflo(w.w), bfhi(w.w)};
                    st_bf16x8(MIX + (size_t)(row0 + ai * 128 + m * 16) * D + col0 + bj * 128, acc[ai][bj][m][0] * g0, acc[ai][bj][m][1] * g1);
                }
            asm volatile("" ::: "memory");
        }
    }
};

constexpr int CW_XCNT = 16384;
struct RmsExchange {
    float* xbuf; unsigned* cnt; unsigned* tmo; unsigned target;
    __device__ __forceinline__ void run(const f32x4 (&v)[2][2][4][2], const pg8::Unit& u, int wr, int wc, int fr, int fq, LAS unsigned char* lds, int wid, int lane) const {
        LAS float* P = (LAS float*)lds;
        LAS float* S = (LAS float*)(lds + 8192);
#pragma unroll
        for (int ai = 0; ai < 2; ++ai)
#pragma unroll
            for (int m = 0; m < 4; ++m) {
                float s = 0.f;
#pragma unroll
                for (int bj = 0; bj < 2; ++bj)
#pragma unroll
                    for (int n = 0; n < 2; ++n) { const f32x4 x = v[ai][bj][m][n]; s += (x.x * x.x + x.y * x.y) + (x.z * x.z + x.w * x.w); }
                s += __shfl_xor(s, 16); s += __shfl_xor(s, 32);
                if (fq == 0) P[(ai * 128 + wr * 64 + m * 16 + fr) * 4 + wc] = s;
            }
        LDS_BARRIER();
        const int row = wid * 32 + (lane & 31);
        if (lane < 32) {
            const f32x4 p = *(const LAS f32x4*)(P + row * 4);
            __hip_atomic_store(xbuf + ((size_t)(u.pm * 256 + row) * 4 + u.pn), (p.x + p.y) + (p.z + p.w), __ATOMIC_RELAXED, __HIP_MEMORY_SCOPE_AGENT);
        }
        asm volatile("s_waitcnt vmcnt(0)" ::: "memory");
        if (lane == 0) __hip_atomic_fetch_add(cnt + 64 * u.pm, 1u, __ATOMIC_RELAXED, __HIP_MEMORY_SCOPE_AGENT);
        if (wid == 0) {
            const unsigned long long t0 = __builtin_amdgcn_s_memrealtime();
            for (;;) {
                if ((unsigned)__builtin_amdgcn_readfirstlane(__hip_atomic_load(cnt + 64 * u.pm, __ATOMIC_RELAXED, __HIP_MEMORY_SCOPE_AGENT)) >= target) break;
                if (__builtin_amdgcn_s_memrealtime() - t0 > 2000000ull) { if (lane == 0) __hip_atomic_store(tmo, 1u, __ATOMIC_RELAXED, __HIP_MEMORY_SCOPE_AGENT); break; }
                __builtin_amdgcn_s_sleep(2);
            }
            __builtin_amdgcn_fence(__ATOMIC_ACQUIRE, "agent");
        }
        asm volatile("s_waitcnt vmcnt(0) lgkmcnt(0)" ::: "memory"); __builtin_amdgcn_s_barrier(); asm volatile("" ::: "memory");
        if (lane < 32) {
            const float* slot = xbuf + (size_t)(u.pm * 256 + row) * 4; float t = 0.f;
#pragma unroll
            for (int q = 0; q < 4; ++q) t += __hip_atomic_load(slot + q, __ATOMIC_RELAXED, __HIP_MEMORY_SCOPE_AGENT);
            S[row] = rsqrtf(t * (1.f / D) + EPS);
        }
        LDS_BARRIER();
    }
};
struct EpiResNorm {
    static constexpr bool PERM = true, AFTER_DRAIN = true;
    float* hb; bf16* XN; const float* gpost; const float* gpre; RmsExchange e1, e2;
    __device__ __forceinline__ void fused(f32x4 (&acc)[2][2][4][2], const pg8::Unit& u, int wr, int wc, int fr, int fq, LAS unsigned char* lds, int wid, int lane) const {
        const LAS float* S = (const LAS float*)(lds + 8192);
        const int col0 = u.pn * 256 + wc * 32 + 8 * fq;
        f32x4 g0[2], g1[2];
#pragma unroll
        for (int bj = 0; bj < 2; ++bj) { g0[bj] = *(const f32x4*)(gpost + col0 + bj * 128); g1[bj] = *(const f32x4*)(gpost + col0 + bj * 128 + 4); }
        e1.run(acc, u, wr, wc, fr, fq, lds, wid, lane);
#pragma unroll
        for (int ai = 0; ai < 2; ++ai)
#pragma unroll
            for (int m = 0; m < 4; ++m) {
                const int rl = ai * 128 + wr * 64 + m * 16 + fr; const float rs = S[rl];
                float* hp = hb + (size_t)(u.pm * 256 + rl) * D + col0;
                f32x4 h00 = *(const f32x4*)hp, h01 = *(const f32x4*)(hp + 4), h10 = *(const f32x4*)(hp + 128), h11 = *(const f32x4*)(hp + 132);
                h00 += acc[ai][0][m][0] * rs * g0[0]; h01 += acc[ai][0][m][1] * rs * g1[0]; h10 += acc[ai][1][m][0] * rs * g0[1]; h11 += acc[ai][1][m][1] * rs * g1[1];
                *(f32x4*)hp = h00; *(f32x4*)(hp + 4) = h01; *(f32x4*)(hp + 128) = h10; *(f32x4*)(hp + 132) = h11;
                acc[ai][0][m][0] = h00; acc[ai][0][m][1] = h01; acc[ai][1][m][0] = h10; acc[ai][1][m][1] = h11;
                asm volatile("" : "+v"(acc[ai][0][m][0]), "+v"(acc[ai][0][m][1]), "+v"(acc[ai][1][m][0]), "+v"(acc[ai][1][m][1]));
                if (m & 1) asm volatile("" ::: "memory");
            }
        if (!gpre) return;
        e2.run(acc, u, wr, wc, fr, fq, lds, wid, lane);
#pragma unroll
        for (int bj = 0; bj < 2; ++bj) { g0[bj] = *(const f32x4*)(gpre + col0 + bj * 128); g1[bj] = *(const f32x4*)(gpre + col0 + bj * 128 + 4); }
#pragma unroll
        for (int ai = 0; ai < 2; ++ai)
#pragma unroll
            for (int m = 0; m < 4; ++m) {
                const int rl = ai * 128 + wr * 64 + m * 16 + fr; const float rs = S[rl];
                bf16* xp = XN + (size_t)(u.pm * 256 + rl) * D + col0;
                st_bf16x8(xp, acc[ai][0][m][0] * rs * g0[0], acc[ai][0][m][1] * rs * g1[0]);
                st_bf16x8(xp + 128, acc[ai][1][m][0] * rs * g0[1], acc[ai][1][m][1] * rs * g1[1]);
            }
    }
};

__device__ __forceinline__ int prow(int r, int j) {
    if (r < MR) { const int s = r & (SEQ - 1); return (s - j >= 0) ? r - j : MR + (NMETA + s - j); }
    const int t = r - MR; return (t - j >= 0) ? r - j : -1;
}
__device__ __forceinline__ void p2_prep(ArgsP a, int l, int gw, int ngw, int lane) {
    unsigned char* ws = a->ws;
    const bf16* Z = (const bf16*)(ws + WS_Z);
    for (int r = gw; r < MT; r += ngw) {
        const float* zf = (const float*)(ws + WS_ZF) + (size_t)r * ZFW;
        f32x4 vq = *(const f32x4*)(zf + ZF_CQ + 4 * lane);
        f32x2 vk = *(const f32x2*)(zf + ZF_CKV + 2 * lane);
        const float vi = zf[ZF_IK + lane];
        const float vw = zf[ZF_IW + (lane & 7)];
        const f32x4 gq = *(const f32x4*)(a->in[I_GDQ] + l * 256 + 4 * lane);
        const f32x2 gk = *(const f32x2*)(a->in[I_GDKV] + l * 128 + 2 * lane);
        const float lg = a->in[I_LNG][l * 64 + lane], lb = a->in[I_LNB][l * 64 + lane];
        float s1 = (vq.x * vq.x + vq.y * vq.y) + (vq.z * vq.z + vq.w * vq.w), s2 = vk.x * vk.x + vk.y * vk.y, s3 = vi;
#pragma unroll
        for (int o = 1; o < 64; o <<= 1) { s1 += __shfl_xor(s1, o); s2 += __shfl_xor(s2, o); s3 += __shfl_xor(s3, o); }
        const float d = vi - s3 * (1.f / 64.f);
        const float var = wave_sum(d * d) * (1.f / 64.f);
        const float r1 = rsqrtf(s1 * (1.f / 256.f) + EPS), r2 = rsqrtf(s2 * (1.f / 128.f) + EPS);
        vq = vq * r1 * gq;
        { u32x2 w; w.x = pk2(vq.x, vq.y); w.y = pk2(vq.z, vq.w); *(u32x2*)((bf16*)(ws + WS_CQN) + (size_t)r * 256 + 4 * lane) = w; }
        *(unsigned*)((bf16*)(ws + WS_KV) + (size_t)r * 128 + 2 * lane) = pk2(vk.x * r2 * gk.x, vk.y * r2 * gk.y);
        ((bf16*)(ws + WS_KI))[(size_t)r * 64 + lane] = (bf16)f2bf(d * rsqrtf(var + EPS) * lg + lb);
        if (lane < 8) ((float*)(ws + WS_WI))[(size_t)r * 8 + lane] = vw * 0.35355339059327373f;
    }
}
__device__ __forceinline__ void p2_chunks(ArgsP a, LAS unsigned char* lds, int l, int gw, int ngw, int wave, int lane) {
    unsigned char* ws = a->ws;
    const bf16* Z = (const bf16*)(ws + WS_Z);
    float* DDp = (float*)(ws + WS_DD);
    LAS float* stg = (LAS float*)(lds + wave * 5120);
    for (int it = gw; it < 257 * 8; it += ngw) {
        const int cid = it >> 3, mx = (it >> 2) & 1, h = it & 3;
        const int nrows = cid == 256 ? NMETA : 64, rbase = cid == 256 ? MR : cid * 64;
        const int k0 = 2 * lane;
        const float* ZFr = (const float*)(ws + WS_ZF);
        const int rl = rbase + (lane < nrows ? lane : 0);
        if (!mx) {
            { const float* zf = ZFr + (size_t)rl * ZFW + ZF_A;
              const f32x4 a0 = *(const f32x4*)zf, a1 = *(const f32x4*)(zf + 4), a2 = *(const f32x4*)(zf + 8), a3 = *(const f32x4*)(zf + 12);
              *(LAS f32x4*)(stg + lane * 16) = a0; *(LAS f32x4*)(stg + lane * 16 + 4) = a1; *(LAS f32x4*)(stg + lane * 16 + 8) = a2; *(LAS f32x4*)(stg + lane * 16 + 12) = a3; }
            float w0[16], w1[16];
#pragma unroll
            for (int j = 0; j < 16; ++j) { const f32x2 w = *(const f32x2*)(a->in[I_WA2] + (size_t)(l * 16 + j) * 512 + h * 128 + k0); w0[j] = w.x; w1[j] = w.y; }
            const f32x2 bb = *(const f32x2*)(a->in[I_BA] + l * 512 + h * 128 + k0);
            bf16* QG = (bf16*)(ws + WS_G);
            float G0 = 0.f, G1 = 0.f;
            unsigned pq[16], pk[16];
#define P2G_LOAD(t0) do { _Pragma("unroll") for (int i = 0; i < 16; ++i) { const int r_ = rbase + (t0) + i; \
                pq[i] = *(const unsigned*)(Z + (size_t)r_ * ZB + ZC_GQ + h * 128 + k0); pk[i] = *(const unsigned*)(Z + (size_t)r_ * ZB + ZC_GK + h * 128 + k0); } } while (0)
            P2G_LOAD(0);
            LDS_WAIT();
            for (int t0 = 0; t0 < nrows; t0 += 16) {
                unsigned cqw[16], ckw[16];
#pragma unroll
                for (int i = 0; i < 16; ++i) { cqw[i] = pq[i]; ckw[i] = pk[i]; }
                if (t0 + 16 < nrows) P2G_LOAD(t0 + 16);
#pragma unroll
                for (int i = 0; i < 16; ++i) {
                    const int r = rbase + t0 + i;
                    const LAS float* ar = stg + (t0 + i) * 16;
                    const f32x4 a0 = *(const LAS f32x4*)ar, a1 = *(const LAS f32x4*)(ar + 4), a2 = *(const LAS f32x4*)(ar + 8), a3 = *(const LAS f32x4*)(ar + 12);
                    const float av[16] = {a0.x, a0.y, a0.z, a0.w, a1.x, a1.y, a1.z, a1.w, a2.x, a2.y, a2.z, a2.w, a3.x, a3.y, a3.z, a3.w};
                    float s0 = bb.x, s1 = bb.y;
#pragma unroll
                    for (int j = 0; j < 16; ++j) { s0 += av[j] * w0[j]; s1 += av[j] * w1[j]; }
                    G0 += logsigmoid_f(s0) * 0.0625f; G1 += logsigmoid_f(s1) * 0.0625f;
                    const float e0 = __expf(G0), e1 = __expf(G1), i0 = __builtin_amdgcn_rcpf(e0), i1 = __builtin_amdgcn_rcpf(e1);
                    *(unsigned*)(QG + (size_t)r * 1024 + h * 128 + k0) = pk2(bflo(cqw[i]) * e0, bfhi(cqw[i]) * e1);
                    *(unsigned*)(QG + (size_t)r * 1024 + 512 + h * 128 + k0) = pk2(bflo(ckw[i]) * i0, bfhi(ckw[i]) * i1);
                }
            }
#undef P2G_LOAD
            *(f32x2*)(DDp + ((size_t)cid * 4 + h) * 128 + k0) = (f32x2){__expf(G0), __expf(G1)};
            LDS_WAIT();
        } else {
            { const float* zf = ZFr + (size_t)rl * ZFW; stg[lane * 2] = zf[ZF_MI + h]; stg[lane * 2 + 1] = zf[ZF_MF + h]; }
            float cq[4][2], ck[4][2];
#pragma unroll
            for (int tap = 0; tap < 4; ++tap) { const f32x2 wq = *(const f32x2*)(a->in[I_CONV] + (size_t)(l * 4 + tap) * 1024 + h * 128 + k0), wk = *(const f32x2*)(a->in[I_CONV] + (size_t)(l * 4 + tap) * 1024 + 512 + h * 128 + k0);
                cq[tap][0] = wq.x; cq[tap][1] = wq.y; ck[tap][0] = wk.x; ck[tap][1] = wk.y; }
            const float fb = a->in[I_FB][l * 4 + h];
            bf16* QM = (bf16*)(ws + WS_QKC);
            float xq[3][2], xk[3][2];
#pragma unroll
            for (int j = 0; j < 3; ++j) {
                const int rp = prow(rbase, j + 1);
                const int rpc = rp >= 0 ? rp : rbase; const float m = rp >= 0 ? 1.f : 0.f;
                const unsigned qw = *(const unsigned*)(Z + (size_t)rpc * ZB + ZC_MQ + h * 128 + k0), kw = *(const unsigned*)(Z + (size_t)rpc * ZB + ZC_MK + h * 128 + k0);
                xq[j][0] = bflo(qw) * m; xq[j][1] = bfhi(qw) * m; xk[j][0] = bflo(kw) * m; xk[j][1] = bfhi(kw) * m;
            }
            float bsum = 0.f;
            unsigned pq[16], pk[16];
#define P2M_LOAD(t0) do { _Pragma("unroll") for (int i = 0; i < 16; ++i) { const int r_ = rbase + (t0) + i; \
                pq[i] = *(const unsigned*)(Z + (size_t)r_ * ZB + ZC_MQ + h * 128 + k0); pk[i] = *(const unsigned*)(Z + (size_t)r_ * ZB + ZC_MK + h * 128 + k0); } } while (0)
            P2M_LOAD(0);
            LDS_WAIT();
            for (int t0 = 0; t0 < nrows; t0 += 16) {
                unsigned cqw[16], ckw[16];
#pragma unroll
                for (int i = 0; i < 16; ++i) { cqw[i] = pq[i]; ckw[i] = pk[i]; }
                if (t0 + 16 < nrows) P2M_LOAD(t0 + 16);
#pragma unroll
                for (int i = 0; i < 16; ++i) {
                    const int r = rbase + t0 + i;
                    const f32x2 gt = *(const LAS f32x2*)(stg + (t0 + i) * 2);
                    const float li = gt.x, lf = logsigmoid_f(gt.y + fb);
                    bsum += lf;
                    const float q0 = bflo(cqw[i]), q1 = bfhi(cqw[i]), kk0 = bflo(ckw[i]), kk1 = bfhi(ckw[i]);
                    const float yq0 = cq[3][0] * q0 + cq[2][0] * xq[0][0] + cq[1][0] * xq[1][0] + cq[0][0] * xq[2][0];
                    const float yq1 = cq[3][1] * q1 + cq[2][1] * xq[0][1] + cq[1][1] * xq[1][1] + cq[0][1] * xq[2][1];
                    const float yk0 = ck[3][0] * kk0 + ck[2][0] * xk[0][0] + ck[1][0] * xk[1][0] + ck[0][0] * xk[2][0];
                    const float yk1 = ck[3][1] * kk1 + ck[2][1] * xk[0][1] + ck[1][1] * xk[1][1] + ck[0][1] * xk[2][1];
                    xq[2][0] = xq[1][0]; xq[2][1] = xq[1][1]; xq[1][0] = xq[0][0]; xq[1][1] = xq[0][1]; xq[0][0] = q0; xq[0][1] = q1;
                    xk[2][0] = xk[1][0]; xk[2][1] = xk[1][1]; xk[1][0] = xk[0][0]; xk[1][1] = xk[0][1]; xk[0][0] = kk0; xk[0][1] = kk1;
                    const float eq = __expf(bsum) * 0.08838834764831845f, ek = __expf(li - bsum);
                    *(unsigned*)(QM + (size_t)r * 1024 + h * 128 + k0) = pk2(silu_f(yq0) * eq, silu_f(yq1) * eq);
                    *(unsigned*)(QM + (size_t)r * 1024 + 512 + h * 128 + k0) = pk2(silu_f(yk0) * ek, silu_f(yk1) * ek);
                }
            }
#undef P2M_LOAD
            const float dd = __expf(bsum);
            *(f32x2*)(DDp + ((size_t)(257 + cid) * 4 + h) * 128 + k0) = (f32x2){dd, dd};
            LDS_WAIT();
        }
    }
}

constexpr int SC_QS = 272, SC_VS = 144;
constexpr int SC_QT = 0, SC_KT = 2 * 17408, SC_VT = 4 * 17408, SC_AT = SC_VT + 2 * 9216, SC_SB = SC_AT + 9216, SC_DD = SC_SB + 2 * 18432, SC_NB = SC_DD + 1024, SC_END = SC_NB + 512;
static_assert(SC_END <= RING_BYTES, "scan LDS");
__device__ __forceinline__ bf16x8 tr8(LAS unsigned char* base, int stride, int row0, int col0, int lane) {
    const int fq = lane >> 4, q4 = (lane & 15) >> 2, p4 = lane & 3;
    LAS unsigned char* p = base + (row0 + 8 * fq + q4) * stride + (col0 + 4 * p4) * 2;
    const s16x4 lo = __builtin_amdgcn_ds_read_tr16_b64_v4i16((LAS s16x4*)p);
    const s16x4 hi = __builtin_amdgcn_ds_read_tr16_b64_v4i16((LAS s16x4*)(p + 4 * stride));
    return __builtin_shufflevector(lo, hi, 0, 1, 2, 3, 4, 5, 6, 7);
}
template <bool ML>
__device__ __forceinline__ void scan_unit(ArgsP a, LAS unsigned char* lds, int b, int h, int vs, int tid_in) {
    int tid = tid_in; asm volatile("" : "+v"(tid));
    unsigned char* ws = a->ws;
    const bf16* Z = (const bf16*)(ws + WS_Z);
    const bf16* QK = (const bf16*)(ws + (ML ? WS_QKC : WS_G));
    const float* DDp = (const float*)(ws + WS_DD) + (ML ? (size_t)257 * 512 : 0);
    bf16* O = (bf16*)(ws + (ML ? WS_OM : WS_OG));
    const int lane = tid & 63, wave = __builtin_amdgcn_readfirstlane(tid >> 6), fr = lane & 15, fq = lane >> 4;
    const int vt = wave & 3, hh = wave >> 2;
    for (int i = tid; i < (2 * 18432 + 1024 + 512) / 4; i += 512) ((LAS unsigned*)(lds + SC_SB))[i] = 0u;
    f32x4 S[4], nacc[4];
#pragma unroll
    for (int i = 0; i < 4; ++i) { S[i] = (f32x4){0.f, 0.f, 0.f, 0.f}; nacc[i] = (f32x4){0.f, 0.f, 0.f, 0.f}; }
    const bf16x8 ones = {(short)0x3F80, (short)0x3F80, (short)0x3F80, (short)0x3F80, (short)0x3F80, (short)0x3F80, (short)0x3F80, (short)0x3F80};
    u32x4 gq[2], gk[2], gv; float gd = 0.f;
    const int vcol = (ML ? ZC_MV : ZC_GV) + h * 256 + vs * 64;
    const bf16* zpage = (const bf16*)(ws + WS_CTL + 512 * 1024);
#define SCAN_LOAD(c) do { const int c_ = (c); \
        _Pragma("unroll") for (int e = 0; e < 2; ++e) { const int pid = tid + 512 * e, t = pid >> 4, ch = pid & 15; \
            const bool ok = c_ > 0 || t >= 48; const int row = c_ == 0 ? MR + t - 48 : b * SEQ + (c_ - 1) * 64 + t; \
            const bf16* qp_ = ok ? QK + (size_t)row * 1024 + h * 128 + ch * 8 : zpage; \
            gq[e] = *(const u32x4*)qp_; gk[e] = *(const u32x4*)(qp_ + 512); } \
        { const int t = tid >> 3, ch = tid & 7; const bool ok = c_ > 0 || t >= 48; const int row = c_ == 0 ? MR + t - 48 : b * SEQ + (c_ - 1) * 64 + t; \
          gv = *(const u32x4*)(ok ? Z + (size_t)row * ZB + vcol + ch * 8 : zpage); } \
        { const int cid = c_ == 0 ? 256 : b * 32 + (c_ - 1); gd = DDp[((size_t)cid * 4 + h) * 128 + (tid & 127)]; } } while (0)
#define SCAN_STORE(buf) do { const int bo_ = (buf); \
        _Pragma("unroll") for (int e = 0; e < 2; ++e) { const int pid = tid + 512 * e, t = pid >> 4, ch = pid & 15; \
            *(LAS u32x4*)(lds + SC_QT + bo_ * 17408 + t * SC_QS + ch * 16) = gq[e]; *(LAS u32x4*)(lds + SC_KT + bo_ * 17408 + t * SC_QS + ch * 16) = gk[e]; } \
        { const int t = tid >> 3, ch = tid & 7; *(LAS u32x4*)(lds + SC_VT + bo_ * 9216 + t * SC_VS + ch * 16) = gv; } \
        if (tid < 128) ((LAS float*)(lds + SC_DD))[bo_ * 128 + tid] = gd; } while (0)
    SCAN_LOAD(0);
    __syncthreads();
    SCAN_STORE(0);
    __syncthreads();
    for (int c = 0; c < 33; ++c) {
        const int buf = c & 1;
        LAS unsigned char* QT = lds + SC_QT + buf * 17408; LAS unsigned char* KT = lds + SC_KT + buf * 17408; LAS unsigned char* VT = lds + SC_VT + buf * 9216;
        LAS unsigned char* AT = lds + SC_AT; LAS unsigned char* SB = lds + SC_SB + buf * 18432; LAS unsigned char* SBn = lds + SC_SB + (buf ^ 1) * 18432;
        const LAS float* ddL = (const LAS float*)(lds + SC_DD) + buf * 128;
        if (c + 1 < 33) SCAN_LOAD(c + 1);
        {
            const int ti = wave >> 1;
#pragma unroll
            for (int sj = 0; sj < 2; ++sj) {
                const int si = 2 * (wave & 1) + sj;
                f32x4 acc = {0.f, 0.f, 0.f, 0.f};
                bf16x8 qa[4], kb[4];
#pragma unroll
                for (int ks = 0; ks < 4; ++ks) { qa[ks] = *(const LAS bf16x8*)(QT + (16 * ti + fr) * SC_QS + (32 * ks + 8 * fq) * 2); kb[ks] = *(const LAS bf16x8*)(KT + (16 * si + fr) * SC_QS + (32 * ks + 8 * fq) * 2); }
                asm volatile("" ::: "memory");
#pragma unroll
                for (int ks = 0; ks < 4; ++ks) acc = __builtin_amdgcn_mfma_f32_16x16x32_bf16(qa[ks], kb[ks], acc, 0, 0, 0);
                const int sg = 16 * si + fr, tg = 16 * ti + 4 * fq;
                LAS bf16* ap = (LAS bf16*)(AT + tg * SC_VS) + sg;
                ap[0 * (SC_VS / 2)] = (bf16)(sg <= tg + 0 ? f2bf(acc.x) : 0u);
                ap[1 * (SC_VS / 2)] = (bf16)(sg <= tg + 1 ? f2bf(acc.y) : 0u);
                ap[2 * (SC_VS / 2)] = (bf16)(sg <= tg + 2 ? f2bf(acc.z) : 0u);
                ap[3 * (SC_VS / 2)] = (bf16)(sg <= tg + 3 ? f2bf(acc.w) : 0u);
            }
        }
        {
            const bf16x8 vb0 = tr8(VT, SC_VS, 0, 16 * vt, lane), vb1 = tr8(VT, SC_VS, 32, 16 * vt, lane);
#pragma unroll
            for (int i = 0; i < 4; ++i) {
                const int kt = 4 * hh + i;
                const bf16x8 ka0 = tr8(KT, SC_QS, 0, 16 * kt, lane), ka1 = tr8(KT, SC_QS, 32, 16 * kt, lane);
                f32x4 acc = S[i];
                acc = __builtin_amdgcn_mfma_f32_16x16x32_bf16(ka0, vb0, acc, 0, 0, 0);
                acc = __builtin_amdgcn_mfma_f32_16x16x32_bf16(ka1, vb1, acc, 0, 0, 0);
                const f32x4 dv = *(const LAS f32x4*)(ddL + 16 * kt + 4 * fq);
                S[i] = acc * dv;
                if (ML) {
                    f32x4 na = nacc[i];
                    na = __builtin_amdgcn_mfma_f32_16x16x32_bf16(ka0, ones, na, 0, 0, 0);
                    na = __builtin_amdgcn_mfma_f32_16x16x32_bf16(ka1, ones, na, 0, 0, 0);
                    nacc[i] = na * dv;
                }
            }
        }
        {
#pragma unroll
            for (int i = 0; i < 4; ++i) {
                const int k0 = 16 * (4 * hh + i) + 4 * fq;
                LAS bf16* sp = (LAS bf16*)(SBn + k0 * SC_VS) + 16 * vt + fr;
                sp[0 * (SC_VS / 2)] = (bf16)f2bf(S[i].x); sp[1 * (SC_VS / 2)] = (bf16)f2bf(S[i].y); sp[2 * (SC_VS / 2)] = (bf16)f2bf(S[i].z); sp[3 * (SC_VS / 2)] = (bf16)f2bf(S[i].w);
                if (ML && vt == 0 && fr == 0) { LAS bf16* np = (LAS bf16*)(lds + SC_NB + (buf ^ 1) * 256) + k0; np[0] = (bf16)f2bf(nacc[i].x); np[1] = (bf16)f2bf(nacc[i].y); np[2] = (bf16)f2bf(nacc[i].z); np[3] = (bf16)f2bf(nacc[i].w); }
            }
        }
        LDS_BARRIER();
#if defined(DIAG_SEL)
        if (blockIdx.x == 0 && tid == 0) { volatile LAS unsigned* M_ = (volatile LAS unsigned*)(lds + MISC_OFF); const unsigned now_ = (unsigned)__builtin_amdgcn_s_memrealtime(); M_[16 + 12] += now_ - M_[15]; M_[15] = now_; }
#endif
        {
            const bf16x8 vb0 = tr8(VT, SC_VS, 0, 16 * vt, lane), vb1 = tr8(VT, SC_VS, 32, 16 * vt, lane);
            bf16x8 sb[4];
#pragma unroll
            for (int ks = 0; ks < 4; ++ks) sb[ks] = tr8(SB, SC_VS, 32 * ks, 16 * vt, lane);
            bf16x8 nb[4];
            if (ML) {
#pragma unroll
                for (int ks = 0; ks < 4; ++ks) nb[ks] = *(const LAS bf16x8*)(lds + SC_NB + buf * 256 + (32 * ks + 8 * fq) * 2);
            }
            u32x2 ow[2];
#pragma unroll
            for (int tj = 0; tj < 2; ++tj) {
                const int ti = 2 * hh + tj;
                f32x4 acc = {0.f, 0.f, 0.f, 0.f}, den = {0.f, 0.f, 0.f, 0.f};
                bf16x8 qa[4];
#pragma unroll
                for (int ks = 0; ks < 4; ++ks) qa[ks] = *(const LAS bf16x8*)(QT + (16 * ti + fr) * SC_QS + (32 * ks + 8 * fq) * 2);
                const bf16x8 aa0 = *(const LAS bf16x8*)(AT + (16 * ti + fr) * SC_VS + (8 * fq) * 2), aa1 = *(const LAS bf16x8*)(AT + (16 * ti + fr) * SC_VS + (32 + 8 * fq) * 2);
                asm volatile("" ::: "memory");
#pragma unroll
                for (int ks = 0; ks < 4; ++ks) {
                    acc = __builtin_amdgcn_mfma_f32_16x16x32_bf16(sb[ks], qa[ks], acc, 0, 0, 0);
                    if (ML) den = __builtin_amdgcn_mfma_f32_16x16x32_bf16(nb[ks], qa[ks], den, 0, 0, 0);
                }
                acc = __builtin_amdgcn_mfma_f32_16x16x32_bf16(vb0, aa0, acc, 0, 0, 0);
                acc = __builtin_amdgcn_mfma_f32_16x16x32_bf16(vb1, aa1, acc, 0, 0, 0);
                if (ML) {
                    den = __builtin_amdgcn_mfma_f32_16x16x32_bf16(ones, aa0, den, 0, 0, 0);
                    den = __builtin_amdgcn_mfma_f32_16x16x32_bf16(ones, aa1, den, 0, 0, 0);
                    const float rd = __builtin_amdgcn_rcpf(fmaxf(fabsf(den.x), 1.f));
                    acc *= rd;
                }
                ow[tj].x = pk2(acc.x, acc.y); ow[tj].y = pk2(acc.z, acc.w);
            }
            if (c + 1 < 33) SCAN_STORE(buf ^ 1);
#pragma unroll
            for (int tj = 0; tj < 2; ++tj) {
                const int t = 16 * (2 * hh + tj) + fr;
                const bool okr = c > 0 || t >= 48;
                const int rowb = c == 0 ? MR + t - 48 : b * SEQ + (c - 1) * 64 + t;
                bf16* op = okr ? O + (size_t)rowb * 1024 + h * 256 + vs * 64 + 16 * vt + 4 * fq : (bf16*)(ws + WS_BIN + 512 * 1024) + (size_t)tid * 4;
                *(u32x2*)op = ow[tj];
            }
        }
        LDS_BARRIER();
#if defined(DIAG_SEL)
        if (blockIdx.x == 0 && tid == 0) { volatile LAS unsigned* M_ = (volatile LAS unsigned*)(lds + MISC_OFF); const unsigned now_ = (unsigned)__builtin_amdgcn_s_memrealtime(); M_[16 + 13] += now_ - M_[15]; M_[15] = now_; }
#endif
    }
#undef SCAN_LOAD
#undef SCAN_STORE
}

template <bool DRY = false>
__device__ __forceinline__ void p6_headnorm(ArgsP a, int l, int gw, int ngw, int lane) {
    unsigned char* ws = a->ws; const bf16* Z = (const bf16*)(ws + WS_Z);
    const f32x4 gg0 = *(const f32x4*)(a->in[I_GGLA] + l * 256 + 4 * lane), gg1 = *(const f32x4*)(a->in[I_GML] + l * 256 + 4 * lane);
    for (int it0 = gw * 4; it0 < MT * 8; it0 += ngw * 4) {
        u32x2 w[4], gw2[4]; bf16* op[4];
#pragma unroll
        for (int i = 0; i < 4; ++i) { const int it = it0 + i, r = it >> 3, mx = (it >> 2) & 1, h = it & 3;
            op[i] = (bf16*)(ws + (mx ? WS_OM : WS_OG)) + (size_t)r * 1024 + h * 256 + 4 * lane;
            w[i] = *(const u32x2*)op[i];
            gw2[i] = *(const u32x2*)(Z + (size_t)r * ZB + (mx ? ZC_MO : ZC_GR) + h * 256 + 4 * lane); }
        f32x4 v[4]; float ss[4];
#pragma unroll
        for (int i = 0; i < 4; ++i) { v[i] = (f32x4){bflo(w[i].x), bfhi(w[i].x), bflo(w[i].y), bfhi(w[i].y)}; ss[i] = (v[i].x * v[i].x + v[i].y * v[i].y) + (v[i].z * v[i].z + v[i].w * v[i].w); }
#pragma unroll
        for (int o = 1; o < 64; o <<= 1) {
#pragma unroll
            for (int i = 0; i < 4; ++i) ss[i] += __shfl_xor(ss[i], o);
        }
#pragma unroll
        for (int i = 0; i < 4; ++i) {
            const int mx = ((it0 + i) >> 2) & 1;
            const float rr = rsqrtf(ss[i] * (1.f / 256.f) + EPS);
            const f32x4 gt = {bflo(gw2[i].x), bfhi(gw2[i].x), bflo(gw2[i].y), bfhi(gw2[i].y)};
            const f32x4 o4 = v[i] * rr * (mx ? gg1 : gg0) * gt;
            u32x2 o; o.x = pk2(o4.x, o4.y); o.y = pk2(o4.z, o4.w);
            *(u32x2*)(DRY ? (bf16*)(ws + WS_XN) + ((size_t)((it0 + i) >> 3) * 1024 + ((it0 + i) & 3) * 256 + 4 * lane) : op[i]) = o;
        }
    }
}

__device__ __forceinline__ int krow(int b, int s) { return s < NMETA ? MR + s : b * SEQ + (s - NMETA); }
__device__ __forceinline__ int t5_bucket(int n) {
    if (n < 16) return n < 0 ? 0 : n;
    const int lg = 16 + (int)(__logf((float)n * (1.f / 16.f)) / 2.0794415416798357f * 16.f);
    return lg < 31 ? lg : 31;
}
__device__ __forceinline__ unsigned off_b(unsigned row, unsigned ch) { return 256u * row + 16u * (ch ^ (((row & 3) << 2) | ((row >> 2) & 3))); }
__device__ __forceinline__ s16x4 tr_rd(LAS unsigned char* p) { return __builtin_amdgcn_ds_read_tr16_b64_v4i16((LAS s16x4*)p); }

constexpr int DW2_STRIDE = 9472, DW2_TILE = 0, DW2_SEL = 8192, DW2_BK = 8832, DSA2_T5 = 8 * DW2_STRIDE, DSA2_BT = DSA2_T5 + 2048 + 64;

__device__ __forceinline__ int wave_sum_dpp(int x) {
    x += __builtin_amdgcn_update_dpp(0, x, 0xB1, 0xf, 0xf, false);
    x += __builtin_amdgcn_update_dpp(0, x, 0x4E, 0xf, 0xf, false);
    x += __builtin_amdgcn_update_dpp(0, x, 0x141, 0xf, 0xf, false);
    x += __builtin_amdgcn_update_dpp(0, x, 0x140, 0xf, 0xf, false);
    return __builtin_amdgcn_readlane(x, 0) + __builtin_amdgcn_readlane(x, 16) + __builtin_amdgcn_readlane(x, 32) + __builtin_amdgcn_readlane(x, 48);
}
__device__ __forceinline__ int wave_scan_dpp(int x) {
    x += __builtin_amdgcn_update_dpp(0, x, 0x111, 0xf, 0xf, false);
    x += __builtin_amdgcn_update_dpp(0, x, 0x112, 0xf, 0xf, false);
    x += __builtin_amdgcn_update_dpp(0, x, 0x114, 0xf, 0xf, false);
    x += __builtin_amdgcn_update_dpp(0, x, 0x118, 0xf, 0xf, false);
    x += __builtin_amdgcn_update_dpp(0, x, 0x142, 0xa, 0xf, false);
    x += __builtin_amdgcn_update_dpp(0, x, 0x143, 0xc, 0xf, false);
    return x;
}
#if defined(DIAG_SEL)
#ifndef DIAG_BLK
#define DIAG_BLK 31
#endif
#define DSTAMP(slot) do { if (blockIdx.x == DIAG_BLK && threadIdx.x == 0) { volatile LAS unsigned* M_ = (volatile LAS unsigned*)(lds + MISC_OFF); const unsigned now_ = (unsigned)__builtin_amdgcn_s_memrealtime(); M_[slot] += now_ - M_[14]; M_[14] = now_; } } while (0)
#else
#define DSTAMP(slot) do {} while (0)
#endif
template <int NR>
__device__ __forceinline__ void dsa_select(const unsigned* scr, int nk, int p, int lane, LAS unsigned char* lds, LAS unsigned char* tile, LAS unsigned short* selL, LAS unsigned short* bkL, const LAS unsigned short* bkT) {
    unsigned u[NR];
#pragma unroll
    for (int i = 0; i < NR; ++i) { const int s = lane + 64 * i; u[i] = s < nk ? __hip_atomic_load(scr + s, __ATOMIC_RELAXED, __HIP_MEMORY_SCOPE_AGENT) : 0u; }
    {

            unsigned tau = 0u;
            for (int bit = 31; bit >= 16; --bit) {
                const unsigned cand = tau | (1u << bit);
                int cnt = 0;
#pragma unroll
                for (int i = 0; i < NR; ++i) cnt += (u[i] >= cand) ? 1 : 0;
                if (wave_sum_dpp(cnt) >= 256) tau = cand;
            }
            DSTAMP(16);
            {
                const unsigned hi = tau >> 16;
                int cab = 0, cc = 0;
#pragma unroll
                for (int i = 0; i < NR; ++i) { const unsigned uh = u[i] >> 16; cab += (uh > hi) ? 1 : 0; cc += (uh == hi) ? 1 : 0; }
                cab = wave_sum_dpp(cab);
                const int cin = wave_scan_dpp(cc);
                const int ncand = __builtin_amdgcn_readlane(cin, 63);
                LAS unsigned short* candL = (LAS unsigned short*)tile;
                int off = cin - cc;
#pragma unroll
                for (int i = 0; i < NR; ++i) { const bool is = (u[i] >> 16) == hi; candL[is ? off : 3072 + lane] = (unsigned short)(u[i] & 0xffffu); off += is ? 1 : 0; }
                LDS_WAIT();
                const int need = 256 - cab;
                unsigned lo = 0u;
                if (ncand <= 64) {
                    const unsigned v = lane < ncand ? (unsigned)candL[lane] + 1u : 0u;
                    for (int bit = 15; bit >= 0; --bit) { const unsigned cand = lo | (1u << bit); if (__popcll(__ballot(v >= cand + 1u)) >= need) lo = cand; }
                } else {
                    for (int bit = 15; bit >= 0; --bit) {
                        const unsigned cand = lo | (1u << bit); int cnt = 0;
                        for (int j = lane; j < ((ncand + 63) & ~63); j += 64) { const unsigned v = j < ncand ? (unsigned)candL[j] + 1u : 0u; cnt += __popcll(__ballot(v >= cand + 1u)); }
                        if (cnt >= need) lo = cand;
                    }
                }
                tau |= lo;
                LDS_WAIT();
            }
            DSTAMP(17);
            unsigned short bkv[NR];
#pragma unroll
            for (int i = 0; i < NR; ++i) { const int d = p - (lane + 64 * i); bkv[i] = bkT[d > 0 ? d : 0]; }
            int cge = 0, ceq = 0;
#pragma unroll
            for (int i = 0; i < NR; ++i) { cge += (u[i] >= tau) ? 1 : 0; ceq += (u[i] == tau) ? 1 : 0; }
            const int tge = wave_sum_dpp(cge);
            if (tge == 256) {
                const int cin = wave_scan_dpp(cge);
                int off = cin - cge;
#pragma unroll
                for (int i = 0; i < NR; ++i) { const bool take = u[i] >= tau; const int pos = take ? off : 256 + lane;
                    selL[pos] = (unsigned short)(lane + 64 * i); bkL[pos] = bkv[i]; off += take ? 1 : 0; }
            } else {
                const int rem = 256 - (tge - wave_sum_dpp(ceq));
                const unsigned long long lt = (1ull << lane) - 1ull;
                int base = 0, eqseen = 0;
#pragma unroll
                for (int i = 0; i < NR; ++i) {
                    const bool gt = u[i] > tau, eq = u[i] == tau;
                    const unsigned long long meq = __ballot(eq);
                    const bool take = gt || (eq && (eqseen + __popcll(meq & lt)) < rem);
                    const unsigned long long mt = __ballot(take);
                    const int pos = take ? base + __popcll(mt & lt) : 256 + lane;
                    selL[pos] = (unsigned short)(lane + 64 * i); bkL[pos] = bkv[i];
                    base += __popcll(mt); eqseen += __popcll(meq);
                }
            }
    }
}
struct DsaGeom {
    int b, cA, hf;
    __device__ __forceinline__ int chunk(int qt) const { return qt < 2 ? cA : 31 - cA; }
    __device__ __forceinline__ int pos0(int qt) const { return NMETA + 64 * chunk(qt) + 32 * hf + 16 * (qt & 1); }
    __device__ __forceinline__ int row0(int qt) const { return b * SEQ + 64 * chunk(qt) + 32 * hf + 16 * (qt & 1); }
};
template <bool DENSE_ONLY>
__device__ __forceinline__ void dsa_unit(ArgsP a, LAS unsigned char* lds, int u_, int nq, int wave, int lane_in) {
    int lane = lane_in; asm volatile("" : "+v"(lane));
    unsigned char* ws = a->ws;
    const bf16* QQ = (const bf16*)(ws + WS_QQ); const bf16* KI = (const bf16*)(ws + WS_KI); const bf16* KV = (const bf16*)(ws + WS_KV);
    unsigned* SC = (unsigned*)(ws + WS_SC) + (size_t)blockIdx.x * 64 * SC_PITCH;
    const DsaGeom G{u_ >> 5, (u_ & 31) >> 1, u_ & 1};
    const int b = DENSE_ONLY ? 0 : G.b;
    const int fr = lane & 15, fq = lane >> 4;
    if (!DENSE_ONLY) {
        int nt[4], T = 0;
#pragma unroll
        for (int qt = 0; qt < 4; ++qt) { nt[qt] = G.pos0(qt) + 15 >= 256 ? G.pos0(qt) / 16 + 1 : 0; T += nt[qt]; }
        const int lo = wave * T / 8, hi = (wave + 1) * T / 8;
        int base = 0;
        for (int qt = 0; qt < 4; ++qt) {
            const int ntq = qt == 0 ? nt[0] : qt == 1 ? nt[1] : qt == 2 ? nt[2] : nt[3];
            const int k0 = lo > base ? lo - base : 0, k1 = hi - base < ntq ? hi - base : ntq;
            base += ntq;
            if (k0 >= k1) continue;
            const int qrow = G.row0(qt) + fr, pq = G.pos0(qt) + fr;
            bf16x8 qf[8][2];
#pragma unroll
            for (int h = 0; h < 8; ++h)
#pragma unroll
                for (int ks = 0; ks < 2; ++ks) qf[h][ks] = *(const bf16x8*)(QQ + (size_t)qrow * NQQ + 2048 + h * 64 + ks * 32 + 8 * fq);
            float wi[8];
            { const f32x4 w0 = *(const f32x4*)((const float*)(ws + WS_WI) + (size_t)qrow * 8), w1 = *(const f32x4*)((const float*)(ws + WS_WI) + (size_t)qrow * 8 + 4);
              wi[0] = w0.x; wi[1] = w0.y; wi[2] = w0.z; wi[3] = w0.w; wi[4] = w1.x; wi[5] = w1.y; wi[6] = w1.z; wi[7] = w1.w; }
            unsigned* scq = SC + (size_t)(16 * qt + fr) * SC_PITCH + 4 * fq;
            bf16x8 pa0[4], pa1[4];
#define DSA_KLOAD(kt0_) do { _Pragma("unroll") for (int j = 0; j < 4; ++j) { const int kt_ = (kt0_) + j < k1 ? (kt0_) + j : k1 - 1; \
                const bf16* kp_ = KI + (size_t)krow(b, 16 * kt_ + fr) * 64 + 8 * fq; pa0[j] = *(const bf16x8*)kp_; pa1[j] = *(const bf16x8*)(kp_ + 32); } } while (0)
            DSA_KLOAD(k0);
            for (int kt0 = k0; kt0 < k1; kt0 += 4) {
                bf16x8 a0[4], a1[4];
#pragma unroll
                for (int j = 0; j < 4; ++j) { a0[j] = pa0[j]; a1[j] = pa1[j]; }
                if (kt0 + 4 < k1) DSA_KLOAD(kt0 + 4);
#pragma unroll
                for (int j = 0; j < 4; ++j) {
                    const int kt = kt0 + j;
                    float s0 = 0.f, s1 = 0.f, s2 = 0.f, s3 = 0.f;
#pragma unroll
                    for (int h = 0; h < 8; ++h) {
                        f32x4 acc = {0.f, 0.f, 0.f, 0.f};
                        acc = __builtin_amdgcn_mfma_f32_16x16x32_bf16(a0[j], qf[h][0], acc, 0, 0, 0);
                        acc = __builtin_amdgcn_mfma_f32_16x16x32_bf16(a1[j], qf[h][1], acc, 0, 0, 0);
                        s0 += wi[h] * fmaxf(acc.x, 0.f); s1 += wi[h] * fmaxf(acc.y, 0.f); s2 += wi[h] * fmaxf(acc.z, 0.f); s3 += wi[h] * fmaxf(acc.w, 0.f);
                    }
                    const int kb = 16 * kt + 4 * fq;
                    u32x4 o;
                    { const unsigned bits = __builtin_bit_cast(unsigned, s0); o.x = (kb + 0) <= pq ? (bits ^ ((bits >> 31) ? 0xffffffffu : 0x80000000u)) : 0u; }
                    { const unsigned bits = __builtin_bit_cast(unsigned, s1); o.y = (kb + 1) <= pq ? (bits ^ ((bits >> 31) ? 0xffffffffu : 0x80000000u)) : 0u; }
                    { const unsigned bits = __builtin_bit_cast(unsigned, s2); o.z = (kb + 2) <= pq ? (bits ^ ((bits >> 31) ? 0xffffffffu : 0x80000000u)) : 0u; }
                    { const unsigned bits = __builtin_bit_cast(unsigned, s3); o.w = (kb + 3) <= pq ? (bits ^ ((bits >> 31) ? 0xffffffffu : 0x80000000u)) : 0u; }
                    if (kt < k1) *(u32x4*)(scq + 16 * kt) = o;
                }
            }
#undef DSA_KLOAD
        }
        VM_WAIT();
        __syncthreads();
        DSTAMP(24);
    }
    LAS unsigned char* wl = lds + wave * DW2_STRIDE;
    LAS unsigned char* tile = wl + DW2_TILE;
    LAS unsigned short* selL = (LAS unsigned short*)(wl + DW2_SEL);
    LAS unsigned short* bkL = (LAS unsigned short*)(wl + DW2_BK);
    const LAS float* t5L = (const LAS float*)(lds + DSA2_T5);
    const LAS unsigned short* bkT = (const LAS unsigned short*)(lds + DSA2_BT);
    const int nqw = DENSE_ONLY ? 2 : 8;
    for (int qi_ = 0; qi_ < nqw; ++qi_) {
        asm volatile("" : "+v"(lane));
        const int iq = DENSE_ONLY ? wave * 2 + qi_ : wave + 8 * qi_;
        if (iq >= nq) break;
        const int p = DENSE_ONLY ? iq : G.pos0(iq >> 4) + (iq & 15), nk = p + 1, qrow = DENSE_ONLY ? MR + iq : G.row0(iq >> 4) + (iq & 15);
        int nsel;
        if (!DENSE_ONLY && nk > 256) {
            const unsigned* scr = SC + (size_t)iq * SC_PITCH;
            const int nreg = (nk + 63) >> 6;
            if (nreg <= 9) dsa_select<9>(scr, nk, p, lane, lds, tile, selL, bkL, bkT);
            else if (nreg <= 17) dsa_select<17>(scr, nk, p, lane, lds, tile, selL, bkL, bkT);
            else if (nreg <= 25) dsa_select<25>(scr, nk, p, lane, lds, tile, selL, bkL, bkT);
            else dsa_select<33>(scr, nk, p, lane, lds, tile, selL, bkL, bkT);
            nsel = 256;
        } else {
#pragma unroll
            for (int m = 0; m < 4; ++m) { const int s = lane + 64 * m; selL[s] = (unsigned short)(s < nk ? s : 0); bkL[s] = bkT[s < nk ? p - s : 0]; }
            nsel = nk;
        }
        DSTAMP(25);
        asm volatile("" : "+v"(lane));
        bf16x8 qB[4];
#pragma unroll
        for (int ks = 0; ks < 4; ++ks) qB[ks] = *(const bf16x8*)(QQ + (size_t)qrow * NQQ + fr * 128 + ks * 32 + 8 * fq);
        LDS_WAIT();
        f32x4 O[8];
#pragma unroll
        for (int nt = 0; nt < 8; ++nt) O[nt] = (f32x4){0.f, 0.f, 0.f, 0.f};
        float qss = 0.f;
#pragma unroll
        for (int ks = 0; ks < 4; ++ks) { const u32x4 w = __builtin_bit_cast(u32x4, qB[ks]);
            qss += (bflo(w.x) * bflo(w.x) + bfhi(w.x) * bfhi(w.x)) + (bflo(w.y) * bflo(w.y) + bfhi(w.y) * bfhi(w.y)) + (bflo(w.z) * bflo(w.z) + bfhi(w.z) * bfhi(w.z)) + (bflo(w.w) * bflo(w.w) + bfhi(w.w) * bfhi(w.w)); }
        qss += __shfl_xor(qss, 16); qss += __shfl_xor(qss, 32);
        const float mb = sqrtf(qss) * t5L[512] + t5L[513];
        float lrun = 0.f;
        const int nblk = (nsel + 31) >> 5;
#define DSA_GATHER(GV, blk_) do { _Pragma("unroll") for (int e = 0; e < 8; ++e) { const int pid = lane + 64 * e, ri = pid >> 4, ch = pid & 15, j = 32 * (blk_) + ri; \
            const int key = (int)selL[j]; GV[e] = *(const u32x4*)(KV + (size_t)krow(b, key) * 128 + ch * 8); } } while (0)
#define DSA_PUT(GV) do { _Pragma("unroll") for (int e = 0; e < 8; ++e) { const int pid = lane + 64 * e, ri = pid >> 4, ch = pid & 15; *(LAS u32x4*)(tile + off_b(ri, ch)) = GV[e]; } } while (0)
        u32x4 gvA[8], gvB[8];
        DSA_GATHER(gvA, 0);
        if (nblk > 1) DSA_GATHER(gvB, 1);
        for (int blk0 = 0; blk0 < nblk; blk0 += 2) {
#pragma unroll
            for (int half = 0; half < 2; ++half) {
                const int blk = blk0 + half;
                if (blk < nblk) {
                    if (half == 0) { DSA_PUT(gvA); if (blk + 2 < nblk) DSA_GATHER(gvA, blk + 2); }
                    else { DSA_PUT(gvB); if (blk + 2 < nblk) DSA_GATHER(gvB, blk + 2); }
                    LDS_WAIT();
                    f32x4 s0 = {0.f, 0.f, 0.f, 0.f}, s1 = {0.f, 0.f, 0.f, 0.f};
        #pragma unroll
                    for (int ks = 0; ks < 4; ++ks) {
                        const bf16x8 k0 = *(const LAS bf16x8*)(tile + off_b(fr, 4 * ks + fq)), k1 = *(const LAS bf16x8*)(tile + off_b(16 + fr, 4 * ks + fq));
                        s0 = __builtin_amdgcn_mfma_f32_16x16x32_bf16(k0, qB[ks], s0, 0, 0, 0);
                        s1 = __builtin_amdgcn_mfma_f32_16x16x32_bf16(k1, qB[ks], s1, 0, 0, 0);
                    }
                    const int j0 = 32 * blk + 4 * fq;
                    const u32x2 b0 = *(const LAS u32x2*)(bkL + j0), b1 = *(const LAS u32x2*)(bkL + j0 + 16);
                    const float t00 = t5L[(b0.x & 0xffffu) + fr], t01 = t5L[(b0.x >> 16) + fr], t02 = t5L[(b0.y & 0xffffu) + fr], t03 = t5L[(b0.y >> 16) + fr];
                    const float t10 = t5L[(b1.x & 0xffffu) + fr], t11 = t5L[(b1.x >> 16) + fr], t12 = t5L[(b1.y & 0xffffu) + fr], t13 = t5L[(b1.y >> 16) + fr];
                    const float e00 = __expf(s0.x + t00 - mb), e01 = __expf(s0.y + t01 - mb), e02 = __expf(s0.z + t02 - mb), e03 = __expf(s0.w + t03 - mb);
                    const float e10 = __expf(s1.x + t10 - mb), e11 = __expf(s1.y + t11 - mb), e12 = __expf(s1.z + t12 - mb), e13 = __expf(s1.w + t13 - mb);
                    const float p00 = (j0 + 0) < nsel ? e00 : 0.f, p01 = (j0 + 1) < nsel ? e01 : 0.f, p02 = (j0 + 2) < nsel ? e02 : 0.f, p03 = (j0 + 3) < nsel ? e03 : 0.f;
                    const float p10 = (j0 + 16) < nsel ? e10 : 0.f, p11 = (j0 + 17) < nsel ? e11 : 0.f, p12 = (j0 + 18) < nsel ? e12 : 0.f, p13 = (j0 + 19) < nsel ? e13 : 0.f;
                    lrun += ((p00 + p01) + (p02 + p03)) + ((p10 + p11) + (p12 + p13));
                    u32x4 pw; pw.x = pk2(p00, p01); pw.y = pk2(p02, p03); pw.z = pk2(p10, p11); pw.w = pk2(p12, p13);
                    const bf16x8 pa = __builtin_bit_cast(bf16x8, pw);
                    const unsigned q4 = (unsigned)(fr >> 2), p4 = (unsigned)(lane & 3);
        #pragma unroll
                    for (int nt = 0; nt < 8; ++nt) {
                        const s16x4 vlo = tr_rd(tile + off_b(4 * fq + q4, 2 * nt + (p4 >> 1)) + 8 * (p4 & 1));
                        const s16x4 vhi = tr_rd(tile + off_b(16 + 4 * fq + q4, 2 * nt + (p4 >> 1)) + 8 * (p4 & 1));
                        const bf16x8 vb = __builtin_shufflevector(vlo, vhi, 0, 1, 2, 3, 4, 5, 6, 7);
                        O[nt] = __builtin_amdgcn_mfma_f32_16x16x32_bf16(pa, vb, O[nt], 0, 0, 0);
                    }

                }
            }
        }
#undef DSA_GATHER
#undef DSA_PUT
        float lt2 = lrun + __shfl_xor(lrun, 16); lt2 += __shfl_xor(lt2, 32);
        const float inv = 1.f / lt2;
        float ir[4];
#pragma unroll
        for (int r = 0; r < 4; ++r) ir[r] = __shfl(inv, 4 * fq + r);
        bf16* od = (bf16*)(ws + WS_OD) + (size_t)qrow * 1024 + fr;
#pragma unroll
        for (int nt = 0; nt < 8; ++nt)
#pragma unroll
            for (int r = 0; r < 4; ++r) { const int hd = 4 * fq + r; od[(size_t)(hd >> 3) * MT * 1024 + (hd & 7) * 128 + 16 * nt] = (bf16)f2bf(O[nt][r] * ir[r]); }
        LDS_WAIT();
        DSTAMP(26);
    }
}
__device__ __forceinline__ void p5_dsa(ArgsP a, LAS unsigned char* lds, int l, int tid, int wave, int lane) {
    LAS float* t5L = (LAS float*)(lds + DSA2_T5);
    __syncthreads();
    t5L[tid] = a->in[I_T5][tid];
    for (int n = tid; n < TT; n += 512) ((LAS unsigned short*)(lds + DSA2_BT))[n] = (unsigned short)(t5_bucket(n) * 16);
    if (tid < 64) {
        const float g0 = fabsf(a->in[I_GDKV][l * 128 + tid]), g1 = fabsf(a->in[I_GDKV][l * 128 + 64 + tid]);
        const float gm = wave_max(fmaxf(g0, g1));
        float tm = 0.f;
#pragma unroll
        for (int i = 0; i < 8; ++i) tm = fmaxf(tm, fabsf(a->in[I_T5][tid + 64 * i]));
        tm = wave_max(tm);
        if (tid == 0) { t5L[512] = 11.313708498984761f * gm; t5L[513] = tm; }
    }
    __syncthreads();
    for (int u = blockIdx.x; u < 256; u += gridDim.x) {
        dsa_unit<false>(a, lds, u, 64, wave, lane);
        __syncthreads();
    }
    if (blockIdx.x == 0) dsa_unit<true>(a, lds, 0, 16, wave, lane);
}

__global__ void __launch_bounds__(NWAVES * 64, 2) fwd(Args a_) {
    extern __shared__ __attribute__((aligned(16))) unsigned char lds_raw[];
    LAS unsigned char* lds = (LAS unsigned char*)lds_raw;
    volatile LAS unsigned* MISC = (volatile LAS unsigned*)(lds + MISC_OFF);
    if (threadIdx.x < 32) MISC[threadIdx.x] = 0u;
    __syncthreads();
    const int g_lo = a_.g_lo, g_hi = a_.g_hi, l_lo = a_.l_lo, l_hi = a_.l_hi, ph_lo = a_.ph_lo, ph_hi = a_.ph_hi, use_bar = a_.use_bar;
    XcdBarrier bar; bar.bar = (unsigned*)(a_.ws + WS_CTL) + CW_BAR; bar.x = 0; bar.st = nullptr;
    if (use_bar) bar = xcd_barrier_post((unsigned*)(a_.ws + WS_CTL) + CW_BAR, MISC + 8);
#if defined(DIAG_SEL)
#ifndef DIAG_BLK
#define DIAG_BLK 31
#endif
    int diag_site = 0; if (threadIdx.x == 0) MISC[15] = (unsigned)__builtin_amdgcn_s_memrealtime();
#define DIAG_STAMP(site) do { if (blockIdx.x == 0 && threadIdx.x == 0) { const unsigned now_ = (unsigned)__builtin_amdgcn_s_memrealtime(); MISC[16 + (site)] += now_ - MISC[15]; MISC[15] = now_; } } while (0)
#define GRID_BAR() do { if (use_bar) xcd_barrier(bar); DIAG_STAMP(diag_site); ++diag_site; } while (0)
#else
#define GRID_BAR() do { if (use_bar) xcd_barrier(bar); } while (0)
#endif
#ifndef PHMASK
#define PHMASK 0xFFFF
#endif
#ifndef PROBE_PH
#define PROBE_PH -1
#endif
#ifndef FUSE_NORM
#define FUSE_NORM 0
#endif
#ifndef PROBE_MASK
#define PROBE_MASK 0
#endif
#define PROBED(k) ((PROBE_MASK >> (k)) & 1)
#ifndef P1_ALIGN
#define P1_ALIGN true
#endif
#define PH(k) (((PHMASK >> (k)) & 1) && ph_lo <= (k) && (k) < ph_hi)
#define PBEGIN ArgsP a = (ArgsP)__builtin_amdgcn_kernarg_segment_ptr(); asm volatile("" : "+s"(a)); unsigned char* ws = a->ws; \
    int tid_ = threadIdx.x; asm volatile("" : "+v"(tid_)); const int tid = tid_, lane = tid & 63, wave = __builtin_amdgcn_readfirstlane(tid >> 6); const int gw = blockIdx.x * NWAVES + wave, ngw = gridDim.x * NWAVES; (void)ws; (void)gw; (void)ngw; (void)lane;

#if defined(DIAG_SEL)
    diag_site = 15;
#endif
    if (((PHMASK >> 13) & 1) && a_.prep) { PBEGIN prep_weights(a, lds, gw, ngw, wave, lane); GRID_BAR(); }

    for (int g = g_lo; g < g_hi; ++g) {
        for (int l = l_lo; l < l_hi; ++l) {
#if defined(DIAG_SEL)
            diag_site = (l == 0) ? 0 : 1;
#endif
            if (PH(0) && l == 0) { PBEGIN p0_init(a, g, gw, ngw, lane); GRID_BAR(); }
            if (PH(1)) { PBEGIN
                FIn f{(bf16*)(ws + WS_Z), (float*)(ws + WS_ZF), (const float*)(ws + WS_BIN) + l * NZ};
                run_gemm<FIn, P1_ALIGN>(lds, (const bf16*)(ws + WS_XN), (const bf16*)(ws + WS_WIN) + (size_t)l * NZ * D, NZ, D, f, gw, ngw, lane);
                if (PROBED(1)) { run_gemm(lds, (const bf16*)(ws + WS_XN), (const bf16*)(ws + WS_WIN) + (size_t)l * NZ * D, NZ, D, f, gw, ngw, lane); }
                GRID_BAR();
            }
            if (PH(2)) {
                { PBEGIN p2_prep(a, l, gw, ngw, lane); }
#if defined(DIAG_SEL)
                __syncthreads(); DIAG_STAMP(14);
#endif
                { PBEGIN __syncthreads(); p2_chunks(a, lds, l, gw, ngw, wave, lane); }
                GRID_BAR();
            }
            if (PH(3)) { PBEGIN
                FQQ f{(bf16*)(ws + WS_QQ)};
                run_gemm(lds, (const bf16*)(ws + WS_CQN), (const bf16*)(ws + WS_WQQ) + (size_t)l * NQQ * 256, NQQ, 256, f, gw, ngw, lane);
                if (PROBED(3)) { run_gemm(lds, (const bf16*)(ws + WS_CQN), (const bf16*)(ws + WS_WQQ) + (size_t)l * NQQ * 256, NQQ, 256, f, gw, ngw, lane); }
            }
#if defined(DIAG_SEL)
            __syncthreads(); DIAG_STAMP(11);
#endif
            if (PH(4)) { PBEGIN
                for (int u = blockIdx.x; u < 256; u += gridDim.x) {
                    const int b = (u >> 4) & 7, h = (u >> 2) & 3, vs = u & 3;
                    if (u >> 7) scan_unit<true>(a, lds, b, h, vs, tid); else scan_unit<false>(a, lds, b, h, vs, tid);
                }
#if PROBE_PH == 4
                for (int u = blockIdx.x; u < 256; u += gridDim.x) {
                    const int b = (u >> 4) & 7, h = (u >> 2) & 3, vs = u & 3;
                    if (u >> 7) scan_unit<true>(a, lds, b, h, vs, tid); else scan_unit<false>(a, lds, b, h, vs, tid);
                }
#endif
                GRID_BAR();
            }
#if defined(DIAG_SEL)
            if (blockIdx.x == DIAG_BLK && threadIdx.x == 0) MISC[14] = (unsigned)__builtin_amdgcn_s_memrealtime();
#endif
            if (PH(5)) { PBEGIN p5_dsa(a, lds, l, tid, wave, lane); }
#if defined(DIAG_SEL)
            __syncthreads(); DSTAMP(27);
#endif
#if PROBE_PH == 5
            if (PH(5)) { PBEGIN p5_dsa(a, lds, l, tid, wave, lane); }
#endif
            if (PH(6)) { PBEGIN p6_headnorm(a, l, gw, ngw, lane); if (PROBED(6)) p6_headnorm<true>(a, l, gw, ngw, lane);
#if defined(DIAG_SEL)
                DSTAMP(28);
#endif
                GRID_BAR();
#if defined(DIAG_SEL)
                DSTAMP(29);
#endif
            }
            if (PH(7)) {
                __syncthreads();
                { PBEGIN
                  const bf16* OD0 = (const bf16*)(ws + WS_OD); const bf16* OD1 = OD0 + (size_t)MT * 1024;
                  const bf16* WB0 = (const bf16*)(ws + WS_WBD) + (size_t)l * D * 2048; const bf16* WB1 = WB0 + (size_t)D * D;
                  int Kc = D, Nc = D; asm volatile("" : "+s"(Kc)); asm volatile("" : "+s"(Nc));
                  pg8::Gemm g{(const bf16*)(ws + WS_OG), (const bf16*)(ws + WS_WBG) + (size_t)l * D * D, MR, Nc, Kc, OD0, OD1, (const bf16*)(ws + WS_OM), WB0, WB1, (const bf16*)(ws + WS_WBM) + (size_t)l * D * D};
                  ChainOrder S; S.S.init(MR, Nc, (int)gridDim.x, (int)blockIdx.x);
                  EpiMix E{(const bf16*)(ws + WS_Z), (bf16*)(ws + WS_MIX)};
                  pg8::gemm_phase<EpiMix, ChainOrder, true, true, true>((PG8_LAS unsigned char*)lds, g, S, E);
                  FBr<0> f0{(const bf16*)(ws + WS_Z), (float*)(ws + WS_Y), (bf16*)(ws + WS_MIX)};
                  mini_gemm(lds, (const bf16*)(ws + WS_OG), (const bf16*)(ws + WS_WBG) + (size_t)l * D * D, Nc, Kc, f0, (int)threadIdx.x);
                  FBr<1> f1{(const bf16*)(ws + WS_Z), (float*)(ws + WS_Y), (bf16*)(ws + WS_MIX)};
                  mini_gemm(lds, OD0, WB0, Nc, Kc, f1, (int)threadIdx.x);
                  mini_gemm(lds, OD1, WB1, Nc, Kc, f1, (int)threadIdx.x);
                  FBr<2> f2{(const bf16*)(ws + WS_Z), (float*)(ws + WS_Y), (bf16*)(ws + WS_MIX)};
                  mini_gemm(lds, (const bf16*)(ws + WS_OM), (const bf16*)(ws + WS_WBM) + (size_t)l * D * D, Nc, Kc, f2, (int)threadIdx.x);
                }
#if PROBED(7)
                { PBEGIN
                  const bf16* OD0 = (const bf16*)(ws + WS_OD); const bf16* OD1 = OD0 + (size_t)MT * 1024;
                  const bf16* WB0 = (const bf16*)(ws + WS_WBD) + (size_t)l * D * 2048; const bf16* WB1 = WB0 + (size_t)D * D;
                  int Kc = D, Nc = D; asm volatile("" : "+s"(Kc)); asm volatile("" : "+s"(Nc));
                  pg8::Gemm g{(const bf16*)(ws + WS_OG), (const bf16*)(ws + WS_WBG) + (size_t)l * D * D, MR, Nc, Kc, OD0, OD1, (const bf16*)(ws + WS_OM), WB0, WB1, (const bf16*)(ws + WS_WBM) + (size_t)l * D * D};
                  ChainOrder S; S.S.init(MR, Nc, (int)gridDim.x, (int)blockIdx.x);
                  EpiMix E{(const bf16*)(ws + WS_Z), (bf16*)(ws + WS_MIX)};
                  pg8::gemm_phase<EpiMix, ChainOrder, true, true, true>((PG8_LAS unsigned char*)lds, g, S, E);
                  FBr<0> f0{(const bf16*)(ws + WS_Z), (float*)(ws + WS_Y), (bf16*)(ws + WS_MIX)};
                  mini_gemm(lds, (const bf16*)(ws + WS_OG), (const bf16*)(ws + WS_WBG) + (size_t)l * D * D, Nc, Kc, f0, (int)threadIdx.x);
                  FBr<1> f1{(const bf16*)(ws + WS_Z), (float*)(ws + WS_Y), (bf16*)(ws + WS_MIX)};
                  mini_gemm(lds, OD0, WB0, Nc, Kc, f1, (int)threadIdx.x);
                  mini_gemm(lds, OD1, WB1, Nc, Kc, f1, (int)threadIdx.x);
                  FBr<2> f2{(const bf16*)(ws + WS_Z), (float*)(ws + WS_Y), (bf16*)(ws + WS_MIX)};
                  mini_gemm(lds, (const bf16*)(ws + WS_OM), (const bf16*)(ws + WS_WBM) + (size_t)l * D * D, Nc, Kc, f2, (int)threadIdx.x);
                }
#endif
                GRID_BAR();
            }
            if (PH(8)) { PBEGIN
                if (FUSE_NORM && gridDim.x == 256) {
                    int Kc = D, Nc = D; asm volatile("" : "+s"(Kc)); asm volatile("" : "+s"(Nc));
                    pg8::Gemm gg{(const bf16*)(ws + WS_MIX), (const bf16*)(ws + WS_WOUT) + (size_t)l * D * D, MR, Nc, Kc};
                    pg8::StaticOrder S; S.init(MR, Nc, (int)gridDim.x, (int)blockIdx.x);
                    unsigned* ctl = (unsigned*)(ws + WS_CTL); float* xb = (float*)(ws + WS_LIF);
                    const unsigned tgt = 32u * (unsigned)(g * NL + l + 1);
                    EpiResNorm E{a->out + (size_t)g * MR * D, (bf16*)(ws + WS_XN), a->in[I_GPOSTMIX] + l * D, a->in[I_GPREMLP] + l * D,
                                 RmsExchange{xb, ctl + CW_XCNT, ctl, tgt}, RmsExchange{xb + 65536, ctl + CW_XCNT + 4096, ctl, tgt}};
                    pg8::gemm_phase<EpiResNorm, pg8::StaticOrder, false, true>((PG8_LAS unsigned char*)lds, gg, S, E);
                    FY f{(bf16*)(ws + WS_Y)};
                    mini_gemm(lds, (const bf16*)(ws + WS_MIX), (const bf16*)(ws + WS_WOUT) + (size_t)l * D * D, Nc, Kc, f, (int)threadIdx.x);
                } else {
                    FY f{(bf16*)(ws + WS_Y)};
                    run_gemm(lds, (const bf16*)(ws + WS_MIX), (const bf16*)(ws + WS_WOUT) + (size_t)l * D * D, D, D, f, gw, ngw, lane);
                }
                GRID_BAR();
            }
            if (PH(9)) { PBEGIN p_norm_res(a, g, a->in[I_GPOSTMIX] + l * D, a->in[I_GPREMLP] + l * D, gw, ngw, lane, (FUSE_NORM && gridDim.x == 256) ? MR : 0); GRID_BAR(); }
            if (PH(10)) { PBEGIN
                FUp f{(bf16*)(ws + WS_Z)};
                run_gemm(lds, (const bf16*)(ws + WS_XN), (const bf16*)(ws + WS_WUP) + (size_t)l * DFF * D, DFF, D, f, gw, ngw, lane);
                if (PROBED(10)) { run_gemm(lds, (const bf16*)(ws + WS_XN), (const bf16*)(ws + WS_WUP) + (size_t)l * DFF * D, DFF, D, f, gw, ngw, lane); }
                GRID_BAR();
            }
            if (PH(11)) { PBEGIN
                if (FUSE_NORM && gridDim.x == 256) {
                    int Kc = DFF, Nc = D; asm volatile("" : "+s"(Kc)); asm volatile("" : "+s"(Nc));
                    pg8::Gemm gg{(const bf16*)(ws + WS_Z), (const bf16*)(ws + WS_WDN) + (size_t)l * D * DFF, MR, Nc, Kc};
                    pg8::StaticOrder S; S.init(MR, Nc, (int)gridDim.x, (int)blockIdx.x);
                    unsigned* ctl = (unsigned*)(ws + WS_CTL); float* xb = (float*)(ws + WS_LIF) + 2 * 65536;
                    const unsigned tgt = 32u * (unsigned)(g * NL + l + 1);
                    EpiResNorm E{a->out + (size_t)g * MR * D, (bf16*)(ws + WS_XN), a->in[I_GPOSTMLP] + l * D, l + 1 < NL ? a->in[I_GPREMIX] + (l + 1) * D : nullptr,
                                 RmsExchange{xb, ctl + CW_XCNT + 2 * 4096, ctl, tgt}, RmsExchange{xb + 65536, ctl + CW_XCNT + 3 * 4096, ctl, 32u * (unsigned)(g * (NL - 1) + l + 1)}};
                    pg8::gemm_phase<EpiResNorm, pg8::StaticOrder, false, true>((PG8_LAS unsigned char*)lds, gg, S, E);
                    FY f{(bf16*)(ws + WS_Y)};
                    mini_gemm(lds, (const bf16*)(ws + WS_Z), (const bf16*)(ws + WS_WDN) + (size_t)l * D * DFF, Nc, Kc, f, (int)threadIdx.x);
                } else {
                    FY f{(bf16*)(ws + WS_Y)};
                    run_gemm(lds, (const bf16*)(ws + WS_Z), (const bf16*)(ws + WS_WDN) + (size_t)l * D * DFF, D, DFF, f, gw, ngw, lane);
                }
                GRID_BAR();
            }
            if (PH(12)) { PBEGIN p_norm_res(a, g, a->in[I_GPOSTMLP] + l * D, l + 1 < NL ? a->in[I_GPREMIX] + (l + 1) * D : nullptr, gw, ngw, lane, (FUSE_NORM && gridDim.x == 256) ? MR : 0); GRID_BAR(); }
        }
    }
#if defined(DIAG_SEL)
    if ((DIAG_SEL >= 24 || DIAG_SEL == 16 || DIAG_SEL == 17) && blockIdx.x == DIAG_BLK && threadIdx.x == 0) { unsigned tot = 0; for (int i = 24; i < 30; ++i) tot += MISC[i]; tot += MISC[16] + MISC[17];
        a_.out[12345] = 100.f + 900.f * (float)MISC[DIAG_SEL] / (float)tot; }
    if (DIAG_SEL < 24 && DIAG_SEL != 16 && DIAG_SEL != 17 && blockIdx.x == 0 && threadIdx.x == 0) { unsigned tot = 0; for (int i = 0; i < 16; ++i) tot += MISC[16 + i];
#if defined(DIAG_ABS)
        a_.out[12345] = 100.f + (float)MISC[16 + DIAG_SEL] * 0.001f; }
#else
        a_.out[12345] = DIAG_SEL == 99 ? 100.f + (float)tot * 0.0001f : 100.f + 900.f * (float)MISC[16 + DIAG_SEL] / (float)tot; }
#endif
#endif
#undef PH
#undef GRID_BAR
#undef PBEGIN
}

#ifndef MK_ONE_LAUNCH
#define MK_ONE_LAUNCH 1
#endif
extern "C" void kernel_launch(void* const* d_in, const int* in_sizes, int n_in, void* d_out, int out_size, void* d_ws, size_t ws_size, hipStream_t stream) {
    static int grid = 0;
    if (grid == 0) {
        if (n_in != 28 || out_size != NB * SEQ * D || ws_size < WS_END) { fprintf(stderr, "kernel_launch: unexpected shapes (n_in %d out %d ws %zu need %zu)\n", n_in, out_size, ws_size, (size_t)WS_END); grid = -1; return; }
        int dev = 0, cus = 0, per_cu = 0;
        if (hipGetDevice(&dev) != hipSuccess || hipDeviceGetAttribute(&cus, hipDeviceAttributeMultiprocessorCount, dev) != hipSuccess) { grid = -1; return; }
        if (hipFuncSetAttribute((const void*)fwd, hipFuncAttributeMaxDynamicSharedMemorySize, LDS_BYTES) != hipSuccess) { fprintf(stderr, "kernel_launch: hipFuncSetAttribute failed\n"); grid = -1; return; }
        if (hipOccupancyMaxActiveBlocksPerMultiprocessor(&per_cu, (const void*)fwd, NWAVES * 64, LDS_BYTES) != hipSuccess || per_cu < 1) { fprintf(stderr, "kernel_launch: occupancy query says %d\n", per_cu); }
        (void)hipGetLastError();
        grid = cus;
    }
    if (grid < 0) return;
    (void)hipMemsetAsync((char*)d_ws + WS_CTL, 0, CTL_ZERO_BYTES, stream);
    Args a{};
    for (int i = 0; i < 28; ++i) a.in[i] = (const float*)d_in[i];
    a.out = (float*)d_out; a.ws = (unsigned char*)d_ws;
#if MK_ONE_LAUNCH
    a.g_lo = 0; a.g_hi = NG; a.l_lo = 0; a.l_hi = NL; a.ph_lo = 0; a.ph_hi = 13; a.prep = 1; a.use_bar = 1;
    hipLaunchKernelGGL(fwd, dim3(grid), dim3(NWAVES * 64), LDS_BYTES, stream, a);
#else
    a.use_bar = 0;
    a.prep = 1; a.g_lo = 0; a.g_hi = 0; a.l_lo = 0; a.l_hi = 0; a.ph_lo = 0; a.ph_hi = 0;
    hipLaunchKernelGGL(fwd, dim3(grid), dim3(NWAVES * 64), LDS_BYTES, stream, a);
    a.prep = 0;
    static const int cuts[] = {0, 1, 2, 3, 5, 7, 8, 9, 10, 11, 12, 13};
    for (int g = 0; g < NG; ++g) for (int l = 0; l < NL; ++l) for (int c = 0; c < 11; ++c) {
        if (c == 0 && l != 0) continue;
        a.g_lo = g; a.g_hi = g + 1; a.l_lo = l; a.l_hi = l + 1; a.ph_lo = cuts[c]; a.ph_hi = cuts[c + 1];
        hipLaunchKernelGGL(fwd, dim3(grid), dim3(NWAVES * 64), LDS_BYTES, stream, a);
    }
#endif
    const hipError_t le = hipPeekAtLastError();
    if (le != hipSuccess) fprintf(stderr, "kernel_launch: launch failed: %s\n", hipGetErrorName(le));
}
```

```cpp
#include <hip/hip_runtime.h>
#include <cstdio>
#include <cstdint>
namespace pg8 {
#define PG8_LAS __attribute__((address_space(3)))
typedef unsigned short bf16_t;
typedef short bf16x8 __attribute__((ext_vector_type(8)));
typedef float f32x4 __attribute__((ext_vector_type(4)));
typedef unsigned u32x4 __attribute__((ext_vector_type(4)));
constexpr int BM = 256, BK = 64, HALF = 128, HTB = HALF * BK * 2  , STAGE_BYTES = 8 * HTB, NXCD = 8, WGM = 8;

__host__ __device__ __forceinline__ int lds_byte(int r, int c) { const int st = (r >> 4) * 2 + (c >> 5), rr = r & 15, cc = c & 31, ob = rr * 64 + cc * 2; return st * 1024 + (ob ^ (((ob >> 9) & 1) << 5)); }
__host__ __device__ __forceinline__ void stage_rc(int b, int& R, int& C) { const int st = b / 1024, sb = b % 1024, swz = sb ^ (((sb >> 9) & 1) << 5); R = (st >> 1) * 16 + swz / 64; C = (st & 1) * 32 + (swz % 64) / 2; }
__host__ __device__ __forceinline__ int perm32(int rho) { const int n = rho >> 4, i = rho & 15; return 8 * (i >> 2) + 4 * n + (i & 3); }

struct Unit { int pm, pn, sub; };
struct Gemm { const bf16_t* A; const bf16_t* Bt; int M, N, K; const bf16_t *A1, *A2, *A3, *B1, *B2, *B3; };

struct StaticOrder {
    int nM, nN, nwg, G, c;
    __host__ __device__ void init(int M, int N, int G_, int c_) { nM = M / BM; nN = N / BM; nwg = nM * nN; G = G_; c = c_; }
    __host__ __device__ bool next(int i, Unit& u) const {
        const long L = (long)i * G + c; if (L >= nwg) return false;
        int wgid = (int)L; { const int q = nwg / NXCD, r = nwg % NXCD, xcd = wgid % NXCD, off = wgid / NXCD; wgid = (xcd < r ? xcd * (q + 1) : r * (q + 1) + (xcd - r) * q) + off; }
        const int nig = WGM * nN, gid = wgid / nig, fm = gid * WGM, gsz = (nM - fm) < WGM ? (nM - fm) : WGM;
        u.pm = fm + ((wgid % nig) % gsz); u.pn = (wgid % nig) / gsz; u.sub = 0; return true;
    }
    __device__ __forceinline__ void a_ready(const Unit&) const {}
    __device__ __forceinline__ void done(const Unit&) const {}
};

__device__ __forceinline__ unsigned cvt_pk_bf16(float lo, float hi) { unsigned r; asm volatile("v_cvt_pk_bf16_f32 %0, %1, %2" : "=v"(r) : "v"(lo), "v"(hi)); return r; }
template <class Epi, class Sched, bool ALIGN_EPI = false, bool SP2 = false, bool CHAIN = false>
__device__ __forceinline__ void gemm_phase(PG8_LAS unsigned char* lds, const Gemm g, const Sched& S, const Epi& E) {
    int tid_ = threadIdx.x; asm volatile("" : "+v"(tid_));
    const int tid = tid_, wid = __builtin_amdgcn_readfirstlane(tid >> 6), lane = tid & 63, wr = wid >> 2, wc = wid & 3, fr = lane & 15, fq = lane >> 4;
    const int K = g.K, nt = K / BK;
    unsigned voffA[2], voffB[2];
#pragma unroll
    for (int i = 0; i < 2; ++i) { int R, C; stage_rc(tid * 16 + i * 8192, R, C); const int Rb = Epi::PERM ? ((R & ~31) + perm32(R & 31)) : R;
        voffA[i] = (unsigned)(R * K + C) * 2u; voffB[i] = (unsigned)(Rb * K + C) * 2u; }
    const size_t kstep = (size_t)(BK * 2);
    const size_t hstep = (size_t)HALF * K * 2;
    const size_t tstep = 2 * hstep;
    const unsigned ldsw = (unsigned)wid * 1024u;
    const int aoff = lds_byte(wr * 64 + fr, fq * 8), boff = lds_byte(wc * 32 + fr, fq * 8);
#define PG8_SA(b, h) (((b) * 2 + (h)) * HTB)
#define PG8_SB(b, h) ((4 + (b) * 2 + (h)) * HTB)
#define PG8_STAGE(bufoff, gbase, voff) do { _Pragma("unroll") for (int _i = 0; _i < 2; ++_i) \
        __builtin_amdgcn_global_load_lds((const unsigned*)((const char*)(gbase) + (voff)[_i]), (PG8_LAS unsigned*)(lds + (bufoff) + ldsw + _i * 8192), 16, 0, 0); } while (0)
#define PG8_LDA(dst, b, h) do { _Pragma("unroll") for (int m = 0; m < 4; ++m) _Pragma("unroll") for (int k = 0; k < 2; ++k) dst[m][k] = *(const PG8_LAS bf16x8*)(lds + PG8_SA(b, h) + aoff + m * 2048 + k * 1024); } while (0)
#define PG8_LDB(dst, b, h) do { _Pragma("unroll") for (int n = 0; n < 2; ++n) _Pragma("unroll") for (int k = 0; k < 2; ++k) dst[n][k] = *(const PG8_LAS bf16x8*)(lds + PG8_SB(b, h) + boff + n * 2048 + k * 1024); } while (0)
#define PG8_MMA(ai, bj, At, Bt) do { __builtin_amdgcn_s_setprio(1); _Pragma("unroll") for (int m = 0; m < 4; ++m) _Pragma("unroll") for (int n = 0; n < 2; ++n) _Pragma("unroll") for (int k = 0; k < 2; ++k) \
        acc[ai][bj][m][n] = __builtin_amdgcn_mfma_f32_16x16x32_bf16(Bt[n][k], At[m][k], acc[ai][bj][m][n], 0, 0, 0); __builtin_amdgcn_s_setprio(0); } while (0)
#define PG8_WAIT_V(n) asm volatile("s_waitcnt vmcnt(" #n ")" ::: "memory")
#define PG8_WAIT_L(n) asm volatile("s_waitcnt lgkmcnt(" #n ")" ::: "memory")
#define PG8_BAR __builtin_amdgcn_s_barrier()
#define PG8_SCHED __builtin_amdgcn_sched_barrier(0)
    Unit cur, nxt; int ui = 0;
    if (!S.next(0, cur)) return;
    f32x4 acc[2][2][4][2];
#pragma unroll
    for (int a = 0; a < 2; ++a)
#pragma unroll
        for (int b = 0; b < 2; ++b)
#pragma unroll
            for (int m = 0; m < 4; ++m)
#pragma unroll
                for (int n = 0; n < 2; ++n) acc[a][b][m][n] = (f32x4){0.f, 0.f, 0.f, 0.f};
    bf16x8 At[4][2], B0[2][2], B1[2][2];
#define PG8_ABASE(u) ((const char*)(!CHAIN || (u).sub == 0 ? g.A : (u).sub == 1 ? g.A1 : (u).sub == 2 ? g.A2 : g.A3) + (size_t)(u).pm * tstep)
#define PG8_BBASE(u) ((const char*)(!CHAIN || (u).sub == 0 ? g.Bt : (u).sub == 1 ? g.B1 : (u).sub == 2 ? g.B2 : g.B3) + (size_t)(u).pn * tstep)
    const char* cA = PG8_ABASE(cur); const char* cB = PG8_BBASE(cur);
    S.a_ready(cur);
    if constexpr (SP2) {
        PG8_STAGE(PG8_SB(0, 0), cB, voffB); PG8_STAGE(PG8_SB(0, 1), cB + hstep, voffB); PG8_STAGE(PG8_SA(0, 0), cA, voffA); PG8_STAGE(PG8_SA(0, 1), cA + hstep, voffA);
        if (wr == 1) PG8_BAR;
        PG8_WAIT_V(2); PG8_BAR;
        PG8_STAGE(PG8_SB(1, 0), cB + kstep, voffB); PG8_STAGE(PG8_SA(1, 0), cA + kstep, voffA); PG8_STAGE(PG8_SB(1, 1), cB + hstep + kstep, voffB);
        PG8_WAIT_V(6); PG8_BAR;
    } else {
        PG8_STAGE(PG8_SB(0, 0), cB, voffB); PG8_STAGE(PG8_SA(0, 0), cA, voffA); PG8_STAGE(PG8_SB(0, 1), cB + hstep, voffB); PG8_STAGE(PG8_SA(0, 1), cA + hstep, voffA);
        if (wr == 1) PG8_BAR;
        PG8_WAIT_V(4); PG8_BAR;
        PG8_STAGE(PG8_SB(1, 0), cB + kstep, voffB); PG8_STAGE(PG8_SA(1, 0), cA + kstep, voffA); PG8_STAGE(PG8_SB(1, 1), cB + hstep + kstep, voffB);
        PG8_WAIT_V(6); PG8_BAR;
    }
    for (;;) {
        const bool has_next = S.next(ui + 1, nxt);
        const char* nA = has_next ? PG8_ABASE(nxt) : cA; const char* nB = has_next ? PG8_BBASE(nxt) : cB;
        for (int t = 0; t < nt; t += 2) {
            const bool last = (t == nt - 2);
            const char* a1 = cA + (size_t)(t + 1) * kstep;
            const char* a2 = last ? nA : cA + (size_t)(t + 2) * kstep; const char* b2 = last ? nB : cB + (size_t)(t + 2) * kstep;
            const char* a3 = a2 + kstep; const char* b3 = b2 + kstep;
            if (last && has_next) S.a_ready(nxt);
            if constexpr (SP2) {
            PG8_LDB(B0, 0, 0); PG8_LDB(B1, 0, 1); PG8_SCHED; PG8_LDA(At, 0, 0); PG8_STAGE(PG8_SA(1, 1), a1 + hstep, voffA);
            PG8_WAIT_V(8); PG8_WAIT_L(0); PG8_BAR; PG8_MMA(0, 0, At, B0); PG8_MMA(0, 1, At, B1); PG8_BAR; PG8_SCHED;
            PG8_LDA(At, 0, 1); PG8_STAGE(PG8_SB(0, 0), b2, voffB); PG8_STAGE(PG8_SB(0, 1), b2 + hstep, voffB); PG8_STAGE(PG8_SA(0, 0), a2, voffA);
            PG8_WAIT_V(8); PG8_WAIT_L(0); PG8_BAR; PG8_MMA(1, 0, At, B0); PG8_MMA(1, 1, At, B1); PG8_BAR; PG8_SCHED;
            PG8_LDB(B0, 1, 0); PG8_LDB(B1, 1, 1); PG8_SCHED; PG8_LDA(At, 1, 0); PG8_STAGE(PG8_SA(0, 1), a2 + hstep, voffA);
            PG8_WAIT_V(8); PG8_WAIT_L(0); PG8_BAR; PG8_MMA(0, 0, At, B0); PG8_MMA(0, 1, At, B1); PG8_BAR; PG8_SCHED;
            PG8_LDA(At, 1, 1); PG8_STAGE(PG8_SB(1, 0), b3, voffB); PG8_STAGE(PG8_SB(1, 1), b3 + hstep, voffB); PG8_STAGE(PG8_SA(1, 0), a3, voffA);
            PG8_WAIT_V(8); PG8_WAIT_L(0); PG8_BAR; PG8_MMA(1, 0, At, B0); PG8_MMA(1, 1, At, B1); PG8_BAR; PG8_SCHED;
            } else {
            PG8_LDB(B0, 0, 0); PG8_SCHED; PG8_LDA(At, 0, 0); PG8_STAGE(PG8_SA(1, 1), a1 + hstep, voffA);
            PG8_WAIT_L(8); PG8_BAR; PG8_WAIT_L(0); PG8_MMA(0, 0, At, B0); PG8_BAR; PG8_SCHED;
            PG8_LDB(B1, 0, 1); PG8_STAGE(PG8_SB(0, 0), b2, voffB);
            PG8_BAR; PG8_WAIT_L(0); PG8_MMA(0, 1, At, B1); PG8_BAR;
            PG8_LDA(At, 0, 1); PG8_STAGE(PG8_SA(0, 0), a2, voffA);
            PG8_BAR; PG8_WAIT_L(0); PG8_MMA(1, 0, At, B0); PG8_BAR; PG8_SCHED;
            PG8_STAGE(PG8_SB(0, 1), b2 + hstep, voffB);
            PG8_WAIT_V(6); PG8_BAR; PG8_MMA(1, 1, At, B1); PG8_BAR;
            PG8_LDB(B0, 1, 0); PG8_SCHED; PG8_LDA(At, 1, 0); PG8_STAGE(PG8_SA(0, 1), a2 + hstep, voffA);
            PG8_WAIT_L(8); PG8_BAR; PG8_WAIT_L(0); PG8_MMA(0, 0, At, B0); PG8_BAR; PG8_SCHED;
            PG8_LDB(B1, 1, 1); PG8_STAGE(PG8_SB(1, 0), b3, voffB);
            PG8_BAR; PG8_WAIT_L(0); PG8_MMA(0, 1, At, B1); PG8_BAR;
            PG8_LDA(At, 1, 1); PG8_STAGE(PG8_SA(1, 0), a3, voffA);
            PG8_BAR; PG8_WAIT_L(0); PG8_MMA(1, 0, At, B0); PG8_BAR; PG8_SCHED;
            PG8_STAGE(PG8_SB(1, 1), b3 + hstep, voffB);
            PG8_WAIT_V(6); PG8_BAR; PG8_MMA(1, 1, At, B1); PG8_BAR;
            }
        }
        if constexpr (ALIGN_EPI) { if (wr == 0) PG8_BAR; }
        if constexpr (CHAIN) { if (cur.sub < 3) E.mid(acc, cur, wr, wc, fr, fq); else E(acc, cur, wr, wc, fr, fq); S.done(cur); }
        else if constexpr (!Epi::AFTER_DRAIN) { E(acc, cur, wr, wc, fr, fq); S.done(cur); }
        if (!has_next) break;
        if (!CHAIN || cur.sub == 3)
#pragma unroll
        for (int a = 0; a < 2; ++a)
#pragma unroll
            for (int b = 0; b < 2; ++b)
#pragma unroll
                for (int m = 0; m < 4; ++m)
#pragma unroll
                    for (int n = 0; n < 2; ++n) acc[a][b][m][n] = (f32x4){0.f, 0.f, 0.f, 0.f};
        cur = nxt; cA = nA; cB = nB; ++ui;
        if constexpr (ALIGN_EPI) { if (wr == 1) PG8_BAR; }
    }
    PG8_WAIT_V(0);
    if constexpr (!ALIGN_EPI) { if (wr == 0) PG8_BAR; }
    PG8_BAR;
    if constexpr (Epi::AFTER_DRAIN) { E.fused(acc, cur, wr, wc, fr, fq, lds, wid, lane); S.done(cur); }
#undef PG8_ABASE
#undef PG8_BBASE
#undef PG8_SA
#undef PG8_SB
#undef PG8_STAGE
#undef PG8_LDA
#undef PG8_LDB
#undef PG8_MMA
#undef PG8_WAIT_V
#undef PG8_WAIT_L
#undef PG8_BAR
#undef PG8_SCHED
}
}

constexpr int NB = 32, SEQ = 2048, NMETA = 16, TT = SEQ + NMETA, D = 1024, NL = 4, DFF = 4096;
constexpr int NG = 4, GB = NB / NG, MR = GB * SEQ  , MT = MR + NMETA  ;
constexpr int NCOLS = 9696, NZ = 9728, ZB = 9216, ZFW = 512;
constexpr float EPS = 1e-6f;
constexpr int ZC_GQ = 0, ZC_GK = 512, ZC_GV = 1024, ZC_GR = 2048, ZC_MQ = 3072, ZC_MK = 3584, ZC_MV = 4096, ZC_MO = 5120, ZC_GATE = 6144;
constexpr int ZF_CQ = 0, ZF_CKV = 256, ZF_IK = 384, ZF_A = 448, ZF_IW = 464, ZF_MI = 472, ZF_MF = 476;
constexpr int NQQ = 2560;

constexpr size_t MiB = 1u << 20;
constexpr size_t WS_CTL = 0, CTL_ZERO_BYTES = 1 * MiB;
constexpr size_t WS_BIN = 1 * MiB;
constexpr size_t WS_WIN = 2 * MiB;
constexpr size_t WS_WQQ = 78 * MiB;
constexpr size_t WS_WBG = 83 * MiB;
constexpr size_t WS_WBM = 91 * MiB;
constexpr size_t WS_WBD = 99 * MiB;
constexpr size_t WS_WOUT = 115 * MiB;
constexpr size_t WS_WUP = 123 * MiB;
constexpr size_t WS_WDN = 155 * MiB;
constexpr size_t WS_HM = 187 * MiB;
constexpr size_t WS_XN = 188 * MiB;
constexpr size_t WS_ZF = 221 * MiB;
constexpr size_t WS_CQN = 254 * MiB;
constexpr size_t WS_KV = 263 * MiB;
constexpr size_t WS_KI = 268 * MiB;
constexpr size_t WS_WI = 271 * MiB;
constexpr size_t WS_LIF = 272 * MiB;
constexpr size_t WS_G = 273 * MiB;
constexpr size_t WS_QKC = 306 * MiB;
constexpr size_t WS_QQ = 339 * MiB;
constexpr size_t WS_OG = 420 * MiB;
constexpr size_t WS_OM = 453 * MiB;
constexpr size_t WS_OD = 486 * MiB;
constexpr size_t WS_Z = 551 * MiB;
constexpr size_t WS_MIX = 840 * MiB;
constexpr size_t WS_Y = 873 * MiB;
constexpr size_t WS_SC = 840 * MiB;
constexpr size_t WS_DD = 1020 * MiB;
constexpr size_t WS_END = 1024 * MiB;
constexpr int SC_PITCH = 2080;
static_assert(WS_Z + (size_t)MT * ZB * 2 <= WS_MIX && WS_Y + (size_t)MT * D * 4 <= WS_END && WS_SC + (size_t)256 * 64 * SC_PITCH * 4 <= WS_END, "ws map");

constexpr int CW_BAR = 4096;

constexpr int RING_BYTES = 139264;
constexpr int MISC_OFF = RING_BYTES + 320;
constexpr int LDS_BYTES = 147456;
constexpr int NWAVES = 8;

#define LAS __attribute__((address_space(3)))
typedef unsigned short bf16;
typedef float f32x4 __attribute__((ext_vector_type(4)));
typedef float f32x2 __attribute__((ext_vector_type(2)));
typedef unsigned u32x4 __attribute__((ext_vector_type(4)));
typedef unsigned u32x2 __attribute__((ext_vector_type(2)));
typedef short bf16x8 __attribute__((ext_vector_type(8)));
typedef short s16x4 __attribute__((ext_vector_type(4)));
#define LDS_WAIT() asm volatile("s_waitcnt lgkmcnt(0)" ::: "memory")
#define VM_WAIT() asm volatile("s_waitcnt vmcnt(0)" ::: "memory")
#define LDS_BARRIER() do { asm volatile("s_waitcnt lgkmcnt(0)" ::: "memory"); __builtin_amdgcn_s_barrier(); asm volatile("" ::: "memory"); } while (0)

typedef __bf16 hwbf16x2 __attribute__((ext_vector_type(2)));
__device__ __forceinline__ unsigned pk2(float lo, float hi) { const f32x2 v = {lo, hi}; const hwbf16x2 b = __builtin_convertvector(v, hwbf16x2); return __builtin_bit_cast(unsigned, b); }
__device__ __forceinline__ unsigned f2bf(float f) { return pk2(f, 0.f) & 0xffffu; }
__device__ __forceinline__ float bf2f(unsigned b) { return __builtin_bit_cast(float, b << 16); }
__device__ __forceinline__ float bflo(unsigned w) { return __builtin_bit_cast(float, w << 16); }
__device__ __forceinline__ float bfhi(unsigned w) { return __builtin_bit_cast(float, w & 0xffff0000u); }
__device__ __forceinline__ float wave_sum(float v) {
#pragma unroll
    for (int o = 1; o < 64; o <<= 1) v += __shfl_xor(v, o);
    return v;
}
__device__ __forceinline__ float wave_max(float v) {
#pragma unroll
    for (int o = 1; o < 64; o <<= 1) v = fmaxf(v, __shfl_xor(v, o));
    return v;
}
__device__ __forceinline__ float sigmoid_f(float x) { return __builtin_amdgcn_rcpf(1.f + __builtin_amdgcn_exp2f(-1.4426950408889634f * x)); }
__device__ __forceinline__ float silu_f(float x) { return x * sigmoid_f(x); }
__device__ __forceinline__ float logsigmoid_f(float x) { return fminf(x, 0.f) - 0.6931471805599453f * __builtin_amdgcn_logf(1.f + __builtin_amdgcn_exp2f(-1.4426950408889634f * fabsf(x))); }

#define XB_TMO      128
#define XB_XCNT(j)  (256  + 64 * (j))
#define XB_XSUB(j)  (1280 + 64 * (j))
#define XB_XGEN(j)  (2304 + 64 * (j))
#define XB_TOP      3328
#define XB_TOPGEN   3392
#define XCD_BAR_WORDS 3456
#define XB_SPIN_CAP (1u << 22)

__device__ __forceinline__ unsigned xb_ld(unsigned* p)              { return __hip_atomic_load(p, __ATOMIC_RELAXED, __HIP_MEMORY_SCOPE_AGENT); }
__device__ __forceinline__ unsigned xb_add(unsigned* p, unsigned v) { return __hip_atomic_fetch_add(p, v, __ATOMIC_RELAXED, __HIP_MEMORY_SCOPE_AGENT); }
__device__ __forceinline__ unsigned xb_xcc_id() { return (unsigned)__builtin_amdgcn_s_getreg((3 << 11) | 20) & 0xFu; }
#define XB_SPIN(cond, bar) do { unsigned _sp = 0; while (cond) { __builtin_amdgcn_s_sleep(1); \
    if ((++_sp & 255u) == 0u) { if (xb_ld(&(bar)[XB_TMO])) break; if (_sp > XB_SPIN_CAP) { atomicAdd(&(bar)[XB_TMO], 1u); break; } } } } while (0)

struct XcdBarrier {
    unsigned* bar; unsigned x;
    volatile LAS unsigned* st;
};

__device__ __forceinline__ XcdBarrier xcd_barrier_post(unsigned* bar, volatile LAS unsigned* st) {
    XcdBarrier b; b.bar = bar; b.x = xb_xcc_id(); b.st = st;
    if (threadIdx.x == 0) (void)xb_add(&bar[XB_XCNT(b.x)], 1u);
    return b;
}
__device__ __forceinline__ void xcd_barrier_complete(unsigned* bar, unsigned x, unsigned& nloc, unsigned& nx) {
    const unsigned G = gridDim.x * gridDim.y * gridDim.z;
    unsigned sum, cnt, mine, sp = 0u;
    for (;;) {
        sum = 0u; cnt = 0u; mine = 0u;
#pragma unroll
        for (unsigned j = 0; j < 16; ++j) { const unsigned c = xb_ld(&bar[XB_XCNT(j)]); sum += c; cnt += (c > 0u) ? 1u : 0u; mine = (j == x) ? c : mine; }
        if (sum == G) break;
        __builtin_amdgcn_s_sleep(1);
        if ((++sp & 255u) == 0u) { if (xb_ld(&bar[XB_TMO])) break; if (sp > XB_SPIN_CAP) { atomicAdd(&bar[XB_TMO], 1u); break; } }
    }
    nloc = mine > 0u ? mine : 1u; nx = cnt > 0u ? cnt : 1u;
}

__device__ __forceinline__ void xcd_barrier(const XcdBarrier& b) {
    asm volatile("s_waitcnt vmcnt(0)" ::: "memory");
    __syncthreads();
    if (threadIdx.x == 0) {
        unsigned* bar = b.bar;
        __builtin_amdgcn_s_waitcnt(0);
        unsigned nloc = b.st[0], nx = b.st[1];
        if (nloc == 0u) { xcd_barrier_complete(bar, b.x, nloc, nx); b.st[0] = nloc; b.st[1] = nx; }
        const unsigned old = xb_add(&bar[XB_XSUB(b.x)], 1u);
        const unsigned gen = old / nloc;
        if (old + 1u == (gen + 1u) * nloc) {
            __builtin_amdgcn_fence(__ATOMIC_RELEASE, "agent");
            asm volatile("s_waitcnt vmcnt(0)" ::: "memory");
            const unsigned og = xb_add(&bar[XB_TOP], 1u);
            const unsigned tg = og / nx;
            if (og + 1u == (tg + 1u) * nx) xb_add(&bar[XB_TOPGEN], 1u);
            else XB_SPIN(xb_ld(&bar[XB_TOPGEN]) == tg, bar);
            __builtin_amdgcn_fence(__ATOMIC_ACQUIRE, "agent");
            xb_add(&bar[XB_XGEN(b.x)], 1u);
            asm volatile("s_waitcnt vmcnt(0)" ::: "memory");
        } else {
            XB_SPIN(xb_ld(&bar[XB_XGEN(b.x)]) == gen, bar);
            __builtin_amdgcn_fence(__ATOMIC_ACQUIRE, "agent");
            asm volatile("s_waitcnt vmcnt(0)" ::: "memory");
        }
    }
    __syncthreads();
}


struct Args { const float* in[28]; float* out; unsigned char* ws; int g_lo, g_hi, l_lo, l_hi, ph_lo, ph_hi, prep, use_bar; };
typedef const __attribute__((address_space(4))) Args* ArgsP;
enum { I_X = 0, I_META, I_T5, I_GPREMIX, I_WIN, I_BIN, I_WA2, I_BA, I_GGLA, I_WBRG, I_GDQ, I_WUQ, I_WIQ, I_GDKV, I_WUV, I_LNG, I_LNB, I_WBRD,
       I_CONV, I_FB, I_GML, I_WBRM, I_WOUT, I_GPOSTMIX, I_GPREMLP, I_WUP, I_WDN, I_GPOSTMLP };

__device__ __forceinline__ int win_src(int n) {
    if (n < 3072) return n;
    if (n < 6144) return n - 3072 + 3544;
    if (n < 9216) return n - 6144 + 6624;
    if (n < 9472) return n - 9216 + 3088;
    if (n < 9600) return n - 9472 + 3344;
    if (n < 9664) return n - 9600 + 3472;
    if (n < 9680) return n - 9664 + 3072;
    if (n < 9688) return n - 9680 + 3536;
    if (n < 9692) return n - 9688 + 6616;
    if (n < 9696) return n - 9692 + 6620;
    return -1;
}
struct CmIdent { __device__ __forceinline__ int operator()(int n) const { return n; } };
struct CmWin { __device__ __forceinline__ int operator()(int n) const { return win_src(n); } };

template <class CM>
__device__ __forceinline__ void tr_item(const float* __restrict__ W, int ldw, bf16* __restrict__ WT, int Kd, LAS float* scr, int k0, int ns0, int nd0, int lane, CM cm) {
    const int sc = cm(ns0 + (lane & 31)); const int scc = sc >= 0 ? sc : 0; const float msk = sc >= 0 ? 1.f : 0.f;
    float wv[32];
#pragma unroll
    for (int i = 0; i < 32; ++i) { const int kk = 2 * i + (lane >> 5); wv[i] = W[(size_t)(k0 + kk) * ldw + scc]; }
#pragma unroll
    for (int i = 0; i < 32; ++i) { const int kk = 2 * i + (lane >> 5); scr[kk * 33 + (lane & 31)] = wv[i] * msk; }
    LDS_WAIT();
    const int c = lane & 7;
#pragma unroll
    for (int j = 0; j < 4; ++j) { const int n = (lane >> 3) + 8 * j; const LAS float* s = scr + (8 * c) * 33 + n;
        u32x4 o; o.x = pk2(s[0 * 33], s[1 * 33]); o.y = pk2(s[2 * 33], s[3 * 33]); o.z = pk2(s[4 * 33], s[5 * 33]); o.w = pk2(s[6 * 33], s[7 * 33]);
        *(u32x4*)(WT + (size_t)(nd0 + n) * Kd + k0 + 8 * c) = o; }
    LDS_WAIT();
}

__device__ __forceinline__ void prep_weights(ArgsP a, LAS unsigned char* lds, int gw, int ngw, int wave, int lane) {
    LAS float* scr = (LAS float*)(lds + wave * 16384);
    unsigned char* ws = a->ws;
    constexpr int I_WIN_N = 16 * 304, I_UQ = 4 * 64, I_IQ = 4 * 16, I_SQ = 16 * 32, I_UP = 16 * 128, I_DN = 64 * 32, I_WBD = 4096, I_B = NZ / 64;
    constexpr int PER_L = I_WIN_N + I_UQ + I_IQ + 3 * I_SQ + I_UP + I_DN + I_WBD + I_B;
    for (int it = gw; it < NL * PER_L; it += ngw) {
        const int l = it / PER_L; int r = it % PER_L;
        if (r < I_WIN_N) { const int kb = r / 304, nb = r % 304;
            tr_item(a->in[I_WIN] + (size_t)l * D * NCOLS, NCOLS, (bf16*)(ws + WS_WIN) + (size_t)l * NZ * D, D, scr, kb * 64, nb * 32, nb * 32, lane, CmWin()); continue; }
        r -= I_WIN_N;
        if (r < I_UQ) { const int kb = r / 64, nb = r % 64;
            tr_item(a->in[I_WUQ] + (size_t)l * 256 * 2048, 2048, (bf16*)(ws + WS_WQQ) + (size_t)l * NQQ * 256, 256, scr, kb * 64, nb * 32, nb * 32, lane, CmIdent()); continue; }
        r -= I_UQ;
        if (r < I_IQ) { const int kb = r / 16, nb = r % 16;
            tr_item(a->in[I_WIQ] + (size_t)l * 256 * 512, 512, (bf16*)(ws + WS_WQQ) + (size_t)l * NQQ * 256, 256, scr, kb * 64, nb * 32, 2048 + nb * 32, lane, CmIdent()); continue; }
        r -= I_IQ;
        if (r < I_SQ) { const int kb = r / 32, nb = r % 32;
            tr_item(a->in[I_WBRG] + (size_t)l * D * D, D, (bf16*)(ws + WS_WBG) + (size_t)l * D * D, D, scr, kb * 64, nb * 32, nb * 32, lane, CmIdent()); continue; }
        r -= I_SQ;
        if (r < I_SQ) { const int kb = r / 32, nb = r % 32;
            tr_item(a->in[I_WBRM] + (size_t)l * D * D, D, (bf16*)(ws + WS_WBM) + (size_t)l * D * D, D, scr, kb * 64, nb * 32, nb * 32, lane, CmIdent()); continue; }
        r -= I_SQ;
        if (r < I_SQ) { const int kb = r / 32, nb = r % 32;
            tr_item(a->in[I_WOUT] + (size_t)l * D * D, D, (bf16*)(ws + WS_WOUT) + (size_t)l * D * D, D, scr, kb * 64, nb * 32, nb * 32, lane, CmIdent()); continue; }
        r -= I_SQ;
        if (r < I_UP) { const int kb = r / 128, nb = r % 128;
            tr_item(a->in[I_WUP] + (size_t)l * D * DFF, DFF, (bf16*)(ws + WS_WUP) + (size_t)l * DFF * D, D, scr, kb * 64, nb * 32, nb * 32, lane, CmIdent()); continue; }
        r -= I_UP;
        if (r < I_DN) { const int kb = r / 32, nb = r % 32;
            tr_item(a->in[I_WDN] + (size_t)l * DFF * D, D, (bf16*)(ws + WS_WDN) + (size_t)l * D * DFF, DFF, scr, kb * 64, nb * 32, nb * 32, lane, CmIdent()); continue; }
        r -= I_DN;
        if (r < I_WBD) {
            const int h = r >> 8, nb = (r >> 4) & 15, cb = r & 15, n = nb * 64 + lane, c0 = cb * 8;
            const float* uv = a->in[I_WUV] + ((size_t)(l * 16 + h) * 128 + c0) * 64;
            const float* wb = a->in[I_WBRD] + ((size_t)l * D + h * 64) * D + n;
            float acc[8];
#pragma unroll
            for (int j = 0; j < 8; ++j) acc[j] = 0.f;
            for (int d0 = 0; d0 < 64; d0 += 8) {
                float wv[8];
#pragma unroll
                for (int e = 0; e < 8; ++e) wv[e] = wb[(size_t)(d0 + e) * D];
#pragma unroll
                for (int j = 0; j < 8; ++j) { const f32x4 u0 = *(const f32x4*)(uv + j * 64 + d0), u1 = *(const f32x4*)(uv + j * 64 + d0 + 4);
                    acc[j] += (u0.x * wv[0] + u0.y * wv[1]) + (u0.z * wv[2] + u0.w * wv[3]) + (u1.x * wv[4] + u1.y * wv[5]) + (u1.z * wv[6] + u1.w * wv[7]); }
            }
            bf16* o = (bf16*)(ws + WS_WBD) + (size_t)l * D * 2048 + (size_t)(h >> 3) * D * D + (size_t)n * D + (h & 7) * 128 + c0;
            u32x4 ow; ow.x = pk2(acc[0], acc[1]); ow.y = pk2(acc[2], acc[3]); ow.z = pk2(acc[4], acc[5]); ow.w = pk2(acc[6], acc[7]);
            *(u32x4*)o = ow;
            continue; }
        r -= I_WBD;
        { const int n = r * 64 + lane; const int sc = win_src(n);
          ((float*)(ws + WS_BIN))[l * NZ + n] = sc >= 0 ? a->in[I_BIN][l * NCOLS + sc] : 0.f; }
    }
}

__device__ __forceinline__ float* hrow(ArgsP a, int g, int r) {
    return r < MR ? a->out + ((size_t)g * MR + r) * D : (float*)(a->ws + WS_HM) + (size_t)(r - MR) * D;
}
__device__ __forceinline__ void rms_row_bf16(const f32x4 (&v)[4], const float* __restrict__ gain, bf16* __restrict__ orow, int lane) {
    float s = 0.f;
#pragma unroll
    for (int j = 0; j < 4; ++j) s += (v[j].x * v[j].x + v[j].y * v[j].y) + (v[j].z * v[j].z + v[j].w * v[j].w);
    const float r = rsqrtf(wave_sum(s) * (1.f / D) + EPS);
#pragma unroll
    for (int j = 0; j < 4; ++j) { const f32x4 gg = *(const f32x4*)(gain + 4 * lane + 256 * j); const f32x4 o = v[j] * r * gg;
        u32x2 w; w.x = pk2(o.x, o.y); w.y = pk2(o.z, o.w); *(u32x2*)(orow + 4 * lane + 256 * j) = w; }
}
__device__ __forceinline__ void p0_init(ArgsP a, int g, int gw, int ngw, int lane) {
    bf16* XN = (bf16*)(a->ws + WS_XN);
    for (int r = gw; r < MT; r += ngw) {
        const float* src = r < MR ? a->in[I_X] + ((size_t)g * MR + r) * D : a->in[I_META] + (size_t)(r - MR) * D;
        float* hd = hrow(a, g, r);
        f32x4 v[4];
#pragma unroll
        for (int j = 0; j < 4; ++j) { v[j] = *(const f32x4*)(src + 4 * lane + 256 * j); *(f32x4*)(hd + 4 * lane + 256 * j) = v[j]; }
        rms_row_bf16(v, a->in[I_GPREMIX], XN + (size_t)r * D, lane);
    }
}
template <bool DRY = false>
__device__ __forceinline__ void p_norm_res(ArgsP a, int g, const float* gpost, const float* gpre, int gw, int ngw, int lane, int rbeg = 0) {
    bf16* XN = (bf16*)(a->ws + (DRY ? WS_Z + 100 * MiB : WS_XN)); const bf16* Y = (const bf16*)(a->ws + WS_Y);
    f32x4 gp[4], gq[4];
#pragma unroll
    for (int j = 0; j < 4; ++j) { gp[j] = *(const f32x4*)(gpost + 4 * lane + 256 * j); gq[j] = gpre ? *(const f32x4*)(gpre + 4 * lane + 256 * j) : (f32x4){0.f, 0.f, 0.f, 0.f}; }
    for (int r0 = rbeg + gw * 2; r0 < MT; r0 += ngw * 2) {
        float* hd[2]; float* hw[2]; u32x2 yw[2][4]; f32x4 v[2][4]; float s[2];
#pragma unroll
        for (int i = 0; i < 2; ++i) { const int r = r0 + i; hd[i] = hrow(a, g, r); hw[i] = DRY ? (float*)(a->ws + WS_Z) + (size_t)r * D : hd[i];
#pragma unroll
            for (int j = 0; j < 4; ++j) { yw[i][j] = *(const u32x2*)(Y + (size_t)r * D + 4 * lane + 256 * j); v[i][j] = *(const f32x4*)(hd[i] + 4 * lane + 256 * j); } }
        f32x4 y[2][4];
#pragma unroll
        for (int i = 0; i < 2; ++i) { s[i] = 0.f;
#pragma unroll
            for (int j = 0; j < 4; ++j) { y[i][j] = (f32x4){bflo(yw[i][j].x), bfhi(yw[i][j].x), bflo(yw[i][j].y), bfhi(yw[i][j].y)};
                s[i] += (y[i][j].x * y[i][j].x + y[i][j].y * y[i][j].y) + (y[i][j].z * y[i][j].z + y[i][j].w * y[i][j].w); } }
#pragma unroll
        for (int o = 1; o < 64; o <<= 1) { s[0] += __shfl_xor(s[0], o); s[1] += __shfl_xor(s[1], o); }
        float s2[2];
#pragma unroll
        for (int i = 0; i < 2; ++i) { const float rr = rsqrtf(s[i] * (1.f / D) + EPS); s2[i] = 0.f;
#pragma unroll
            for (int j = 0; j < 4; ++j) { v[i][j] = v[i][j] + y[i][j] * rr * gp[j]; *(f32x4*)(hw[i] + 4 * lane + 256 * j) = v[i][j];
                s2[i] += (v[i][j].x * v[i][j].x + v[i][j].y * v[i][j].y) + (v[i][j].z * v[i][j].z + v[i][j].w * v[i][j].w); } }
        if (gpre) {
#pragma unroll
            for (int o = 1; o < 64; o <<= 1) { s2[0] += __shfl_xor(s2[0], o); s2[1] += __shfl_xor(s2[1], o); }
#pragma unroll
            for (int i = 0; i < 2; ++i) { const float r2 = rsqrtf(s2[i] * (1.f / D) + EPS);
#pragma unroll
                for (int j = 0; j < 4; ++j) { const f32x4 o4 = v[i][j] * r2 * gq[j]; u32x2 w; w.x = pk2(o4.x, o4.y); w.y = pk2(o4.z, o4.w); *(u32x2*)(XN + (size_t)(r0 + i) * D + 4 * lane + 256 * j) = w; } }
        }
    }
}

template <class F> struct EpiT {
    static constexpr bool PERM = true, AFTER_DRAIN = false;
    F f;
    __device__ __forceinline__ void operator()(const f32x4 (&acc)[2][2][4][2], const pg8::Unit& u, int wr, int wc, int fr, int fq) const {
        const int row0 = u.pm * 256 + wr * 64 + fr, col0 = u.pn * 256 + wc * 32 + 8 * fq;
        if constexpr (F::HAS_BIAS) {
            const f32x4 b00 = *(const f32x4*)(f.bias + col0), b01 = *(const f32x4*)(f.bias + col0 + 4), b10 = *(const f32x4*)(f.bias + col0 + 128), b11 = *(const f32x4*)(f.bias + col0 + 132);
#pragma unroll
            for (int ai = 0; ai < 2; ++ai)
#pragma unroll
                for (int m = 0; m < 4; ++m) { f.apply(row0 + ai * 128 + m * 16, col0, acc[ai][0][m][0] + b00, acc[ai][0][m][1] + b01); f.apply(row0 + ai * 128 + m * 16, col0 + 128, acc[ai][1][m][0] + b10, acc[ai][1][m][1] + b11); }
            return;
        }
#pragma unroll
        for (int ai = 0; ai < 2; ++ai)
#pragma unroll
            for (int m = 0; m < 4; ++m)
#pragma unroll
                for (int bj = 0; bj < 2; ++bj) f.apply(row0 + ai * 128 + m * 16, col0 + bj * 128, acc[ai][bj][m][0], acc[ai][bj][m][1]);
    }
};
__device__ __forceinline__ void st_bf16x8(bf16* p, f32x4 v0, f32x4 v1) { u32x4 w; w.x = pk2(v0.x, v0.y); w.y = pk2(v0.z, v0.w); w.z = pk2(v1.x, v1.y); w.w = pk2(v1.z, v1.w); *(u32x4*)p = w; }
__device__ __forceinline__ void st_bf16x8_nt(bf16* p, f32x4 v0, f32x4 v1) { u32x4 w; w.x = pk2(v0.x, v0.y); w.y = pk2(v0.z, v0.w); w.z = pk2(v1.x, v1.y); w.w = pk2(v1.z, v1.w); __builtin_nontemporal_store(w, (u32x4*)p); }
__device__ __forceinline__ void ld_bf16x8(const bf16* p, f32x4& v0, f32x4& v1) { const u32x4 w = *(const u32x4*)p;
    v0 = (f32x4){bflo(w.x), bfhi(w.x), bflo(w.y), bfhi(w.y)}; v1 = (f32x4){bflo(w.z), bfhi(w.z), bflo(w.w), bfhi(w.w)}; }

#if defined(NT_STORES)
#define ST_BIG st_bf16x8_nt
#else
#define ST_BIG st_bf16x8
#endif
struct FIn {
    static constexpr bool HAS_BIAS = true, STAGGER = true;
    bf16* Z; float* ZF; const float* bias;
    __device__ __forceinline__ void apply(int row, int col, f32x4 v0, f32x4 v1) const {
        const int t = col >> 8;
        if (t >= 36) { float* p = ZF + (size_t)row * ZFW + (col - ZB); *(f32x4*)p = v0; *(f32x4*)(p + 4) = v1; return; }
        if (t < 2) { v0 *= 0.08838834764831845f; v1 *= 0.08838834764831845f; }
        else if (t >= 8 && t < 12) {
#pragma unroll
            for (int i = 0; i < 4; ++i) { v0[i] = silu_f(v0[i]); v1[i] = silu_f(v1[i]); } }
        else if (t >= 20) {
#pragma unroll
            for (int i = 0; i < 4; ++i) { v0[i] = sigmoid_f(v0[i]); v1[i] = sigmoid_f(v1[i]); } }
        ST_BIG(Z + (size_t)row * ZB + col, v0, v1);
    }
};
struct FQQ {
    static constexpr bool HAS_BIAS = false, STAGGER = false;
    bf16* QQ;
    __device__ __forceinline__ void apply(int row, int col, f32x4 v0, f32x4 v1) const {
        const float s = col < 2048 ? 0.08838834764831845f : 0.125f;
        st_bf16x8(QQ + (size_t)row * NQQ + col, v0 * s, v1 * s);
    }
};
template <int IDX> struct FBr {
    static constexpr bool HAS_BIAS = false;
    const bf16* Z; float* Y; bf16* MIX;
    __device__ __forceinline__ void apply(int row, int col, f32x4 v0, f32x4 v1) const {
        f32x4 g0, g1; ld_bf16x8(Z + (size_t)row * ZB + ZC_GATE + IDX * 1024 + col, g0, g1);
        float* y = Y + (size_t)row * D + col;
        f32x4 a0 = v0 * g0, a1 = v1 * g1;
        if (IDX > 0) { a0 += *(const f32x4*)y; a1 += *(const f32x4*)(y + 4); }
        if (IDX < 2) { *(f32x4*)y = a0; *(f32x4*)(y + 4) = a1; }
        else st_bf16x8(MIX + (size_t)row * D + col, a0, a1);
    }
};
struct FY {
    static constexpr bool HAS_BIAS = false, STAGGER = false;
    bf16* Y;
    __device__ __forceinline__ void apply(int row, int col, f32x4 v0, f32x4 v1) const { st_bf16x8(Y + (size_t)row * D + col, v0, v1); }
};
struct FUp {
    static constexpr bool HAS_BIAS = false, STAGGER = true;
    bf16* U;
    __device__ __forceinline__ void apply(int row, int col, f32x4 v0, f32x4 v1) const {
#pragma unroll
        for (int i = 0; i < 4; ++i) { const float p = fmaxf(v0[i], 0.f), q = fmaxf(v1[i], 0.f); v0[i] = p * p; v1[i] = q * q; }
#if defined(PROBE_NOSTORE)
        if (v0.x == 12345.678f) st_bf16x8(U + (size_t)row * DFF + col, v0, v1);
#else
        ST_BIG(U + (size_t)row * DFF + col, v0, v1);
#endif
    }
};

template <class F>
__device__ __forceinline__ void mini_gemm(LAS unsigned char* lds, const bf16* __restrict__ A, const bf16* __restrict__ Bt, int N, int K, const F& f, int tid_in, int bfirst = 0) {
    int tid = tid_in; asm volatile("" : "+v"(tid));
    const int lane = tid & 63, wave = __builtin_amdgcn_readfirstlane(tid >> 6), fr = lane & 15, fq = lane >> 4;
    LAS float* red = (LAS float*)lds;
    const int kw = K >> 3, kbeg = wave * kw;
    const int nblk_ = (int)gridDim.x - bfirst;
    for (int wt = (int)blockIdx.x - bfirst; wt >= 0 && wt < N / 32; wt += nblk_) {
        const int n0 = wt * 32;
        f32x4 acc0 = {0.f, 0.f, 0.f, 0.f}, acc1 = {0.f, 0.f, 0.f, 0.f};
        const bf16* ap = A + (size_t)(MR + fr) * K + fq * 8 + kbeg;
        const bf16* b0 = Bt + (size_t)(n0 + pg8::perm32(fr)) * K + fq * 8 + kbeg;
        const bf16* b1 = Bt + (size_t)(n0 + pg8::perm32(16 + fr)) * K + fq * 8 + kbeg;
        if (kw < 128) {
            const bf16x8 av = *(const bf16x8*)ap, w0 = *(const bf16x8*)b0, w1 = *(const bf16x8*)b1;
            acc0 = __builtin_amdgcn_mfma_f32_16x16x32_bf16(w0, av, acc0, 0, 0, 0);
            acc1 = __builtin_amdgcn_mfma_f32_16x16x32_bf16(w1, av, acc1, 0, 0, 0);
        } else {
            for (int k = 0; k < kw; k += 128) {
                bf16x8 av[4], w0[4], w1[4];
#pragma unroll
                for (int u = 0; u < 4; ++u) { av[u] = *(const bf16x8*)(ap + k + 32 * u); w0[u] = *(const bf16x8*)(b0 + k + 32 * u); w1[u] = *(const bf16x8*)(b1 + k + 32 * u); }
#pragma unroll
                for (int u = 0; u < 4; ++u) {
                    acc0 = __builtin_amdgcn_mfma_f32_16x16x32_bf16(w0[u], av[u], acc0, 0, 0, 0);
                    acc1 = __builtin_amdgcn_mfma_f32_16x16x32_bf16(w1[u], av[u], acc1, 0, 0, 0);
                }
            }
        }
        *(LAS f32x4*)(red + (wave * 64 + lane) * 8) = acc0; *(LAS f32x4*)(red + (wave * 64 + lane) * 8 + 4) = acc1;
        LDS_WAIT();
        __syncthreads();
        if (wave == 0) {
            f32x4 s0 = {0.f, 0.f, 0.f, 0.f}, s1 = {0.f, 0.f, 0.f, 0.f};
#pragma unroll
            for (int w = 0; w < 8; ++w) { s0 += *(const LAS f32x4*)(red + (w * 64 + lane) * 8); s1 += *(const LAS f32x4*)(red + (w * 64 + lane) * 8 + 4); }
            if constexpr (F::HAS_BIAS) { s0 += *(const f32x4*)(f.bias + n0 + 8 * fq); s1 += *(const f32x4*)(f.bias + n0 + 8 * fq + 4); }
            f.apply(MR + fr, n0 + 8 * fq, s0, s1);
        }
        __syncthreads();
    }
}
template <class F, bool ALIGN = true>
__device__ __forceinline__ void run_gemm(LAS unsigned char* lds, const bf16* A, const bf16* Bt, int N, int K, const F& f, int gw, int ngw, int lane) {
    asm volatile("" : "+s"(K)); asm volatile("" : "+s"(N));
    pg8::Gemm g{A, Bt, MR, N, K}; pg8::StaticOrder S; S.init(MR, N, (int)gridDim.x, (int)blockIdx.x);
    EpiT<F> E{f};
#if defined(STAGGER_TICKS)
    if (F::STAGGER) {
        const unsigned long long t0 = __builtin_amdgcn_s_memrealtime(), dl = (unsigned long long)(blockIdx.x & 3u) * STAGGER_TICKS;
        while (__builtin_amdgcn_s_memrealtime() - t0 < dl) __builtin_amdgcn_s_sleep(4);
    }
#endif
    pg8::gemm_phase<EpiT<F>, pg8::StaticOrder, ALIGN, true>((PG8_LAS unsigned char*)lds, g, S, E);
    mini_gemm(lds, A, Bt, N, K, f, (int)threadIdx.x, ((MR / 256) * (N / 256)) % (int)gridDim.x);
}

struct ChainOrder {
    pg8::StaticOrder S;
    __device__ __forceinline__ bool next(int i, pg8::Unit& u) const { if (!S.next(i >> 2, u)) return false; u.sub = i & 3; return true; }
    __device__ __forceinline__ void a_ready(const pg8::Unit&) const {}
    __device__ __forceinline__ void done(const pg8::Unit&) const {}
};
struct EpiMix {
    static constexpr bool PERM = true, AFTER_DRAIN = false;
    const bf16* Z; bf16* MIX;
    __device__ __forceinline__ void mid(f32x4 (&acc)[2][2][4][2], const pg8::Unit& u, int wr, int wc, int fr, int fq) const {
        if (u.sub == 1) return;
        const int gi = u.sub == 0 ? 0 : 1;
        const int row0 = u.pm * 256 + wr * 64 + fr, col0 = u.pn * 256 + wc * 32 + 8 * fq;
#pragma unroll
        for (int ai = 0; ai < 2; ++ai) {
            u32x4 ga[4][2], gb[4][2];
#pragma unroll
            for (int m = 0; m < 4; ++m)
#pragma unroll
                for (int bj = 0; bj < 2; ++bj) { const bf16* gp = Z + (size_t)(row0 + ai * 128 + m * 16) * ZB + ZC_GATE + gi * 1024 + col0 + bj * 128;
                    ga[m][bj] = *(const u32x4*)gp; gb[m][bj] = *(const u32x4*)(gp + 1024); }
#pragma unroll
            for (int m = 0; m < 4; ++m)
#pragma unroll
                for (int bj = 0; bj < 2; ++bj) {
                    const u32x4 a = ga[m][bj], b = gb[m][bj];
                    f32x4 r0, r1;
                    r0.x = bflo(a.x) * __builtin_amdgcn_rcpf(bflo(b.x)); r0.y = bfhi(a.x) * __builtin_amdgcn_rcpf(bfhi(b.x)); r0.z = bflo(a.y) * __builtin_amdgcn_rcpf(bflo(b.y)); r0.w = bfhi(a.y) * __builtin_amdgcn_rcpf(bfhi(b.y));
                    r1.x = bflo(a.z) * __builtin_amdgcn_rcpf(bflo(b.z)); r1.y = bfhi(a.z) * __builtin_amdgcn_rcpf(bfhi(b.z)); r1.z = bflo(a.w) * __builtin_amdgcn_rcpf(bflo(b.w)); r1.w = bfhi(a.w) * __builtin_amdgcn_rcpf(bfhi(b.w));
                    acc[ai][bj][m][0] *= r0; acc[ai][bj][m][1] *= r1;
                }
            asm volatile("" ::: "memory");
        }
    }
    __device__ __forceinline__ void operator()(const f32x4 (&acc)[2][2][4][2], const pg8::Unit& u, int wr, int wc, int fr, int fq) const {
        const int row0 = u.pm * 256 + wr * 64 + fr, col0 = u.pn * 256 + wc * 32 + 8 * fq;
#pragma unroll
        for (int ai = 0; ai < 2; ++ai) {
            u32x4 gc[4][2];
#pragma unroll
            for (int m = 0; m < 4; ++m)
#pragma unroll
                for (int bj = 0; bj < 2; ++bj) gc[m][bj] = *(const u32x4*)(Z + (size_t)(row0 + ai * 128 + m * 16) * ZB + ZC_GATE + 2 * 1024 + col0 + bj * 128);
#pragma unroll
            for (int m = 0; m < 4; ++m)
#pragma unroll
                for (int bj = 0; bj < 2; ++bj) {
                    const u32x4 w = gc[m][bj];
                    const f32x4 g0 = {bflo(w.x), bfhi(w.x), bflo(w.y), bfhi(w.y)}, g1 = {bflo(w.z), bfhi(w.z), bflo(w.w), bfhi(w.w)};
                    st_bf16x8(MIX + (size_t)(row0 + ai * 128 + m * 16) * D + col0 + bj * 128, acc[ai][bj][m][0] * g0, acc[ai][bj][m][1] * g1);
                }
            asm volatile("" ::: "memory");
        }
    }
};

constexpr int CW_XCNT = 16384;
struct RmsExchange {
    float* xbuf; unsigned* cnt; unsigned* tmo; unsigned target;
    __device__ __forceinline__ void run(const f32x4 (&v)[2][2][4][2], const pg8::Unit& u, int wr, int wc, int fr, int fq, LAS unsigned char* lds, int wid, int lane) const {
        LAS float* P = (LAS float*)lds;
        LAS float* S = (LAS float*)(lds + 8192);
#pragma unroll
        for (int ai = 0; ai < 2; ++ai)
#pragma unroll
            for (int m = 0; m < 4; ++m) {
                float s = 0.f;
#pragma unroll
                for (int bj = 0; bj < 2; ++bj)
#pragma unroll
                    for (int n = 0; n < 2; ++n) { const f32x4 x = v[ai][bj][m][n]; s += (x.x * x.x + x.y * x.y) + (x.z * x.z + x.w * x.w); }
                s += __shfl_xor(s, 16); s += __shfl_xor(s, 32);
                if (fq == 0) P[(ai * 128 + wr * 64 + m * 16 + fr) * 4 + wc] = s;
            }
        LDS_BARRIER();
        const int row = wid * 32 + (lane & 31);
        if (lane < 32) {
            const f32x4 p = *(const LAS f32x4*)(P + row * 4);
            __hip_atomic_store(xbuf + ((size_t)(u.pm * 256 + row) * 4 + u.pn), (p.x + p.y) + (p.z + p.w), __ATOMIC_RELAXED, __HIP_MEMORY_SCOPE_AGENT);
        }
        asm volatile("s_waitcnt vmcnt(0)" ::: "memory");
        if (lane == 0) __hip_atomic_fetch_add(cnt + 64 * u.pm, 1u, __ATOMIC_RELAXED, __HIP_MEMORY_SCOPE_AGENT);
        if (wid == 0) {
            const unsigned long long t0 = __builtin_amdgcn_s_memrealtime();
            for (;;) {
                if ((unsigned)__builtin_amdgcn_readfirstlane(__hip_atomic_load(cnt + 64 * u.pm, __ATOMIC_RELAXED, __HIP_MEMORY_SCOPE_AGENT)) >= target) break;
                if (__builtin_amdgcn_s_memrealtime() - t0 > 2000000ull) { if (lane == 0) __hip_atomic_store(tmo, 1u, __ATOMIC_RELAXED, __HIP_MEMORY_SCOPE_AGENT); break; }
                __builtin_amdgcn_s_sleep(2);
            }
            __builtin_amdgcn_fence(__ATOMIC_ACQUIRE, "agent");
        }
        asm volatile("s_waitcnt vmcnt(0) lgkmcnt(0)" ::: "memory"); __builtin_amdgcn_s_barrier(); asm volatile("" ::: "memory");
        if (lane < 32) {
            const float* slot = xbuf + (size_t)(u.pm * 256 + row) * 4; float t = 0.f;
#pragma unroll
            for (int q = 0; q < 4; ++q) t += __hip_atomic_load(slot + q, __ATOMIC_RELAXED, __HIP_MEMORY_SCOPE_AGENT);
            S[row] = rsqrtf(t * (1.f / D) + EPS);
        }
        LDS_BARRIER();
    }
};
struct EpiResNorm {
    static constexpr bool PERM = true, AFTER_DRAIN = true;
    float* hb; bf16* XN; const float* gpost; const float* gpre; RmsExchange e1, e2;
    __device__ __forceinline__ void fused(f32x4 (&acc)[2][2][4][2], const pg8::Unit& u, int wr, int wc, int fr, int fq, LAS unsigned char* lds, int wid, int lane) const {
        const LAS float* S = (const LAS float*)(lds + 8192);
        const int col0 = u.pn * 256 + wc * 32 + 8 * fq;
        f32x4 g0[2], g1[2];
#pragma unroll
        for (int bj = 0; bj < 2; ++bj) { g0[bj] = *(const f32x4*)(gpost + col0 + bj * 128); g1[bj] = *(const f32x4*)(gpost + col0 + bj * 128 + 4); }
        e1.run(acc, u, wr, wc, fr, fq, lds, wid, lane);
#pragma unroll
        for (int ai = 0; ai < 2; ++ai)
#pragma unroll
            for (int m = 0; m < 4; ++m) {
                const int rl = ai * 128 + wr * 64 + m * 16 + fr; const float rs = S[rl];
                float* hp = hb + (size_t)(u.pm * 256 + rl) * D + col0;
                f32x4 h00 = *(const f32x4*)hp, h01 = *(const f32x4*)(hp + 4), h10 = *(const f32x4*)(hp + 128), h11 = *(const f32x4*)(hp + 132);
                h00 += acc[ai][0][m][0] * rs * g0[0]; h01 += acc[ai][0][m][1] * rs * g1[0]; h10 += acc[ai][1][m][0] * rs * g0[1]; h11 += acc[ai][1][m][1] * rs * g1[1];
                *(f32x4*)hp = h00; *(f32x4*)(hp + 4) = h01; *(f32x4*)(hp + 128) = h10; *(f32x4*)(hp + 132) = h11;
                acc[ai][0][m][0] = h00; acc[ai][0][m][1] = h01; acc[ai][1][m][0] = h10; acc[ai][1][m][1] = h11;
                asm volatile("" : "+v"(acc[ai][0][m][0]), "+v"(acc[ai][0][m][1]), "+v"(acc[ai][1][m][0]), "+v"(acc[ai][1][m][1]));
                if (m & 1) asm volatile("" ::: "memory");
            }
        if (!gpre) return;
        e2.run(acc, u, wr, wc, fr, fq, lds, wid, lane);
#pragma unroll
        for (int bj = 0; bj < 2; ++bj) { g0[bj] = *(const f32x4*)(gpre + col0 + bj * 128); g1[bj] = *(const f32x4*)(gpre + col0 + bj * 128 + 4); }
#pragma unroll
        for (int ai = 0; ai < 2; ++ai)
#pragma unroll
            for (int m = 0; m < 4; ++m) {
                const int rl = ai * 128 + wr * 64 + m * 16 + fr; const float rs = S[rl];
                bf16* xp = XN + (size_t)(u.pm * 256 + rl) * D + col0;
                st_bf16x8(xp, acc[ai][0][m][0] * rs * g0[0], acc[ai][0][m][1] * rs * g1[0]);
                st_bf16x8(xp + 128, acc[ai][1][m][0] * rs * g0[1], acc[ai][1][m][1] * rs * g1[1]);
            }
    }
};

__device__ __forceinline__ int prow(int r, int j) {
    if (r < MR) { const int s = r & (SEQ - 1); return (s - j >= 0) ? r - j : MR + (NMETA + s - j); }
    const int t = r - MR; return (t - j >= 0) ? r - j : -1;
}
__device__ __forceinline__ void p2_prep(ArgsP a, int l, int gw, int ngw, int lane) {
    unsigned char* ws = a->ws;
    const bf16* Z = (const bf16*)(ws + WS_Z);
    for (int r = gw; r < MT; r += ngw) {
        const float* zf = (const float*)(ws + WS_ZF) + (size_t)r * ZFW;
        f32x4 vq = *(const f32x4*)(zf + ZF_CQ + 4 * lane);
        f32x2 vk = *(const f32x2*)(zf + ZF_CKV + 2 * lane);
        const float vi = zf[ZF_IK + lane];
        const float vw = zf[ZF_IW + (lane & 7)];
        const f32x4 gq = *(const f32x4*)(a->in[I_GDQ] + l * 256 + 4 * lane);
        const f32x2 gk = *(const f32x2*)(a->in[I_GDKV] + l * 128 + 2 * lane);
        const float lg = a->in[I_LNG][l * 64 + lane], lb = a->in[I_LNB][l * 64 + lane];
        float s1 = (vq.x * vq.x + vq.y * vq.y) + (vq.z * vq.z + vq.w * vq.w), s2 = vk.x * vk.x + vk.y * vk.y, s3 = vi;
#pragma unroll
        for (int o = 1; o < 64; o <<= 1) { s1 += __shfl_xor(s1, o); s2 += __shfl_xor(s2, o); s3 += __shfl_xor(s3, o); }
        const float d = vi - s3 * (1.f / 64.f);
        const float var = wave_sum(d * d) * (1.f / 64.f);
        const float r1 = rsqrtf(s1 * (1.f / 256.f) + EPS), r2 = rsqrtf(s2 * (1.f / 128.f) + EPS);
        vq = vq * r1 * gq;
        { u32x2 w; w.x = pk2(vq.x, vq.y); w.y = pk2(vq.z, vq.w); *(u32x2*)((bf16*)(ws + WS_CQN) + (size_t)r * 256 + 4 * lane) = w; }
        *(unsigned*)((bf16*)(ws + WS_KV) + (size_t)r * 128 + 2 * lane) = pk2(vk.x * r2 * gk.x, vk.y * r2 * gk.y);
        ((bf16*)(ws + WS_KI))[(size_t)r * 64 + lane] = (bf16)f2bf(d * rsqrtf(var + EPS) * lg + lb);
        if (lane < 8) ((float*)(ws + WS_WI))[(size_t)r * 8 + lane] = vw * 0.35355339059327373f;
    }
}
__device__ __forceinline__ void p2_chunks(ArgsP a, LAS unsigned char* lds, int l, int gw, int ngw, int wave, int lane) {
    unsigned char* ws = a->ws;
    const bf16* Z = (const bf16*)(ws + WS_Z);
    float* DDp = (float*)(ws + WS_DD);
    LAS float* stg = (LAS float*)(lds + wave * 5120);
    for (int it = gw; it < 257 * 8; it += ngw) {
        const int cid = it >> 3, mx = (it >> 2) & 1, h = it & 3;
        const int nrows = cid == 256 ? NMETA : 64, rbase = cid == 256 ? MR : cid * 64;
        const int k0 = 2 * lane;
        const float* ZFr = (const float*)(ws + WS_ZF);
        const int rl = rbase + (lane < nrows ? lane : 0);
        if (!mx) {
            { const float* zf = ZFr + (size_t)rl * ZFW + ZF_A;
              const f32x4 a0 = *(const f32x4*)zf, a1 = *(const f32x4*)(zf + 4), a2 = *(const f32x4*)(zf + 8), a3 = *(const f32x4*)(zf + 12);
              *(LAS f32x4*)(stg + lane * 16) = a0; *(LAS f32x4*)(stg + lane * 16 + 4) = a1; *(LAS f32x4*)(stg + lane * 16 + 8) = a2; *(LAS f32x4*)(stg + lane * 16 + 12) = a3; }
            float w0[16], w1[16];
#pragma unroll
            for (int j = 0; j < 16; ++j) { const f32x2 w = *(const f32x2*)(a->in[I_WA2] + (size_t)(l * 16 + j) * 512 + h * 128 + k0); w0[j] = w.x; w1[j] = w.y; }
            const f32x2 bb = *(const f32x2*)(a->in[I_BA] + l * 512 + h * 128 + k0);
            bf16* QG = (bf16*)(ws + WS_G);
            float G0 = 0.f, G1 = 0.f;
            unsigned pq[16], pk[16];
#define P2G_LOAD(t0) do { _Pragma("unroll") for (int i = 0; i < 16; ++i) { const int r_ = rbase + (t0) + i; \
                pq[i] = *(const unsigned*)(Z + (size_t)r_ * ZB + ZC_GQ + h * 128 + k0); pk[i] = *(const unsigned*)(Z + (size_t)r_ * ZB + ZC_GK + h * 128 + k0); } } while (0)
            P2G_LOAD(0);
            LDS_WAIT();
            for (int t0 = 0; t0 < nrows; t0 += 16) {
                unsigned cqw[16], ckw[16];
#pragma unroll
                for (int i = 0; i < 16; ++i) { cqw[i] = pq[i]; ckw[i] = pk[i]; }
                if (t0 + 16 < nrows) P2G_LOAD(t0 + 16);
#pragma unroll
                for (int i = 0; i < 16; ++i) {
                    const int r = rbase + t0 + i;
                    const LAS float* ar = stg + (t0 + i) * 16;
                    const f32x4 a0 = *(const LAS f32x4*)ar, a1 = *(const LAS f32x4*)(ar + 4), a2 = *(const LAS f32x4*)(ar + 8), a3 = *(const LAS f32x4*)(ar + 12);
                    const float av[16] = {a0.x, a0.y, a0.z, a0.w, a1.x, a1.y, a1.z, a1.w, a2.x, a2.y, a2.z, a2.w, a3.x, a3.y, a3.z, a3.w};
                    float s0 = bb.x, s1 = bb.y;
#pragma unroll
                    for (int j = 0; j < 16; ++j) { s0 += av[j] * w0[j]; s1 += av[j] * w1[j]; }
                    G0 += logsigmoid_f(s0) * 0.0625f; G1 += logsigmoid_f(s1) * 0.0625f;
                    const float e0 = __expf(G0), e1 = __expf(G1), i0 = __builtin_amdgcn_rcpf(e0), i1 = __builtin_amdgcn_rcpf(e1);
                    *(unsigned*)(QG + (size_t)r * 1024 + h * 128 + k0) = pk2(bflo(cqw[i]) * e0, bfhi(cqw[i]) * e1);
                    *(unsigned*)(QG + (size_t)r * 1024 + 512 + h * 128 + k0) = pk2(bflo(ckw[i]) * i0, bfhi(ckw[i]) * i1);
                }
            }
#undef P2G_LOAD
            *(f32x2*)(DDp + ((size_t)cid * 4 + h) * 128 + k0) = (f32x2){__expf(G0), __expf(G1)};
            LDS_WAIT();
        } else {
            { const float* zf = ZFr + (size_t)rl * ZFW; stg[lane * 2] = zf[ZF_MI + h]; stg[lane * 2 + 1] = zf[ZF_MF + h]; }
            float cq[4][2], ck[4][2];
#pragma unroll
            for (int tap = 0; tap < 4; ++tap) { const f32x2 wq = *(const f32x2*)(a->in[I_CONV] + (size_t)(l * 4 + tap) * 1024 + h * 128 + k0), wk = *(const f32x2*)(a->in[I_CONV] + (size_t)(l * 4 + tap) * 1024 + 512 + h * 128 + k0);
                cq[tap][0] = wq.x; cq[tap][1] = wq.y; ck[tap][0] = wk.x; ck[tap][1] = wk.y; }
            const float fb = a->in[I_FB][l * 4 + h];
            bf16* QM = (bf16*)(ws + WS_QKC);
            float xq[3][2], xk[3][2];
#pragma unroll
            for (int j = 0; j < 3; ++j) {
                const int rp = prow(rbase, j + 1);
                const int rpc = rp >= 0 ? rp : rbase; const float m = rp >= 0 ? 1.f : 0.f;
                const unsigned qw = *(const unsigned*)(Z + (size_t)rpc * ZB + ZC_MQ + h * 128 + k0), kw = *(const unsigned*)(Z + (size_t)rpc * ZB + ZC_MK + h * 128 + k0);
                xq[j][0] = bflo(qw) * m; xq[j][1] = bfhi(qw) * m; xk[j][0] = bflo(kw) * m; xk[j][1] = bfhi(kw) * m;
            }
            float bsum = 0.f;
            unsigned pq[16], pk[16];
#define P2M_LOAD(t0) do { _Pragma("unroll") for (int i = 0; i < 16; ++i) { const int r_ = rbase + (t0) + i; \
                pq[i] = *(const unsigned*)(Z + (size_t)r_ * ZB + ZC_MQ + h * 128 + k0); pk[i] = *(const unsigned*)(Z + (size_t)r_ * ZB + ZC_MK + h * 128 + k0); } } while (0)
            P2M_LOAD(0);
            LDS_WAIT();
            for (int t0 = 0; t0 < nrows; t0 += 16) {
                unsigned cqw[16], ckw[16];
#pragma unroll
                for (int i = 0; i < 16; ++i) { cqw[i] = pq[i]; ckw[i] = pk[i]; }
                if (t0 + 16 < nrows) P2M_LOAD(t0 + 16);
#pragma unroll
                for (int i = 0; i < 16; ++i) {
                    const int r = rbase + t0 + i;
                    const f32x2 gt = *(const LAS f32x2*)(stg + (t0 + i) * 2);
                    const float li = gt.x, lf = logsigmoid_f(gt.y + fb);
                    bsum += lf;
                    const float q0 = bflo(cqw[i]), q1 = bfhi(cqw[i]), kk0 = bflo(ckw[i]), kk1 = bfhi(ckw[i]);
                    const float yq0 = cq[3][0] * q0 + cq[2][0] * xq[0][0] + cq[1][0] * xq[1][0] + cq[0][0] * xq[2][0];
                    const float yq1 = cq[3][1] * q1 + cq[2][1] * xq[0][1] + cq[1][1] * xq[1][1] + cq[0][1] * xq[2][1];
                    const float yk0 = ck[3][0] * kk0 + ck[2][0] * xk[0][0] + ck[1][0] * xk[1][0] + ck[0][0] * xk[2][0];
                    const float yk1 = ck[3][1] * kk1 + ck[2][1] * xk[0][1] + ck[1][1] * xk[1][1] + ck[0][1] * xk[2][1];
                    xq[2][0] = xq[1][0]; xq[2][1] = xq[1][1]; xq[1][0] = xq[0][0]; xq[1][1] = xq[0][1]; xq[0][0] = q0; xq[0][1] = q1;
                    xk[2][0] = xk[1][0]; xk[2][1] = xk[1][1]; xk[1][0] = xk[0][0]; xk[1][1] = xk[0][1]; xk[0][0] = kk0; xk[0][1] = kk1;
                    const float eq = __expf(bsum) * 0.08838834764831845f, ek = __expf(li - bsum);
                    *(unsigned*)(QM + (size_t)r * 1024 + h * 128 + k0) = pk2(silu_f(yq0) * eq, silu_f(yq1) * eq);
                    *(unsigned*)(QM + (size_t)r * 1024 + 512 + h * 128 + k0) = pk2(silu_f(yk0) * ek, silu_f(yk1) * ek);
                }
            }
#undef P2M_LOAD
            const float dd = __expf(bsum);
            *(f32x2*)(DDp + ((size_t)(257 + cid) * 4 + h) * 128 + k0) = (f32x2){dd, dd};
            LDS_WAIT();
        }
    }
}

constexpr int SC_QS = 272, SC_VS = 144;
constexpr int SC_QT = 0, SC_KT = 2 * 17408, SC_VT = 4 * 17408, SC_AT = SC_VT + 2 * 9216, SC_SB = SC_AT + 9216, SC_DD = SC_SB + 2 * 18432, SC_NB = SC_DD + 1024, SC_END = SC_NB + 512;
static_assert(SC_END <= RING_BYTES, "scan LDS");
__device__ __forceinline__ bf16x8 tr8(LAS unsigned char* base, int stride, int row0, int col0, int lane) {
    const int fq = lane >> 4, q4 = (lane & 15) >> 2, p4 = lane & 3;
    LAS unsigned char* p = base + (row0 + 8 * fq + q4) * stride + (col0 + 4 * p4) * 2;
    const s16x4 lo = __builtin_amdgcn_ds_read_tr16_b64_v4i16((LAS s16x4*)p);
    const s16x4 hi = __builtin_amdgcn_ds_read_tr16_b64_v4i16((LAS s16x4*)(p + 4 * stride));
    return __builtin_shufflevector(lo, hi, 0, 1, 2, 3, 4, 5, 6, 7);
}
template <bool ML>
__device__ __forceinline__ void scan_unit(ArgsP a, LAS unsigned char* lds, int b, int h, int vs, int tid_in) {
    int tid = tid_in; asm volatile("" : "+v"(tid));
    unsigned char* ws = a->ws;
    const bf16* Z = (const bf16*)(ws + WS_Z);
    const bf16* QK = (const bf16*)(ws + (ML ? WS_QKC : WS_G));
    const float* DDp = (const float*)(ws + WS_DD) + (ML ? (size_t)257 * 512 : 0);
    bf16* O = (bf16*)(ws + (ML ? WS_OM : WS_OG));
    const int lane = tid & 63, wave = __builtin_amdgcn_readfirstlane(tid >> 6), fr = lane & 15, fq = lane >> 4;
    const int vt = wave & 3, hh = wave >> 2;
    for (int i = tid; i < (2 * 18432 + 1024 + 512) / 4; i += 512) ((LAS unsigned*)(lds + SC_SB))[i] = 0u;
    f32x4 S[4], nacc[4];
#pragma unroll
    for (int i = 0; i < 4; ++i) { S[i] = (f32x4){0.f, 0.f, 0.f, 0.f}; nacc[i] = (f32x4){0.f, 0.f, 0.f, 0.f}; }
    const bf16x8 ones = {(short)0x3F80, (short)0x3F80, (short)0x3F80, (short)0x3F80, (short)0x3F80, (short)0x3F80, (short)0x3F80, (short)0x3F80};
    u32x4 gq[2], gk[2], gv; float gd = 0.f;
    const int vcol = (ML ? ZC_MV : ZC_GV) + h * 256 + vs * 64;
    const bf16* zpage = (const bf16*)(ws + WS_CTL + 512 * 1024);
#define SCAN_LOAD(c) do { const int c_ = (c); \
        _Pragma("unroll") for (int e = 0; e < 2; ++e) { const int pid = tid + 512 * e, t = pid >> 4, ch = pid & 15; \
            const bool ok = c_ > 0 || t >= 48; const int row = c_ == 0 ? MR + t - 48 : b * SEQ + (c_ - 1) * 64 + t; \
            const bf16* qp_ = ok ? QK + (size_t)row * 1024 + h * 128 + ch * 8 : zpage; \
            gq[e] = *(const u32x4*)qp_; gk[e] = *(const u32x4*)(qp_ + 512); } \
        { const int t = tid >> 3, ch = tid & 7; const bool ok = c_ > 0 || t >= 48; const int row = c_ == 0 ? MR + t - 48 : b * SEQ + (c_ - 1) * 64 + t; \
          gv = *(const u32x4*)(ok ? Z + (size_t)row * ZB + vcol + ch * 8 : zpage); } \
        { const int cid = c_ == 0 ? 256 : b * 32 + (c_ - 1); gd = DDp[((size_t)cid * 4 + h) * 128 + (tid & 127)]; } } while (0)
#define SCAN_STORE(buf) do { const int bo_ = (buf); \
        _Pragma("unroll") for (int e = 0; e < 2; ++e) { const int pid = tid + 512 * e, t = pid >> 4, ch = pid & 15; \
            *(LAS u32x4*)(lds + SC_QT + bo_ * 17408 + t * SC_QS + ch * 16) = gq[e]; *(LAS u32x4*)(lds + SC_KT + bo_ * 17408 + t * SC_QS + ch * 16) = gk[e]; } \
        { const int t = tid >> 3, ch = tid & 7; *(LAS u32x4*)(lds + SC_VT + bo_ * 9216 + t * SC_VS + ch * 16) = gv; } \
        if (tid < 128) ((LAS float*)(lds + SC_DD))[bo_ * 128 + tid] = gd; } while (0)
    SCAN_LOAD(0);
    __syncthreads();
    SCAN_STORE(0);
    __syncthreads();
    for (int c = 0; c < 33; ++c) {
        const int buf = c & 1;
        LAS unsigned char* QT = lds + SC_QT + buf * 17408; LAS unsigned char* KT = lds + SC_KT + buf * 17408; LAS unsigned char* VT = lds + SC_VT + buf * 9216;
        LAS unsigned char* AT = lds + SC_AT; LAS unsigned char* SB = lds + SC_SB + buf * 18432; LAS unsigned char* SBn = lds + SC_SB + (buf ^ 1) * 18432;
        const LAS float* ddL = (const LAS float*)(lds + SC_DD) + buf * 128;
        if (c + 1 < 33) SCAN_LOAD(c + 1);
        {
            const int ti = wave >> 1;
#pragma unroll
            for (int sj = 0; sj < 2; ++sj) {
                const int si = 2 * (wave & 1) + sj;
                f32x4 acc = {0.f, 0.f, 0.f, 0.f};
                bf16x8 qa[4], kb[4];
#pragma unroll
                for (int ks = 0; ks < 4; ++ks) { qa[ks] = *(const LAS bf16x8*)(QT + (16 * ti + fr) * SC_QS + (32 * ks + 8 * fq) * 2); kb[ks] = *(const LAS bf16x8*)(KT + (16 * si + fr) * SC_QS + (32 * ks + 8 * fq) * 2); }
                asm volatile("" ::: "memory");
#pragma unroll
                for (int ks = 0; ks < 4; ++ks) acc = __builtin_amdgcn_mfma_f32_16x16x32_bf16(qa[ks], kb[ks], acc, 0, 0, 0);
                const int sg = 16 * si + fr, tg = 16 * ti + 4 * fq;
                LAS bf16* ap = (LAS bf16*)(AT + tg * SC_VS) + sg;
                ap[0 * (SC_VS / 2)] = (bf16)(sg <= tg + 0 ? f2bf(acc.x) : 0u);
                ap[1 * (SC_VS / 2)] = (bf16)(sg <= tg + 1 ? f2bf(acc.y) : 0u);
                ap[2 * (SC_VS / 2)] = (bf16)(sg <= tg + 2 ? f2bf(acc.z) : 0u);
                ap[3 * (SC_VS / 2)] = (bf16)(sg <= tg + 3 ? f2bf(acc.w) : 0u);
            }
        }
        {
            const bf16x8 vb0 = tr8(VT, SC_VS, 0, 16 * vt, lane), vb1 = tr8(VT, SC_VS, 32, 16 * vt, lane);
#pragma unroll
            for (int i = 0; i < 4; ++i) {
                const int kt = 4 * hh + i;
                const bf16x8 ka0 = tr8(KT, SC_QS, 0, 16 * kt, lane), ka1 = tr8(KT, SC_QS, 32, 16 * kt, lane);
                f32x4 acc = S[i];
                acc = __builtin_amdgcn_mfma_f32_16x16x32_bf16(ka0, vb0, acc, 0, 0, 0);
                acc = __builtin_amdgcn_mfma_f32_16x16x32_bf16(ka1, vb1, acc, 0, 0, 0);
                const f32x4 dv = *(const LAS f32x4*)(ddL + 16 * kt + 4 * fq);
                S[i] = acc * dv;
                if (ML) {
                    f32x4 na = nacc[i];
                    na = __builtin_amdgcn_mfma_f32_16x16x32_bf16(ka0, ones, na, 0, 0, 0);
                    na = __builtin_amdgcn_mfma_f32_16x16x32_bf16(ka1, ones, na, 0, 0, 0);
                    nacc[i] = na * dv;
                }
            }
        }
        {
#pragma unroll
            for (int i = 0; i < 4; ++i) {
                const int k0 = 16 * (4 * hh + i) + 4 * fq;
                LAS bf16* sp = (LAS bf16*)(SBn + k0 * SC_VS) + 16 * vt + fr;
                sp[0 * (SC_VS / 2)] = (bf16)f2bf(S[i].x); sp[1 * (SC_VS / 2)] = (bf16)f2bf(S[i].y); sp[2 * (SC_VS / 2)] = (bf16)f2bf(S[i].z); sp[3 * (SC_VS / 2)] = (bf16)f2bf(S[i].w);
                if (ML && vt == 0 && fr == 0) { LAS bf16* np = (LAS bf16*)(lds + SC_NB + (buf ^ 1) * 256) + k0; np[0] = (bf16)f2bf(nacc[i].x); np[1] = (bf16)f2bf(nacc[i].y); np[2] = (bf16)f2bf(nacc[i].z); np[3] = (bf16)f2bf(nacc[i].w); }
            }
        }
        LDS_BARRIER();
#if defined(DIAG_SEL)
        if (blockIdx.x == 0 && tid == 0) { volatile LAS unsigned* M_ = (volatile LAS unsigned*)(lds + MISC_OFF); const unsigned now_ = (unsigned)__builtin_amdgcn_s_memrealtime(); M_[16 + 12] += now_ - M_[15]; M_[15] = now_; }
#endif
        {
            const bf16x8 vb0 = tr8(VT, SC_VS, 0, 16 * vt, lane), vb1 = tr8(VT, SC_VS, 32, 16 * vt, lane);
            bf16x8 sb[4];
#pragma unroll
            for (int ks = 0; ks < 4; ++ks) sb[ks] = tr8(SB, SC_VS, 32 * ks, 16 * vt, lane);
            bf16x8 nb[4];
            if (ML) {
#pragma unroll
                for (int ks = 0; ks < 4; ++ks) nb[ks] = *(const LAS bf16x8*)(lds + SC_NB + buf * 256 + (32 * ks + 8 * fq) * 2);
            }
            u32x2 ow[2];
#pragma unroll
            for (int tj = 0; tj < 2; ++tj) {
                const int ti = 2 * hh + tj;
                f32x4 acc = {0.f, 0.f, 0.f, 0.f}, den = {0.f, 0.f, 0.f, 0.f};
                bf16x8 qa[4];
#pragma unroll
                for (int ks = 0; ks < 4; ++ks) qa[ks] = *(const LAS bf16x8*)(QT + (16 * ti + fr) * SC_QS + (32 * ks + 8 * fq) * 2);
                const bf16x8 aa0 = *(const LAS bf16x8*)(AT + (16 * ti + fr) * SC_VS + (8 * fq) * 2), aa1 = *(const LAS bf16x8*)(AT + (16 * ti + fr) * SC_VS + (32 + 8 * fq) * 2);
                asm volatile("" ::: "memory");
#pragma unroll
                for (int ks = 0; ks < 4; ++ks) {
                    acc = __builtin_amdgcn_mfma_f32_16x16x32_bf16(sb[ks], qa[ks], acc, 0, 0, 0);
                    if (ML) den = __builtin_amdgcn_mfma_f32_16x16x32_bf16(nb[ks], qa[ks], den, 0, 0, 0);
                }
                acc = __builtin_amdgcn_mfma_f32_16x16x32_bf16(vb0, aa0, acc, 0, 0, 0);
                acc = __builtin_amdgcn_mfma_f32_16x16x32_bf16(vb1, aa1, acc, 0, 0, 0);
                if (ML) {
                    den = __builtin_amdgcn_mfma_f32_16x16x32_bf16(ones, aa0, den, 0, 0, 0);
                    den = __builtin_amdgcn_mfma_f32_16x16x32_bf16(ones, aa1, den, 0, 0, 0);
                    const float rd = __builtin_amdgcn_rcpf(fmaxf(fabsf(den.x), 1.f));
                    acc *= rd;
                }
                ow[tj].x = pk2(acc.x, acc.y); ow[tj].y = pk2(acc.z, acc.w);
            }
            if (c + 1 < 33) SCAN_STORE(buf ^ 1);
#pragma unroll
            for (int tj = 0; tj < 2; ++tj) {
                const int t = 16 * (2 * hh + tj) + fr;
                const bool okr = c > 0 || t >= 48;
                const int rowb = c == 0 ? MR + t - 48 : b * SEQ + (c - 1) * 64 + t;
                bf16* op = okr ? O + (size_t)rowb * 1024 + h * 256 + vs * 64 + 16 * vt + 4 * fq : (bf16*)(ws + WS_BIN + 512 * 1024) + (size_t)tid * 4;
                *(u32x2*)op = ow[tj];
            }
        }
        LDS_BARRIER();
#if defined(DIAG_SEL)
        if (blockIdx.x == 0 && tid == 0) { volatile LAS unsigned* M_ = (volatile LAS unsigned*)(lds + MISC_OFF); const unsigned now_ = (unsigned)__builtin_amdgcn_s_memrealtime(); M_[16 + 13] += now_ - M_[15]; M_[15] = now_; }
#endif
    }
#undef SCAN_LOAD
#undef SCAN_STORE
}

template <bool DRY = false>
__device__ __forceinline__ void p6_headnorm(ArgsP a, int l, int gw, int ngw, int lane) {
    unsigned char* ws = a->ws; const bf16* Z = (const bf16*)(ws + WS_Z);
    const f32x4 gg0 = *(const f32x4*)(a->in[I_GGLA] + l * 256 + 4 * lane), gg1 = *(const f32x4*)(a->in[I_GML] + l * 256 + 4 * lane);
    for (int it0 = gw * 4; it0 < MT * 8; it0 += ngw * 4) {
        u32x2 w[4], gw2[4]; bf16* op[4];
#pragma unroll
        for (int i = 0; i < 4; ++i) { const int it = it0 + i, r = it >> 3, mx = (it >> 2) & 1, h = it & 3;
            op[i] = (bf16*)(ws + (mx ? WS_OM : WS_OG)) + (size_t)r * 1024 + h * 256 + 4 * lane;
            w[i] = *(const u32x2*)op[i];
            gw2[i] = *(const u32x2*)(Z + (size_t)r * ZB + (mx ? ZC_MO : ZC_GR) + h * 256 + 4 * lane); }
        f32x4 v[4]; float ss[4];
#pragma unroll
        for (int i = 0; i < 4; ++i) { v[i] = (f32x4){bflo(w[i].x), bfhi(w[i].x), bflo(w[i].y), bfhi(w[i].y)}; ss[i] = (v[i].x * v[i].x + v[i].y * v[i].y) + (v[i].z * v[i].z + v[i].w * v[i].w); }
#pragma unroll
        for (int o = 1; o < 64; o <<= 1) {
#pragma unroll
            for (int i = 0; i < 4; ++i) ss[i] += __shfl_xor(ss[i], o);
        }
#pragma unroll
        for (int i = 0; i < 4; ++i) {
            const int mx = ((it0 + i) >> 2) & 1;
            const float rr = rsqrtf(ss[i] * (1.f / 256.f) + EPS);
            const f32x4 gt = {bflo(gw2[i].x), bfhi(gw2[i].x), bflo(gw2[i].y), bfhi(gw2[i].y)};
            const f32x4 o4 = v[i] * rr * (mx ? gg1 : gg0) * gt;
            u32x2 o; o.x = pk2(o4.x, o4.y); o.y = pk2(o4.z, o4.w);
            *(u32x2*)(DRY ? (bf16*)(ws + WS_XN) + ((size_t)((it0 + i) >> 3) * 1024 + ((it0 + i) & 3) * 256 + 4 * lane) : op[i]) = o;
        }
    }
}

__device__ __forceinline__ int krow(int b, int s) { return s < NMETA ? MR + s : b * SEQ + (s - NMETA); }
__device__ __forceinline__ int t5_bucket(int n) {
    if (n < 16) return n < 0 ? 0 : n;
    const int lg = 16 + (int)(__logf((float)n * (1.f / 16.f)) / 2.0794415416798357f * 16.f);
    return lg < 31 ? lg : 31;
}
__device__ __forceinline__ unsigned off_b(unsigned row, unsigned ch) { return 256u * row + 16u * (ch ^ (((row & 3) << 2) | ((row >> 2) & 3))); }
__device__ __forceinline__ s16x4 tr_rd(LAS unsigned char* p) { return __builtin_amdgcn_ds_read_tr16_b64_v4i16((LAS s16x4*)p); }

constexpr int DW2_STRIDE = 9472, DW2_TILE = 0, DW2_SEL = 8192, DW2_BK = 8832, DSA2_T5 = 8 * DW2_STRIDE, DSA2_BT = DSA2_T5 + 2048 + 64;

__device__ __forceinline__ int wave_sum_dpp(int x) {
    x += __builtin_amdgcn_update_dpp(0, x, 0xB1, 0xf, 0xf, false);
    x += __builtin_amdgcn_update_dpp(0, x, 0x4E, 0xf, 0xf, false);
    x += __builtin_amdgcn_update_dpp(0, x, 0x141, 0xf, 0xf, false);
    x += __builtin_amdgcn_update_dpp(0, x, 0x140, 0xf, 0xf, false);
    return __builtin_amdgcn_readlane(x, 0) + __builtin_amdgcn_readlane(x, 16) + __builtin_amdgcn_readlane(x, 32) + __builtin_amdgcn_readlane(x, 48);
}
__device__ __forceinline__ int wave_scan_dpp(int x) {
    x += __builtin_amdgcn_update_dpp(0, x, 0x111, 0xf, 0xf, false);
    x += __builtin_amdgcn_update_dpp(0, x, 0x112, 0xf, 0xf, false);
    x += __builtin_amdgcn_update_dpp(0, x, 0x114, 0xf, 0xf, false);
    x += __builtin_amdgcn_update_dpp(0, x, 0x118, 0xf, 0xf, false);
    x += __builtin_amdgcn_update_dpp(0, x, 0x142, 0xa, 0xf, false);
    x += __builtin_amdgcn_update_dpp(0, x, 0x143, 0xc, 0xf, false);
    return x;
}
#if defined(DIAG_SEL)
#ifndef DIAG_BLK
#define DIAG_BLK 31
#endif
#define DSTAMP(slot) do { if (blockIdx.x == DIAG_BLK && threadIdx.x == 0) { volatile LAS unsigned* M_ = (volatile LAS unsigned*)(lds + MISC_OFF); const unsigned now_ = (unsigned)__builtin_amdgcn_s_memrealtime(); M_[slot] += now_ - M_[14]; M_[14] = now_; } } while (0)
#else
#define DSTAMP(slot) do {} while (0)
#endif
template <int NR>
__device__ __forceinline__ void dsa_select(const unsigned* scr, int nk, int p, int lane, LAS unsigned char* lds, LAS unsigned char* tile, LAS unsigned short* selL, LAS unsigned short* bkL, const LAS unsigned short* bkT) {
    unsigned u[NR];
#pragma unroll
    for (int i = 0; i < NR; ++i) { const int s = lane + 64 * i; u[i] = s < nk ? __hip_atomic_load(scr + s, __ATOMIC_RELAXED, __HIP_MEMORY_SCOPE_AGENT) : 0u; }
    {

            unsigned tau = 0u;
            for (int bit = 31; bit >= 16; --bit) {
                const unsigned cand = tau | (1u << bit);
                int cnt = 0;
#pragma unroll
                for (int i = 0; i < NR; ++i) cnt += (u[i] >= cand) ? 1 : 0;
                if (wave_sum_dpp(cnt) >= 256) tau = cand;
            }
            DSTAMP(16);
            {
                const unsigned hi = tau >> 16;
                int cab = 0, cc = 0;
#pragma unroll
                for (int i = 0; i < NR; ++i) { const unsigned uh = u[i] >> 16; cab += (uh > hi) ? 1 : 0; cc += (uh == hi) ? 1 : 0; }
                cab = wave_sum_dpp(cab);
                const int cin = wave_scan_dpp(cc);
                const int ncand = __builtin_amdgcn_readlane(cin, 63);
                LAS unsigned short* candL = (LAS unsigned short*)tile;
                int off = cin - cc;
#pragma unroll
                for (int i = 0; i < NR; ++i) { const bool is = (u[i] >> 16) == hi; candL[is ? off : 3072 + lane] = (unsigned short)(u[i] & 0xffffu); off += is ? 1 : 0; }
                LDS_WAIT();
                const int need = 256 - cab;
                unsigned lo = 0u;
                if (ncand <= 64) {
                    const unsigned v = lane < ncand ? (unsigned)candL[lane] + 1u : 0u;
                    for (int bit = 15; bit >= 0; --bit) { const unsigned cand = lo | (1u << bit); if (__popcll(__ballot(v >= cand + 1u)) >= need) lo = cand; }
                } else {
                    for (int bit = 15; bit >= 0; --bit) {
                        const unsigned cand = lo | (1u << bit); int cnt = 0;
                        for (int j = lane; j < ((ncand + 63) & ~63); j += 64) { const unsigned v = j < ncand ? (unsigned)candL[j] + 1u : 0u; cnt += __popcll(__ballot(v >= cand + 1u)); }
                        if (cnt >= need) lo = cand;
                    }
                }
                tau |= lo;
                LDS_WAIT();
            }
            DSTAMP(17);
            unsigned short bkv[NR];
#pragma unroll
            for (int i = 0; i < NR; ++i) { const int d = p - (lane + 64 * i); bkv[i] = bkT[d > 0 ? d : 0]; }
            int cge = 0, ceq = 0;
#pragma unroll
            for (int i = 0; i < NR; ++i) { cge += (u[i] >= tau) ? 1 : 0; ceq += (u[i] == tau) ? 1 : 0; }
            const int tge = wave_sum_dpp(cge);
            if (tge == 256) {
                const int cin = wave_scan_dpp(cge);
                int off = cin - cge;
#pragma unroll
                for (int i = 0; i < NR; ++i) { const bool take = u[i] >= tau; const int pos = take ? off : 256 + lane;
                    selL[pos] = (unsigned short)(lane + 64 * i); bkL[pos] = bkv[i]; off += take ? 1 : 0; }
            } else {
                const int rem = 256 - (tge - wave_sum_dpp(ceq));
                const unsigned long long lt = (1ull << lane) - 1ull;
                int base = 0, eqseen = 0;
#pragma unroll
                for (int i = 0; i < NR; ++i) {
                    const bool gt = u[i] > tau, eq = u[i] == tau;
                    const unsigned long long meq = __ballot(eq);
                    const bool take = gt || (eq && (eqseen + __popcll(meq & lt)) < rem);
                    const unsigned long long mt = __ballot(take);
                    const int pos = take ? base + __popcll(mt & lt) : 256 + lane;
                    selL[pos] = (unsigned short)(lane + 64 * i); bkL[pos] = bkv[i];
                    base += __popcll(mt); eqseen += __popcll(meq);
                }
            }
    }
}
struct DsaGeom {
    int b, cA, hf;
    __device__ __forceinline__ int chunk(int qt) const { return qt < 2 ? cA : 31 - cA; }
    __device__ __forceinline__ int pos0(int qt) const { return NMETA + 64 * chunk(qt) + 32 * hf + 16 * (qt & 1); }
    __device__ __forceinline__ int row0(int qt) const { return b * SEQ + 64 * chunk(qt) + 32 * hf + 16 * (qt & 1); }
};
template <bool DENSE_ONLY>
__device__ __forceinline__ void dsa_unit(ArgsP a, LAS unsigned char* lds, int u_, int nq, int wave, int lane_in) {
    int lane = lane_in; asm volatile("" : "+v"(lane));
    unsigned char* ws = a->ws;
    const bf16* QQ = (const bf16*)(ws + WS_QQ); const bf16* KI = (const bf16*)(ws + WS_KI); const bf16* KV = (const bf16*)(ws + WS_KV);
    unsigned* SC = (unsigned*)(ws + WS_SC) + (size_t)blockIdx.x * 64 * SC_PITCH;
    const DsaGeom G{u_ >> 5, (u_ & 31) >> 1, u_ & 1};
    const int b = DENSE_ONLY ? 0 : G.b;
    const int fr = lane & 15, fq = lane >> 4;
    if (!DENSE_ONLY) {
        int nt[4], T = 0;
#pragma unroll
        for (int qt = 0; qt < 4; ++qt) { nt[qt] = G.pos0(qt) + 15 >= 256 ? G.pos0(qt) / 16 + 1 : 0; T += nt[qt]; }
        const int lo = wave * T / 8, hi = (wave + 1) * T / 8;
        int base = 0;
        for (int qt = 0; qt < 4; ++qt) {
            const int ntq = qt == 0 ? nt[0] : qt == 1 ? nt[1] : qt == 2 ? nt[2] : nt[3];
            const int k0 = lo > base ? lo - base : 0, k1 = hi - base < ntq ? hi - base : ntq;
            base += ntq;
            if (k0 >= k1) continue;
            const int qrow = G.row0(qt) + fr, pq = G.pos0(qt) + fr;
            bf16x8 qf[8][2];
#pragma unroll
            for (int h = 0; h < 8; ++h)
#pragma unroll
                for (int ks = 0; ks < 2; ++ks) qf[h][ks] = *(const bf16x8*)(QQ + (size_t)qrow * NQQ + 2048 + h * 64 + ks * 32 + 8 * fq);
            float wi[8];
            { const f32x4 w0 = *(const f32x4*)((const float*)(ws + WS_WI) + (size_t)qrow * 8), w1 = *(const f32x4*)((const float*)(ws + WS_WI) + (size_t)qrow * 8 + 4);
              wi[0] = w0.x; wi[1] = w0.y; wi[2] = w0.z; wi[3] = w0.w; wi[4] = w1.x; wi[5] = w1.y; wi[6] = w1.z; wi[7] = w1.w; }
            unsigned* scq = SC + (size_t)(16 * qt + fr) * SC_PITCH + 4 * fq;
            bf16x8 pa0[4], pa1[4];
#define DSA_KLOAD(kt0_) do { _Pragma("unroll") for (int j = 0; j < 4; ++j) { const int kt_ = (kt0_) + j < k1 ? (kt0_) + j : k1 - 1; \
                const bf16* kp_ = KI + (size_t)krow(b, 16 * kt_ + fr) * 64 + 8 * fq; pa0[j] = *(const bf16x8*)kp_; pa1[j] = *(const bf16x8*)(kp_ + 32); } } while (0)
            DSA_KLOAD(k0);
            for (int kt0 = k0; kt0 < k1; kt0 += 4) {
                bf16x8 a0[4], a1[4];
#pragma unroll
                for (int j = 0; j < 4; ++j) { a0[j] = pa0[j]; a1[j] = pa1[j]; }
                if (kt0 + 4 < k1) DSA_KLOAD(kt0 + 4);
#pragma unroll
                for (int j = 0; j < 4; ++j) {
                    const int kt = kt0 + j;
                    float s0 = 0.f, s1 = 0.f, s2 = 0.f, s3 = 0.f;
#pragma unroll
                    for (int h = 0; h < 8; ++h) {
                        f32x4 acc = {0.f, 0.f, 0.f, 0.f};
                        acc = __builtin_amdgcn_mfma_f32_16x16x32_bf16(a0[j], qf[h][0], acc, 0, 0, 0);
                        acc = __builtin_amdgcn_mfma_f32_16x16x32_bf16(a1[j], qf[h][1], acc, 0, 0, 0);
                        s0 += wi[h] * fmaxf(acc.x, 0.f); s1 += wi[h] * fmaxf(acc.y, 0.f); s2 += wi[h] * fmaxf(acc.z, 0.f); s3 += wi[h] * fmaxf(acc.w, 0.f);
                    }
                    const int kb = 16 * kt + 4 * fq;
                    u32x4 o;
                    { const unsigned bits = __builtin_bit_cast(unsigned, s0); o.x = (kb + 0) <= pq ? (bits ^ ((bits >> 31) ? 0xffffffffu : 0x80000000u)) : 0u; }
                    { const unsigned bits = __builtin_bit_cast(unsigned, s1); o.y = (kb + 1) <= pq ? (bits ^ ((bits >> 31) ? 0xffffffffu : 0x80000000u)) : 0u; }
                    { const unsigned bits = __builtin_bit_cast(unsigned, s2); o.z = (kb + 2) <= pq ? (bits ^ ((bits >> 31) ? 0xffffffffu : 0x80000000u)) : 0u; }
                    { const unsigned bits = __builtin_bit_cast(unsigned, s3); o.w = (kb + 3) <= pq ? (bits ^ ((bits >> 31) ? 0xffffffffu : 0x80000000u)) : 0u; }
                    if (kt < k1) *(u32x4*)(scq + 16 * kt) = o;
                }
            }
#undef DSA_KLOAD
        }
        VM_WAIT();
        __syncthreads();
        DSTAMP(24);
    }
    LAS unsigned char* wl = lds + wave * DW2_STRIDE;
    LAS unsigned char* tile = wl + DW2_TILE;
    LAS unsigned short* selL = (LAS unsigned short*)(wl + DW2_SEL);
    LAS unsigned short* bkL = (LAS unsigned short*)(wl + DW2_BK);
    const LAS float* t5L = (const LAS float*)(lds + DSA2_T5);
    const LAS unsigned short* bkT = (const LAS unsigned short*)(lds + DSA2_BT);
    const int nqw = DENSE_ONLY ? 2 : 8;
    for (int qi_ = 0; qi_ < nqw; ++qi_) {
        asm volatile("" : "+v"(lane));
        const int iq = DENSE_ONLY ? wave * 2 + qi_ : wave + 8 * qi_;
        if (iq >= nq) break;
        const int p = DENSE_ONLY ? iq : G.pos0(iq >> 4) + (iq & 15), nk = p + 1, qrow = DENSE_ONLY ? MR + iq : G.row0(iq >> 4) + (iq & 15);
        int nsel;
        if (!DENSE_ONLY && nk > 256) {
            const unsigned* scr = SC + (size_t)iq * SC_PITCH;
            const int nreg = (nk + 63) >> 6;
            if (nreg <= 9) dsa_select<9>(scr, nk, p, lane, lds, tile, selL, bkL, bkT);
            else if (nreg <= 17) dsa_select<17>(scr, nk, p, lane, lds, tile, selL, bkL, bkT);
            else if (nreg <= 25) dsa_select<25>(scr, nk, p, lane, lds, tile, selL, bkL, bkT);
            else dsa_select<33>(scr, nk, p, lane, lds, tile, selL, bkL, bkT);
            nsel = 256;
        } else {
#pragma unroll
            for (int m = 0; m < 4; ++m) { const int s = lane + 64 * m; selL[s] = (unsigned short)(s < nk ? s : 0); bkL[s] = bkT[s < nk ? p - s : 0]; }
            nsel = nk;
        }
        DSTAMP(25);
        asm volatile("" : "+v"(lane));
        bf16x8 qB[4];
#pragma unroll
        for (int ks = 0; ks < 4; ++ks) qB[ks] = *(const bf16x8*)(QQ + (size_t)qrow * NQQ + fr * 128 + ks * 32 + 8 * fq);
        LDS_WAIT();
        f32x4 O[8];
#pragma unroll
        for (int nt = 0; nt < 8; ++nt) O[nt] = (f32x4){0.f, 0.f, 0.f, 0.f};
        float qss = 0.f;
#pragma unroll
        for (int ks = 0; ks < 4; ++ks) { const u32x4 w = __builtin_bit_cast(u32x4, qB[ks]);
            qss += (bflo(w.x) * bflo(w.x) + bfhi(w.x) * bfhi(w.x)) + (bflo(w.y) * bflo(w.y) + bfhi(w.y) * bfhi(w.y)) + (bflo(w.z) * bflo(w.z) + bfhi(w.z) * bfhi(w.z)) + (bflo(w.w) * bflo(w.w) + bfhi(w.w) * bfhi(w.w)); }
        qss += __shfl_xor(qss, 16); qss += __shfl_xor(qss, 32);
        const float mb = sqrtf(qss) * t5L[512] + t5L[513];
        float lrun = 0.f;
        const int nblk = (nsel + 31) >> 5;
#define DSA_GATHER(GV, blk_) do { _Pragma("unroll") for (int e = 0; e < 8; ++e) { const int pid = lane + 64 * e, ri = pid >> 4, ch = pid & 15, j = 32 * (blk_) + ri; \
            const int key = (int)selL[j]; GV[e] = *(const u32x4*)(KV + (size_t)krow(b, key) * 128 + ch * 8); } } while (0)
#define DSA_PUT(GV) do { _Pragma("unroll") for (int e = 0; e < 8; ++e) { const int pid = lane + 64 * e, ri = pid >> 4, ch = pid & 15; *(LAS u32x4*)(tile + off_b(ri, ch)) = GV[e]; } } while (0)
        u32x4 gvA[8], gvB[8];
        DSA_GATHER(gvA, 0);
        if (nblk > 1) DSA_GATHER(gvB, 1);
        for (int blk0 = 0; blk0 < nblk; blk0 += 2) {
#pragma unroll
            for (int half = 0; half < 2; ++half) {
                const int blk = blk0 + half;
                if (blk < nblk) {
                    if (half == 0) { DSA_PUT(gvA); if (blk + 2 < nblk) DSA_GATHER(gvA, blk + 2); }
                    else { DSA_PUT(gvB); if (blk + 2 < nblk) DSA_GATHER(gvB, blk + 2); }
                    LDS_WAIT();
                    f32x4 s0 = {0.f, 0.f, 0.f, 0.f}, s1 = {0.f, 0.f, 0.f, 0.f};
        #pragma unroll
                    for (int ks = 0; ks < 4; ++ks) {
                        const bf16x8 k0 = *(const LAS bf16x8*)(tile + off_b(fr, 4 * ks + fq)), k1 = *(const LAS bf16x8*)(tile + off_b(16 + fr, 4 * ks + fq));
                        s0 = __builtin_amdgcn_mfma_f32_16x16x32_bf16(k0, qB[ks], s0, 0, 0, 0);
                        s1 = __builtin_amdgcn_mfma_f32_16x16x32_bf16(k1, qB[ks], s1, 0, 0, 0);
                    }
                    const int j0 = 32 * blk + 4 * fq;
                    const u32x2 b0 = *(const LAS u32x2*)(bkL + j0), b1 = *(const LAS u32x2*)(bkL + j0 + 16);
                    const float t00 = t5L[(b0.x & 0xffffu) + fr], t01 = t5L[(b0.x >> 16) + fr], t02 = t5L[(b0.y & 0xffffu) + fr], t03 = t5L[(b0.y >> 16) + fr];
                    const float t10 = t5L[(b1.x & 0xffffu) + fr], t11 = t5L[(b1.x >> 16) + fr], t12 = t5L[(b1.y & 0xffffu) + fr], t13 = t5L[(b1.y >> 16) + fr];
                    const float e00 = __expf(s0.x + t00 - mb), e01 = __expf(s0.y + t01 - mb), e02 = __expf(s0.z + t02 - mb), e03 = __expf(s0.w + t03 - mb);
                    const float e10 = __expf(s1.x + t10 - mb), e11 = __expf(s1.y + t11 - mb), e12 = __expf(s1.z + t12 - mb), e13 = __expf(s1.w + t13 - mb);
                    const float p00 = (j0 + 0) < nsel ? e00 : 0.f, p01 = (j0 + 1) < nsel ? e01 : 0.f, p02 = (j0 + 2) < nsel ? e02 : 0.f, p03 = (j0 + 3) < nsel ? e03 : 0.f;
                    const float p10 = (j0 + 16) < nsel ? e10 : 0.f, p11 = (j0 + 17) < nsel ? e11 : 0.f, p12 = (j0 + 18) < nsel ? e12 : 0.f, p13 = (j0 + 19) < nsel ? e13 : 0.f;
                    lrun += ((p00 + p01) + (p02 + p03)) + ((p10 + p11) + (p12 + p13));
                    u32x4 pw; pw.x = pk2(p00, p01); pw.y = pk2(p02, p03); pw.z = pk2(p10, p11); pw.w = pk2(p12, p13);
                    const bf16x8 pa = __builtin_bit_cast(bf16x8, pw);
                    const unsigned q4 = (unsigned)(fr >> 2), p4 = (unsigned)(lane & 3);
        #pragma unroll
                    for (int nt = 0; nt < 8; ++nt) {
                        const s16x4 vlo = tr_rd(tile + off_b(4 * fq + q4, 2 * nt + (p4 >> 1)) + 8 * (p4 & 1));
                        const s16x4 vhi = tr_rd(tile + off_b(16 + 4 * fq + q4, 2 * nt + (p4 >> 1)) + 8 * (p4 & 1));
                        const bf16x8 vb = __builtin_shufflevector(vlo, vhi, 0, 1, 2, 3, 4, 5, 6, 7);
                        O[nt] = __builtin_amdgcn_mfma_f32_16x16x32_bf16(pa, vb, O[nt], 0, 0, 0);
                    }

                }
            }
        }
#undef DSA_GATHER
#undef DSA_PUT
        float lt2 = lrun + __shfl_xor(lrun, 16); lt2 += __shfl_xor(lt2, 32);
        const float inv = 1.f / lt2;
        float ir[4];
#pragma unroll
        for (int r = 0; r < 4; ++r) ir[r] = __shfl(inv, 4 * fq + r);
        bf16* od = (bf16*)(ws + WS_OD) + (size_t)qrow * 1024 + fr;
#pragma unroll
        for (int nt = 0; nt < 8; ++nt)
#pragma unroll
            for (int r = 0; r < 4; ++r) { const int hd = 4 * fq + r; od[(size_t)(hd >> 3) * MT * 1024 + (hd & 7) * 128 + 16 * nt] = (bf16)f2bf(O[nt][r] * ir[r]); }
        LDS_WAIT();
        DSTAMP(26);
    }
}
__device__ __forceinline__ void p5_dsa(ArgsP a, LAS unsigned char* lds, int l, int tid, int wave, int lane) {
    LAS float* t5L = (LAS float*)(lds + DSA2_T5);
    __syncthreads();
    t5L[tid] = a->in[I_T5][tid];
    for (int n = tid; n < TT; n += 512) ((LAS unsigned short*)(lds + DSA2_BT))[n] = (unsigned short)(t5_bucket(n) * 16);
    if (tid < 64) {
        const float g0 = fabsf(a->in[I_GDKV][l * 128 + tid]), g1 = fabsf(a->in[I_GDKV][l * 128 + 64 + tid]);
        const float gm = wave_max(fmaxf(g0, g1));
        float tm = 0.f;
#pragma unroll
        for (int i = 0; i < 8; ++i) tm = fmaxf(tm, fabsf(a->in[I_T5][tid + 64 * i]));
        tm = wave_max(tm);
        if (tid == 0) { t5L[512] = 11.313708498984761f * gm; t5L[513] = tm; }
    }
    __syncthreads();
    for (int u = blockIdx.x; u < 256; u += gridDim.x) {
        dsa_unit<false>(a, lds, u, 64, wave, lane);
        __syncthreads();
    }
    if (blockIdx.x == 0) dsa_unit<true>(a, lds, 0, 16, wave, lane);
}

__global__ void __launch_bounds__(NWAVES * 64, 2) fwd(Args a_) {
    extern __shared__ __attribute__((aligned(16))) unsigned char lds_raw[];
    LAS unsigned char* lds = (LAS unsigned char*)lds_raw;
    volatile LAS unsigned* MISC = (volatile LAS unsigned*)(lds + MISC_OFF);
    if (threadIdx.x < 32) MISC[threadIdx.x] = 0u;
    __syncthreads();
    const int g_lo = a_.g_lo, g_hi = a_.g_hi, l_lo = a_.l_lo, l_hi = a_.l_hi, ph_lo = a_.ph_lo, ph_hi = a_.ph_hi, use_bar = a_.use_bar;
    XcdBarrier bar; bar.bar = (unsigned*)(a_.ws + WS_CTL) + CW_BAR; bar.x = 0; bar.st = nullptr;
    if (use_bar) bar = xcd_barrier_post((unsigned*)(a_.ws + WS_CTL) + CW_BAR, MISC + 8);
#if defined(DIAG_SEL)
#ifndef DIAG_BLK
#define DIAG_BLK 31
#endif
    int diag_site = 0; if (threadIdx.x == 0) MISC[15] = (unsigned)__builtin_amdgcn_s_memrealtime();
#define DIAG_STAMP(site) do { if (blockIdx.x == 0 && threadIdx.x == 0) { const unsigned now_ = (unsigned)__builtin_amdgcn_s_memrealtime(); MISC[16 + (site)] += now_ - MISC[15]; MISC[15] = now_; } } while (0)
#define GRID_BAR() do { if (use_bar) xcd_barrier(bar); DIAG_STAMP(diag_site); ++diag_site; } while (0)
#else
#define GRID_BAR() do { if (use_bar) xcd_barrier(bar); } while (0)
#endif
#ifndef PHMASK
#define PHMASK 0xFFFF
#endif
#ifndef PROBE_PH
#define PROBE_PH -1
#endif
#ifndef FUSE_NORM
#define FUSE_NORM 0
#endif
#ifndef PROBE_MASK
#define PROBE_MASK 0
#endif
#define PROBED(k) ((PROBE_MASK >> (k)) & 1)
#ifndef P1_ALIGN
#define P1_ALIGN true
#endif
#define PH(k) (((PHMASK >> (k)) & 1) && ph_lo <= (k) && (k) < ph_hi)
#define PBEGIN ArgsP a = (ArgsP)__builtin_amdgcn_kernarg_segment_ptr(); asm volatile("" : "+s"(a)); unsigned char* ws = a->ws; \
    int tid_ = threadIdx.x; asm volatile("" : "+v"(tid_)); const int tid = tid_, lane = tid & 63, wave = __builtin_amdgcn_readfirstlane(tid >> 6); const int gw = blockIdx.x * NWAVES + wave, ngw = gridDim.x * NWAVES; (void)ws; (void)gw; (void)ngw; (void)lane;

#if defined(DIAG_SEL)
    diag_site = 15;
#endif
    if (((PHMASK >> 13) & 1) && a_.prep) { PBEGIN prep_weights(a, lds, gw, ngw, wave, lane); GRID_BAR(); }

    for (int g = g_lo; g < g_hi; ++g) {
        for (int l = l_lo; l < l_hi; ++l) {
#if defined(DIAG_SEL)
            diag_site = (l == 0) ? 0 : 1;
#endif
            if (PH(0) && l == 0) { PBEGIN p0_init(a, g, gw, ngw, lane); GRID_BAR(); }
            if (PH(1)) { PBEGIN
                FIn f{(bf16*)(ws + WS_Z), (float*)(ws + WS_ZF), (const float*)(ws + WS_BIN) + l * NZ};
                run_gemm<FIn, P1_ALIGN>(lds, (const bf16*)(ws + WS_XN), (const bf16*)(ws + WS_WIN) + (size_t)l * NZ * D, NZ, D, f, gw, ngw, lane);
                if (PROBED(1)) { run_gemm(lds, (const bf16*)(ws + WS_XN), (const bf16*)(ws + WS_WIN) + (size_t)l * NZ * D, NZ, D, f, gw, ngw, lane); }
                GRID_BAR();
            }
            if (PH(2)) {
                { PBEGIN p2_prep(a, l, gw, ngw, lane); }
#if defined(DIAG_SEL)
                __syncthreads(); DIAG_STAMP(14);
#endif
                { PBEGIN __syncthreads(); p2_chunks(a, lds, l, gw, ngw, wave, lane); }
                GRID_BAR();
            }
            if (PH(3)) { PBEGIN
                FQQ f{(bf16*)(ws + WS_QQ)};
                run_gemm(lds, (const bf16*)(ws + WS_CQN), (const bf16*)(ws + WS_WQQ) + (size_t)l * NQQ * 256, NQQ, 256, f, gw, ngw, lane);
                if (PROBED(3)) { run_gemm(lds, (const bf16*)(ws + WS_CQN), (const bf16*)(ws + WS_WQQ) + (size_t)l * NQQ * 256, NQQ, 256, f, gw, ngw, lane); }
            }
#if defined(DIAG_SEL)
            __syncthreads(); DIAG_STAMP(11);
#endif
            if (PH(4)) { PBEGIN
                for (int u = blockIdx.x; u < 256; u += gridDim.x) {
                    const int b = (u >> 4) & 7, h = (u >> 2) & 3, vs = u & 3;
                    if (u >> 7) scan_unit<true>(a, lds, b, h, vs, tid); else scan_unit<false>(a, lds, b, h, vs, tid);
                }
#if PROBE_PH == 4
                for (int u = blockIdx.x; u < 256; u += gridDim.x) {
                    const int b = (u >> 4) & 7, h = (u >> 2) & 3, vs = u & 3;
                    if (u >> 7) scan_unit<true>(a, lds, b, h, vs, tid); else scan_unit<false>(a, lds, b, h, vs, tid);
                }
#endif
                GRID_BAR();
            }
#if defined(DIAG_SEL)
            if (blockIdx.x == DIAG_BLK && threadIdx.x == 0) MISC[14] = (unsigned)__builtin_amdgcn_s_memrealtime();
#endif
            if (PH(5)) { PBEGIN p5_dsa(a, lds, l, tid, wave, lane); }
#if defined(DIAG_SEL)
            __syncthreads(); DSTAMP(27);
#endif
#if PROBE_PH == 5
            if (PH(5)) { PBEGIN p5_dsa(a, lds, l, tid, wave, lane); }
#endif
            if (PH(6)) { PBEGIN p6_headnorm(a, l, gw, ngw, lane); if (PROBED(6)) p6_headnorm<true>(a, l, gw, ngw, lane);
#if defined(DIAG_SEL)
                DSTAMP(28);
#endif
                GRID_BAR();
#if defined(DIAG_SEL)
                DSTAMP(29);
#endif
            }
            if (PH(7)) {
                __syncthreads();
                { PBEGIN
                  const bf16* OD0 = (const bf16*)(ws + WS_OD); const bf16* OD1 = OD0 + (size_t)MT * 1024;
                  const bf16* WB0 = (const bf16*)(ws + WS_WBD) + (size_t)l * D * 2048; const bf16* WB1 = WB0 + (size_t)D * D;
                  int Kc = D, Nc = D; asm volatile("" : "+s"(Kc)); asm volatile("" : "+s"(Nc));
                  pg8::Gemm g{(const bf16*)(ws + WS_OG), (const bf16*)(ws + WS_WBG) + (size_t)l * D * D, MR, Nc, Kc, OD0, OD1, (const bf16*)(ws + WS_OM), WB0, WB1, (const bf16*)(ws + WS_WBM) + (size_t)l * D * D};
                  ChainOrder S; S.S.init(MR, Nc, (int)gridDim.x, (int)blockIdx.x);
                  EpiMix E{(const bf16*)(ws + WS_Z), (bf16*)(ws + WS_MIX)};
                  pg8::gemm_phase<EpiMix, ChainOrder, true, true, true>((PG8_LAS unsigned char*)lds, g, S, E);
                  FBr<0> f0{(const bf16*)(ws + WS_Z), (float*)(ws + WS_Y), (bf16*)(ws + WS_MIX)};
                  mini_gemm(lds, (const bf16*)(ws + WS_OG), (const bf16*)(ws + WS_WBG) + (size_t)l * D * D, Nc, Kc, f0, (int)threadIdx.x);
                  FBr<1> f1{(const bf16*)(ws + WS_Z), (float*)(ws + WS_Y), (bf16*)(ws + WS_MIX)};
                  mini_gemm(lds, OD0, WB0, Nc, Kc, f1, (int)threadIdx.x);
                  mini_gemm(lds, OD1, WB1, Nc, Kc, f1, (int)threadIdx.x);
                  FBr<2> f2{(const bf16*)(ws + WS_Z), (float*)(ws + WS_Y), (bf16*)(ws + WS_MIX)};
                  mini_gemm(lds, (const bf16*)(ws + WS_OM), (const bf16*)(ws + WS_WBM) + (size_t)l * D * D, Nc, Kc, f2, (int)threadIdx.x);
                }
#if PROBED(7)
                { PBEGIN
                  const bf16* OD0 = (const bf16*)(ws + WS_OD); const bf16* OD1 = OD0 + (size_t)MT * 1024;
                  const bf16* WB0 = (const bf16*)(ws + WS_WBD) + (size_t)l * D * 2048; const bf16* WB1 = WB0 + (size_t)D * D;
                  int Kc = D, Nc = D; asm volatile("" : "+s"(Kc)); asm volatile("" : "+s"(Nc));
                  pg8::Gemm g{(const bf16*)(ws + WS_OG), (const bf16*)(ws + WS_WBG) + (size_t)l * D * D, MR, Nc, Kc, OD0, OD1, (const bf16*)(ws + WS_OM), WB0, WB1, (const bf16*)(ws + WS_WBM) + (size_t)l * D * D};
                  ChainOrder S; S.S.init(MR, Nc, (int)gridDim.x, (int)blockIdx.x);
                  EpiMix E{(const bf16*)(ws + WS_Z), (bf16*)(ws + WS_MIX)};
                  pg8::gemm_phase<EpiMix, ChainOrder, true, true, true>((PG8_LAS unsigned char*)lds, g, S, E);
                  FBr<0> f0{(const bf16*)(ws + WS_Z), (float*)(ws + WS_Y), (bf16*)(ws + WS_MIX)};
                  mini_gemm(lds, (const bf16*)(ws + WS_OG), (const bf16*)(ws + WS_WBG) + (size_t)l * D * D, Nc, Kc, f0, (int)threadIdx.x);
                  FBr<1> f1{(const bf16*)(ws + WS_Z), (float*)(ws + WS_Y), (bf16*)(ws + WS_MIX)};
                  mini_gemm(lds, OD0, WB0, Nc, Kc, f1, (int)threadIdx.x);
                  mini_gemm(lds, OD1, WB1, Nc, Kc, f1, (int)threadIdx.x);
                  FBr<2> f2{(const bf16*)(ws + WS_Z), (float*)(ws + WS_Y), (bf16*)(ws + WS_MIX)};
                  mini_gemm(lds, (const bf16*)(ws + WS_OM), (const bf16*)(ws + WS_WBM) + (size_t)l * D * D, Nc, Kc, f2, (int)threadIdx.x);
                }
#endif
                GRID_BAR();
            }
            if (PH(8)) { PBEGIN
                if (FUSE_NORM && gridDim.x == 256) {
                    int Kc = D, Nc = D; asm volatile("" : "+s"(Kc)); asm volatile("" : "+s"(Nc));
                    pg8::Gemm gg{(const bf16*)(ws + WS_MIX), (const bf16*)(ws + WS_WOUT) + (size_t)l * D * D, MR, Nc, Kc};
                    pg8::StaticOrder S; S.init(MR, Nc, (int)gridDim.x, (int)blockIdx.x);
                    unsigned* ctl = (unsigned*)(ws + WS_CTL); float* xb = (float*)(ws + WS_LIF);
                    const unsigned tgt = 32u * (unsigned)(g * NL + l + 1);
                    EpiResNorm E{a->out + (size_t)g * MR * D, (bf16*)(ws + WS_XN), a->in[I_GPOSTMIX] + l * D, a->in[I_GPREMLP] + l * D,
                                 RmsExchange{xb, ctl + CW_XCNT, ctl, tgt}, RmsExchange{xb + 65536, ctl + CW_XCNT + 4096, ctl, tgt}};
                    pg8::gemm_phase<EpiResNorm, pg8::StaticOrder, false, true>((PG8_LAS unsigned char*)lds, gg, S, E);
                    FY f{(bf16*)(ws + WS_Y)};
                    mini_gemm(lds, (const bf16*)(ws + WS_MIX), (const bf16*)(ws + WS_WOUT) + (size_t)l * D * D, Nc, Kc, f, (int)threadIdx.x);
                } else {
                    FY f{(bf16*)(ws + WS_Y)};
                    run_gemm(lds, (const bf16*)(ws + WS_MIX), (const bf16*)(ws + WS_WOUT) + (size_t)l * D * D, D, D, f, gw, ngw, lane);
                }
                GRID_BAR();
            }
            if (PH(9)) { PBEGIN p_norm_res(a, g, a->in[I_GPOSTMIX] + l * D, a->in[I_GPREMLP] + l * D, gw, ngw, lane, (FUSE_NORM && gridDim.x == 256) ? MR : 0); GRID_BAR(); }
            if (PH(10)) { PBEGIN
                FUp f{(bf16*)(ws + WS_Z)};
                run_gemm(lds, (const bf16*)(ws + WS_XN), (const bf16*)(ws + WS_WUP) + (size_t)l * DFF * D, DFF, D, f, gw, ngw, lane);
                if (PROBED(10)) { run_gemm(lds, (const bf16*)(ws + WS_XN), (const bf16*)(ws + WS_WUP) + (size_t)l * DFF * D, DFF, D, f, gw, ngw, lane); }
                GRID_BAR();
            }
            if (PH(11)) { PBEGIN
                if (FUSE_NORM && gridDim.x == 256) {
                    int Kc = DFF, Nc = D; asm volatile("" : "+s"(Kc)); asm volatile("" : "+s"(Nc));
                    pg8::Gemm gg{(const bf16*)(ws + WS_Z), (const bf16*)(ws + WS_WDN) + (size_t)l * D * DFF, MR, Nc, Kc};
                    pg8::StaticOrder S; S.init(MR, Nc, (int)gridDim.x, (int)blockIdx.x);
                    unsigned* ctl = (unsigned*)(ws + WS_CTL); float* xb = (float*)(ws + WS_LIF) + 2 * 65536;
                    const unsigned tgt = 32u * (unsigned)(g * NL + l + 1);
                    EpiResNorm E{a->out + (size_t)g * MR * D, (bf16*)(ws + WS_XN), a->in[I_GPOSTMLP] + l * D, l + 1 < NL ? a->in[I_GPREMIX] + (l + 1) * D : nullptr,
                                 RmsExchange{xb, ctl + CW_XCNT + 2 * 4096, ctl, tgt}, RmsExchange{xb + 65536, ctl + CW_XCNT + 3 * 4096, ctl, 32u * (unsigned)(g * (NL - 1) + l + 1)}};
                    pg8::gemm_phase<EpiResNorm, pg8::StaticOrder, false, true>((PG8_LAS unsigned char*)lds, gg, S, E);
                    FY f{(bf16*)(ws + WS_Y)};
                    mini_gemm(lds, (const bf16*)(ws + WS_Z), (const bf16*)(ws + WS_WDN) + (size_t)l * D * DFF, Nc, Kc, f, (int)threadIdx.x);
                } else {
                    FY f{(bf16*)(ws + WS_Y)};
                    run_gemm(lds, (const bf16*)(ws + WS_Z), (const bf16*)(ws + WS_WDN) + (size_t)l * D * DFF, D, DFF, f, gw, ngw, lane);
                }
                GRID_BAR();
            }
            if (PH(12)) { PBEGIN p_norm_res(a, g, a->in[I_GPOSTMLP] + l * D, l + 1 < NL ? a->in[I_GPREMIX] + (l + 1) * D : nullptr, gw, ngw, lane, (FUSE_NORM && gridDim.x == 256) ? MR : 0); GRID_BAR(); }
        }
    }
#if defined(DIAG_SEL)
    if ((DIAG_SEL >= 24 || DIAG_SEL == 16 || DIAG_SEL == 17) && blockIdx.x == DIAG_BLK && threadIdx.x == 0) { unsigned tot = 0; for (int i = 24; i < 30; ++i) tot += MISC[i]; tot += MISC[16] + MISC[17];
        a_.out[12345] = 100.f + 900.f * (float)MISC[DIAG_SEL] / (float)tot; }
    if (DIAG_SEL < 24 && DIAG_SEL != 16 && DIAG_SEL != 17 && blockIdx.x == 0 && threadIdx.x == 0) { unsigned tot = 0; for (int i = 0; i < 16; ++i) tot += MISC[16 + i];
#if defined(DIAG_ABS)
        a_.out[12345] = 100.f + (float)MISC[16 + DIAG_SEL] * 0.001f; }
#else
        a_.out[12345] = DIAG_SEL == 99 ? 100.f + (float)tot * 0.0001f : 100.f + 900.f * (float)MISC[16 + DIAG_SEL] / (float)tot; }
#endif
#endif
#undef PH
#undef GRID_BAR
#undef PBEGIN
}

#ifndef MK_ONE_LAUNCH
#define MK_ONE_LAUNCH 1
#endif
extern "C" void kernel_launch(void* const* d_in, const int* in_sizes, int n_in, void* d_out, int out_size, void* d_ws, size_t ws_size, hipStream_t stream) {
    static int grid = 0;
    if (grid == 0) {
        if (n_in != 28 || out_size != NB * SEQ * D || ws_size < WS_END) { fprintf(stderr, "kernel_launch: unexpected shapes (n_in %d out %d ws %zu need %zu)\n", n_in, out_size, ws_size, (size_t)WS_END); grid = -1; return; }
        int dev = 0, cus = 0, per_cu = 0;
        if (hipGetDevice(&dev) != hipSuccess || hipDeviceGetAttribute(&cus, hipDeviceAttributeMultiprocessorCount, dev) != hipSuccess) { grid = -1; return; }
        if (hipFuncSetAttribute((const void*)fwd, hipFuncAttributeMaxDynamicSharedMemorySize, LDS_BYTES) != hipSuccess) { fprintf(stderr, "kernel_launch: hipFuncSetAttribute failed\n"); grid = -1; return; }
        if (hipOccupancyMaxActiveBlocksPerMultiprocessor(&per_cu, (const void*)fwd, NWAVES * 64, LDS_BYTES) != hipSuccess || per_cu < 1) { fprintf(stderr, "kernel_launch: occupancy query says %d\n", per_cu); }
        (void)hipGetLastError();
        grid = cus;
    }
    if (grid < 0) return;
    (void)hipMemsetAsync((char*)d_ws + WS_CTL, 0, CTL_ZERO_BYTES, stream);
    Args a{};
    for (int i = 0; i < 28; ++i) a.in[i] = (const float*)d_in[i];
    a.out = (float*)d_out; a.ws = (unsigned char*)d_ws;
#if MK_ONE_LAUNCH
    a.g_lo = 0; a.g_hi = NG; a.l_lo = 0; a.l_hi = NL; a.ph_lo = 0; a.ph_hi = 13; a.prep = 1; a.use_bar = 1;
    hipLaunchKernelGGL(fwd, dim3(grid), dim3(NWAVES * 64), LDS_BYTES, stream, a);
#else
    a.use_bar = 0;
    a.prep = 1; a.g_lo = 0; a.g_hi = 0; a.l_lo = 0; a.l_hi = 0; a.ph_lo = 0; a.ph_hi = 0;
    hipLaunchKernelGGL(fwd, dim3(grid), dim3(NWAVES * 64), LDS_BYTES, stream, a);
    a.prep = 0;
    static const int cuts[] = {0, 1, 2, 3, 5, 7, 8, 9, 10, 11, 12, 13};
    for (int g = 0; g < NG; ++g) for (int l = 0; l < NL; ++l) for (int c = 0; c < 11; ++c) {
        if (c == 0 && l != 0) continue;
        a.g_lo = g; a.g_hi = g + 1; a.l_lo = l; a.l_hi = l + 1; a.ph_lo = cuts[c]; a.ph_hi = cuts[c + 1];
        hipLaunchKernelGGL(fwd, dim3(grid), dim3(NWAVES * 64), LDS_BYTES, stream, a);
    }
#endif
    const hipError_t le = hipPeekAtLastError();
    if (le != hipSuccess) fprintf(stderr, "kernel_launch: launch failed: %s\n", hipGetErrorName(le));
}
```

```cpp
#include <hip/hip_runtime.h>
#include <cstdio>
#include <cstdint>
namespace pg8 {
#define PG8_LAS __attribute__((address_space(3)))
typedef unsigned short bf16_t;
typedef short bf16x8 __attribute__((ext_vector_type(8)));
typedef float f32x4 __attribute__((ext_vector_type(4)));
typedef unsigned u32x4 __attribute__((ext_vector_type(4)));
typedef int i32x4v __attribute__((ext_vector_type(4)));
typedef int i32x8v __attribute__((ext_vector_type(8)));
__device__ __forceinline__ void mfma8_acc(f32x4& acc, const i32x8v& a, const i32x8v& b) { asm volatile("v_mfma_f32_16x16x128_f8f6f4 %0, %1, %2, %0" : "+v"(acc) : "v"(a), "v"(b)); }
__device__ __forceinline__ i32x8v cat8(bf16x8 lo, bf16x8 hi) { const i32x4v a = __builtin_bit_cast(i32x4v, lo), b = __builtin_bit_cast(i32x4v, hi); return __builtin_shufflevector(a, b, 0, 1, 2, 3, 4, 5, 6, 7); }
constexpr int BM = 256, BK = 64, HALF = 128, HTB = HALF * BK * 2  , STAGE_BYTES = 8 * HTB, NXCD = 8, WGM = 8;

__host__ __device__ __forceinline__ int lds_byte(int r, int c) { const int st = (r >> 4) * 2 + (c >> 5), rr = r & 15, cc = c & 31, ob = rr * 64 + cc * 2; return st * 1024 + (ob ^ (((ob >> 9) & 1) << 5)); }
__host__ __device__ __forceinline__ void stage_rc(int b, int& R, int& C) { const int st = b / 1024, sb = b % 1024, swz = sb ^ (((sb >> 9) & 1) << 5); R = (st >> 1) * 16 + swz / 64; C = (st & 1) * 32 + (swz % 64) / 2; }
__host__ __device__ __forceinline__ int perm32(int rho) { const int n = rho >> 4, i = rho & 15; return 8 * (i >> 2) + 4 * n + (i & 3); }

struct Unit { int pm, pn, sub, pb; };
struct Gemm { const bf16_t* A; const bf16_t* Bt; int M, N, K; const bf16_t *A1, *A2, *A3, *B1, *B2, *B3; };

struct StaticOrder {
    int nM, nN, nwg, G, c;
    __host__ __device__ void init(int M, int N, int G_, int c_) { nM = M / BM; nN = N / BM; nwg = nM * nN; G = G_; c = c_; }
    __host__ __device__ bool next(int i, Unit& u) const { return at((long)i * G + c, u); }
    __host__ __device__ bool at(long L, Unit& u) const {
        if (L >= nwg) return false;
        int wgid = (int)L; { const int q = nwg / NXCD, r = nwg % NXCD, xcd = wgid % NXCD, off = wgid / NXCD; wgid = (xcd < r ? xcd * (q + 1) : r * (q + 1) + (xcd - r) * q) + off; }
        const int nig = WGM * nN, gid = wgid / nig, fm = gid * WGM, gsz = (nM - fm) < WGM ? (nM - fm) : WGM;
        u.pm = fm + ((wgid % nig) % gsz); u.pn = (wgid % nig) / gsz; u.pb = u.pn; u.sub = 0; return true;
    }
    __device__ __forceinline__ void a_ready(const Unit&) const {}
    __device__ __forceinline__ void done(const Unit&) const {}
};

__device__ __forceinline__ unsigned cvt_pk_bf16(float lo, float hi) { unsigned r; asm volatile("v_cvt_pk_bf16_f32 %0, %1, %2" : "=v"(r) : "v"(lo), "v"(hi)); return r; }
#ifndef RELAX_EPI
#define RELAX_EPI 1
#endif
template <class Epi, class Sched, bool ALIGN_EPI = false, bool SP2 = false, bool CHAIN = false, bool FP8 = false>
__device__ __forceinline__ void gemm_phase(PG8_LAS unsigned char* lds, const Gemm g, const Sched& S, const Epi& E) {
    int tid_ = threadIdx.x; asm volatile("" : "+v"(tid_));
    const int tid = tid_, wid = __builtin_amdgcn_readfirstlane(tid >> 6), lane = tid & 63, wr = wid >> 2, wc = wid & 3, fr = lane & 15, fq = lane >> 4;
    const int K = g.K, nt = K / BK;
    unsigned voffA[2], voffB[2];
#pragma unroll
    for (int i = 0; i < 2; ++i) { int R, C; stage_rc(tid * 16 + i * 8192, R, C); const int Rb = Epi::PERM ? ((R & ~31) + perm32(R & 31)) : R;
        voffA[i] = (unsigned)(R * K + C) * 2u; voffB[i] = (unsigned)(Rb * K + C) * 2u; }
    const size_t kstep = (size_t)(BK * 2);
    const size_t hstep = (size_t)HALF * K * 2;
    const size_t tstep = 2 * hstep;
    const unsigned ldsw = (unsigned)wid * 1024u;
    const int aoff = lds_byte(wr * 64 + fr, fq * 8), boff = lds_byte(wc * 32 + fr, fq * 8);
#define PG8_SA(b, h) (((b) * 2 + (h)) * HTB)
#define PG8_SB(b, h) ((4 + (b) * 2 + (h)) * HTB)
#define PG8_STAGE(bufoff, gbase, voff) do { _Pragma("unroll") for (int _i = 0; _i < 2; ++_i) \
        __builtin_amdgcn_global_load_lds((const unsigned*)((const char*)(gbase) + (voff)[_i]), (PG8_LAS unsigned*)(lds + (bufoff) + ldsw + _i * 8192), 16, 0, 0); } while (0)
#define PG8_LDA(dst, b, h) do { if constexpr (FP8) { _Pragma("unroll") for (int m = 0; m < 4; ++m) dst##8[m] = __builtin_shufflevector(*(const PG8_LAS i32x4v*)(lds + PG8_SA(b, h) + aoff + m * 2048), *(const PG8_LAS i32x4v*)(lds + PG8_SA(b, h) + aoff + m * 2048 + 1024), 0, 1, 2, 3, 4, 5, 6, 7); } \
        else { _Pragma("unroll") for (int m = 0; m < 4; ++m) _Pragma("unroll") for (int k = 0; k < 2; ++k) dst[m][k] = *(const PG8_LAS bf16x8*)(lds + PG8_SA(b, h) + aoff + m * 2048 + k * 1024); } } while (0)
#define PG8_LDB(dst, b, h) do { if constexpr (FP8) { _Pragma("unroll") for (int n = 0; n < 2; ++n) dst##8[n] = __builtin_shufflevector(*(const PG8_LAS i32x4v*)(lds + PG8_SB(b, h) + boff + n * 2048), *(const PG8_LAS i32x4v*)(lds + PG8_SB(b, h) + boff + n * 2048 + 1024), 0, 1, 2, 3, 4, 5, 6, 7); } \
        else { _Pragma("unroll") for (int n = 0; n < 2; ++n) _Pragma("unroll") for (int k = 0; k < 2; ++k) dst[n][k] = *(const PG8_LAS bf16x8*)(lds + PG8_SB(b, h) + boff + n * 2048 + k * 1024); } } while (0)
#define PG8_MMA(ai, bj, At, Bt) do { __builtin_amdgcn_s_setprio(1); \
        if constexpr (FP8) { _Pragma("unroll") for (int m = 0; m < 4; ++m) _Pragma("unroll") for (int n = 0; n < 2; ++n) \
            mfma8_acc(acc[ai][bj][m][n], Bt##8[n], At##8[m]); } \
        else { _Pragma("unroll") for (int m = 0; m < 4; ++m) _Pragma("unroll") for (int n = 0; n < 2; ++n) _Pragma("unroll") for (int k = 0; k < 2; ++k) \
            acc[ai][bj][m][n] = __builtin_amdgcn_mfma_f32_16x16x32_bf16(Bt[n][k], At[m][k], acc[ai][bj][m][n], 0, 0, 0); } \
        __builtin_amdgcn_s_setprio(0); } while (0)
#define PG8_WAIT_V(n) asm volatile("s_waitcnt vmcnt(" #n ")" ::: "memory")
#define PG8_WAIT_V8_OR_24(rl) asm volatile("s_cmp_lg_u32 %0, 0\n\ts_cbranch_scc1 .Lpg8rl%=\n\ts_waitcnt vmcnt(8)\n.Lpg8rl%=:\n\ts_waitcnt vmcnt(24)" :: "s"(rl) : "memory", "scc")
#define PG8_WAIT_L(n) asm volatile("s_waitcnt lgkmcnt(" #n ")" ::: "memory")
#define PG8_BAR __builtin_amdgcn_s_barrier()
#define PG8_SCHED __builtin_amdgcn_sched_barrier(0)
    Unit cur, nxt; int ui = 0;
    if (!S.next(0, cur)) return;
    f32x4 acc[2][2][4][2];
#pragma unroll
    for (int a = 0; a < 2; ++a)
#pragma unroll
        for (int b = 0; b < 2; ++b)
#pragma unroll
            for (int m = 0; m < 4; ++m)
#pragma unroll
                for (int n = 0; n < 2; ++n) acc[a][b][m][n] = (f32x4){0.f, 0.f, 0.f, 0.f};
    bf16x8 At[4][2], B0[2][2], B1[2][2];
    i32x8v At8[4], B08[2], B18[2];
#define PG8_ABASE(u) ((const char*)(!CHAIN || (u).sub == 0 ? g.A : (u).sub == 1 ? g.A1 : (u).sub == 2 ? g.A2 : g.A3) + (size_t)(u).pm * tstep)
#define PG8_BBASE(u) ((const char*)(!CHAIN || (u).sub == 0 ? g.Bt : (u).sub == 1 ? g.B1 : (u).sub == 2 ? g.B2 : g.B3) + (size_t)(u).pb * tstep)
    const char* cA = PG8_ABASE(cur); const char* cB = PG8_BBASE(cur);
    S.a_ready(cur);
    if constexpr (SP2) {
        PG8_STAGE(PG8_SB(0, 0), cB, voffB); PG8_STAGE(PG8_SB(0, 1), cB + hstep, voffB); PG8_STAGE(PG8_SA(0, 0), cA, voffA); PG8_STAGE(PG8_SA(0, 1), cA + hstep, voffA);
        if (wr == 1) PG8_BAR;
        PG8_WAIT_V(2); PG8_BAR;
        PG8_STAGE(PG8_SB(1, 0), cB + kstep, voffB); PG8_STAGE(PG8_SA(1, 0), cA + kstep, voffA); PG8_STAGE(PG8_SB(1, 1), cB + hstep + kstep, voffB);
        PG8_WAIT_V(6); PG8_BAR;
    } else {
        PG8_STAGE(PG8_SB(0, 0), cB, voffB); PG8_STAGE(PG8_SA(0, 0), cA, voffA); PG8_STAGE(PG8_SB(0, 1), cB + hstep, voffB); PG8_STAGE(PG8_SA(0, 1), cA + hstep, voffA);
        if (wr == 1) PG8_BAR;
        PG8_WAIT_V(4); PG8_BAR;
        PG8_STAGE(PG8_SB(1, 0), cB + kstep, voffB); PG8_STAGE(PG8_SA(1, 0), cA + kstep, voffA); PG8_STAGE(PG8_SB(1, 1), cB + hstep + kstep, voffB);
        PG8_WAIT_V(6); PG8_BAR;
    }
    for (;;) {
        const bool has_next = S.next(ui + 1, nxt);
        const char* nA = has_next ? PG8_ABASE(nxt) : cA; const char* nB = has_next ? PG8_BBASE(nxt) : cB;
        for (int t = 0; t < nt; t += 2) {
            const bool last = (t == nt - 2);
            const char* a1 = cA + (size_t)(t + 1) * kstep;
            const char* a2 = last ? nA : cA + (size_t)(t + 2) * kstep; const char* b2 = last ? nB : cB + (size_t)(t + 2) * kstep;
            const char* a3 = a2 + kstep; const char* b3 = b2 + kstep;
            if (last && has_next) S.a_ready(nxt);
            const int rl = __builtin_amdgcn_readfirstlane((RELAX_EPI && SP2 && !Epi::AFTER_DRAIN && ui > 0 && t == 0 && (!CHAIN || cur.sub == 0)) ? 1 : 0);
            if constexpr (SP2) {
            PG8_LDB(B0, 0, 0); PG8_LDB(B1, 0, 1); PG8_SCHED; PG8_LDA(At, 0, 0); PG8_STAGE(PG8_SA(1, 1), a1 + hstep, voffA);
            PG8_WAIT_V8_OR_24(rl); PG8_WAIT_L(0); PG8_BAR; PG8_MMA(0, 0, At, B0); PG8_MMA(0, 1, At, B1); PG8_BAR; PG8_SCHED;
            PG8_LDA(At, 0, 1); PG8_STAGE(PG8_SB(0, 0), b2, voffB); PG8_STAGE(PG8_SB(0, 1), b2 + hstep, voffB); PG8_STAGE(PG8_SA(0, 0), a2, voffA);
            PG8_WAIT_V8_OR_24(rl); PG8_WAIT_L(0); PG8_BAR; PG8_MMA(1, 0, At, B0); PG8_MMA(1, 1, At, B1); PG8_BAR; PG8_SCHED;
            PG8_LDB(B0, 1, 0); PG8_LDB(B1, 1, 1); PG8_SCHED; PG8_LDA(At, 1, 0); PG8_STAGE(PG8_SA(0, 1), a2 + hstep, voffA);
            PG8_WAIT_V(8); PG8_WAIT_L(0); PG8_BAR; PG8_MMA(0, 0, At, B0); PG8_MMA(0, 1, At, B1); PG8_BAR; PG8_SCHED;
            PG8_LDA(At, 1, 1); PG8_STAGE(PG8_SB(1, 0), b3, voffB); PG8_STAGE(PG8_SB(1, 1), b3 + hstep, voffB); PG8_STAGE(PG8_SA(1, 0), a3, voffA);
            PG8_WAIT_V(8); PG8_WAIT_L(0); PG8_BAR; PG8_MMA(1, 0, At, B0); PG8_MMA(1, 1, At, B1); PG8_BAR; PG8_SCHED;
            } else {
            PG8_LDB(B0, 0, 0); PG8_SCHED; PG8_LDA(At, 0, 0); PG8_STAGE(PG8_SA(1, 1), a1 + hstep, voffA);
            PG8_WAIT_L(8); PG8_BAR; PG8_WAIT_L(0); PG8_MMA(0, 0, At, B0); PG8_BAR; PG8_SCHED;
            PG8_LDB(B1, 0, 1); PG8_STAGE(PG8_SB(0, 0), b2, voffB);
            PG8_BAR; PG8_WAIT_L(0); PG8_MMA(0, 1, At, B1); PG8_BAR;
            PG8_LDA(At, 0, 1); PG8_STAGE(PG8_SA(0, 0), a2, voffA);
            PG8_BAR; PG8_WAIT_L(0); PG8_MMA(1, 0, At, B0); PG8_BAR; PG8_SCHED;
            PG8_STAGE(PG8_SB(0, 1), b2 + hstep, voffB);
            PG8_WAIT_V(6); PG8_BAR; PG8_MMA(1, 1, At, B1); PG8_BAR;
            PG8_LDB(B0, 1, 0); PG8_SCHED; PG8_LDA(At, 1, 0); PG8_STAGE(PG8_SA(0, 1), a2 + hstep, voffA);
            PG8_WAIT_L(8); PG8_BAR; PG8_WAIT_L(0); PG8_MMA(0, 0, At, B0); PG8_BAR; PG8_SCHED;
            PG8_LDB(B1, 1, 1); PG8_STAGE(PG8_SB(1, 0), b3, voffB);
            PG8_BAR; PG8_WAIT_L(0); PG8_MMA(0, 1, At, B1); PG8_BAR;
            PG8_LDA(At, 1, 1); PG8_STAGE(PG8_SA(1, 0), a3, voffA);
            PG8_BAR; PG8_WAIT_L(0); PG8_MMA(1, 0, At, B0); PG8_BAR; PG8_SCHED;
            PG8_STAGE(PG8_SB(1, 1), b3 + hstep, voffB);
            PG8_WAIT_V(6); PG8_BAR; PG8_MMA(1, 1, At, B1); PG8_BAR;
            }
        }
        if constexpr (FP8) { asm volatile("s_nop 15\n\ts_nop 15" ::: "memory"); }
        if constexpr (ALIGN_EPI) { if (wr == 0) PG8_BAR; }
        if constexpr (CHAIN) { if (cur.sub < 3) E.mid(acc, cur, wr, wc, fr, fq); else E(acc, cur, wr, wc, fr, fq); S.done(cur); }
        else if constexpr (!Epi::AFTER_DRAIN) { E(acc, cur, wr, wc, fr, fq); S.done(cur); }
        if (!has_next) break;
        if (!CHAIN || cur.sub == 3)
#pragma unroll
        for (int a = 0; a < 2; ++a)
#pragma unroll
            for (int b = 0; b < 2; ++b)
#pragma unroll
                for (int m = 0; m < 4; ++m)
#pragma unroll
                    for (int n = 0; n < 2; ++n) acc[a][b][m][n] = (f32x4){0.f, 0.f, 0.f, 0.f};
        cur = nxt; cA = nA; cB = nB; ++ui;
        if constexpr (ALIGN_EPI) { if (wr == 1) PG8_BAR; }
    }
    PG8_WAIT_V(0);
    if constexpr (!ALIGN_EPI) { if (wr == 0) PG8_BAR; }
    PG8_BAR;
    if constexpr (Epi::AFTER_DRAIN) { E.fused(acc, cur, wr, wc, fr, fq, lds, wid, lane); S.done(cur); }
#undef PG8_ABASE
#undef PG8_BBASE
#undef PG8_SA
#undef PG8_SB
#undef PG8_STAGE
#undef PG8_LDA
#undef PG8_LDB
#undef PG8_MMA
#undef PG8_WAIT_V
#undef PG8_WAIT_L
#undef PG8_BAR
#undef PG8_SCHED
}
}

constexpr int NB = 32, SEQ = 2048, NMETA = 16, TT = SEQ + NMETA, D = 1024, NL = 4, DFF = 4096;
constexpr int NG = 4, GB = NB / NG, MR = GB * SEQ  , MT = MR + NMETA  ;
constexpr int NCOLS = 9696, NZ = 9728, ZB = 9216, ZFW = 512;
constexpr float EPS = 1e-6f;
constexpr int ZC_GQ = 0, ZC_GK = 512, ZC_GV = 1024, ZC_GR = 2048, ZC_MQ = 3072, ZC_MK = 3584, ZC_MV = 4096, ZC_MO = 5120, ZC_GATE = 6144;
constexpr int ZF_CQ = 0, ZF_CKV = 256, ZF_IK = 384, ZF_A = 448, ZF_IW = 464, ZF_MI = 472, ZF_MF = 476;
constexpr int NQQ = 2560;

constexpr size_t MiB = 1u << 20;
constexpr size_t WS_CTL = 0, CTL_ZERO_BYTES = 1 * MiB;
constexpr size_t WS_BIN = 1 * MiB;
constexpr size_t WS_WIN = 2 * MiB;
constexpr size_t WS_W16 = WS_WIN + 20 * MiB;
#ifndef P11_FP8
#define P11_FP8 1
#endif
constexpr float U8_SCALE = 8.f, WD8_SCALE = 2048.f;
constexpr float X8_SCALE = 16.f, W8_SCALE = 1024.f, Z8_DESCALE = 1.f / (16.f * 1024.f);
#ifndef P1_CFG
#define P1_CFG 0
#endif
#if P1_CFG == 0
constexpr int P1_N8T = 16, P1_F8FULL = 3;
__host__ __device__ constexpr bool p1_is8(int t) { return t >= 20 && t < 36; }
__host__ __device__ constexpr int p1_idx8(int t) { return t - 20; }
__host__ __device__ constexpr int p1_tile8(int j) { return 20 + j; }
__host__ __device__ constexpr int p1_idx16(int t) { return t < 20 ? t : t - 16; }
__host__ __device__ constexpr int p1_tile16(int j) { return j < 20 ? j : j + 16; }
#else
constexpr int P1_N8T = 20, P1_F8FULL = 4;
__host__ __device__ constexpr bool p1_is8(int t) { return (t >= 8 && t < 12) || (t >= 20 && t < 36); }
__host__ __device__ constexpr int p1_idx8(int t) { return t < 12 ? t - 8 : t - 16; }
__host__ __device__ constexpr int p1_tile8(int j) { return j < 4 ? 8 + j : 16 + j; }
__host__ __device__ constexpr int p1_idx16(int t) { return t < 8 ? t : (t < 20 ? t - 4 : t - 20); }
__host__ __device__ constexpr int p1_tile16(int j) { return j < 8 ? j : (j < 16 ? j + 4 : j + 20); }
#endif
constexpr int P1_N16T = 38 - P1_N8T;
constexpr size_t WS_XN8 = 840 * MiB;
constexpr size_t WS_WQQ = 78 * MiB;
constexpr size_t WS_WBG = 83 * MiB;
constexpr size_t WS_WBM = 91 * MiB;
constexpr size_t WS_WBD = 99 * MiB;
constexpr size_t WS_WOUT = 115 * MiB;
constexpr size_t WS_WUP = 123 * MiB;
constexpr size_t WS_WDN = 155 * MiB;
constexpr size_t WS_HM = 187 * MiB;
constexpr size_t WS_XN = 188 * MiB;
constexpr size_t WS_ZF = 221 * MiB;
constexpr size_t WS_CQN = 254 * MiB;
constexpr size_t WS_KV = 263 * MiB;
constexpr size_t WS_KI = 268 * MiB;
constexpr size_t WS_WI = 271 * MiB;
constexpr size_t WS_LIF = 272 * MiB;
constexpr size_t WS_G = 273 * MiB;
constexpr size_t WS_QKC = 306 * MiB;
constexpr size_t WS_QQ = 339 * MiB;
constexpr size_t WS_OG = 420 * MiB;
constexpr size_t WS_OM = 453 * MiB;
constexpr size_t WS_OD = 486 * MiB;
constexpr size_t WS_Z = 551 * MiB;
constexpr size_t WS_MIX = 840 * MiB;
constexpr size_t WS_Y = 873 * MiB;
constexpr size_t WS_SC = 840 * MiB;
constexpr size_t WS_DD = 1020 * MiB;
constexpr size_t WS_END = 1024 * MiB;
constexpr int SC_PITCH = 2080;
static_assert(WS_Z + (size_t)MT * ZB * 2 <= WS_MIX && WS_Y + (size_t)MT * D * 4 <= WS_END && WS_SC + (size_t)256 * 64 * SC_PITCH * 4 <= WS_END, "ws map");

constexpr int CW_BAR = 4096;

constexpr int RING_BYTES = 143360;
constexpr int MISC_OFF = RING_BYTES + 320;
constexpr int LDS_BYTES = 147456;
constexpr int NWAVES = 8;

#define LAS __attribute__((address_space(3)))
typedef unsigned short bf16;
typedef float f32x4 __attribute__((ext_vector_type(4)));
typedef float f32x2 __attribute__((ext_vector_type(2)));
typedef unsigned u32x4 __attribute__((ext_vector_type(4)));
typedef unsigned u32x2 __attribute__((ext_vector_type(2)));
typedef short bf16x8 __attribute__((ext_vector_type(8)));
typedef short s16x4 __attribute__((ext_vector_type(4)));
#define LDS_WAIT() asm volatile("s_waitcnt lgkmcnt(0)" ::: "memory")
#define VM_WAIT() asm volatile("s_waitcnt vmcnt(0)" ::: "memory")
#define LDS_BARRIER() do { asm volatile("s_waitcnt lgkmcnt(0)" ::: "memory"); __builtin_amdgcn_s_barrier(); asm volatile("" ::: "memory"); } while (0)

typedef __bf16 hwbf16x2 __attribute__((ext_vector_type(2)));
__device__ __forceinline__ unsigned pk2(float lo, float hi) { const f32x2 v = {lo, hi}; const hwbf16x2 b = __builtin_convertvector(v, hwbf16x2); return __builtin_bit_cast(unsigned, b); }
__device__ __forceinline__ unsigned f2bf(float f) { return pk2(f, 0.f) & 0xffffu; }
__device__ __forceinline__ float bf2f(unsigned b) { return __builtin_bit_cast(float, b << 16); }
__device__ __forceinline__ float bflo(unsigned w) { return __builtin_bit_cast(float, w << 16); }
__device__ __forceinline__ float bfhi(unsigned w) { return __builtin_bit_cast(float, w & 0xffff0000u); }
__device__ __forceinline__ float wave_sum(float v) {
#pragma unroll
    for (int o = 1; o < 64; o <<= 1) v += __shfl_xor(v, o);
    return v;
}
__device__ __forceinline__ float wave_max(float v) {
#pragma unroll
    for (int o = 1; o < 64; o <<= 1) v = fmaxf(v, __shfl_xor(v, o));
    return v;
}
__device__ __forceinline__ float sigmoid_f(float x) { return __builtin_amdgcn_rcpf(1.f + __builtin_amdgcn_exp2f(-1.4426950408889634f * x)); }
__device__ __forceinline__ float silu_f(float x) { return x * sigmoid_f(x); }
__device__ __forceinline__ float logsigmoid_f(float x) { return fminf(x, 0.f) - 0.6931471805599453f * __builtin_amdgcn_logf(1.f + __builtin_amdgcn_exp2f(-1.4426950408889634f * fabsf(x))); }

#define XB_TMO      128
#define XB_XCNT(j)  (256  + 64 * (j))
#define XB_XSUB(j)  (1280 + 64 * (j))
#define XB_XGEN(j)  (2304 + 64 * (j))
#define XB_TOP      3328
#define XB_TOPGEN   3392
#define XCD_BAR_WORDS 3456
#define XB_SPIN_CAP (1u << 22)

__device__ __forceinline__ unsigned xb_ld(unsigned* p)              { return __hip_atomic_load(p, __ATOMIC_RELAXED, __HIP_MEMORY_SCOPE_AGENT); }
__device__ __forceinline__ unsigned xb_add(unsigned* p, unsigned v) { return __hip_atomic_fetch_add(p, v, __ATOMIC_RELAXED, __HIP_MEMORY_SCOPE_AGENT); }
__device__ __forceinline__ unsigned xb_xcc_id() { return (unsigned)__builtin_amdgcn_s_getreg((3 << 11) | 20) & 0xFu; }
#define XB_SPIN(cond, bar) do { unsigned _sp = 0; while (cond) { __builtin_amdgcn_s_sleep(1); \
    if ((++_sp & 255u) == 0u) { if (xb_ld(&(bar)[XB_TMO])) break; if (_sp > XB_SPIN_CAP) { atomicAdd(&(bar)[XB_TMO], 1u); break; } } } } while (0)

struct XcdBarrier {
    unsigned* bar; unsigned x;
    volatile LAS unsigned* st;
};

__device__ __forceinline__ XcdBarrier xcd_barrier_post(unsigned* bar, volatile LAS unsigned* st) {
    XcdBarrier b; b.bar = bar; b.x = xb_xcc_id(); b.st = st;
    if (threadIdx.x == 0) (void)xb_add(&bar[XB_XCNT(b.x)], 1u);
    return b;
}
__device__ __forceinline__ void xcd_barrier_complete(unsigned* bar, unsigned x, unsigned& nloc, unsigned& nx) {
    const unsigned G = gridDim.x * gridDim.y * gridDim.z;
    unsigned sum, cnt, mine, sp = 0u;
    for (;;) {
        sum = 0u; cnt = 0u; mine = 0u;
#pragma unroll
        for (unsigned j = 0; j < 16; ++j) { const unsigned c = xb_ld(&bar[XB_XCNT(j)]); sum += c; cnt += (c > 0u) ? 1u : 0u; mine = (j == x) ? c : mine; }
        if (sum == G) break;
        __builtin_amdgcn_s_sleep(1);
        if ((++sp & 255u) == 0u) { if (xb_ld(&bar[XB_TMO])) break; if (sp > XB_SPIN_CAP) { atomicAdd(&bar[XB_TMO], 1u); break; } }
    }
    nloc = mine > 0u ? mine : 1u; nx = cnt > 0u ? cnt : 1u;
}

__device__ __forceinline__ void xcd_barrier(const XcdBarrier& b) {
    asm volatile("s_waitcnt vmcnt(0)" ::: "memory");
    __syncthreads();
    if (threadIdx.x == 0) {
        unsigned* bar = b.bar;
        __builtin_amdgcn_s_waitcnt(0);
        unsigned nloc = b.st[0], nx = b.st[1];
        if (nloc == 0u) { xcd_barrier_complete(bar, b.x, nloc, nx); b.st[0] = nloc; b.st[1] = nx; }
        const unsigned old = xb_add(&bar[XB_XSUB(b.x)], 1u);
        const unsigned gen = old / nloc;
        if (old + 1u == (gen + 1u) * nloc) {
            __builtin_amdgcn_fence(__ATOMIC_RELEASE, "agent");
            asm volatile("s_waitcnt vmcnt(0)" ::: "memory");
            const unsigned og = xb_add(&bar[XB_TOP], 1u);
            const unsigned tg = og / nx;
            if (og + 1u == (tg + 1u) * nx) xb_add(&bar[XB_TOPGEN], 1u);
            else XB_SPIN(xb_ld(&bar[XB_TOPGEN]) == tg, bar);
            __builtin_amdgcn_fence(__ATOMIC_ACQUIRE, "agent");
            xb_add(&bar[XB_XGEN(b.x)], 1u);
            asm volatile("s_waitcnt vmcnt(0)" ::: "memory");
        } else {
            XB_SPIN(xb_ld(&bar[XB_XGEN(b.x)]) == gen, bar);
            __builtin_amdgcn_fence(__ATOMIC_ACQUIRE, "agent");
            asm volatile("s_waitcnt vmcnt(0)" ::: "memory");
        }
    }
    __syncthreads();
}


struct Args { const float* in[28]; float* out; unsigned char* ws; int g_lo, g_hi, l_lo, l_hi, ph_lo, ph_hi, prep, use_bar; };
typedef const __attribute__((address_space(4))) Args* ArgsP;
enum { I_X = 0, I_META, I_T5, I_GPREMIX, I_WIN, I_BIN, I_WA2, I_BA, I_GGLA, I_WBRG, I_GDQ, I_WUQ, I_WIQ, I_GDKV, I_WUV, I_LNG, I_LNB, I_WBRD,
       I_CONV, I_FB, I_GML, I_WBRM, I_WOUT, I_GPOSTMIX, I_GPREMLP, I_WUP, I_WDN, I_GPOSTMLP };

__device__ __forceinline__ int win_src(int n) {
    if (n < 3072) return n;
    if (n < 6144) return n - 3072 + 3544;
    if (n < 9216) return n - 6144 + 6624;
    if (n < 9472) return n - 9216 + 3088;
    if (n < 9600) return n - 9472 + 3344;
    if (n < 9664) return n - 9600 + 3472;
    if (n < 9680) return n - 9664 + 3072;
    if (n < 9688) return n - 9680 + 3536;
    if (n < 9692) return n - 9688 + 6616;
    if (n < 9696) return n - 9692 + 6620;
    return -1;
}
struct CmIdent { __device__ __forceinline__ int operator()(int n) const { return n; } };
struct CmWin { __device__ __forceinline__ int operator()(int n) const { return win_src(n); } };

__device__ __forceinline__ unsigned pk4_fp8(float a, float b, float c, float d) {
    a = fminf(fmaxf(a, -448.f), 448.f); b = fminf(fmaxf(b, -448.f), 448.f); c = fminf(fmaxf(c, -448.f), 448.f); d = fminf(fmaxf(d, -448.f), 448.f);
    unsigned w = 0u; w = (unsigned)__builtin_amdgcn_cvt_pk_fp8_f32(a, b, (int)w, false); w = (unsigned)__builtin_amdgcn_cvt_pk_fp8_f32(c, d, (int)w, true); return w;
}
__device__ __forceinline__ unsigned pk4_fp8_pos(float a, float b, float c, float d) {
    a = fminf(a, 448.f); b = fminf(b, 448.f); c = fminf(c, 448.f); d = fminf(d, 448.f);
    unsigned w = 0u; w = (unsigned)__builtin_amdgcn_cvt_pk_fp8_f32(a, b, (int)w, false); w = (unsigned)__builtin_amdgcn_cvt_pk_fp8_f32(c, d, (int)w, true); return w;
}
template <class CM, bool F8 = false>
__device__ __forceinline__ void tr_item(const float* __restrict__ W, int ldw, bf16* __restrict__ WT, int Kd, LAS float* scr, int k0, int ns0, int nd0, int lane, CM cm, float sc8 = W8_SCALE) {
    const int sc = cm(ns0 + (lane & 31)); const int scc = sc >= 0 ? sc : 0; const float msk = sc >= 0 ? 1.f : 0.f;
    float wv[32];
#pragma unroll
    for (int i = 0; i < 32; ++i) { const int kk = 2 * i + (lane >> 5); wv[i] = W[(size_t)(k0 + kk) * ldw + scc]; }
#pragma unroll
    for (int i = 0; i < 32; ++i) { const int kk = 2 * i + (lane >> 5); scr[kk * 33 + (lane & 31)] = wv[i] * msk; }
    LDS_WAIT();
    const int c = lane & 7;
#pragma unroll
    for (int j = 0; j < 4; ++j) { const int n = (lane >> 3) + 8 * j; const LAS float* s = scr + (8 * c) * 33 + n;
        if constexpr (F8) { u32x2 o; o.x = pk4_fp8(s[0 * 33] * sc8, s[1 * 33] * sc8, s[2 * 33] * sc8, s[3 * 33] * sc8); o.y = pk4_fp8(s[4 * 33] * sc8, s[5 * 33] * sc8, s[6 * 33] * sc8, s[7 * 33] * sc8);
            *(u32x2*)((unsigned char*)WT + (size_t)(nd0 + n) * Kd + k0 + 8 * c) = o; }
        else { u32x4 o; o.x = pk2(s[0 * 33], s[1 * 33]); o.y = pk2(s[2 * 33], s[3 * 33]); o.z = pk2(s[4 * 33], s[5 * 33]); o.w = pk2(s[6 * 33], s[7 * 33]);
            *(u32x4*)(WT + (size_t)(nd0 + n) * Kd + k0 + 8 * c) = o; } }
    LDS_WAIT();
}

__device__ __forceinline__ void prep_weights(ArgsP a, LAS unsigned char* lds, int gw, int ngw, int wave, int lane) {
    LAS float* scr = (LAS float*)(lds + wave * 16384);
    unsigned char* ws = a->ws;
    constexpr int I_WIN_N = 16 * 304, I_UQ = 4 * 64, I_IQ = 4 * 16, I_SQ = 16 * 32, I_UP = 16 * 128, I_DN = 64 * 32, I_WBD = 4096, I_B = NZ / 64;
    constexpr int PER_L = I_WIN_N + I_UQ + I_IQ + 3 * I_SQ + I_UP + I_DN + I_WBD + I_B;
    for (int it = gw; it < NL * PER_L; it += ngw) {
        const int l = it / PER_L; int r = it % PER_L;
        if (r < I_WIN_N) { const int kb = r / 304, nb = r % 304;
            const int t = nb >> 3;
            if (p1_is8(t)) tr_item<CmWin, true>(a->in[I_WIN] + (size_t)l * D * NCOLS, NCOLS, (bf16*)(ws + WS_WIN + (size_t)l * P1_N8T * 256 * D), D, scr, kb * 64, nb * 32, p1_idx8(t) * 256 + (nb & 7) * 32, lane, CmWin());
            else tr_item(a->in[I_WIN] + (size_t)l * D * NCOLS, NCOLS, (bf16*)(ws + WS_W16) + (size_t)l * P1_N16T * 256 * D, D, scr, kb * 64, nb * 32, p1_idx16(t) * 256 + (nb & 7) * 32, lane, CmWin());
            continue; }
        r -= I_WIN_N;
        if (r < I_UQ) { const int kb = r / 64, nb = r % 64;
            tr_item(a->in[I_WUQ] + (size_t)l * 256 * 2048, 2048, (bf16*)(ws + WS_WQQ) + (size_t)l * NQQ * 256, 256, scr, kb * 64, nb * 32, nb * 32, lane, CmIdent()); continue; }
        r -= I_UQ;
        if (r < I_IQ) { const int kb = r / 16, nb = r % 16;
            tr_item(a->in[I_WIQ] + (size_t)l * 256 * 512, 512, (bf16*)(ws + WS_WQQ) + (size_t)l * NQQ * 256, 256, scr, kb * 64, nb * 32, 2048 + nb * 32, lane, CmIdent()); continue; }
        r -= I_IQ;
        if (r < I_SQ) { const int kb = r / 32, nb = r % 32;
            tr_item(a->in[I_WBRG] + (size_t)l * D * D, D, (bf16*)(ws + WS_WBG) + (size_t)l * D * D, D, scr, kb * 64, nb * 32, nb * 32, lane, CmIdent()); continue; }
        r -= I_SQ;
        if (r < I_SQ) { const int kb = r / 32, nb = r % 32;
            tr_item(a->in[I_WBRM] + (size_t)l * D * D, D, (bf16*)(ws + WS_WBM) + (size_t)l * D * D, D, scr, kb * 64, nb * 32, nb * 32, lane, CmIdent()); continue; }
        r -= I_SQ;
        if (r < I_SQ) { const int kb = r / 32, nb = r % 32;
            tr_item(a->in[I_WOUT] + (size_t)l * D * D, D, (bf16*)(ws + WS_WOUT) + (size_t)l * D * D, D, scr, kb * 64, nb * 32, nb * 32, lane, CmIdent()); continue; }
        r -= I_SQ;
        if (r < I_UP) { const int kb = r / 128, nb = r % 128;
            tr_item(a->in[I_WUP] + (size_t)l * D * DFF, DFF, (bf16*)(ws + WS_WUP) + (size_t)l * DFF * D, D, scr, kb * 64, nb * 32, nb * 32, lane, CmIdent()); continue; }
        r -= I_UP;
        if (r < I_DN) { const int kb = r / 32, nb = r % 32;
#if P11_FP8
            tr_item<CmIdent, true>(a->in[I_WDN] + (size_t)l * DFF * D, D, (bf16*)(ws + WS_WDN + (size_t)l * D * DFF), DFF, scr, kb * 64, nb * 32, nb * 32, lane, CmIdent(), WD8_SCALE); continue; }
#else
            tr_item(a->in[I_WDN] + (size_t)l * DFF * D, D, (bf16*)(ws + WS_WDN) + (size_t)l * D * DFF, DFF, scr, kb * 64, nb * 32, nb * 32, lane, CmIdent()); continue; }
#endif
        r -= I_DN;
        if (r < I_WBD) {
            const int h = r >> 8, nb = (r >> 4) & 15, cb = r & 15, n = nb * 64 + lane, c0 = cb * 8;
            const float* uv = a->in[I_WUV] + ((size_t)(l * 16 + h) * 128 + c0) * 64;
            const float* wb = a->in[I_WBRD] + ((size_t)l * D + h * 64) * D + n;
            float acc[8];
#pragma unroll
            for (int j = 0; j < 8; ++j) acc[j] = 0.f;
            for (int d0 = 0; d0 < 64; d0 += 8) {
                float wv[8];
#pragma unroll
                for (int e = 0; e < 8; ++e) wv[e] = wb[(size_t)(d0 + e) * D];
#pragma unroll
                for (int j = 0; j < 8; ++j) { const f32x4 u0 = *(const f32x4*)(uv + j * 64 + d0), u1 = *(const f32x4*)(uv + j * 64 + d0 + 4);
                    acc[j] += (u0.x * wv[0] + u0.y * wv[1]) + (u0.z * wv[2] + u0.w * wv[3]) + (u1.x * wv[4] + u1.y * wv[5]) + (u1.z * wv[6] + u1.w * wv[7]); }
            }
            bf16* o = (bf16*)(ws + WS_WBD) + (size_t)l * D * 2048 + (size_t)(h >> 3) * D * D + (size_t)n * D + (h & 7) * 128 + c0;
            u32x4 ow; ow.x = pk2(acc[0], acc[1]); ow.y = pk2(acc[2], acc[3]); ow.z = pk2(acc[4], acc[5]); ow.w = pk2(acc[6], acc[7]);
            *(u32x4*)o = ow;
            continue; }
        r -= I_WBD;
        { const int n = r * 64 + lane; const int sc = win_src(n);
          ((float*)(ws + WS_BIN))[l * NZ + n] = sc >= 0 ? a->in[I_BIN][l * NCOLS + sc] : 0.f; }
    }
}

__device__ __forceinline__ float* hrow(ArgsP a, int g, int r) {
    return r < MR ? a->out + ((size_t)g * MR + r) * D : (float*)(a->ws + WS_HM) + (size_t)(r - MR) * D;
}
__device__ __forceinline__ bf16* hrow16(ArgsP a, int g, int r) {
    return r < MR ? (bf16*)(a->out + ((size_t)g * MR + r) * D) : (bf16*)(a->ws + WS_HM) + (size_t)(r - MR) * D;
}
__device__ __forceinline__ void rms_row_bf16(const f32x4 (&v)[4], const float* __restrict__ gain, bf16* __restrict__ orow, int lane, unsigned char* __restrict__ orow8 = nullptr) {
    float s = 0.f;
#pragma unroll
    for (int j = 0; j < 4; ++j) s += (v[j].x * v[j].x + v[j].y * v[j].y) + (v[j].z * v[j].z + v[j].w * v[j].w);
    const float r = rsqrtf(wave_sum(s) * (1.f / D) + EPS);
#pragma unroll
    for (int j = 0; j < 4; ++j) { const f32x4 gg = *(const f32x4*)(gain + 4 * lane + 256 * j); const f32x4 o = v[j] * r * gg;
        u32x2 w; w.x = pk2(o.x, o.y); w.y = pk2(o.z, o.w); *(u32x2*)(orow + 4 * lane + 256 * j) = w;
        if (orow8) *(unsigned*)(orow8 + 4 * lane + 256 * j) = pk4_fp8(o.x * X8_SCALE, o.y * X8_SCALE, o.z * X8_SCALE, o.w * X8_SCALE); }
}
__device__ __forceinline__ const float* h0row(ArgsP a, int g, int r) { return r < MR ? a->in[I_X] + ((size_t)g * MR + r) * D : a->in[I_META] + (size_t)(r - MR) * D; }
__device__ __forceinline__ void p0_init(ArgsP a, int g, int gw, int ngw, int lane) {
    bf16* XN = (bf16*)(a->ws + WS_XN);
    const int nrows = g == 0 ? MT : MR;
    for (int r0 = gw * 4; r0 < nrows; r0 += ngw * 4) {
        f32x4 v[4][4];
#pragma unroll
        for (int i = 0; i < 4; ++i) { const float* src = h0row(a, g, r0 + i);
#pragma unroll
            for (int j = 0; j < 4; ++j) v[i][j] = *(const f32x4*)(src + 4 * lane + 256 * j); }
        rms_row_bf16(v[0], a->in[I_GPREMIX], XN + (size_t)r0 * D, lane, a->ws + WS_XN8 + (size_t)r0 * D);
        rms_row_bf16(v[1], a->in[I_GPREMIX], XN + (size_t)(r0 + 1) * D, lane, a->ws + WS_XN8 + (size_t)(r0 + 1) * D);
        rms_row_bf16(v[2], a->in[I_GPREMIX], XN + (size_t)(r0 + 2) * D, lane, a->ws + WS_XN8 + (size_t)(r0 + 2) * D);
        rms_row_bf16(v[3], a->in[I_GPREMIX], XN + (size_t)(r0 + 3) * D, lane, a->ws + WS_XN8 + (size_t)(r0 + 3) * D);
    }
}
template <bool DRY = false>
__device__ __forceinline__ void p_norm_res(ArgsP a, int g, const float* gpost, const float* gpre, int gw, int ngw, int lane, int rbeg = 0, bool first = false, bool x8 = false, bool last = false) {
    bf16* XN = (bf16*)(a->ws + (DRY ? WS_Z + 100 * MiB : WS_XN)); const bf16* Y = (const bf16*)(a->ws + WS_Y);
    f32x4 gp[4], gq[4];
#pragma unroll
    for (int j = 0; j < 4; ++j) { gp[j] = *(const f32x4*)(gpost + 4 * lane + 256 * j); gq[j] = gpre ? *(const f32x4*)(gpre + 4 * lane + 256 * j) : (f32x4){0.f, 0.f, 0.f, 0.f}; }
    const int nrows = g == 0 ? MT : MR;
    for (int r0 = rbeg + gw * 4; r0 < nrows; r0 += ngw * 4) {
        bf16* hd[4]; u32x2 yw[4][4]; f32x4 v[4][4]; float s[4];
#pragma unroll
        for (int i = 0; i < 4; ++i) { const int r = r0 + i; hd[i] = DRY ? (bf16*)(a->ws + WS_Z) + (size_t)r * D : hrow16(a, g, r);
#pragma unroll
            for (int j = 0; j < 4; ++j) yw[i][j] = *(const u32x2*)(Y + (size_t)r * D + 4 * lane + 256 * j);
            if (first) { const float* hs = h0row(a, g, r);
#pragma unroll
                for (int j = 0; j < 4; ++j) v[i][j] = *(const f32x4*)(hs + 4 * lane + 256 * j);
            } else { const bf16* hs = hrow16(a, g, r);
#pragma unroll
                for (int j = 0; j < 4; ++j) { const u32x2 w = *(const u32x2*)(hs + 4 * lane + 256 * j); v[i][j] = (f32x4){bflo(w.x), bfhi(w.x), bflo(w.y), bfhi(w.y)}; } } }
        f32x4 y[4][4];
#pragma unroll
        for (int i = 0; i < 4; ++i) { s[i] = 0.f;
#pragma unroll
            for (int j = 0; j < 4; ++j) { y[i][j] = (f32x4){bflo(yw[i][j].x), bfhi(yw[i][j].x), bflo(yw[i][j].y), bfhi(yw[i][j].y)};
                s[i] += (y[i][j].x * y[i][j].x + y[i][j].y * y[i][j].y) + (y[i][j].z * y[i][j].z + y[i][j].w * y[i][j].w); } }
#pragma unroll
        for (int o = 1; o < 64; o <<= 1) { s[0] += __shfl_xor(s[0], o); s[1] += __shfl_xor(s[1], o); s[2] += __shfl_xor(s[2], o); s[3] += __shfl_xor(s[3], o); }
        float s2[4];
#pragma unroll
        for (int i = 0; i < 4; ++i) { const float rr = rsqrtf(s[i] * (1.f / D) + EPS); s2[i] = 0.f;
#pragma unroll
            for (int j = 0; j < 4; ++j) { v[i][j] = v[i][j] + y[i][j] * rr * gp[j];
                if (last && !DRY && r0 < MR) *(f32x4*)(a->out + ((size_t)g * MR + r0 + i) * D + 4 * lane + 256 * j) = v[i][j];
                else { u32x2 w; w.x = pk2(v[i][j].x, v[i][j].y); w.y = pk2(v[i][j].z, v[i][j].w); *(u32x2*)(hd[i] + 4 * lane + 256 * j) = w; }
                s2[i] += (v[i][j].x * v[i][j].x + v[i][j].y * v[i][j].y) + (v[i][j].z * v[i][j].z + v[i][j].w * v[i][j].w); } }
        if (gpre) {
#pragma unroll
            for (int o = 1; o < 64; o <<= 1) { s2[0] += __shfl_xor(s2[0], o); s2[1] += __shfl_xor(s2[1], o); s2[2] += __shfl_xor(s2[2], o); s2[3] += __shfl_xor(s2[3], o); }
#pragma unroll
            for (int i = 0; i < 4; ++i) { const float r2 = rsqrtf(s2[i] * (1.f / D) + EPS);
#pragma unroll
                for (int j = 0; j < 4; ++j) { const f32x4 o4 = v[i][j] * r2 * gq[j]; u32x2 w; w.x = pk2(o4.x, o4.y); w.y = pk2(o4.z, o4.w); *(u32x2*)(XN + (size_t)(r0 + i) * D + 4 * lane + 256 * j) = w;
                    if (x8 && !DRY) *(unsigned*)(a->ws + WS_XN8 + (size_t)(r0 + i) * D + 4 * lane + 256 * j) = pk4_fp8(o4.x * X8_SCALE, o4.y * X8_SCALE, o4.z * X8_SCALE, o4.w * X8_SCALE); } }
        }
    }
}

template <class F> struct EpiT {
    static constexpr bool PERM = true, AFTER_DRAIN = false;
    F f;
    __device__ __forceinline__ void operator()(const f32x4 (&acc)[2][2][4][2], const pg8::Unit& u, int wr, int wc, int fr, int fq) const {
        const int row0 = u.pm * 256 + wr * 64 + fr, col0 = u.pn * 256 + wc * 32 + 8 * fq;
        if constexpr (F::HAS_BIAS) {
            const f32x4 b00 = *(const f32x4*)(f.bias + col0), b01 = *(const f32x4*)(f.bias + col0 + 4), b10 = *(const f32x4*)(f.bias + col0 + 128), b11 = *(const f32x4*)(f.bias + col0 + 132);
#pragma unroll
            for (int ai = 0; ai < 2; ++ai)
#pragma unroll
                for (int m = 0; m < 4; ++m) { f.apply(row0 + ai * 128 + m * 16, col0, acc[ai][0][m][0] * f.asc + b00, acc[ai][0][m][1] * f.asc + b01); f.apply(row0 + ai * 128 + m * 16, col0 + 128, acc[ai][1][m][0] * f.asc + b10, acc[ai][1][m][1] * f.asc + b11); }
            return;
        }
#pragma unroll
        for (int ai = 0; ai < 2; ++ai)
#pragma unroll
            for (int m = 0; m < 4; ++m)
#pragma unroll
                for (int bj = 0; bj < 2; ++bj) f.apply(row0 + ai * 128 + m * 16, col0 + bj * 128, acc[ai][bj][m][0], acc[ai][bj][m][1]);
    }
};
__device__ __forceinline__ void st_bf16x8(bf16* p, f32x4 v0, f32x4 v1) { u32x4 w; w.x = pk2(v0.x, v0.y); w.y = pk2(v0.z, v0.w); w.z = pk2(v1.x, v1.y); w.w = pk2(v1.z, v1.w); *(u32x4*)p = w; }
__device__ __forceinline__ void st_bf16x8_nt(bf16* p, f32x4 v0, f32x4 v1) { u32x4 w; w.x = pk2(v0.x, v0.y); w.y = pk2(v0.z, v0.w); w.z = pk2(v1.x, v1.y); w.w = pk2(v1.z, v1.w); __builtin_nontemporal_store(w, (u32x4*)p); }
__device__ __forceinline__ void ld_bf16x8(const bf16* p, f32x4& v0, f32x4& v1) { const u32x4 w = *(const u32x4*)p;
    v0 = (f32x4){bflo(w.x), bfhi(w.x), bflo(w.y), bfhi(w.y)}; v1 = (f32x4){bflo(w.z), bfhi(w.z), bflo(w.w), bfhi(w.w)}; }

#if defined(NT_STORES)
#define ST_BIG st_bf16x8_nt
#else
#define ST_BIG st_bf16x8
#endif
struct FIn {
    static constexpr bool HAS_BIAS = true, STAGGER = true;
    bf16* Z; float* ZF; const float* bias; float asc;
    __device__ __forceinline__ void apply(int row, int col, f32x4 v0, f32x4 v1) const {
        const int t = col >> 8;
        if (t >= 36) { float* p = ZF + (size_t)row * ZFW + (col - ZB); *(f32x4*)p = v0; *(f32x4*)(p + 4) = v1; return; }
        if (t < 2) { v0 *= 0.08838834764831845f; v1 *= 0.08838834764831845f; }
        else if (t >= 8 && t < 12) {
#pragma unroll
            for (int i = 0; i < 4; ++i) { v0[i] = silu_f(v0[i]); v1[i] = silu_f(v1[i]); } }
        else if (t >= 20) {
#pragma unroll
            for (int i = 0; i < 4; ++i) { v0[i] = sigmoid_f(v0[i]); v1[i] = sigmoid_f(v1[i]); } }
        ST_BIG(Z + (size_t)row * ZB + col, v0, v1);
    }
};
struct FQQ {
    static constexpr bool HAS_BIAS = false, STAGGER = false;
    bf16* QQ;
    __device__ __forceinline__ void apply(int row, int col, f32x4 v0, f32x4 v1) const {
        const float s = col < 2048 ? 0.08838834764831845f : 0.125f;
        st_bf16x8(QQ + (size_t)row * NQQ + col, v0 * s, v1 * s);
    }
};
template <int IDX> struct FBr {
    static constexpr bool HAS_BIAS = false;
    const bf16* Z; float* Y; bf16* MIX;
    __device__ __forceinline__ void apply(int row, int col, f32x4 v0, f32x4 v1) const {
        f32x4 g0, g1; ld_bf16x8(Z + (size_t)row * ZB + ZC_GATE + IDX * 1024 + col, g0, g1);
        float* y = Y + (size_t)row * D + col;
        f32x4 a0 = v0 * g0, a1 = v1 * g1;
        if (IDX > 0) { a0 += *(const f32x4*)y; a1 += *(const f32x4*)(y + 4); }
        if (IDX < 2) { *(f32x4*)y = a0; *(f32x4*)(y + 4) = a1; }
        else st_bf16x8(MIX + (size_t)row * D + col, a0, a1);
    }
};
struct FY {
    static constexpr bool HAS_BIAS = false, STAGGER = false;
    bf16* Y; float asc;
    __device__ __forceinline__ void apply(int row, int col, f32x4 v0, f32x4 v1) const { st_bf16x8(Y + (size_t)row * D + col, v0 * asc, v1 * asc); }
};
struct FUp {
    static constexpr bool HAS_BIAS = false, STAGGER = true;
    unsigned char* U;
    __device__ __forceinline__ void apply(int row, int col, f32x4 v0, f32x4 v1) const {
#pragma unroll
#if P11_FP8
        for (int i = 0; i < 4; ++i) { const float p = fmaxf(v0[i], 0.f), q = fmaxf(v1[i], 0.f); v0[i] = p * p * U8_SCALE; v1[i] = q * q * U8_SCALE; }
        u32x2 w; w.x = pk4_fp8_pos(v0.x, v0.y, v0.z, v0.w); w.y = pk4_fp8_pos(v1.x, v1.y, v1.z, v1.w);
        *(u32x2*)(U + (size_t)row * DFF + col) = w;
#else
        for (int i = 0; i < 4; ++i) { const float p = fmaxf(v0[i], 0.f), q = fmaxf(v1[i], 0.f); v0[i] = p * p; v1[i] = q * q; }
        ST_BIG((bf16*)U + (size_t)row * DFF + col, v0, v1);
#endif
    }
};

template <class F>
__device__ __forceinline__ void mini_gemm(LAS unsigned char* lds, const bf16* __restrict__ A, const bf16* __restrict__ Bt, int N, int K, const F& f, int tid_in, int bfirst = 0, bool p1map = false, int nuse = 0) {
    int tid = tid_in; asm volatile("" : "+v"(tid));
    const int lane = tid & 63, wave = __builtin_amdgcn_readfirstlane(tid >> 6), fr = lane & 15, fq = lane >> 4;
    LAS float* red = (LAS float*)lds;
    const int kw = K >> 3, kbeg = wave * kw;
    const int nblk_ = nuse > 0 ? nuse : (int)gridDim.x - bfirst;
    for (int wt = (int)blockIdx.x - bfirst < nblk_ ? (int)blockIdx.x - bfirst : -1; wt >= 0 && wt < N / 32; wt += nblk_) {
        const int n0 = wt * 32, nr0 = p1map ? p1_tile16(wt >> 3) * 256 + (wt & 7) * 32 : n0;
        f32x4 acc0 = {0.f, 0.f, 0.f, 0.f}, acc1 = {0.f, 0.f, 0.f, 0.f};
        const bf16* ap = A + (size_t)(MR + fr) * K + fq * 8 + kbeg;
        const bf16* b0 = Bt + (size_t)(n0 + pg8::perm32(fr)) * K + fq * 8 + kbeg;
        const bf16* b1 = Bt + (size_t)(n0 + pg8::perm32(16 + fr)) * K + fq * 8 + kbeg;
        if (kw < 128) {
            const bf16x8 av = *(const bf16x8*)ap, w0 = *(const bf16x8*)b0, w1 = *(const bf16x8*)b1;
            acc0 = __builtin_amdgcn_mfma_f32_16x16x32_bf16(w0, av, acc0, 0, 0, 0);
            acc1 = __builtin_amdgcn_mfma_f32_16x16x32_bf16(w1, av, acc1, 0, 0, 0);
        } else {
            for (int k = 0; k < kw; k += 128) {
                bf16x8 av[4], w0[4], w1[4];
#pragma unroll
                for (int u = 0; u < 4; ++u) { av[u] = *(const bf16x8*)(ap + k + 32 * u); w0[u] = *(const bf16x8*)(b0 + k + 32 * u); w1[u] = *(const bf16x8*)(b1 + k + 32 * u); }
#pragma unroll
                for (int u = 0; u < 4; ++u) {
                    acc0 = __builtin_amdgcn_mfma_f32_16x16x32_bf16(w0[u], av[u], acc0, 0, 0, 0);
                    acc1 = __builtin_amdgcn_mfma_f32_16x16x32_bf16(w1[u], av[u], acc1, 0, 0, 0);
                }
            }
        }
        *(LAS f32x4*)(red + (wave * 64 + lane) * 8) = acc0; *(LAS f32x4*)(red + (wave * 64 + lane) * 8 + 4) = acc1;
        LDS_WAIT();
        __syncthreads();
        if (wave == 0) {
            f32x4 s0 = {0.f, 0.f, 0.f, 0.f}, s1 = {0.f, 0.f, 0.f, 0.f};
#pragma unroll
            for (int w = 0; w < 8; ++w) { s0 += *(const LAS f32x4*)(red + (w * 64 + lane) * 8); s1 += *(const LAS f32x4*)(red + (w * 64 + lane) * 8 + 4); }
            if constexpr (F::HAS_BIAS) { s0 = s0 * f.asc + *(const f32x4*)(f.bias + nr0 + 8 * fq); s1 = s1 * f.asc + *(const f32x4*)(f.bias + nr0 + 8 * fq + 4); }
            f.apply(MR + fr, nr0 + 8 * fq, s0, s1);
        }
        __syncthreads();
    }
}
template <class F>
__device__ __forceinline__ void mini_gemm8(LAS unsigned char* lds, const unsigned char* __restrict__ A8, const unsigned char* __restrict__ B8, int N, int K, const F& f, int tid_in, bool p1map) {
    int tid = tid_in; asm volatile("" : "+v"(tid));
    const int lane = tid & 63, wave = __builtin_amdgcn_readfirstlane(tid >> 6), fr = lane & 15, fq = lane >> 4;
    LAS float* red = (LAS float*)lds;
    const int kw = K >> 3;
    for (int wt = (int)blockIdx.x; wt < N / 32; wt += (int)gridDim.x) {
        const int n0 = wt * 32, nr0 = p1map ? p1_tile8(wt >> 3) * 256 + (wt & 7) * 32 : n0;
        const size_t ko = (size_t)wave * kw + fq * 32;
        const unsigned char* ap = A8 + (size_t)(MR + fr) * K + ko;
        const unsigned char* b0 = B8 + (size_t)(n0 + pg8::perm32(fr)) * K + ko;
        const unsigned char* b1 = B8 + (size_t)(n0 + pg8::perm32(16 + fr)) * K + ko;
        f32x4 acc0 = {0.f, 0.f, 0.f, 0.f}, acc1 = {0.f, 0.f, 0.f, 0.f};
        for (int k = 0; k < kw; k += 128) {
            const pg8::i32x4v a0 = *(const pg8::i32x4v*)(ap + k), a1 = *(const pg8::i32x4v*)(ap + k + 16), p0 = *(const pg8::i32x4v*)(b0 + k), p1 = *(const pg8::i32x4v*)(b0 + k + 16), q0 = *(const pg8::i32x4v*)(b1 + k), q1 = *(const pg8::i32x4v*)(b1 + k + 16);
            const pg8::i32x8v av = __builtin_shufflevector(a0, a1, 0, 1, 2, 3, 4, 5, 6, 7), w0 = __builtin_shufflevector(p0, p1, 0, 1, 2, 3, 4, 5, 6, 7), w1 = __builtin_shufflevector(q0, q1, 0, 1, 2, 3, 4, 5, 6, 7);
            acc0 = __builtin_amdgcn_mfma_scale_f32_16x16x128_f8f6f4(w0, av, acc0, 0, 0, 0, 0, 0, 0); acc1 = __builtin_amdgcn_mfma_scale_f32_16x16x128_f8f6f4(w1, av, acc1, 0, 0, 0, 0, 0, 0);
        }
        *(LAS f32x4*)(red + (wave * 64 + lane) * 8) = acc0; *(LAS f32x4*)(red + (wave * 64 + lane) * 8 + 4) = acc1;
        LDS_WAIT();
        __syncthreads();
        if (wave == 0) {
            f32x4 s0 = {0.f, 0.f, 0.f, 0.f}, s1 = {0.f, 0.f, 0.f, 0.f};
#pragma unroll
            for (int w = 0; w < 8; ++w) { s0 += *(const LAS f32x4*)(red + (w * 64 + lane) * 8); s1 += *(const LAS f32x4*)(red + (w * 64 + lane) * 8 + 4); }
            if constexpr (F::HAS_BIAS) { s0 = s0 * f.asc + *(const f32x4*)(f.bias + nr0 + 8 * fq); s1 = s1 * f.asc + *(const f32x4*)(f.bias + nr0 + 8 * fq + 4); }
            f.apply(MR + fr, nr0 + 8 * fq, s0, s1);
        }
        __syncthreads();
    }
}
__device__ __forceinline__ void mini_mix(LAS unsigned char* lds, const bf16* __restrict__ A0, const bf16* __restrict__ A1, const bf16* __restrict__ A2, const bf16* __restrict__ A3,
                                         const bf16* __restrict__ B0, const bf16* __restrict__ B1, const bf16* __restrict__ B2, const bf16* __restrict__ B3,
                                         const bf16* __restrict__ Z, bf16* __restrict__ MIX, int tid_in) {
    int tid = tid_in; asm volatile("" : "+v"(tid));
    const int lane = tid & 63, wave = __builtin_amdgcn_readfirstlane(tid >> 6), fr = lane & 15, fq = lane >> 4;
    LAS float* red = (LAS float*)lds;
    const int kbeg = wave * (D / 8);
    for (int wt = blockIdx.x; wt < D / 32; wt += gridDim.x) {
        const int n0 = wt * 32;
        f32x4 acc[3][2];
#pragma unroll
        for (int q = 0; q < 3; ++q) { acc[q][0] = (f32x4){0.f, 0.f, 0.f, 0.f}; acc[q][1] = (f32x4){0.f, 0.f, 0.f, 0.f}; }
        const size_t ao = (size_t)(MR + fr) * D + fq * 8 + kbeg, bo0 = (size_t)(n0 + pg8::perm32(fr)) * D + fq * 8 + kbeg, bo1 = (size_t)(n0 + pg8::perm32(16 + fr)) * D + fq * 8 + kbeg;
        bf16x8 av[4][4], w0[4][4], w1[4][4];
#pragma unroll
        for (int pr = 0; pr < 4; ++pr) { const bf16* Ap = pr == 0 ? A0 : pr == 1 ? A1 : pr == 2 ? A2 : A3; const bf16* Bp = pr == 0 ? B0 : pr == 1 ? B1 : pr == 2 ? B2 : B3;
#pragma unroll
            for (int u = 0; u < 4; ++u) { av[pr][u] = *(const bf16x8*)(Ap + ao + 32 * u); w0[pr][u] = *(const bf16x8*)(Bp + bo0 + 32 * u); w1[pr][u] = *(const bf16x8*)(Bp + bo1 + 32 * u); } }
#pragma unroll
        for (int pr = 0; pr < 4; ++pr) { const int q = pr == 0 ? 0 : pr == 3 ? 2 : 1;
#pragma unroll
            for (int u = 0; u < 4; ++u) {
                acc[q][0] = __builtin_amdgcn_mfma_f32_16x16x32_bf16(w0[pr][u], av[pr][u], acc[q][0], 0, 0, 0);
                acc[q][1] = __builtin_amdgcn_mfma_f32_16x16x32_bf16(w1[pr][u], av[pr][u], acc[q][1], 0, 0, 0);
            } }
#pragma unroll
        for (int q = 0; q < 3; ++q) { *(LAS f32x4*)(red + (wave * 64 + lane) * 24 + 8 * q) = acc[q][0]; *(LAS f32x4*)(red + (wave * 64 + lane) * 24 + 8 * q + 4) = acc[q][1]; }
        LDS_WAIT();
        __syncthreads();
        if (wave == 0) {
            f32x4 m0 = {0.f, 0.f, 0.f, 0.f}, m1 = {0.f, 0.f, 0.f, 0.f};
#pragma unroll
            for (int q = 0; q < 3; ++q) {
                f32x4 s0 = {0.f, 0.f, 0.f, 0.f}, s1 = {0.f, 0.f, 0.f, 0.f};
#pragma unroll
                for (int w = 0; w < 8; ++w) { s0 += *(const LAS f32x4*)(red + (w * 64 + lane) * 24 + 8 * q); s1 += *(const LAS f32x4*)(red + (w * 64 + lane) * 24 + 8 * q + 4); }
                f32x4 g0, g1; ld_bf16x8(Z + (size_t)(MR + fr) * ZB + ZC_GATE + q * 1024 + n0 + 8 * fq, g0, g1);
                m0 += s0 * g0; m1 += s1 * g1;
            }
            st_bf16x8(MIX + (size_t)(MR + fr) * D + n0 + 8 * fq, m0, m1);
        }
        __syncthreads();
    }
}
template <class F, bool ALIGN = true>
__device__ __forceinline__ void run_gemm(LAS unsigned char* lds, const bf16* A, const bf16* Bt, int N, int K, const F& f, int gw, int ngw, int lane, bool meta = true) {
    asm volatile("" : "+s"(K)); asm volatile("" : "+s"(N));
    pg8::Gemm g{A, Bt, MR, N, K}; pg8::StaticOrder S; S.init(MR, N, (int)gridDim.x, (int)blockIdx.x);
    EpiT<F> E{f};
#if defined(STAGGER_TICKS)
    if (F::STAGGER) {
        const unsigned long long t0 = __builtin_amdgcn_s_memrealtime(), dl = (unsigned long long)(blockIdx.x & 3u) * STAGGER_TICKS;
        while (__builtin_amdgcn_s_memrealtime() - t0 < dl) __builtin_amdgcn_s_sleep(4);
    }
#endif
    pg8::gemm_phase<EpiT<F>, pg8::StaticOrder, ALIGN, true>((PG8_LAS unsigned char*)lds, g, S, E);
    if (meta) mini_gemm(lds, A, Bt, N, K, f, (int)threadIdx.x, ((MR / 256) * (N / 256)) % (int)gridDim.x);
}

struct P1Order8 {
    pg8::StaticOrder S; int c; bool bal;
    __device__ __forceinline__ bool next(int i, pg8::Unit& u) const {
        long L;
        if (!bal) L = (long)i * S.G + c;
        else if (i < P1_F8FULL) L = i * 256 + c;
        else if (c >= 128 && i < P1_F8FULL + 2) L = P1_F8FULL * 256 + (i - P1_F8FULL) * 128 + (c - 128);
        else return false;
        if (!S.at(L, u)) return false;
        u.pn = p1_tile8(u.pb); return true;
    }
    __device__ __forceinline__ void a_ready(const pg8::Unit&) const {}
    __device__ __forceinline__ void done(const pg8::Unit&) const {}
};
struct P1Order16 {
    pg8::StaticOrder S;
    __device__ __forceinline__ bool next(int i, pg8::Unit& u) const { if (!S.next(i, u)) return false; u.pn = p1_tile16(u.pb); return true; }
    __device__ __forceinline__ void a_ready(const pg8::Unit&) const {}
    __device__ __forceinline__ void done(const pg8::Unit&) const {}
};
static_assert(P1_N8T * 64 == 128 * P1_F8FULL + 128 * (P1_F8FULL + 2), "fp8 unit split");
template <bool ALIGN>
__device__ __forceinline__ void run_p1(LAS unsigned char* lds, unsigned char* ws, int l, bool meta) {
    int K16 = D, K8 = D / 2; asm volatile("" : "+s"(K16)); asm volatile("" : "+s"(K8));
    const float* bias = (const float*)(ws + WS_BIN) + l * NZ;
    const bf16* W16 = (const bf16*)(ws + WS_W16) + (size_t)l * P1_N16T * 256 * D;
    const unsigned char* W8 = ws + WS_WIN + (size_t)l * P1_N8T * 256 * D;
    FIn f16{(bf16*)(ws + WS_Z), (float*)(ws + WS_ZF), bias, 1.f}, f8{(bf16*)(ws + WS_Z), (float*)(ws + WS_ZF), bias, Z8_DESCALE};
    {
        pg8::Gemm g{(const bf16*)(ws + WS_XN), W16, MR, P1_N16T * 256, K16}; P1Order16 S; S.S.init(MR, P1_N16T * 256, (int)gridDim.x, (int)blockIdx.x);
        EpiT<FIn> E{f16};
        pg8::gemm_phase<EpiT<FIn>, P1Order16, ALIGN, true>((PG8_LAS unsigned char*)lds, g, S, E);
    }
    {
        pg8::Gemm g{(const bf16*)(ws + WS_XN8), (const bf16*)W8, MR, P1_N8T * 256, K8}; P1Order8 S; S.S.init(MR, P1_N8T * 256, (int)gridDim.x, (int)blockIdx.x); S.c = (int)blockIdx.x; S.bal = gridDim.x == 256;
        EpiT<FIn> E{f8};
        pg8::gemm_phase<EpiT<FIn>, P1Order8, ALIGN, true, false, true>((PG8_LAS unsigned char*)lds, g, S, E);
    }
    if (!meta) return;
    mini_gemm8(lds, ws + WS_XN8, W8, P1_N8T * 256, K16, f8, (int)threadIdx.x, true);
    mini_gemm(lds, (const bf16*)(ws + WS_XN), W16, P1_N16T * 256, K16, f16, (int)threadIdx.x, 0, true, gridDim.x == 256 ? 128 : 0);
}

__device__ __forceinline__ void run_p11(LAS unsigned char* lds, unsigned char* ws, int l, bool meta) {
#if !P11_FP8
    { FY f{(bf16*)(ws + WS_Y), 1.f}; run_gemm(lds, (const bf16*)(ws + WS_Z), (const bf16*)(ws + WS_WDN) + (size_t)l * D * DFF, D, DFF, f, 0, 0, 0, meta); return; }
#endif
    int K8 = DFF / 2, Kb = DFF, Nc = D; asm volatile("" : "+s"(K8)); asm volatile("" : "+s"(Kb)); asm volatile("" : "+s"(Nc));
    const unsigned char* U8 = ws + WS_Z; const unsigned char* WD8 = ws + WS_WDN + (size_t)l * D * DFF;
    FY f{(bf16*)(ws + WS_Y), 1.f / (U8_SCALE * WD8_SCALE)};
    pg8::Gemm g{(const bf16*)U8, (const bf16*)WD8, MR, Nc, K8}; pg8::StaticOrder S; S.init(MR, Nc, (int)gridDim.x, (int)blockIdx.x);
    EpiT<FY> E{f};
    pg8::gemm_phase<EpiT<FY>, pg8::StaticOrder, true, true, false, true>((PG8_LAS unsigned char*)lds, g, S, E);
    if (meta) mini_gemm8(lds, U8, WD8, Nc, Kb, f, (int)threadIdx.x, false);
}

struct ChainOrder {
    pg8::StaticOrder S;
    __device__ __forceinline__ bool next(int i, pg8::Unit& u) const { if (!S.next(i >> 2, u)) return false; u.sub = i & 3; return true; }
    __device__ __forceinline__ void a_ready(const pg8::Unit&) const {}
    __device__ __forceinline__ void done(const pg8::Unit&) const {}
};
struct EpiMix {
    static constexpr bool PERM = true, AFTER_DRAIN = false;
    const bf16* Z; bf16* MIX;
    __device__ __forceinline__ void mid(f32x4 (&acc)[2][2][4][2], const pg8::Unit& u, int wr, int wc, int fr, int fq) const {
        if (u.sub == 1) return;
        const int gi = u.sub == 0 ? 0 : 1;
        const int row0 = u.pm * 256 + wr * 64 + fr, col0 = u.pn * 256 + wc * 32 + 8 * fq;
#pragma unroll
        for (int ai = 0; ai < 2; ++ai) {
            u32x4 ga[4][2], gb[4][2];
#pragma unroll
            for (int m = 0; m < 4; ++m)
#pragma unroll
                for (int bj = 0; bj < 2; ++bj) { const bf16* gp = Z + (size_t)(row0 + ai * 128 + m * 16) * ZB + ZC_GATE + gi * 1024 + col0 + bj * 128;
                    ga[m][bj] = *(const u32x4*)gp; gb[m][bj] = *(const u32x4*)(gp + 1024); }
#pragma unroll
            for (int m = 0; m < 4; ++m)
#pragma unroll
                for (int bj = 0; bj < 2; ++bj) {
                    const u32x4 a = ga[m][bj], b = gb[m][bj];
                    f32x4 r0, r1;
                    r0.x = bflo(a.x) * __builtin_amdgcn_rcpf(bflo(b.x)); r0.y = bfhi(a.x) * __builtin_amdgcn_rcpf(bfhi(b.x)); r0.z = bflo(a.y) * __builtin_amdgcn_rcpf(bflo(b.y)); r0.w = bfhi(a.y) * __builtin_amdgcn_rcpf(bfhi(b.y));
                    r1.x = bflo(a.z) * __builtin_amdgcn_rcpf(bflo(b.z)); r1.y = bfhi(a.z) * __builtin_amdgcn_rcpf(bfhi(b.z)); r1.z = bflo(a.w) * __builtin_amdgcn_rcpf(bflo(b.w)); r1.w = bfhi(a.w) * __builtin_amdgcn_rcpf(bfhi(b.w));
                    acc[ai][bj][m][0] *= r0; acc[ai][bj][m][1] *= r1;
                }
            asm volatile("" ::: "memory");
        }
    }
    __device__ __forceinline__ void operator()(const f32x4 (&acc)[2][2][4][2], const pg8::Unit& u, int wr, int wc, int fr, int fq) const {
        const int row0 = u.pm * 256 + wr * 64 + fr, col0 = u.pn * 256 + wc * 32 + 8 * fq;
#pragma unroll
        for (int ai = 0; ai < 2; ++ai) {
            u32x4 gc[4][2];
#pragma unroll
            for (int m = 0; m < 4; ++m)
#pragma unroll
                for (int bj = 0; bj < 2; ++bj) gc[m][bj] = *(const u32x4*)(Z + (size_t)(row0 + ai * 128 + m * 16) * ZB + ZC_GATE + 2 * 1024 + col0 + bj * 128);
#pragma unroll
            for (int m = 0; m < 4; ++m)
#pragma unroll
                for (int bj = 0; bj < 2; ++bj) {
                    const u32x4 w = gc[m][bj];
                    const f32x4 g0 = {bflo(w.x), bfhi(w.x), bflo(w.y), bfhi(w.y)}, g1 = {bflo(w.z), bfhi(w.z), bflo(w.w), bfhi(w.w)};
                    st_bf16x8(MIX + (size_t)(row0 + ai * 128 + m * 16) * D + col0 + bj * 128, acc[ai][bj][m][0] * g0, acc[ai][bj][m][1] * g1);
                }
            asm volatile("" ::: "memory");
        }
    }
};

constexpr int CW_XCNT = 16384;
struct RmsExchange {
    float* xbuf; unsigned* cnt; unsigned* tmo; unsigned target;
    __device__ __forceinline__ void run(const f32x4 (&v)[2][2][4][2], const pg8::Unit& u, int wr, int wc, int fr, int fq, LAS unsigned char* lds, int wid, int lane) const {
        LAS float* P = (LAS float*)lds;
        LAS float* S = (LAS float*)(lds + 8192);
#pragma unroll
        for (int ai = 0; ai < 2; ++ai)
#pragma unroll
            for (int m = 0; m < 4; ++m) {
                float s = 0.f;
#pragma unroll
                for (int bj = 0; bj < 2; ++bj)
#pragma unroll
                    for (int n = 0; n < 2; ++n) { const f32x4 x = v[ai][bj][m][n]; s += (x.x * x.x + x.y * x.y) + (x.z * x.z + x.w * x.w); }
                s += __shfl_xor(s, 16); s += __shfl_xor(s, 32);
                if (fq == 0) P[(ai * 128 + wr * 64 + m * 16 + fr) * 4 + wc] = s;
            }
        LDS_BARRIER();
        const int row = wid * 32 + (lane & 31);
        if (lane < 32) {
            const f32x4 p = *(const LAS f32x4*)(P + row * 4);
            __hip_atomic_store(xbuf + ((size_t)(u.pm * 256 + row) * 4 + u.pn), (p.x + p.y) + (p.z + p.w), __ATOMIC_RELAXED, __HIP_MEMORY_SCOPE_AGENT);
        }
        asm volatile("s_waitcnt vmcnt(0)" ::: "memory");
        if (lane == 0) __hip_atomic_fetch_add(cnt + 64 * u.pm, 1u, __ATOMIC_RELAXED, __HIP_MEMORY_SCOPE_AGENT);
        if (wid == 0) {
            const unsigned long long t0 = __builtin_amdgcn_s_memrealtime();
            for (;;) {
                if ((unsigned)__builtin_amdgcn_readfirstlane(__hip_atomic_load(cnt + 64 * u.pm, __ATOMIC_RELAXED, __HIP_MEMORY_SCOPE_AGENT)) >= target) break;
                if (__builtin_amdgcn_s_memrealtime() - t0 > 2000000ull) { if (lane == 0) __hip_atomic_store(tmo, 1u, __ATOMIC_RELAXED, __HIP_MEMORY_SCOPE_AGENT); break; }
                __builtin_amdgcn_s_sleep(2);
            }
            __builtin_amdgcn_fence(__ATOMIC_ACQUIRE, "agent");
        }
        asm volatile("s_waitcnt vmcnt(0) lgkmcnt(0)" ::: "memory"); __builtin_amdgcn_s_barrier(); asm volatile("" ::: "memory");
        if (lane < 32) {
            const float* slot = xbuf + (size_t)(u.pm * 256 + row) * 4; float t = 0.f;
#pragma unroll
            for (int q = 0; q < 4; ++q) t += __hip_atomic_load(slot + q, __ATOMIC_RELAXED, __HIP_MEMORY_SCOPE_AGENT);
            S[row] = rsqrtf(t * (1.f / D) + EPS);
        }
        LDS_BARRIER();
    }
};
struct EpiResNorm {
    static constexpr bool PERM = true, AFTER_DRAIN = true;
    float* hb; bf16* XN; const float* gpost; const float* gpre; RmsExchange e1, e2;
    __device__ __forceinline__ void fused(f32x4 (&acc)[2][2][4][2], const pg8::Unit& u, int wr, int wc, int fr, int fq, LAS unsigned char* lds, int wid, int lane) const {
        const LAS float* S = (const LAS float*)(lds + 8192);
        const int col0 = u.pn * 256 + wc * 32 + 8 * fq;
        f32x4 g0[2], g1[2];
#pragma unroll
        for (int bj = 0; bj < 2; ++bj) { g0[bj] = *(const f32x4*)(gpost + col0 + bj * 128); g1[bj] = *(const f32x4*)(gpost + col0 + bj * 128 + 4); }
        e1.run(acc, u, wr, wc, fr, fq, lds, wid, lane);
#pragma unroll
        for (int ai = 0; ai < 2; ++ai)
#pragma unroll
            for (int m = 0; m < 4; ++m) {
                const int rl = ai * 128 + wr * 64 + m * 16 + fr; const float rs = S[rl];
                float* hp = hb + (size_t)(u.pm * 256 + rl) * D + col0;
                f32x4 h00 = *(const f32x4*)hp, h01 = *(const f32x4*)(hp + 4), h10 = *(const f32x4*)(hp + 128), h11 = *(const f32x4*)(hp + 132);
                h00 += acc[ai][0][m][0] * rs * g0[0]; h01 += acc[ai][0][m][1] * rs * g1[0]; h10 += acc[ai][1][m][0] * rs * g0[1]; h11 += acc[ai][1][m][1] * rs * g1[1];
                *(f32x4*)hp = h00; *(f32x4*)(hp + 4) = h01; *(f32x4*)(hp + 128) = h10; *(f32x4*)(hp + 132) = h11;
                acc[ai][0][m][0] = h00; acc[ai][0][m][1] = h01; acc[ai][1][m][0] = h10; acc[ai][1][m][1] = h11;
                asm volatile("" : "+v"(acc[ai][0][m][0]), "+v"(acc[ai][0][m][1]), "+v"(acc[ai][1][m][0]), "+v"(acc[ai][1][m][1]));
                if (m & 1) asm volatile("" ::: "memory");
            }
        if (!gpre) return;
        e2.run(acc, u, wr, wc, fr, fq, lds, wid, lane);
#pragma unroll
        for (int bj = 0; bj < 2; ++bj) { g0[bj] = *(const f32x4*)(gpre + col0 + bj * 128); g1[bj] = *(const f32x4*)(gpre + col0 + bj * 128 + 4); }
#pragma unroll
        for (int ai = 0; ai < 2; ++ai)
#pragma unroll
            for (int m = 0; m < 4; ++m) {
                const int rl = ai * 128 + wr * 64 + m * 16 + fr; const float rs = S[rl];
                bf16* xp = XN + (size_t)(u.pm * 256 + rl) * D + col0;
                st_bf16x8(xp, acc[ai][0][m][0] * rs * g0[0], acc[ai][0][m][1] * rs * g1[0]);
                st_bf16x8(xp + 128, acc[ai][1][m][0] * rs * g0[1], acc[ai][1][m][1] * rs * g1[1]);
            }
    }
};

__device__ __forceinline__ int prow(int r, int j) {
    if (r < MR) { const int s = r & (SEQ - 1); return (s - j >= 0) ? r - j : MR + (NMETA + s - j); }
    const int t = r - MR; return (t - j >= 0) ? r - j : -1;
}
__device__ __forceinline__ void p2_prep(ArgsP a, int l, int gw, int ngw, int lane, bool meta) {
    unsigned char* ws = a->ws;
    const bf16* Z = (const bf16*)(ws + WS_Z);
    const int nrows = meta ? MT : MR;
    const f32x4 gq = *(const f32x4*)(a->in[I_GDQ] + l * 256 + 4 * lane);
    const f32x2 gk = *(const f32x2*)(a->in[I_GDKV] + l * 128 + 2 * lane);
    const float lg = a->in[I_LNG][l * 64 + lane], lb = a->in[I_LNB][l * 64 + lane];
    for (int r0 = gw * 4; r0 < nrows; r0 += ngw * 4) {
        f32x4 vq[4]; f32x2 vk[4]; float vi[4], vw[4];
#pragma unroll
        for (int i = 0; i < 4; ++i) { const float* zf = (const float*)(ws + WS_ZF) + (size_t)(r0 + i) * ZFW;
            vq[i] = *(const f32x4*)(zf + ZF_CQ + 4 * lane); vk[i] = *(const f32x2*)(zf + ZF_CKV + 2 * lane); vi[i] = zf[ZF_IK + lane]; vw[i] = zf[ZF_IW + (lane & 7)]; }
        float s1[4], s2[4], s3[4];
#pragma unroll
        for (int i = 0; i < 4; ++i) { s1[i] = (vq[i].x * vq[i].x + vq[i].y * vq[i].y) + (vq[i].z * vq[i].z + vq[i].w * vq[i].w); s2[i] = vk[i].x * vk[i].x + vk[i].y * vk[i].y; s3[i] = vi[i]; }
#pragma unroll
        for (int o = 1; o < 64; o <<= 1) {
#pragma unroll
            for (int i = 0; i < 4; ++i) { s1[i] += __shfl_xor(s1[i], o); s2[i] += __shfl_xor(s2[i], o); s3[i] += __shfl_xor(s3[i], o); }
        }
        float d[4], var[4];
#pragma unroll
        for (int i = 0; i < 4; ++i) { d[i] = vi[i] - s3[i] * (1.f / 64.f); var[i] = d[i] * d[i]; }
#pragma unroll
        for (int o = 1; o < 64; o <<= 1) {
#pragma unroll
            for (int i = 0; i < 4; ++i) var[i] += __shfl_xor(var[i], o);
        }
#pragma unroll
        for (int i = 0; i < 4; ++i) { const int r = r0 + i;
            const float r1 = rsqrtf(s1[i] * (1.f / 256.f) + EPS), r2 = rsqrtf(s2[i] * (1.f / 128.f) + EPS);
            const f32x4 q = vq[i] * r1 * gq;
            { u32x2 w; w.x = pk2(q.x, q.y); w.y = pk2(q.z, q.w); *(u32x2*)((bf16*)(ws + WS_CQN) + (size_t)r * 256 + 4 * lane) = w; }
            *(unsigned*)((bf16*)(ws + WS_KV) + (size_t)r * 128 + 2 * lane) = pk2(vk[i].x * r2 * gk.x, vk[i].y * r2 * gk.y);
            ((bf16*)(ws + WS_KI))[(size_t)r * 64 + lane] = (bf16)f2bf(d[i] * rsqrtf(var[i] * (1.f / 64.f) + EPS) * lg + lb);
            if (lane < 8) ((float*)(ws + WS_WI))[(size_t)r * 8 + lane] = vw[i] * 0.35355339059327373f; }
    }
}
__device__ __forceinline__ void p2_chunks(ArgsP a, LAS unsigned char* lds, int l, int gw, int ngw, int wave, int lane, bool meta) {
    unsigned char* ws = a->ws;
    const bf16* Z = (const bf16*)(ws + WS_Z);
    float* DDp = (float*)(ws + WS_DD);
    LAS float* stg = (LAS float*)(lds + wave * 5120);
    const int nitems = meta ? 257 * 8 : 256 * 8;
    for (int it = gw; it < nitems; it += ngw) {
        const int cid = it >> 3, mx = (it >> 2) & 1, h = it & 3;
        const int nrows = cid == 256 ? NMETA : 64, rbase = cid == 256 ? MR : cid * 64;
        const int k0 = 2 * lane;
        const float* ZFr = (const float*)(ws + WS_ZF);
        const int rl = rbase + (lane < nrows ? lane : 0);
        if (!mx) {
            { const float* zf = ZFr + (size_t)rl * ZFW + ZF_A;
              const f32x4 a0 = *(const f32x4*)zf, a1 = *(const f32x4*)(zf + 4), a2 = *(const f32x4*)(zf + 8), a3 = *(const f32x4*)(zf + 12);
              *(LAS f32x4*)(stg + lane * 16) = a0; *(LAS f32x4*)(stg + lane * 16 + 4) = a1; *(LAS f32x4*)(stg + lane * 16 + 8) = a2; *(LAS f32x4*)(stg + lane * 16 + 12) = a3; }
            float w0[16], w1[16];
#pragma unroll
            for (int j = 0; j < 16; ++j) { const f32x2 w = *(const f32x2*)(a->in[I_WA2] + (size_t)(l * 16 + j) * 512 + h * 128 + k0); w0[j] = w.x; w1[j] = w.y; }
            const f32x2 bb = *(const f32x2*)(a->in[I_BA] + l * 512 + h * 128 + k0);
            bf16* QG = (bf16*)(ws + WS_G);
            float G0 = 0.f, G1 = 0.f;
            unsigned pq[16], pk[16];
#define P2G_LOAD(t0) do { _Pragma("unroll") for (int i = 0; i < 16; ++i) { const int r_ = rbase + (t0) + i; \
                pq[i] = *(const unsigned*)(Z + (size_t)r_ * ZB + ZC_GQ + h * 128 + k0); pk[i] = *(const unsigned*)(Z + (size_t)r_ * ZB + ZC_GK + h * 128 + k0); } } while (0)
            P2G_LOAD(0);
            LDS_WAIT();
            for (int t0 = 0; t0 < nrows; t0 += 16) {
                unsigned cqw[16], ckw[16];
#pragma unroll
                for (int i = 0; i < 16; ++i) { cqw[i] = pq[i]; ckw[i] = pk[i]; }
                if (t0 + 16 < nrows) P2G_LOAD(t0 + 16);
#pragma unroll
                for (int i = 0; i < 16; ++i) {
                    const int r = rbase + t0 + i;
                    const LAS float* ar = stg + (t0 + i) * 16;
                    const f32x4 a0 = *(const LAS f32x4*)ar, a1 = *(const LAS f32x4*)(ar + 4), a2 = *(const LAS f32x4*)(ar + 8), a3 = *(const LAS f32x4*)(ar + 12);
                    const float av[16] = {a0.x, a0.y, a0.z, a0.w, a1.x, a1.y, a1.z, a1.w, a2.x, a2.y, a2.z, a2.w, a3.x, a3.y, a3.z, a3.w};
                    float s0 = bb.x, s1 = bb.y;
#pragma unroll
                    for (int j = 0; j < 16; ++j) { s0 += av[j] * w0[j]; s1 += av[j] * w1[j]; }
                    G0 += logsigmoid_f(s0) * 0.0625f; G1 += logsigmoid_f(s1) * 0.0625f;
                    const float e0 = __expf(G0), e1 = __expf(G1), i0 = __builtin_amdgcn_rcpf(e0), i1 = __builtin_amdgcn_rcpf(e1);
                    *(unsigned*)(QG + (size_t)r * 1024 + h * 128 + k0) = pk2(bflo(cqw[i]) * e0, bfhi(cqw[i]) * e1);
                    *(unsigned*)(QG + (size_t)r * 1024 + 512 + h * 128 + k0) = pk2(bflo(ckw[i]) * i0, bfhi(ckw[i]) * i1);
                }
            }
#undef P2G_LOAD
            *(f32x2*)(DDp + ((size_t)cid * 4 + h) * 128 + k0) = (f32x2){__expf(G0), __expf(G1)};
            LDS_WAIT();
        } else {
            { const float* zf = ZFr + (size_t)rl * ZFW; stg[lane * 2] = zf[ZF_MI + h]; stg[lane * 2 + 1] = zf[ZF_MF + h]; }
            float cq[4][2], ck[4][2];
#pragma unroll
            for (int tap = 0; tap < 4; ++tap) { const f32x2 wq = *(const f32x2*)(a->in[I_CONV] + (size_t)(l * 4 + tap) * 1024 + h * 128 + k0), wk = *(const f32x2*)(a->in[I_CONV] + (size_t)(l * 4 + tap) * 1024 + 512 + h * 128 + k0);
                cq[tap][0] = wq.x; cq[tap][1] = wq.y; ck[tap][0] = wk.x; ck[tap][1] = wk.y; }
            const float fb = a->in[I_FB][l * 4 + h];
            bf16* QM = (bf16*)(ws + WS_QKC);
            float xq[3][2], xk[3][2];
#pragma unroll
            for (int j = 0; j < 3; ++j) {
                const int rp = prow(rbase, j + 1);
                const int rpc = rp >= 0 ? rp : rbase; const float m = rp >= 0 ? 1.f : 0.f;
                const unsigned qw = *(const unsigned*)(Z + (size_t)rpc * ZB + ZC_MQ + h * 128 + k0), kw = *(const unsigned*)(Z + (size_t)rpc * ZB + ZC_MK + h * 128 + k0);
                xq[j][0] = bflo(qw) * m; xq[j][1] = bfhi(qw) * m; xk[j][0] = bflo(kw) * m; xk[j][1] = bfhi(kw) * m;
            }
            float bsum = 0.f;
            unsigned pq[16], pk[16];
#define P2M_LOAD(t0) do { _Pragma("unroll") for (int i = 0; i < 16; ++i) { const int r_ = rbase + (t0) + i; \
                pq[i] = *(const unsigned*)(Z + (size_t)r_ * ZB + ZC_MQ + h * 128 + k0); pk[i] = *(const unsigned*)(Z + (size_t)r_ * ZB + ZC_MK + h * 128 + k0); } } while (0)
            P2M_LOAD(0);
            LDS_WAIT();
            for (int t0 = 0; t0 < nrows; t0 += 16) {
                unsigned cqw[16], ckw[16];
#pragma unroll
                for (int i = 0; i < 16; ++i) { cqw[i] = pq[i]; ckw[i] = pk[i]; }
                if (t0 + 16 < nrows) P2M_LOAD(t0 + 16);
#pragma unroll
                for (int i = 0; i < 16; ++i) {
                    const int r = rbase + t0 + i;
                    const f32x2 gt = *(const LAS f32x2*)(stg + (t0 + i) * 2);
                    const float li = gt.x, lf = logsigmoid_f(gt.y + fb);
                    bsum += lf;
                    const float q0 = bflo(cqw[i]), q1 = bfhi(cqw[i]), kk0 = bflo(ckw[i]), kk1 = bfhi(ckw[i]);
                    const float yq0 = cq[3][0] * q0 + cq[2][0] * xq[0][0] + cq[1][0] * xq[1][0] + cq[0][0] * xq[2][0];
                    const float yq1 = cq[3][1] * q1 + cq[2][1] * xq[0][1] + cq[1][1] * xq[1][1] + cq[0][1] * xq[2][1];
                    const float yk0 = ck[3][0] * kk0 + ck[2][0] * xk[0][0] + ck[1][0] * xk[1][0] + ck[0][0] * xk[2][0];
                    const float yk1 = ck[3][1] * kk1 + ck[2][1] * xk[0][1] + ck[1][1] * xk[1][1] + ck[0][1] * xk[2][1];
                    xq[2][0] = xq[1][0]; xq[2][1] = xq[1][1]; xq[1][0] = xq[0][0]; xq[1][1] = xq[0][1]; xq[0][0] = q0; xq[0][1] = q1;
                    xk[2][0] = xk[1][0]; xk[2][1] = xk[1][1]; xk[1][0] = xk[0][0]; xk[1][1] = xk[0][1]; xk[0][0] = kk0; xk[0][1] = kk1;
                    const float eq = __expf(bsum) * 0.08838834764831845f, ek = __expf(li - bsum);
                    *(unsigned*)(QM + (size_t)r * 1024 + h * 128 + k0) = pk2(silu_f(yq0) * eq, silu_f(yq1) * eq);
                    *(unsigned*)(QM + (size_t)r * 1024 + 512 + h * 128 + k0) = pk2(silu_f(yk0) * ek, silu_f(yk1) * ek);
                }
            }
#undef P2M_LOAD
            const float dd = __expf(bsum);
            *(f32x2*)(DDp + ((size_t)(257 + cid) * 4 + h) * 128 + k0) = (f32x2){dd, dd};
            LDS_WAIT();
        }
    }
}

constexpr int SC_QS = 288, SC_VS = 160;
constexpr int SC_QB = 64 * SC_QS, SC_VB = 64 * SC_VS;
constexpr int SC_QT = 0, SC_KT = 2 * SC_QB, SC_VT = 4 * SC_QB, SC_AT = SC_VT + 2 * SC_VB, SC_SB = SC_AT + SC_VB, SC_DD = SC_SB + 2 * SC_QB, SC_NB = SC_DD + 1024, SC_END = SC_NB + 512;
static_assert(SC_END <= RING_BYTES, "scan LDS");
__device__ __forceinline__ bf16x8 tr8(LAS unsigned char* base, int stride, int row0, int col0, int lane) {
    const int fq = lane >> 4, q4 = (lane & 15) >> 2, p4 = lane & 3;
    LAS unsigned char* p = base + (row0 + 8 * fq + q4) * stride + (col0 + 4 * p4) * 2;
    const s16x4 lo = __builtin_amdgcn_ds_read_tr16_b64_v4i16((LAS s16x4*)p);
    const s16x4 hi = __builtin_amdgcn_ds_read_tr16_b64_v4i16((LAS s16x4*)(p + 4 * stride));
    return __builtin_shufflevector(lo, hi, 0, 1, 2, 3, 4, 5, 6, 7);
}
template <bool ML>
__device__ __forceinline__ void scan_unit(ArgsP a, LAS unsigned char* lds, int b, int h, int vs, int tid_in) {
    int tid = tid_in; asm volatile("" : "+v"(tid));
    unsigned char* ws = a->ws;
    const bf16* Z = (const bf16*)(ws + WS_Z);
    const bf16* QK = (const bf16*)(ws + (ML ? WS_QKC : WS_G));
    const float* DDp = (const float*)(ws + WS_DD) + (ML ? (size_t)257 * 512 : 0);
    bf16* O = (bf16*)(ws + (ML ? WS_OM : WS_OG));
    const int lane = tid & 63, wave = __builtin_amdgcn_readfirstlane(tid >> 6), fr = lane & 15, fq = lane >> 4;
    const int vt = wave & 3, hh = wave >> 2;
    for (int i = tid; i < (2 * SC_QB + 1024 + 512) / 4; i += 512) ((LAS unsigned*)(lds + SC_SB))[i] = 0u;
    f32x4 S[4], nacc[4];
#pragma unroll
    for (int i = 0; i < 4; ++i) { S[i] = (f32x4){0.f, 0.f, 0.f, 0.f}; nacc[i] = (f32x4){0.f, 0.f, 0.f, 0.f}; }
    const bf16x8 ones = {(short)0x3F80, (short)0x3F80, (short)0x3F80, (short)0x3F80, (short)0x3F80, (short)0x3F80, (short)0x3F80, (short)0x3F80};
    struct SSet { u32x4 gq[2], gk[2], gv; float gd; };
    SSet sA, sB; sA.gd = 0.f; sB.gd = 0.f;
    const int vcol = (ML ? ZC_MV : ZC_GV) + h * 256 + vs * 64;
    const bf16* zpage = (const bf16*)(ws + WS_CTL + 512 * 1024);
#define SCAN_LOAD(S, c) do { const int c_ = (c); \
        _Pragma("unroll") for (int e = 0; e < 2; ++e) { const int pid = tid + 512 * e, t = pid >> 4, ch = pid & 15; \
            const bool ok = c_ > 0 || t >= 48; const int row = c_ == 0 ? MR + t - 48 : b * SEQ + (c_ - 1) * 64 + t; \
            const bf16* qp_ = ok ? QK + (size_t)row * 1024 + h * 128 + ch * 8 : zpage; \
            S.gq[e] = *(const u32x4*)qp_; S.gk[e] = *(const u32x4*)(qp_ + 512); } \
        { const int t = tid >> 3, ch = tid & 7; const bool ok = c_ > 0 || t >= 48; const int row = c_ == 0 ? MR + t - 48 : b * SEQ + (c_ - 1) * 64 + t; \
          S.gv = *(const u32x4*)(ok ? Z + (size_t)row * ZB + vcol + ch * 8 : zpage); } \
        { const int cid = c_ == 0 ? 256 : b * 32 + (c_ - 1); S.gd = DDp[((size_t)cid * 4 + h) * 128 + (tid & 127)]; } } while (0)
#define SCAN_STORE(S, buf) do { const int bo_ = (buf); \
        _Pragma("unroll") for (int e = 0; e < 2; ++e) { const int pid = tid + 512 * e, t = pid >> 4, ch = pid & 15; \
            *(LAS u32x4*)(lds + SC_QT + bo_ * SC_QB + t * SC_QS + ch * 16) = S.gq[e]; *(LAS u32x4*)(lds + SC_KT + bo_ * SC_QB + t * SC_QS + ch * 16) = S.gk[e]; } \
        { const int t = tid >> 3, ch = tid & 7; *(LAS u32x4*)(lds + SC_VT + bo_ * SC_VB + t * SC_VS + ch * 16) = S.gv; } \
        if (tid < 128) ((LAS float*)(lds + SC_DD))[bo_ * 128 + tid] = S.gd; } while (0)
    SCAN_LOAD(sA, 0);
    __syncthreads();
    SCAN_STORE(sA, 0);
    __syncthreads();
    SCAN_LOAD(sB, 1);
    auto body = [&](const int c, SSet& Ld, SSet& St) __attribute__((always_inline)) {
        const int buf = c & 1;
        LAS unsigned char* QT = lds + SC_QT + buf * SC_QB; LAS unsigned char* KT = lds + SC_KT + buf * SC_QB; LAS unsigned char* VT = lds + SC_VT + buf * SC_VB;
        LAS unsigned char* AT = lds + SC_AT; LAS unsigned char* SB = lds + SC_SB + buf * SC_QB; LAS unsigned char* SBn = lds + SC_SB + (buf ^ 1) * SC_QB;
        const LAS float* ddL = (const LAS float*)(lds + SC_DD) + buf * 128;
        if (c + 2 < 33) SCAN_LOAD(Ld, c + 2);
        {
            const int ti = wave >> 1;
            bf16x8 qa[4];
            if (2 * (wave & 1) <= ti) {
#pragma unroll
                for (int ks = 0; ks < 4; ++ks) qa[ks] = *(const LAS bf16x8*)(QT + (16 * ti + fr) * SC_QS + (32 * ks + 8 * fq) * 2);
            }
#pragma unroll
            for (int sj = 0; sj < 2; ++sj) {
                const int si = 2 * (wave & 1) + sj;
                const int tg = 16 * ti + fr, sg = 16 * si + 4 * fq;
                if (si > ti) { *(LAS u32x2*)(AT + tg * SC_VS + sg * 2) = (u32x2){0u, 0u}; continue; }
                f32x4 acc = {0.f, 0.f, 0.f, 0.f};
                bf16x8 kb[4];
#pragma unroll
                for (int ks = 0; ks < 4; ++ks) kb[ks] = *(const LAS bf16x8*)(KT + (16 * si + fr) * SC_QS + (32 * ks + 8 * fq) * 2);
                asm volatile("" ::: "memory");
#pragma unroll
                for (int ks = 0; ks < 4; ++ks) acc = __builtin_amdgcn_mfma_f32_16x16x32_bf16(kb[ks], qa[ks], acc, 0, 0, 0);
                u32x2 aw; aw.x = pk2(sg + 0 <= tg ? acc.x : 0.f, sg + 1 <= tg ? acc.y : 0.f); aw.y = pk2(sg + 2 <= tg ? acc.z : 0.f, sg + 3 <= tg ? acc.w : 0.f);
                *(LAS u32x2*)(AT + tg * SC_VS + sg * 2) = aw;
            }
        }
        {
            const bf16x8 vb0 = tr8(VT, SC_VS, 0, 16 * vt, lane), vb1 = tr8(VT, SC_VS, 32, 16 * vt, lane);
#pragma unroll
            for (int i = 0; i < 4; ++i) {
                const int kt = 4 * hh + i;
                const bf16x8 ka0 = tr8(KT, SC_QS, 0, 16 * kt, lane), ka1 = tr8(KT, SC_QS, 32, 16 * kt, lane);
                f32x4 acc = S[i];
                acc = __builtin_amdgcn_mfma_f32_16x16x32_bf16(ka0, vb0, acc, 0, 0, 0);
                acc = __builtin_amdgcn_mfma_f32_16x16x32_bf16(ka1, vb1, acc, 0, 0, 0);
                const f32x4 dv = *(const LAS f32x4*)(ddL + 16 * kt + 4 * fq);
                S[i] = acc * dv;
                if (ML) {
                    f32x4 na = nacc[i];
                    na = __builtin_amdgcn_mfma_f32_16x16x32_bf16(ka0, ones, na, 0, 0, 0);
                    na = __builtin_amdgcn_mfma_f32_16x16x32_bf16(ka1, ones, na, 0, 0, 0);
                    nacc[i] = na * dv;
                }
            }
        }
        {
#pragma unroll
            for (int i = 0; i < 4; ++i) {
                const int k0 = 16 * (4 * hh + i) + 4 * fq;
                u32x2 sw; sw.x = pk2(S[i].x, S[i].y); sw.y = pk2(S[i].z, S[i].w);
                *(LAS u32x2*)(SBn + (16 * vt + fr) * SC_QS + k0 * 2) = sw;
                if (ML && vt == 0 && fr == 0) { LAS bf16* np = (LAS bf16*)(lds + SC_NB + (buf ^ 1) * 256) + k0; np[0] = (bf16)f2bf(nacc[i].x); np[1] = (bf16)f2bf(nacc[i].y); np[2] = (bf16)f2bf(nacc[i].z); np[3] = (bf16)f2bf(nacc[i].w); }
            }
        }
        LDS_BARRIER();
#if defined(DIAG_SEL)
        if (blockIdx.x == 0 && tid == 0) { volatile LAS unsigned* M_ = (volatile LAS unsigned*)(lds + MISC_OFF); const unsigned now_ = (unsigned)__builtin_amdgcn_s_memrealtime(); M_[16 + 12] += now_ - M_[15]; M_[15] = now_; }
#endif
        {
            const bf16x8 vb0 = tr8(VT, SC_VS, 0, 16 * vt, lane), vb1 = tr8(VT, SC_VS, 32, 16 * vt, lane);
            bf16x8 sb[4];
#pragma unroll
            for (int ks = 0; ks < 4; ++ks) sb[ks] = *(const LAS bf16x8*)(SB + (16 * vt + fr) * SC_QS + (32 * ks + 8 * fq) * 2);
            bf16x8 nb[4];
            if (ML) {
#pragma unroll
                for (int ks = 0; ks < 4; ++ks) nb[ks] = *(const LAS bf16x8*)(lds + SC_NB + buf * 256 + (32 * ks + 8 * fq) * 2);
            }
            u32x2 ow[2];
#pragma unroll
            for (int tj = 0; tj < 2; ++tj) {
                const int ti = 2 * hh + tj;
                f32x4 acc = {0.f, 0.f, 0.f, 0.f}, den = {0.f, 0.f, 0.f, 0.f};
                bf16x8 qa[4];
#pragma unroll
                for (int ks = 0; ks < 4; ++ks) qa[ks] = *(const LAS bf16x8*)(QT + (16 * ti + fr) * SC_QS + (32 * ks + 8 * fq) * 2);
                const bf16x8 aa0 = *(const LAS bf16x8*)(AT + (16 * ti + fr) * SC_VS + (8 * fq) * 2), aa1 = *(const LAS bf16x8*)(AT + (16 * ti + fr) * SC_VS + (32 + 8 * fq) * 2);
                asm volatile("" ::: "memory");
#pragma unroll
                for (int ks = 0; ks < 4; ++ks) {
                    acc = __builtin_amdgcn_mfma_f32_16x16x32_bf16(sb[ks], qa[ks], acc, 0, 0, 0);
                    if (ML) den = __builtin_amdgcn_mfma_f32_16x16x32_bf16(nb[ks], qa[ks], den, 0, 0, 0);
                }
                acc = __builtin_amdgcn_mfma_f32_16x16x32_bf16(vb0, aa0, acc, 0, 0, 0);
                acc = __builtin_amdgcn_mfma_f32_16x16x32_bf16(vb1, aa1, acc, 0, 0, 0);
                if (ML) {
                    den = __builtin_amdgcn_mfma_f32_16x16x32_bf16(ones, aa0, den, 0, 0, 0);
                    den = __builtin_amdgcn_mfma_f32_16x16x32_bf16(ones, aa1, den, 0, 0, 0);
                    const float rd = __builtin_amdgcn_rcpf(fmaxf(fabsf(den.x), 1.f));
                    acc *= rd;
                }
                ow[tj].x = pk2(acc.x, acc.y); ow[tj].y = pk2(acc.z, acc.w);
            }
            if (c + 1 < 33) SCAN_STORE(St, buf ^ 1);
#pragma unroll
            for (int tj = 0; tj < 2; ++tj) {
                const int t = 16 * (2 * hh + tj) + fr;
                const bool okr = c > 0 || t >= 48;
                const int rowb = c == 0 ? MR + t - 48 : b * SEQ + (c - 1) * 64 + t;
                bf16* op = okr ? O + (size_t)rowb * 1024 + h * 256 + vs * 64 + 16 * vt + 4 * fq : (bf16*)(ws + WS_BIN + 512 * 1024) + (size_t)tid * 4;
                *(u32x2*)op = ow[tj];
            }
        }
        LDS_BARRIER();
#if defined(DIAG_SEL)
        if (blockIdx.x == 0 && tid == 0) { volatile LAS unsigned* M_ = (volatile LAS unsigned*)(lds + MISC_OFF); const unsigned now_ = (unsigned)__builtin_amdgcn_s_memrealtime(); M_[16 + 13] += now_ - M_[15]; M_[15] = now_; }
#endif
    };
    for (int c = 0; c < 33; c += 2) { body(c, sA, sB); if (c + 1 < 33) body(c + 1, sB, sA); }
#undef SCAN_LOAD
#undef SCAN_STORE
}

constexpr int MX_Z = 16 * 384, MX_ITEMS = MX_Z + 2048 + 2048 + 256 + 128 + 128 + 128;
constexpr size_t MX_SLOT = 176 * 1024;
static_assert((size_t)MX_ITEMS * 16 <= MX_SLOT && 4 * MX_SLOT <= MiB, "meta save area");
__device__ __forceinline__ void meta_xfer(ArgsP a, int l, bool save, int tid) {
    unsigned char* ws = a->ws;
    unsigned char* S = ws + WS_LIF + (size_t)l * MX_SLOT;
    const int nth = (int)gridDim.x * 512;
    for (int i = save ? nth - 1 - ((int)blockIdx.x * 512 + tid) : (int)blockIdx.x * 512 + tid; i < MX_ITEMS; i += nth) {
        unsigned char* p;
        if (i < MX_Z) { const int t = i / 384, j = i % 384; p = ws + WS_Z + ((size_t)(MR + t) * ZB + (j < 128 ? ZC_GV + 8 * j : ZC_MQ + 8 * (j - 128))) * 2; }
        else if (i < MX_Z + 2048) p = ws + WS_G + (size_t)MR * 1024 * 2 + (size_t)(i - MX_Z) * 16;
        else if (i < MX_Z + 4096) p = ws + WS_QKC + (size_t)MR * 1024 * 2 + (size_t)(i - MX_Z - 2048) * 16;
        else if (i < MX_Z + 4352) p = ws + WS_KV + (size_t)MR * 128 * 2 + (size_t)(i - MX_Z - 4096) * 16;
        else if (i < MX_Z + 4480) p = ws + WS_KI + (size_t)MR * 64 * 2 + (size_t)(i - MX_Z - 4352) * 16;
        else if (i < MX_Z + 4608) p = ws + WS_DD + (size_t)256 * 512 * 4 + (size_t)(i - MX_Z - 4480) * 16;
        else p = ws + WS_DD + (size_t)(257 + 256) * 512 * 4 + (size_t)(i - MX_Z - 4608) * 16;
        unsigned char* q = S + (size_t)i * 16;
        if (save) *(u32x4*)q = *(const u32x4*)p; else *(u32x4*)p = *(const u32x4*)q;
    }
}

template <bool DRY = false>
__device__ __forceinline__ void p6_headnorm(ArgsP a, int l, int gw, int ngw, int lane, LAS unsigned* ctr = nullptr, int nrows = MT) {
    unsigned char* ws = a->ws; const bf16* Z = (const bf16*)(ws + WS_Z);
    const f32x4 gg0 = *(const f32x4*)(a->in[I_GGLA] + l * 256 + 4 * lane), gg1 = *(const f32x4*)(a->in[I_GML] + l * 256 + 4 * lane);
    const int wbase = gw & ~7, nslot = 8 * ((nrows + ngw - 1) / ngw);
    for (int k_ = 0;; ++k_) {
        int r;
        if (ctr) { unsigned s_ = 0u; if (lane == 0) s_ = __hip_atomic_fetch_add(ctr, 1u, __ATOMIC_RELAXED, __HIP_MEMORY_SCOPE_WORKGROUP);
                   s_ = (unsigned)__builtin_amdgcn_readfirstlane((int)s_); if (s_ >= (unsigned)nslot) break; r = wbase + (int)(s_ & 7u) + ngw * (int)(s_ >> 3); if (r >= nrows) continue; }
        else { r = gw + ngw * k_; if (r >= nrows) break; }
        u32x2 w[8], gw2[8]; bf16* op[8];
#pragma unroll
        for (int i = 0; i < 8; ++i) { const int mx = i >> 2, h = i & 3;
            op[i] = (bf16*)(ws + (mx ? WS_OM : WS_OG)) + (size_t)r * 1024 + h * 256 + 4 * lane;
            w[i] = *(const u32x2*)op[i];
            gw2[i] = *(const u32x2*)(Z + (size_t)r * ZB + (mx ? ZC_MO : ZC_GR) + h * 256 + 4 * lane); }
        f32x4 v[8]; float ss[8];
#pragma unroll
        for (int i = 0; i < 8; ++i) { v[i] = (f32x4){bflo(w[i].x), bfhi(w[i].x), bflo(w[i].y), bfhi(w[i].y)}; ss[i] = (v[i].x * v[i].x + v[i].y * v[i].y) + (v[i].z * v[i].z + v[i].w * v[i].w); }
#pragma unroll
        for (int o = 1; o < 64; o <<= 1) {
#pragma unroll
            for (int i = 0; i < 8; ++i) ss[i] += __shfl_xor(ss[i], o);
        }
#pragma unroll
        for (int i = 0; i < 8; ++i) {
            const int mx = i >> 2;
            const float rr = rsqrtf(ss[i] * (1.f / 256.f) + EPS);
            const f32x4 gt = {bflo(gw2[i].x), bfhi(gw2[i].x), bflo(gw2[i].y), bfhi(gw2[i].y)};
            const f32x4 o4 = v[i] * rr * (mx ? gg1 : gg0) * gt;
            u32x2 o; o.x = pk2(o4.x, o4.y); o.y = pk2(o4.z, o4.w);
            *(u32x2*)(DRY ? (bf16*)(ws + WS_XN) + ((size_t)r * 1024 + (i & 3) * 256 + 4 * lane) : op[i]) = o;
        }
    }
}

__device__ __forceinline__ int krow(int b, int s) { return s < NMETA ? MR + s : b * SEQ + (s - NMETA); }
__device__ __forceinline__ int t5_bucket(int n) {
    if (n < 16) return n < 0 ? 0 : n;
    const int lg = 16 + (int)(__logf((float)n * (1.f / 16.f)) / 2.0794415416798357f * 16.f);
    return lg < 31 ? lg : 31;
}
__device__ __forceinline__ unsigned off_b(unsigned row, unsigned ch) { return 256u * row + 16u * (ch ^ (((row & 3) << 2) | ((row >> 2) & 3))); }
__device__ __forceinline__ s16x4 tr_rd(LAS unsigned char* p) { return __builtin_amdgcn_ds_read_tr16_b64_v4i16((LAS s16x4*)p); }

constexpr int DW2_STRIDE = 9472, DW2_TILE = 0, DW2_SEL = 8192, DW2_BK = 8832, DSA2_T5 = 8 * DW2_STRIDE, DSA2_BT = DSA2_T5 + 2048 + 64, DSA2_QC = DSA2_BT + 4160;

__device__ __forceinline__ int wave_sum_dpp(int x) {
    x += __builtin_amdgcn_update_dpp(0, x, 0xB1, 0xf, 0xf, false);
    x += __builtin_amdgcn_update_dpp(0, x, 0x4E, 0xf, 0xf, false);
    x += __builtin_amdgcn_update_dpp(0, x, 0x141, 0xf, 0xf, false);
    x += __builtin_amdgcn_update_dpp(0, x, 0x140, 0xf, 0xf, false);
    return __builtin_amdgcn_readlane(x, 0) + __builtin_amdgcn_readlane(x, 16) + __builtin_amdgcn_readlane(x, 32) + __builtin_amdgcn_readlane(x, 48);
}
__device__ __forceinline__ int wave_scan_dpp(int x) {
    x += __builtin_amdgcn_update_dpp(0, x, 0x111, 0xf, 0xf, false);
    x += __builtin_amdgcn_update_dpp(0, x, 0x112, 0xf, 0xf, false);
    x += __builtin_amdgcn_update_dpp(0, x, 0x114, 0xf, 0xf, false);
    x += __builtin_amdgcn_update_dpp(0, x, 0x118, 0xf, 0xf, false);
    x += __builtin_amdgcn_update_dpp(0, x, 0x142, 0xa, 0xf, false);
    x += __builtin_amdgcn_update_dpp(0, x, 0x143, 0xc, 0xf, false);
    return x;
}
#if defined(DIAG_SEL)
#ifndef DIAG_BLK
#define DIAG_BLK 31
#endif
#define DSTAMP(slot) do { if (blockIdx.x == DIAG_BLK && threadIdx.x == 0) { volatile LAS unsigned* M_ = (volatile LAS unsigned*)(lds + MISC_OFF); const unsigned now_ = (unsigned)__builtin_amdgcn_s_memrealtime(); M_[slot] += now_ - M_[14]; M_[14] = now_; } } while (0)
#else
#define DSTAMP(slot) do {} while (0)
#endif
template <int NR>
__device__ __forceinline__ void dsa_select(const unsigned* scr, int nk, int p, int lane, LAS unsigned char* lds, LAS unsigned char* tile, LAS unsigned short* selL, LAS unsigned short* bkL, const LAS unsigned short* bkT, int rowbase) {
    const int row0 = lane < NMETA ? MR + lane : rowbase + lane, rowl = rowbase + lane;
    unsigned u[NR];
#pragma unroll
    for (int i = 0; i < NR; ++i) { const int s = lane + 64 * i; u[i] = s < nk ? __hip_atomic_load(scr + s, __ATOMIC_RELAXED, __HIP_MEMORY_SCOPE_AGENT) : 0u; }
    {

            unsigned tau = 0u;
            for (int bit = 31; bit >= 16; --bit) {
                const unsigned cand = tau | (1u << bit);
                int cnt = 0;
#pragma unroll
                for (int i = 0; i < NR; ++i) cnt += (u[i] >= cand) ? 1 : 0;
                if (wave_sum_dpp(cnt) >= 256) tau = cand;
            }
            DSTAMP(16);
            {
                const unsigned hi = tau >> 16;
                int cab = 0, cc = 0;
#pragma unroll
                for (int i = 0; i < NR; ++i) { const unsigned uh = u[i] >> 16; cab += (uh > hi) ? 1 : 0; cc += (uh == hi) ? 1 : 0; }
                cab = wave_sum_dpp(cab);
                const int cin = wave_scan_dpp(cc);
                const int ncand = __builtin_amdgcn_readlane(cin, 63);
                LAS unsigned short* candL = (LAS unsigned short*)tile;
                int off = cin - cc;
#pragma unroll
                for (int i = 0; i < NR; ++i) { const bool is = (u[i] >> 16) == hi; candL[is ? off : 3072 + lane] = (unsigned short)(u[i] & 0xffffu); off += is ? 1 : 0; }
                LDS_WAIT();
                const int need = 256 - cab;
                unsigned lo = 0u;
                if (ncand <= 64) {
                    const unsigned v = lane < ncand ? (unsigned)candL[lane] + 1u : 0u;
                    for (int bit = 15; bit >= 0; --bit) { const unsigned cand = lo | (1u << bit); if (__popcll(__ballot(v >= cand + 1u)) >= need) lo = cand; }
                } else {
                    for (int bit = 15; bit >= 0; --bit) {
                        const unsigned cand = lo | (1u << bit); int cnt = 0;
                        for (int j = lane; j < ((ncand + 63) & ~63); j += 64) { const unsigned v = j < ncand ? (unsigned)candL[j] + 1u : 0u; cnt += __popcll(__ballot(v >= cand + 1u)); }
                        if (cnt >= need) lo = cand;
                    }
                }
                tau |= lo;
                LDS_WAIT();
            }
            DSTAMP(17);
            unsigned short bkv[NR];
#pragma unroll
            for (int i = 0; i < NR; ++i) { const int d = p - (lane + 64 * i); bkv[i] = bkT[d > 0 ? d : 0]; }
            int cge = 0, ceq = 0;
#pragma unroll
            for (int i = 0; i < NR; ++i) { cge += (u[i] >= tau) ? 1 : 0; ceq += (u[i] == tau) ? 1 : 0; }
            const int tge = wave_sum_dpp(cge);
            if (tge == 256) {
                const int cin = wave_scan_dpp(cge);
                int off = cin - cge;
#pragma unroll
                for (int i = 0; i < NR; ++i) { const bool take = u[i] >= tau; const int pos = take ? off : 256 + lane;
                    selL[pos] = (unsigned short)(i == 0 ? row0 : rowl + 64 * i); bkL[pos] = bkv[i]; off += take ? 1 : 0; }
            } else {
                const int rem = 256 - (tge - wave_sum_dpp(ceq));
                const unsigned long long lt = (1ull << lane) - 1ull;
                int base = 0, eqseen = 0;
#pragma unroll
                for (int i = 0; i < NR; ++i) {
                    const bool gt = u[i] > tau, eq = u[i] == tau;
                    const unsigned long long meq = __ballot(eq);
                    const bool take = gt || (eq && (eqseen + __popcll(meq & lt)) < rem);
                    const unsigned long long mt = __ballot(take);
                    const int pos = take ? base + __popcll(mt & lt) : 256 + lane;
                    selL[pos] = (unsigned short)(i == 0 ? row0 : rowl + 64 * i); bkL[pos] = bkv[i];
                    base += __popcll(mt); eqseen += __popcll(meq);
                }
            }
    }
}
struct DsaGeom {
    int b, cA, hf;
    __device__ __forceinline__ int chunk(int qt) const { return qt < 2 ? cA : 31 - cA; }
    __device__ __forceinline__ int pos0(int qt) const { return NMETA + 64 * chunk(qt) + 32 * hf + 16 * (qt & 1); }
    __device__ __forceinline__ int row0(int qt) const { return b * SEQ + 64 * chunk(qt) + 32 * hf + 16 * (qt & 1); }
};
template <bool DENSE_ONLY>
__device__ __forceinline__ void dsa_unit(ArgsP a, LAS unsigned char* lds, int u_, int nq, int wave, int lane_in) {
    int lane = lane_in; asm volatile("" : "+v"(lane));
    unsigned char* ws = a->ws;
    const bf16* QQ = (const bf16*)(ws + WS_QQ); const bf16* KI = (const bf16*)(ws + WS_KI); const bf16* KV = (const bf16*)(ws + WS_KV);
    unsigned* SC = (unsigned*)(ws + WS_SC) + (size_t)blockIdx.x * 64 * SC_PITCH;
    const DsaGeom G{u_ >> 5, (u_ & 31) >> 1, u_ & 1};
    const int b = DENSE_ONLY ? 0 : G.b;
    const int fr = lane & 15, fq = lane >> 4;
    if (!DENSE_ONLY) {
        if (wave == 0 && lane == 0) *(LAS unsigned*)(lds + DSA2_QC) = 0u;
        int nt[4], T = 0;
#pragma unroll
        for (int qt = 0; qt < 4; ++qt) { nt[qt] = G.pos0(qt) + 15 >= 256 ? G.pos0(qt) / 16 + 1 : 0; T += nt[qt]; }
        const int lo = wave * T / 8, hi = (wave + 1) * T / 8;
        int base = 0;
        for (int qt = 0; qt < 4; ++qt) {
            const int ntq = qt == 0 ? nt[0] : qt == 1 ? nt[1] : qt == 2 ? nt[2] : nt[3];
            const int k0 = lo > base ? lo - base : 0, k1 = hi - base < ntq ? hi - base : ntq;
            base += ntq;
            if (k0 >= k1) continue;
            const int qrow = G.row0(qt) + fr, pq = G.pos0(qt) + fr;
            bf16x8 qf[8][2];
#pragma unroll
            for (int h = 0; h < 8; ++h)
#pragma unroll
                for (int ks = 0; ks < 2; ++ks) qf[h][ks] = *(const bf16x8*)(QQ + (size_t)qrow * NQQ + 2048 + h * 64 + ks * 32 + 8 * fq);
            float wi[8];
            { const f32x4 w0 = *(const f32x4*)((const float*)(ws + WS_WI) + (size_t)qrow * 8), w1 = *(const f32x4*)((const float*)(ws + WS_WI) + (size_t)qrow * 8 + 4);
              wi[0] = w0.x; wi[1] = w0.y; wi[2] = w0.z; wi[3] = w0.w; wi[4] = w1.x; wi[5] = w1.y; wi[6] = w1.z; wi[7] = w1.w; }
            unsigned* scq = SC + (size_t)(16 * qt + fr) * SC_PITCH + 4 * fq;
            bf16x8 pa0[4], pa1[4];
#define DSA_KLOAD(kt0_) do { _Pragma("unroll") for (int j = 0; j < 4; ++j) { const int kt_ = (kt0_) + j < k1 ? (kt0_) + j : k1 - 1; \
                const bf16* kp_ = KI + (size_t)krow(b, 16 * kt_ + fr) * 64 + 8 * fq; pa0[j] = *(const bf16x8*)kp_; pa1[j] = *(const bf16x8*)(kp_ + 32); } } while (0)
            DSA_KLOAD(k0);
            for (int kt0 = k0; kt0 < k1; kt0 += 4) {
                bf16x8 a0[4], a1[4];
#pragma unroll
                for (int j = 0; j < 4; ++j) { a0[j] = pa0[j]; a1[j] = pa1[j]; }
                if (kt0 + 4 < k1) DSA_KLOAD(kt0 + 4);
#pragma unroll
                for (int j = 0; j < 4; ++j) {
                    const int kt = kt0 + j;
                    float s0 = 0.f, s1 = 0.f, s2 = 0.f, s3 = 0.f;
#pragma unroll
                    for (int h = 0; h < 8; ++h) {
                        f32x4 acc = {0.f, 0.f, 0.f, 0.f};
                        acc = __builtin_amdgcn_mfma_f32_16x16x32_bf16(a0[j], qf[h][0], acc, 0, 0, 0);
                        acc = __builtin_amdgcn_mfma_f32_16x16x32_bf16(a1[j], qf[h][1], acc, 0, 0, 0);
                        s0 += wi[h] * fmaxf(acc.x, 0.f); s1 += wi[h] * fmaxf(acc.y, 0.f); s2 += wi[h] * fmaxf(acc.z, 0.f); s3 += wi[h] * fmaxf(acc.w, 0.f);
                    }
                    const int kb = 16 * kt + 4 * fq;
                    u32x4 o;
                    { const unsigned bits = __builtin_bit_cast(unsigned, s0); o.x = (kb + 0) <= pq ? (bits ^ ((bits >> 31) ? 0xffffffffu : 0x80000000u)) : 0u; }
                    { const unsigned bits = __builtin_bit_cast(unsigned, s1); o.y = (kb + 1) <= pq ? (bits ^ ((bits >> 31) ? 0xffffffffu : 0x80000000u)) : 0u; }
                    { const unsigned bits = __builtin_bit_cast(unsigned, s2); o.z = (kb + 2) <= pq ? (bits ^ ((bits >> 31) ? 0xffffffffu : 0x80000000u)) : 0u; }
                    { const unsigned bits = __builtin_bit_cast(unsigned, s3); o.w = (kb + 3) <= pq ? (bits ^ ((bits >> 31) ? 0xffffffffu : 0x80000000u)) : 0u; }
                    if (kt < k1) *(u32x4*)(scq + 16 * kt) = o;
                }
            }
#undef DSA_KLOAD
        }
        VM_WAIT();
        __syncthreads();
        DSTAMP(24);
    }
    LAS unsigned char* wl = lds + wave * DW2_STRIDE;
    LAS unsigned char* tile = wl + DW2_TILE;
    LAS unsigned short* selL = (LAS unsigned short*)(wl + DW2_SEL);
    LAS unsigned short* bkL = (LAS unsigned short*)(wl + DW2_BK);
    const LAS float* t5L = (const LAS float*)(lds + DSA2_T5);
    const LAS unsigned short* bkT = (const LAS unsigned short*)(lds + DSA2_BT);
    for (int qi_ = 0;; ++qi_) {
        asm volatile("" : "+v"(lane));
        int iq;
        if (DENSE_ONLY) { if (qi_ >= 2) break; iq = wave * 2 + qi_; }
        else { unsigned j_ = 0u; if (lane == 0) j_ = __hip_atomic_fetch_add((LAS unsigned*)(lds + DSA2_QC), 1u, __ATOMIC_RELAXED, __HIP_MEMORY_SCOPE_WORKGROUP);
               j_ = (unsigned)__builtin_amdgcn_readfirstlane((int)j_); if (j_ >= (unsigned)nq) break; iq = j_ < 32u ? 32 + (int)j_ : (int)j_ - 32; }
        if (iq >= nq) break;
        const int p = DENSE_ONLY ? iq : G.pos0(iq >> 4) + (iq & 15), nk = p + 1, qrow = DENSE_ONLY ? MR + iq : G.row0(iq >> 4) + (iq & 15);
        int nsel;
        if (!DENSE_ONLY && nk > 256) {
            const unsigned* scr = SC + (size_t)iq * SC_PITCH;
            const int nreg = (nk + 63) >> 6;
            if (nreg <= 9) dsa_select<9>(scr, nk, p, lane, lds, tile, selL, bkL, bkT, b * SEQ - NMETA);
            else if (nreg <= 17) dsa_select<17>(scr, nk, p, lane, lds, tile, selL, bkL, bkT, b * SEQ - NMETA);
            else if (nreg <= 25) dsa_select<25>(scr, nk, p, lane, lds, tile, selL, bkL, bkT, b * SEQ - NMETA);
            else dsa_select<33>(scr, nk, p, lane, lds, tile, selL, bkL, bkT, b * SEQ - NMETA);
            nsel = 256;
        } else {
#pragma unroll
            for (int m = 0; m < 4; ++m) { const int s = lane + 64 * m; selL[s] = (unsigned short)krow(b, s < nk ? s : 0); bkL[s] = bkT[s < nk ? p - s : 0]; }
            nsel = nk;
        }
        DSTAMP(25);
        asm volatile("" : "+v"(lane));
        bf16x8 qB[4];
#pragma unroll
        for (int ks = 0; ks < 4; ++ks) qB[ks] = *(const bf16x8*)(QQ + (size_t)qrow * NQQ + fr * 128 + ks * 32 + 8 * fq);
        LDS_WAIT();
        f32x4 O[8];
#pragma unroll
        for (int nt = 0; nt < 8; ++nt) O[nt] = (f32x4){0.f, 0.f, 0.f, 0.f};
        float qss = 0.f;
#pragma unroll
        for (int ks = 0; ks < 4; ++ks) { const u32x4 w = __builtin_bit_cast(u32x4, qB[ks]);
            qss += (bflo(w.x) * bflo(w.x) + bfhi(w.x) * bfhi(w.x)) + (bflo(w.y) * bflo(w.y) + bfhi(w.y) * bfhi(w.y)) + (bflo(w.z) * bflo(w.z) + bfhi(w.z) * bfhi(w.z)) + (bflo(w.w) * bflo(w.w) + bfhi(w.w) * bfhi(w.w)); }
        qss += __shfl_xor(qss, 16); qss += __shfl_xor(qss, 32);
        const float mb = sqrtf(qss) * t5L[512] + t5L[513];
        float lrun = 0.f;
        const int nblk = (nsel + 31) >> 5;
#define DSA_GATHER(GV, blk_) do { _Pragma("unroll") for (int e = 0; e < 8; ++e) { const int pid = lane + 64 * e, ri = pid >> 4, ch = pid & 15, j = 32 * (blk_) + ri; \
            const unsigned row_ = (unsigned)selL[j]; GV[e] = *(const u32x4*)((const unsigned char*)KV + (row_ * 256u + (unsigned)ch * 16u)); } } while (0)
#define DSA_PUT(GV) do { _Pragma("unroll") for (int e = 0; e < 8; ++e) { const int pid = lane + 64 * e, ri = pid >> 4, ch = pid & 15; *(LAS u32x4*)(tile + off_b(ri, ch)) = GV[e]; } } while (0)
        u32x4 gvA[8], gvB[8];
        DSA_GATHER(gvA, 0);
        if (nblk > 1) DSA_GATHER(gvB, 1);
        for (int blk0 = 0; blk0 < nblk; blk0 += 2) {
#pragma unroll
            for (int half = 0; half < 2; ++half) {
                const int blk = blk0 + half;
                if (blk < nblk) {
                    if (half == 0) { DSA_PUT(gvA); if (blk + 2 < nblk) DSA_GATHER(gvA, blk + 2); }
                    else { DSA_PUT(gvB); if (blk + 2 < nblk) DSA_GATHER(gvB, blk + 2); }
                    LDS_WAIT();
                    f32x4 s0 = {0.f, 0.f, 0.f, 0.f}, s1 = {0.f, 0.f, 0.f, 0.f};
        #pragma unroll
                    for (int ks = 0; ks < 4; ++ks) {
                        const bf16x8 k0 = *(const LAS bf16x8*)(tile + off_b(fr, 4 * ks + fq)), k1 = *(const LAS bf16x8*)(tile + off_b(16 + fr, 4 * ks + fq));
                        s0 = __builtin_amdgcn_mfma_f32_16x16x32_bf16(k0, qB[ks], s0, 0, 0, 0);
                        s1 = __builtin_amdgcn_mfma_f32_16x16x32_bf16(k1, qB[ks], s1, 0, 0, 0);
                    }
                    const int j0 = 32 * blk + 4 * fq;
                    const u32x2 b0 = *(const LAS u32x2*)(bkL + j0), b1 = *(const LAS u32x2*)(bkL + j0 + 16);
                    const float t00 = t5L[(b0.x & 0xffffu) + fr], t01 = t5L[(b0.x >> 16) + fr], t02 = t5L[(b0.y & 0xffffu) + fr], t03 = t5L[(b0.y >> 16) + fr];
                    const float t10 = t5L[(b1.x & 0xffffu) + fr], t11 = t5L[(b1.x >> 16) + fr], t12 = t5L[(b1.y & 0xffffu) + fr], t13 = t5L[(b1.y >> 16) + fr];
                    const float e00 = __expf(s0.x + t00 - mb), e01 = __expf(s0.y + t01 - mb), e02 = __expf(s0.z + t02 - mb), e03 = __expf(s0.w + t03 - mb);
                    const float e10 = __expf(s1.x + t10 - mb), e11 = __expf(s1.y + t11 - mb), e12 = __expf(s1.z + t12 - mb), e13 = __expf(s1.w + t13 - mb);
                    const float p00 = (j0 + 0) < nsel ? e00 : 0.f, p01 = (j0 + 1) < nsel ? e01 : 0.f, p02 = (j0 + 2) < nsel ? e02 : 0.f, p03 = (j0 + 3) < nsel ? e03 : 0.f;
                    const float p10 = (j0 + 16) < nsel ? e10 : 0.f, p11 = (j0 + 17) < nsel ? e11 : 0.f, p12 = (j0 + 18) < nsel ? e12 : 0.f, p13 = (j0 + 19) < nsel ? e13 : 0.f;
                    lrun += ((p00 + p01) + (p02 + p03)) + ((p10 + p11) + (p12 + p13));
                    u32x4 pw; pw.x = pk2(p00, p01); pw.y = pk2(p02, p03); pw.z = pk2(p10, p11); pw.w = pk2(p12, p13);
                    const bf16x8 pa = __builtin_bit_cast(bf16x8, pw);
                    const unsigned q4 = (unsigned)(fr >> 2), p4 = (unsigned)(lane & 3);
        #pragma unroll
                    for (int nt = 0; nt < 8; ++nt) {
                        const s16x4 vlo = tr_rd(tile + off_b(4 * fq + q4, 2 * nt + (p4 >> 1)) + 8 * (p4 & 1));
                        const s16x4 vhi = tr_rd(tile + off_b(16 + 4 * fq + q4, 2 * nt + (p4 >> 1)) + 8 * (p4 & 1));
                        const bf16x8 vb = __builtin_shufflevector(vlo, vhi, 0, 1, 2, 3, 4, 5, 6, 7);
                        O[nt] = __builtin_amdgcn_mfma_f32_16x16x32_bf16(vb, pa, O[nt], 0, 0, 0);
                    }

                }
            }
        }
#undef DSA_GATHER
#undef DSA_PUT
        float lt2 = lrun + __shfl_xor(lrun, 16); lt2 += __shfl_xor(lt2, 32);
        const float inv = __builtin_amdgcn_rcpf(lt2);
        bf16* od = (bf16*)(ws + WS_OD) + (size_t)qrow * 1024 + (size_t)(fr >> 3) * MT * 1024 + (fr & 7) * 128 + 4 * fq;
#pragma unroll
        for (int nt = 0; nt < 8; ++nt) { u32x2 ow; ow.x = pk2(O[nt].x * inv, O[nt].y * inv); ow.y = pk2(O[nt].z * inv, O[nt].w * inv); *(u32x2*)(od + 16 * nt) = ow; }
        LDS_WAIT();
        DSTAMP(26);
    }
}
__device__ __forceinline__ void p5_dsa(ArgsP a, LAS unsigned char* lds, int l, int tid, int wave, int lane, bool meta = true) {
    LAS float* t5L = (LAS float*)(lds + DSA2_T5);
    __syncthreads();
    t5L[tid] = a->in[I_T5][tid];
    if (tid == 0) *(LAS unsigned*)(lds + DSA2_QC + 4) = 0u;
    for (int n = tid; n < TT; n += 512) ((LAS unsigned short*)(lds + DSA2_BT))[n] = (unsigned short)(t5_bucket(n) * 16);
    if (tid < 64) {
        const float g0 = fabsf(a->in[I_GDKV][l * 128 + tid]), g1 = fabsf(a->in[I_GDKV][l * 128 + 64 + tid]);
        const float gm = wave_max(fmaxf(g0, g1));
        float tm = 0.f;
#pragma unroll
        for (int i = 0; i < 8; ++i) tm = fmaxf(tm, fabsf(a->in[I_T5][tid + 64 * i]));
        tm = wave_max(tm);
        if (tid == 0) { t5L[512] = 11.313708498984761f * gm; t5L[513] = tm; }
    }
    __syncthreads();
    for (int u = blockIdx.x; u < 256; u += gridDim.x) {
        dsa_unit<false>(a, lds, u, 64, wave, lane);
        if (u + (int)gridDim.x < 256) __syncthreads();
    }
    if (meta && blockIdx.x == 0) dsa_unit<true>(a, lds, 0, 16, wave, lane);
}

__global__ void __launch_bounds__(NWAVES * 64, 2) fwd(Args a_) {
    extern __shared__ __attribute__((aligned(16))) unsigned char lds_raw[];
    LAS unsigned char* lds = (LAS unsigned char*)lds_raw;
    volatile LAS unsigned* MISC = (volatile LAS unsigned*)(lds + MISC_OFF);
    if (threadIdx.x < 32) MISC[threadIdx.x] = 0u;
    __syncthreads();
    const int g_lo = a_.g_lo, g_hi = a_.g_hi, l_lo = a_.l_lo, l_hi = a_.l_hi, ph_lo = a_.ph_lo, ph_hi = a_.ph_hi, use_bar = a_.use_bar;
    XcdBarrier bar; bar.bar = (unsigned*)(a_.ws + WS_CTL) + CW_BAR; bar.x = 0; bar.st = nullptr;
    if (use_bar) bar = xcd_barrier_post((unsigned*)(a_.ws + WS_CTL) + CW_BAR, MISC + 8);
#if defined(DIAG_SEL)
#ifndef DIAG_BLK
#define DIAG_BLK 31
#endif
    int diag_site = 0; if (threadIdx.x == 0) MISC[15] = (unsigned)__builtin_amdgcn_s_memrealtime();
#define DIAG_STAMP(site) do { if (blockIdx.x == 0 && threadIdx.x == 0) { const unsigned now_ = (unsigned)__builtin_amdgcn_s_memrealtime(); MISC[16 + (site)] += now_ - MISC[15]; MISC[15] = now_; } } while (0)
#define GRID_BAR() do { if (use_bar) xcd_barrier(bar); DIAG_STAMP(diag_site); ++diag_site; } while (0)
#else
#define GRID_BAR() do { if (use_bar) xcd_barrier(bar); } while (0)
#endif
#ifndef PHMASK
#define PHMASK 0xFFFF
#endif
#ifndef PROBE_PH
#define PROBE_PH -1
#endif
#ifndef FUSE_NORM
#define FUSE_NORM 0
#endif
#ifndef PROBE_MASK
#define PROBE_MASK 0
#endif
#define PROBED(k) ((PROBE_MASK >> (k)) & 1)
#ifndef P1_ALIGN
#define P1_ALIGN true
#endif
#define PH(k) (((PHMASK >> (k)) & 1) && ph_lo <= (k) && (k) < ph_hi)
#define PBEGIN ArgsP a = (ArgsP)__builtin_amdgcn_kernarg_segment_ptr(); asm volatile("" : "+s"(a)); unsigned char* ws = a->ws; \
    int tid_ = threadIdx.x; asm volatile("" : "+v"(tid_)); const int tid = tid_, lane = tid & 63, wave = __builtin_amdgcn_readfirstlane(tid >> 6); const int gw = blockIdx.x * NWAVES + wave, ngw = gridDim.x * NWAVES; (void)ws; (void)gw; (void)ngw; (void)lane;

#if defined(DIAG_SEL)
    diag_site = 15;
#endif
    const bool full_ = PHMASK == 0xFFFF && a_.prep && g_lo == 0 && g_hi == NG && l_lo == 0 && l_hi == NL && ph_lo == 0 && ph_hi >= 13;
    if (((PHMASK >> 13) & 1) && a_.prep) { PBEGIN prep_weights(a, lds, gw, ngw, wave, lane); if (!full_) GRID_BAR(); }

    for (int g = g_lo; g < g_hi; ++g) {
        for (int l = l_lo; l < l_hi; ++l) {
#if defined(DIAG_SEL)
            diag_site = (l == 0) ? 0 : 1;
#endif
            if (PH(0) && l == 0 && (!full_ || g == 0)) { PBEGIN p0_init(a, g, gw, ngw, lane); GRID_BAR(); }
            if (PH(1)) { PBEGIN
                if (g > 0) meta_xfer(a, l, false, tid);
                run_p1<P1_ALIGN>(lds, ws, l, g == 0);
                GRID_BAR();
            }
            if (PH(2)) {
                { PBEGIN p2_prep(a, l, gw, ngw, lane, g == 0); }
#if defined(DIAG_SEL)
                __syncthreads(); DIAG_STAMP(14);
#endif
                { PBEGIN __syncthreads(); p2_chunks(a, lds, l, gw, ngw, wave, lane, g == 0); }
                GRID_BAR();
            }
            for (int st_ = 0; st_ < 2; ++st_) {
            const bool gemm_now = (st_ == 0) != (((blockIdx.x >> 5) & 1) != 0);
            if (gemm_now && PH(3)) { PBEGIN
                FQQ f{(bf16*)(ws + WS_QQ)};
                if (g == 0) meta_xfer(a, l, true, tid);
                run_gemm(lds, (const bf16*)(ws + WS_CQN), (const bf16*)(ws + WS_WQQ) + (size_t)l * NQQ * 256, NQQ, 256, f, gw, ngw, lane, g == 0);
                if (PROBED(3)) { run_gemm(lds, (const bf16*)(ws + WS_CQN), (const bf16*)(ws + WS_WQQ) + (size_t)l * NQQ * 256, NQQ, 256, f, gw, ngw, lane); }
            }
#if defined(DIAG_SEL)
            __syncthreads(); DIAG_STAMP(11);
#endif
            if (!gemm_now && PH(4)) { PBEGIN
                for (int u_ = blockIdx.x; u_ < 256; u_ += gridDim.x) {
                    const int u = (u_ & 128) | ((u_ & 7) << 4) | ((u_ & 127) >> 3);
                    const int b = (u >> 4) & 7, h = (u >> 2) & 3, vs = u & 3;
                    if (u >> 7) scan_unit<true>(a, lds, b, h, vs, tid); else scan_unit<false>(a, lds, b, h, vs, tid);
                }
#if PROBE_PH == 4
                for (int u = blockIdx.x; u < 256; u += gridDim.x) {
                    const int b = (u >> 4) & 7, h = (u >> 2) & 3, vs = u & 3;
                    if (u >> 7) scan_unit<true>(a, lds, b, h, vs, tid); else scan_unit<false>(a, lds, b, h, vs, tid);
                }
#endif
            }
            __syncthreads();
            }
            if (PH(4)) GRID_BAR();
#if defined(DIAG_SEL)
            if (blockIdx.x == DIAG_BLK && threadIdx.x == 0) MISC[14] = (unsigned)__builtin_amdgcn_s_memrealtime();
#endif
            if (PH(5)) { PBEGIN p5_dsa(a, lds, l, tid, wave, lane, g == 0); }
#if defined(DIAG_SEL)
            __syncthreads(); DSTAMP(27);
#endif
#if PROBE_PH == 5
            if (PH(5)) { PBEGIN p5_dsa(a, lds, l, tid, wave, lane); }
#endif
            if (PH(6)) { PBEGIN p6_headnorm(a, l, gw, ngw, lane, PH(5) ? (LAS unsigned*)(lds + DSA2_QC + 4) : nullptr, g == 0 ? MT : MR); if (PROBED(6)) p6_headnorm<true>(a, l, gw, ngw, lane);
#if defined(DIAG_SEL)
                DSTAMP(28);
#endif
                GRID_BAR();
#if defined(DIAG_SEL)
                DSTAMP(29);
#endif
            }
            if (PH(7)) {
                __syncthreads();
                const bool meta7 = g == 0;
                { PBEGIN
                  const bf16* OD0 = (const bf16*)(ws + WS_OD); const bf16* OD1 = OD0 + (size_t)MT * 1024;
                  const bf16* WB0 = (const bf16*)(ws + WS_WBD) + (size_t)l * D * 2048; const bf16* WB1 = WB0 + (size_t)D * D;
                  int Kc = D, Nc = D; asm volatile("" : "+s"(Kc)); asm volatile("" : "+s"(Nc));
                  pg8::Gemm g{(const bf16*)(ws + WS_OG), (const bf16*)(ws + WS_WBG) + (size_t)l * D * D, MR, Nc, Kc, OD0, OD1, (const bf16*)(ws + WS_OM), WB0, WB1, (const bf16*)(ws + WS_WBM) + (size_t)l * D * D};
                  ChainOrder S; S.S.init(MR, Nc, (int)gridDim.x, (int)blockIdx.x);
                  EpiMix E{(const bf16*)(ws + WS_Z), (bf16*)(ws + WS_MIX)};
                  pg8::gemm_phase<EpiMix, ChainOrder, true, true, true>((PG8_LAS unsigned char*)lds, g, S, E);
                  if (meta7) mini_mix(lds, (const bf16*)(ws + WS_OG), OD0, OD1, (const bf16*)(ws + WS_OM), (const bf16*)(ws + WS_WBG) + (size_t)l * D * D, WB0, WB1, (const bf16*)(ws + WS_WBM) + (size_t)l * D * D,
                           (const bf16*)(ws + WS_Z), (bf16*)(ws + WS_MIX), (int)threadIdx.x);
                }
#if PROBED(7)
                { PBEGIN
                  const bf16* OD0 = (const bf16*)(ws + WS_OD); const bf16* OD1 = OD0 + (size_t)MT * 1024;
                  const bf16* WB0 = (const bf16*)(ws + WS_WBD) + (size_t)l * D * 2048; const bf16* WB1 = WB0 + (size_t)D * D;
                  int Kc = D, Nc = D; asm volatile("" : "+s"(Kc)); asm volatile("" : "+s"(Nc));
                  pg8::Gemm g{(const bf16*)(ws + WS_OG), (const bf16*)(ws + WS_WBG) + (size_t)l * D * D, MR, Nc, Kc, OD0, OD1, (const bf16*)(ws + WS_OM), WB0, WB1, (const bf16*)(ws + WS_WBM) + (size_t)l * D * D};
                  ChainOrder S; S.S.init(MR, Nc, (int)gridDim.x, (int)blockIdx.x);
                  EpiMix E{(const bf16*)(ws + WS_Z), (bf16*)(ws + WS_MIX)};
                  pg8::gemm_phase<EpiMix, ChainOrder, true, true, true>((PG8_LAS unsigned char*)lds, g, S, E);
                  FBr<0> f0{(const bf16*)(ws + WS_Z), (float*)(ws + WS_Y), (bf16*)(ws + WS_MIX)};
                  mini_gemm(lds, (const bf16*)(ws + WS_OG), (const bf16*)(ws + WS_WBG) + (size_t)l * D * D, Nc, Kc, f0, (int)threadIdx.x);
                  FBr<1> f1{(const bf16*)(ws + WS_Z), (float*)(ws + WS_Y), (bf16*)(ws + WS_MIX)};
                  mini_gemm(lds, OD0, WB0, Nc, Kc, f1, (int)threadIdx.x);
                  mini_gemm(lds, OD1, WB1, Nc, Kc, f1, (int)threadIdx.x);
                  FBr<2> f2{(const bf16*)(ws + WS_Z), (float*)(ws + WS_Y), (bf16*)(ws + WS_MIX)};
                  mini_gemm(lds, (const bf16*)(ws + WS_OM), (const bf16*)(ws + WS_WBM) + (size_t)l * D * D, Nc, Kc, f2, (int)threadIdx.x);
                }
#endif
                GRID_BAR();
            }
            if (PH(8)) { PBEGIN
                if (FUSE_NORM && gridDim.x == 256) {
                    int Kc = D, Nc = D; asm volatile("" : "+s"(Kc)); asm volatile("" : "+s"(Nc));
                    pg8::Gemm gg{(const bf16*)(ws + WS_MIX), (const bf16*)(ws + WS_WOUT) + (size_t)l * D * D, MR, Nc, Kc};
                    pg8::StaticOrder S; S.init(MR, Nc, (int)gridDim.x, (int)blockIdx.x);
                    unsigned* ctl = (unsigned*)(ws + WS_CTL); float* xb = (float*)(ws + WS_LIF);
                    const unsigned tgt = 32u * (unsigned)(g * NL + l + 1);
                    EpiResNorm E{a->out + (size_t)g * MR * D, (bf16*)(ws + WS_XN), a->in[I_GPOSTMIX] + l * D, a->in[I_GPREMLP] + l * D,
                                 RmsExchange{xb, ctl + CW_XCNT, ctl, tgt}, RmsExchange{xb + 65536, ctl + CW_XCNT + 4096, ctl, tgt}};
                    pg8::gemm_phase<EpiResNorm, pg8::StaticOrder, false, true>((PG8_LAS unsigned char*)lds, gg, S, E);
                    FY f{(bf16*)(ws + WS_Y), 1.f};
                    mini_gemm(lds, (const bf16*)(ws + WS_MIX), (const bf16*)(ws + WS_WOUT) + (size_t)l * D * D, Nc, Kc, f, (int)threadIdx.x);
                } else {
                    FY f{(bf16*)(ws + WS_Y), 1.f};
                    run_gemm(lds, (const bf16*)(ws + WS_MIX), (const bf16*)(ws + WS_WOUT) + (size_t)l * D * D, D, D, f, gw, ngw, lane, g == 0);
                }
                GRID_BAR();
            }
            if (PH(9)) { PBEGIN p_norm_res(a, g, a->in[I_GPOSTMIX] + l * D, a->in[I_GPREMLP] + l * D, gw, ngw, lane, (FUSE_NORM && gridDim.x == 256) ? MR : 0, l == 0); GRID_BAR(); }
            if (PH(10)) { PBEGIN
                FUp f{ws + WS_Z};
                run_gemm(lds, (const bf16*)(ws + WS_XN), (const bf16*)(ws + WS_WUP) + (size_t)l * DFF * D, DFF, D, f, gw, ngw, lane, g == 0);
                if (PROBED(10)) { run_gemm(lds, (const bf16*)(ws + WS_XN), (const bf16*)(ws + WS_WUP) + (size_t)l * DFF * D, DFF, D, f, gw, ngw, lane); }
                GRID_BAR();
            }
            if (PH(11)) { PBEGIN
                run_p11(lds, ws, l, g == 0);
                GRID_BAR();
            }
            if (PH(12)) { PBEGIN p_norm_res(a, g, a->in[I_GPOSTMLP] + l * D, l + 1 < NL ? a->in[I_GPREMIX] + (l + 1) * D : nullptr, gw, ngw, lane, (FUSE_NORM && gridDim.x == 256) ? MR : 0, false, l + 1 < NL, l + 1 == NL);
                if (full_ && l + 1 == NL && g + 1 < NG) { PBEGIN p0_init(a, g + 1, gw, ngw, lane); }
                GRID_BAR(); }
        }
    }
#if defined(DIAG_SEL)
    if ((DIAG_SEL >= 24 || DIAG_SEL == 16 || DIAG_SEL == 17) && blockIdx.x == DIAG_BLK && threadIdx.x == 0) { unsigned tot = 0; for (int i = 24; i < 30; ++i) tot += MISC[i]; tot += MISC[16] + MISC[17];
        a_.out[12345] = 100.f + 900.f * (float)MISC[DIAG_SEL] / (float)tot; }
    if (DIAG_SEL < 24 && DIAG_SEL != 16 && DIAG_SEL != 17 && blockIdx.x == 0 && threadIdx.x == 0) { unsigned tot = 0; for (int i = 0; i < 16; ++i) tot += MISC[16 + i];
#if defined(DIAG_ABS)
        a_.out[12345] = 100.f + (float)MISC[16 + DIAG_SEL] * 0.001f; }
#else
        a_.out[12345] = DIAG_SEL == 99 ? 100.f + (float)tot * 0.0001f : 100.f + 900.f * (float)MISC[16 + DIAG_SEL] / (float)tot; }
#endif
#endif
#undef PH
#undef GRID_BAR
#undef PBEGIN
}

#ifndef MK_ONE_LAUNCH
#define MK_ONE_LAUNCH 1
#endif
extern "C" void kernel_launch(void* const* d_in, const int* in_sizes, int n_in, void* d_out, int out_size, void* d_ws, size_t ws_size, hipStream_t stream) {
    static int grid = 0;
    if (grid == 0) {
        if (n_in != 28 || out_size != NB * SEQ * D || ws_size < WS_END) { fprintf(stderr, "kernel_launch: unexpected shapes (n_in %d out %d ws %zu need %zu)\n", n_in, out_size, ws_size, (size_t)WS_END); grid = -1; return; }
        int dev = 0, cus = 0, per_cu = 0;
        if (hipGetDevice(&dev) != hipSuccess || hipDeviceGetAttribute(&cus, hipDeviceAttributeMultiprocessorCount, dev) != hipSuccess) { grid = -1; return; }
        if (hipFuncSetAttribute((const void*)fwd, hipFuncAttributeMaxDynamicSharedMemorySize, LDS_BYTES) != hipSuccess) { fprintf(stderr, "kernel_launch: hipFuncSetAttribute failed\n"); grid = -1; return; }
        if (hipOccupancyMaxActiveBlocksPerMultiprocessor(&per_cu, (const void*)fwd, NWAVES * 64, LDS_BYTES) != hipSuccess || per_cu < 1) { fprintf(stderr, "kernel_launch: occupancy query says %d\n", per_cu); }
        (void)hipGetLastError();
        grid = cus;
    }
    if (grid < 0) return;
    (void)hipMemsetAsync((char*)d_ws + WS_CTL, 0, CTL_ZERO_BYTES, stream);
    Args a{};
    for (int i = 0; i < 28; ++i) a.in[i] = (const float*)d_in[i];
    a.out = (float*)d_out; a.ws = (unsigned char*)d_ws;
#if MK_ONE_LAUNCH
    a.g_lo = 0; a.g_hi = NG; a.l_lo = 0; a.l_hi = NL; a.ph_lo = 0; a.ph_hi = 13; a.prep = 1; a.use_bar = 1;
    hipLaunchKernelGGL(fwd, dim3(grid), dim3(NWAVES * 64), LDS_BYTES, stream, a);
#else
    a.use_bar = 0;
    a.prep = 1; a.g_lo = 0; a.g_hi = 0; a.l_lo = 0; a.l_hi = 0; a.ph_lo = 0; a.ph_hi = 0;
    hipLaunchKernelGGL(fwd, dim3(grid), dim3(NWAVES * 64), LDS_BYTES, stream, a);
    a.prep = 0;
    static const int cuts[] = {0, 1, 2, 3, 5, 7, 8, 9, 10, 11, 12, 13};
    for (int g = 0; g < NG; ++g) for (int l = 0; l < NL; ++l) for (int c = 0; c < 11; ++c) {
        if (c == 0 && l != 0) continue;
        a.g_lo = g; a.g_hi = g + 1; a.l_lo = l; a.l_hi = l + 1; a.ph_lo = cuts[c]; a.ph_hi = cuts[c + 1];
        hipLaunchKernelGGL(fwd, dim3(grid), dim3(NWAVES * 64), LDS_BYTES, stream, a);
    }
#endif
    const hipError_t le = hipPeekAtLastError();
    if (le != hipSuccess) fprintf(stderr, "kernel_launch: launch failed: %s\n", hipGetErrorName(le));
}
```
